# Optimizing an MI355X kernel written in HIP

```python
import math
import jax, jax.numpy as jnp
from jax import lax
import numpy as np

D_MODEL = 1024
BATCH = 8
SEQ = 4096
DEPTH = 2

HEAD_DIM = 64
NSA_HEADS = 8
NSA_GROUPS = 2
NSA_HPG = NSA_HEADS // NSA_GROUPS
CMP_BLOCK = 32
CMP_STRIDE = 16
CMP_HIDDEN = 256
SEL_BLOCK = 64
N_SEL = 8
WINDOW = 512
FORCE_BONUS = 1e4
DSA_HEADS = 8
IDX_HEADS = 4
IDX_DIM = 64
DSA_TOPK_MAX = 256
Q_BLOCK = 128
N_BUCKETS = 32
T5_MAX_DIST = 128
N_ATTN_HEADS = NSA_HEADS + DSA_HEADS
LRU_WIDTH = 512
LRU_BLOCKS = 8
LRU_BLOCK_DIM = LRU_WIDTH // LRU_BLOCKS
CONV_WIDTH = 4
LRU_C = 8.0
MLSTM_HEADS = 4
MLSTM_DIM = 128
MLSTM_WIDTH = MLSTM_HEADS * MLSTM_DIM
MLSTM_CHUNK = 64
PLE_DIM = 256
RMS_EPS = 1e-6
NEG = -1e30
N_EVEN = (DEPTH + 1) // 2
N_ODD = DEPTH // 2
NSA_WIDTH = NSA_HEADS * HEAD_DIM
DSA_WIDTH = DSA_HEADS * HEAD_DIM
NSA_KV = NSA_GROUPS * HEAD_DIM
ATTN_SPLITS = (NSA_WIDTH, 6 * NSA_KV, 3 * NSA_HEADS, NSA_WIDTH,
               DSA_WIDTH, HEAD_DIM, HEAD_DIM, IDX_HEADS * IDX_DIM, IDX_DIM, IDX_HEADS, DSA_WIDTH)
ATTN_IN = sum(ATTN_SPLITS)
ATTN_OUT = NSA_WIDTH + DSA_WIDTH
REC_SPLITS = (LRU_WIDTH, LRU_WIDTH, MLSTM_WIDTH, MLSTM_WIDTH, MLSTM_WIDTH,
              MLSTM_HEADS, MLSTM_HEADS, MLSTM_WIDTH, MLSTM_WIDTH)
REC_IN = sum(REC_SPLITS)
REC_OUT = LRU_WIDTH + MLSTM_WIDTH

kernel_name = "hybrid_nsa_dsa_rglru_mlstm_trunk"


def rmsnorm(x, g):
    xf = x.astype(jnp.float32)
    y = xf * lax.rsqrt(jnp.mean(xf * xf, axis=-1, keepdims=True) + RMS_EPS)
    return (y * g.astype(jnp.float32)).astype(x.dtype)


def split_cols(u, widths):
    return jnp.split(u, [int(c) for c in np.cumsum(widths)[:-1]], axis=-1)


def masked_softmax(s, mask):
    return jax.nn.softmax(jnp.where(mask, s, NEG), axis=-1)


def t5_bucket(dist):
    n = jnp.maximum(dist, 0)
    max_exact = N_BUCKETS // 2
    nf = jnp.maximum(n, 1).astype(jnp.float32)
    large = max_exact + (jnp.log(nf / max_exact) / math.log(T5_MAX_DIST / max_exact)
                         * (N_BUCKETS - max_exact)).astype(jnp.int32)
    large = jnp.minimum(large, N_BUCKETS - 1)
    return jnp.where(n < max_exact, n, large)


def causal_dwconv(x, w, b):
    y = lax.conv_general_dilated(x, w[:, None, :], window_strides=(1,),
                                 padding=[(CONV_WIDTH - 1, 0)],
                                 dimension_numbers=('NWC', 'WIO', 'NWC'),
                                 feature_group_count=x.shape[-1])
    return y + b


def compress_blocks(k, pos, w1, w2):
    B, S = k.shape[0], k.shape[1]
    n_cmp = (S - CMP_BLOCK) // CMP_STRIDE + 1
    idx = np.arange(n_cmp)[:, None] * CMP_STRIDE + np.arange(CMP_BLOCK)[None, :]
    blk = k[:, idx] + pos[None, None, :, None, :]
    blk = blk.transpose(0, 1, 3, 2, 4).reshape(B, n_cmp, NSA_GROUPS, CMP_BLOCK * HEAD_DIM)
    return jax.nn.silu(blk @ w1) @ w2


def sparse_attention_layer(h, w_in, w_out, cmp_pos_k, cmp_w1_k, cmp_w2_k,
                           cmp_pos_v, cmp_w1_v, cmp_w2_v, t5_table):
    f32 = jnp.float32
    B, S, _ = h.shape
    u = h @ w_in
    (a_q, a_kv, a_g, a_z, b_q, b_k, b_v, b_qi, b_ki, b_wi, b_z) = split_cols(u, ATTN_SPLITS)
    scale = HEAD_DIM ** -0.5

    a_q = a_q.astype(f32).reshape(B, S, NSA_GROUPS, NSA_HPG, HEAD_DIM)
    gates = jax.nn.sigmoid(a_g.astype(f32)).reshape(B, S, NSA_GROUPS, NSA_HPG, 3)
    kc, vc, ks, vs, kw, vw = [t.reshape(B, S, NSA_GROUPS, HEAD_DIM) for t in jnp.split(a_kv, 6, axis=-1)]
    k_cmp = compress_blocks(kc, cmp_pos_k, cmp_w1_k, cmp_w2_k).astype(f32)
    v_cmp = compress_blocks(vc, cmp_pos_v, cmp_w1_v, cmp_w2_v).astype(f32)
    n_cmp = k_cmp.shape[1]
    cmp_end = jnp.asarray(np.arange(n_cmp) * CMP_STRIDE + CMP_BLOCK - 1, jnp.int32)
    n_blocks = S // SEL_BLOCK
    n_pick = min(N_SEL, n_blocks)
    ci = np.arange(n_cmp)[:, None]
    sj = np.arange(n_blocks)[None, :]
    overlap = jnp.asarray(((ci * CMP_STRIDE < (sj + 1) * SEL_BLOCK)
                           & (ci * CMP_STRIDE + CMP_BLOCK > sj * SEL_BLOCK)).astype(np.float32))
    blk_start = jnp.arange(n_blocks, dtype=jnp.int32) * SEL_BLOCK
    nb_idx = jnp.arange(n_blocks, dtype=jnp.int32)
    ks_blocks = ks.astype(f32).transpose(0, 2, 1, 3).reshape(B, NSA_GROUPS, n_blocks, SEL_BLOCK, HEAD_DIM)
    vs_blocks = vs.astype(f32).transpose(0, 2, 1, 3).reshape(B, NSA_GROUPS, n_blocks, SEL_BLOCK, HEAD_DIM)
    pad = ((0, 0), (WINDOW, 0), (0, 0), (0, 0))
    kw_pad = jnp.pad(kw.astype(f32), pad)
    vw_pad = jnp.pad(vw.astype(f32), pad)
    tbl_a = t5_table[:, :NSA_HEADS].astype(f32).reshape(N_BUCKETS, NSA_GROUPS, NSA_HPG).transpose(1, 2,0)
    g_ar = jnp.arange(NSA_GROUPS)[None, :, None, None, None]
    h_ar = jnp.arange(NSA_HPG)[None, None, :, None, None]

    b_q = b_q.astype(f32).reshape(B, S, DSA_HEADS, HEAD_DIM)
    b_k = b_k.astype(f32)
    b_v = b_v.astype(f32)
    b_qi = b_qi.astype(f32).reshape(B, S, IDX_HEADS, IDX_DIM)
    b_ki = b_ki.astype(f32)
    b_wi = b_wi.astype(f32) * (IDX_DIM ** -0.5 * IDX_HEADS ** -0.5)
    k_top = min(DSA_TOPK_MAX, S // 4)
    tbl_b = t5_table[:, NSA_HEADS:].astype(f32).T
    key_pos = jnp.arange(S, dtype=jnp.int32)

    def block_fn(qb):
        q0 = qb * Q_BLOCK
        t = q0 + jnp.arange(Q_BLOCK, dtype=jnp.int32)
        qa = lax.dynamic_slice_in_dim(a_q, q0, Q_BLOCK, axis=1)
        dist_c = t[:, None] - cmp_end[None, :]
        mask_c = dist_c >= 0
        s_c = jnp.einsum('bqghd,bcgd->bghqc', qa, k_cmp) * scale + tbl_a[:, :, t5_bucket(dist_c)]
        p_c = masked_softmax(s_c, mask_c) * jnp.any(mask_c, axis=-1)[:, None].astype(f32)
        o_c = jnp.einsum('bghqc,bcgd->bqghd', p_c, v_cmp)
        imp = jnp.einsum('bghqc,cn->bgqn', p_c, overlap)
        cur = t // SEL_BLOCK
        forced = ((nb_idx[None, :] == 0) | (nb_idx[None, :] == cur[:, None])
                  | (nb_idx[None, :] == cur[:, None] - 1)).astype(f32)
        admissible = blk_start[None, :] <= t[:, None]
        score = jnp.where(admissible, imp + FORCE_BONUS * forced, NEG)
        _, sel = lax.top_k(score, n_pick)
        gather = jax.vmap(jax.vmap(lambda kb, ix: kb[ix]))
        k_sel = gather(ks_blocks, sel).reshape(B, NSA_GROUPS, Q_BLOCK, n_pick * SEL_BLOCK, HEAD_DIM)
        v_sel = gather(vs_blocks, sel).reshape(B, NSA_GROUPS, Q_BLOCK, n_pick * SEL_BLOCK, HEAD_DIM)
        pos_sel = (sel[..., None] * SEL_BLOCK + jnp.arange(SEL_BLOCK, dtype=jnp.int32)).reshape(
            B, NSA_GROUPS, Q_BLOCK, n_pick * SEL_BLOCK)
        dist_s = t[None, None, :, None] - pos_sel
        bias_s = tbl_a[g_ar, h_ar, t5_bucket(dist_s)[:, :, None]]
        s_s = jnp.einsum('bqghd,bgqkd->bghqk', qa, k_sel) * scale + bias_s
        p_s = masked_softmax(s_s, (dist_s >= 0)[:, :, None])
        o_s = jnp.einsum('bghqk,bgqkd->bqghd', p_s, v_sel)
        k_win = lax.dynamic_slice_in_dim(kw_pad, q0, Q_BLOCK + WINDOW, axis=1)
        v_win = lax.dynamic_slice_in_dim(vw_pad, q0, Q_BLOCK + WINDOW, axis=1)
        pos_w = q0 - WINDOW + jnp.arange(Q_BLOCK + WINDOW, dtype=jnp.int32)
        dist_w = t[:, None] - pos_w[None, :]
        mask_w = (dist_w >= 0) & (dist_w < WINDOW) & (pos_w >= 0)[None, :]
        s_w = jnp.einsum('bqghd,bkgd->bghqk', qa, k_win) * scale + tbl_a[:, :, t5_bucket(dist_w)]
        p_w = masked_softmax(s_w, mask_w)
        o_w = jnp.einsum('bghqk,bkgd->bqghd', p_w, v_win)
        g = lax.dynamic_slice_in_dim(gates, q0, Q_BLOCK, axis=1)
        o_a = (g[..., 0:1] * o_c + g[..., 1:2] * o_s + g[..., 2:3] * o_w).reshape(B, Q_BLOCK, NSA_WIDTH)
        qi = lax.dynamic_slice_in_dim(b_qi, q0, Q_BLOCK, axis=1)
        wi = lax.dynamic_slice_in_dim(b_wi, q0, Q_BLOCK, axis=1)
        idx_score = jnp.einsum('bqh,bqhs->bqs', wi, jax.nn.relu(jnp.einsum('bqhd,bsd->bqhs', qi, b_ki)))
        idx_score = jnp.where(key_pos[None, :] <= t[:, None], idx_score, NEG)
        _, sel_b = lax.top_k(idx_score, k_top)
        take = jax.vmap(lambda kk, ix: kk[ix])
        k_b = take(b_k, sel_b)
        v_b = take(b_v, sel_b)
        dist_b = t[None, :, None] - sel_b
        bias_b = tbl_b[:, t5_bucket(dist_b)].transpose(1, 0, 2, 3)
        qd = lax.dynamic_slice_in_dim(b_q, q0, Q_BLOCK, axis=1)
        s_b = jnp.einsum('bqhd,bqkd->bhqk', qd, k_b) * scale + bias_b
        p_b = masked_softmax(s_b, (dist_b >= 0)[:, None])
        o_b = jnp.einsum('bhqk,bqkd->bqhd', p_b, v_b).reshape(B, Q_BLOCK, DSA_WIDTH)
        return o_a, o_b

    o_a, o_b = lax.map(block_fn, jnp.arange(S // Q_BLOCK, dtype=jnp.int32))
    o_a = o_a.transpose(1, 0, 2, 3).reshape(B, S, NSA_WIDTH)
    o_b = o_b.transpose(1, 0, 2, 3).reshape(B, S, DSA_WIDTH)
    y = jnp.concatenate([o_a * jax.nn.silu(a_z.astype(f32)), o_b * jax.nn.silu(b_z.astype(f32))], axis=-1)
    return y.astype(h.dtype) @ w_out


def rglru(x, conv_w, conv_b, wa, ba, wx, bx, lam):
    B, S, _ = x.shape
    xc = causal_dwconv(x, conv_w, conv_b)
    xb = xc.reshape(B, S, LRU_BLOCKS, LRU_BLOCK_DIM)
    r = jax.nn.sigmoid(jnp.einsum('bsgi,gij->bsgj', xb, wa).reshape(B, S, LRU_WIDTH) + ba)
    ig = jax.nn.sigmoid(jnp.einsum('bsgi,gij->bsgj', xb, wx).reshape(B, S, LRU_WIDTH) + bx)
    log_a = -LRU_C * r.astype(jnp.float32) * jax.nn.softplus(-lam.astype(jnp.float32))
    a = jnp.exp(log_a)
    b = jnp.sqrt(-jnp.expm1(2.0 * log_a)) * (ig * xc).astype(jnp.float32)

    def combine(lhs, rhs):
        a1, b1 = lhs
        a2, b2 = rhs
        return a1 * a2, a2 * b1 + b2

    _, hs = lax.associative_scan(combine, (a, b), axis=1)
    return hs


def mlstm_chunkwise(q, k, v, i_pre, f_pre):
    f32 = jnp.float32
    B, S, _ = q.shape
    L = MLSTM_CHUNK
    nc = S // L

    def to_chunks(t):
        return t.astype(f32).reshape(B, nc, L, MLSTM_HEADS, MLSTM_DIM).transpose(1, 0, 3, 2, 4)

    def gate_chunks(t):
        return t.reshape(B, nc, L, MLSTM_HEADS).transpose(1, 0, 3, 2)

    qc = to_chunks(q)
    kc = to_chunks(k) * (MLSTM_DIM ** -0.5)
    vc = to_chunks(v)
    li = gate_chunks(i_pre.astype(f32))
    lf = gate_chunks(jax.nn.log_sigmoid(f_pre.astype(f32)))
    causal = jnp.asarray(np.tril(np.ones((L, L), dtype=bool)))

    def step(carry, xs):
        C, n, m = carry
        q_, k_, v_, li_, lf_ = xs
        b = jnp.cumsum(lf_, axis=-1)
        dmat = jnp.where(causal, b[..., :, None] - b[..., None, :] + li_[..., None, :], -jnp.inf)
        inter = b + m[..., None]
        m_t = jnp.maximum(inter, jnp.max(dmat, axis=-1))
        w = jnp.einsum('bhld,bhsd->bhls', q_, k_) * jnp.exp(dmat - m_t[..., None])
        prev = jnp.exp(inter - m_t)
        num = prev[..., None] * jnp.einsum('bhld,bhde->bhle', q_, C) + jnp.einsum('bhls,bhse->bhle', w, v_)
        den = prev * jnp.einsum('bhld,bhd->bhl', q_, n) + jnp.sum(w, axis=-1)
        out = num / jnp.maximum(jnp.abs(den), jnp.exp(-m_t))[..., None]
        b_last = b[..., -1]
        decay = b_last[..., None] - b + li_
        m_new = jnp.maximum(b_last + m, jnp.max(decay, axis=-1))
        wk = jnp.exp(decay - m_new[..., None])
        keep = jnp.exp(b_last + m - m_new)
        C_new = keep[..., None, None] * C + jnp.einsum('bhs,bhsd,bhse->bhde', wk, k_, v_)
        n_new = keep[..., None] * n + jnp.einsum('bhs,bhsd->bhd', wk, k_)
        return (C_new, n_new, m_new), out

    init = (jnp.zeros((B, MLSTM_HEADS, MLSTM_DIM, MLSTM_DIM), f32),
            jnp.zeros((B, MLSTM_HEADS, MLSTM_DIM), f32),
            jnp.zeros((B, MLSTM_HEADS), f32))
    _, hs = lax.scan(step, init, (qc, kc, vc, li, lf))
    return hs.transpose(1, 0, 3, 2, 4).reshape(B, S, MLSTM_WIDTH)


def recurrent_layer(h, w_in, w_out, conv_c_w, conv_c_b, wa, ba, wx, bx, lam,
                    conv_d_w, conv_d_b, b_i, b_f):
    f32 = jnp.float32
    u = h @ w_in
    c_x, c_z, d_q, d_k, d_v, d_i, d_f, d_o, d_z = split_cols(u, REC_SPLITS)
    y_c = rglru(c_x, conv_c_w, conv_c_b, wa, ba, wx, bx, lam) * jax.nn.silu(c_z.astype(f32))
    qk = jax.nn.silu(causal_dwconv(jnp.concatenate([d_q, d_k], axis=-1), conv_d_w, conv_d_b))
    q, k = jnp.split(qk, 2, axis=-1)
    h_d = mlstm_chunkwise(q, k, d_v, d_i + b_i, d_f + b_f)
    y_d = jax.nn.sigmoid(d_o.astype(f32)) * h_d * jax.nn.silu(d_z.astype(f32))
    y = jnp.concatenate([y_c, y_d], axis=-1)
    return y.astype(h.dtype) @ w_out


def setup_inputs(seed: int = 0) -> dict:
    key = jax.random.key(seed)
    keys = iter(jax.random.split(key, 40))

    def nrm(shape, scale):
        return jax.random.normal(next(keys), shape, jnp.float32) * scale

    a0 = jax.random.uniform(next(keys), (N_ODD, LRU_WIDTH), jnp.float32, minval=0.9, maxval=0.999)
    return {
        "x": nrm((BATCH, SEQ, D_MODEL), 1.0),
        "p": nrm((DEPTH, BATCH, SEQ, PLE_DIM), 1.0),
        "norm_g": 1.0 + nrm((DEPTH, D_MODEL), 0.02),
        "final_g": 1.0 + nrm((D_MODEL,), 0.02),
        "ple_w": nrm((DEPTH, PLE_DIM, D_MODEL), PLE_DIM ** -0.5),
        "ple_gate_w": nrm((DEPTH, D_MODEL, D_MODEL), D_MODEL ** -0.5),
        "t5_table": nrm((N_BUCKETS, N_ATTN_HEADS), 0.3),
        "attn_w_in": nrm((N_EVEN, D_MODEL, ATTN_IN), D_MODEL ** -0.5),
        "attn_w_out": nrm((N_EVEN, ATTN_OUT, D_MODEL), ATTN_OUT ** -0.5),
        "cmp_pos_k": nrm((N_EVEN, CMP_BLOCK, HEAD_DIM), 0.1),
        "cmp_w1_k": nrm((N_EVEN, CMP_BLOCK * HEAD_DIM, CMP_HIDDEN), (CMP_BLOCK * HEAD_DIM) ** -0.5),
        "cmp_w2_k": nrm((N_EVEN, CMP_HIDDEN, HEAD_DIM), CMP_HIDDEN ** -0.5),
        "cmp_pos_v": nrm((N_EVEN, CMP_BLOCK, HEAD_DIM), 0.1),
        "cmp_w1_v": nrm((N_EVEN, CMP_BLOCK * HEAD_DIM, CMP_HIDDEN), (CMP_BLOCK * HEAD_DIM) ** -0.5),
        "cmp_w2_v": nrm((N_EVEN, CMP_HIDDEN, HEAD_DIM), CMP_HIDDEN ** -0.5),
        "rec_w_in": nrm((N_ODD, D_MODEL, REC_IN), D_MODEL ** -0.5),
        "rec_w_out": nrm((N_ODD, REC_OUT, D_MODEL), REC_OUT ** -0.5),
        "lru_conv_w": nrm((N_ODD, CONV_WIDTH, LRU_WIDTH), CONV_WIDTH ** -0.5),
        "lru_conv_b": nrm((N_ODD, LRU_WIDTH), 0.01),
        "lru_wa": nrm((N_ODD, LRU_BLOCKS, LRU_BLOCK_DIM, LRU_BLOCK_DIM), LRU_BLOCK_DIM ** -0.5),
        "lru_ba": nrm((N_ODD, LRU_WIDTH), 0.01),
        "lru_wx": nrm((N_ODD, LRU_BLOCKS, LRU_BLOCK_DIM, LRU_BLOCK_DIM), LRU_BLOCK_DIM ** -0.5),
        "lru_bx": nrm((N_ODD, LRU_WIDTH), 0.01),
        "lru_lambda": jnp.log(a0) - jnp.log1p(-a0),
        "mlstm_conv_w": nrm((N_ODD, CONV_WIDTH, 2 * MLSTM_WIDTH), CONV_WIDTH ** -0.5),
        "mlstm_conv_b": nrm((N_ODD, 2 * MLSTM_WIDTH), 0.01),
        "mlstm_b_i": nrm((N_ODD, MLSTM_HEADS), 0.1),
        "mlstm_b_f": jnp.linspace(3.0, 6.0, MLSTM_HEADS, dtype=jnp.float32)[None, :] + nrm((N_ODD, MLSTM_HEADS), 0.1),
    }


def reference(x, p, norm_g, final_g, ple_w, ple_gate_w, t5_table,
              attn_w_in, attn_w_out, cmp_pos_k, cmp_w1_k, cmp_w2_k,
              cmp_pos_v, cmp_w1_v, cmp_w2_v,
              rec_w_in, rec_w_out, lru_conv_w, lru_conv_b, lru_wa, lru_ba,
              lru_wx, lru_bx, lru_lambda, mlstm_conv_w, mlstm_conv_b, mlstm_b_i, mlstm_b_f):
    for i in range(DEPTH):
        hn = rmsnorm(x, norm_g[i])
        j = i // 2
        if i % 2 == 0:
            y = sparse_attention_layer(hn, attn_w_in[j], attn_w_out[j],
                                       cmp_pos_k[j], cmp_w1_k[j], cmp_w2_k[j],
                                       cmp_pos_v[j], cmp_w1_v[j], cmp_w2_v[j], t5_table)
        else:
            y = recurrent_layer(hn, rec_w_in[j], rec_w_out[j], lru_conv_w[j], lru_conv_b[j],
                                lru_wa[j], lru_ba[j], lru_wx[j], lru_bx[j], lru_lambda[j],
                                mlstm_conv_w[j], mlstm_conv_b[j], mlstm_b_i[j], mlstm_b_f[j])
        x = x + y
        x = x + (p[i] @ ple_w[i]) * jax.nn.sigmoid(x @ ple_gate_w[i])
    return rmsnorm(x, final_g)
```

```cpp
#include <hip/hip_runtime.h>
#include <cstdio>
#include <cstdint>

#ifndef MK_PER_PHASE
#define MK_PER_PHASE 0
#endif

#define LAS __attribute__((address_space(3)))
typedef unsigned short bf16_t;
typedef short bf16x8 __attribute__((ext_vector_type(8)));
typedef float f32x4 __attribute__((ext_vector_type(4)));
#define DI __device__ __forceinline__

constexpr int NB = 8, SEQ = 4096, DM = 1024, MT = NB * SEQ;
constexpr int LD0 = 3328, LD1 = 3840;
constexpr int C_AQ = 0, C_KC = 512, C_VC = 640, C_KS = 768, C_VS = 896, C_KW = 1024, C_VW = 1152, C_AZ = 1280, C_BQ = 1792, C_BZ = 2304,
              C_BK = 2816, C_BV = 2880, C_BKI = 2944, C_BQI = 3008, C_AG = 3264, C_BWI = 3288;
constexpr int C_CX = 0, C_CZ = 512, C_DQ = 1024, C_DK = 1536, C_DV = 2048, C_DO = 2560, C_DZ = 3072, C_DI = 3584, C_DF = 3588;
constexpr int NCMP = 255;
constexpr float NEG_INF = -__builtin_inff();

DI int map0(int n) {
    if (n < 1280) return n;
    if (n < 1792) return 1304 + (n - 1280);
    if (n < 2304) return 1816 + (n - 1792);
    if (n < 2816) return 2780 + (n - 2304);
    if (n < 2880) return 2328 + (n - 2816);
    if (n < 2944) return 2392 + (n - 2880);
    if (n < 3008) return 2712 + (n - 2944);
    if (n < 3264) return 2456 + (n - 3008);
    if (n < 3288) return 1280 + (n - 3264);
    if (n < 3292) return 2776 + (n - 3288);
    return -1;
}
DI int map1(int n) {
    if (n < 2560) return n;
    if (n < 3072) return 2568 + (n - 2560);
    if (n < 3584) return 3080 + (n - 3072);
    if (n < 3588) return 2560 + (n - 3584);
    if (n < 3592) return 2564 + (n - 3588);
    return -1;
}
DI int mapid(int n) { return n; }

constexpr size_t CTL_BYTES = 16384;
constexpr size_t WS_WIN0  = CTL_BYTES;
constexpr size_t WS_WOUT0 = WS_WIN0  + (size_t)LD0 * 1024 * 2;
constexpr size_t WS_WG0   = WS_WOUT0 + (size_t)1024 * 1024 * 2;
constexpr size_t WS_WP0   = WS_WG0   + (size_t)1024 * 1024 * 2;
constexpr size_t WS_WIN1  = WS_WP0   + (size_t)1024 * 256 * 2;
constexpr size_t WS_WOUT1 = WS_WIN1  + (size_t)LD1 * 1024 * 2;
constexpr size_t WS_WG1   = WS_WOUT1 + (size_t)1024 * 1024 * 2;
constexpr size_t WS_WP1   = WS_WG1   + (size_t)1024 * 1024 * 2;
constexpr size_t WS_WC1K  = WS_WP1   + (size_t)1024 * 256 * 2;
constexpr size_t WS_WC1V  = WS_WC1K  + (size_t)256 * 2048 * 2;
constexpr size_t WS_BFA   = WS_WC1V  + (size_t)256 * 2048 * 2;
constexpr size_t WS_BFB   = WS_BFA   + (size_t)MT * 1024 * 2;
constexpr size_t WS_PBF   = WS_BFB   + (size_t)MT * 1024 * 2;
constexpr size_t WS_U     = WS_PBF   + (size_t)2 * MT * 256 * 2;
constexpr size_t WS_X     = WS_U     + (size_t)MT * LD1 * 2;
constexpr size_t WS_AK    = WS_X;
constexpr size_t WS_AV    = WS_AK    + (size_t)4096 * 2048 * 2;
constexpr size_t WS_HK    = WS_AV    + (size_t)4096 * 2048 * 2;
constexpr size_t WS_HV    = WS_HK    + (size_t)4096 * 256 * 2;
constexpr size_t WS_LRUA  = WS_X;
constexpr size_t WS_LRUH  = WS_LRUA  + (size_t)MT * 512 * 2;
constexpr size_t WS_S     = WS_X     + (size_t)64 * 1024 * 1024;
constexpr size_t WS_KCMP  = WS_S;
constexpr size_t WS_VCMP  = WS_KCMP  + (size_t)16 * 256 * 64 * 4;
constexpr size_t WS_AEND  = WS_VCMP  + (size_t)16 * 256 * 64 * 4;
constexpr size_t WS_HEND  = WS_AEND  + (size_t)8 * 64 * 512 * 4;
constexpr size_t WS_HIN   = WS_HEND  + (size_t)8 * 64 * 512 * 4;
constexpr size_t WS_ZLOC  = WS_HIN   + (size_t)8 * 64 * 512 * 4;
constexpr size_t WS_NIN   = WS_ZLOC  + (size_t)2048 * 128 * 4;
constexpr size_t WS_SCAL  = WS_NIN   + (size_t)2048 * 128 * 4;
constexpr size_t WS_END   = WS_SCAL  + (size_t)3 * 2048 * 4;
static_assert(WS_HV + (size_t)4096 * 256 * 2 <= WS_S, "compress region");
static_assert(WS_LRUH + (size_t)MT * 512 * 2 <= WS_S, "lru region");

constexpr int XCD_BAR_WORDS_C = 3456;
constexpr int CW_QNSA = 3520, CW_QDSA = 3584;

constexpr int LDS_BYTES = 147456;
constexpr int LDS_CTL_OFF = 0;
constexpr int LDS_WORK_OFF = 1024;

DI float bf2f(bf16_t v) { return __uint_as_float(((unsigned)v) << 16); }
DI bf16_t f2bf(float f) { unsigned u = __float_as_uint(f); u += 0x7FFFu + ((u >> 16) & 1u); return (bf16_t)(u >> 16); }
DI unsigned pack2(float lo, float hi) { return (unsigned)f2bf(lo) | ((unsigned)f2bf(hi) << 16); }
DI float sigmoidf_(float x) { return 1.0f / (1.0f + expf(-x)); }
DI float siluf_(float x) { return x / (1.0f + expf(-x)); }
DI float wave_max(float v) { for (int o = 32; o >= 1; o >>= 1) v = fmaxf(v, __shfl_xor(v, o)); return v; }
DI float wave_sum(float v) { for (int o = 32; o >= 1; o >>= 1) v += __shfl_xor(v, o); return v; }
DI void unpack8(const uint4& v, float (&f)[8]) {
    f[0] = __uint_as_float(v.x << 16); f[1] = __uint_as_float(v.x & 0xFFFF0000u);
    f[2] = __uint_as_float(v.y << 16); f[3] = __uint_as_float(v.y & 0xFFFF0000u);
    f[4] = __uint_as_float(v.z << 16); f[5] = __uint_as_float(v.z & 0xFFFF0000u);
    f[6] = __uint_as_float(v.w << 16); f[7] = __uint_as_float(v.w & 0xFFFF0000u);
}

#define XB_TMO      128
#define XB_XCNT(j)  (256  + 64 * (j))
#define XB_XSUB(j)  (1280 + 64 * (j))
#define XB_XGEN(j)  (2304 + 64 * (j))
#define XB_TOP      3328
#define XB_TOPGEN   3392
#define XCD_BAR_WORDS 3456
#define XB_SPIN_CAP (1u << 22)
static_assert(XCD_BAR_WORDS == XCD_BAR_WORDS_C, "bar words");

__device__ __forceinline__ unsigned xb_ld(unsigned* p)              { return __hip_atomic_load(p, __ATOMIC_RELAXED, __HIP_MEMORY_SCOPE_AGENT); }
__device__ __forceinline__ unsigned xb_add(unsigned* p, unsigned v) { return __hip_atomic_fetch_add(p, v, __ATOMIC_RELAXED, __HIP_MEMORY_SCOPE_AGENT); }
__device__ __forceinline__ unsigned xb_xcc_id() { return (unsigned)__builtin_amdgcn_s_getreg((3 << 11) | 20) & 0xFu; }
#define XB_SPIN(cond, bar) do { unsigned _sp = 0; while (cond) { __builtin_amdgcn_s_sleep(1); \
    if ((++_sp & 255u) == 0u) { if (xb_ld(&(bar)[XB_TMO])) break; if (_sp > XB_SPIN_CAP) { atomicAdd(&(bar)[XB_TMO], 1u); break; } } } } while (0)

struct XcdBarrier { unsigned* bar; unsigned x; volatile LAS unsigned* st; };

__device__ __forceinline__ XcdBarrier xcd_barrier_post(unsigned* bar, volatile LAS unsigned* st) {
    XcdBarrier b; b.bar = bar; b.x = xb_xcc_id(); b.st = st;
    if (threadIdx.x == 0) (void)xb_add(&bar[XB_XCNT(b.x)], 1u);
    return b;
}
__device__ __forceinline__ void xcd_barrier_complete(unsigned* bar, unsigned x, unsigned& nloc, unsigned& nx) {
    const unsigned G = gridDim.x * gridDim.y * gridDim.z;
    unsigned sum, cnt, mine, sp = 0u;
    for (;;) {
        sum = 0u; cnt = 0u; mine = 0u;
#pragma unroll
        for (unsigned j = 0; j < 16; ++j) { const unsigned c = xb_ld(&bar[XB_XCNT(j)]); sum += c; cnt += (c > 0u) ? 1u : 0u; mine = (j == x) ? c : mine; }
        if (sum == G) break;
        __builtin_amdgcn_s_sleep(1);
        if ((++sp & 255u) == 0u) { if (xb_ld(&bar[XB_TMO])) break; if (sp > XB_SPIN_CAP) { atomicAdd(&bar[XB_TMO], 1u); break; } }
    }
    nloc = mine > 0u ? mine : 1u; nx = cnt > 0u ? cnt : 1u;
}
__device__ __forceinline__ void xcd_barrier(const XcdBarrier& b) {
    asm volatile("s_waitcnt vmcnt(0)" ::: "memory");
    __syncthreads();
    if (threadIdx.x == 0) {
        unsigned* bar = b.bar;
        __builtin_amdgcn_s_waitcnt(0);
        unsigned nloc = b.st[0], nx = b.st[1];
        if (nloc == 0u) { xcd_barrier_complete(bar, b.x, nloc, nx); b.st[0] = nloc; b.st[1] = nx; }
        const unsigned old = xb_add(&bar[XB_XSUB(b.x)], 1u);
        const unsigned gen = old / nloc;
        if (old + 1u == (gen + 1u) * nloc) {
            __builtin_amdgcn_fence(__ATOMIC_RELEASE, "agent");
            asm volatile("s_waitcnt vmcnt(0)" ::: "memory");
            const unsigned og = xb_add(&bar[XB_TOP], 1u);
            const unsigned tg = og / nx;
            if (og + 1u == (tg + 1u) * nx) xb_add(&bar[XB_TOPGEN], 1u);
            else XB_SPIN(xb_ld(&bar[XB_TOPGEN]) == tg, bar);
            __builtin_amdgcn_fence(__ATOMIC_ACQUIRE, "agent");
            xb_add(&bar[XB_XGEN(b.x)], 1u);
            asm volatile("s_waitcnt vmcnt(0)" ::: "memory");
        } else {
            XB_SPIN(xb_ld(&bar[XB_XGEN(b.x)]) == gen, bar);
            __builtin_amdgcn_fence(__ATOMIC_ACQUIRE, "agent");
            asm volatile("s_waitcnt vmcnt(0)" ::: "memory");
        }
    }
    __syncthreads();
}

namespace pg8 {
constexpr int BM = 256, BK = 64, HALF = 128, HTB = HALF * BK * 2, STAGE_BYTES = 8 * HTB, NXCD = 8, WGM = 8;
__host__ __device__ __forceinline__ int lds_byte(int r, int c) { const int st = (r >> 4) * 2 + (c >> 5), rr = r & 15, cc = c & 31, ob = rr * 64 + cc * 2; return st * 1024 + (ob ^ (((ob >> 9) & 1) << 5)); }
__host__ __device__ __forceinline__ void stage_rc(int b, int& R, int& C) { const int st = b / 1024, sb = b % 1024, swz = sb ^ (((sb >> 9) & 1) << 5); R = (st >> 1) * 16 + swz / 64; C = (st & 1) * 32 + (swz % 64) / 2; }
__host__ __device__ __forceinline__ int perm32(int rho) { const int n = rho >> 4, i = rho & 15; return 8 * (i >> 2) + 4 * n + (i & 3); }
struct Unit { int pm, pn; };
struct Gemm { const bf16_t* A; const bf16_t* Bt; int M, N, K; };
struct StaticOrder {
    int nM, nN, nwg, G, c;
    __host__ __device__ void init(int M, int N, int G_, int c_) { nM = M / BM; nN = N / BM; nwg = nM * nN; G = G_; c = c_; }
    __host__ __device__ bool next(int i, Unit& u) const {
        const long L = (long)i * G + c; if (L >= nwg) return false;
        int wgid = (int)L; { const int q = nwg / NXCD, r = nwg % NXCD, xcd = wgid % NXCD, off = wgid / NXCD; wgid = (xcd < r ? xcd * (q + 1) : r * (q + 1) + (xcd - r) * q) + off; }
        const int nig = WGM * nN, gid = wgid / nig, fm = gid * WGM, gsz = (nM - fm) < WGM ? (nM - fm) : WGM;
        u.pm = fm + ((wgid % nig) % gsz); u.pn = (wgid % nig) / gsz; return true;
    }
    __device__ __forceinline__ void a_ready(const Unit&) const {}
    __device__ __forceinline__ void done(const Unit&) const {}
};
template <class Epi, class Sched>
__device__ __forceinline__ void gemm_phase(LAS unsigned char* lds, const Gemm g, const Sched& S, const Epi& E) {
    const int tid = threadIdx.x, wid = __builtin_amdgcn_readfirstlane(tid >> 6), lane = tid & 63, wr = wid >> 2, wc = wid & 3, fr = lane & 15, fq = lane >> 4;
    const int K = g.K, nt = K / BK;
    unsigned voffA[2], voffB[2];
#pragma unroll
    for (int i = 0; i < 2; ++i) { int R, C; stage_rc(tid * 16 + i * 8192, R, C); const int Rb = Epi::PERM ? ((R & ~31) + perm32(R & 31)) : R;
        voffA[i] = (unsigned)(R * K + C) * 2u; voffB[i] = (unsigned)(Rb * K + C) * 2u; }
    const size_t kstep = (size_t)(BK * 2);
    const size_t hstep = (size_t)HALF * K * 2;
    const size_t tstep = 2 * hstep;
    const unsigned ldsw = (unsigned)wid * 1024u;
    const int aoff = lds_byte(wr * 64 + fr, fq * 8), boff = lds_byte(wc * 32 + fr, fq * 8);
#define PG8_SA(b, h) (((b) * 2 + (h)) * HTB)
#define PG8_SB(b, h) ((4 + (b) * 2 + (h)) * HTB)
#define PG8_STAGE(bufoff, gbase, voff) do { _Pragma("unroll") for (int _i = 0; _i < 2; ++_i) \
        __builtin_amdgcn_global_load_lds((const unsigned*)((const char*)(gbase) + (voff)[_i]), (LAS unsigned*)(lds + (bufoff) + ldsw + _i * 8192), 16, 0, 0); } while (0)
#define PG8_LDA(dst, b, h) do { _Pragma("unroll") for (int m = 0; m < 4; ++m) _Pragma("unroll") for (int k = 0; k < 2; ++k) dst[m][k] = *(const LAS bf16x8*)(lds + PG8_SA(b, h) + aoff + m * 2048 + k * 1024); } while (0)
#define PG8_LDB(dst, b, h) do { _Pragma("unroll") for (int n = 0; n < 2; ++n) _Pragma("unroll") for (int k = 0; k < 2; ++k) dst[n][k] = *(const LAS bf16x8*)(lds + PG8_SB(b, h) + boff + n * 2048 + k * 1024); } while (0)
#define PG8_MMA(ai, bj, At, Bt) do { __builtin_amdgcn_s_setprio(1); _Pragma("unroll") for (int m = 0; m < 4; ++m) _Pragma("unroll") for (int n = 0; n < 2; ++n) _Pragma("unroll") for (int k = 0; k < 2; ++k) \
        acc[ai][bj][m][n] = __builtin_amdgcn_mfma_f32_16x16x32_bf16(Bt[n][k], At[m][k], acc[ai][bj][m][n], 0, 0, 0); __builtin_amdgcn_s_setprio(0); } while (0)
#define PG8_WAIT_V(n) asm volatile("s_waitcnt vmcnt(" #n ")" ::: "memory")
#define PG8_WAIT_L(n) asm volatile("s_waitcnt lgkmcnt(" #n ")" ::: "memory")
#define PG8_BAR __builtin_amdgcn_s_barrier()
#define PG8_SCHED __builtin_amdgcn_sched_barrier(0)
    Unit cur, nxt; int ui = 0;
    if (!S.next(0, cur)) return;
    f32x4 acc[2][2][4][2];
#pragma unroll
    for (int a = 0; a < 2; ++a)
#pragma unroll
        for (int b = 0; b < 2; ++b)
#pragma unroll
            for (int m = 0; m < 4; ++m)
#pragma unroll
                for (int n = 0; n < 2; ++n) acc[a][b][m][n] = (f32x4){0.f, 0.f, 0.f, 0.f};
    bf16x8 At[4][2], B0[2][2], B1[2][2];
    const char* cA = (const char*)g.A + (size_t)cur.pm * tstep; const char* cB = (const char*)g.Bt + (size_t)cur.pn * tstep;
    S.a_ready(cur);
    PG8_STAGE(PG8_SB(0, 0), cB, voffB); PG8_STAGE(PG8_SA(0, 0), cA, voffA); PG8_STAGE(PG8_SB(0, 1), cB + hstep, voffB); PG8_STAGE(PG8_SA(0, 1), cA + hstep, voffA);
    if (wr == 1) PG8_BAR;
    PG8_WAIT_V(4); PG8_BAR;
    PG8_STAGE(PG8_SB(1, 0), cB + kstep, voffB); PG8_STAGE(PG8_SA(1, 0), cA + kstep, voffA); PG8_STAGE(PG8_SB(1, 1), cB + hstep + kstep, voffB);
    PG8_WAIT_V(6); PG8_BAR;
    for (;;) {
        const bool has_next = S.next(ui + 1, nxt);
        const char* nA = has_next ? (const char*)g.A + (size_t)nxt.pm * tstep : cA; const char* nB = has_next ? (const char*)g.Bt + (size_t)nxt.pn * tstep : cB;
        for (int t = 0; t < nt; t += 2) {
            const bool last = (t == nt - 2);
            const char* a1 = cA + (size_t)(t + 1) * kstep;
            const char* a2 = last ? nA : cA + (size_t)(t + 2) * kstep; const char* b2 = last ? nB : cB + (size_t)(t + 2) * kstep;
            const char* a3 = a2 + kstep; const char* b3 = b2 + kstep;
            if (last && has_next) S.a_ready(nxt);
            PG8_LDB(B0, 0, 0); PG8_SCHED; PG8_LDA(At, 0, 0); PG8_STAGE(PG8_SA(1, 1), a1 + hstep, voffA);
            PG8_WAIT_L(8); PG8_BAR; PG8_WAIT_L(0); PG8_MMA(0, 0, At, B0); PG8_BAR; PG8_SCHED;
            PG8_LDB(B1, 0, 1); PG8_STAGE(PG8_SB(0, 0), b2, voffB);
            PG8_BAR; PG8_WAIT_L(0); PG8_MMA(0, 1, At, B1); PG8_BAR;
            PG8_LDA(At, 0, 1); PG8_STAGE(PG8_SA(0, 0), a2, voffA);
            PG8_BAR; PG8_WAIT_L(0); PG8_MMA(1, 0, At, B0); PG8_BAR; PG8_SCHED;
            PG8_STAGE(PG8_SB(0, 1), b2 + hstep, voffB);
            PG8_WAIT_V(6); PG8_BAR; PG8_MMA(1, 1, At, B1); PG8_BAR;
            PG8_LDB(B0, 1, 0); PG8_SCHED; PG8_LDA(At, 1, 0); PG8_STAGE(PG8_SA(0, 1), a2 + hstep, voffA);
            PG8_WAIT_L(8); PG8_BAR; PG8_WAIT_L(0); PG8_MMA(0, 0, At, B0); PG8_BAR; PG8_SCHED;
            PG8_LDB(B1, 1, 1); PG8_STAGE(PG8_SB(1, 0), b3, voffB);
            PG8_BAR; PG8_WAIT_L(0); PG8_MMA(0, 1, At, B1); PG8_BAR;
            PG8_LDA(At, 1, 1); PG8_STAGE(PG8_SA(1, 0), a3, voffA);
            PG8_BAR; PG8_WAIT_L(0); PG8_MMA(1, 0, At, B0); PG8_BAR; PG8_SCHED;
            PG8_STAGE(PG8_SB(1, 1), b3 + hstep, voffB);
            PG8_WAIT_V(6); PG8_BAR; PG8_MMA(1, 1, At, B1); PG8_BAR;
        }
        E(acc, cur, wr, wc, fr, fq); S.done(cur);
        if (!has_next) break;
#pragma unroll
        for (int a = 0; a < 2; ++a)
#pragma unroll
            for (int b = 0; b < 2; ++b)
#pragma unroll
                for (int m = 0; m < 4; ++m)
#pragma unroll
                    for (int n = 0; n < 2; ++n) acc[a][b][m][n] = (f32x4){0.f, 0.f, 0.f, 0.f};
        cur = nxt; cA = nA; cB = nB; ++ui;
    }
    PG8_WAIT_V(0);
    if (wr == 0) PG8_BAR;
    PG8_BAR;
#undef PG8_SA
#undef PG8_SB
#undef PG8_STAGE
#undef PG8_LDA
#undef PG8_LDB
#undef PG8_MMA
#undef PG8_WAIT_V
#undef PG8_WAIT_L
#undef PG8_BAR
#undef PG8_SCHED
}

template <int ACT  > struct EpiBf16 {
    static constexpr bool PERM = true;
    bf16_t* O; int ldc;
    __device__ __forceinline__ void operator()(const f32x4 (&acc)[2][2][4][2], const Unit& u, int wr, int wc, int fr, int fq) const {
        const int row0 = u.pm * BM + wr * 64 + fr, col0 = u.pn * BM + wc * 32 + 8 * fq;
#pragma unroll
        for (int ai = 0; ai < 2; ++ai)
#pragma unroll
            for (int m = 0; m < 4; ++m) { bf16_t* rowp = O + (size_t)(row0 + ai * HALF + m * 16) * ldc + col0;
#pragma unroll
                for (int bj = 0; bj < 2; ++bj) { f32x4 v0 = acc[ai][bj][m][0], v1 = acc[ai][bj][m][1];
                    if (ACT == 1) { for (int i = 0; i < 4; ++i) { v0[i] = siluf_(v0[i]); v1[i] = siluf_(v1[i]); } }
                    uint4 o; o.x = pack2(v0[0], v0[1]); o.y = pack2(v0[2], v0[3]); o.z = pack2(v1[0], v1[1]); o.w = pack2(v1[2], v1[3]);
                    *(uint4*)(rowp + bj * HALF) = o; } }
    }
};
struct EpiF32 {
    static constexpr bool PERM = false;
    float* C; int ldc;
    __device__ __forceinline__ void operator()(const f32x4 (&acc)[2][2][4][2], const Unit& u, int wr, int wc, int fr, int fq) const {
        const int row0 = u.pm * BM + wr * 64 + fr, col0 = u.pn * BM + wc * 32 + 4 * fq;
#pragma unroll
        for (int ai = 0; ai < 2; ++ai)
#pragma unroll
            for (int m = 0; m < 4; ++m) { float* rowp = C + (size_t)(row0 + ai * HALF + m * 16) * ldc + col0;
#pragma unroll
                for (int bj = 0; bj < 2; ++bj)
#pragma unroll
                    for (int n = 0; n < 2; ++n) *(f32x4*)(rowp + bj * HALF + n * 16) = acc[ai][bj][m][n]; }
    }
};
struct EpiResid {
    static constexpr bool PERM = false;
    const float* Xi; float* Xo; bf16_t* Ob;
    __device__ __forceinline__ void operator()(const f32x4 (&acc)[2][2][4][2], const Unit& u, int wr, int wc, int fr, int fq) const {
        const int row0 = u.pm * BM + wr * 64 + fr, col0 = u.pn * BM + wc * 32 + 4 * fq;
#pragma unroll
        for (int ai = 0; ai < 2; ++ai)
#pragma unroll
            for (int m = 0; m < 4; ++m) { const size_t ro = (size_t)(row0 + ai * HALF + m * 16) * 1024 + col0;
#pragma unroll
                for (int bj = 0; bj < 2; ++bj)
#pragma unroll
                    for (int n = 0; n < 2; ++n) { const size_t o = ro + bj * HALF + n * 16;
                        const f32x4 xi = *(const f32x4*)(Xi + o); const f32x4 v = xi + acc[ai][bj][m][n];
                        *(f32x4*)(Xo + o) = v; uint2 pk; pk.x = pack2(v[0], v[1]); pk.y = pack2(v[2], v[3]); *(uint2*)(Ob + o) = pk; } }
    }
};
struct EpiGate {
    static constexpr bool PERM = false;
    float* X; const float* E;
    __device__ __forceinline__ void operator()(const f32x4 (&acc)[2][2][4][2], const Unit& u, int wr, int wc, int fr, int fq) const {
        const int row0 = u.pm * BM + wr * 64 + fr, col0 = u.pn * BM + wc * 32 + 4 * fq;
#pragma unroll
        for (int ai = 0; ai < 2; ++ai)
#pragma unroll
            for (int m = 0; m < 4; ++m) { const size_t ro = (size_t)(row0 + ai * HALF + m * 16) * 1024 + col0;
#pragma unroll
                for (int bj = 0; bj < 2; ++bj)
#pragma unroll
                    for (int n = 0; n < 2; ++n) { const size_t o = ro + bj * HALF + n * 16;
                        const f32x4 xi = *(const f32x4*)(X + o); const f32x4 e = *(const f32x4*)(E + o); f32x4 v;
                        for (int i = 0; i < 4; ++i) v[i] = xi[i] + e[i] * sigmoidf_(acc[ai][bj][m][n][i]);
                        *(f32x4*)(X + o) = v; } }
    }
};
}

struct Args { const float* in[28]; float* out; unsigned char* ws; int ph_lo, ph_hi; };

struct Frame {
    int tid, lane, wave, G, bid, gw, nw;
    unsigned char* lds;
    unsigned* ctl;
    const float* in[28]; float* out; unsigned char* ws;
    const LAS unsigned char* lut;
    const LAS float* tbl;
};
DI int t5b(const Frame& F, int n) { return n < 16 ? n : (n >= 113 ? 31 : (int)F.lut[n]); }

template <class Map>
DI void transpose_w(const Frame& F, const float* src, int K, int Nsrc, bf16_t* dst, int Npad, Map map) {
    float* tile = (float*)F.lds;
    const int ntn = Npad / 64, ntk = K / 64, ntiles = ntn * ntk;
    for (int tix = F.bid; tix < ntiles; tix += F.G) {
        const int nt = tix / ntk, kt = tix % ntk;
        for (int e = F.tid; e < 4096; e += 512) { const int kk = e >> 6, nn = e & 63; const int col = map(nt * 64 + nn);
            tile[kk * 65 + nn] = col >= 0 ? src[(size_t)(kt * 64 + kk) * Nsrc + col] : 0.f; }
        __syncthreads();
        for (int e = F.tid; e < 4096; e += 512) { const int nn = e >> 6, kk = e & 63;
            dst[(size_t)(nt * 64 + nn) * K + kt * 64 + kk] = f2bf(tile[kk * 65 + nn]); }
        __syncthreads();
    }
}
template <int OUTF>
DI void rmsnorm_rows(const Frame& F, const float* X, const float* g, bf16_t* Ob, float* Of) {
    for (int row = F.gw; row < MT; row += F.nw) {
        const float* xr = X + (size_t)row * 1024;
        f32x4 v[4]; float ss = 0.f;
#pragma unroll
        for (int i = 0; i < 4; ++i) { v[i] = *(const f32x4*)(xr + i * 256 + F.lane * 4); ss += v[i][0] * v[i][0] + v[i][1] * v[i][1] + v[i][2] * v[i][2] + v[i][3] * v[i][3]; }
        ss = wave_sum(ss);
        const float rs = rsqrtf(ss * (1.0f / 1024.0f) + 1e-6f);
#pragma unroll
        for (int i = 0; i < 4; ++i) { const f32x4 gg = *(const f32x4*)(g + i * 256 + F.lane * 4); f32x4 y;
            for (int j = 0; j < 4; ++j) y[j] = v[i][j] * rs * gg[j];
            if (OUTF) *(f32x4*)(Of + (size_t)row * 1024 + i * 256 + F.lane * 4) = y;
            else { uint2 pk; pk.x = pack2(y[0], y[1]); pk.y = pack2(y[2], y[3]); *(uint2*)(Ob + (size_t)row * 1024 + i * 256 + F.lane * 4) = pk; } }
    }
}
DI void p0_prologue(const Frame& F) {
    unsigned char* ws = F.ws;
    transpose_w(F, F.in[7], 1024, 3292, (bf16_t*)(ws + WS_WIN0), LD0, [](int n) { return map0(n); });
    transpose_w(F, F.in[8], 1024, 1024, (bf16_t*)(ws + WS_WOUT0), 1024, [](int n) { return mapid(n); });
    transpose_w(F, F.in[5], 1024, 1024, (bf16_t*)(ws + WS_WG0), 1024, [](int n) { return mapid(n); });
    transpose_w(F, F.in[5] + (size_t)1024 * 1024, 1024, 1024, (bf16_t*)(ws + WS_WG1), 1024, [](int n) { return mapid(n); });
    transpose_w(F, F.in[4], 256, 1024, (bf16_t*)(ws + WS_WP0), 1024, [](int n) { return mapid(n); });
    transpose_w(F, F.in[4] + (size_t)256 * 1024, 256, 1024, (bf16_t*)(ws + WS_WP1), 1024, [](int n) { return mapid(n); });
    transpose_w(F, F.in[15], 1024, 3592, (bf16_t*)(ws + WS_WIN1), LD1, [](int n) { return map1(n); });
    transpose_w(F, F.in[16], 1024, 1024, (bf16_t*)(ws + WS_WOUT1), 1024, [](int n) { return mapid(n); });
    transpose_w(F, F.in[10], 2048, 256, (bf16_t*)(ws + WS_WC1K), 256, [](int n) { return mapid(n); });
    transpose_w(F, F.in[13], 2048, 256, (bf16_t*)(ws + WS_WC1V), 256, [](int n) { return mapid(n); });
    rmsnorm_rows<0>(F, F.in[0], F.in[2], (bf16_t*)(ws + WS_BFA), nullptr);
    { const float* p = F.in[1]; bf16_t* pb = (bf16_t*)(ws + WS_PBF); const size_t n8 = (size_t)2 * MT * 256 / 8;
      for (size_t i = (size_t)F.bid * 512 + F.tid; i < n8; i += (size_t)F.G * 512) {
          const f32x4 a = *(const f32x4*)(p + i * 8), b = *(const f32x4*)(p + i * 8 + 4);
          uint4 o; o.x = pack2(a[0], a[1]); o.y = pack2(a[2], a[3]); o.z = pack2(b[0], b[1]); o.w = pack2(b[2], b[3]); *(uint4*)(pb + i * 8) = o; } }
}

DI void p2a_build_blocks(const Frame& F) {
    const bf16_t* U = (const bf16_t*)(F.ws + WS_U);
    bf16_t* AK = (bf16_t*)(F.ws + WS_AK); bf16_t* AV = (bf16_t*)(F.ws + WS_AV);
    const float* posk = F.in[9]; const float* posv = F.in[12];
    const size_t nitem = (size_t)2 * 4096 * 32 * 8;
    for (size_t it = (size_t)F.bid * 512 + F.tid; it < nitem; it += (size_t)F.G * 512) {
        const int c8 = (int)(it & 7), l = (int)((it >> 3) & 31), r = (int)((it >> 8) & 4095), which = (int)(it >> 20);
        bf16_t* dst = (which ? AV : AK) + (size_t)r * 2048 + l * 64 + c8 * 8;
        uint4 o = make_uint4(0u, 0u, 0u, 0u);
        if (r < 4080) {
            const int b = r / 510, rem = r % 510, i = rem >> 1, g = rem & 1;
            const bf16_t* sp = U + ((size_t)b * SEQ + 16 * i + l) * LD0 + (which ? C_VC : C_KC) + g * 64 + c8 * 8;
            const float* pp = (which ? posv : posk) + l * 64 + c8 * 8;
            const uint4 v = *(const uint4*)sp; float f[8]; unpack8(v, f);
            o.x = pack2(f[0] + pp[0], f[1] + pp[1]); o.y = pack2(f[2] + pp[2], f[3] + pp[3]); o.z = pack2(f[4] + pp[4], f[5] + pp[5]); o.w = pack2(f[6] + pp[6], f[7] + pp[7]);
        }
        *(uint4*)dst = o;
    }
}
DI void p2c_compress_out(const Frame& F) {
    const bf16_t* HK = (const bf16_t*)(F.ws + WS_HK); const bf16_t* HV = (const bf16_t*)(F.ws + WS_HV);
    float* KC = (float*)(F.ws + WS_KCMP); float* VC = (float*)(F.ws + WS_VCMP);
    const float* w2k = F.in[11]; const float* w2v = F.in[14];
    for (int it = F.gw; it < 2 * 16 * 256; it += F.nw) {
        const int i = it & 255, bg = (it >> 8) & 15, which = it >> 12;
        float acc = 0.f;
        if (i < NCMP) {
            const int b = bg >> 1, g = bg & 1; const int r = (b * 255 + i) * 2 + g;
            const bf16_t* hr = (which ? HV : HK) + (size_t)r * 256; const float* w2 = which ? w2v : w2k;
            for (int j = 0; j < 256; j += 8) { const uint4 hv = *(const uint4*)(hr + j); float hf[8]; unpack8(hv, hf);
#pragma unroll
                for (int q = 0; q < 8; ++q) acc += hf[q] * w2[(size_t)(j + q) * 64 + F.lane]; }
        }
        (which ? VC : KC)[((size_t)bg * 256 + i) * 64 + F.lane] = acc;
    }
}

template <int NH>
DI void dotn_bf(const bf16_t* kp, const float* qs, float (&acc)[NH]) {
#pragma unroll
    for (int h = 0; h < NH; ++h) acc[h] = 0.f;
#pragma unroll 2
    for (int c = 0; c < 8; ++c) { const uint4 v = *(const uint4*)(kp + c * 8); float kf[8]; unpack8(v, kf);
#pragma unroll
        for (int h = 0; h < NH; ++h) { const f32x4 q0 = *(const f32x4*)(qs + h * 64 + c * 8), q1 = *(const f32x4*)(qs + h * 64 + c * 8 + 4);
            acc[h] += q0[0] * kf[0] + q0[1] * kf[1] + q0[2] * kf[2] + q0[3] * kf[3] + q1[0] * kf[4] + q1[1] * kf[5] + q1[2] * kf[6] + q1[3] * kf[7]; } }
}
DI void dot4_bf(const bf16_t* kp, const float* qs, float (&acc)[4]) { dotn_bf<4>(kp, qs, acc); }
DI void dot4_f32(const float* kp, const float* qs, float (&acc)[4]) {
    acc[0] = acc[1] = acc[2] = acc[3] = 0.f;
#pragma unroll 4
    for (int c = 0; c < 16; ++c) { const f32x4 kv = *(const f32x4*)(kp + c * 4);
#pragma unroll
        for (int h = 0; h < 4; ++h) { const f32x4 q0 = *(const f32x4*)(qs + h * 64 + c * 4);
            acc[h] += q0[0] * kv[0] + q0[1] * kv[1] + q0[2] * kv[2] + q0[3] * kv[3]; } }
}

template <int NH, int HS>
DI void softmax_lds(float* ps, int nr, int lane, float (&inv)[NH]) {
#pragma unroll
    for (int h = 0; h < NH; ++h) {
        float mx = NEG_INF;
#pragma unroll 1
        for (int r = 0; r < nr; ++r) mx = fmaxf(mx, ps[h * HS + r * 64 + lane]);
        mx = wave_max(mx);
        float sm = 0.f;
#pragma unroll 1
        for (int r = 0; r < nr; ++r) { const float sv = ps[h * HS + r * 64 + lane]; const float e = sv > NEG_INF ? expf(sv - mx) : 0.f; ps[h * HS + r * 64 + lane] = e; sm += e; }
        sm = wave_sum(sm);
        inv[h] = sm > 0.f ? 1.0f / sm : 0.f;
    }
}

DI void nsa_task(const Frame& F, int b, int g, int t, float* wl) {
    int lane = F.lane; asm volatile("" : "+v"(lane)); asm volatile("" : "+v"(wl));
    const bf16_t* U = (const bf16_t*)(F.ws + WS_U);
    const float* KC = (const float*)(F.ws + WS_KCMP) + (size_t)(b * 2 + g) * 256 * 64;
    const float* VC = (const float*)(F.ws + WS_VCMP) + (size_t)(b * 2 + g) * 256 * 64;
    bf16_t* Y = (bf16_t*)(F.ws + WS_BFB);
    const size_t row = (size_t)b * SEQ + t;
    const bf16_t* Ur = U + row * LD0;
    float* qs = wl; float* ps = wl + 256;
    const LAS float* tb = F.tbl + (g * 4) * 32;
    __builtin_amdgcn_wave_barrier();
#pragma unroll
    for (int h = 0; h < 4; ++h) qs[h * 64 + lane] = bf2f(Ur[C_AQ + (g * 4 + h) * 64 + lane]);
    __builtin_amdgcn_wave_barrier();
    float oc[4] = {0.f, 0.f, 0.f, 0.f}, os[4] = {0.f, 0.f, 0.f, 0.f}, ow[4] = {0.f, 0.f, 0.f, 0.f};
    float inv[4];

    const int nv = t >= 31 ? ((t - 31) >> 4) + 1 : 0;
#pragma unroll 1
    for (int r = 0; r < 4; ++r) {
        const int i = r * 64 + lane; const bool valid = i < nv;
        float sc[4] = {NEG_INF, NEG_INF, NEG_INF, NEG_INF};
        if (r * 64 < nv) {
            float acc[4]; dot4_f32(KC + (size_t)(valid ? i : 0) * 64, qs, acc);
            if (valid) { const int bk = t5b(F, t - (16 * i + 31));
#pragma unroll
                for (int h = 0; h < 4; ++h) sc[h] = acc[h] * 0.125f + tb[h * 32 + bk]; }
        }
#pragma unroll
        for (int h = 0; h < 4; ++h) ps[h * 512 + i] = sc[h];
    }
    __builtin_amdgcn_wave_barrier();
    softmax_lds<4, 512>(ps, 4, lane, inv);
#pragma unroll 1
    for (int r = 0; r < 4; ++r) {
#pragma unroll
        for (int h = 0; h < 4; ++h) ps[h * 512 + r * 64 + lane] *= inv[h];
    }
    __builtin_amdgcn_wave_barrier();
#pragma unroll 8
    for (int i = 0; i < nv; ++i) { const float v = VC[(size_t)i * 64 + lane];
#pragma unroll
        for (int h = 0; h < 4; ++h) oc[h] += ps[h * 512 + i] * v; }
#ifndef NSA_STAGE
#define NSA_STAGE 4
#endif
    if (NSA_STAGE < 2) return;
    const int cur = t >> 6;
    unsigned long long selmask = 0ull; const int npick = (cur + 1) < 8 ? (cur + 1) : 8;
    {
        float imp = 0.f;
        const int i0 = 4 * lane - 1 < 0 ? 0 : 4 * lane - 1, i1 = 4 * lane + 3 > 254 ? 254 : 4 * lane + 3;
#pragma unroll
        for (int h = 0; h < 4; ++h) for (int i = i0; i <= i1; ++i) imp += ps[h * 512 + i];
        const bool adm = lane <= cur; const bool forced = (lane == 0) || (lane == cur) || (lane == cur - 1);
        float score = adm ? imp + (forced ? 1.0e4f : 0.f) : NEG_INF;
#pragma unroll 1
        for (int k = 0; k < npick; ++k) {
            const float mx = wave_max(score);
            const unsigned long long cand = __ballot(score == mx);
            const int j = cand ? __builtin_ctzll(cand) : 0;
            selmask |= 1ull << j;
            if (lane == j) score = NEG_INF;
        }
    }
    __builtin_amdgcn_wave_barrier();
    {
        unsigned long long m = selmask;
#pragma unroll 1
        for (int k = 0; k < npick; ++k) {
            const int j = __builtin_ctzll(m); m &= m - 1;
            const int pos = j * 64 + lane;
            float sc[4] = {NEG_INF, NEG_INF, NEG_INF, NEG_INF};
            float acc[4]; dot4_bf(U + ((size_t)b * SEQ + pos) * LD0 + C_KS + g * 64, qs, acc);
            if (pos <= t) { const int bk = t5b(F, t - pos);
#pragma unroll
                for (int h = 0; h < 4; ++h) sc[h] = acc[h] * 0.125f + tb[h * 32 + bk]; }
#pragma unroll
            for (int h = 0; h < 4; ++h) ps[h * 512 + k * 64 + lane] = sc[h];
        }
        __builtin_amdgcn_wave_barrier();
        softmax_lds<4, 512>(ps, npick, lane, inv);
        __builtin_amdgcn_wave_barrier();
        m = selmask;
#pragma unroll 1
        for (int k = 0; k < npick; ++k) {
            const int j = __builtin_ctzll(m); m &= m - 1;
            const int kend = (j * 64 + 63 <= t) ? 64 : (t - j * 64 + 1);
#pragma unroll 8
            for (int kk = 0; kk < kend; ++kk) {
                const float v = bf2f(U[((size_t)b * SEQ + j * 64 + kk) * LD0 + C_VS + g * 64 + lane]);
#pragma unroll
                for (int h = 0; h < 4; ++h) os[h] += ps[h * 512 + k * 64 + kk] * v; }
        }
#pragma unroll
        for (int h = 0; h < 4; ++h) os[h] *= inv[h];
    }
    __builtin_amdgcn_wave_barrier();
    if (NSA_STAGE < 3) return;
    {
#pragma unroll 1
        for (int r = 0; r < 8; ++r) {
            const int pos = t - 511 + r * 64 + lane;
            float sc[4] = {NEG_INF, NEG_INF, NEG_INF, NEG_INF};
            if (t - 511 + r * 64 + 63 >= 0) {
                float acc[4]; dot4_bf(U + ((size_t)b * SEQ + (pos < 0 ? 0 : pos)) * LD0 + C_KW + g * 64, qs, acc);
                if (pos >= 0) { const int bk = t5b(F, t - pos);
#pragma unroll
                    for (int h = 0; h < 4; ++h) sc[h] = acc[h] * 0.125f + tb[h * 32 + bk]; }
            }
#pragma unroll
            for (int h = 0; h < 4; ++h) ps[h * 512 + r * 64 + lane] = sc[h];
        }
        __builtin_amdgcn_wave_barrier();
        softmax_lds<4, 512>(ps, 8, lane, inv);
        __builtin_amdgcn_wave_barrier();
        const int pi0 = (t >= 511 ? 0 : 511 - t) & ~7;
#pragma unroll 8
        for (int pi = pi0; pi < 512; ++pi) {
            const int pos = t - 511 + pi;
            const float v = bf2f(U[((size_t)b * SEQ + (pos < 0 ? 0 : pos)) * LD0 + C_VW + g * 64 + lane]);
#pragma unroll
            for (int h = 0; h < 4; ++h) ow[h] += ps[h * 512 + pi] * v; }
#pragma unroll
        for (int h = 0; h < 4; ++h) ow[h] *= inv[h];
    }
    if (NSA_STAGE < 4) return;
    const float gsig = sigmoidf_(bf2f(Ur[C_AG + g * 12 + (lane < 12 ? lane : 0)]));
#pragma unroll
    for (int h = 0; h < 4; ++h) {
        const int hh = g * 4 + h;
        const float g0 = __shfl(gsig, h * 3 + 0), g1 = __shfl(gsig, h * 3 + 1), g2 = __shfl(gsig, h * 3 + 2);
        const float oa = g0 * oc[h] + g1 * os[h] + g2 * ow[h];
        const float z = bf2f(Ur[C_AZ + hh * 64 + lane]);
        Y[row * 1024 + hh * 64 + lane] = f2bf(oa * siluf_(z));
    }
    __builtin_amdgcn_wave_barrier();
}

DI unsigned okey(float x) { unsigned u = __float_as_uint(x); if ((u << 1) == 0u) u = 0u; return (u >> 31) ? ~u : (u | 0x80000000u); }

DI void dsa_task(const Frame& F, int b, int t, float* wl, unsigned* keys) {
    int lane = F.lane; asm volatile("" : "+v"(lane)); asm volatile("" : "+v"(wl)); asm volatile("" : "+v"(keys));
    const bf16_t* U = (const bf16_t*)(F.ws + WS_U);
    bf16_t* Y = (bf16_t*)(F.ws + WS_BFB);
    const size_t row = (size_t)b * SEQ + t;
    const bf16_t* Ur = U + row * LD0;
    float* qis = wl; float* qds = wl + 256; int* idx = (int*)(wl + 768); float* pb = (float*)keys;
    const LAS float* tb = F.tbl + 8 * 32;
    __builtin_amdgcn_wave_barrier();
#pragma unroll
    for (int h = 0; h < 4; ++h) qis[h * 64 + lane] = bf2f(Ur[C_BQI + h * 64 + lane]);
#pragma unroll
    for (int h = 0; h < 8; ++h) qds[h * 64 + lane] = bf2f(Ur[C_BQ + h * 64 + lane]);
    float wi[4];
#pragma unroll
    for (int h = 0; h < 4; ++h) wi[h] = bf2f(Ur[C_BWI + h]) * 0.0625f;
    __builtin_amdgcn_wave_barrier();
    const int nk = t + 1, nr = (nk + 63) >> 6;
    int nsel;
    if (nk <= 256) {
#pragma unroll 1
        for (int r = 0; r < nr; ++r) { const int s = r * 64 + lane; if (s < nk) idx[s] = s; }
        nsel = nk;
    } else {
#pragma unroll 1
        for (int r = 0; r < nr; ++r) {
            const int s = r * 64 + lane; unsigned key = 0u;
            float acc[4]; dot4_bf(U + ((size_t)b * SEQ + (s < nk ? s : t)) * LD0 + C_BKI, qis, acc);
            if (s < nk) { const float scv = wi[0] * fmaxf(acc[0], 0.f) + wi[1] * fmaxf(acc[1], 0.f) + wi[2] * fmaxf(acc[2], 0.f) + wi[3] * fmaxf(acc[3], 0.f); key = okey(scv); }
            keys[s] = key;
        }
        __builtin_amdgcn_wave_barrier();
        unsigned tau = 0u;
#pragma unroll 1
        for (int bit = 31; bit >= 0; --bit) {
            const unsigned trial = tau | (1u << bit); int cnt = 0;
#pragma unroll 8
            for (int r = 0; r < nr; ++r) cnt += keys[r * 64 + lane] >= trial ? 1 : 0;
            cnt = (int)wave_sum((float)cnt);
            if (cnt >= 256) tau = trial;
        }
        int cgt = 0;
#pragma unroll 1
        for (int r = 0; r < nr; ++r) cgt += keys[r * 64 + lane] > tau ? 1 : 0;
        cgt = (int)wave_sum((float)cgt);
        const int quota = 256 - cgt;
        int base = 0, taken = 0;
        const unsigned long long ltmask = (1ull << lane) - 1ull;
#pragma unroll 1
        for (int r = 0; r < nr; ++r) {
            const unsigned key = keys[r * 64 + lane];
            const bool eq = key == tau;
            const unsigned long long eqm = __ballot(eq);
            const int erank = __popcll(eqm & ltmask);
            const bool sel = (key > tau) || (eq && (taken + erank < quota));
            const unsigned long long sm = __ballot(sel);
            if (sel) idx[base + __popcll(sm & ltmask)] = r * 64 + lane;
            base += __popcll(sm); taken += __popcll(eqm);
        }
        nsel = 256;
    }
    __builtin_amdgcn_wave_barrier();
    const int nr2 = (nsel + 63) >> 6;
#pragma unroll 1
    for (int r = 0; r < nr2; ++r) {
        const int j = r * 64 + lane; const bool valid = j < nsel; const int s = valid ? idx[j] : 0;
        const bf16_t* kp = U + ((size_t)b * SEQ + s) * LD0 + C_BK;
        float a0[8]; dotn_bf<8>(kp, qds, a0);
        const int bk = t5b(F, valid ? t - s : 0);
#pragma unroll
        for (int h = 0; h < 8; ++h) pb[h * 256 + j] = valid ? a0[h] * 0.125f + tb[h * 32 + bk] : NEG_INF;
    }
    __builtin_amdgcn_wave_barrier();
    float inv[8];
    softmax_lds<8, 256>(pb, nr2, lane, inv);
    __builtin_amdgcn_wave_barrier();
    float ob[8] = {0.f, 0.f, 0.f, 0.f, 0.f, 0.f, 0.f, 0.f};
#pragma unroll 8
    for (int j = 0; j < nsel; ++j) {
        const int s = idx[j];
        const float v = bf2f(U[((size_t)b * SEQ + s) * LD0 + C_BV + lane]);
#pragma unroll
        for (int h = 0; h < 8; ++h) ob[h] += pb[h * 256 + j] * v;
    }
#pragma unroll
    for (int h = 0; h < 8; ++h) {
        const float z = bf2f(Ur[C_BZ + h * 64 + lane]);
        Y[row * 1024 + 512 + h * 64 + lane] = f2bf(ob[h] * inv[h] * siluf_(z));
    }
    __builtin_amdgcn_wave_barrier();
}

DI void p3_attention(const Frame& F) {
    unsigned char* base = F.lds;
    constexpr int DSA_W = 4;
    float* wl_nsa; float* wl_dsa = nullptr; unsigned* keys = nullptr;
    if (F.wave < DSA_W) { unsigned char* R = base + F.wave * 20480; keys = (unsigned*)R; wl_dsa = (float*)(R + 16384); wl_nsa = (float*)R; }
    else wl_nsa = (float*)(base + DSA_W * 20480 + (F.wave - DSA_W) * 9216);
    unsigned* qn = F.ctl + CW_QNSA; unsigned* qd = F.ctl + CW_QDSA;
    const int NDSA = NB * SEQ, NNSA = NB * 2 * SEQ;
#ifndef ATT_MASK
#define ATT_MASK 3
#endif
    if ((ATT_MASK & 1) && F.wave < DSA_W) {
        for (;;) {
            unsigned k = 0; if (F.lane == 0) k = __hip_atomic_fetch_add(qd, 1u, __ATOMIC_RELAXED, __HIP_MEMORY_SCOPE_AGENT);
            k = __builtin_amdgcn_readfirstlane(k);
            if (k >= (unsigned)NDSA) break;
            const int t = SEQ - 1 - (int)(k >> 3), b = (int)(k & 7);
            dsa_task(F, b, t, wl_dsa, keys);
        }
    }
    if (ATT_MASK & 2) for (;;) {
        unsigned k = 0; if (F.lane == 0) k = __hip_atomic_fetch_add(qn, 1u, __ATOMIC_RELAXED, __HIP_MEMORY_SCOPE_AGENT);
        k = __builtin_amdgcn_readfirstlane(k);
        if (k >= (unsigned)NNSA) break;
        const int t = SEQ - 1 - (int)(k >> 4), bg = (int)(k & 15);
        nsa_task(F, bg >> 1, bg & 1, t, wl_nsa);
    }
}

DI f32x4 mma16(const bf16_t* A, int lda, const bf16_t* Bt, int ldb, int K, int lane) {
    const int fr = lane & 15, fq = lane >> 4;
    f32x4 acc = {0.f, 0.f, 0.f, 0.f};
    for (int k = 0; k < K; k += 32) {
        const bf16x8 a = *(const bf16x8*)(A + fr * lda + k + fq * 8);
        const bf16x8 b = *(const bf16x8*)(Bt + fr * ldb + k + fq * 8);
        acc = __builtin_amdgcn_mfma_f32_16x16x32_bf16(a, b, acc, 0, 0, 0);
    }
    return acc;
}
DI void conv8(const bf16_t* U1, int b, int t, int col, const float* cw  , int nch, const float* cb, float (&y)[8]) {
#pragma unroll
    for (int i = 0; i < 8; ++i) y[i] = cb[i];
#pragma unroll
    for (int j = 0; j < 4; ++j) { const int tt = t - 3 + j;
        if (tt >= 0) { const uint4 v = *(const uint4*)(U1 + ((size_t)b * SEQ + tt) * LD1 + col); float f[8]; unpack8(v, f);
#pragma unroll
            for (int i = 0; i < 8; ++i) y[i] += cw[(size_t)j * nch + i] * f[i]; } }
}
DI void mlstm_gates(const Frame& F, const bf16_t* U1, int b, int h, int c, float* li, float* bc) {
    if (F.wave == 0) {
        const size_t row = (size_t)b * SEQ + c * 64 + F.lane;
        const float ip = bf2f(U1[row * LD1 + C_DI + h]) + F.in[26][h];
        const float fp = bf2f(U1[row * LD1 + C_DF + h]) + F.in[27][h];
        const float lf = fminf(fp, 0.f) - log1pf(expf(-fabsf(fp)));
        float cs = lf;
        for (int o = 1; o < 64; o <<= 1) { const float n = __shfl_up(cs, o); if (F.lane >= o) cs += n; }
        li[F.lane] = ip; bc[F.lane] = cs;
    }
    __syncthreads();
}
constexpr int ML_LI = 0, ML_BC = 256, ML_WK = 512, ML_MT = 768, ML_DQ = 1024, ML_RS = 1280, ML_NIN = 1536, ML_Q = 2048, ML_K = ML_Q + 64 * 136 * 2, ML_VT = ML_K + 64 * 136 * 2,
              ML_CT = ML_VT + 128 * 72 * 2, ML_W = ML_CT + 128 * 136 * 2, ML_KT = ML_W + 64 * 72 * 2, ML_END = ML_KT + 128 * 72 * 2;
static_assert(ML_END + LDS_WORK_OFF <= LDS_BYTES, "mlstm lds");

DI void p8a_mlstm_local(const Frame& F) {
    const bf16_t* U1 = (const bf16_t*)(F.ws + WS_U);
    bf16_t* ST = (bf16_t*)(F.ws + WS_BFB);
    float* zloc = (float*)(F.ws + WS_ZLOC); float* scal = (float*)(F.ws + WS_SCAL);
    unsigned char* L = F.lds;
    float* li = (float*)(L + ML_LI); float* bc = (float*)(L + ML_BC); float* wk = (float*)(L + ML_WK);
    bf16_t* kT = (bf16_t*)(L + ML_KT); bf16_t* vT = (bf16_t*)(L + ML_VT);
    const float* cw = F.in[24]; const float* cb = F.in[25];
    for (int unit = F.bid; unit < 2048; unit += F.G) {
        const int c = unit & 63, h = (unit >> 6) & 3, b = unit >> 8;
        mlstm_gates(F, U1, b, h, c, li, bc);
        if (F.wave == 0) {
            const float bl = bc[63]; const float dec = bl - bc[F.lane] + li[F.lane];
            const float dmx = wave_max(dec);
            wk[F.lane] = expf(dec - dmx);
            if (F.lane == 0) { scal[unit] = bl; scal[2048 + unit] = dmx; }
        }
        __syncthreads();
        for (int it = F.tid; it < 1024; it += 512) {
            const int s = it >> 4, d0 = (it & 15) * 8; const int t = c * 64 + s;
            float y[8]; conv8(U1, b, t, C_DK + h * 128 + d0, cw + 512 + h * 128 + d0, 1024, cb + 512 + h * 128 + d0, y);
            const float w = wk[s] * 0.08838834764831845f;
#pragma unroll
            for (int i = 0; i < 8; ++i) kT[(d0 + i) * 72 + s] = f2bf(siluf_(y[i]) * w);
            const uint4 vv = *(const uint4*)(U1 + ((size_t)b * SEQ + t) * LD1 + C_DV + h * 128 + d0); float vf[8]; unpack8(vv, vf);
#pragma unroll
            for (int i = 0; i < 8; ++i) vT[(d0 + i) * 72 + s] = f2bf(vf[i]);
        }
        __syncthreads();
        for (int tix = F.wave * 8; tix < F.wave * 8 + 8; ++tix) {
            const int et = tix >> 3, dt = tix & 7;
            const f32x4 a = mma16(vT + et * 16 * 72, 72, kT + dt * 16 * 72, 72, 64, F.lane);
            const int fr = F.lane & 15, fq = F.lane >> 4;
#pragma unroll
            for (int r = 0; r < 4; ++r) ST[(size_t)unit * 16384 + (size_t)(et * 16 + 4 * fq + r) * 128 + dt * 16 + fr] = f2bf(a[r]);
        }
        if (F.tid < 128) { float z = 0.f; for (int s = 0; s < 64; ++s) z += bf2f(kT[F.tid * 72 + s]); zloc[(size_t)unit * 128 + F.tid] = z; }
        __syncthreads();
    }
}

DI void p8a_lru_local(const Frame& F) {
    const bf16_t* U1 = (const bf16_t*)(F.ws + WS_U);
    bf16_t* LA = (bf16_t*)(F.ws + WS_LRUA); bf16_t* LH = (bf16_t*)(F.ws + WS_LRUH);
    float* Aend = (float*)(F.ws + WS_AEND); float* Hend = (float*)(F.ws + WS_HEND);
    float* xs = (float*)(F.lds + ML_END) + F.wave * 64;
    const int lane = F.lane;
    for (int unit = F.gw; unit < 4096; unit += F.nw) {
        const int g = unit & 7, c = (unit >> 3) & 63, b = unit >> 9;
        const int ch = g * 64 + lane;
        float wa[64], wx[64];
#pragma unroll
        for (int i = 0; i < 64; ++i) { wa[i] = F.in[19][(size_t)(g * 64 + i) * 64 + lane]; wx[i] = F.in[21][(size_t)(g * 64 + i) * 64 + lane]; }
        const float cw0 = F.in[17][ch], cw1 = F.in[17][512 + ch], cw2 = F.in[17][1024 + ch], cw3 = F.in[17][1536 + ch], cb = F.in[18][ch];
        const float ba = F.in[20][ch], bx = F.in[22][ch];
        const float sp = log1pf(expf(-F.in[23][ch]));
        const int t0 = c * 64;
        float x0 = t0 >= 3 ? bf2f(U1[((size_t)b * SEQ + t0 - 3) * LD1 + C_CX + ch]) : 0.f;
        float x1 = t0 >= 2 ? bf2f(U1[((size_t)b * SEQ + t0 - 2) * LD1 + C_CX + ch]) : 0.f;
        float x2 = t0 >= 1 ? bf2f(U1[((size_t)b * SEQ + t0 - 1) * LD1 + C_CX + ch]) : 0.f;
        float Ac = 1.f, hl = 0.f;
        for (int s = 0; s < 64; ++s) {
            const size_t row = (size_t)b * SEQ + t0 + s;
            const float x3 = bf2f(U1[row * LD1 + C_CX + ch]);
            const float xc = cw0 * x0 + cw1 * x1 + cw2 * x2 + cw3 * x3 + cb;
            x0 = x1; x1 = x2; x2 = x3;
            __builtin_amdgcn_wave_barrier();
            xs[lane] = xc;
            __builtin_amdgcn_wave_barrier();
            float pr = ba, px = bx;
#pragma unroll
            for (int i = 0; i < 64; i += 4) { const f32x4 xv = *(const f32x4*)(xs + i);
                pr += xv[0] * wa[i] + xv[1] * wa[i + 1] + xv[2] * wa[i + 2] + xv[3] * wa[i + 3];
                px += xv[0] * wx[i] + xv[1] * wx[i + 1] + xv[2] * wx[i + 2] + xv[3] * wx[i + 3]; }
            const float r = sigmoidf_(pr), ig = sigmoidf_(px);
            const float la = -8.0f * r * sp;
            const float a = expf(la);
            const float bt = sqrtf(-expm1f(2.0f * la)) * (ig * xc);
            Ac *= a; hl = a * hl + bt;
            LA[row * 512 + ch] = f2bf(Ac); LH[row * 512 + ch] = f2bf(hl);
        }
        Aend[((size_t)b * 64 + c) * 512 + ch] = Ac; Hend[((size_t)b * 64 + c) * 512 + ch] = hl;
    }
}

DI void p8b_scans(const Frame& F) {
    const int gt = F.bid * 512 + F.tid, nthr = F.G * 512;
    if (gt < 4096) {
        const int b = gt >> 9, ch = gt & 511;
        const float* Aend = (const float*)(F.ws + WS_AEND); const float* Hend = (const float*)(F.ws + WS_HEND); float* Hin = (float*)(F.ws + WS_HIN);
        float H = 0.f;
        for (int c = 0; c < 64; ++c) { const size_t o = ((size_t)b * 64 + c) * 512 + ch; Hin[o] = H; H = Aend[o] * H + Hend[o]; }
    }
    const float* scal = (const float*)(F.ws + WS_SCAL); float* minp = (float*)(F.ws + WS_SCAL) + 4096;
    if (gt >= nthr - 4096) {
        const int q = gt - (nthr - 4096); const int bh = q >> 7, d = q & 127;
        const float* zloc = (const float*)(F.ws + WS_ZLOC); float* nin = (float*)(F.ws + WS_NIN);
        float m = 0.f, n = 0.f;
        for (int c = 0; c < 64; ++c) { const int unit = bh * 64 + c; const float bl = scal[unit], dm = scal[2048 + unit];
            const float mn = fmaxf(bl + m, dm); const float keep = expf(bl + m - mn), add = expf(dm - mn);
            nin[(size_t)unit * 128 + d] = n; if (d == 0) minp[unit] = m;
            n = keep * n + add * zloc[(size_t)unit * 128 + d]; m = mn; }
    }
    bf16_t* ST = (bf16_t*)(F.ws + WS_BFB);
    for (int el = gt; el < 32 * 16384; el += nthr) {
        const int bh = el >> 14, ed = el & 16383;
        float m = 0.f, C = 0.f;
        for (int c = 0; c < 64; ++c) { const int unit = bh * 64 + c; const float bl = scal[unit], dm = scal[2048 + unit];
            const float mn = fmaxf(bl + m, dm); const float keep = expf(bl + m - mn), add = expf(dm - mn);
            bf16_t* p = ST + (size_t)unit * 16384 + ed; const float Sl = bf2f(*p); *p = f2bf(C);
            C = keep * C + add * Sl; m = mn; }
    }
}

DI void p8c_mlstm_out(const Frame& F) {
    const bf16_t* U1 = (const bf16_t*)(F.ws + WS_U);
    const bf16_t* ST = (const bf16_t*)(F.ws + WS_BFB);
    bf16_t* Y = (bf16_t*)(F.ws + WS_BFA);
    const float* nin_g = (const float*)(F.ws + WS_NIN); const float* minp = (const float*)(F.ws + WS_SCAL) + 4096;
    unsigned char* L = F.lds;
    float* li = (float*)(L + ML_LI); float* bc = (float*)(L + ML_BC); float* mt = (float*)(L + ML_MT); float* dq = (float*)(L + ML_DQ); float* rs = (float*)(L + ML_RS); float* nin = (float*)(L + ML_NIN);
    bf16_t* q = (bf16_t*)(L + ML_Q); bf16_t* k = (bf16_t*)(L + ML_K); bf16_t* vT = (bf16_t*)(L + ML_VT); bf16_t* CT = (bf16_t*)(L + ML_CT); bf16_t* W = (bf16_t*)(L + ML_W);
    const float* cw = F.in[24]; const float* cb = F.in[25];
    for (int unit = F.bid; unit < 2048; unit += F.G) {
        const int c = unit & 63, h = (unit >> 6) & 3, b = unit >> 8;
        const float m_in = minp[unit];
        mlstm_gates(F, U1, b, h, c, li, bc);
        for (int it = F.tid; it < 1024; it += 512) {
            const int s = it >> 4, d0 = (it & 15) * 8; const int t = c * 64 + s;
            float y[8];
            conv8(U1, b, t, C_DQ + h * 128 + d0, cw + h * 128 + d0, 1024, cb + h * 128 + d0, y);
            uint4 o; o.x = pack2(siluf_(y[0]), siluf_(y[1])); o.y = pack2(siluf_(y[2]), siluf_(y[3])); o.z = pack2(siluf_(y[4]), siluf_(y[5])); o.w = pack2(siluf_(y[6]), siluf_(y[7]));
            *(uint4*)(q + s * 136 + d0) = o;
            conv8(U1, b, t, C_DK + h * 128 + d0, cw + 512 + h * 128 + d0, 1024, cb + 512 + h * 128 + d0, y);
            const float sc = 0.08838834764831845f;
            o.x = pack2(siluf_(y[0]) * sc, siluf_(y[1]) * sc); o.y = pack2(siluf_(y[2]) * sc, siluf_(y[3]) * sc); o.z = pack2(siluf_(y[4]) * sc, siluf_(y[5]) * sc); o.w = pack2(siluf_(y[6]) * sc, siluf_(y[7]) * sc);
            *(uint4*)(k + s * 136 + d0) = o;
            const uint4 vv = *(const uint4*)(U1 + ((size_t)b * SEQ + t) * LD1 + C_DV + h * 128 + d0);
            const bf16_t* vp = (const bf16_t*)&vv;
#pragma unroll
            for (int i = 0; i < 8; ++i) vT[(d0 + i) * 72 + s] = vp[i];
        }
        for (int it = F.tid; it < 2048; it += 512) { const int e = it >> 4, d0 = (it & 15) * 8;
            *(uint4*)(CT + e * 136 + d0) = *(const uint4*)(ST + (size_t)unit * 16384 + e * 128 + d0); }
        if (F.tid < 128) nin[F.tid] = nin_g[(size_t)unit * 128 + F.tid];
        if (F.tid >= 128 && F.tid < 192) { const int l = F.tid - 128; float mx = bc[l] + m_in;
            for (int s = 0; s <= l; ++s) mx = fmaxf(mx, bc[l] - bc[s] + li[s]);
            mt[l] = mx; }
        __syncthreads();
        if (F.tid < 64) { float a = 0.f; for (int d = 0; d < 128; ++d) a += bf2f(q[F.tid * 136 + d]) * nin[d]; dq[F.tid] = a; }
        for (int tix = F.wave * 2; tix < F.wave * 2 + 2; ++tix) {
            const int lt = tix >> 2, st = tix & 3;
            const f32x4 a = mma16(q + lt * 16 * 136, 136, k + st * 16 * 136, 136, 128, F.lane);
            const int fr = F.lane & 15, fq = F.lane >> 4; const int s = st * 16 + fr;
#pragma unroll
            for (int r = 0; r < 4; ++r) { const int l = lt * 16 + 4 * fq + r;
                const float w = s <= l ? a[r] * expf(bc[l] - bc[s] + li[s] - mt[l]) : 0.f;
                W[l * 72 + s] = f2bf(w); }
        }
        __syncthreads();
        if (F.tid < 64) { float a = 0.f; for (int s = 0; s < 64; ++s) a += bf2f(W[F.tid * 72 + s]); rs[F.tid] = a; }
        __syncthreads();
        for (int tix = F.wave * 4; tix < F.wave * 4 + 4; ++tix) {
            const int lt = tix >> 3, et = tix & 7;
            const f32x4 qc = mma16(q + lt * 16 * 136, 136, CT + et * 16 * 136, 136, 128, F.lane);
            const f32x4 wv = mma16(W + lt * 16 * 72, 72, vT + et * 16 * 72, 72, 64, F.lane);
            const int fr = F.lane & 15, fq = F.lane >> 4; const int e = et * 16 + fr;
#pragma unroll
            for (int r = 0; r < 4; ++r) { const int l = lt * 16 + 4 * fq + r;
                const float prev = expf(bc[l] + m_in - mt[l]);
                const float num = prev * qc[r] + wv[r];
                const float den = prev * dq[l] + rs[l];
                const float hv = num / fmaxf(fabsf(den), expf(-mt[l]));
                const size_t row = (size_t)b * SEQ + c * 64 + l;
                const float og = sigmoidf_(bf2f(U1[row * LD1 + C_DO + h * 128 + e]));
                const float zz = siluf_(bf2f(U1[row * LD1 + C_DZ + h * 128 + e]));
                Y[row * 1024 + 512 + h * 128 + e] = f2bf(og * hv * zz); }
        }
        __syncthreads();
    }
}
DI void p8c_lru_out(const Frame& F) {
    const bf16_t* U1 = (const bf16_t*)(F.ws + WS_U);
    const bf16_t* LA = (const bf16_t*)(F.ws + WS_LRUA); const bf16_t* LH = (const bf16_t*)(F.ws + WS_LRUH);
    const float* Hin = (const float*)(F.ws + WS_HIN);
    bf16_t* Y = (bf16_t*)(F.ws + WS_BFA);
    const size_t n8 = (size_t)MT * 64;
    for (size_t it = (size_t)F.bid * 512 + F.tid; it < n8; it += (size_t)F.G * 512) {
        const size_t row = it >> 6; const int c0 = (int)(it & 63) * 8; const int b = (int)(row >> 12), t = (int)(row & 4095), c = t >> 6;
        const uint4 av = *(const uint4*)(LA + row * 512 + c0), hv = *(const uint4*)(LH + row * 512 + c0), zv = *(const uint4*)(U1 + row * LD1 + C_CZ + c0);
        float af[8], hf[8], zf[8]; unpack8(av, af); unpack8(hv, hf); unpack8(zv, zf);
        const float* hi = Hin + ((size_t)b * 64 + c) * 512 + c0; float y[8];
#pragma unroll
        for (int i = 0; i < 8; ++i) y[i] = (af[i] * hi[i] + hf[i]) * siluf_(zf[i]);
        uint4 o; o.x = pack2(y[0], y[1]); o.y = pack2(y[2], y[3]); o.z = pack2(y[4], y[5]); o.w = pack2(y[6], y[7]);
        *(uint4*)(Y + row * 1024 + c0) = o;
    }
}

constexpr int N_PHASES = 16;
__global__ void __launch_bounds__(512, 2) mk_fwd(Args args) {
    extern __shared__ __attribute__((aligned(16))) unsigned char smem[];
    Frame F;
    F.tid = threadIdx.x; F.lane = F.tid & 63; F.wave = __builtin_amdgcn_readfirstlane(F.tid >> 6);
    F.G = gridDim.x; F.bid = blockIdx.x; F.gw = F.bid * 8 + F.wave; F.nw = F.G * 8;
    F.lds = smem + LDS_WORK_OFF; F.ws = args.ws; F.out = args.out; F.ctl = (unsigned*)args.ws;
#pragma unroll
    for (int i = 0; i < 28; ++i) F.in[i] = args.in[i];
    LAS unsigned char* lsm = (LAS unsigned char*)smem;
    LAS unsigned char* lut = lsm + (LDS_BYTES - 4096);
    LAS float* tbl = (LAS float*)(lsm + (LDS_BYTES - 4096 + 256));
    if (F.tid < 4) ((LAS unsigned*)lsm)[F.tid] = 0u;
    if (F.tid < 128) { const int n = F.tid; int bk;
        if (n < 16) bk = n; else { bk = 16; const int thr[15] = {19, 21, 24, 27, 31, 35, 40, 46, 52, 59, 67, 77, 87, 99, 113};
#pragma unroll
            for (int j = 0; j < 15; ++j) bk += (n >= thr[j]) ? 1 : 0; }
        lut[n] = (unsigned char)bk; }
    { const int hd = F.tid >> 5, bk = F.tid & 31; tbl[hd * 32 + bk] = args.in[6][bk * 16 + hd]; }
    F.lut = lut; F.tbl = tbl;
    __syncthreads();
    const int lo = args.ph_lo, hi = args.ph_hi;
    XcdBarrier bar; bar.bar = F.ctl; bar.x = 0; bar.st = nullptr;
#if !MK_PER_PHASE
    bar = xcd_barrier_post(F.ctl, (volatile LAS unsigned*)lsm);
#endif
#ifndef PH_MASK
#define PH_MASK 0xFFFF
#endif
#define IN(k) (((PH_MASK >> (k)) & 1) && lo <= (k) && (k) < hi)
#if MK_PER_PHASE
#define SEAM(k) do { } while (0)
#else
#define SEAM(k) do { if (IN(k) && IN((k) + 1)) xcd_barrier(bar); } while (0)
#endif
    LAS unsigned char* glds = lsm + LDS_WORK_OFF;
    unsigned char* ws = args.ws;
    bf16_t* BFA = (bf16_t*)(ws + WS_BFA); bf16_t* BFB = (bf16_t*)(ws + WS_BFB); bf16_t* U = (bf16_t*)(ws + WS_U); float* Ef = (float*)(ws + WS_U);

    if (IN(0)) { p0_prologue(F); }
    SEAM(0);
    if (IN(1)) {
        pg8::Gemm g{BFA, (const bf16_t*)(ws + WS_WIN0), MT, LD0, 1024}; pg8::StaticOrder S; S.init(MT, LD0, F.G, F.bid);
        pg8::EpiBf16<0> E{U, LD0};
        pg8::gemm_phase(glds, g, S, E);
    }
    SEAM(1);
    if (IN(2)) { p2a_build_blocks(F); }
    SEAM(2);
    if (IN(3)) {
        { pg8::Gemm g{(const bf16_t*)(ws + WS_AK), (const bf16_t*)(ws + WS_WC1K), 4096, 256, 2048}; pg8::StaticOrder S; S.init(4096, 256, F.G, F.bid);
          pg8::EpiBf16<1> E{(bf16_t*)(ws + WS_HK), 256}; pg8::gemm_phase(glds, g, S, E); }
        { pg8::Gemm g{(const bf16_t*)(ws + WS_AV), (const bf16_t*)(ws + WS_WC1V), 4096, 256, 2048}; pg8::StaticOrder S; S.init(4096, 256, F.G, (F.bid + F.G - 16) % F.G);
          pg8::EpiBf16<1> E{(bf16_t*)(ws + WS_HV), 256}; pg8::gemm_phase(glds, g, S, E); }
    }
    SEAM(3);
    if (IN(4)) { p2c_compress_out(F); }
    SEAM(4);
    if (IN(5)) { p3_attention(F); }
    SEAM(5);
    if (IN(6)) {
        pg8::Gemm g{BFB, (const bf16_t*)(ws + WS_WOUT0), MT, 1024, 1024}; pg8::StaticOrder S; S.init(MT, 1024, F.G, F.bid);
        pg8::EpiResid E{F.in[0], F.out, BFA};
        pg8::gemm_phase(glds, g, S, E);
    }
    SEAM(6);
    if (IN(7)) {
        { pg8::Gemm g{(const bf16_t*)(ws + WS_PBF), (const bf16_t*)(ws + WS_WP0), MT, 1024, 256}; pg8::StaticOrder S; S.init(MT, 1024, F.G, F.bid);
          pg8::EpiF32 E{Ef, 1024}; pg8::gemm_phase(glds, g, S, E); }
        asm volatile("s_waitcnt vmcnt(0)" ::: "memory"); __syncthreads();
        { pg8::Gemm g{BFA, (const bf16_t*)(ws + WS_WG0), MT, 1024, 1024}; pg8::StaticOrder S; S.init(MT, 1024, F.G, F.bid);
          pg8::EpiGate E{F.out, Ef}; pg8::gemm_phase(glds, g, S, E); }
    }
    SEAM(7);
    if (IN(8)) { rmsnorm_rows<0>(F, F.out, F.in[2] + 1024, BFB, nullptr); }
    SEAM(8);
    if (IN(9)) {
        pg8::Gemm g{BFB, (const bf16_t*)(ws + WS_WIN1), MT, LD1, 1024}; pg8::StaticOrder S; S.init(MT, LD1, F.G, F.bid);
        pg8::EpiBf16<0> E{U, LD1};
        pg8::gemm_phase(glds, g, S, E);
    }
    SEAM(9);
    if (IN(10)) { p8a_mlstm_local(F); p8a_lru_local(F); }
    SEAM(10);
    if (IN(11)) { p8b_scans(F); }
    SEAM(11);
    if (IN(12)) { p8c_mlstm_out(F); p8c_lru_out(F); }
    SEAM(12);
    if (IN(13)) {
        pg8::Gemm g{BFA, (const bf16_t*)(ws + WS_WOUT1), MT, 1024, 1024}; pg8::StaticOrder S; S.init(MT, 1024, F.G, F.bid);
        pg8::EpiResid E{F.out, F.out, BFB};
        pg8::gemm_phase(glds, g, S, E);
    }
    SEAM(13);
    if (IN(14)) {
        { pg8::Gemm g{(const bf16_t*)(ws + WS_PBF) + (size_t)MT * 256, (const bf16_t*)(ws + WS_WP1), MT, 1024, 256}; pg8::StaticOrder S; S.init(MT, 1024, F.G, F.bid);
          pg8::EpiF32 E{Ef, 1024}; pg8::gemm_phase(glds, g, S, E); }
        asm volatile("s_waitcnt vmcnt(0)" ::: "memory"); __syncthreads();
        { pg8::Gemm g{BFB, (const bf16_t*)(ws + WS_WG1), MT, 1024, 1024}; pg8::StaticOrder S; S.init(MT, 1024, F.G, F.bid);
          pg8::EpiGate E{F.out, Ef}; pg8::gemm_phase(glds, g, S, E); }
    }
    SEAM(14);
    if (IN(15)) { rmsnorm_rows<1>(F, F.out, F.in[3], nullptr, F.out); }
#undef IN
#undef SEAM
}

extern "C" void kernel_launch(void* const* d_in, const int* in_sizes, int n_in, void* d_out, int out_size, void* d_ws, size_t ws_size, hipStream_t stream) {
    static int grid = 0;
    if (grid == 0) {
        if (n_in != 28 || out_size != MT * DM || ws_size < WS_END) { fprintf(stderr, "kernel_launch: unexpected shapes (n_in %d, out %d, ws %zu < %zu)\n", n_in, out_size, ws_size, (size_t)WS_END); grid = -1; return; }
        int dev = 0, cus = 0, per_cu = 0;
        if (hipGetDevice(&dev) != hipSuccess || hipDeviceGetAttribute(&cus, hipDeviceAttributeMultiprocessorCount, dev) != hipSuccess) { grid = -1; return; }
        if (hipFuncSetAttribute((const void*)mk_fwd, hipFuncAttributeMaxDynamicSharedMemorySize, LDS_BYTES) != hipSuccess) { fprintf(stderr, "kernel_launch: hipFuncSetAttribute failed\n"); grid = -1; return; }
        if (hipOccupancyMaxActiveBlocksPerMultiprocessor(&per_cu, (const void*)mk_fwd, 512, LDS_BYTES) != hipSuccess || per_cu < 1)
            fprintf(stderr, "kernel_launch: occupancy query reports %d workgroups per CU\n", per_cu);
        (void)hipGetLastError();
        grid = cus;
    }
    if (grid < 0) return;
    if (hipMemsetAsync(d_ws, 0, CTL_BYTES, stream) != hipSuccess) return;
    Args a{};
    for (int i = 0; i < 28; ++i) a.in[i] = (const float*)d_in[i];
    a.out = (float*)d_out; a.ws = (unsigned char*)d_ws;
#if MK_PER_PHASE
    for (int p = 0; p < N_PHASES; ++p) { a.ph_lo = p; a.ph_hi = p + 1; hipLaunchKernelGGL(mk_fwd, dim3(grid), dim3(512), LDS_BYTES, stream, a); }
#else
    a.ph_lo = 0; a.ph_hi = N_PHASES;
    hipLaunchKernelGGL(mk_fwd, dim3(grid), dim3(512), LDS_BYTES, stream, a);
#endif
}
```

```cpp
#include <hip/hip_runtime.h>
#include <cstdio>
#include <cstdint>

#ifndef MK_PER_PHASE
#define MK_PER_PHASE 0
#endif

#define LAS __attribute__((address_space(3)))
typedef unsigned short bf16_t;
typedef short bf16x8 __attribute__((ext_vector_type(8)));
typedef float f32x4 __attribute__((ext_vector_type(4)));
#define DI __device__ __forceinline__

constexpr int NB = 8, SEQ = 4096, DM = 1024, MT = NB * SEQ;
constexpr int LD0 = 3328, LD1 = 3840;
constexpr int C_AQ = 0, C_KC = 512, C_VC = 640, C_KS = 768, C_VS = 896, C_KW = 1024, C_VW = 1152, C_AZ = 1280, C_BQ = 1792, C_BZ = 2304,
              C_BK = 2816, C_BV = 2880, C_BKI = 2944, C_BQI = 3008, C_AG = 3264, C_BWI = 3288;
constexpr int C_CX = 0, C_CZ = 512, C_DQ = 1024, C_DK = 1536, C_DV = 2048, C_DO = 2560, C_DZ = 3072, C_DI = 3584, C_DF = 3588;
constexpr int NCMP = 255;
constexpr float NEG_INF = -__builtin_inff();

DI int map0(int n) {
    if (n < 1280) return n;
    if (n < 1792) return 1304 + (n - 1280);
    if (n < 2304) return 1816 + (n - 1792);
    if (n < 2816) return 2780 + (n - 2304);
    if (n < 2880) return 2328 + (n - 2816);
    if (n < 2944) return 2392 + (n - 2880);
    if (n < 3008) return 2712 + (n - 2944);
    if (n < 3264) return 2456 + (n - 3008);
    if (n < 3288) return 1280 + (n - 3264);
    if (n < 3292) return 2776 + (n - 3288);
    return -1;
}
DI int map1(int n) {
    if (n < 2560) return n;
    if (n < 3072) return 2568 + (n - 2560);
    if (n < 3584) return 3080 + (n - 3072);
    if (n < 3588) return 2560 + (n - 3584);
    if (n < 3592) return 2564 + (n - 3588);
    return -1;
}
DI int mapid(int n) { return n; }

constexpr size_t CTL_BYTES = 16384;
constexpr size_t WS_WIN0  = CTL_BYTES;
constexpr size_t WS_WOUT0 = WS_WIN0  + (size_t)LD0 * 1024 * 2;
constexpr size_t WS_WG0   = WS_WOUT0 + (size_t)1024 * 1024 * 2;
constexpr size_t WS_WP0   = WS_WG0   + (size_t)1024 * 1024 * 2;
constexpr size_t WS_WIN1  = WS_WP0   + (size_t)1024 * 256 * 2;
constexpr size_t WS_WOUT1 = WS_WIN1  + (size_t)LD1 * 1024 * 2;
constexpr size_t WS_WG1   = WS_WOUT1 + (size_t)1024 * 1024 * 2;
constexpr size_t WS_WP1   = WS_WG1   + (size_t)1024 * 1024 * 2;
constexpr size_t WS_WC1K  = WS_WP1   + (size_t)1024 * 256 * 2;
constexpr size_t WS_WC1V  = WS_WC1K  + (size_t)256 * 2048 * 2;
constexpr size_t WS_BFA   = WS_WC1V  + (size_t)256 * 2048 * 2;
constexpr size_t WS_BFB   = WS_BFA   + (size_t)MT * 1024 * 2;
constexpr size_t WS_PBF   = WS_BFB   + (size_t)MT * 1024 * 2;
constexpr size_t WS_U     = WS_PBF   + (size_t)2 * MT * 256 * 2;
constexpr size_t WS_X     = WS_U     + (size_t)MT * LD1 * 2;
constexpr size_t WS_AK    = WS_X;
constexpr size_t WS_AV    = WS_AK    + (size_t)4096 * 2048 * 2;
constexpr size_t WS_HK    = WS_AV    + (size_t)4096 * 2048 * 2;
constexpr size_t WS_HV    = WS_HK    + (size_t)4096 * 256 * 2;
constexpr size_t WS_LRUA  = WS_X;
constexpr size_t WS_LRUH  = WS_LRUA  + (size_t)MT * 512 * 2;
constexpr size_t WS_S     = WS_X     + (size_t)64 * 1024 * 1024;
constexpr size_t WS_KCMP  = WS_S;
constexpr size_t WS_VCMP  = WS_KCMP  + (size_t)16 * 256 * 64 * 4;
constexpr size_t WS_AEND  = WS_VCMP  + (size_t)16 * 256 * 64 * 4;
constexpr size_t WS_HEND  = WS_AEND  + (size_t)8 * 64 * 512 * 4;
constexpr size_t WS_HIN   = WS_HEND  + (size_t)8 * 64 * 512 * 4;
constexpr size_t WS_ZLOC  = WS_HIN   + (size_t)8 * 64 * 512 * 4;
constexpr size_t WS_NIN   = WS_ZLOC  + (size_t)2048 * 128 * 4;
constexpr size_t WS_SCAL  = WS_NIN   + (size_t)2048 * 128 * 4;
constexpr size_t WS_END   = WS_SCAL  + (size_t)3 * 2048 * 4;
static_assert(WS_HV + (size_t)4096 * 256 * 2 <= WS_S, "compress region");
static_assert(WS_LRUH + (size_t)MT * 512 * 2 <= WS_S, "lru region");

constexpr int XCD_BAR_WORDS_C = 3456;
constexpr int CW_QNSA = 3520, CW_QDSA = 3584;

constexpr int LDS_BYTES = 147456;
constexpr int LDS_CTL_OFF = 0;
constexpr int LDS_WORK_OFF = 1024;

DI float bf2f(bf16_t v) { return __uint_as_float(((unsigned)v) << 16); }
DI bf16_t f2bf(float f) { unsigned u = __float_as_uint(f); u += 0x7FFFu + ((u >> 16) & 1u); return (bf16_t)(u >> 16); }
typedef __bf16 bf16v2 __attribute__((ext_vector_type(2)));
typedef float f32x2 __attribute__((ext_vector_type(2)));
DI unsigned pack2(float lo, float hi) { const f32x2 v = {lo, hi}; return __builtin_bit_cast(unsigned, __builtin_convertvector(v, bf16v2)); }
DI float sigmoidf_(float x) { return 1.0f / (1.0f + expf(-x)); }
DI float siluf_(float x) { return x / (1.0f + expf(-x)); }
DI float wave_max(float v) { for (int o = 32; o >= 1; o >>= 1) v = fmaxf(v, __shfl_xor(v, o)); return v; }
DI float wave_sum(float v) { for (int o = 32; o >= 1; o >>= 1) v += __shfl_xor(v, o); return v; }
DI void unpack8(const uint4& v, float (&f)[8]) {
    f[0] = __uint_as_float(v.x << 16); f[1] = __uint_as_float(v.x & 0xFFFF0000u);
    f[2] = __uint_as_float(v.y << 16); f[3] = __uint_as_float(v.y & 0xFFFF0000u);
    f[4] = __uint_as_float(v.z << 16); f[5] = __uint_as_float(v.z & 0xFFFF0000u);
    f[6] = __uint_as_float(v.w << 16); f[7] = __uint_as_float(v.w & 0xFFFF0000u);
}

#define XB_TMO      128
#define XB_XCNT(j)  (256  + 64 * (j))
#define XB_XSUB(j)  (1280 + 64 * (j))
#define XB_XGEN(j)  (2304 + 64 * (j))
#define XB_TOP      3328
#define XB_TOPGEN   3392
#define XCD_BAR_WORDS 3456
#define XB_SPIN_CAP (1u << 22)
static_assert(XCD_BAR_WORDS == XCD_BAR_WORDS_C, "bar words");

__device__ __forceinline__ unsigned xb_ld(unsigned* p)              { return __hip_atomic_load(p, __ATOMIC_RELAXED, __HIP_MEMORY_SCOPE_AGENT); }
__device__ __forceinline__ unsigned xb_add(unsigned* p, unsigned v) { return __hip_atomic_fetch_add(p, v, __ATOMIC_RELAXED, __HIP_MEMORY_SCOPE_AGENT); }
__device__ __forceinline__ unsigned xb_xcc_id() { return (unsigned)__builtin_amdgcn_s_getreg((3 << 11) | 20) & 0xFu; }
#define XB_SPIN(cond, bar) do { unsigned _sp = 0; while (cond) { __builtin_amdgcn_s_sleep(1); \
    if ((++_sp & 255u) == 0u) { if (xb_ld(&(bar)[XB_TMO])) break; if (_sp > XB_SPIN_CAP) { atomicAdd(&(bar)[XB_TMO], 1u); break; } } } } while (0)

struct XcdBarrier { unsigned* bar; unsigned x; volatile LAS unsigned* st; };

__device__ __forceinline__ XcdBarrier xcd_barrier_post(unsigned* bar, volatile LAS unsigned* st) {
    XcdBarrier b; b.bar = bar; b.x = xb_xcc_id(); b.st = st;
    if (threadIdx.x == 0) (void)xb_add(&bar[XB_XCNT(b.x)], 1u);
    return b;
}
__device__ __forceinline__ void xcd_barrier_complete(unsigned* bar, unsigned x, unsigned& nloc, unsigned& nx) {
    const unsigned G = gridDim.x * gridDim.y * gridDim.z;
    unsigned sum, cnt, mine, sp = 0u;
    for (;;) {
        sum = 0u; cnt = 0u; mine = 0u;
#pragma unroll
        for (unsigned j = 0; j < 16; ++j) { const unsigned c = xb_ld(&bar[XB_XCNT(j)]); sum += c; cnt += (c > 0u) ? 1u : 0u; mine = (j == x) ? c : mine; }
        if (sum == G) break;
        __builtin_amdgcn_s_sleep(1);
        if ((++sp & 255u) == 0u) { if (xb_ld(&bar[XB_TMO])) break; if (sp > XB_SPIN_CAP) { atomicAdd(&bar[XB_TMO], 1u); break; } }
    }
    nloc = mine > 0u ? mine : 1u; nx = cnt > 0u ? cnt : 1u;
}
__device__ __forceinline__ void xcd_barrier(const XcdBarrier& b) {
    asm volatile("s_waitcnt vmcnt(0)" ::: "memory");
    __syncthreads();
    if (threadIdx.x == 0) {
        unsigned* bar = b.bar;
        __builtin_amdgcn_s_waitcnt(0);
        unsigned nloc = b.st[0], nx = b.st[1];
        if (nloc == 0u) { xcd_barrier_complete(bar, b.x, nloc, nx); b.st[0] = nloc; b.st[1] = nx; }
        const unsigned old = xb_add(&bar[XB_XSUB(b.x)], 1u);
        const unsigned gen = old / nloc;
        if (old + 1u == (gen + 1u) * nloc) {
            __builtin_amdgcn_fence(__ATOMIC_RELEASE, "agent");
            asm volatile("s_waitcnt vmcnt(0)" ::: "memory");
            const unsigned og = xb_add(&bar[XB_TOP], 1u);
            const unsigned tg = og / nx;
            if (og + 1u == (tg + 1u) * nx) xb_add(&bar[XB_TOPGEN], 1u);
            else XB_SPIN(xb_ld(&bar[XB_TOPGEN]) == tg, bar);
            __builtin_amdgcn_fence(__ATOMIC_ACQUIRE, "agent");
            xb_add(&bar[XB_XGEN(b.x)], 1u);
            asm volatile("s_waitcnt vmcnt(0)" ::: "memory");
        } else {
            XB_SPIN(xb_ld(&bar[XB_XGEN(b.x)]) == gen, bar);
            __builtin_amdgcn_fence(__ATOMIC_ACQUIRE, "agent");
            asm volatile("s_waitcnt vmcnt(0)" ::: "memory");
        }
    }
    __syncthreads();
}

namespace pg8 {
constexpr int BM = 256, BK = 64, HALF = 128, HTB = HALF * BK * 2, STAGE_BYTES = 8 * HTB, NXCD = 8, WGM = 8;
__host__ __device__ __forceinline__ int lds_byte(int r, int c) { const int st = (r >> 4) * 2 + (c >> 5), rr = r & 15, cc = c & 31, ob = rr * 64 + cc * 2; return st * 1024 + (ob ^ (((ob >> 9) & 1) << 5)); }
__host__ __device__ __forceinline__ void stage_rc(int b, int& R, int& C) { const int st = b / 1024, sb = b % 1024, swz = sb ^ (((sb >> 9) & 1) << 5); R = (st >> 1) * 16 + swz / 64; C = (st & 1) * 32 + (swz % 64) / 2; }
__host__ __device__ __forceinline__ int perm32(int rho) { const int n = rho >> 4, i = rho & 15; return 8 * (i >> 2) + 4 * n + (i & 3); }
struct Unit { int pm, pn; };
struct Gemm { const bf16_t* A; const bf16_t* Bt; int M, N, K; };
struct StaticOrder {
    int nM, nN, nwg, G, c;
    __host__ __device__ void init(int M, int N, int G_, int c_) { nM = M / BM; nN = N / BM; nwg = nM * nN; G = G_; c = c_; }
    __host__ __device__ bool next(int i, Unit& u) const {
        const long L = (long)i * G + c; if (L >= nwg) return false;
        int wgid = (int)L; { const int q = nwg / NXCD, r = nwg % NXCD, xcd = wgid % NXCD, off = wgid / NXCD; wgid = (xcd < r ? xcd * (q + 1) : r * (q + 1) + (xcd - r) * q) + off; }
        const int nig = WGM * nN, gid = wgid / nig, fm = gid * WGM, gsz = (nM - fm) < WGM ? (nM - fm) : WGM;
        u.pm = fm + ((wgid % nig) % gsz); u.pn = (wgid % nig) / gsz; return true;
    }
    __device__ __forceinline__ void a_ready(const Unit&) const {}
    __device__ __forceinline__ void done(const Unit&) const {}
};
template <class Epi, class Sched>
__device__ __forceinline__ void gemm_phase(LAS unsigned char* lds, const Gemm g, const Sched& S, const Epi& E) {
    const int tid = threadIdx.x, wid = __builtin_amdgcn_readfirstlane(tid >> 6), lane = tid & 63, wr = wid >> 2, wc = wid & 3, fr = lane & 15, fq = lane >> 4;
    const int K = g.K, nt = K / BK;
    unsigned voffA[2], voffB[2];
#pragma unroll
    for (int i = 0; i < 2; ++i) { int R, C; stage_rc(tid * 16 + i * 8192, R, C); const int Rb = Epi::PERM ? ((R & ~31) + perm32(R & 31)) : R;
        voffA[i] = (unsigned)(R * K + C) * 2u; voffB[i] = (unsigned)(Rb * K + C) * 2u; }
    const size_t kstep = (size_t)(BK * 2);
    const size_t hstep = (size_t)HALF * K * 2;
    const size_t tstep = 2 * hstep;
    const unsigned ldsw = (unsigned)wid * 1024u;
    const int aoff = lds_byte(wr * 64 + fr, fq * 8), boff = lds_byte(wc * 32 + fr, fq * 8);
#define PG8_SA(b, h) (((b) * 2 + (h)) * HTB)
#define PG8_SB(b, h) ((4 + (b) * 2 + (h)) * HTB)
#define PG8_STAGE(bufoff, gbase, voff) do { _Pragma("unroll") for (int _i = 0; _i < 2; ++_i) \
        __builtin_amdgcn_global_load_lds((const unsigned*)((const char*)(gbase) + (voff)[_i]), (LAS unsigned*)(lds + (bufoff) + ldsw + _i * 8192), 16, 0, 0); } while (0)
#define PG8_LDA(dst, b, h) do { _Pragma("unroll") for (int m = 0; m < 4; ++m) _Pragma("unroll") for (int k = 0; k < 2; ++k) dst[m][k] = *(const LAS bf16x8*)(lds + PG8_SA(b, h) + aoff + m * 2048 + k * 1024); } while (0)
#define PG8_LDB(dst, b, h) do { _Pragma("unroll") for (int n = 0; n < 2; ++n) _Pragma("unroll") for (int k = 0; k < 2; ++k) dst[n][k] = *(const LAS bf16x8*)(lds + PG8_SB(b, h) + boff + n * 2048 + k * 1024); } while (0)
#define PG8_MMA(ai, bj, At, Bt) do { __builtin_amdgcn_s_setprio(1); _Pragma("unroll") for (int m = 0; m < 4; ++m) _Pragma("unroll") for (int n = 0; n < 2; ++n) _Pragma("unroll") for (int k = 0; k < 2; ++k) \
        acc[ai][bj][m][n] = __builtin_amdgcn_mfma_f32_16x16x32_bf16(Bt[n][k], At[m][k], acc[ai][bj][m][n], 0, 0, 0); __builtin_amdgcn_s_setprio(0); } while (0)
#define PG8_WAIT_V(n) asm volatile("s_waitcnt vmcnt(" #n ")" ::: "memory")
#define PG8_WAIT_L(n) asm volatile("s_waitcnt lgkmcnt(" #n ")" ::: "memory")
#define PG8_BAR __builtin_amdgcn_s_barrier()
#define PG8_SCHED __builtin_amdgcn_sched_barrier(0)
    Unit cur, nxt; int ui = 0;
    if (!S.next(0, cur)) return;
    f32x4 acc[2][2][4][2];
#pragma unroll
    for (int a = 0; a < 2; ++a)
#pragma unroll
        for (int b = 0; b < 2; ++b)
#pragma unroll
            for (int m = 0; m < 4; ++m)
#pragma unroll
                for (int n = 0; n < 2; ++n) acc[a][b][m][n] = (f32x4){0.f, 0.f, 0.f, 0.f};
    bf16x8 At[4][2], B0[2][2], B1[2][2];
    const char* cA = (const char*)g.A + (size_t)cur.pm * tstep; const char* cB = (const char*)g.Bt + (size_t)cur.pn * tstep;
    S.a_ready(cur);
    PG8_STAGE(PG8_SB(0, 0), cB, voffB); PG8_STAGE(PG8_SA(0, 0), cA, voffA); PG8_STAGE(PG8_SB(0, 1), cB + hstep, voffB); PG8_STAGE(PG8_SA(0, 1), cA + hstep, voffA);
    if (wr == 1) PG8_BAR;
    PG8_WAIT_V(4); PG8_BAR;
    PG8_STAGE(PG8_SB(1, 0), cB + kstep, voffB); PG8_STAGE(PG8_SA(1, 0), cA + kstep, voffA); PG8_STAGE(PG8_SB(1, 1), cB + hstep + kstep, voffB);
    PG8_WAIT_V(6); PG8_BAR;
    for (;;) {
        const bool has_next = S.next(ui + 1, nxt);
        const char* nA = has_next ? (const char*)g.A + (size_t)nxt.pm * tstep : cA; const char* nB = has_next ? (const char*)g.Bt + (size_t)nxt.pn * tstep : cB;
        for (int t = 0; t < nt; t += 2) {
            const bool last = (t == nt - 2);
            const char* a1 = cA + (size_t)(t + 1) * kstep;
            const char* a2 = last ? nA : cA + (size_t)(t + 2) * kstep; const char* b2 = last ? nB : cB + (size_t)(t + 2) * kstep;
            const char* a3 = a2 + kstep; const char* b3 = b2 + kstep;
            if (last && has_next) S.a_ready(nxt);
            PG8_LDB(B0, 0, 0); PG8_SCHED; PG8_LDA(At, 0, 0); PG8_STAGE(PG8_SA(1, 1), a1 + hstep, voffA);
            PG8_WAIT_L(8); PG8_BAR; PG8_WAIT_L(0); PG8_MMA(0, 0, At, B0); PG8_BAR; PG8_SCHED;
            PG8_LDB(B1, 0, 1); PG8_STAGE(PG8_SB(0, 0), b2, voffB);
            PG8_BAR; PG8_WAIT_L(0); PG8_MMA(0, 1, At, B1); PG8_BAR;
            PG8_LDA(At, 0, 1); PG8_STAGE(PG8_SA(0, 0), a2, voffA);
            PG8_BAR; PG8_WAIT_L(0); PG8_MMA(1, 0, At, B0); PG8_BAR; PG8_SCHED;
            PG8_STAGE(PG8_SB(0, 1), b2 + hstep, voffB);
            PG8_WAIT_V(6); PG8_BAR; PG8_MMA(1, 1, At, B1); PG8_BAR;
            PG8_LDB(B0, 1, 0); PG8_SCHED; PG8_LDA(At, 1, 0); PG8_STAGE(PG8_SA(0, 1), a2 + hstep, voffA);
            PG8_WAIT_L(8); PG8_BAR; PG8_WAIT_L(0); PG8_MMA(0, 0, At, B0); PG8_BAR; PG8_SCHED;
            PG8_LDB(B1, 1, 1); PG8_STAGE(PG8_SB(1, 0), b3, voffB);
            PG8_BAR; PG8_WAIT_L(0); PG8_MMA(0, 1, At, B1); PG8_BAR;
            PG8_LDA(At, 1, 1); PG8_STAGE(PG8_SA(1, 0), a3, voffA);
            PG8_BAR; PG8_WAIT_L(0); PG8_MMA(1, 0, At, B0); PG8_BAR; PG8_SCHED;
            PG8_STAGE(PG8_SB(1, 1), b3 + hstep, voffB);
            PG8_WAIT_V(6); PG8_BAR; PG8_MMA(1, 1, At, B1); PG8_BAR;
        }
        E(acc, cur, wr, wc, fr, fq); S.done(cur);
        if (!has_next) break;
#pragma unroll
        for (int a = 0; a < 2; ++a)
#pragma unroll
            for (int b = 0; b < 2; ++b)
#pragma unroll
                for (int m = 0; m < 4; ++m)
#pragma unroll
                    for (int n = 0; n < 2; ++n) acc[a][b][m][n] = (f32x4){0.f, 0.f, 0.f, 0.f};
        cur = nxt; cA = nA; cB = nB; ++ui;
    }
    PG8_WAIT_V(0);
    if (wr == 0) PG8_BAR;
    PG8_BAR;
#undef PG8_SA
#undef PG8_SB
#undef PG8_STAGE
#undef PG8_LDA
#undef PG8_LDB
#undef PG8_MMA
#undef PG8_WAIT_V
#undef PG8_WAIT_L
#undef PG8_BAR
#undef PG8_SCHED
}

template <int ACT  > struct EpiBf16 {
    static constexpr bool PERM = true;
    bf16_t* O; int ldc;
    __device__ __forceinline__ void operator()(const f32x4 (&acc)[2][2][4][2], const Unit& u, int wr, int wc, int fr, int fq) const {
        const int row0 = u.pm * BM + wr * 64 + fr, col0 = u.pn * BM + wc * 32 + 8 * fq;
#pragma unroll
        for (int ai = 0; ai < 2; ++ai)
#pragma unroll
            for (int m = 0; m < 4; ++m) { bf16_t* rowp = O + (size_t)(row0 + ai * HALF + m * 16) * ldc + col0;
#pragma unroll
                for (int bj = 0; bj < 2; ++bj) { f32x4 v0 = acc[ai][bj][m][0], v1 = acc[ai][bj][m][1];
                    if (ACT == 1) { for (int i = 0; i < 4; ++i) { v0[i] = siluf_(v0[i]); v1[i] = siluf_(v1[i]); } }
                    uint4 o; o.x = pack2(v0[0], v0[1]); o.y = pack2(v0[2], v0[3]); o.z = pack2(v1[0], v1[1]); o.w = pack2(v1[2], v1[3]);
                    *(uint4*)(rowp + bj * HALF) = o; } }
    }
};
struct EpiF32 {
    static constexpr bool PERM = false;
    float* C; int ldc;
    __device__ __forceinline__ void operator()(const f32x4 (&acc)[2][2][4][2], const Unit& u, int wr, int wc, int fr, int fq) const {
        const int row0 = u.pm * BM + wr * 64 + fr, col0 = u.pn * BM + wc * 32 + 4 * fq;
#pragma unroll
        for (int ai = 0; ai < 2; ++ai)
#pragma unroll
            for (int m = 0; m < 4; ++m) { float* rowp = C + (size_t)(row0 + ai * HALF + m * 16) * ldc + col0;
#pragma unroll
                for (int bj = 0; bj < 2; ++bj)
#pragma unroll
                    for (int n = 0; n < 2; ++n) *(f32x4*)(rowp + bj * HALF + n * 16) = acc[ai][bj][m][n]; }
    }
};
struct EpiResid {
    static constexpr bool PERM = false;
    const float* Xi; float* Xo; bf16_t* Ob;
    __device__ __forceinline__ void operator()(const f32x4 (&acc)[2][2][4][2], const Unit& u, int wr, int wc, int fr, int fq) const {
        const int row0 = u.pm * BM + wr * 64 + fr, col0 = u.pn * BM + wc * 32 + 4 * fq;
#pragma unroll
        for (int ai = 0; ai < 2; ++ai)
#pragma unroll
            for (int m = 0; m < 4; ++m) { const size_t ro = (size_t)(row0 + ai * HALF + m * 16) * 1024 + col0;
#pragma unroll
                for (int bj = 0; bj < 2; ++bj)
#pragma unroll
                    for (int n = 0; n < 2; ++n) { const size_t o = ro + bj * HALF + n * 16;
                        const f32x4 xi = *(const f32x4*)(Xi + o); const f32x4 v = xi + acc[ai][bj][m][n];
                        *(f32x4*)(Xo + o) = v; uint2 pk; pk.x = pack2(v[0], v[1]); pk.y = pack2(v[2], v[3]); *(uint2*)(Ob + o) = pk; } }
    }
};
struct EpiGate {
    static constexpr bool PERM = false;
    float* X; const float* E;
    __device__ __forceinline__ void operator()(const f32x4 (&acc)[2][2][4][2], const Unit& u, int wr, int wc, int fr, int fq) const {
        const int row0 = u.pm * BM + wr * 64 + fr, col0 = u.pn * BM + wc * 32 + 4 * fq;
#pragma unroll
        for (int ai = 0; ai < 2; ++ai)
#pragma unroll
            for (int m = 0; m < 4; ++m) { const size_t ro = (size_t)(row0 + ai * HALF + m * 16) * 1024 + col0;
#pragma unroll
                for (int bj = 0; bj < 2; ++bj)
#pragma unroll
                    for (int n = 0; n < 2; ++n) { const size_t o = ro + bj * HALF + n * 16;
                        const f32x4 xi = *(const f32x4*)(X + o); const f32x4 e = *(const f32x4*)(E + o); f32x4 v;
                        for (int i = 0; i < 4; ++i) v[i] = xi[i] + e[i] * sigmoidf_(acc[ai][bj][m][n][i]);
                        *(f32x4*)(X + o) = v; } }
    }
};
}

struct Args { const float* in[28]; float* out; unsigned char* ws; int ph_lo, ph_hi; };

struct Frame {
    int tid, lane, wave, G, bid, gw, nw;
    unsigned char* lds;
    unsigned* ctl;
    const float* in[28]; float* out; unsigned char* ws;
    const LAS unsigned char* lut;
    const LAS float* tbl;
    const LAS float* biasL;
    LAS unsigned char* ldsl;
};
DI int t5b(const Frame& F, int n) { return n < 16 ? n : (n >= 113 ? 31 : (int)F.lut[n]); }

template <class Map>
DI void transpose_w(const Frame& F, const float* src, int K, int Nsrc, bf16_t* dst, int Npad, Map map) {
    float* tile = (float*)F.lds;
    const int ntn = Npad / 64, ntk = K / 64, ntiles = ntn * ntk;
    for (int tix = F.bid; tix < ntiles; tix += F.G) {
        const int nt = tix / ntk, kt = tix % ntk;
        for (int e = F.tid; e < 4096; e += 512) { const int kk = e >> 6, nn = e & 63; const int col = map(nt * 64 + nn);
            tile[kk * 65 + nn] = col >= 0 ? src[(size_t)(kt * 64 + kk) * Nsrc + col] : 0.f; }
        __syncthreads();
        for (int e = F.tid; e < 4096; e += 512) { const int nn = e >> 6, kk = e & 63;
            dst[(size_t)(nt * 64 + nn) * K + kt * 64 + kk] = f2bf(tile[kk * 65 + nn]); }
        __syncthreads();
    }
}
template <int OUTF>
DI void rmsnorm_rows(const Frame& F, const float* X, const float* g, bf16_t* Ob, float* Of) {
    for (int row = F.gw; row < MT; row += F.nw) {
        const float* xr = X + (size_t)row * 1024;
        f32x4 v[4]; float ss = 0.f;
#pragma unroll
        for (int i = 0; i < 4; ++i) { v[i] = *(const f32x4*)(xr + i * 256 + F.lane * 4); ss += v[i][0] * v[i][0] + v[i][1] * v[i][1] + v[i][2] * v[i][2] + v[i][3] * v[i][3]; }
        ss = wave_sum(ss);
        const float rs = rsqrtf(ss * (1.0f / 1024.0f) + 1e-6f);
#pragma unroll
        for (int i = 0; i < 4; ++i) { const f32x4 gg = *(const f32x4*)(g + i * 256 + F.lane * 4); f32x4 y;
            for (int j = 0; j < 4; ++j) y[j] = v[i][j] * rs * gg[j];
            if (OUTF) *(f32x4*)(Of + (size_t)row * 1024 + i * 256 + F.lane * 4) = y;
            else { uint2 pk; pk.x = pack2(y[0], y[1]); pk.y = pack2(y[2], y[3]); *(uint2*)(Ob + (size_t)row * 1024 + i * 256 + F.lane * 4) = pk; } }
    }
}
DI void p0_prologue(const Frame& F) {
    unsigned char* ws = F.ws;
    transpose_w(F, F.in[7], 1024, 3292, (bf16_t*)(ws + WS_WIN0), LD0, [](int n) { return map0(n); });
    transpose_w(F, F.in[8], 1024, 1024, (bf16_t*)(ws + WS_WOUT0), 1024, [](int n) { return mapid(n); });
    transpose_w(F, F.in[5], 1024, 1024, (bf16_t*)(ws + WS_WG0), 1024, [](int n) { return mapid(n); });
    transpose_w(F, F.in[5] + (size_t)1024 * 1024, 1024, 1024, (bf16_t*)(ws + WS_WG1), 1024, [](int n) { return mapid(n); });
    transpose_w(F, F.in[4], 256, 1024, (bf16_t*)(ws + WS_WP0), 1024, [](int n) { return mapid(n); });
    transpose_w(F, F.in[4] + (size_t)256 * 1024, 256, 1024, (bf16_t*)(ws + WS_WP1), 1024, [](int n) { return mapid(n); });
    transpose_w(F, F.in[15], 1024, 3592, (bf16_t*)(ws + WS_WIN1), LD1, [](int n) { return map1(n); });
    transpose_w(F, F.in[16], 1024, 1024, (bf16_t*)(ws + WS_WOUT1), 1024, [](int n) { return mapid(n); });
    transpose_w(F, F.in[10], 2048, 256, (bf16_t*)(ws + WS_WC1K), 256, [](int n) { return mapid(n); });
    transpose_w(F, F.in[13], 2048, 256, (bf16_t*)(ws + WS_WC1V), 256, [](int n) { return mapid(n); });
    rmsnorm_rows<0>(F, F.in[0], F.in[2], (bf16_t*)(ws + WS_BFA), nullptr);
    { const float* p = F.in[1]; bf16_t* pb = (bf16_t*)(ws + WS_PBF); const size_t n8 = (size_t)2 * MT * 256 / 8;
      for (size_t i = (size_t)F.bid * 512 + F.tid; i < n8; i += (size_t)F.G * 512) {
          const f32x4 a = *(const f32x4*)(p + i * 8), b = *(const f32x4*)(p + i * 8 + 4);
          uint4 o; o.x = pack2(a[0], a[1]); o.y = pack2(a[2], a[3]); o.z = pack2(b[0], b[1]); o.w = pack2(b[2], b[3]); *(uint4*)(pb + i * 8) = o; } }
}

DI void p2a_build_blocks(const Frame& F) {
    const bf16_t* U = (const bf16_t*)(F.ws + WS_U);
    bf16_t* AK = (bf16_t*)(F.ws + WS_AK); bf16_t* AV = (bf16_t*)(F.ws + WS_AV);
    const float* posk = F.in[9]; const float* posv = F.in[12];
    const size_t nitem = (size_t)2 * 4096 * 32 * 8;
    for (size_t it = (size_t)F.bid * 512 + F.tid; it < nitem; it += (size_t)F.G * 512) {
        const int c8 = (int)(it & 7), l = (int)((it >> 3) & 31), r = (int)((it >> 8) & 4095), which = (int)(it >> 20);
        bf16_t* dst = (which ? AV : AK) + (size_t)r * 2048 + l * 64 + c8 * 8;
        uint4 o = make_uint4(0u, 0u, 0u, 0u);
        if (r < 4080) {
            const int b = r / 510, rem = r % 510, i = rem >> 1, g = rem & 1;
            const bf16_t* sp = U + ((size_t)b * SEQ + 16 * i + l) * LD0 + (which ? C_VC : C_KC) + g * 64 + c8 * 8;
            const float* pp = (which ? posv : posk) + l * 64 + c8 * 8;
            const uint4 v = *(const uint4*)sp; float f[8]; unpack8(v, f);
            o.x = pack2(f[0] + pp[0], f[1] + pp[1]); o.y = pack2(f[2] + pp[2], f[3] + pp[3]); o.z = pack2(f[4] + pp[4], f[5] + pp[5]); o.w = pack2(f[6] + pp[6], f[7] + pp[7]);
        }
        *(uint4*)dst = o;
    }
}
DI void p2c_compress_out(const Frame& F) {
    const bf16_t* HK = (const bf16_t*)(F.ws + WS_HK); const bf16_t* HV = (const bf16_t*)(F.ws + WS_HV);
    float* KC = (float*)(F.ws + WS_KCMP); float* VC = (float*)(F.ws + WS_VCMP);
    const float* w2k = F.in[11]; const float* w2v = F.in[14];
    for (int it = F.gw; it < 2 * 16 * 256; it += F.nw) {
        const int i = it & 255, bg = (it >> 8) & 15, which = it >> 12;
        float acc = 0.f;
        if (i < NCMP) {
            const int b = bg >> 1, g = bg & 1; const int r = (b * 255 + i) * 2 + g;
            const bf16_t* hr = (which ? HV : HK) + (size_t)r * 256; const float* w2 = which ? w2v : w2k;
            for (int j = 0; j < 256; j += 8) { const uint4 hv = *(const uint4*)(hr + j); float hf[8]; unpack8(hv, hf);
#pragma unroll
                for (int q = 0; q < 8; ++q) acc += hf[q] * w2[(size_t)(j + q) * 64 + F.lane]; }
        }
        (which ? VC : KC)[((size_t)bg * 256 + i) * 64 + F.lane] = acc;
    }
}

template <int NH>
DI void dotn_bf(const bf16_t* kp, const float* qs, float (&acc)[NH]) {
#pragma unroll
    for (int h = 0; h < NH; ++h) acc[h] = 0.f;
#pragma unroll 2
    for (int c = 0; c < 8; ++c) { const uint4 v = *(const uint4*)(kp + c * 8); float kf[8]; unpack8(v, kf);
#pragma unroll
        for (int h = 0; h < NH; ++h) { const f32x4 q0 = *(const f32x4*)(qs + h * 64 + c * 8), q1 = *(const f32x4*)(qs + h * 64 + c * 8 + 4);
            acc[h] += q0[0] * kf[0] + q0[1] * kf[1] + q0[2] * kf[2] + q0[3] * kf[3] + q1[0] * kf[4] + q1[1] * kf[5] + q1[2] * kf[6] + q1[3] * kf[7]; } }
}
DI void dot4_bf(const bf16_t* kp, const float* qs, float (&acc)[4]) { dotn_bf<4>(kp, qs, acc); }
DI void dot4_f32(const float* kp, const float* qs, float (&acc)[4]) {
    acc[0] = acc[1] = acc[2] = acc[3] = 0.f;
#pragma unroll 4
    for (int c = 0; c < 16; ++c) { const f32x4 kv = *(const f32x4*)(kp + c * 4);
#pragma unroll
        for (int h = 0; h < 4; ++h) { const f32x4 q0 = *(const f32x4*)(qs + h * 64 + c * 4);
            acc[h] += q0[0] * kv[0] + q0[1] * kv[1] + q0[2] * kv[2] + q0[3] * kv[3]; } }
}

template <int NH, int HS>
DI void softmax_lds(float* ps, int nr, int lane, float (&inv)[NH]) {
#pragma unroll
    for (int h = 0; h < NH; ++h) {
        float mx = NEG_INF;
#pragma unroll 1
        for (int r = 0; r < nr; ++r) mx = fmaxf(mx, ps[h * HS + r * 64 + lane]);
        mx = wave_max(mx);
        float sm = 0.f;
#pragma unroll 1
        for (int r = 0; r < nr; ++r) { const float sv = ps[h * HS + r * 64 + lane]; const float e = sv > NEG_INF ? expf(sv - mx) : 0.f; ps[h * HS + r * 64 + lane] = e; sm += e; }
        sm = wave_sum(sm);
        inv[h] = sm > 0.f ? 1.0f / sm : 0.f;
    }
}

DI void nsa_task(const Frame& F, int b, int g, int t, float* wl) {
    int lane = F.lane; asm volatile("" : "+v"(lane)); asm volatile("" : "+v"(wl));
    const bf16_t* U = (const bf16_t*)(F.ws + WS_U);
    const float* KC = (const float*)(F.ws + WS_KCMP) + (size_t)(b * 2 + g) * 256 * 64;
    const float* VC = (const float*)(F.ws + WS_VCMP) + (size_t)(b * 2 + g) * 256 * 64;
    bf16_t* Y = (bf16_t*)(F.ws + WS_BFB);
    const size_t row = (size_t)b * SEQ + t;
    const bf16_t* Ur = U + row * LD0;
    float* qs = wl; float* ps = wl + 256;
    const LAS float* tb = F.tbl + (g * 4) * 32;
    __builtin_amdgcn_wave_barrier();
#pragma unroll
    for (int h = 0; h < 4; ++h) qs[h * 64 + lane] = bf2f(Ur[C_AQ + (g * 4 + h) * 64 + lane]);
    __builtin_amdgcn_wave_barrier();
    float oc[4] = {0.f, 0.f, 0.f, 0.f}, os[4] = {0.f, 0.f, 0.f, 0.f}, ow[4] = {0.f, 0.f, 0.f, 0.f};
    float inv[4];

    const int nv = t >= 31 ? ((t - 31) >> 4) + 1 : 0;
#pragma unroll 1
    for (int r = 0; r < 4; ++r) {
        const int i = r * 64 + lane; const bool valid = i < nv;
        float sc[4] = {NEG_INF, NEG_INF, NEG_INF, NEG_INF};
        if (r * 64 < nv) {
            float acc[4]; dot4_f32(KC + (size_t)(valid ? i : 0) * 64, qs, acc);
            if (valid) { const int bk = t5b(F, t - (16 * i + 31));
#pragma unroll
                for (int h = 0; h < 4; ++h) sc[h] = acc[h] * 0.125f + tb[h * 32 + bk]; }
        }
#pragma unroll
        for (int h = 0; h < 4; ++h) ps[h * 512 + i] = sc[h];
    }
    __builtin_amdgcn_wave_barrier();
    softmax_lds<4, 512>(ps, 4, lane, inv);
#pragma unroll 1
    for (int r = 0; r < 4; ++r) {
#pragma unroll
        for (int h = 0; h < 4; ++h) ps[h * 512 + r * 64 + lane] *= inv[h];
    }
    __builtin_amdgcn_wave_barrier();
#pragma unroll 8
    for (int i = 0; i < nv; ++i) { const float v = VC[(size_t)i * 64 + lane];
#pragma unroll
        for (int h = 0; h < 4; ++h) oc[h] += ps[h * 512 + i] * v; }
#ifndef NSA_STAGE
#define NSA_STAGE 4
#endif
    if (NSA_STAGE < 2) return;
    const int cur = t >> 6;
    unsigned long long selmask = 0ull; const int npick = (cur + 1) < 8 ? (cur + 1) : 8;
    {
        float imp = 0.f;
        const int i0 = 4 * lane - 1 < 0 ? 0 : 4 * lane - 1, i1 = 4 * lane + 3 > 254 ? 254 : 4 * lane + 3;
#pragma unroll
        for (int h = 0; h < 4; ++h) for (int i = i0; i <= i1; ++i) imp += ps[h * 512 + i];
        const bool adm = lane <= cur; const bool forced = (lane == 0) || (lane == cur) || (lane == cur - 1);
        float score = adm ? imp + (forced ? 1.0e4f : 0.f) : NEG_INF;
#pragma unroll 1
        for (int k = 0; k < npick; ++k) {
            const float mx = wave_max(score);
            const unsigned long long cand = __ballot(score == mx);
            const int j = cand ? __builtin_ctzll(cand) : 0;
            selmask |= 1ull << j;
            if (lane == j) score = NEG_INF;
        }
    }
    __builtin_amdgcn_wave_barrier();
    {
        unsigned long long m = selmask;
#pragma unroll 1
        for (int k = 0; k < npick; ++k) {
            const int j = __builtin_ctzll(m); m &= m - 1;
            const int pos = j * 64 + lane;
            float sc[4] = {NEG_INF, NEG_INF, NEG_INF, NEG_INF};
            float acc[4]; dot4_bf(U + ((size_t)b * SEQ + pos) * LD0 + C_KS + g * 64, qs, acc);
            if (pos <= t) { const int bk = t5b(F, t - pos);
#pragma unroll
                for (int h = 0; h < 4; ++h) sc[h] = acc[h] * 0.125f + tb[h * 32 + bk]; }
#pragma unroll
            for (int h = 0; h < 4; ++h) ps[h * 512 + k * 64 + lane] = sc[h];
        }
        __builtin_amdgcn_wave_barrier();
        softmax_lds<4, 512>(ps, npick, lane, inv);
        __builtin_amdgcn_wave_barrier();
        m = selmask;
#pragma unroll 1
        for (int k = 0; k < npick; ++k) {
            const int j = __builtin_ctzll(m); m &= m - 1;
            const int kend = (j * 64 + 63 <= t) ? 64 : (t - j * 64 + 1);
#pragma unroll 8
            for (int kk = 0; kk < kend; ++kk) {
                const float v = bf2f(U[((size_t)b * SEQ + j * 64 + kk) * LD0 + C_VS + g * 64 + lane]);
#pragma unroll
                for (int h = 0; h < 4; ++h) os[h] += ps[h * 512 + k * 64 + kk] * v; }
        }
#pragma unroll
        for (int h = 0; h < 4; ++h) os[h] *= inv[h];
    }
    __builtin_amdgcn_wave_barrier();
    if (NSA_STAGE < 3) return;
    {
#pragma unroll 1
        for (int r = 0; r < 8; ++r) {
            const int pos = t - 511 + r * 64 + lane;
            float sc[4] = {NEG_INF, NEG_INF, NEG_INF, NEG_INF};
            if (t - 511 + r * 64 + 63 >= 0) {
                float acc[4]; dot4_bf(U + ((size_t)b * SEQ + (pos < 0 ? 0 : pos)) * LD0 + C_KW + g * 64, qs, acc);
                if (pos >= 0) { const int bk = t5b(F, t - pos);
#pragma unroll
                    for (int h = 0; h < 4; ++h) sc[h] = acc[h] * 0.125f + tb[h * 32 + bk]; }
            }
#pragma unroll
            for (int h = 0; h < 4; ++h) ps[h * 512 + r * 64 + lane] = sc[h];
        }
        __builtin_amdgcn_wave_barrier();
        softmax_lds<4, 512>(ps, 8, lane, inv);
        __builtin_amdgcn_wave_barrier();
        const int pi0 = (t >= 511 ? 0 : 511 - t) & ~7;
#pragma unroll 8
        for (int pi = pi0; pi < 512; ++pi) {
            const int pos = t - 511 + pi;
            const float v = bf2f(U[((size_t)b * SEQ + (pos < 0 ? 0 : pos)) * LD0 + C_VW + g * 64 + lane]);
#pragma unroll
            for (int h = 0; h < 4; ++h) ow[h] += ps[h * 512 + pi] * v; }
#pragma unroll
        for (int h = 0; h < 4; ++h) ow[h] *= inv[h];
    }
    if (NSA_STAGE < 4) return;
    const float gsig = sigmoidf_(bf2f(Ur[C_AG + g * 12 + (lane < 12 ? lane : 0)]));
#pragma unroll
    for (int h = 0; h < 4; ++h) {
        const int hh = g * 4 + h;
        const float g0 = __shfl(gsig, h * 3 + 0), g1 = __shfl(gsig, h * 3 + 1), g2 = __shfl(gsig, h * 3 + 2);
        const float oa = g0 * oc[h] + g1 * os[h] + g2 * ow[h];
        const float z = bf2f(Ur[C_AZ + hh * 64 + lane]);
        Y[row * 1024 + hh * 64 + lane] = f2bf(oa * siluf_(z));
    }
    __builtin_amdgcn_wave_barrier();
}

DI unsigned okey(float x) { unsigned u = __float_as_uint(x); if ((u << 1) == 0u) u = 0u; return (u >> 31) ? ~u : (u | 0x80000000u); }

DI void dsa_task(const Frame& F, int b, int t, float* wl, unsigned* keys) {
    int lane = F.lane; asm volatile("" : "+v"(lane)); asm volatile("" : "+v"(wl)); asm volatile("" : "+v"(keys));
    const bf16_t* U = (const bf16_t*)(F.ws + WS_U);
    bf16_t* Y = (bf16_t*)(F.ws + WS_BFB);
    const size_t row = (size_t)b * SEQ + t;
    const bf16_t* Ur = U + row * LD0;
    float* qis = wl; float* qds = wl + 256; int* idx = (int*)(wl + 768); float* pb = (float*)keys;
    const LAS float* tb = F.tbl + 8 * 32;
    __builtin_amdgcn_wave_barrier();
#pragma unroll
    for (int h = 0; h < 4; ++h) qis[h * 64 + lane] = bf2f(Ur[C_BQI + h * 64 + lane]);
#pragma unroll
    for (int h = 0; h < 8; ++h) qds[h * 64 + lane] = bf2f(Ur[C_BQ + h * 64 + lane]);
    float wi[4];
#pragma unroll
    for (int h = 0; h < 4; ++h) wi[h] = bf2f(Ur[C_BWI + h]) * 0.0625f;
    __builtin_amdgcn_wave_barrier();
    const int nk = t + 1, nr = (nk + 63) >> 6;
    int nsel;
    if (nk <= 256) {
#pragma unroll 1
        for (int r = 0; r < nr; ++r) { const int s = r * 64 + lane; if (s < nk) idx[s] = s; }
        nsel = nk;
    } else {
#pragma unroll 1
        for (int r = 0; r < nr; ++r) {
            const int s = r * 64 + lane; unsigned key = 0u;
            float acc[4]; dot4_bf(U + ((size_t)b * SEQ + (s < nk ? s : t)) * LD0 + C_BKI, qis, acc);
            if (s < nk) { const float scv = wi[0] * fmaxf(acc[0], 0.f) + wi[1] * fmaxf(acc[1], 0.f) + wi[2] * fmaxf(acc[2], 0.f) + wi[3] * fmaxf(acc[3], 0.f); key = okey(scv); }
            keys[s] = key;
        }
        __builtin_amdgcn_wave_barrier();
        unsigned tau = 0u;
#pragma unroll 1
        for (int bit = 31; bit >= 0; --bit) {
            const unsigned trial = tau | (1u << bit); int cnt = 0;
#pragma unroll 8
            for (int r = 0; r < nr; ++r) cnt += keys[r * 64 + lane] >= trial ? 1 : 0;
            cnt = (int)wave_sum((float)cnt);
            if (cnt >= 256) tau = trial;
        }
        int cgt = 0;
#pragma unroll 1
        for (int r = 0; r < nr; ++r) cgt += keys[r * 64 + lane] > tau ? 1 : 0;
        cgt = (int)wave_sum((float)cgt);
        const int quota = 256 - cgt;
        int base = 0, taken = 0;
        const unsigned long long ltmask = (1ull << lane) - 1ull;
#pragma unroll 1
        for (int r = 0; r < nr; ++r) {
            const unsigned key = keys[r * 64 + lane];
            const bool eq = key == tau;
            const unsigned long long eqm = __ballot(eq);
            const int erank = __popcll(eqm & ltmask);
            const bool sel = (key > tau) || (eq && (taken + erank < quota));
            const unsigned long long sm = __ballot(sel);
            if (sel) idx[base + __popcll(sm & ltmask)] = r * 64 + lane;
            base += __popcll(sm); taken += __popcll(eqm);
        }
        nsel = 256;
    }
    __builtin_amdgcn_wave_barrier();
    const int nr2 = (nsel + 63) >> 6;
#pragma unroll 1
    for (int r = 0; r < nr2; ++r) {
        const int j = r * 64 + lane; const bool valid = j < nsel; const int s = valid ? idx[j] : 0;
        const bf16_t* kp = U + ((size_t)b * SEQ + s) * LD0 + C_BK;
        float a0[8]; dotn_bf<8>(kp, qds, a0);
        const int bk = t5b(F, valid ? t - s : 0);
#pragma unroll
        for (int h = 0; h < 8; ++h) pb[h * 256 + j] = valid ? a0[h] * 0.125f + tb[h * 32 + bk] : NEG_INF;
    }
    __builtin_amdgcn_wave_barrier();
    float inv[8];
    softmax_lds<8, 256>(pb, nr2, lane, inv);
    __builtin_amdgcn_wave_barrier();
    float ob[8] = {0.f, 0.f, 0.f, 0.f, 0.f, 0.f, 0.f, 0.f};
#pragma unroll 8
    for (int j = 0; j < nsel; ++j) {
        const int s = idx[j];
        const float v = bf2f(U[((size_t)b * SEQ + s) * LD0 + C_BV + lane]);
#pragma unroll
        for (int h = 0; h < 8; ++h) ob[h] += pb[h * 256 + j] * v;
    }
#pragma unroll
    for (int h = 0; h < 8; ++h) {
        const float z = bf2f(Ur[C_BZ + h * 64 + lane]);
        Y[row * 1024 + 512 + h * 64 + lane] = f2bf(ob[h] * inv[h] * siluf_(z));
    }
    __builtin_amdgcn_wave_barrier();
}

#ifndef ATT_NAIVE
#define ATT_NAIVE 0
#endif
#if ATT_NAIVE
DI void p3_attention(const Frame& F) {
    unsigned char* base = F.lds;
    constexpr int DSA_W = 4;
    float* wl_nsa; float* wl_dsa = nullptr; unsigned* keys = nullptr;
    if (F.wave < DSA_W) { unsigned char* R = base + F.wave * 20480; keys = (unsigned*)R; wl_dsa = (float*)(R + 16384); wl_nsa = (float*)R; }
    else wl_nsa = (float*)(base + DSA_W * 20480 + (F.wave - DSA_W) * 9216);
    unsigned* qn = F.ctl + CW_QNSA; unsigned* qd = F.ctl + CW_QDSA;
    const int NDSA = NB * SEQ, NNSA = NB * 2 * SEQ;
#ifndef ATT_MASK
#define ATT_MASK 3
#endif
    if ((ATT_MASK & 1) && F.wave < DSA_W) {
        for (;;) {
            unsigned k = 0; if (F.lane == 0) k = __hip_atomic_fetch_add(qd, 1u, __ATOMIC_RELAXED, __HIP_MEMORY_SCOPE_AGENT);
            k = __builtin_amdgcn_readfirstlane(k);
            if (k >= (unsigned)NDSA) break;
            const int t = SEQ - 1 - (int)(k >> 3), b = (int)(k & 7);
            dsa_task(F, b, t, wl_dsa, keys);
        }
    }
    if (ATT_MASK & 2) for (;;) {
        unsigned k = 0; if (F.lane == 0) k = __hip_atomic_fetch_add(qn, 1u, __ATOMIC_RELAXED, __HIP_MEMORY_SCOPE_AGENT);
        k = __builtin_amdgcn_readfirstlane(k);
        if (k >= (unsigned)NNSA) break;
        const int t = SEQ - 1 - (int)(k >> 4), bg = (int)(k & 15);
        nsa_task(F, bg >> 1, bg & 1, t, wl_nsa);
    }
}

#else
typedef float f32x16 __attribute__((ext_vector_type(16)));
#define MFMA32(a, b, c) __builtin_amdgcn_mfma_f32_32x32x16_bf16((a), (b), (c), 0, 0, 0)
constexpr float LOG2E = 1.4426950408889634f;
constexpr float QK_C1 = 0.125f * LOG2E;
constexpr int AT_BUF = 0;
constexpr int AT_PSUM = 32768;
constexpr int AT_SELM = AT_PSUM + 65536;
constexpr int AT_MISC = AT_SELM + 1024;
constexpr int AT_END = AT_MISC + 256;
static_assert(AT_END + LDS_WORK_OFF <= LDS_BYTES - 12288, "attention lds");
enum { FL_NEAR = 1, FL_CAUSAL = 2, FL_WINLO = 4, FL_BITS = 8, FL_LANE = 16 };

struct Att { float m, l; f32x16 o0, o1; };
DI void att_init(Att& a) { a.m = NEG_INF; a.l = 0.f;
#pragma unroll
    for (int i = 0; i < 16; ++i) { a.o0[i] = 0.f; a.o1[i] = 0.f; } }

typedef unsigned u32x4 __attribute__((ext_vector_type(4)));
#define OPAQUE(x) asm volatile("" : "+v"(x))
DI void st_write_K(LAS unsigned char* Kt, int tid, const uint4& rg) {
    OPAQUE(tid);
    const int key = tid >> 3, c = tid & 7;
    const u32x4 v = {rg.x, rg.y, rg.z, rg.w};
    *(LAS u32x4*)(Kt + key * 128 + ((c ^ (key & 7)) << 4)) = v;
}
DI void st_write_VT(LAS unsigned char* Vt, int tid, const uint4& rg) {
    OPAQUE(tid);
    const int key = tid >> 3, dc = tid & 7;
    const int G = key >> 4, u = key & 15, a = (u >> 3) & 1, hh = (u >> 2) & 1, i = u & 3;
    const int cc = 2 * G + hh, e = 4 * a + i;
    const unsigned w[4] = {rg.x, rg.y, rg.z, rg.w};
#pragma unroll
    for (int jj = 0; jj < 8; ++jj) { const int d = dc * 8 + jj; const unsigned short val = (unsigned short)((jj & 1) ? (w[jj >> 1] >> 16) : (w[jj >> 1] & 0xFFFFu));
        *(LAS unsigned short*)(Vt + d * 128 + ((cc ^ ((d >> 1) & 7)) << 4) + e * 2) = val; }
}
DI void qk_tile(const LAS unsigned char* Kt, const bf16x8 (&qf)[4], int r, int hf, f32x16& s0, f32x16& s1) {
    OPAQUE(r); OPAQUE(hf);
#pragma unroll
    for (int i = 0; i < 16; ++i) { s0[i] = 0.f; s1[i] = 0.f; }
#pragma unroll
    for (int s = 0; s < 4; ++s) {
        const int c = 2 * s + hf;
        const bf16x8 a0 = *(const LAS bf16x8*)(Kt + r * 128 + ((c ^ (r & 7)) << 4));
        const bf16x8 a1 = *(const LAS bf16x8*)(Kt + (32 + r) * 128 + ((c ^ (r & 7)) << 4));
        s0 = MFMA32(a0, qf[s], s0); s1 = MFMA32(a1, qf[s], s1);
    }
}
template <int FLAGS>
DI void fix_scores(f32x16& s, int posb, int kstep, int tq, const LAS float* bl, float bfar, unsigned mword, bool laneok, int hf) {
    OPAQUE(hf); OPAQUE(tq);
#pragma unroll
    for (int i = 0; i < 16; ++i) {
        const int koff = (i & 3) + 8 * (i >> 2) + 4 * hf;
        const int dist = tq - (posb + kstep * koff);
        float bias = bfar;
        if (FLAGS & FL_NEAR) { int dd = dist < 0 ? 0 : dist; dd = dd > 127 ? 127 : dd; bias = bl[dd]; }
        const float v = s[i] * QK_C1 + bias;
        bool ok = true;
        if (FLAGS & FL_CAUSAL) ok = ok && (dist >= 0);
        if (FLAGS & FL_WINLO) ok = ok && (dist < 512);
        if (FLAGS & FL_BITS) ok = ok && (((mword >> koff) & 1u) != 0u);
        if (FLAGS & FL_LANE) ok = ok && laneok;
        s[i] = ok ? v : NEG_INF;
    }
}
DI bf16x8 pack8(const f32x16& x, int s) {
    typedef unsigned u32x4 __attribute__((ext_vector_type(4)));
    u32x4 p;
    p[0] = pack2(x[8 * s + 0], x[8 * s + 1]); p[1] = pack2(x[8 * s + 2], x[8 * s + 3]); p[2] = pack2(x[8 * s + 4], x[8 * s + 5]); p[3] = pack2(x[8 * s + 6], x[8 * s + 7]);
    return __builtin_bit_cast(bf16x8, p);
}
DI void pv_tile(const LAS unsigned char* Vt, const f32x16& p0, const f32x16& p1, int r, int hf, f32x16& o0, f32x16& o1) {
    OPAQUE(r); OPAQUE(hf);
#pragma unroll
    for (int G = 0; G < 4; ++G) {
        const bf16x8 pb = pack8((G >> 1) ? p1 : p0, G & 1);
        const int cc = 2 * G + hf;
        const bf16x8 a0 = *(const LAS bf16x8*)(Vt + r * 128 + ((cc ^ ((r >> 1) & 7)) << 4));
        const bf16x8 a1 = *(const LAS bf16x8*)(Vt + (32 + r) * 128 + ((cc ^ ((r >> 1) & 7)) << 4));
        o0 = MFMA32(a0, pb, o0); o1 = MFMA32(a1, pb, o1);
    }
}
DI void online_pv(Att& st, f32x16& s0, f32x16& s1, const LAS unsigned char* Vt, int r, int hf) {
    float tm = NEG_INF;
#pragma unroll
    for (int i = 0; i < 16; ++i) tm = fmaxf(tm, fmaxf(s0[i], s1[i]));
    tm = fmaxf(tm, __shfl_xor(tm, 32));
    const float mn = fmaxf(st.m, tm);
    const float mu = (mn == NEG_INF) ? 0.f : mn;
    const float alpha = __builtin_amdgcn_exp2f(st.m - mu);
    float ls = 0.f;
#pragma unroll
    for (int i = 0; i < 16; ++i) { s0[i] = __builtin_amdgcn_exp2f(s0[i] - mu); s1[i] = __builtin_amdgcn_exp2f(s1[i] - mu); ls += s0[i] + s1[i]; }
    st.l = st.l * alpha + ls; st.m = mn;
#pragma unroll
    for (int i = 0; i < 16; ++i) { st.o0[i] *= alpha; st.o1[i] *= alpha; }
    pv_tile(Vt, s0, s1, r, hf, st.o0, st.o1);
}
template <class LD, class BODY>
DI void tile_stream(int n, LAS unsigned char* buf, int tid, bool useV, LD ld, BODY body) {
    if (n <= 0) return;
    uint4 rk, rv = make_uint4(0u, 0u, 0u, 0u);
    ld(0, rk, rv);
    st_write_K(buf, tid, rk); if (useV) st_write_VT(buf + 8192, tid, rv);
    if (n > 1) ld(1, rk, rv);
    __syncthreads();
#pragma unroll 1
    for (int i = 0; i < n; ++i) {
        LAS unsigned char* cur = buf + (i & 1) * 16384;
        body(i, cur, cur + 8192);
        if (i + 1 < n) { LAS unsigned char* nxt = buf + ((i + 1) & 1) * 16384; st_write_K(nxt, tid, rk); if (useV) st_write_VT(nxt + 8192, tid, rv); if (i + 2 < n) ld(i + 2, rk, rv); }
        __syncthreads();
    }
}
DI uint4 cvt8_f32(const float* p) { const f32x4 a = *(const f32x4*)p, b = *(const f32x4*)(p + 4); uint4 o; o.x = pack2(a[0], a[1]); o.y = pack2(a[2], a[3]); o.z = pack2(b[0], b[1]); o.w = pack2(b[2], b[3]); return o; }

DI void nsa_unit(const Frame& F, int b, int g, int qb) {
    const int tid = F.tid, lane = F.lane, w = F.wave, r = lane & 31, hf = lane >> 5;
    LAS unsigned char* L = F.ldsl;
    LAS unsigned char* buf = L + AT_BUF;
    LAS float* psum = (LAS float*)(L + AT_PSUM);
    LAS unsigned long long* selm = (LAS unsigned long long*)(L + AT_SELM);
    LAS unsigned char* tlist = L + AT_SELM + 528;
    LAS int* tcnt = (LAS int*)(L + AT_SELM + 520);
    const bf16_t* U = (const bf16_t*)(F.ws + WS_U);
    const float* KC = (const float*)(F.ws + WS_KCMP) + (size_t)(b * 2 + g) * 256 * 64;
    const float* VC = (const float*)(F.ws + WS_VCMP) + (size_t)(b * 2 + g) * 256 * 64;
    bf16_t* Y = (bf16_t*)(F.ws + WS_BFB);
    const int t0 = qb * 64;
    const int ql = r >> 2, h = r & 3, hh = g * 4 + h;
    const int tq = t0 + 8 * w + ql;
    const size_t row = (size_t)b * SEQ + tq;
    const bf16_t* Ur = U + row * LD0;
    bf16x8 qf[4];
#pragma unroll
    for (int s = 0; s < 4; ++s) qf[s] = *(const bf16x8*)(Ur + C_AQ + hh * 64 + 16 * s + 8 * hf);
    const LAS float* bl = F.biasL + hh * 128; const float bfar = bl[127];
    float gate[3];
    { const unsigned* gp = (const unsigned*)(Ur + C_AG);
#pragma unroll
      for (int j = 0; j < 3; ++j) { const int e = hh * 3 + j; const unsigned wv = gp[e >> 1]; gate[j] = sigmoidf_((e & 1) ? __uint_as_float(wv & 0xFFFF0000u) : __uint_as_float(wv << 16)); } }
    LAS float* opark = psum + w * 2048 + lane;

    const int nvmax = ((t0 + 63 - 31) >> 4) + 1;
    const int ntc = (nvmax + 63) >> 6;
    for (int e = tid; e < 64 * 256; e += 512) psum[e] = 0.f;
    float cm = NEG_INF, cl = 0.f;
    {
        auto ldc = [&](int i, uint4& rk, uint4& rv) { const int key = tid >> 3, c = tid & 7; rk = cvt8_f32(KC + (size_t)(i * 64 + key) * 64 + c * 8); (void)rv; };
        auto body = [&](int i, LAS unsigned char* Kt, LAS unsigned char* Vt) { (void)Vt;
            f32x16 s0, s1; qk_tile(Kt, qf, r, hf, s0, s1);
            fix_scores<FL_NEAR | FL_CAUSAL>(s0, 16 * (i * 64) + 31, 16, tq, bl, bfar, 0u, true, hf);
            fix_scores<FL_NEAR | FL_CAUSAL>(s1, 16 * (i * 64 + 32) + 31, 16, tq, bl, bfar, 0u, true, hf);
            float tm = NEG_INF;
#pragma unroll
            for (int k = 0; k < 16; ++k) tm = fmaxf(tm, fmaxf(s0[k], s1[k]));
            tm = fmaxf(tm, __shfl_xor(tm, 32));
            const float mn = fmaxf(cm, tm); const float mu = (mn == NEG_INF) ? 0.f : mn;
            float ls = 0.f;
#pragma unroll
            for (int k = 0; k < 16; ++k) ls += __builtin_amdgcn_exp2f(s0[k] - mu) + __builtin_amdgcn_exp2f(s1[k] - mu);
            cl = cl * __builtin_amdgcn_exp2f(cm - mu) + ls; cm = mn; };
        tile_stream(ntc, buf, tid, false, ldc, body);
    }
    f32x16 c0, c1;
    {
        cl += __shfl_xor(cl, 32);
        const float cinv = cl > 0.f ? 1.0f / cl : 0.f; const float cmu = (cm == NEG_INF) ? 0.f : cm;
#pragma unroll
        for (int i = 0; i < 16; ++i) { c0[i] = 0.f; c1[i] = 0.f; }
        auto ldc = [&](int i, uint4& rk, uint4& rv) { const int key = tid >> 3, c = tid & 7; rk = cvt8_f32(KC + (size_t)(i * 64 + key) * 64 + c * 8); rv = cvt8_f32(VC + (size_t)(i * 64 + key) * 64 + c * 8); };
        auto body = [&](int i, LAS unsigned char* Kt, LAS unsigned char* Vt) {
            f32x16 s0, s1; qk_tile(Kt, qf, r, hf, s0, s1);
            fix_scores<FL_NEAR | FL_CAUSAL>(s0, 16 * (i * 64) + 31, 16, tq, bl, bfar, 0u, true, hf);
            fix_scores<FL_NEAR | FL_CAUSAL>(s1, 16 * (i * 64 + 32) + 31, 16, tq, bl, bfar, 0u, true, hf);
#pragma unroll
            for (int k = 0; k < 16; ++k) { s0[k] = __builtin_amdgcn_exp2f(s0[k] - cmu) * cinv; s1[k] = __builtin_amdgcn_exp2f(s1[k] - cmu) * cinv; }
#pragma unroll
            for (int k = 0; k < 16; ++k) {
                float a0 = s0[k], a1 = s1[k];
                a0 += __shfl_xor(a0, 1); a0 += __shfl_xor(a0, 2); a1 += __shfl_xor(a1, 1); a1 += __shfl_xor(a1, 2);
                const int koff = (k & 3) + 8 * (k >> 2) + 4 * hf;
                if (h == 0) { psum[(8 * w + ql) * 256 + i * 64 + koff] = a0; psum[(8 * w + ql) * 256 + i * 64 + 32 + koff] = a1; }
            }
            pv_tile(Vt, s0, s1, r, hf, c0, c1); };
        tile_stream(ntc, buf, tid, true, ldc, body);
    }
    {
        const int cur = qb; const int npick = (cur + 1) < 8 ? (cur + 1) : 8;
#pragma unroll 1
        for (int q = 0; q < 8; ++q) {
            const LAS float* pr = psum + (8 * w + q) * 256;
            float imp = 0.f;
            const int i0 = 4 * lane - 1 < 0 ? 0 : 4 * lane - 1, i1 = 4 * lane + 3 > 254 ? 254 : 4 * lane + 3;
            for (int i = i0; i <= i1; ++i) imp += pr[i];
            const bool adm = lane <= cur; const bool forced = (lane == 0) || (lane == cur) || (lane == cur - 1);
            float score = adm ? imp + (forced ? 1.0e4f : 0.f) : NEG_INF;
            unsigned long long sm = 0ull;
#pragma unroll 1
            for (int k = 0; k < npick; ++k) {
                const float mx = wave_max(score);
                const unsigned long long cand = __ballot(score == mx);
                const int j = cand ? __builtin_ctzll(cand) : 0;
                sm |= 1ull << j;
                if (lane == j) score = NEG_INF;
            }
            if (lane == 0) selm[8 * w + q] = sm;
        }
    }
    __syncthreads();
    if (w == 0) {
        unsigned long long m = selm[lane];
        unsigned lo = (unsigned)m, hi = (unsigned)(m >> 32);
        for (int o = 32; o >= 1; o >>= 1) { lo |= __shfl_xor(lo, o); hi |= __shfl_xor(hi, o); }
        const unsigned long long un = ((unsigned long long)hi << 32) | lo;
        const bool mine = (un >> lane) & 1ull;
        const int pos = __popcll(un & ((1ull << lane) - 1ull));
        if (mine) tlist[pos] = (unsigned char)lane;
        if (lane == 0) tcnt[0] = __popcll(un);
    }
    __syncthreads();
#pragma unroll
    for (int i = 0; i < 16; ++i) { opark[i * 64] = gate[0] * c0[i]; opark[(16 + i) * 64] = gate[0] * c1[i]; }
    const unsigned long long mysel = selm[8 * w + ql];
    {
        Att st; att_init(st);
        const int nts = tcnt[0];
        auto lds_ = [&](int i, uint4& rk, uint4& rv) { const int j = tlist[i]; const int key = tid >> 3, c = tid & 7;
            const bf16_t* p = U + ((size_t)b * SEQ + j * 64 + key) * LD0 + g * 64 + c * 8; rk = *(const uint4*)(p + C_KS); rv = *(const uint4*)(p + C_VS); };
        auto body = [&](int i, LAS unsigned char* Kt, LAS unsigned char* Vt) {
            const int j = tlist[i];
            const bool laneok = (mysel >> j) & 1ull;
            if (__ballot(laneok) == 0ull) return;
            f32x16 s0, s1; qk_tile(Kt, qf, r, hf, s0, s1);
            if (j >= qb - 2) { fix_scores<FL_NEAR | FL_CAUSAL | FL_LANE>(s0, j * 64, 1, tq, bl, bfar, 0u, laneok, hf); fix_scores<FL_NEAR | FL_CAUSAL | FL_LANE>(s1, j * 64 + 32, 1, tq, bl, bfar, 0u, laneok, hf); }
            else { fix_scores<FL_LANE>(s0, j * 64, 1, tq, bl, bfar, 0u, laneok, hf); fix_scores<FL_LANE>(s1, j * 64 + 32, 1, tq, bl, bfar, 0u, laneok, hf); }
            online_pv(st, s0, s1, Vt, r, hf); };
        tile_stream(nts, buf, tid, true, lds_, body);
        float l = st.l + __shfl_xor(st.l, 32);
        const float sc = l > 0.f ? gate[1] / l : 0.f;
#pragma unroll
        for (int i = 0; i < 16; ++i) { opark[i * 64] += sc * st.o0[i]; opark[(16 + i) * 64] += sc * st.o1[i]; }
    }
    {
        Att st; att_init(st);
        const int j0 = qb - 8 < 0 ? 0 : qb - 8; const int ntw = qb - j0 + 1;
        auto ldw = [&](int i, uint4& rk, uint4& rv) { const int j = j0 + i; const int key = tid >> 3, c = tid & 7;
            const bf16_t* p = U + ((size_t)b * SEQ + j * 64 + key) * LD0 + g * 64 + c * 8; rk = *(const uint4*)(p + C_KW); rv = *(const uint4*)(p + C_VW); };
        auto body = [&](int i, LAS unsigned char* Kt, LAS unsigned char* Vt) {
            const int j = j0 + i;
            f32x16 s0, s1; qk_tile(Kt, qf, r, hf, s0, s1);
            if (j >= qb - 2) { fix_scores<FL_NEAR | FL_CAUSAL>(s0, j * 64, 1, tq, bl, bfar, 0u, true, hf); fix_scores<FL_NEAR | FL_CAUSAL>(s1, j * 64 + 32, 1, tq, bl, bfar, 0u, true, hf); }
            else if (j == qb - 8) { fix_scores<FL_WINLO>(s0, j * 64, 1, tq, bl, bfar, 0u, true, hf); fix_scores<FL_WINLO>(s1, j * 64 + 32, 1, tq, bl, bfar, 0u, true, hf); }
            else { fix_scores<0>(s0, j * 64, 1, tq, bl, bfar, 0u, true, hf); fix_scores<0>(s1, j * 64 + 32, 1, tq, bl, bfar, 0u, true, hf); }
            online_pv(st, s0, s1, Vt, r, hf); };
        tile_stream(ntw, buf, tid, true, ldw, body);
        float l = st.l + __shfl_xor(st.l, 32);
        const float sc = l > 0.f ? gate[2] / l : 0.f;
#pragma unroll
        for (int i = 0; i < 16; ++i) { c0[i] = opark[i * 64] + sc * st.o0[i]; c1[i] = opark[(16 + i) * 64] + sc * st.o1[i]; }
    }
#pragma unroll
    for (int dh = 0; dh < 2; ++dh)
#pragma unroll
        for (int k = 0; k < 4; ++k) {
            const int d = 32 * dh + 8 * k + 4 * hf;
            const uint2 zz = *(const uint2*)(Ur + C_AZ + hh * 64 + d);
            const float z0 = __uint_as_float(zz.x << 16), z1 = __uint_as_float(zz.x & 0xFFFF0000u), z2 = __uint_as_float(zz.y << 16), z3 = __uint_as_float(zz.y & 0xFFFF0000u);
            const f32x16& o = dh ? c1 : c0;
            uint2 pk; pk.x = pack2(o[4 * k + 0] * siluf_(z0), o[4 * k + 1] * siluf_(z1)); pk.y = pack2(o[4 * k + 2] * siluf_(z2), o[4 * k + 3] * siluf_(z3));
            *(uint2*)(Y + row * 1024 + hh * 64 + d) = pk;
        }
    __syncthreads();
}

DI unsigned short okey16(float x) {
    const _Float16 hx = (_Float16)x; unsigned short u = __builtin_bit_cast(unsigned short, hx);
    if ((u & 0x7FFFu) == 0u) u = 0u;
    return (u & 0x8000u) ? (unsigned short)~u : (unsigned short)(u | 0x8000u);
}
DI void dsa_unit(const Frame& F, int b, int qt) {
    const int tid = F.tid, lane = F.lane, w = F.wave, r = lane & 31, hf = lane >> 5, fr = lane & 15, fq = lane >> 4;
    LAS unsigned char* L = F.ldsl;
    LAS unsigned char* buf = L + AT_BUF;
    LAS unsigned* mask = (LAS unsigned*)(L + AT_PSUM);
    const bf16_t* U = (const bf16_t*)(F.ws + WS_U);
    bf16_t* Y = (bf16_t*)(F.ws + WS_BFB);
    unsigned short* KS = (unsigned short*)(F.ws + WS_BFA) + (size_t)F.bid * 32 * 4096;
    const int t0 = qt * 32;
    const int nt = ((t0 + 31) >> 6) + 1;
    {
        bf16x8 qi[2]; float wi[4];
        { const bf16_t* Uq = U + ((size_t)b * SEQ + t0 + 4 * w + (fr >> 2)) * LD0;
#pragma unroll
          for (int ks = 0; ks < 2; ++ks) qi[ks] = *(const bf16x8*)(Uq + C_BQI + (fr & 3) * 64 + 32 * ks + 8 * fq);
          const uint2 wv = *(const uint2*)(U + ((size_t)b * SEQ + t0 + 4 * w + fq) * LD0 + C_BWI);
          wi[0] = __uint_as_float(wv.x << 16) * 0.0625f; wi[1] = __uint_as_float(wv.x & 0xFFFF0000u) * 0.0625f; wi[2] = __uint_as_float(wv.y << 16) * 0.0625f; wi[3] = __uint_as_float(wv.y & 0xFFFF0000u) * 0.0625f; }
        const int tqi = t0 + 4 * w + fq;
        auto ldi = [&](int i, uint4& rk, uint4& rv) { const int key = tid >> 3, c = tid & 7; rk = *(const uint4*)(U + ((size_t)b * SEQ + i * 64 + key) * LD0 + C_BKI + c * 8); (void)rv; };
        auto body = [&](int i, LAS unsigned char* Kt, LAS unsigned char* Vt) { (void)Vt;
#pragma unroll
            for (int kg = 0; kg < 4; ++kg) {
                const int kk = 16 * kg + fr;
                f32x4 acc = {0.f, 0.f, 0.f, 0.f};
#pragma unroll
                for (int ks = 0; ks < 2; ++ks) { const int c = 4 * ks + fq;
                    const bf16x8 kb = *(const LAS bf16x8*)(Kt + kk * 128 + ((c ^ (kk & 7)) << 4));
                    acc = __builtin_amdgcn_mfma_f32_16x16x32_bf16(qi[ks], kb, acc, 0, 0, 0); }
                const float sc = wi[0] * fmaxf(acc[0], 0.f) + wi[1] * fmaxf(acc[1], 0.f) + wi[2] * fmaxf(acc[2], 0.f) + wi[3] * fmaxf(acc[3], 0.f);
                const int pos = i * 64 + kk;
                KS[(size_t)(4 * w + fq) * 4096 + pos] = pos <= tqi ? okey16(sc) : (unsigned short)0;
            } };
        tile_stream(nt, buf, tid, false, ldi, body);
    }
    asm volatile("s_waitcnt vmcnt(0)" ::: "memory");
    __syncthreads();
    __builtin_amdgcn_fence(__ATOMIC_ACQUIRE, "agent");
    asm volatile("s_waitcnt vmcnt(0)" ::: "memory");
#pragma unroll 1
    for (int q = 0; q < 4; ++q) {
        const int qq = 4 * w + q; const int tqq = t0 + qq; const int nk = tqq + 1;
        const unsigned short* kq = KS + (size_t)qq * 4096;
        uint4 kv[8];
#pragma unroll
        for (int c = 0; c < 8; ++c) { kv[c] = make_uint4(0u, 0u, 0u, 0u); if (c * 512 < nk) kv[c] = *(const uint4*)(kq + c * 512 + lane * 8); }
#pragma unroll
        for (int c = 0; c < 8; ++c) { unsigned* wv = (unsigned*)&kv[c]; (void)wv; }
        unsigned kw[32];
#pragma unroll
        for (int c = 0; c < 8; ++c) { kw[4 * c] = kv[c].x; kw[4 * c + 1] = kv[c].y; kw[4 * c + 2] = kv[c].z; kw[4 * c + 3] = kv[c].w; }
#pragma unroll
        for (int e = 0; e < 32; ++e) { const int idx = (e >> 2) * 512 + lane * 8 + (e & 3) * 2;
            unsigned lo = kw[e] & 0xFFFFu, hi = kw[e] >> 16; if (idx >= nk) lo = 0u; if (idx + 1 >= nk) hi = 0u; kw[e] = lo | (hi << 16); }
        unsigned tau = 0u; int quota = 0;
        const bool all = nk <= 256;
        if (!all) {
#pragma unroll 1
            for (int bit = 15; bit >= 0; --bit) {
                const unsigned trial = tau | (1u << bit); int cnt = 0;
#pragma unroll
                for (int e = 0; e < 32; ++e) cnt += ((kw[e] & 0xFFFFu) >= trial ? 1 : 0) + ((kw[e] >> 16) >= trial ? 1 : 0);
                cnt = (int)wave_sum((float)cnt);
                if (cnt >= 256) tau = trial;
            }
            int cgt = 0;
#pragma unroll
            for (int e = 0; e < 32; ++e) cgt += ((kw[e] & 0xFFFFu) > tau ? 1 : 0) + ((kw[e] >> 16) > tau ? 1 : 0);
            cgt = (int)wave_sum((float)cgt);
            quota = 256 - cgt;
        }
        int taken = 0;
#pragma unroll
        for (int c = 0; c < 8; ++c) {
            unsigned eqb = 0u, gtb = 0u;
#pragma unroll
            for (int e = 0; e < 8; ++e) { const unsigned k16 = (e & 1) ? (kw[4 * c + (e >> 1)] >> 16) : (kw[4 * c + (e >> 1)] & 0xFFFFu);
                const int idx = c * 512 + lane * 8 + e;
                if (all) { if (idx < nk) gtb |= 1u << e; } else { if (k16 > tau) gtb |= 1u << e; else if (k16 == tau) eqb |= 1u << e; } }
            unsigned selb = gtb;
            if (!all) {
                const int ne = __popc(eqb);
                int pre = ne;
                for (int o = 1; o < 64; o <<= 1) { const int nn = __shfl_up(pre, o); if (lane >= o) pre += nn; }
                int rank = taken + pre - ne;
#pragma unroll
                for (int e = 0; e < 8; ++e) if ((eqb >> e) & 1u) { if (rank < quota) selb |= 1u << e; ++rank; }
                taken += __shfl(pre, 63);
            }
            unsigned wv = selb << (8 * (lane & 3));
            wv |= __shfl_xor(wv, 1); wv |= __shfl_xor(wv, 2);
            if ((lane & 3) == 0) mask[qq * 128 + c * 16 + (lane >> 2)] = wv;
        }
    }
    __syncthreads();
    {
        const int ql = r >> 3, h = r & 7;
        const int tq = t0 + 4 * w + ql;
        const size_t row = (size_t)b * SEQ + tq;
        const bf16_t* Ur = U + row * LD0;
        bf16x8 qf[4];
#pragma unroll
        for (int s = 0; s < 4; ++s) qf[s] = *(const bf16x8*)(Ur + C_BQ + h * 64 + 16 * s + 8 * hf);
        const LAS float* bl = F.biasL + (8 + h) * 128; const float bfar = bl[127];
        const LAS unsigned* mq = mask + (4 * w + ql) * 128;
        Att st; att_init(st);
        auto lda = [&](int i, uint4& rk, uint4& rv) { const int key = tid >> 3, c = tid & 7;
            const bf16_t* p = U + ((size_t)b * SEQ + i * 64 + key) * LD0 + c * 8; rk = *(const uint4*)(p + C_BK); rv = *(const uint4*)(p + C_BV); };
        auto body = [&](int i, LAS unsigned char* Kt, LAS unsigned char* Vt) {
            const unsigned m0 = mq[2 * i], m1 = mq[2 * i + 1];
            f32x16 s0, s1; qk_tile(Kt, qf, r, hf, s0, s1);
            if (i >= nt - 4) { fix_scores<FL_NEAR | FL_CAUSAL | FL_BITS>(s0, i * 64, 1, tq, bl, bfar, m0, true, hf); fix_scores<FL_NEAR | FL_CAUSAL | FL_BITS>(s1, i * 64 + 32, 1, tq, bl, bfar, m1, true, hf); }
            else { fix_scores<FL_BITS>(s0, i * 64, 1, tq, bl, bfar, m0, true, hf); fix_scores<FL_BITS>(s1, i * 64 + 32, 1, tq, bl, bfar, m1, true, hf); }
            online_pv(st, s0, s1, Vt, r, hf); };
        tile_stream(nt, buf, tid, true, lda, body);
        float l = st.l + __shfl_xor(st.l, 32);
        const float sc = l > 0.f ? 1.0f / l : 0.f;
#pragma unroll
        for (int dh = 0; dh < 2; ++dh)
#pragma unroll
            for (int k = 0; k < 4; ++k) {
                const int d = 32 * dh + 8 * k + 4 * hf;
                const uint2 zz = *(const uint2*)(Ur + C_BZ + h * 64 + d);
                const float z0 = __uint_as_float(zz.x << 16), z1 = __uint_as_float(zz.x & 0xFFFF0000u), z2 = __uint_as_float(zz.y << 16), z3 = __uint_as_float(zz.y & 0xFFFF0000u);
                const f32x16& o = dh ? st.o1 : st.o0;
                uint2 pk; pk.x = pack2(o[4 * k + 0] * sc * siluf_(z0), o[4 * k + 1] * sc * siluf_(z1)); pk.y = pack2(o[4 * k + 2] * sc * siluf_(z2), o[4 * k + 3] * sc * siluf_(z3));
                *(uint2*)(Y + row * 1024 + 512 + h * 64 + d) = pk;
            }
    }
    __syncthreads();
}

DI void p3_attention(const Frame& F) {
    LAS int* ub = (LAS int*)(F.ldsl + AT_MISC);
    unsigned* qn = F.ctl + CW_QNSA; unsigned* qd = F.ctl + CW_QDSA;
    const int NDSA = NB * (SEQ / 32), NNSA = NB * 2 * (SEQ / 64);
#ifndef ATT_MASK
#define ATT_MASK 3
#endif
    if (ATT_MASK & 1) for (;;) {
        __syncthreads();
        if (F.tid == 0) ub[0] = (int)__hip_atomic_fetch_add(qd, 1u, __ATOMIC_RELAXED, __HIP_MEMORY_SCOPE_AGENT);
        __syncthreads();
        const int k = ub[0];
        if (k >= NDSA) break;
        dsa_unit(F, k & 7, (SEQ / 32) - 1 - (k >> 3));
    }
    if (ATT_MASK & 2) for (;;) {
        __syncthreads();
        if (F.tid == 0) ub[0] = (int)__hip_atomic_fetch_add(qn, 1u, __ATOMIC_RELAXED, __HIP_MEMORY_SCOPE_AGENT);
        __syncthreads();
        const int k = ub[0];
        if (k >= NNSA) break;
        const int bg = k & 15;
        nsa_unit(F, bg >> 1, bg & 1, 63 - (k >> 4));
    }
}
#endif

DI f32x4 mma16(const bf16_t* A, int lda, const bf16_t* Bt, int ldb, int K, int lane) {
    const int fr = lane & 15, fq = lane >> 4;
    f32x4 acc = {0.f, 0.f, 0.f, 0.f};
    for (int k = 0; k < K; k += 32) {
        const bf16x8 a = *(const bf16x8*)(A + fr * lda + k + fq * 8);
        const bf16x8 b = *(const bf16x8*)(Bt + fr * ldb + k + fq * 8);
        acc = __builtin_amdgcn_mfma_f32_16x16x32_bf16(a, b, acc, 0, 0, 0);
    }
    return acc;
}
DI void conv8(const bf16_t* U1, int b, int t, int col, const float* cw  , int nch, const float* cb, float (&y)[8]) {
#pragma unroll
    for (int i = 0; i < 8; ++i) y[i] = cb[i];
#pragma unroll
    for (int j = 0; j < 4; ++j) { const int tt = t - 3 + j;
        if (tt >= 0) { const uint4 v = *(const uint4*)(U1 + ((size_t)b * SEQ + tt) * LD1 + col); float f[8]; unpack8(v, f);
#pragma unroll
            for (int i = 0; i < 8; ++i) y[i] += cw[(size_t)j * nch + i] * f[i]; } }
}
DI void mlstm_gates(const Frame& F, const bf16_t* U1, int b, int h, int c, float* li, float* bc) {
    if (F.wave == 0) {
        const size_t row = (size_t)b * SEQ + c * 64 + F.lane;
        const float ip = bf2f(U1[row * LD1 + C_DI + h]) + F.in[26][h];
        const float fp = bf2f(U1[row * LD1 + C_DF + h]) + F.in[27][h];
        const float lf = fminf(fp, 0.f) - log1pf(expf(-fabsf(fp)));
        float cs = lf;
        for (int o = 1; o < 64; o <<= 1) { const float n = __shfl_up(cs, o); if (F.lane >= o) cs += n; }
        li[F.lane] = ip; bc[F.lane] = cs;
    }
    __syncthreads();
}
constexpr int ML_LI = 0, ML_BC = 256, ML_WK = 512, ML_MT = 768, ML_DQ = 1024, ML_RS = 1280, ML_NIN = 1536, ML_Q = 2048, ML_K = ML_Q + 64 * 136 * 2, ML_VT = ML_K + 64 * 136 * 2,
              ML_CT = ML_VT + 128 * 72 * 2, ML_W = ML_CT + 128 * 136 * 2, ML_KT = ML_W + 64 * 72 * 2, ML_END = ML_KT + 128 * 72 * 2;
static_assert(ML_END + LDS_WORK_OFF <= LDS_BYTES, "mlstm lds");

DI void p8a_mlstm_local(const Frame& F) {
    const bf16_t* U1 = (const bf16_t*)(F.ws + WS_U);
    bf16_t* ST = (bf16_t*)(F.ws + WS_BFB);
    float* zloc = (float*)(F.ws + WS_ZLOC); float* scal = (float*)(F.ws + WS_SCAL);
    unsigned char* L = F.lds;
    float* li = (float*)(L + ML_LI); float* bc = (float*)(L + ML_BC); float* wk = (float*)(L + ML_WK);
    bf16_t* kT = (bf16_t*)(L + ML_KT); bf16_t* vT = (bf16_t*)(L + ML_VT);
    const float* cw = F.in[24]; const float* cb = F.in[25];
    for (int unit = F.bid; unit < 2048; unit += F.G) {
        const int c = unit & 63, h = (unit >> 6) & 3, b = unit >> 8;
        mlstm_gates(F, U1, b, h, c, li, bc);
        if (F.wave == 0) {
            const float bl = bc[63]; const float dec = bl - bc[F.lane] + li[F.lane];
            const float dmx = wave_max(dec);
            wk[F.lane] = expf(dec - dmx);
            if (F.lane == 0) { scal[unit] = bl; scal[2048 + unit] = dmx; }
        }
        __syncthreads();
        for (int it = F.tid; it < 1024; it += 512) {
            const int s = it >> 4, d0 = (it & 15) * 8; const int t = c * 64 + s;
            float y[8]; conv8(U1, b, t, C_DK + h * 128 + d0, cw + 512 + h * 128 + d0, 1024, cb + 512 + h * 128 + d0, y);
            const float w = wk[s] * 0.08838834764831845f;
#pragma unroll
            for (int i = 0; i < 8; ++i) kT[(d0 + i) * 72 + s] = f2bf(siluf_(y[i]) * w);
            const uint4 vv = *(const uint4*)(U1 + ((size_t)b * SEQ + t) * LD1 + C_DV + h * 128 + d0); float vf[8]; unpack8(vv, vf);
#pragma unroll
            for (int i = 0; i < 8; ++i) vT[(d0 + i) * 72 + s] = f2bf(vf[i]);
        }
        __syncthreads();
        for (int tix = F.wave * 8; tix < F.wave * 8 + 8; ++tix) {
            const int et = tix >> 3, dt = tix & 7;
            const f32x4 a = mma16(vT + et * 16 * 72, 72, kT + dt * 16 * 72, 72, 64, F.lane);
            const int fr = F.lane & 15, fq = F.lane >> 4;
#pragma unroll
            for (int r = 0; r < 4; ++r) ST[(size_t)unit * 16384 + (size_t)(et * 16 + 4 * fq + r) * 128 + dt * 16 + fr] = f2bf(a[r]);
        }
        if (F.tid < 128) { float z = 0.f; for (int s = 0; s < 64; ++s) z += bf2f(kT[F.tid * 72 + s]); zloc[(size_t)unit * 128 + F.tid] = z; }
        __syncthreads();
    }
}

DI void p8a_lru_local(const Frame& F) {
    const bf16_t* U1 = (const bf16_t*)(F.ws + WS_U);
    bf16_t* LA = (bf16_t*)(F.ws + WS_LRUA); bf16_t* LH = (bf16_t*)(F.ws + WS_LRUH);
    float* Aend = (float*)(F.ws + WS_AEND); float* Hend = (float*)(F.ws + WS_HEND);
    float* xs = (float*)(F.lds + ML_END) + F.wave * 64;
    const int lane = F.lane;
    for (int unit = F.gw; unit < 4096; unit += F.nw) {
        const int g = unit & 7, c = (unit >> 3) & 63, b = unit >> 9;
        const int ch = g * 64 + lane;
        float wa[64], wx[64];
#pragma unroll
        for (int i = 0; i < 64; ++i) { wa[i] = F.in[19][(size_t)(g * 64 + i) * 64 + lane]; wx[i] = F.in[21][(size_t)(g * 64 + i) * 64 + lane]; }
        const float cw0 = F.in[17][ch], cw1 = F.in[17][512 + ch], cw2 = F.in[17][1024 + ch], cw3 = F.in[17][1536 + ch], cb = F.in[18][ch];
        const float ba = F.in[20][ch], bx = F.in[22][ch];
        const float sp = log1pf(expf(-F.in[23][ch]));
        const int t0 = c * 64;
        float x0 = t0 >= 3 ? bf2f(U1[((size_t)b * SEQ + t0 - 3) * LD1 + C_CX + ch]) : 0.f;
        float x1 = t0 >= 2 ? bf2f(U1[((size_t)b * SEQ + t0 - 2) * LD1 + C_CX + ch]) : 0.f;
        float x2 = t0 >= 1 ? bf2f(U1[((size_t)b * SEQ + t0 - 1) * LD1 + C_CX + ch]) : 0.f;
        float Ac = 1.f, hl = 0.f;
        for (int s = 0; s < 64; ++s) {
            const size_t row = (size_t)b * SEQ + t0 + s;
            const float x3 = bf2f(U1[row * LD1 + C_CX + ch]);
            const float xc = cw0 * x0 + cw1 * x1 + cw2 * x2 + cw3 * x3 + cb;
            x0 = x1; x1 = x2; x2 = x3;
            __builtin_amdgcn_wave_barrier();
            xs[lane] = xc;
            __builtin_amdgcn_wave_barrier();
            float pr = ba, px = bx;
#pragma unroll
            for (int i = 0; i < 64; i += 4) { const f32x4 xv = *(const f32x4*)(xs + i);
                pr += xv[0] * wa[i] + xv[1] * wa[i + 1] + xv[2] * wa[i + 2] + xv[3] * wa[i + 3];
                px += xv[0] * wx[i] + xv[1] * wx[i + 1] + xv[2] * wx[i + 2] + xv[3] * wx[i + 3]; }
            const float r = sigmoidf_(pr), ig = sigmoidf_(px);
            const float la = -8.0f * r * sp;
            const float a = expf(la);
            const float bt = sqrtf(-expm1f(2.0f * la)) * (ig * xc);
            Ac *= a; hl = a * hl + bt;
            LA[row * 512 + ch] = f2bf(Ac); LH[row * 512 + ch] = f2bf(hl);
        }
        Aend[((size_t)b * 64 + c) * 512 + ch] = Ac; Hend[((size_t)b * 64 + c) * 512 + ch] = hl;
    }
}

DI void p8b_scans(const Frame& F) {
    const int gt = F.bid * 512 + F.tid, nthr = F.G * 512;
    if (gt < 4096) {
        const int b = gt >> 9, ch = gt & 511;
        const float* Aend = (const float*)(F.ws + WS_AEND); const float* Hend = (const float*)(F.ws + WS_HEND); float* Hin = (float*)(F.ws + WS_HIN);
        float H = 0.f;
        for (int c = 0; c < 64; ++c) { const size_t o = ((size_t)b * 64 + c) * 512 + ch; Hin[o] = H; H = Aend[o] * H + Hend[o]; }
    }
    const float* scal = (const float*)(F.ws + WS_SCAL); float* minp = (float*)(F.ws + WS_SCAL) + 4096;
    if (gt >= nthr - 4096) {
        const int q = gt - (nthr - 4096); const int bh = q >> 7, d = q & 127;
        const float* zloc = (const float*)(F.ws + WS_ZLOC); float* nin = (float*)(F.ws + WS_NIN);
        float m = 0.f, n = 0.f;
        for (int c = 0; c < 64; ++c) { const int unit = bh * 64 + c; const float bl = scal[unit], dm = scal[2048 + unit];
            const float mn = fmaxf(bl + m, dm); const float keep = expf(bl + m - mn), add = expf(dm - mn);
            nin[(size_t)unit * 128 + d] = n; if (d == 0) minp[unit] = m;
            n = keep * n + add * zloc[(size_t)unit * 128 + d]; m = mn; }
    }
    bf16_t* ST = (bf16_t*)(F.ws + WS_BFB);
    for (int el = gt; el < 32 * 16384; el += nthr) {
        const int bh = el >> 14, ed = el & 16383;
        float m = 0.f, C = 0.f;
        for (int c = 0; c < 64; ++c) { const int unit = bh * 64 + c; const float bl = scal[unit], dm = scal[2048 + unit];
            const float mn = fmaxf(bl + m, dm); const float keep = expf(bl + m - mn), add = expf(dm - mn);
            bf16_t* p = ST + (size_t)unit * 16384 + ed; const float Sl = bf2f(*p); *p = f2bf(C);
            C = keep * C + add * Sl; m = mn; }
    }
}

DI void p8c_mlstm_out(const Frame& F) {
    const bf16_t* U1 = (const bf16_t*)(F.ws + WS_U);
    const bf16_t* ST = (const bf16_t*)(F.ws + WS_BFB);
    bf16_t* Y = (bf16_t*)(F.ws + WS_BFA);
    const float* nin_g = (const float*)(F.ws + WS_NIN); const float* minp = (const float*)(F.ws + WS_SCAL) + 4096;
    unsigned char* L = F.lds;
    float* li = (float*)(L + ML_LI); float* bc = (float*)(L + ML_BC); float* mt = (float*)(L + ML_MT); float* dq = (float*)(L + ML_DQ); float* rs = (float*)(L + ML_RS); float* nin = (float*)(L + ML_NIN);
    bf16_t* q = (bf16_t*)(L + ML_Q); bf16_t* k = (bf16_t*)(L + ML_K); bf16_t* vT = (bf16_t*)(L + ML_VT); bf16_t* CT = (bf16_t*)(L + ML_CT); bf16_t* W = (bf16_t*)(L + ML_W);
    const float* cw = F.in[24]; const float* cb = F.in[25];
    for (int unit = F.bid; unit < 2048; unit += F.G) {
        const int c = unit & 63, h = (unit >> 6) & 3, b = unit >> 8;
        const float m_in = minp[unit];
        mlstm_gates(F, U1, b, h, c, li, bc);
        for (int it = F.tid; it < 1024; it += 512) {
            const int s = it >> 4, d0 = (it & 15) * 8; const int t = c * 64 + s;
            float y[8];
            conv8(U1, b, t, C_DQ + h * 128 + d0, cw + h * 128 + d0, 1024, cb + h * 128 + d0, y);
            uint4 o; o.x = pack2(siluf_(y[0]), siluf_(y[1])); o.y = pack2(siluf_(y[2]), siluf_(y[3])); o.z = pack2(siluf_(y[4]), siluf_(y[5])); o.w = pack2(siluf_(y[6]), siluf_(y[7]));
            *(uint4*)(q + s * 136 + d0) = o;
            conv8(U1, b, t, C_DK + h * 128 + d0, cw + 512 + h * 128 + d0, 1024, cb + 512 + h * 128 + d0, y);
            const float sc = 0.08838834764831845f;
            o.x = pack2(siluf_(y[0]) * sc, siluf_(y[1]) * sc); o.y = pack2(siluf_(y[2]) * sc, siluf_(y[3]) * sc); o.z = pack2(siluf_(y[4]) * sc, siluf_(y[5]) * sc); o.w = pack2(siluf_(y[6]) * sc, siluf_(y[7]) * sc);
            *(uint4*)(k + s * 136 + d0) = o;
            const uint4 vv = *(const uint4*)(U1 + ((size_t)b * SEQ + t) * LD1 + C_DV + h * 128 + d0);
            const bf16_t* vp = (const bf16_t*)&vv;
#pragma unroll
            for (int i = 0; i < 8; ++i) vT[(d0 + i) * 72 + s] = vp[i];
        }
        for (int it = F.tid; it < 2048; it += 512) { const int e = it >> 4, d0 = (it & 15) * 8;
            *(uint4*)(CT + e * 136 + d0) = *(const uint4*)(ST + (size_t)unit * 16384 + e * 128 + d0); }
        if (F.tid < 128) nin[F.tid] = nin_g[(size_t)unit * 128 + F.tid];
        if (F.tid >= 128 && F.tid < 192) { const int l = F.tid - 128; float mx = bc[l] + m_in;
            for (int s = 0; s <= l; ++s) mx = fmaxf(mx, bc[l] - bc[s] + li[s]);
            mt[l] = mx; }
        __syncthreads();
        if (F.tid < 64) { float a = 0.f; for (int d = 0; d < 128; ++d) a += bf2f(q[F.tid * 136 + d]) * nin[d]; dq[F.tid] = a; }
        for (int tix = F.wave * 2; tix < F.wave * 2 + 2; ++tix) {
            const int lt = tix >> 2, st = tix & 3;
            const f32x4 a = mma16(q + lt * 16 * 136, 136, k + st * 16 * 136, 136, 128, F.lane);
            const int fr = F.lane & 15, fq = F.lane >> 4; const int s = st * 16 + fr;
#pragma unroll
            for (int r = 0; r < 4; ++r) { const int l = lt * 16 + 4 * fq + r;
                const float w = s <= l ? a[r] * expf(bc[l] - bc[s] + li[s] - mt[l]) : 0.f;
                W[l * 72 + s] = f2bf(w); }
        }
        __syncthreads();
        if (F.tid < 64) { float a = 0.f; for (int s = 0; s < 64; ++s) a += bf2f(W[F.tid * 72 + s]); rs[F.tid] = a; }
        __syncthreads();
        for (int tix = F.wave * 4; tix < F.wave * 4 + 4; ++tix) {
            const int lt = tix >> 3, et = tix & 7;
            const f32x4 qc = mma16(q + lt * 16 * 136, 136, CT + et * 16 * 136, 136, 128, F.lane);
            const f32x4 wv = mma16(W + lt * 16 * 72, 72, vT + et * 16 * 72, 72, 64, F.lane);
            const int fr = F.lane & 15, fq = F.lane >> 4; const int e = et * 16 + fr;
#pragma unroll
            for (int r = 0; r < 4; ++r) { const int l = lt * 16 + 4 * fq + r;
                const float prev = expf(bc[l] + m_in - mt[l]);
                const float num = prev * qc[r] + wv[r];
                const float den = prev * dq[l] + rs[l];
                const float hv = num / fmaxf(fabsf(den), expf(-mt[l]));
                const size_t row = (size_t)b * SEQ + c * 64 + l;
                const float og = sigmoidf_(bf2f(U1[row * LD1 + C_DO + h * 128 + e]));
                const float zz = siluf_(bf2f(U1[row * LD1 + C_DZ + h * 128 + e]));
                Y[row * 1024 + 512 + h * 128 + e] = f2bf(og * hv * zz); }
        }
        __syncthreads();
    }
}
DI void p8c_lru_out(const Frame& F) {
    const bf16_t* U1 = (const bf16_t*)(F.ws + WS_U);
    const bf16_t* LA = (const bf16_t*)(F.ws + WS_LRUA); const bf16_t* LH = (const bf16_t*)(F.ws + WS_LRUH);
    const float* Hin = (const float*)(F.ws + WS_HIN);
    bf16_t* Y = (bf16_t*)(F.ws + WS_BFA);
    const size_t n8 = (size_t)MT * 64;
    for (size_t it = (size_t)F.bid * 512 + F.tid; it < n8; it += (size_t)F.G * 512) {
        const size_t row = it >> 6; const int c0 = (int)(it & 63) * 8; const int b = (int)(row >> 12), t = (int)(row & 4095), c = t >> 6;
        const uint4 av = *(const uint4*)(LA + row * 512 + c0), hv = *(const uint4*)(LH + row * 512 + c0), zv = *(const uint4*)(U1 + row * LD1 + C_CZ + c0);
        float af[8], hf[8], zf[8]; unpack8(av, af); unpack8(hv, hf); unpack8(zv, zf);
        const float* hi = Hin + ((size_t)b * 64 + c) * 512 + c0; float y[8];
#pragma unroll
        for (int i = 0; i < 8; ++i) y[i] = (af[i] * hi[i] + hf[i]) * siluf_(zf[i]);
        uint4 o; o.x = pack2(y[0], y[1]); o.y = pack2(y[2], y[3]); o.z = pack2(y[4], y[5]); o.w = pack2(y[6], y[7]);
        *(uint4*)(Y + row * 1024 + c0) = o;
    }
}

constexpr int N_PHASES = 16;
__global__ void __launch_bounds__(512, 2) mk_fwd(Args args) {
    extern __shared__ __attribute__((aligned(16))) unsigned char smem[];
    Frame F;
    F.tid = threadIdx.x; F.lane = F.tid & 63; F.wave = __builtin_amdgcn_readfirstlane(F.tid >> 6);
    F.G = gridDim.x; F.bid = blockIdx.x; F.gw = F.bid * 8 + F.wave; F.nw = F.G * 8;
    F.lds = smem + LDS_WORK_OFF; F.ws = args.ws; F.out = args.out; F.ctl = (unsigned*)args.ws;
#pragma unroll
    for (int i = 0; i < 28; ++i) F.in[i] = args.in[i];
    LAS unsigned char* lsm = (LAS unsigned char*)smem;
    LAS unsigned char* lut = lsm + (LDS_BYTES - 12288);
    LAS float* tbl = (LAS float*)(lsm + (LDS_BYTES - 12288 + 256));
    LAS float* biasL = (LAS float*)(lsm + (LDS_BYTES - 8192));
    if (F.tid < 4) ((LAS unsigned*)lsm)[F.tid] = 0u;
    if (F.tid < 128) { const int n = F.tid; int bk;
        if (n < 16) bk = n; else { bk = 16; const int thr[15] = {19, 21, 24, 27, 31, 35, 40, 46, 52, 59, 67, 77, 87, 99, 113};
#pragma unroll
            for (int j = 0; j < 15; ++j) bk += (n >= thr[j]) ? 1 : 0; }
        lut[n] = (unsigned char)bk; }
    { const int hd = F.tid >> 5, bk = F.tid & 31; tbl[hd * 32 + bk] = args.in[6][bk * 16 + hd]; }
    F.lut = lut; F.tbl = tbl; F.biasL = biasL; F.ldsl = lsm + LDS_WORK_OFF;
    __syncthreads();
    for (int e = F.tid; e < 16 * 128; e += 512) { const int hd = e >> 7, n = e & 127; const int bk = n < 16 ? n : (n >= 113 ? 31 : (int)lut[n]); biasL[e] = tbl[hd * 32 + bk] * 1.4426950408889634f; }
    __syncthreads();
    const int lo = args.ph_lo, hi = args.ph_hi;
    XcdBarrier bar; bar.bar = F.ctl; bar.x = 0; bar.st = nullptr;
#if !MK_PER_PHASE
    bar = xcd_barrier_post(F.ctl, (volatile LAS unsigned*)lsm);
#endif
#ifndef PH_MASK
#define PH_MASK 0xFFFF
#endif
#define IN(k) (((PH_MASK >> (k)) & 1) && lo <= (k) && (k) < hi)
#if MK_PER_PHASE
#define SEAM(k) do { } while (0)
#else
#define SEAM(k) do { if (IN(k) && IN((k) + 1)) xcd_barrier(bar); } while (0)
#endif
    LAS unsigned char* glds = lsm + LDS_WORK_OFF;
    unsigned char* ws = args.ws;
    bf16_t* BFA = (bf16_t*)(ws + WS_BFA); bf16_t* BFB = (bf16_t*)(ws + WS_BFB); bf16_t* U = (bf16_t*)(ws + WS_U); float* Ef = (float*)(ws + WS_U);

    if (IN(0)) { p0_prologue(F); }
    SEAM(0);
    if (IN(1)) {
        pg8::Gemm g{BFA, (const bf16_t*)(ws + WS_WIN0), MT, LD0, 1024}; pg8::StaticOrder S; S.init(MT, LD0, F.G, F.bid);
        pg8::EpiBf16<0> E{U, LD0};
        pg8::gemm_phase(glds, g, S, E);
    }
    SEAM(1);
    if (IN(2)) { p2a_build_blocks(F); }
    SEAM(2);
    if (IN(3)) {
        { pg8::Gemm g{(const bf16_t*)(ws + WS_AK), (const bf16_t*)(ws + WS_WC1K), 4096, 256, 2048}; pg8::StaticOrder S; S.init(4096, 256, F.G, F.bid);
          pg8::EpiBf16<1> E{(bf16_t*)(ws + WS_HK), 256}; pg8::gemm_phase(glds, g, S, E); }
        { pg8::Gemm g{(const bf16_t*)(ws + WS_AV), (const bf16_t*)(ws + WS_WC1V), 4096, 256, 2048}; pg8::StaticOrder S; S.init(4096, 256, F.G, (F.bid + F.G - 16) % F.G);
          pg8::EpiBf16<1> E{(bf16_t*)(ws + WS_HV), 256}; pg8::gemm_phase(glds, g, S, E); }
    }
    SEAM(3);
    if (IN(4)) { p2c_compress_out(F); }
    SEAM(4);
    if (IN(5)) { p3_attention(F); }
    SEAM(5);
    if (IN(6)) {
        pg8::Gemm g{BFB, (const bf16_t*)(ws + WS_WOUT0), MT, 1024, 1024}; pg8::StaticOrder S; S.init(MT, 1024, F.G, F.bid);
        pg8::EpiResid E{F.in[0], F.out, BFA};
        pg8::gemm_phase(glds, g, S, E);
    }
    SEAM(6);
    if (IN(7)) {
        { pg8::Gemm g{(const bf16_t*)(ws + WS_PBF), (const bf16_t*)(ws + WS_WP0), MT, 1024, 256}; pg8::StaticOrder S; S.init(MT, 1024, F.G, F.bid);
          pg8::EpiF32 E{Ef, 1024}; pg8::gemm_phase(glds, g, S, E); }
        asm volatile("s_waitcnt vmcnt(0)" ::: "memory"); __syncthreads();
        { pg8::Gemm g{BFA, (const bf16_t*)(ws + WS_WG0), MT, 1024, 1024}; pg8::StaticOrder S; S.init(MT, 1024, F.G, F.bid);
          pg8::EpiGate E{F.out, Ef}; pg8::gemm_phase(glds, g, S, E); }
    }
    SEAM(7);
    if (IN(8)) { rmsnorm_rows<0>(F, F.out, F.in[2] + 1024, BFB, nullptr); }
    SEAM(8);
    if (IN(9)) {
        pg8::Gemm g{BFB, (const bf16_t*)(ws + WS_WIN1), MT, LD1, 1024}; pg8::StaticOrder S; S.init(MT, LD1, F.G, F.bid);
        pg8::EpiBf16<0> E{U, LD1};
        pg8::gemm_phase(glds, g, S, E);
    }
    SEAM(9);
    if (IN(10)) { p8a_mlstm_local(F); p8a_lru_local(F); }
    SEAM(10);
    if (IN(11)) { p8b_scans(F); }
    SEAM(11);
    if (IN(12)) { p8c_mlstm_out(F); p8c_lru_out(F); }
    SEAM(12);
    if (IN(13)) {
        pg8::Gemm g{BFA, (const bf16_t*)(ws + WS_WOUT1), MT, 1024, 1024}; pg8::StaticOrder S; S.init(MT, 1024, F.G, F.bid);
        pg8::EpiResid E{F.out, F.out, BFB};
        pg8::gemm_phase(glds, g, S, E);
    }
    SEAM(13);
    if (IN(14)) {
        { pg8::Gemm g{(const bf16_t*)(ws + WS_PBF) + (size_t)MT * 256, (const bf16_t*)(ws + WS_WP1), MT, 1024, 256}; pg8::StaticOrder S; S.init(MT, 1024, F.G, F.bid);
          pg8::EpiF32 E{Ef, 1024}; pg8::gemm_phase(glds, g, S, E); }
        asm volatile("s_waitcnt vmcnt(0)" ::: "memory"); __syncthreads();
        { pg8::Gemm g{BFB, (const bf16_t*)(ws + WS_WG1), MT, 1024, 1024}; pg8::StaticOrder S; S.init(MT, 1024, F.G, F.bid);
          pg8::EpiGate E{F.out, Ef}; pg8::gemm_phase(glds, g, S, E); }
    }
    SEAM(14);
    if (IN(15)) { rmsnorm_rows<1>(F, F.out, F.in[3], nullptr, F.out); }
#undef IN
#undef SEAM
}

extern "C" void kernel_launch(void* const* d_in, const int* in_sizes, int n_in, void* d_out, int out_size, void* d_ws, size_t ws_size, hipStream_t stream) {
    static int grid = 0;
    if (grid == 0) {
        if (n_in != 28 || out_size != MT * DM || ws_size < WS_END) { fprintf(stderr, "kernel_launch: unexpected shapes (n_in %d, out %d, ws %zu < %zu)\n", n_in, out_size, ws_size, (size_t)WS_END); grid = -1; return; }
        int dev = 0, cus = 0, per_cu = 0;
        if (hipGetDevice(&dev) != hipSuccess || hipDeviceGetAttribute(&cus, hipDeviceAttributeMultiprocessorCount, dev) != hipSuccess) { grid = -1; return; }
        if (hipFuncSetAttribute((const void*)mk_fwd, hipFuncAttributeMaxDynamicSharedMemorySize, LDS_BYTES) != hipSuccess) { fprintf(stderr, "kernel_launch: hipFuncSetAttribute failed\n"); grid = -1; return; }
        if (hipOccupancyMaxActiveBlocksPerMultiprocessor(&per_cu, (const void*)mk_fwd, 512, LDS_BYTES) != hipSuccess || per_cu < 1)
            fprintf(stderr, "kernel_launch: occupancy query reports %d workgroups per CU\n", per_cu);
        (void)hipGetLastError();
        grid = cus;
    }
    if (grid < 0) return;
    if (hipMemsetAsync(d_ws, 0, CTL_BYTES, stream) != hipSuccess) return;
    Args a{};
    for (int i = 0; i < 28; ++i) a.in[i] = (const float*)d_in[i];
    a.out = (float*)d_out; a.ws = (unsigned char*)d_ws;
#if MK_PER_PHASE
    for (int p = 0; p < N_PHASES; ++p) { a.ph_lo = p; a.ph_hi = p + 1; hipLaunchKernelGGL(mk_fwd, dim3(grid), dim3(512), LDS_BYTES, stream, a); }
#else
    a.ph_lo = 0; a.ph_hi = N_PHASES;
    hipLaunchKernelGGL(mk_fwd, dim3(grid), dim3(512), LDS_BYTES, stream, a);
#endif
}
```

```cpp
#include <hip/hip_runtime.h>
#include <cstdio>
#include <cstdint>

#ifndef MK_PER_PHASE
#define MK_PER_PHASE 0
#endif

#define LAS __attribute__((address_space(3)))
typedef unsigned short bf16_t;
typedef short bf16x8 __attribute__((ext_vector_type(8)));
typedef float f32x4 __attribute__((ext_vector_type(4)));
#define DI __device__ __forceinline__

constexpr int NB = 8, SEQ = 4096, DM = 1024, MT = NB * SEQ;
constexpr int LD0 = 3072, LD1 = 3840;
constexpr int C_AQ = 0, C_KC = 512, C_VC = 640, C_KS = 768, C_KW = 896, C_AZ = 1024, C_BQ = 1536, C_BZ = 2048,
              C_BK = 2560, C_BKI = 2624, C_BQI = 2688, C_AG = 2944, C_BWI = 2968;
constexpr int C_VS = 0, C_VW = 0, C_BV = 0;
constexpr int C_CX = 0, C_CZ = 512, C_DQ = 1024, C_DK = 1536, C_DV = 2048, C_DO = 2560, C_DZ = 3072, C_DI = 3584, C_DF = 3588;
constexpr int NCMP = 255;
constexpr float NEG_INF = -__builtin_inff();

DI int map0(int n) {
    if (n < 896) return n;
    if (n < 1024) return 1024 + (n - 896);
    if (n < 1536) return 1304 + (n - 1024);
    if (n < 2048) return 1816 + (n - 1536);
    if (n < 2560) return 2780 + (n - 2048);
    if (n < 2624) return 2328 + (n - 2560);
    if (n < 2688) return 2712 + (n - 2624);
    if (n < 2944) return 2456 + (n - 2688);
    if (n < 2968) return 1280 + (n - 2944);
    if (n < 2972) return 2776 + (n - 2968);
    return -1;
}
DI int map1(int n) {
    if (n < 2560) return n;
    if (n < 3072) return 2568 + (n - 2560);
    if (n < 3584) return 3080 + (n - 3072);
    if (n < 3588) return 2560 + (n - 3584);
    if (n < 3592) return 2564 + (n - 3588);
    return -1;
}
DI int mapid(int n) { return n; }
DI int mapv(int f) { return f < 128 ? 896 + f : (f < 256 ? 1152 + (f - 128) : (f < 320 ? 2392 + (f - 256) : -1)); }

constexpr size_t CTL_BYTES = 16384;
constexpr size_t WS_WIN0  = CTL_BYTES;
constexpr size_t WS_WOUT0 = WS_WIN0  + (size_t)LD0 * 1024 * 2;
constexpr size_t WS_WG0   = WS_WOUT0 + (size_t)1024 * 1024 * 2;
constexpr size_t WS_WP0   = WS_WG0   + (size_t)1024 * 1024 * 2;
constexpr size_t WS_WIN1  = WS_WP0   + (size_t)1024 * 256 * 2;
constexpr size_t WS_WOUT1 = WS_WIN1  + (size_t)LD1 * 1024 * 2;
constexpr size_t WS_WG1   = WS_WOUT1 + (size_t)1024 * 1024 * 2;
constexpr size_t WS_WP1   = WS_WG1   + (size_t)1024 * 1024 * 2;
constexpr size_t WS_WC1K  = WS_WP1   + (size_t)1024 * 256 * 2;
constexpr size_t WS_WC1V  = WS_WC1K  + (size_t)256 * 2048 * 2;
constexpr size_t WS_WVT   = WS_WC1V  + (size_t)256 * 2048 * 2;
constexpr size_t WS_BFA   = WS_WVT   + (size_t)512 * 1024 * 2;
constexpr size_t WS_BFB   = WS_BFA   + (size_t)MT * 1024 * 2;
constexpr size_t WS_PBF   = WS_BFB   + (size_t)MT * 1024 * 2;
constexpr size_t WS_U     = WS_PBF   + (size_t)2 * MT * 256 * 2;
constexpr size_t WS_X     = WS_U     + (size_t)MT * LD1 * 2;
constexpr size_t WS_AK    = WS_X;
constexpr size_t WS_AV    = WS_AK    + (size_t)4096 * 2048 * 2;
constexpr size_t WS_HK    = WS_AV    + (size_t)4096 * 2048 * 2;
constexpr size_t WS_HV    = WS_HK    + (size_t)4096 * 256 * 2;
constexpr size_t WS_LRUA  = WS_X;
constexpr size_t WS_LRUH  = WS_LRUA  + (size_t)MT * 512 * 2;
constexpr size_t WS_S     = WS_X     + (size_t)64 * 1024 * 1024;
constexpr size_t WS_KCMP  = WS_S;
constexpr size_t WS_VCMP  = WS_KCMP  + (size_t)16 * 256 * 64 * 4;
constexpr size_t WS_AEND  = WS_VCMP  + (size_t)16 * 256 * 64 * 4;
constexpr size_t WS_HEND  = WS_AEND  + (size_t)8 * 64 * 512 * 4;
constexpr size_t WS_HIN   = WS_HEND  + (size_t)8 * 64 * 512 * 4;
constexpr size_t WS_ZLOC  = WS_HIN   + (size_t)8 * 64 * 512 * 4;
constexpr size_t WS_NIN   = WS_ZLOC  + (size_t)2048 * 128 * 4;
constexpr size_t WS_SCAL  = WS_NIN   + (size_t)2048 * 128 * 4;
constexpr size_t WS_VCT   = WS_SCAL  + (size_t)3 * 2048 * 4;
constexpr size_t WS_END   = WS_VCT   + (size_t)16 * 64 * 256 * 2;
constexpr size_t WS_VT    = WS_U     + (size_t)MT * LD0 * 2;
static_assert(WS_VT + (size_t)512 * MT * 2 <= WS_X, "VT region");
static_assert(WS_HV + (size_t)4096 * 256 * 2 <= WS_S, "compress region");
static_assert(WS_LRUH + (size_t)MT * 512 * 2 <= WS_S, "lru region");

constexpr int XCD_BAR_WORDS_C = 3456;
constexpr int CW_QNSA = 3520, CW_QDSA = 3584;

constexpr int LDS_BYTES = 147456;
constexpr int LDS_CTL_OFF = 0;
constexpr int LDS_WORK_OFF = 1024;

DI float bf2f(bf16_t v) { return __uint_as_float(((unsigned)v) << 16); }
DI bf16_t f2bf(float f) { unsigned u = __float_as_uint(f); u += 0x7FFFu + ((u >> 16) & 1u); return (bf16_t)(u >> 16); }
typedef __bf16 bf16v2 __attribute__((ext_vector_type(2)));
typedef float f32x2 __attribute__((ext_vector_type(2)));
DI unsigned pack2(float lo, float hi) { const f32x2 v = {lo, hi}; return __builtin_bit_cast(unsigned, __builtin_convertvector(v, bf16v2)); }
DI float sigmoidf_(float x) { return 1.0f / (1.0f + expf(-x)); }
DI float siluf_(float x) { return x / (1.0f + expf(-x)); }
DI float wave_max(float v) { for (int o = 32; o >= 1; o >>= 1) v = fmaxf(v, __shfl_xor(v, o)); return v; }
DI float wave_sum(float v) { for (int o = 32; o >= 1; o >>= 1) v += __shfl_xor(v, o); return v; }
DI void unpack8(const uint4& v, float (&f)[8]) {
    f[0] = __uint_as_float(v.x << 16); f[1] = __uint_as_float(v.x & 0xFFFF0000u);
    f[2] = __uint_as_float(v.y << 16); f[3] = __uint_as_float(v.y & 0xFFFF0000u);
    f[4] = __uint_as_float(v.z << 16); f[5] = __uint_as_float(v.z & 0xFFFF0000u);
    f[6] = __uint_as_float(v.w << 16); f[7] = __uint_as_float(v.w & 0xFFFF0000u);
}

#define XB_TMO      128
#define XB_XCNT(j)  (256  + 64 * (j))
#define XB_XSUB(j)  (1280 + 64 * (j))
#define XB_XGEN(j)  (2304 + 64 * (j))
#define XB_TOP      3328
#define XB_TOPGEN   3392
#define XCD_BAR_WORDS 3456
#define XB_SPIN_CAP (1u << 22)
static_assert(XCD_BAR_WORDS == XCD_BAR_WORDS_C, "bar words");

__device__ __forceinline__ unsigned xb_ld(unsigned* p)              { return __hip_atomic_load(p, __ATOMIC_RELAXED, __HIP_MEMORY_SCOPE_AGENT); }
__device__ __forceinline__ unsigned xb_add(unsigned* p, unsigned v) { return __hip_atomic_fetch_add(p, v, __ATOMIC_RELAXED, __HIP_MEMORY_SCOPE_AGENT); }
__device__ __forceinline__ unsigned xb_xcc_id() { return (unsigned)__builtin_amdgcn_s_getreg((3 << 11) | 20) & 0xFu; }
#define XB_SPIN(cond, bar) do { unsigned _sp = 0; while (cond) { __builtin_amdgcn_s_sleep(1); \
    if ((++_sp & 255u) == 0u) { if (xb_ld(&(bar)[XB_TMO])) break; if (_sp > XB_SPIN_CAP) { atomicAdd(&(bar)[XB_TMO], 1u); break; } } } } while (0)

struct XcdBarrier { unsigned* bar; unsigned x; volatile LAS unsigned* st; };

__device__ __forceinline__ XcdBarrier xcd_barrier_post(unsigned* bar, volatile LAS unsigned* st) {
    XcdBarrier b; b.bar = bar; b.x = xb_xcc_id(); b.st = st;
    if (threadIdx.x == 0) (void)xb_add(&bar[XB_XCNT(b.x)], 1u);
    return b;
}
__device__ __forceinline__ void xcd_barrier_complete(unsigned* bar, unsigned x, unsigned& nloc, unsigned& nx) {
    const unsigned G = gridDim.x * gridDim.y * gridDim.z;
    unsigned sum, cnt, mine, sp = 0u;
    for (;;) {
        sum = 0u; cnt = 0u; mine = 0u;
#pragma unroll
        for (unsigned j = 0; j < 16; ++j) { const unsigned c = xb_ld(&bar[XB_XCNT(j)]); sum += c; cnt += (c > 0u) ? 1u : 0u; mine = (j == x) ? c : mine; }
        if (sum == G) break;
        __builtin_amdgcn_s_sleep(1);
        if ((++sp & 255u) == 0u) { if (xb_ld(&bar[XB_TMO])) break; if (sp > XB_SPIN_CAP) { atomicAdd(&bar[XB_TMO], 1u); break; } }
    }
    nloc = mine > 0u ? mine : 1u; nx = cnt > 0u ? cnt : 1u;
}
__device__ __forceinline__ void xcd_barrier(const XcdBarrier& b) {
    asm volatile("s_waitcnt vmcnt(0)" ::: "memory");
    __syncthreads();
    if (threadIdx.x == 0) {
        unsigned* bar = b.bar;
        __builtin_amdgcn_s_waitcnt(0);
        unsigned nloc = b.st[0], nx = b.st[1];
        if (nloc == 0u) { xcd_barrier_complete(bar, b.x, nloc, nx); b.st[0] = nloc; b.st[1] = nx; }
        const unsigned old = xb_add(&bar[XB_XSUB(b.x)], 1u);
        const unsigned gen = old / nloc;
        if (old + 1u == (gen + 1u) * nloc) {
            __builtin_amdgcn_fence(__ATOMIC_RELEASE, "agent");
            asm volatile("s_waitcnt vmcnt(0)" ::: "memory");
            const unsigned og = xb_add(&bar[XB_TOP], 1u);
            const unsigned tg = og / nx;
            if (og + 1u == (tg + 1u) * nx) xb_add(&bar[XB_TOPGEN], 1u);
            else XB_SPIN(xb_ld(&bar[XB_TOPGEN]) == tg, bar);
            __builtin_amdgcn_fence(__ATOMIC_ACQUIRE, "agent");
            xb_add(&bar[XB_XGEN(b.x)], 1u);
            asm volatile("s_waitcnt vmcnt(0)" ::: "memory");
        } else {
            XB_SPIN(xb_ld(&bar[XB_XGEN(b.x)]) == gen, bar);
            __builtin_amdgcn_fence(__ATOMIC_ACQUIRE, "agent");
            asm volatile("s_waitcnt vmcnt(0)" ::: "memory");
        }
    }
    __syncthreads();
}

namespace pg8 {
constexpr int BM = 256, BK = 64, HALF = 128, HTB = HALF * BK * 2, STAGE_BYTES = 8 * HTB, NXCD = 8, WGM = 8;
__host__ __device__ __forceinline__ int lds_byte(int r, int c) { const int st = (r >> 4) * 2 + (c >> 5), rr = r & 15, cc = c & 31, ob = rr * 64 + cc * 2; return st * 1024 + (ob ^ (((ob >> 9) & 1) << 5)); }
__host__ __device__ __forceinline__ void stage_rc(int b, int& R, int& C) { const int st = b / 1024, sb = b % 1024, swz = sb ^ (((sb >> 9) & 1) << 5); R = (st >> 1) * 16 + swz / 64; C = (st & 1) * 32 + (swz % 64) / 2; }
__host__ __device__ __forceinline__ int perm32(int rho) { const int n = rho >> 4, i = rho & 15; return 8 * (i >> 2) + 4 * n + (i & 3); }
struct Unit { int pm, pn; };
struct Gemm { const bf16_t* A; const bf16_t* Bt; int M, N, K; };
struct StaticOrder {
    int nM, nN, nwg, G, c;
    __host__ __device__ void init(int M, int N, int G_, int c_) { nM = M / BM; nN = N / BM; nwg = nM * nN; G = G_; c = c_; }
    __host__ __device__ bool next(int i, Unit& u) const {
        const long L = (long)i * G + c; if (L >= nwg) return false;
        int wgid = (int)L; { const int q = nwg / NXCD, r = nwg % NXCD, xcd = wgid % NXCD, off = wgid / NXCD; wgid = (xcd < r ? xcd * (q + 1) : r * (q + 1) + (xcd - r) * q) + off; }
        const int nig = WGM * nN, gid = wgid / nig, fm = gid * WGM, gsz = (nM - fm) < WGM ? (nM - fm) : WGM;
        u.pm = fm + ((wgid % nig) % gsz); u.pn = (wgid % nig) / gsz; return true;
    }
    __device__ __forceinline__ void a_ready(const Unit&) const {}
    __device__ __forceinline__ void done(const Unit&) const {}
};
template <class Epi, class Sched>
__device__ __forceinline__ void gemm_phase(LAS unsigned char* lds, const Gemm g, const Sched& S, const Epi& E) {
    int tid_ = threadIdx.x; asm volatile("" : "+v"(tid_));
    const int tid = tid_, wid = __builtin_amdgcn_readfirstlane(tid >> 6), lane = tid & 63, wr = wid >> 2, wc = wid & 3, fr = lane & 15, fq = lane >> 4;
    const int K = g.K, nt = K / BK;
    unsigned voffA[2], voffB[2];
#pragma unroll
    for (int i = 0; i < 2; ++i) { int R, C; stage_rc(tid * 16 + i * 8192, R, C); const int Rb = Epi::PERM ? ((R & ~31) + perm32(R & 31)) : R;
        voffA[i] = (unsigned)(R * K + C) * 2u; voffB[i] = (unsigned)(Rb * K + C) * 2u; }
    const size_t kstep = (size_t)(BK * 2);
    const size_t hstep = (size_t)HALF * K * 2;
    const size_t tstep = 2 * hstep;
    const unsigned ldsw = (unsigned)wid * 1024u;
    const int aoff = lds_byte(wr * 64 + fr, fq * 8), boff = lds_byte(wc * 32 + fr, fq * 8);
#define PG8_SA(b, h) (((b) * 2 + (h)) * HTB)
#define PG8_SB(b, h) ((4 + (b) * 2 + (h)) * HTB)
#define PG8_STAGE(bufoff, gbase, voff) do { _Pragma("unroll") for (int _i = 0; _i < 2; ++_i) \
        __builtin_amdgcn_global_load_lds((const unsigned*)((const char*)(gbase) + (voff)[_i]), (LAS unsigned*)(lds + (bufoff) + ldsw + _i * 8192), 16, 0, 0); } while (0)
#define PG8_LDA(dst, b, h) do { _Pragma("unroll") for (int m = 0; m < 4; ++m) _Pragma("unroll") for (int k = 0; k < 2; ++k) dst[m][k] = *(const LAS bf16x8*)(lds + PG8_SA(b, h) + aoff + m * 2048 + k * 1024); } while (0)
#define PG8_LDB(dst, b, h) do { _Pragma("unroll") for (int n = 0; n < 2; ++n) _Pragma("unroll") for (int k = 0; k < 2; ++k) dst[n][k] = *(const LAS bf16x8*)(lds + PG8_SB(b, h) + boff + n * 2048 + k * 1024); } while (0)
#define PG8_MMA(ai, bj, At, Bt) do { __builtin_amdgcn_s_setprio(1); _Pragma("unroll") for (int m = 0; m < 4; ++m) _Pragma("unroll") for (int n = 0; n < 2; ++n) _Pragma("unroll") for (int k = 0; k < 2; ++k) \
        acc[ai][bj][m][n] = __builtin_amdgcn_mfma_f32_16x16x32_bf16(Bt[n][k], At[m][k], acc[ai][bj][m][n], 0, 0, 0); __builtin_amdgcn_s_setprio(0); } while (0)
#define PG8_WAIT_V(n) asm volatile("s_waitcnt vmcnt(" #n ")" ::: "memory")
#define PG8_WAIT_L(n) asm volatile("s_waitcnt lgkmcnt(" #n ")" ::: "memory")
#define PG8_BAR __builtin_amdgcn_s_barrier()
#define PG8_SCHED __builtin_amdgcn_sched_barrier(0)
    Unit cur, nxt; int ui = 0;
    if (!S.next(0, cur)) return;
    f32x4 acc[2][2][4][2];
#pragma unroll
    for (int a = 0; a < 2; ++a)
#pragma unroll
        for (int b = 0; b < 2; ++b)
#pragma unroll
            for (int m = 0; m < 4; ++m)
#pragma unroll
                for (int n = 0; n < 2; ++n) acc[a][b][m][n] = (f32x4){0.f, 0.f, 0.f, 0.f};
    bf16x8 At[4][2], B0[2][2], B1[2][2];
    const char* cA = (const char*)g.A + (size_t)cur.pm * tstep; const char* cB = (const char*)g.Bt + (size_t)cur.pn * tstep;
    S.a_ready(cur);
    PG8_STAGE(PG8_SB(0, 0), cB, voffB); PG8_STAGE(PG8_SA(0, 0), cA, voffA); PG8_STAGE(PG8_SB(0, 1), cB + hstep, voffB); PG8_STAGE(PG8_SA(0, 1), cA + hstep, voffA);
    if (wr == 1) PG8_BAR;
    PG8_WAIT_V(4); PG8_BAR;
    PG8_STAGE(PG8_SB(1, 0), cB + kstep, voffB); PG8_STAGE(PG8_SA(1, 0), cA + kstep, voffA); PG8_STAGE(PG8_SB(1, 1), cB + hstep + kstep, voffB);
    PG8_WAIT_V(6); PG8_BAR;
    for (;;) {
        const bool has_next = S.next(ui + 1, nxt);
        const char* nA = has_next ? (const char*)g.A + (size_t)nxt.pm * tstep : cA; const char* nB = has_next ? (const char*)g.Bt + (size_t)nxt.pn * tstep : cB;
        for (int t = 0; t < nt; t += 2) {
            const bool last = (t == nt - 2);
            const char* a1 = cA + (size_t)(t + 1) * kstep;
            const char* a2 = last ? nA : cA + (size_t)(t + 2) * kstep; const char* b2 = last ? nB : cB + (size_t)(t + 2) * kstep;
            const char* a3 = a2 + kstep; const char* b3 = b2 + kstep;
            if (last && has_next) S.a_ready(nxt);
            PG8_LDB(B0, 0, 0); PG8_SCHED; PG8_LDA(At, 0, 0); PG8_STAGE(PG8_SA(1, 1), a1 + hstep, voffA);
            PG8_WAIT_L(8); PG8_BAR; PG8_WAIT_L(0); PG8_MMA(0, 0, At, B0); PG8_BAR; PG8_SCHED;
            PG8_LDB(B1, 0, 1); PG8_STAGE(PG8_SB(0, 0), b2, voffB);
            PG8_BAR; PG8_WAIT_L(0); PG8_MMA(0, 1, At, B1); PG8_BAR;
            PG8_LDA(At, 0, 1); PG8_STAGE(PG8_SA(0, 0), a2, voffA);
            PG8_BAR; PG8_WAIT_L(0); PG8_MMA(1, 0, At, B0); PG8_BAR; PG8_SCHED;
            PG8_STAGE(PG8_SB(0, 1), b2 + hstep, voffB);
            PG8_WAIT_V(6); PG8_BAR; PG8_MMA(1, 1, At, B1); PG8_BAR;
            PG8_LDB(B0, 1, 0); PG8_SCHED; PG8_LDA(At, 1, 0); PG8_STAGE(PG8_SA(0, 1), a2 + hstep, voffA);
            PG8_WAIT_L(8); PG8_BAR; PG8_WAIT_L(0); PG8_MMA(0, 0, At, B0); PG8_BAR; PG8_SCHED;
            PG8_LDB(B1, 1, 1); PG8_STAGE(PG8_SB(1, 0), b3, voffB);
            PG8_BAR; PG8_WAIT_L(0); PG8_MMA(0, 1, At, B1); PG8_BAR;
            PG8_LDA(At, 1, 1); PG8_STAGE(PG8_SA(1, 0), a3, voffA);
            PG8_BAR; PG8_WAIT_L(0); PG8_MMA(1, 0, At, B0); PG8_BAR; PG8_SCHED;
            PG8_STAGE(PG8_SB(1, 1), b3 + hstep, voffB);
            PG8_WAIT_V(6); PG8_BAR; PG8_MMA(1, 1, At, B1); PG8_BAR;
        }
        E(acc, cur, wr, wc, fr, fq); S.done(cur);
        if (!has_next) break;
#pragma unroll
        for (int a = 0; a < 2; ++a)
#pragma unroll
            for (int b = 0; b < 2; ++b)
#pragma unroll
                for (int m = 0; m < 4; ++m)
#pragma unroll
                    for (int n = 0; n < 2; ++n) acc[a][b][m][n] = (f32x4){0.f, 0.f, 0.f, 0.f};
        cur = nxt; cA = nA; cB = nB; ++ui;
    }
    PG8_WAIT_V(0);
    if (wr == 0) PG8_BAR;
    PG8_BAR;
#undef PG8_SA
#undef PG8_SB
#undef PG8_STAGE
#undef PG8_LDA
#undef PG8_LDB
#undef PG8_MMA
#undef PG8_WAIT_V
#undef PG8_WAIT_L
#undef PG8_BAR
#undef PG8_SCHED
}

template <int ACT  > struct EpiBf16 {
    static constexpr bool PERM = true;
    bf16_t* O; int ldc;
    __device__ __forceinline__ void operator()(const f32x4 (&acc)[2][2][4][2], const Unit& u, int wr, int wc, int fr, int fq) const {
        const int row0 = u.pm * BM + wr * 64 + fr, col0 = u.pn * BM + wc * 32 + 8 * fq;
#pragma unroll
        for (int ai = 0; ai < 2; ++ai)
#pragma unroll
            for (int m = 0; m < 4; ++m) { bf16_t* rowp = O + (size_t)(row0 + ai * HALF + m * 16) * ldc + col0;
#pragma unroll
                for (int bj = 0; bj < 2; ++bj) { f32x4 v0 = acc[ai][bj][m][0], v1 = acc[ai][bj][m][1];
                    if (ACT == 1) { for (int i = 0; i < 4; ++i) { v0[i] = siluf_(v0[i]); v1[i] = siluf_(v1[i]); } }
                    uint4 o; o.x = pack2(v0[0], v0[1]); o.y = pack2(v0[2], v0[3]); o.z = pack2(v1[0], v1[1]); o.w = pack2(v1[2], v1[3]);
                    *(uint4*)(rowp + bj * HALF) = o; } }
    }
};
struct EpiF32 {
    static constexpr bool PERM = false;
    float* C; int ldc;
    __device__ __forceinline__ void operator()(const f32x4 (&acc)[2][2][4][2], const Unit& u, int wr, int wc, int fr, int fq) const {
        const int row0 = u.pm * BM + wr * 64 + fr, col0 = u.pn * BM + wc * 32 + 4 * fq;
#pragma unroll
        for (int ai = 0; ai < 2; ++ai)
#pragma unroll
            for (int m = 0; m < 4; ++m) { float* rowp = C + (size_t)(row0 + ai * HALF + m * 16) * ldc + col0;
#pragma unroll
                for (int bj = 0; bj < 2; ++bj)
#pragma unroll
                    for (int n = 0; n < 2; ++n) *(f32x4*)(rowp + bj * HALF + n * 16) = acc[ai][bj][m][n]; }
    }
};
struct EpiResid {
    static constexpr bool PERM = false;
    const float* Xi; float* Xo; bf16_t* Ob;
    __device__ __forceinline__ void operator()(const f32x4 (&acc)[2][2][4][2], const Unit& u, int wr, int wc, int fr, int fq) const {
        const int row0 = u.pm * BM + wr * 64 + fr, col0 = u.pn * BM + wc * 32 + 4 * fq;
#pragma unroll
        for (int ai = 0; ai < 2; ++ai)
#pragma unroll
            for (int m = 0; m < 4; ++m) { const size_t ro = (size_t)(row0 + ai * HALF + m * 16) * 1024 + col0;
#pragma unroll
                for (int bj = 0; bj < 2; ++bj)
#pragma unroll
                    for (int n = 0; n < 2; ++n) { const size_t o = ro + bj * HALF + n * 16;
                        const f32x4 xi = *(const f32x4*)(Xi + o); const f32x4 v = xi + acc[ai][bj][m][n];
                        *(f32x4*)(Xo + o) = v; uint2 pk; pk.x = pack2(v[0], v[1]); pk.y = pack2(v[2], v[3]); *(uint2*)(Ob + o) = pk; } }
    }
};
struct EpiGate {
    static constexpr bool PERM = true;
    float* X; const bf16_t* E;
    __device__ __forceinline__ void operator()(const f32x4 (&acc)[2][2][4][2], const Unit& u, int wr, int wc, int fr, int fq) const {
        const int row0 = u.pm * BM + wr * 64 + fr, col0 = u.pn * BM + wc * 32 + 8 * fq;
#pragma unroll
        for (int ai = 0; ai < 2; ++ai)
#pragma unroll
            for (int m = 0; m < 4; ++m) { const size_t ro = (size_t)(row0 + ai * HALF + m * 16) * 1024 + col0;
#pragma unroll
                for (int bj = 0; bj < 2; ++bj) { const size_t o = ro + bj * HALF;
                    const uint4 ev = *(const uint4*)(E + o); float ef[8]; unpack8(ev, ef);
#pragma unroll
                    for (int n = 0; n < 2; ++n) { const f32x4 xi = *(const f32x4*)(X + o + 4 * n); f32x4 v;
#pragma unroll
                        for (int i = 0; i < 4; ++i) v[i] = xi[i] + ef[4 * n + i] * sigmoidf_(acc[ai][bj][m][n][i]);
                        *(f32x4*)(X + o + 4 * n) = v; } } }
    }
};
}

struct Args { const float* in[28]; float* out; unsigned char* ws; int ph_lo, ph_hi; };

struct Frame {
    int tid, lane, wave, G, bid, gw, nw;
    unsigned char* lds;
    unsigned* ctl;
    const float* in[28]; float* out; unsigned char* ws;
    const LAS unsigned char* lut;
    const LAS float* tbl;
    const LAS float* biasL;
    LAS unsigned char* ldsl;
};
DI int t5b(const Frame& F, int n) { return n < 16 ? n : (n >= 113 ? 31 : (int)F.lut[n]); }

DI bool phase_refresh(Frame& F) { int t_ = threadIdx.x; asm volatile("" : "+v"(t_)); F.tid = t_; F.lane = t_ & 63; return true; }
template <class Map>
DI void transpose_w(const Frame& F, const float* src, int K, int Nsrc, bf16_t* dst, int Npad, Map map) {
    float* tile = (float*)F.lds;
    const int ntn = Npad / 64, ntk = K / 64, ntiles = ntn * ntk;
    for (int tix = F.bid; tix < ntiles; tix += F.G) {
        const int nt = tix / ntk, kt = tix % ntk;
        for (int e = F.tid; e < 4096; e += 512) { const int kk = e >> 6, nn = e & 63; const int col = map(nt * 64 + nn);
            tile[kk * 65 + nn] = col >= 0 ? src[(size_t)(kt * 64 + kk) * Nsrc + col] : 0.f; }
        __syncthreads();
        for (int e = F.tid; e < 4096; e += 512) { const int nn = e >> 6, kk = e & 63;
            dst[(size_t)(nt * 64 + nn) * K + kt * 64 + kk] = f2bf(tile[kk * 65 + nn]); }
        __syncthreads();
    }
}
template <int OUTF>
DI void rmsnorm_rows(const Frame& F, const float* X, const float* g, bf16_t* Ob, float* Of) {
    for (int row = F.gw; row < MT; row += F.nw) {
        const float* xr = X + (size_t)row * 1024;
        f32x4 v[4]; float ss = 0.f;
#pragma unroll
        for (int i = 0; i < 4; ++i) { v[i] = *(const f32x4*)(xr + i * 256 + F.lane * 4); ss += v[i][0] * v[i][0] + v[i][1] * v[i][1] + v[i][2] * v[i][2] + v[i][3] * v[i][3]; }
        ss = wave_sum(ss);
        const float rs = rsqrtf(ss * (1.0f / 1024.0f) + 1e-6f);
#pragma unroll
        for (int i = 0; i < 4; ++i) { const f32x4 gg = *(const f32x4*)(g + i * 256 + F.lane * 4); f32x4 y;
            for (int j = 0; j < 4; ++j) y[j] = v[i][j] * rs * gg[j];
            if (OUTF) *(f32x4*)(Of + (size_t)row * 1024 + i * 256 + F.lane * 4) = y;
            else { uint2 pk; pk.x = pack2(y[0], y[1]); pk.y = pack2(y[2], y[3]); *(uint2*)(Ob + (size_t)row * 1024 + i * 256 + F.lane * 4) = pk; } }
    }
}
DI void p0_prologue(const Frame& F) {
    unsigned char* ws = F.ws;
    transpose_w(F, F.in[7], 1024, 3292, (bf16_t*)(ws + WS_WIN0), LD0, [](int n) { return map0(n); });
    transpose_w(F, F.in[7], 1024, 3292, (bf16_t*)(ws + WS_WVT), 512, [](int n) { return mapv(n); });
    transpose_w(F, F.in[8], 1024, 1024, (bf16_t*)(ws + WS_WOUT0), 1024, [](int n) { return mapid(n); });
    transpose_w(F, F.in[5], 1024, 1024, (bf16_t*)(ws + WS_WG0), 1024, [](int n) { return mapid(n); });
    transpose_w(F, F.in[5] + (size_t)1024 * 1024, 1024, 1024, (bf16_t*)(ws + WS_WG1), 1024, [](int n) { return mapid(n); });
    transpose_w(F, F.in[4], 256, 1024, (bf16_t*)(ws + WS_WP0), 1024, [](int n) { return mapid(n); });
    transpose_w(F, F.in[4] + (size_t)256 * 1024, 256, 1024, (bf16_t*)(ws + WS_WP1), 1024, [](int n) { return mapid(n); });
    transpose_w(F, F.in[15], 1024, 3592, (bf16_t*)(ws + WS_WIN1), LD1, [](int n) { return map1(n); });
    transpose_w(F, F.in[16], 1024, 1024, (bf16_t*)(ws + WS_WOUT1), 1024, [](int n) { return mapid(n); });
    transpose_w(F, F.in[10], 2048, 256, (bf16_t*)(ws + WS_WC1K), 256, [](int n) { return mapid(n); });
    transpose_w(F, F.in[13], 2048, 256, (bf16_t*)(ws + WS_WC1V), 256, [](int n) { return mapid(n); });
    rmsnorm_rows<0>(F, F.in[0], F.in[2], (bf16_t*)(ws + WS_BFA), nullptr);
    { const float* p = F.in[1]; bf16_t* pb = (bf16_t*)(ws + WS_PBF); const size_t n8 = (size_t)2 * MT * 256 / 8;
      for (size_t i = (size_t)F.bid * 512 + F.tid; i < n8; i += (size_t)F.G * 512) {
          const f32x4 a = *(const f32x4*)(p + i * 8), b = *(const f32x4*)(p + i * 8 + 4);
          uint4 o; o.x = pack2(a[0], a[1]); o.y = pack2(a[2], a[3]); o.z = pack2(b[0], b[1]); o.w = pack2(b[2], b[3]); *(uint4*)(pb + i * 8) = o; } }
}

DI void p2a_build_blocks(const Frame& F) {
    const bf16_t* U = (const bf16_t*)(F.ws + WS_U);
    bf16_t* AK = (bf16_t*)(F.ws + WS_AK); bf16_t* AV = (bf16_t*)(F.ws + WS_AV);
    const float* posk = F.in[9]; const float* posv = F.in[12];
    const size_t nitem = (size_t)2 * 4096 * 32 * 8;
    for (size_t it = (size_t)F.bid * 512 + F.tid; it < nitem; it += (size_t)F.G * 512) {
        const int c8 = (int)(it & 7), l = (int)((it >> 3) & 31), r = (int)((it >> 8) & 4095), which = (int)(it >> 20);
        bf16_t* dst = (which ? AV : AK) + (size_t)r * 2048 + l * 64 + c8 * 8;
        uint4 o = make_uint4(0u, 0u, 0u, 0u);
        if (r < 4080) {
            const int b = r / 510, rem = r % 510, i = rem >> 1, g = rem & 1;
            const bf16_t* sp = U + ((size_t)b * SEQ + 16 * i + l) * LD0 + (which ? C_VC : C_KC) + g * 64 + c8 * 8;
            const float* pp = (which ? posv : posk) + l * 64 + c8 * 8;
            const uint4 v = *(const uint4*)sp; float f[8]; unpack8(v, f);
            o.x = pack2(f[0] + pp[0], f[1] + pp[1]); o.y = pack2(f[2] + pp[2], f[3] + pp[3]); o.z = pack2(f[4] + pp[4], f[5] + pp[5]); o.w = pack2(f[6] + pp[6], f[7] + pp[7]);
        }
        *(uint4*)dst = o;
    }
}
DI void p2c_compress_out(const Frame& F) {
    const bf16_t* HK = (const bf16_t*)(F.ws + WS_HK); const bf16_t* HV = (const bf16_t*)(F.ws + WS_HV);
    float* KC = (float*)(F.ws + WS_KCMP); float* VC = (float*)(F.ws + WS_VCMP);
    const float* w2k = F.in[11]; const float* w2v = F.in[14];
    for (int it = F.gw; it < 2 * 16 * 256; it += F.nw) {
        const int i = it & 255, bg = (it >> 8) & 15, which = it >> 12;
        float acc = 0.f;
        if (i < NCMP) {
            const int b = bg >> 1, g = bg & 1; const int r = (b * 255 + i) * 2 + g;
            const bf16_t* hr = (which ? HV : HK) + (size_t)r * 256; const float* w2 = which ? w2v : w2k;
            for (int j = 0; j < 256; j += 8) { const uint4 hv = *(const uint4*)(hr + j); float hf[8]; unpack8(hv, hf);
#pragma unroll
                for (int q = 0; q < 8; ++q) acc += hf[q] * w2[(size_t)(j + q) * 64 + F.lane]; }
        }
        (which ? VC : KC)[((size_t)bg * 256 + i) * 64 + F.lane] = acc;
        if (which) ((bf16_t*)(F.ws + WS_VCT))[((size_t)bg * 64 + F.lane) * 256 + i] = f2bf(acc);
    }
}

template <int NH>
DI void dotn_bf(const bf16_t* kp, const float* qs, float (&acc)[NH]) {
#pragma unroll
    for (int h = 0; h < NH; ++h) acc[h] = 0.f;
#pragma unroll 2
    for (int c = 0; c < 8; ++c) { const uint4 v = *(const uint4*)(kp + c * 8); float kf[8]; unpack8(v, kf);
#pragma unroll
        for (int h = 0; h < NH; ++h) { const f32x4 q0 = *(const f32x4*)(qs + h * 64 + c * 8), q1 = *(const f32x4*)(qs + h * 64 + c * 8 + 4);
            acc[h] += q0[0] * kf[0] + q0[1] * kf[1] + q0[2] * kf[2] + q0[3] * kf[3] + q1[0] * kf[4] + q1[1] * kf[5] + q1[2] * kf[6] + q1[3] * kf[7]; } }
}
DI void dot4_bf(const bf16_t* kp, const float* qs, float (&acc)[4]) { dotn_bf<4>(kp, qs, acc); }
DI void dot4_f32(const float* kp, const float* qs, float (&acc)[4]) {
    acc[0] = acc[1] = acc[2] = acc[3] = 0.f;
#pragma unroll 4
    for (int c = 0; c < 16; ++c) { const f32x4 kv = *(const f32x4*)(kp + c * 4);
#pragma unroll
        for (int h = 0; h < 4; ++h) { const f32x4 q0 = *(const f32x4*)(qs + h * 64 + c * 4);
            acc[h] += q0[0] * kv[0] + q0[1] * kv[1] + q0[2] * kv[2] + q0[3] * kv[3]; } }
}

template <int NH, int HS>
DI void softmax_lds(float* ps, int nr, int lane, float (&inv)[NH]) {
#pragma unroll
    for (int h = 0; h < NH; ++h) {
        float mx = NEG_INF;
#pragma unroll 1
        for (int r = 0; r < nr; ++r) mx = fmaxf(mx, ps[h * HS + r * 64 + lane]);
        mx = wave_max(mx);
        float sm = 0.f;
#pragma unroll 1
        for (int r = 0; r < nr; ++r) { const float sv = ps[h * HS + r * 64 + lane]; const float e = sv > NEG_INF ? expf(sv - mx) : 0.f; ps[h * HS + r * 64 + lane] = e; sm += e; }
        sm = wave_sum(sm);
        inv[h] = sm > 0.f ? 1.0f / sm : 0.f;
    }
}

DI void nsa_task(const Frame& F, int b, int g, int t, float* wl) {
    int lane = F.lane; asm volatile("" : "+v"(lane)); asm volatile("" : "+v"(wl));
    const bf16_t* U = (const bf16_t*)(F.ws + WS_U);
    const float* KC = (const float*)(F.ws + WS_KCMP) + (size_t)(b * 2 + g) * 256 * 64;
    const float* VC = (const float*)(F.ws + WS_VCMP) + (size_t)(b * 2 + g) * 256 * 64;
    bf16_t* Y = (bf16_t*)(F.ws + WS_BFB);
    const size_t row = (size_t)b * SEQ + t;
    const bf16_t* Ur = U + row * LD0;
    float* qs = wl; float* ps = wl + 256;
    const LAS float* tb = F.tbl + (g * 4) * 32;
    __builtin_amdgcn_wave_barrier();
#pragma unroll
    for (int h = 0; h < 4; ++h) qs[h * 64 + lane] = bf2f(Ur[C_AQ + (g * 4 + h) * 64 + lane]);
    __builtin_amdgcn_wave_barrier();
    float oc[4] = {0.f, 0.f, 0.f, 0.f}, os[4] = {0.f, 0.f, 0.f, 0.f}, ow[4] = {0.f, 0.f, 0.f, 0.f};
    float inv[4];

    const int nv = t >= 31 ? ((t - 31) >> 4) + 1 : 0;
#pragma unroll 1
    for (int r = 0; r < 4; ++r) {
        const int i = r * 64 + lane; const bool valid = i < nv;
        float sc[4] = {NEG_INF, NEG_INF, NEG_INF, NEG_INF};
        if (r * 64 < nv) {
            float acc[4]; dot4_f32(KC + (size_t)(valid ? i : 0) * 64, qs, acc);
            if (valid) { const int bk = t5b(F, t - (16 * i + 31));
#pragma unroll
                for (int h = 0; h < 4; ++h) sc[h] = acc[h] * 0.125f + tb[h * 32 + bk]; }
        }
#pragma unroll
        for (int h = 0; h < 4; ++h) ps[h * 512 + i] = sc[h];
    }
    __builtin_amdgcn_wave_barrier();
    softmax_lds<4, 512>(ps, 4, lane, inv);
#pragma unroll 1
    for (int r = 0; r < 4; ++r) {
#pragma unroll
        for (int h = 0; h < 4; ++h) ps[h * 512 + r * 64 + lane] *= inv[h];
    }
    __builtin_amdgcn_wave_barrier();
#pragma unroll 8
    for (int i = 0; i < nv; ++i) { const float v = VC[(size_t)i * 64 + lane];
#pragma unroll
        for (int h = 0; h < 4; ++h) oc[h] += ps[h * 512 + i] * v; }
#ifndef NSA_STAGE
#define NSA_STAGE 4
#endif
    if (NSA_STAGE < 2) return;
    const int cur = t >> 6;
    unsigned long long selmask = 0ull; const int npick = (cur + 1) < 8 ? (cur + 1) : 8;
    {
        float imp = 0.f;
        const int i0 = 4 * lane - 1 < 0 ? 0 : 4 * lane - 1, i1 = 4 * lane + 3 > 254 ? 254 : 4 * lane + 3;
#pragma unroll
        for (int h = 0; h < 4; ++h) for (int i = i0; i <= i1; ++i) imp += ps[h * 512 + i];
        const bool adm = lane <= cur; const bool forced = (lane == 0) || (lane == cur) || (lane == cur - 1);
        float score = adm ? imp + (forced ? 1.0e4f : 0.f) : NEG_INF;
#pragma unroll 1
        for (int k = 0; k < npick; ++k) {
            const float mx = wave_max(score);
            const unsigned long long cand = __ballot(score == mx);
            const int j = cand ? __builtin_ctzll(cand) : 0;
            selmask |= 1ull << j;
            if (lane == j) score = NEG_INF;
        }
    }
    __builtin_amdgcn_wave_barrier();
    {
        unsigned long long m = selmask;
#pragma unroll 1
        for (int k = 0; k < npick; ++k) {
            const int j = __builtin_ctzll(m); m &= m - 1;
            const int pos = j * 64 + lane;
            float sc[4] = {NEG_INF, NEG_INF, NEG_INF, NEG_INF};
            float acc[4]; dot4_bf(U + ((size_t)b * SEQ + pos) * LD0 + C_KS + g * 64, qs, acc);
            if (pos <= t) { const int bk = t5b(F, t - pos);
#pragma unroll
                for (int h = 0; h < 4; ++h) sc[h] = acc[h] * 0.125f + tb[h * 32 + bk]; }
#pragma unroll
            for (int h = 0; h < 4; ++h) ps[h * 512 + k * 64 + lane] = sc[h];
        }
        __builtin_amdgcn_wave_barrier();
        softmax_lds<4, 512>(ps, npick, lane, inv);
        __builtin_amdgcn_wave_barrier();
        m = selmask;
#pragma unroll 1
        for (int k = 0; k < npick; ++k) {
            const int j = __builtin_ctzll(m); m &= m - 1;
            const int kend = (j * 64 + 63 <= t) ? 64 : (t - j * 64 + 1);
#pragma unroll 8
            for (int kk = 0; kk < kend; ++kk) {
                const float v = bf2f(U[((size_t)b * SEQ + j * 64 + kk) * LD0 + C_VS + g * 64 + lane]);
#pragma unroll
                for (int h = 0; h < 4; ++h) os[h] += ps[h * 512 + k * 64 + kk] * v; }
        }
#pragma unroll
        for (int h = 0; h < 4; ++h) os[h] *= inv[h];
    }
    __builtin_amdgcn_wave_barrier();
    if (NSA_STAGE < 3) return;
    {
#pragma unroll 1
        for (int r = 0; r < 8; ++r) {
            const int pos = t - 511 + r * 64 + lane;
            float sc[4] = {NEG_INF, NEG_INF, NEG_INF, NEG_INF};
            if (t - 511 + r * 64 + 63 >= 0) {
                float acc[4]; dot4_bf(U + ((size_t)b * SEQ + (pos < 0 ? 0 : pos)) * LD0 + C_KW + g * 64, qs, acc);
                if (pos >= 0) { const int bk = t5b(F, t - pos);
#pragma unroll
                    for (int h = 0; h < 4; ++h) sc[h] = acc[h] * 0.125f + tb[h * 32 + bk]; }
            }
#pragma unroll
            for (int h = 0; h < 4; ++h) ps[h * 512 + r * 64 + lane] = sc[h];
        }
        __builtin_amdgcn_wave_barrier();
        softmax_lds<4, 512>(ps, 8, lane, inv);
        __builtin_amdgcn_wave_barrier();
        const int pi0 = (t >= 511 ? 0 : 511 - t) & ~7;
#pragma unroll 8
        for (int pi = pi0; pi < 512; ++pi) {
            const int pos = t - 511 + pi;
            const float v = bf2f(U[((size_t)b * SEQ + (pos < 0 ? 0 : pos)) * LD0 + C_VW + g * 64 + lane]);
#pragma unroll
            for (int h = 0; h < 4; ++h) ow[h] += ps[h * 512 + pi] * v; }
#pragma unroll
        for (int h = 0; h < 4; ++h) ow[h] *= inv[h];
    }
    if (NSA_STAGE < 4) return;
    const float gsig = sigmoidf_(bf2f(Ur[C_AG + g * 12 + (lane < 12 ? lane : 0)]));
#pragma unroll
    for (int h = 0; h < 4; ++h) {
        const int hh = g * 4 + h;
        const float g0 = __shfl(gsig, h * 3 + 0), g1 = __shfl(gsig, h * 3 + 1), g2 = __shfl(gsig, h * 3 + 2);
        const float oa = g0 * oc[h] + g1 * os[h] + g2 * ow[h];
        const float z = bf2f(Ur[C_AZ + hh * 64 + lane]);
        Y[row * 1024 + hh * 64 + lane] = f2bf(oa * siluf_(z));
    }
    __builtin_amdgcn_wave_barrier();
}

DI unsigned okey(float x) { unsigned u = __float_as_uint(x); if ((u << 1) == 0u) u = 0u; return (u >> 31) ? ~u : (u | 0x80000000u); }

DI void dsa_task(const Frame& F, int b, int t, float* wl, unsigned* keys) {
    int lane = F.lane; asm volatile("" : "+v"(lane)); asm volatile("" : "+v"(wl)); asm volatile("" : "+v"(keys));
    const bf16_t* U = (const bf16_t*)(F.ws + WS_U);
    bf16_t* Y = (bf16_t*)(F.ws + WS_BFB);
    const size_t row = (size_t)b * SEQ + t;
    const bf16_t* Ur = U + row * LD0;
    float* qis = wl; float* qds = wl + 256; int* idx = (int*)(wl + 768); float* pb = (float*)keys;
    const LAS float* tb = F.tbl + 8 * 32;
    __builtin_amdgcn_wave_barrier();
#pragma unroll
    for (int h = 0; h < 4; ++h) qis[h * 64 + lane] = bf2f(Ur[C_BQI + h * 64 + lane]);
#pragma unroll
    for (int h = 0; h < 8; ++h) qds[h * 64 + lane] = bf2f(Ur[C_BQ + h * 64 + lane]);
    float wi[4];
#pragma unroll
    for (int h = 0; h < 4; ++h) wi[h] = bf2f(Ur[C_BWI + h]) * 0.0625f;
    __builtin_amdgcn_wave_barrier();
    const int nk = t + 1, nr = (nk + 63) >> 6;
    int nsel;
    if (nk <= 256) {
#pragma unroll 1
        for (int r = 0; r < nr; ++r) { const int s = r * 64 + lane; if (s < nk) idx[s] = s; }
        nsel = nk;
    } else {
#pragma unroll 1
        for (int r = 0; r < nr; ++r) {
            const int s = r * 64 + lane; unsigned key = 0u;
            float acc[4]; dot4_bf(U + ((size_t)b * SEQ + (s < nk ? s : t)) * LD0 + C_BKI, qis, acc);
            if (s < nk) { const float scv = wi[0] * fmaxf(acc[0], 0.f) + wi[1] * fmaxf(acc[1], 0.f) + wi[2] * fmaxf(acc[2], 0.f) + wi[3] * fmaxf(acc[3], 0.f); key = okey(scv); }
            keys[s] = key;
        }
        __builtin_amdgcn_wave_barrier();
        unsigned tau = 0u;
#pragma unroll 1
        for (int bit = 31; bit >= 0; --bit) {
            const unsigned trial = tau | (1u << bit); int cnt = 0;
#pragma unroll 8
            for (int r = 0; r < nr; ++r) cnt += keys[r * 64 + lane] >= trial ? 1 : 0;
            cnt = (int)wave_sum((float)cnt);
            if (cnt >= 256) tau = trial;
        }
        int cgt = 0;
#pragma unroll 1
        for (int r = 0; r < nr; ++r) cgt += keys[r * 64 + lane] > tau ? 1 : 0;
        cgt = (int)wave_sum((float)cgt);
        const int quota = 256 - cgt;
        int base = 0, taken = 0;
        const unsigned long long ltmask = (1ull << lane) - 1ull;
#pragma unroll 1
        for (int r = 0; r < nr; ++r) {
            const unsigned key = keys[r * 64 + lane];
            const bool eq = key == tau;
            const unsigned long long eqm = __ballot(eq);
            const int erank = __popcll(eqm & ltmask);
            const bool sel = (key > tau) || (eq && (taken + erank < quota));
            const unsigned long long sm = __ballot(sel);
            if (sel) idx[base + __popcll(sm & ltmask)] = r * 64 + lane;
            base += __popcll(sm); taken += __popcll(eqm);
        }
        nsel = 256;
    }
    __builtin_amdgcn_wave_barrier();
    const int nr2 = (nsel + 63) >> 6;
#pragma unroll 1
    for (int r = 0; r < nr2; ++r) {
        const int j = r * 64 + lane; const bool valid = j < nsel; const int s = valid ? idx[j] : 0;
        const bf16_t* kp = U + ((size_t)b * SEQ + s) * LD0 + C_BK;
        float a0[8]; dotn_bf<8>(kp, qds, a0);
        const int bk = t5b(F, valid ? t - s : 0);
#pragma unroll
        for (int h = 0; h < 8; ++h) pb[h * 256 + j] = valid ? a0[h] * 0.125f + tb[h * 32 + bk] : NEG_INF;
    }
    __builtin_amdgcn_wave_barrier();
    float inv[8];
    softmax_lds<8, 256>(pb, nr2, lane, inv);
    __builtin_amdgcn_wave_barrier();
    float ob[8] = {0.f, 0.f, 0.f, 0.f, 0.f, 0.f, 0.f, 0.f};
#pragma unroll 8
    for (int j = 0; j < nsel; ++j) {
        const int s = idx[j];
        const float v = bf2f(U[((size_t)b * SEQ + s) * LD0 + C_BV + lane]);
#pragma unroll
        for (int h = 0; h < 8; ++h) ob[h] += pb[h * 256 + j] * v;
    }
#pragma unroll
    for (int h = 0; h < 8; ++h) {
        const float z = bf2f(Ur[C_BZ + h * 64 + lane]);
        Y[row * 1024 + 512 + h * 64 + lane] = f2bf(ob[h] * inv[h] * siluf_(z));
    }
    __builtin_amdgcn_wave_barrier();
}

#ifndef ATT_NAIVE
#define ATT_NAIVE 0
#endif
#if ATT_NAIVE
DI void p3_attention(const Frame& F) {
    unsigned char* base = F.lds;
    constexpr int DSA_W = 4;
    float* wl_nsa; float* wl_dsa = nullptr; unsigned* keys = nullptr;
    if (F.wave < DSA_W) { unsigned char* R = base + F.wave * 20480; keys = (unsigned*)R; wl_dsa = (float*)(R + 16384); wl_nsa = (float*)R; }
    else wl_nsa = (float*)(base + DSA_W * 20480 + (F.wave - DSA_W) * 9216);
    unsigned* qn = F.ctl + CW_QNSA; unsigned* qd = F.ctl + CW_QDSA;
    const int NDSA = NB * SEQ, NNSA = NB * 2 * SEQ;
#ifndef ATT_MASK
#define ATT_MASK 3
#endif
    if ((ATT_MASK & 1) && F.wave < DSA_W) {
        for (;;) {
            unsigned k = 0; if (F.lane == 0) k = __hip_atomic_fetch_add(qd, 1u, __ATOMIC_RELAXED, __HIP_MEMORY_SCOPE_AGENT);
            k = __builtin_amdgcn_readfirstlane(k);
            if (k >= (unsigned)NDSA) break;
            const int t = SEQ - 1 - (int)(k >> 3), b = (int)(k & 7);
            dsa_task(F, b, t, wl_dsa, keys);
        }
    }
    if (ATT_MASK & 2) for (;;) {
        unsigned k = 0; if (F.lane == 0) k = __hip_atomic_fetch_add(qn, 1u, __ATOMIC_RELAXED, __HIP_MEMORY_SCOPE_AGENT);
        k = __builtin_amdgcn_readfirstlane(k);
        if (k >= (unsigned)NNSA) break;
        const int t = SEQ - 1 - (int)(k >> 4), bg = (int)(k & 15);
        nsa_task(F, bg >> 1, bg & 1, t, wl_nsa);
    }
}

#else
typedef float f32x16 __attribute__((ext_vector_type(16)));
#define MFMA32(a, b, c) __builtin_amdgcn_mfma_f32_32x32x16_bf16((a), (b), (c), 0, 0, 0)
constexpr float LOG2E = 1.4426950408889634f;
constexpr float QK_C1 = 0.125f * LOG2E;
constexpr int AT_BUF = 0;
constexpr int AT_PSUM = 32768;
constexpr int AT_SELM = AT_PSUM + 65536;
constexpr int AT_MISC = AT_SELM + 1024;
constexpr int AT_END = AT_MISC + 64 + 2048;
static_assert(AT_END + LDS_WORK_OFF <= LDS_BYTES - 12288, "attention lds");
enum { FL_NEAR = 1, FL_CAUSAL = 2, FL_WINLO = 4, FL_BITS = 8, FL_LANE = 16 };

struct Att { float m, l; f32x16 o0, o1; };
DI void att_init(Att& a) { a.m = NEG_INF; a.l = 0.f;
#pragma unroll
    for (int i = 0; i < 16; ++i) { a.o0[i] = 0.f; a.o1[i] = 0.f; } }

typedef unsigned u32x4 __attribute__((ext_vector_type(4)));
#define OPAQUE(x) asm volatile("" : "+v"(x))
DI void st_write_K(LAS unsigned char* Kt, int tid, const uint4& rg) {
    OPAQUE(tid);
    const int key = tid >> 3, c = tid & 7;
    const u32x4 v = {rg.x, rg.y, rg.z, rg.w};
    *(LAS u32x4*)(Kt + key * 128 + ((c ^ (key & 7)) << 4)) = v;
}
DI void st_write_VT(LAS unsigned char* Vt, int tid, const uint4& rg) {
    OPAQUE(tid);
    const int d = tid >> 3, m = tid & 7, G = m >> 1, a = m & 1, sw = (d >> 1) & 7;
    typedef unsigned u32x2 __attribute__((ext_vector_type(2)));
    const u32x2 lo = {rg.x, rg.y}, hi = {rg.z, rg.w};
    *(LAS u32x2*)(Vt + d * 128 + (((2 * G) ^ sw) << 4) + 8 * a) = lo;
    *(LAS u32x2*)(Vt + d * 128 + (((2 * G + 1) ^ sw) << 4) + 8 * a) = hi;
}
DI void qk_tile(const LAS unsigned char* Kt, const bf16x8 (&qf)[4], int r, int hf, f32x16& s0, f32x16& s1) {
    OPAQUE(r); OPAQUE(hf);
#pragma unroll
    for (int i = 0; i < 16; ++i) { s0[i] = 0.f; s1[i] = 0.f; }
#pragma unroll
    for (int s = 0; s < 4; ++s) {
        const int c = 2 * s + hf;
        const bf16x8 a0 = *(const LAS bf16x8*)(Kt + r * 128 + ((c ^ (r & 7)) << 4));
        const bf16x8 a1 = *(const LAS bf16x8*)(Kt + (32 + r) * 128 + ((c ^ (r & 7)) << 4));
        s0 = MFMA32(a0, qf[s], s0); s1 = MFMA32(a1, qf[s], s1);
    }
}
template <int FLAGS>
DI void fix_scores(f32x16& s, int posb, int kstep, int tq, const LAS float* bl, float bfar, unsigned mword, bool laneok, int hf) {
    OPAQUE(hf); OPAQUE(tq);
#pragma unroll
    for (int i = 0; i < 16; ++i) {
        const int koff = (i & 3) + 8 * (i >> 2) + 4 * hf;
        const int dist = tq - (posb + kstep * koff);
        float bias = bfar;
        if (FLAGS & FL_NEAR) { int dd = dist < 0 ? 0 : dist; dd = dd > 127 ? 127 : dd; bias = bl[dd]; }
        const float v = s[i] * QK_C1 + bias;
        bool ok = true;
        if (FLAGS & FL_CAUSAL) ok = ok && (dist >= 0);
        if (FLAGS & FL_WINLO) ok = ok && (dist < 512);
        if (FLAGS & FL_BITS) ok = ok && (((mword >> koff) & 1u) != 0u);
        if (FLAGS & FL_LANE) ok = ok && laneok;
        s[i] = ok ? v : NEG_INF;
    }
}
DI bf16x8 pack8(const f32x16& x, int s) {
    typedef unsigned u32x4 __attribute__((ext_vector_type(4)));
    u32x4 p;
    p[0] = pack2(x[8 * s + 0], x[8 * s + 1]); p[1] = pack2(x[8 * s + 2], x[8 * s + 3]); p[2] = pack2(x[8 * s + 4], x[8 * s + 5]); p[3] = pack2(x[8 * s + 6], x[8 * s + 7]);
    return __builtin_bit_cast(bf16x8, p);
}
DI void pv_tile(const LAS unsigned char* Vt, const f32x16& p0, const f32x16& p1, int r, int hf, f32x16& o0, f32x16& o1) {
    OPAQUE(r); OPAQUE(hf);
#pragma unroll
    for (int G = 0; G < 4; ++G) {
        const bf16x8 pb = pack8((G >> 1) ? p1 : p0, G & 1);
        const int cc = 2 * G + hf;
        const bf16x8 a0 = *(const LAS bf16x8*)(Vt + r * 128 + ((cc ^ ((r >> 1) & 7)) << 4));
        const bf16x8 a1 = *(const LAS bf16x8*)(Vt + (32 + r) * 128 + ((cc ^ ((r >> 1) & 7)) << 4));
        o0 = MFMA32(a0, pb, o0); o1 = MFMA32(a1, pb, o1);
    }
}
DI void online_pv(Att& st, f32x16& s0, f32x16& s1, const LAS unsigned char* Vt, int r, int hf) {
    float tm = NEG_INF;
#pragma unroll
    for (int i = 0; i < 16; ++i) tm = fmaxf(tm, fmaxf(s0[i], s1[i]));
    tm = fmaxf(tm, __shfl_xor(tm, 32));
    const float mn = fmaxf(st.m, tm);
    const float mu = (mn == NEG_INF) ? 0.f : mn;
    const float alpha = __builtin_amdgcn_exp2f(st.m - mu);
    float ls = 0.f;
#pragma unroll
    for (int i = 0; i < 16; ++i) { s0[i] = __builtin_amdgcn_exp2f(s0[i] - mu); s1[i] = __builtin_amdgcn_exp2f(s1[i] - mu); ls += s0[i] + s1[i]; }
    st.l = st.l * alpha + ls;
    if (__ballot(mn != st.m) != 0ull) {
#pragma unroll
        for (int i = 0; i < 16; ++i) { st.o0[i] *= alpha; st.o1[i] *= alpha; } }
    st.m = mn;
    pv_tile(Vt, s0, s1, r, hf, st.o0, st.o1);
}
template <bool BITS>
DI void online_pv_far(Att& st, f32x16& s0, f32x16& s1, const LAS unsigned char* Vt, int r, int hf, float bfar, bool laneok, unsigned m0, unsigned m1) {
    OPAQUE(hf);
    float tm = fmaxf(s0[0], s1[0]);
#pragma unroll
    for (int i = 1; i < 16; ++i) tm = fmaxf(fmaxf(tm, s0[i]), s1[i]);
    tm = laneok ? tm * QK_C1 + bfar : NEG_INF;
    tm = fmaxf(tm, __shfl_xor(tm, 32));
    const float mn = fmaxf(st.m, tm);
    const float mu = (mn == NEG_INF) ? 0.f : mn;
    const float alpha = __builtin_amdgcn_exp2f(st.m - mu);
    const float cb = laneok ? bfar - mu : NEG_INF;
    const unsigned w0 = m0 >> (4 * hf), w1 = m1 >> (4 * hf);
    float ls = 0.f;
#pragma unroll
    for (int i = 0; i < 16; ++i) {
        float p0 = __builtin_amdgcn_exp2f(s0[i] * QK_C1 + cb), p1 = __builtin_amdgcn_exp2f(s1[i] * QK_C1 + cb);
        if (BITS) { const int kc = (i & 3) + 8 * (i >> 2);
            p0 = __uint_as_float(__float_as_uint(p0) & (unsigned)__builtin_amdgcn_sbfe((int)w0, kc, 1));
            p1 = __uint_as_float(__float_as_uint(p1) & (unsigned)__builtin_amdgcn_sbfe((int)w1, kc, 1)); }
        s0[i] = p0; s1[i] = p1; ls += p0 + p1;
    }
    st.l = st.l * alpha + ls;
    if (__ballot(mn != st.m) != 0ull) {
#pragma unroll
        for (int i = 0; i < 16; ++i) { st.o0[i] *= alpha; st.o1[i] *= alpha; } }
    st.m = mn;
    pv_tile(Vt, s0, s1, r, hf, st.o0, st.o1);
}
#define LDS_BARRIER() do { asm volatile("s_waitcnt lgkmcnt(0)" ::: "memory"); __builtin_amdgcn_s_barrier(); asm volatile("" ::: "memory"); } while (0)
template <class LD, class BODY>
DI void tile_stream(int n, LAS unsigned char* buf, int tid, bool useV, LD ld, BODY body) {
    if (n <= 0) return;
    uint4 rk, rv = make_uint4(0u, 0u, 0u, 0u);
    ld(0, rk, rv);
    st_write_K(buf, tid, rk); if (useV) st_write_VT(buf + 8192, tid, rv);
    if (n > 1) ld(1, rk, rv);
    LDS_BARRIER();
#pragma unroll 1
    for (int i = 0; i < n; ++i) {
        LAS unsigned char* cur = buf + (i & 1) * 16384;
        if (i + 1 < n) { LAS unsigned char* nxt = buf + ((i + 1) & 1) * 16384; st_write_K(nxt, tid, rk); if (useV) st_write_VT(nxt + 8192, tid, rv); if (i + 2 < n) ld(i + 2, rk, rv); }
        body(i, cur, cur + 8192);
        LDS_BARRIER();
    }
}
DI uint4 cvt8_f32(const float* p) { const f32x4 a = *(const f32x4*)p, b = *(const f32x4*)(p + 4); uint4 o; o.x = pack2(a[0], a[1]); o.y = pack2(a[2], a[3]); o.z = pack2(b[0], b[1]); o.w = pack2(b[2], b[3]); return o; }

DI void nsa_unit(const Frame& F, int b, int g, int qb) {
    const int tid = F.tid, lane = F.lane, w = F.wave, r = lane & 31, hf = lane >> 5;
    LAS unsigned char* L = F.ldsl;
    LAS unsigned char* buf = L + AT_BUF;
    LAS float* psum = (LAS float*)(L + AT_PSUM);
    LAS unsigned long long* selm = (LAS unsigned long long*)(L + AT_SELM);
    LAS unsigned char* tlist = L + AT_SELM + 528;
    LAS int* tcnt = (LAS int*)(L + AT_SELM + 520);
    const bf16_t* U = (const bf16_t*)(F.ws + WS_U);
    const float* KC = (const float*)(F.ws + WS_KCMP) + (size_t)(b * 2 + g) * 256 * 64;
    const bf16_t* VCT = (const bf16_t*)(F.ws + WS_VCT) + (size_t)(b * 2 + g) * 64 * 256;
    const bf16_t* VT = (const bf16_t*)(F.ws + WS_VT);
    bf16_t* Y = (bf16_t*)(F.ws + WS_BFB);
    const int t0 = qb * 64;
    const int ql = r >> 2, h = r & 3, hh = g * 4 + h;
    const int tq = t0 + 8 * w + ql;
    const size_t row = (size_t)b * SEQ + tq;
    const bf16_t* Ur = U + row * LD0;
    bf16x8 qf[4];
#pragma unroll
    for (int s = 0; s < 4; ++s) qf[s] = *(const bf16x8*)(Ur + C_AQ + hh * 64 + 16 * s + 8 * hf);
    const LAS float* bl = F.biasL + hh * 128; const float bfar = bl[127];
    float gate[3];
    { const unsigned* gp = (const unsigned*)(Ur + C_AG);
#pragma unroll
      for (int j = 0; j < 3; ++j) { const int e = hh * 3 + j; const unsigned wv = gp[e >> 1]; gate[j] = sigmoidf_((e & 1) ? __uint_as_float(wv & 0xFFFF0000u) : __uint_as_float(wv << 16)); } }
    LAS float* opark = psum + w * 2048 + lane;

    const int nvmax = ((t0 + 63 - 31) >> 4) + 1;
    const int ntc = (nvmax + 63) >> 6;
    for (int e = tid; e < 64 * 256; e += 512) psum[e] = 0.f;
    float cm = NEG_INF, cl = 0.f;
    {
        auto ldc = [&](int i, uint4& rk, uint4& rv) { const int key = tid >> 3, c = tid & 7; rk = cvt8_f32(KC + (size_t)(i * 64 + key) * 64 + c * 8); (void)rv; };
        auto body = [&](int i, LAS unsigned char* Kt, LAS unsigned char* Vt) { (void)Vt;
            f32x16 s0, s1; qk_tile(Kt, qf, r, hf, s0, s1);
            fix_scores<FL_NEAR | FL_CAUSAL>(s0, 16 * (i * 64) + 31, 16, tq, bl, bfar, 0u, true, hf);
            fix_scores<FL_NEAR | FL_CAUSAL>(s1, 16 * (i * 64 + 32) + 31, 16, tq, bl, bfar, 0u, true, hf);
            float tm = NEG_INF;
#pragma unroll
            for (int k = 0; k < 16; ++k) tm = fmaxf(tm, fmaxf(s0[k], s1[k]));
            tm = fmaxf(tm, __shfl_xor(tm, 32));
            const float mn = fmaxf(cm, tm); const float mu = (mn == NEG_INF) ? 0.f : mn;
            float ls = 0.f;
#pragma unroll
            for (int k = 0; k < 16; ++k) ls += __builtin_amdgcn_exp2f(s0[k] - mu) + __builtin_amdgcn_exp2f(s1[k] - mu);
            cl = cl * __builtin_amdgcn_exp2f(cm - mu) + ls; cm = mn; };
        tile_stream(ntc, buf, tid, false, ldc, body);
    }
    f32x16 c0, c1;
    {
        cl += __shfl_xor(cl, 32);
        const float cinv = cl > 0.f ? 1.0f / cl : 0.f; const float cmu = (cm == NEG_INF) ? 0.f : cm;
#pragma unroll
        for (int i = 0; i < 16; ++i) { c0[i] = 0.f; c1[i] = 0.f; }
        auto ldc = [&](int i, uint4& rk, uint4& rv) { const int key = tid >> 3, c = tid & 7; rk = cvt8_f32(KC + (size_t)(i * 64 + key) * 64 + c * 8); rv = *(const uint4*)(VCT + (size_t)key * 256 + i * 64 + c * 8); };
        auto body = [&](int i, LAS unsigned char* Kt, LAS unsigned char* Vt) {
            f32x16 s0, s1; qk_tile(Kt, qf, r, hf, s0, s1);
            fix_scores<FL_NEAR | FL_CAUSAL>(s0, 16 * (i * 64) + 31, 16, tq, bl, bfar, 0u, true, hf);
            fix_scores<FL_NEAR | FL_CAUSAL>(s1, 16 * (i * 64 + 32) + 31, 16, tq, bl, bfar, 0u, true, hf);
#pragma unroll
            for (int k = 0; k < 16; ++k) { s0[k] = __builtin_amdgcn_exp2f(s0[k] - cmu) * cinv; s1[k] = __builtin_amdgcn_exp2f(s1[k] - cmu) * cinv; }
#pragma unroll
            for (int k = 0; k < 16; ++k) {
                float a0 = s0[k], a1 = s1[k];
                a0 += __shfl_xor(a0, 1); a0 += __shfl_xor(a0, 2); a1 += __shfl_xor(a1, 1); a1 += __shfl_xor(a1, 2);
                const int koff = (k & 3) + 8 * (k >> 2) + 4 * hf;
                if (h == 0) { psum[(8 * w + ql) * 256 + i * 64 + koff] = a0; psum[(8 * w + ql) * 256 + i * 64 + 32 + koff] = a1; }
            }
            pv_tile(Vt, s0, s1, r, hf, c0, c1); };
        tile_stream(ntc, buf, tid, true, ldc, body);
    }
    {
        const int cur = qb; const int npick = (cur + 1) < 8 ? (cur + 1) : 8;
        LAS float* scw = (LAS float*)(L + AT_MISC + 64) + w * 64;
#pragma unroll 1
        for (int q = 0; q < 8; ++q) {
            const LAS float* pr = psum + (8 * w + q) * 256;
            float imp = 0.f;
            const int i0 = 4 * lane - 1 < 0 ? 0 : 4 * lane - 1, i1 = 4 * lane + 3 > 254 ? 254 : 4 * lane + 3;
            for (int i = i0; i <= i1; ++i) imp += pr[i];
            const bool adm = lane <= cur; const bool forced = (lane == 0) || (lane == cur) || (lane == cur - 1);
            const float score = adm ? imp + (forced ? 1.0e4f : 0.f) : NEG_INF;
            __builtin_amdgcn_wave_barrier();
            scw[lane] = score;
            __builtin_amdgcn_wave_barrier();
            int rank = 0;
#pragma unroll
            for (int j4 = 0; j4 < 16; ++j4) { const f32x4 o = *(const LAS f32x4*)(scw + 4 * j4);
#pragma unroll
                for (int e = 0; e < 4; ++e) { const int j = 4 * j4 + e; rank += (o[e] > score || (o[e] == score && j < lane)) ? 1 : 0; } }
            const unsigned long long sm = __ballot(adm && rank < npick);
            if (lane == 0) selm[8 * w + q] = sm;
        }
    }
    __syncthreads();
    if (w == 0) {
        unsigned long long m = selm[lane];
        unsigned lo = (unsigned)m, hi = (unsigned)(m >> 32);
        for (int o = 32; o >= 1; o >>= 1) { lo |= __shfl_xor(lo, o); hi |= __shfl_xor(hi, o); }
        const unsigned long long un = ((unsigned long long)hi << 32) | lo;
        const bool mine = (un >> lane) & 1ull;
        const int pos = __popcll(un & ((1ull << lane) - 1ull));
        if (mine) tlist[pos] = (unsigned char)lane;
        if (lane == 0) tcnt[0] = __popcll(un);
    }
    __syncthreads();
#pragma unroll
    for (int i = 0; i < 16; ++i) { opark[i * 64] = gate[0] * c0[i]; opark[(16 + i) * 64] = gate[0] * c1[i]; }
    const unsigned long long mysel = selm[8 * w + ql];
    {
        Att st; att_init(st);
        const int nts = tcnt[0];
        auto lds_ = [&](int i, uint4& rk, uint4& rv) { const int j = tlist[i]; const int key = tid >> 3, c = tid & 7;
            const bf16_t* p = U + ((size_t)b * SEQ + j * 64 + key) * LD0 + g * 64 + c * 8; rk = *(const uint4*)(p + C_KS); rv = *(const uint4*)(VT + (size_t)(g * 64 + key) * MT + (size_t)b * SEQ + j * 64 + c * 8); };
        auto body = [&](int i, LAS unsigned char* Kt, LAS unsigned char* Vt) {
            const int j = tlist[i];
            const bool laneok = (mysel >> j) & 1ull;
            if (__ballot(laneok) == 0ull) return;
            f32x16 s0, s1; qk_tile(Kt, qf, r, hf, s0, s1);
            if (j >= qb - 2) { fix_scores<FL_NEAR | FL_CAUSAL | FL_LANE>(s0, j * 64, 1, tq, bl, bfar, 0u, laneok, hf); fix_scores<FL_NEAR | FL_CAUSAL | FL_LANE>(s1, j * 64 + 32, 1, tq, bl, bfar, 0u, laneok, hf); }
            else { online_pv_far<false>(st, s0, s1, Vt, r, hf, bfar, laneok, 0u, 0u); return; }
            online_pv(st, s0, s1, Vt, r, hf); };
        tile_stream(nts, buf, tid, true, lds_, body);
        float l = st.l + __shfl_xor(st.l, 32);
        const float sc = l > 0.f ? gate[1] / l : 0.f;
#pragma unroll
        for (int i = 0; i < 16; ++i) { opark[i * 64] += sc * st.o0[i]; opark[(16 + i) * 64] += sc * st.o1[i]; }
    }
    {
        Att st; att_init(st);
        const int j0 = qb - 8 < 0 ? 0 : qb - 8; const int ntw = qb - j0 + 1;
        auto ldw = [&](int i, uint4& rk, uint4& rv) { const int j = j0 + i; const int key = tid >> 3, c = tid & 7;
            const bf16_t* p = U + ((size_t)b * SEQ + j * 64 + key) * LD0 + g * 64 + c * 8; rk = *(const uint4*)(p + C_KW); rv = *(const uint4*)(VT + (size_t)(128 + g * 64 + key) * MT + (size_t)b * SEQ + j * 64 + c * 8); };
        auto body = [&](int i, LAS unsigned char* Kt, LAS unsigned char* Vt) {
            const int j = j0 + i;
            f32x16 s0, s1; qk_tile(Kt, qf, r, hf, s0, s1);
            if (j >= qb - 2) { fix_scores<FL_NEAR | FL_CAUSAL>(s0, j * 64, 1, tq, bl, bfar, 0u, true, hf); fix_scores<FL_NEAR | FL_CAUSAL>(s1, j * 64 + 32, 1, tq, bl, bfar, 0u, true, hf); }
            else if (j == qb - 8) { fix_scores<FL_WINLO>(s0, j * 64, 1, tq, bl, bfar, 0u, true, hf); fix_scores<FL_WINLO>(s1, j * 64 + 32, 1, tq, bl, bfar, 0u, true, hf); }
            else { online_pv_far<false>(st, s0, s1, Vt, r, hf, bfar, true, 0u, 0u); return; }
            online_pv(st, s0, s1, Vt, r, hf); };
        tile_stream(ntw, buf, tid, true, ldw, body);
        float l = st.l + __shfl_xor(st.l, 32);
        const float sc = l > 0.f ? gate[2] / l : 0.f;
#pragma unroll
        for (int i = 0; i < 16; ++i) { c0[i] = opark[i * 64] + sc * st.o0[i]; c1[i] = opark[(16 + i) * 64] + sc * st.o1[i]; }
    }
#pragma unroll
    for (int dh = 0; dh < 2; ++dh)
#pragma unroll
        for (int k = 0; k < 4; ++k) {
            const int d = 32 * dh + 8 * k + 4 * hf;
            const uint2 zz = *(const uint2*)(Ur + C_AZ + hh * 64 + d);
            const float z0 = __uint_as_float(zz.x << 16), z1 = __uint_as_float(zz.x & 0xFFFF0000u), z2 = __uint_as_float(zz.y << 16), z3 = __uint_as_float(zz.y & 0xFFFF0000u);
            const f32x16& o = dh ? c1 : c0;
            uint2 pk; pk.x = pack2(o[4 * k + 0] * siluf_(z0), o[4 * k + 1] * siluf_(z1)); pk.y = pack2(o[4 * k + 2] * siluf_(z2), o[4 * k + 3] * siluf_(z3));
            *(uint2*)(Y + row * 1024 + hh * 64 + d) = pk;
        }
    __syncthreads();
}

DI unsigned short okey16(float x) {
    const _Float16 hx = (_Float16)x; unsigned short u = __builtin_bit_cast(unsigned short, hx);
    if ((u & 0x7FFFu) == 0u) u = 0u;
    return (u & 0x8000u) ? (unsigned short)~u : (unsigned short)(u | 0x8000u);
}
DI void dsa_unit(const Frame& F, int b, int qt) {
    const int tid = F.tid, lane = F.lane, w = F.wave, r = lane & 31, hf = lane >> 5, fr = lane & 15, fq = lane >> 4;
    LAS unsigned char* L = F.ldsl;
    LAS unsigned char* buf = L + AT_BUF;
    LAS unsigned* mask = (LAS unsigned*)(L + AT_PSUM);
    const bf16_t* U = (const bf16_t*)(F.ws + WS_U);
    bf16_t* Y = (bf16_t*)(F.ws + WS_BFB);
    const bf16_t* VT = (const bf16_t*)(F.ws + WS_VT);
    unsigned short* KS = (unsigned short*)(F.ws + WS_BFA) + (size_t)F.bid * 32 * 4096;
    const int t0 = qt * 32;
    const int nt = ((t0 + 31) >> 6) + 1;
    {
        bf16x8 qi[2]; float wi[4];
        { const bf16_t* Uq = U + ((size_t)b * SEQ + t0 + 4 * w + (fr >> 2)) * LD0;
#pragma unroll
          for (int ks = 0; ks < 2; ++ks) qi[ks] = *(const bf16x8*)(Uq + C_BQI + (fr & 3) * 64 + 32 * ks + 8 * fq);
          const uint2 wv = *(const uint2*)(U + ((size_t)b * SEQ + t0 + 4 * w + fq) * LD0 + C_BWI);
          wi[0] = __uint_as_float(wv.x << 16) * 0.0625f; wi[1] = __uint_as_float(wv.x & 0xFFFF0000u) * 0.0625f; wi[2] = __uint_as_float(wv.y << 16) * 0.0625f; wi[3] = __uint_as_float(wv.y & 0xFFFF0000u) * 0.0625f; }
        const int tqi = t0 + 4 * w + fq;
        auto ldi = [&](int i, uint4& rk, uint4& rv) { const int key = tid >> 3, c = tid & 7; rk = *(const uint4*)(U + ((size_t)b * SEQ + i * 64 + key) * LD0 + C_BKI + c * 8); (void)rv; };
        auto body = [&](int i, LAS unsigned char* Kt, LAS unsigned char* Vt) { (void)Vt;
#pragma unroll
            for (int kg = 0; kg < 4; ++kg) {
                const int kk = 16 * kg + fr;
                f32x4 acc = {0.f, 0.f, 0.f, 0.f};
#pragma unroll
                for (int ks = 0; ks < 2; ++ks) { const int c = 4 * ks + fq;
                    const bf16x8 kb = *(const LAS bf16x8*)(Kt + kk * 128 + ((c ^ (kk & 7)) << 4));
                    acc = __builtin_amdgcn_mfma_f32_16x16x32_bf16(qi[ks], kb, acc, 0, 0, 0); }
                const float sc = wi[0] * fmaxf(acc[0], 0.f) + wi[1] * fmaxf(acc[1], 0.f) + wi[2] * fmaxf(acc[2], 0.f) + wi[3] * fmaxf(acc[3], 0.f);
                const int pos = i * 64 + kk;
                KS[(size_t)(4 * w + fq) * 4096 + pos] = pos <= tqi ? okey16(sc) : (unsigned short)0;
            } };
        tile_stream(nt, buf, tid, false, ldi, body);
    }
    asm volatile("s_waitcnt vmcnt(0)" ::: "memory");
    __syncthreads();
    __builtin_amdgcn_fence(__ATOMIC_ACQUIRE, "agent");
    asm volatile("s_waitcnt vmcnt(0)" ::: "memory");
    {
    LAS unsigned char* maskb = (LAS unsigned char*)mask;
    const unsigned long long lt_lo_hi = 0ull; (void)lt_lo_hi;
#pragma unroll 1
    for (int q = 0; q < 4; ++q) {
        const int qq = 4 * w + q; const int tqq = t0 + qq; const int nk = tqq + 1;
        const unsigned short* kq = KS + (size_t)qq * 4096;
        unsigned kw[32];
#pragma unroll
        for (int c = 0; c < 8; ++c) { uint4 kv = make_uint4(0u, 0u, 0u, 0u); if (c * 512 < nk) kv = *(const uint4*)(kq + c * 512 + lane * 8);
            kw[4 * c] = kv.x; kw[4 * c + 1] = kv.y; kw[4 * c + 2] = kv.z; kw[4 * c + 3] = kv.w; }
#pragma unroll
        for (int e = 0; e < 32; ++e) { const int idx = (e >> 2) * 512 + lane * 8 + (e & 3) * 2;
            unsigned lo = kw[e] & 0xFFFFu, hi = kw[e] >> 16; if (idx >= nk) lo = 0u; if (idx + 1 >= nk) hi = 0u; kw[e] = lo | (hi << 16); }
        unsigned tau = 0u; int quota = 0;
        const bool all = nk <= 256;
        if (!all) {
#pragma unroll 1
            for (int bit = 15; bit >= 0; --bit) {
                const unsigned trial = tau | (1u << bit); int cnt = 0;
#pragma unroll
                for (int e = 0; e < 32; ++e) cnt += ((kw[e] & 0xFFFFu) >= trial ? 1 : 0) + ((kw[e] >> 16) >= trial ? 1 : 0);
                int tot = 0;
#pragma unroll
                for (int bb = 0; bb < 7; ++bb) tot += __popcll(__ballot((cnt >> bb) & 1)) << bb;
                if (tot >= 256) tau = trial;
            }
            int cgt = 0;
#pragma unroll
            for (int e = 0; e < 32; ++e) cgt += ((kw[e] & 0xFFFFu) > tau ? 1 : 0) + ((kw[e] >> 16) > tau ? 1 : 0);
            int tot = 0;
#pragma unroll
            for (int bb = 0; bb < 7; ++bb) tot += __popcll(__ballot((cgt >> bb) & 1)) << bb;
            quota = 256 - tot;
        }
        int taken = 0;
#pragma unroll
        for (int c = 0; c < 8; ++c) {
            unsigned eqb = 0u, gtb = 0u;
#pragma unroll
            for (int e = 0; e < 8; ++e) { const unsigned k16 = (e & 1) ? (kw[4 * c + (e >> 1)] >> 16) : (kw[4 * c + (e >> 1)] & 0xFFFFu);
                const int idx = c * 512 + lane * 8 + e;
                if (all) { if (idx < nk) gtb |= 1u << e; } else { if (k16 > tau) gtb |= 1u << e; else if (k16 == tau) eqb |= 1u << e; } }
            unsigned selb = gtb;
            if (!all && __ballot(eqb != 0u) != 0ull) {
                const int ne = __popc(eqb);
                int excl = 0, totc = 0;
#pragma unroll
                for (int bb = 0; bb < 4; ++bb) { const unsigned long long bl_ = __ballot((ne >> bb) & 1);
                    excl += (int)__builtin_amdgcn_mbcnt_hi((unsigned)(bl_ >> 32), __builtin_amdgcn_mbcnt_lo((unsigned)bl_, 0u)) << bb; totc += __popcll(bl_) << bb; }
                int rank = taken + excl;
#pragma unroll
                for (int e = 0; e < 8; ++e) if ((eqb >> e) & 1u) { if (rank < quota) selb |= 1u << e; ++rank; }
                taken += totc;
            }
            maskb[qq * 512 + c * 64 + lane] = (unsigned char)selb;
        }
    }
    }
    __syncthreads();
    {
        const int ql = r >> 3, h = r & 7;
        const int tq = t0 + 4 * w + ql;
        const size_t row = (size_t)b * SEQ + tq;
        const bf16_t* Ur = U + row * LD0;
        bf16x8 qf[4];
#pragma unroll
        for (int s = 0; s < 4; ++s) qf[s] = *(const bf16x8*)(Ur + C_BQ + h * 64 + 16 * s + 8 * hf);
        const LAS float* bl = F.biasL + (8 + h) * 128; const float bfar = bl[127];
        const LAS unsigned* mq = mask + (4 * w + ql) * 128;
        Att st; att_init(st);
        auto lda = [&](int i, uint4& rk, uint4& rv) { const int key = tid >> 3, c = tid & 7;
            const bf16_t* p = U + ((size_t)b * SEQ + i * 64 + key) * LD0 + c * 8; rk = *(const uint4*)(p + C_BK); rv = *(const uint4*)(VT + (size_t)(256 + key) * MT + (size_t)b * SEQ + i * 64 + c * 8); };
        auto body = [&](int i, LAS unsigned char* Kt, LAS unsigned char* Vt) {
            const unsigned m0 = mq[2 * i], m1 = mq[2 * i + 1];
            f32x16 s0, s1; qk_tile(Kt, qf, r, hf, s0, s1);
            if (i >= nt - 4) { fix_scores<FL_NEAR | FL_CAUSAL | FL_BITS>(s0, i * 64, 1, tq, bl, bfar, m0, true, hf); fix_scores<FL_NEAR | FL_CAUSAL | FL_BITS>(s1, i * 64 + 32, 1, tq, bl, bfar, m1, true, hf); }
            else { online_pv_far<true>(st, s0, s1, Vt, r, hf, bfar, true, m0, m1); return; }
            online_pv(st, s0, s1, Vt, r, hf); };
        tile_stream(nt, buf, tid, true, lda, body);
        float l = st.l + __shfl_xor(st.l, 32);
        const float sc = l > 0.f ? 1.0f / l : 0.f;
#pragma unroll
        for (int dh = 0; dh < 2; ++dh)
#pragma unroll
            for (int k = 0; k < 4; ++k) {
                const int d = 32 * dh + 8 * k + 4 * hf;
                const uint2 zz = *(const uint2*)(Ur + C_BZ + h * 64 + d);
                const float z0 = __uint_as_float(zz.x << 16), z1 = __uint_as_float(zz.x & 0xFFFF0000u), z2 = __uint_as_float(zz.y << 16), z3 = __uint_as_float(zz.y & 0xFFFF0000u);
                const f32x16& o = dh ? st.o1 : st.o0;
                uint2 pk; pk.x = pack2(o[4 * k + 0] * sc * siluf_(z0), o[4 * k + 1] * sc * siluf_(z1)); pk.y = pack2(o[4 * k + 2] * sc * siluf_(z2), o[4 * k + 3] * sc * siluf_(z3));
                *(uint2*)(Y + row * 1024 + 512 + h * 64 + d) = pk;
            }
    }
    __syncthreads();
}

DI void p3_attention(const Frame& F, int qoff = 0) {
    LAS int* ub = (LAS int*)(F.ldsl + AT_MISC);
    unsigned* qn = F.ctl + CW_QNSA + qoff; unsigned* qd = F.ctl + CW_QDSA + qoff;
    const int NDSA = NB * (SEQ / 32), NNSA = NB * 2 * (SEQ / 64);
#ifndef ATT_MASK
#define ATT_MASK 3
#endif
    if (ATT_MASK & 1) for (;;) {
        __syncthreads();
        if (F.tid == 0) ub[0] = (int)__hip_atomic_fetch_add(qd, 1u, __ATOMIC_RELAXED, __HIP_MEMORY_SCOPE_AGENT);
        __syncthreads();
        const int k = ub[0];
        if (k >= NDSA) break;
        dsa_unit(F, k & 7, (SEQ / 32) - 1 - (k >> 3));
    }
    if (ATT_MASK & 2) for (;;) {
        __syncthreads();
        if (F.tid == 0) ub[0] = (int)__hip_atomic_fetch_add(qn, 1u, __ATOMIC_RELAXED, __HIP_MEMORY_SCOPE_AGENT);
        __syncthreads();
        const int k = ub[0];
        if (k >= NNSA) break;
        const int bg = k & 15;
        nsa_unit(F, bg >> 1, bg & 1, 63 - (k >> 4));
    }
}
#endif

DI f32x4 mma16(const bf16_t* A, int lda, const bf16_t* Bt, int ldb, int K, int lane) {
    const int fr = lane & 15, fq = lane >> 4;
    f32x4 acc = {0.f, 0.f, 0.f, 0.f};
    for (int k = 0; k < K; k += 32) {
        const bf16x8 a = *(const bf16x8*)(A + fr * lda + k + fq * 8);
        const bf16x8 b = *(const bf16x8*)(Bt + fr * ldb + k + fq * 8);
        acc = __builtin_amdgcn_mfma_f32_16x16x32_bf16(a, b, acc, 0, 0, 0);
    }
    return acc;
}
DI void conv8(const bf16_t* U1, int b, int t, int col, const float* cw  , int nch, const float* cb, float (&y)[8]) {
#pragma unroll
    for (int i = 0; i < 8; ++i) y[i] = cb[i];
#pragma unroll
    for (int j = 0; j < 4; ++j) { const int tt = t - 3 + j;
        if (tt >= 0) { const uint4 v = *(const uint4*)(U1 + ((size_t)b * SEQ + tt) * LD1 + col); float f[8]; unpack8(v, f);
#pragma unroll
            for (int i = 0; i < 8; ++i) y[i] += cw[(size_t)j * nch + i] * f[i]; } }
}
DI void mlstm_gates(const Frame& F, const bf16_t* U1, int b, int h, int c, float* li, float* bc) {
    if (F.wave == 0) {
        const size_t row = (size_t)b * SEQ + c * 64 + F.lane;
        const float ip = bf2f(U1[row * LD1 + C_DI + h]) + F.in[26][h];
        const float fp = bf2f(U1[row * LD1 + C_DF + h]) + F.in[27][h];
        const float lf = fminf(fp, 0.f) - log1pf(expf(-fabsf(fp)));
        float cs = lf;
        for (int o = 1; o < 64; o <<= 1) { const float n = __shfl_up(cs, o); if (F.lane >= o) cs += n; }
        li[F.lane] = ip; bc[F.lane] = cs;
    }
    __syncthreads();
}
constexpr int ML_LI = 0, ML_BC = 256, ML_WK = 512, ML_MT = 768, ML_DQ = 1024, ML_RS = 1280, ML_NIN = 1536, ML_Q = 2048, ML_K = ML_Q + 64 * 136 * 2, ML_VT = ML_K + 64 * 136 * 2,
              ML_CT = ML_VT + 128 * 72 * 2, ML_W = ML_CT + 128 * 136 * 2, ML_KT = ML_W + 64 * 72 * 2, ML_END = ML_KT + 128 * 72 * 2;
static_assert(ML_END + LDS_WORK_OFF <= LDS_BYTES, "mlstm lds");

DI void p8a_mlstm_local(const Frame& F) {
    const bf16_t* U1 = (const bf16_t*)(F.ws + WS_U);
    bf16_t* ST = (bf16_t*)(F.ws + WS_BFB);
    float* zloc = (float*)(F.ws + WS_ZLOC); float* scal = (float*)(F.ws + WS_SCAL);
    unsigned char* L = F.lds;
    float* li = (float*)(L + ML_LI); float* bc = (float*)(L + ML_BC); float* wk = (float*)(L + ML_WK);
    bf16_t* kT = (bf16_t*)(L + ML_KT); bf16_t* vT = (bf16_t*)(L + ML_VT);
    const float* cw = F.in[24]; const float* cb = F.in[25];
    for (int unit = F.bid; unit < 2048; unit += F.G) {
        const int c = unit & 63, h = (unit >> 6) & 3, b = unit >> 8;
        mlstm_gates(F, U1, b, h, c, li, bc);
        if (F.wave == 0) {
            const float bl = bc[63]; const float dec = bl - bc[F.lane] + li[F.lane];
            const float dmx = wave_max(dec);
            wk[F.lane] = expf(dec - dmx);
            if (F.lane == 0) { scal[unit] = bl; scal[2048 + unit] = dmx; }
        }
        __syncthreads();
        for (int it = F.tid; it < 1024; it += 512) {
            const int s = it >> 4, d0 = (it & 15) * 8; const int t = c * 64 + s;
            float y[8]; conv8(U1, b, t, C_DK + h * 128 + d0, cw + 512 + h * 128 + d0, 1024, cb + 512 + h * 128 + d0, y);
            const float w = wk[s] * 0.08838834764831845f;
#pragma unroll
            for (int i = 0; i < 8; ++i) kT[(d0 + i) * 72 + s] = f2bf(siluf_(y[i]) * w);
            const uint4 vv = *(const uint4*)(U1 + ((size_t)b * SEQ + t) * LD1 + C_DV + h * 128 + d0); float vf[8]; unpack8(vv, vf);
#pragma unroll
            for (int i = 0; i < 8; ++i) vT[(d0 + i) * 72 + s] = f2bf(vf[i]);
        }
        __syncthreads();
        for (int tix = F.wave * 8; tix < F.wave * 8 + 8; ++tix) {
            const int et = tix >> 3, dt = tix & 7;
            const f32x4 a = mma16(vT + et * 16 * 72, 72, kT + dt * 16 * 72, 72, 64, F.lane);
            const int fr = F.lane & 15, fq = F.lane >> 4;
#pragma unroll
            for (int r = 0; r < 4; ++r) ST[(size_t)unit * 16384 + (size_t)(et * 16 + 4 * fq + r) * 128 + dt * 16 + fr] = f2bf(a[r]);
        }
        if (F.tid < 128) { float z = 0.f; for (int s = 0; s < 64; ++s) z += bf2f(kT[F.tid * 72 + s]); zloc[(size_t)unit * 128 + F.tid] = z; }
        __syncthreads();
    }
}

DI void p8a_lru_local(const Frame& F) {
    const bf16_t* U1 = (const bf16_t*)(F.ws + WS_U);
    bf16_t* LA = (bf16_t*)(F.ws + WS_LRUA); bf16_t* LH = (bf16_t*)(F.ws + WS_LRUH);
    float* Aend = (float*)(F.ws + WS_AEND); float* Hend = (float*)(F.ws + WS_HEND);
    float* xs = (float*)(F.lds + ML_END) + F.wave * 64;
    const int lane = F.lane;
    for (int unit = F.gw; unit < 4096; unit += F.nw) {
        const int g = unit & 7, c = (unit >> 3) & 63, b = unit >> 9;
        const int ch = g * 64 + lane;
        float wa[64], wx[64];
#pragma unroll
        for (int i = 0; i < 64; ++i) { wa[i] = F.in[19][(size_t)(g * 64 + i) * 64 + lane]; wx[i] = F.in[21][(size_t)(g * 64 + i) * 64 + lane]; }
        const float cw0 = F.in[17][ch], cw1 = F.in[17][512 + ch], cw2 = F.in[17][1024 + ch], cw3 = F.in[17][1536 + ch], cb = F.in[18][ch];
        const float ba = F.in[20][ch], bx = F.in[22][ch];
        const float sp = log1pf(expf(-F.in[23][ch]));
        const int t0 = c * 64;
        float x0 = t0 >= 3 ? bf2f(U1[((size_t)b * SEQ + t0 - 3) * LD1 + C_CX + ch]) : 0.f;
        float x1 = t0 >= 2 ? bf2f(U1[((size_t)b * SEQ + t0 - 2) * LD1 + C_CX + ch]) : 0.f;
        float x2 = t0 >= 1 ? bf2f(U1[((size_t)b * SEQ + t0 - 1) * LD1 + C_CX + ch]) : 0.f;
        float Ac = 1.f, hl = 0.f;
        for (int s = 0; s < 64; ++s) {
            const size_t row = (size_t)b * SEQ + t0 + s;
            const float x3 = bf2f(U1[row * LD1 + C_CX + ch]);
            const float xc = cw0 * x0 + cw1 * x1 + cw2 * x2 + cw3 * x3 + cb;
            x0 = x1; x1 = x2; x2 = x3;
            __builtin_amdgcn_wave_barrier();
            xs[lane] = xc;
            __builtin_amdgcn_wave_barrier();
            float pr = ba, px = bx;
#pragma unroll
            for (int i = 0; i < 64; i += 4) { const f32x4 xv = *(const f32x4*)(xs + i);
                pr += xv[0] * wa[i] + xv[1] * wa[i + 1] + xv[2] * wa[i + 2] + xv[3] * wa[i + 3];
                px += xv[0] * wx[i] + xv[1] * wx[i + 1] + xv[2] * wx[i + 2] + xv[3] * wx[i + 3]; }
            const float r = sigmoidf_(pr), ig = sigmoidf_(px);
            const float la = -8.0f * r * sp;
            const float a = expf(la);
            const float bt = sqrtf(-expm1f(2.0f * la)) * (ig * xc);
            Ac *= a; hl = a * hl + bt;
            LA[row * 512 + ch] = f2bf(Ac); LH[row * 512 + ch] = f2bf(hl);
        }
        Aend[((size_t)b * 64 + c) * 512 + ch] = Ac; Hend[((size_t)b * 64 + c) * 512 + ch] = hl;
    }
}

DI void p8b_scans(const Frame& F) {
    const int gt = F.bid * 512 + F.tid, nthr = F.G * 512;
    if (gt < 4096) {
        const int b = gt >> 9, ch = gt & 511;
        const float* Aend = (const float*)(F.ws + WS_AEND); const float* Hend = (const float*)(F.ws + WS_HEND); float* Hin = (float*)(F.ws + WS_HIN);
        float H = 0.f;
#pragma unroll 1
        for (int c0 = 0; c0 < 64; c0 += 8) {
            float av[8], hv[8];
#pragma unroll
            for (int j = 0; j < 8; ++j) { const size_t o = ((size_t)b * 64 + c0 + j) * 512 + ch; av[j] = Aend[o]; hv[j] = Hend[o]; }
#pragma unroll
            for (int j = 0; j < 8; ++j) { const size_t o = ((size_t)b * 64 + c0 + j) * 512 + ch; Hin[o] = H; H = av[j] * H + hv[j]; }
        }
    }
    const float* scal = (const float*)(F.ws + WS_SCAL); float* minp = (float*)(F.ws + WS_SCAL) + 4096;
    if (gt >= nthr - 4096) {
        const int q = gt - (nthr - 4096); const int bh = q >> 7, d = q & 127;
        const float* zloc = (const float*)(F.ws + WS_ZLOC); float* nin = (float*)(F.ws + WS_NIN);
        float m = 0.f, n = 0.f;
#pragma unroll 1
        for (int c0 = 0; c0 < 64; c0 += 8) {
            float zv[8];
#pragma unroll
            for (int j = 0; j < 8; ++j) zv[j] = zloc[(size_t)(bh * 64 + c0 + j) * 128 + d];
#pragma unroll
            for (int j = 0; j < 8; ++j) { const int unit = bh * 64 + c0 + j; const float bl = scal[unit], dm = scal[2048 + unit];
                const float mn = fmaxf(bl + m, dm); const float keep = expf(bl + m - mn), add = expf(dm - mn);
                nin[(size_t)unit * 128 + d] = n; if (d == 0) minp[unit] = m;
                n = keep * n + add * zv[j]; m = mn; }
        }
    }
    bf16_t* ST = (bf16_t*)(F.ws + WS_BFB);
    float* kp = (float*)F.lds; float* ad = kp + 64;
    for (int k = 0; k < 4; ++k) {
        const int el = gt + k * nthr; const int bh = el >> 14, ed = el & 16383;
        __syncthreads();
        if (F.tid == 0) { float m = 0.f;
            for (int c = 0; c < 64; ++c) { const int unit = bh * 64 + c; const float bl = scal[unit], dm = scal[2048 + unit];
                const float mn = fmaxf(bl + m, dm); kp[c] = expf(bl + m - mn); ad[c] = expf(dm - mn); m = mn; } }
        __syncthreads();
        float C = 0.f;
#pragma unroll 1
        for (int c0 = 0; c0 < 64; c0 += 16) {
            bf16_t sv[16];
#pragma unroll
            for (int j = 0; j < 16; ++j) sv[j] = ST[(size_t)(bh * 64 + c0 + j) * 16384 + ed];
#pragma unroll
            for (int j = 0; j < 16; ++j) { ST[(size_t)(bh * 64 + c0 + j) * 16384 + ed] = f2bf(C); C = kp[c0 + j] * C + ad[c0 + j] * bf2f(sv[j]); }
        }
    }
}

DI void p8c_mlstm_out(const Frame& F) {
    const bf16_t* U1 = (const bf16_t*)(F.ws + WS_U);
    const bf16_t* ST = (const bf16_t*)(F.ws + WS_BFB);
    bf16_t* Y = (bf16_t*)(F.ws + WS_BFA);
    const float* nin_g = (const float*)(F.ws + WS_NIN); const float* minp = (const float*)(F.ws + WS_SCAL) + 4096;
    unsigned char* L = F.lds;
    float* li = (float*)(L + ML_LI); float* bc = (float*)(L + ML_BC); float* mt = (float*)(L + ML_MT); float* dq = (float*)(L + ML_DQ); float* rs = (float*)(L + ML_RS); float* nin = (float*)(L + ML_NIN);
    bf16_t* q = (bf16_t*)(L + ML_Q); bf16_t* k = (bf16_t*)(L + ML_K); bf16_t* vT = (bf16_t*)(L + ML_VT); bf16_t* CT = (bf16_t*)(L + ML_CT); bf16_t* W = (bf16_t*)(L + ML_W);
    const float* cw = F.in[24]; const float* cb = F.in[25];
    for (int unit = F.bid; unit < 2048; unit += F.G) {
        const int c = unit & 63, h = (unit >> 6) & 3, b = unit >> 8;
        const float m_in = minp[unit];
        mlstm_gates(F, U1, b, h, c, li, bc);
        for (int it = F.tid; it < 1024; it += 512) {
            const int s = it >> 4, d0 = (it & 15) * 8; const int t = c * 64 + s;
            float y[8];
            conv8(U1, b, t, C_DQ + h * 128 + d0, cw + h * 128 + d0, 1024, cb + h * 128 + d0, y);
            uint4 o; o.x = pack2(siluf_(y[0]), siluf_(y[1])); o.y = pack2(siluf_(y[2]), siluf_(y[3])); o.z = pack2(siluf_(y[4]), siluf_(y[5])); o.w = pack2(siluf_(y[6]), siluf_(y[7]));
            *(uint4*)(q + s * 136 + d0) = o;
            conv8(U1, b, t, C_DK + h * 128 + d0, cw + 512 + h * 128 + d0, 1024, cb + 512 + h * 128 + d0, y);
            const float sc = 0.08838834764831845f;
            o.x = pack2(siluf_(y[0]) * sc, siluf_(y[1]) * sc); o.y = pack2(siluf_(y[2]) * sc, siluf_(y[3]) * sc); o.z = pack2(siluf_(y[4]) * sc, siluf_(y[5]) * sc); o.w = pack2(siluf_(y[6]) * sc, siluf_(y[7]) * sc);
            *(uint4*)(k + s * 136 + d0) = o;
            const uint4 vv = *(const uint4*)(U1 + ((size_t)b * SEQ + t) * LD1 + C_DV + h * 128 + d0);
            const bf16_t* vp = (const bf16_t*)&vv;
#pragma unroll
            for (int i = 0; i < 8; ++i) vT[(d0 + i) * 72 + s] = vp[i];
        }
        for (int it = F.tid; it < 2048; it += 512) { const int e = it >> 4, d0 = (it & 15) * 8;
            *(uint4*)(CT + e * 136 + d0) = *(const uint4*)(ST + (size_t)unit * 16384 + e * 128 + d0); }
        if (F.tid < 128) nin[F.tid] = nin_g[(size_t)unit * 128 + F.tid];
        if (F.tid >= 128 && F.tid < 192) { const int l = F.tid - 128; float mx = bc[l] + m_in;
            for (int s = 0; s <= l; ++s) mx = fmaxf(mx, bc[l] - bc[s] + li[s]);
            mt[l] = mx; }
        __syncthreads();
        if (F.tid < 64) { float a = 0.f; for (int d = 0; d < 128; ++d) a += bf2f(q[F.tid * 136 + d]) * nin[d]; dq[F.tid] = a; }
        for (int tix = F.wave * 2; tix < F.wave * 2 + 2; ++tix) {
            const int lt = tix >> 2, st = tix & 3;
            const f32x4 a = mma16(q + lt * 16 * 136, 136, k + st * 16 * 136, 136, 128, F.lane);
            const int fr = F.lane & 15, fq = F.lane >> 4; const int s = st * 16 + fr;
#pragma unroll
            for (int r = 0; r < 4; ++r) { const int l = lt * 16 + 4 * fq + r;
                const float w = s <= l ? a[r] * expf(bc[l] - bc[s] + li[s] - mt[l]) : 0.f;
                W[l * 72 + s] = f2bf(w); }
        }
        __syncthreads();
        if (F.tid < 64) { float a = 0.f; for (int s = 0; s < 64; ++s) a += bf2f(W[F.tid * 72 + s]); rs[F.tid] = a; }
        __syncthreads();
        for (int tix = F.wave * 4; tix < F.wave * 4 + 4; ++tix) {
            const int lt = tix >> 3, et = tix & 7;
            const f32x4 qc = mma16(q + lt * 16 * 136, 136, CT + et * 16 * 136, 136, 128, F.lane);
            const f32x4 wv = mma16(W + lt * 16 * 72, 72, vT + et * 16 * 72, 72, 64, F.lane);
            const int fr = F.lane & 15, fq = F.lane >> 4; const int e = et * 16 + fr;
#pragma unroll
            for (int r = 0; r < 4; ++r) { const int l = lt * 16 + 4 * fq + r;
                const float prev = expf(bc[l] + m_in - mt[l]);
                const float num = prev * qc[r] + wv[r];
                const float den = prev * dq[l] + rs[l];
                const float hv = num / fmaxf(fabsf(den), expf(-mt[l]));
                const size_t row = (size_t)b * SEQ + c * 64 + l;
                const float og = sigmoidf_(bf2f(U1[row * LD1 + C_DO + h * 128 + e]));
                const float zz = siluf_(bf2f(U1[row * LD1 + C_DZ + h * 128 + e]));
                Y[row * 1024 + 512 + h * 128 + e] = f2bf(og * hv * zz); }
        }
        __syncthreads();
    }
}
DI void p8c_lru_out(const Frame& F) {
    const bf16_t* U1 = (const bf16_t*)(F.ws + WS_U);
    const bf16_t* LA = (const bf16_t*)(F.ws + WS_LRUA); const bf16_t* LH = (const bf16_t*)(F.ws + WS_LRUH);
    const float* Hin = (const float*)(F.ws + WS_HIN);
    bf16_t* Y = (bf16_t*)(F.ws + WS_BFA);
    const size_t n8 = (size_t)MT * 64;
    for (size_t it = (size_t)F.bid * 512 + F.tid; it < n8; it += (size_t)F.G * 512) {
        const size_t row = it >> 6; const int c0 = (int)(it & 63) * 8; const int b = (int)(row >> 12), t = (int)(row & 4095), c = t >> 6;
        const uint4 av = *(const uint4*)(LA + row * 512 + c0), hv = *(const uint4*)(LH + row * 512 + c0), zv = *(const uint4*)(U1 + row * LD1 + C_CZ + c0);
        float af[8], hf[8], zf[8]; unpack8(av, af); unpack8(hv, hf); unpack8(zv, zf);
        const float* hi = Hin + ((size_t)b * 64 + c) * 512 + c0; float y[8];
#pragma unroll
        for (int i = 0; i < 8; ++i) y[i] = (af[i] * hi[i] + hf[i]) * siluf_(zf[i]);
        uint4 o; o.x = pack2(y[0], y[1]); o.y = pack2(y[2], y[3]); o.z = pack2(y[4], y[5]); o.w = pack2(y[6], y[7]);
        *(uint4*)(Y + row * 1024 + c0) = o;
    }
}

constexpr int N_PHASES = 16;
__global__ void __launch_bounds__(512, 2) mk_fwd(Args args) {
    extern __shared__ __attribute__((aligned(16))) unsigned char smem[];
    Frame F;
    F.tid = threadIdx.x; F.lane = F.tid & 63; F.wave = __builtin_amdgcn_readfirstlane(F.tid >> 6);
    F.G = gridDim.x; F.bid = blockIdx.x; F.gw = F.bid * 8 + F.wave; F.nw = F.G * 8;
    F.lds = smem + LDS_WORK_OFF; F.ws = args.ws; F.out = args.out; F.ctl = (unsigned*)args.ws;
#pragma unroll
    for (int i = 0; i < 28; ++i) F.in[i] = args.in[i];
    LAS unsigned char* lsm = (LAS unsigned char*)smem;
    LAS unsigned char* lut = lsm + (LDS_BYTES - 12288);
    LAS float* tbl = (LAS float*)(lsm + (LDS_BYTES - 12288 + 256));
    LAS float* biasL = (LAS float*)(lsm + (LDS_BYTES - 8192));
    if (F.tid < 4) ((LAS unsigned*)lsm)[F.tid] = 0u;
    if (F.tid < 128) { const int n = F.tid; int bk;
        if (n < 16) bk = n; else { bk = 16; const int thr[15] = {19, 21, 24, 27, 31, 35, 40, 46, 52, 59, 67, 77, 87, 99, 113};
#pragma unroll
            for (int j = 0; j < 15; ++j) bk += (n >= thr[j]) ? 1 : 0; }
        lut[n] = (unsigned char)bk; }
    { const int hd = F.tid >> 5, bk = F.tid & 31; tbl[hd * 32 + bk] = args.in[6][bk * 16 + hd]; }
    F.lut = lut; F.tbl = tbl; F.biasL = biasL; F.ldsl = lsm + LDS_WORK_OFF;
    __syncthreads();
    for (int e = F.tid; e < 16 * 128; e += 512) { const int hd = e >> 7, n = e & 127; const int bk = n < 16 ? n : (n >= 113 ? 31 : (int)lut[n]); biasL[e] = tbl[hd * 32 + bk] * 1.4426950408889634f; }
    __syncthreads();
    const int lo = args.ph_lo, hi = args.ph_hi;
    XcdBarrier bar; bar.bar = F.ctl; bar.x = 0; bar.st = nullptr;
#if !MK_PER_PHASE
    bar = xcd_barrier_post(F.ctl, (volatile LAS unsigned*)lsm);
#endif
#ifndef PH_MASK
#define PH_MASK 0xFFFF
#endif
#define IN(k) (phase_refresh(F), ((PH_MASK >> (k)) & 1) && lo <= (k) && (k) < hi)
#ifndef DLY_LO
#define DLY_LO -1
#define DLY_HI -1
#endif
#ifndef DLY_MULT
#define DLY_MULT 4
#endif
    unsigned long long dly_t0 = 0ull;
#define DLY_START(k) do { if ((k) == DLY_LO && F.bid == 0 && F.tid == 0) dly_t0 = __builtin_amdgcn_s_memrealtime(); } while (0)
#define DLY_END(k) do { if ((k) == DLY_HI && F.bid == 0) { if (F.tid == 0) { const unsigned long long t1 = __builtin_amdgcn_s_memrealtime(); const unsigned long long until = t1 + DLY_MULT * (t1 - dly_t0); \
        while (__builtin_amdgcn_s_memrealtime() < until) __builtin_amdgcn_s_sleep(16); } __syncthreads(); } } while (0)
#if MK_PER_PHASE
#define SEAM(k) do { } while (0)
#else
#define SEAM(k) do { if (IN(k) && IN((k) + 1)) xcd_barrier(bar); DLY_END(k); DLY_START((k) + 1); } while (0)
#endif
    LAS unsigned char* glds = lsm + LDS_WORK_OFF;
    unsigned char* ws = args.ws;
    bf16_t* BFA = (bf16_t*)(ws + WS_BFA); bf16_t* BFB = (bf16_t*)(ws + WS_BFB); bf16_t* U = (bf16_t*)(ws + WS_U); bf16_t* Ef = (bf16_t*)(ws + WS_U);

    DLY_START(0);
    if (IN(0)) { p0_prologue(F); }
    SEAM(0);
    if (IN(1)) {
        pg8::Gemm g{BFA, (const bf16_t*)(ws + WS_WIN0), MT, LD0, 1024}; pg8::StaticOrder S; S.init(MT, LD0, F.G, F.bid);
        pg8::EpiBf16<0> E{U, LD0};
        pg8::gemm_phase(glds, g, S, E);
        pg8::Gemm g2{(const bf16_t*)(ws + WS_WVT), BFA, 512, MT, 1024}; pg8::StaticOrder S2; S2.init(512, MT, F.G, F.bid);
        pg8::EpiBf16<0> E2{(bf16_t*)(ws + WS_VT), MT};
        pg8::gemm_phase(glds, g2, S2, E2);
    }
    SEAM(1);
    if (IN(2)) { p2a_build_blocks(F); }
    SEAM(2);
    if (IN(3)) {
        { pg8::Gemm g{(const bf16_t*)(ws + WS_AK), (const bf16_t*)(ws + WS_WC1K), 4096, 256, 2048}; pg8::StaticOrder S; S.init(4096, 256, F.G, F.bid);
          pg8::EpiBf16<1> E{(bf16_t*)(ws + WS_HK), 256}; pg8::gemm_phase(glds, g, S, E); }
        { pg8::Gemm g{(const bf16_t*)(ws + WS_AV), (const bf16_t*)(ws + WS_WC1V), 4096, 256, 2048}; pg8::StaticOrder S; S.init(4096, 256, F.G, (F.bid + F.G - 16) % F.G);
          pg8::EpiBf16<1> E{(bf16_t*)(ws + WS_HV), 256}; pg8::gemm_phase(glds, g, S, E); }
    }
    SEAM(3);
    if (IN(4)) { p2c_compress_out(F); }
    SEAM(4);
#ifndef TIMEX
#define TIMEX 0
#endif
    if (IN(5)) { p3_attention(F); }
    SEAM(5);
    if (IN(6)) {
        pg8::Gemm g{BFB, (const bf16_t*)(ws + WS_WOUT0), MT, 1024, 1024}; pg8::StaticOrder S; S.init(MT, 1024, F.G, F.bid);
        pg8::EpiResid E{F.in[0], F.out, BFA};
        pg8::gemm_phase(glds, g, S, E);
    }
    SEAM(6);
    if (IN(7)) {
        { pg8::Gemm g{(const bf16_t*)(ws + WS_PBF), (const bf16_t*)(ws + WS_WP0), MT, 1024, 256}; pg8::StaticOrder S; S.init(MT, 1024, F.G, F.bid);
          pg8::EpiBf16<0> E{Ef, 1024}; pg8::gemm_phase(glds, g, S, E); }
        asm volatile("s_waitcnt vmcnt(0)" ::: "memory"); __syncthreads();
        { pg8::Gemm g{BFA, (const bf16_t*)(ws + WS_WG0), MT, 1024, 1024}; pg8::StaticOrder S; S.init(MT, 1024, F.G, F.bid);
          pg8::EpiGate E{F.out, Ef}; pg8::gemm_phase(glds, g, S, E); }
    }
    SEAM(7);
    if (IN(8)) { rmsnorm_rows<0>(F, F.out, F.in[2] + 1024, BFB, nullptr); }
    SEAM(8);
    if (IN(9)) {
        pg8::Gemm g{BFB, (const bf16_t*)(ws + WS_WIN1), MT, LD1, 1024}; pg8::StaticOrder S; S.init(MT, LD1, F.G, F.bid);
        pg8::EpiBf16<0> E{U, LD1};
        pg8::gemm_phase(glds, g, S, E);
    }
    SEAM(9);
    if (IN(10)) { p8a_mlstm_local(F); p8a_lru_local(F); }
    SEAM(10);
    if (IN(11)) { p8b_scans(F); }
    SEAM(11);
    if (IN(12)) { p8c_mlstm_out(F); p8c_lru_out(F); }
    SEAM(12);

    if (IN(13)) {
        pg8::Gemm g{BFA, (const bf16_t*)(ws + WS_WOUT1), MT, 1024, 1024}; pg8::StaticOrder S; S.init(MT, 1024, F.G, F.bid);
        pg8::EpiResid E{F.out, F.out, BFB};
        pg8::gemm_phase(glds, g, S, E);
    }
    SEAM(13);
    if (IN(14)) {
        { pg8::Gemm g{(const bf16_t*)(ws + WS_PBF) + (size_t)MT * 256, (const bf16_t*)(ws + WS_WP1), MT, 1024, 256}; pg8::StaticOrder S; S.init(MT, 1024, F.G, F.bid);
          pg8::EpiBf16<0> E{Ef, 1024}; pg8::gemm_phase(glds, g, S, E); }
        asm volatile("s_waitcnt vmcnt(0)" ::: "memory"); __syncthreads();
        { pg8::Gemm g{BFB, (const bf16_t*)(ws + WS_WG1), MT, 1024, 1024}; pg8::StaticOrder S; S.init(MT, 1024, F.G, F.bid);
          pg8::EpiGate E{F.out, Ef}; pg8::gemm_phase(glds, g, S, E); }
    }
    SEAM(14);
    if (IN(15)) { rmsnorm_rows<1>(F, F.out, F.in[3], nullptr, F.out); }
#undef IN
#undef SEAM
}

extern "C" void kernel_launch(void* const* d_in, const int* in_sizes, int n_in, void* d_out, int out_size, void* d_ws, size_t ws_size, hipStream_t stream) {
    static int grid = 0;
    if (grid == 0) {
        if (n_in != 28 || out_size != MT * DM || ws_size < WS_END) { fprintf(stderr, "kernel_launch: unexpected shapes (n_in %d, out %d, ws %zu < %zu)\n", n_in, out_size, ws_size, (size_t)WS_END); grid = -1; return; }
        int dev = 0, cus = 0, per_cu = 0;
        if (hipGetDevice(&dev) != hipSuccess || hipDeviceGetAttribute(&cus, hipDeviceAttributeMultiprocessorCount, dev) != hipSuccess) { grid = -1; return; }
        if (hipFuncSetAttribute((const void*)mk_fwd, hipFuncAttributeMaxDynamicSharedMemorySize, LDS_BYTES) != hipSuccess) { fprintf(stderr, "kernel_launch: hipFuncSetAttribute failed\n"); grid = -1; return; }
        if (hipOccupancyMaxActiveBlocksPerMultiprocessor(&per_cu, (const void*)mk_fwd, 512, LDS_BYTES) != hipSuccess || per_cu < 1)
            fprintf(stderr, "kernel_launch: occupancy query reports %d workgroups per CU\n", per_cu);
        (void)hipGetLastError();
        grid = cus;
    }
    if (grid < 0) return;
    if (hipMemsetAsync(d_ws, 0, CTL_BYTES, stream) != hipSuccess) return;
    Args a{};
    for (int i = 0; i < 28; ++i) a.in[i] = (const float*)d_in[i];
    a.out = (float*)d_out; a.ws = (unsigned char*)d_ws;
#if MK_PER_PHASE
    for (int p = 0; p < N_PHASES; ++p) { a.ph_lo = p; a.ph_hi = p + 1; hipLaunchKernelGGL(mk_fwd, dim3(grid), dim3(512), LDS_BYTES, stream, a); }
#else
    a.ph_lo = 0; a.ph_hi = N_PHASES;
    hipLaunchKernelGGL(mk_fwd, dim3(grid), dim3(512), LDS_BYTES, stream, a);
#endif
}
```

```cpp
#include <hip/hip_runtime.h>
#include <cstdio>
#include <cstdint>

#ifndef MK_PER_PHASE
#define MK_PER_PHASE 0
#endif

#define LAS __attribute__((address_space(3)))
typedef unsigned short bf16_t;
typedef short bf16x8 __attribute__((ext_vector_type(8)));
typedef float f32x4 __attribute__((ext_vector_type(4)));
#define DI __device__ __forceinline__

constexpr int NB = 8, SEQ = 4096, DM = 1024, MT = NB * SEQ;
constexpr int LD0 = 3072, LD1 = 3840;
constexpr int C_AQ = 0, C_KC = 512, C_VC = 640, C_KS = 768, C_KW = 896, C_AZ = 1024, C_BQ = 1536, C_BZ = 2048,
              C_BK = 2560, C_BKI = 2624, C_BQI = 2688, C_AG = 2944, C_BWI = 2968;
constexpr int C_VS = 0, C_VW = 0, C_BV = 0;
constexpr int C_CX = 0, C_CZ = 512, C_DQ = 1024, C_DK = 1536, C_DV = 2048, C_DO = 2560, C_DZ = 3072, C_DI = 3584, C_DF = 3588;
constexpr int NCMP = 255;
constexpr float NEG_INF = -__builtin_inff();

DI int map0(int n) {
    if (n < 896) return n;
    if (n < 1024) return 1024 + (n - 896);
    if (n < 1536) return 1304 + (n - 1024);
    if (n < 2048) return 1816 + (n - 1536);
    if (n < 2560) return 2780 + (n - 2048);
    if (n < 2624) return 2328 + (n - 2560);
    if (n < 2688) return 2712 + (n - 2624);
    if (n < 2944) return 2456 + (n - 2688);
    if (n < 2968) return 1280 + (n - 2944);
    if (n < 2972) return 2776 + (n - 2968);
    return -1;
}
DI int map1(int n) {
    if (n < 2560) return n;
    if (n < 3072) return 2568 + (n - 2560);
    if (n < 3584) return 3080 + (n - 3072);
    if (n < 3588) return 2560 + (n - 3584);
    if (n < 3592) return 2564 + (n - 3588);
    return -1;
}
DI int mapid(int n) { return n; }
DI int mapv(int f) { return f < 128 ? 896 + f : (f < 256 ? 1152 + (f - 128) : (f < 320 ? 2392 + (f - 256) : -1)); }

constexpr size_t CTL_BYTES = 16384;
constexpr size_t WS_WIN0  = CTL_BYTES;
constexpr size_t WS_WOUT0 = WS_WIN0  + (size_t)LD0 * 1024 * 2;
constexpr size_t WS_WG0   = WS_WOUT0 + (size_t)1024 * 1024 * 2;
constexpr size_t WS_WP0   = WS_WG0   + (size_t)1024 * 1024 * 2;
constexpr size_t WS_WIN1  = WS_WP0   + (size_t)1024 * 256 * 2;
constexpr size_t WS_WOUT1 = WS_WIN1  + (size_t)LD1 * 1024 * 2;
constexpr size_t WS_WG1   = WS_WOUT1 + (size_t)1024 * 1024 * 2;
constexpr size_t WS_WP1   = WS_WG1   + (size_t)1024 * 1024 * 2;
constexpr size_t WS_WC1K  = WS_WP1   + (size_t)1024 * 256 * 2;
constexpr size_t WS_WC1V  = WS_WC1K  + (size_t)256 * 2048 * 2;
constexpr size_t WS_WVT   = WS_WC1V  + (size_t)256 * 2048 * 2;
constexpr size_t WS_BFA   = WS_WVT   + (size_t)512 * 1024 * 2;
constexpr size_t WS_BFB   = WS_BFA   + (size_t)MT * 1024 * 2;
constexpr size_t WS_PBF   = WS_BFB   + (size_t)MT * 1024 * 2;
constexpr size_t WS_U     = WS_PBF   + (size_t)2 * MT * 256 * 2;
constexpr size_t WS_X     = WS_U     + (size_t)MT * LD1 * 2;
constexpr size_t WS_AK    = WS_X;
constexpr size_t WS_AV    = WS_AK    + (size_t)4096 * 2048 * 2;
constexpr size_t WS_HK    = WS_AV    + (size_t)4096 * 2048 * 2;
constexpr size_t WS_HV    = WS_HK    + (size_t)4096 * 256 * 2;
constexpr size_t WS_LRUA  = WS_X;
constexpr size_t WS_LRUH  = WS_LRUA  + (size_t)MT * 512 * 2;
constexpr size_t WS_S     = WS_X     + (size_t)64 * 1024 * 1024;
constexpr size_t WS_KCMP  = WS_S;
constexpr size_t WS_VCMP  = WS_KCMP  + (size_t)16 * 256 * 64 * 4;
constexpr size_t WS_AEND  = WS_VCMP  + (size_t)16 * 256 * 64 * 4;
constexpr size_t WS_HEND  = WS_AEND  + (size_t)8 * 64 * 512 * 4;
constexpr size_t WS_HIN   = WS_HEND  + (size_t)8 * 64 * 512 * 4;
constexpr size_t WS_ZLOC  = WS_HIN   + (size_t)8 * 64 * 512 * 4;
constexpr size_t WS_NIN   = WS_ZLOC  + (size_t)2048 * 128 * 4;
constexpr size_t WS_SCAL  = WS_NIN   + (size_t)2048 * 128 * 4;
constexpr size_t WS_VCT   = WS_SCAL  + (size_t)3 * 2048 * 4;
constexpr size_t WS_WAT   = WS_VCT   + (size_t)16 * 64 * 256 * 2;
constexpr size_t WS_WXT   = WS_WAT   + (size_t)8 * 64 * 64 * 2;
constexpr size_t WS_END   = WS_WXT   + (size_t)8 * 64 * 64 * 2;
constexpr size_t WS_VT    = WS_U     + (size_t)MT * LD0 * 2;
static_assert(WS_VT + (size_t)512 * MT * 2 <= WS_X, "VT region");
static_assert(WS_HV + (size_t)4096 * 256 * 2 <= WS_S, "compress region");
static_assert(WS_LRUH + (size_t)MT * 512 * 2 <= WS_S, "lru region");

constexpr int XCD_BAR_WORDS_C = 3456;
constexpr int CW_QNSA = 3520, CW_QDSA = 3584;

constexpr int LDS_BYTES = 147456;
constexpr int LDS_CTL_OFF = 0;
constexpr int LDS_WORK_OFF = 1024;

DI float bf2f(bf16_t v) { return __uint_as_float(((unsigned)v) << 16); }
DI bf16_t f2bf(float f) { unsigned u = __float_as_uint(f); u += 0x7FFFu + ((u >> 16) & 1u); return (bf16_t)(u >> 16); }
typedef __bf16 bf16v2 __attribute__((ext_vector_type(2)));
typedef float f32x2 __attribute__((ext_vector_type(2)));
DI unsigned pack2(float lo, float hi) { const f32x2 v = {lo, hi}; return __builtin_bit_cast(unsigned, __builtin_convertvector(v, bf16v2)); }
DI float fexp_(float x) { return __builtin_amdgcn_exp2f(x * 1.4426950408889634f); }
DI float sigmoidf_(float x) { return __builtin_amdgcn_rcpf(1.0f + fexp_(-x)); }
DI float siluf_(float x) { return x * __builtin_amdgcn_rcpf(1.0f + fexp_(-x)); }
DI float wave_max(float v) { for (int o = 32; o >= 1; o >>= 1) v = fmaxf(v, __shfl_xor(v, o)); return v; }
DI float wave_sum(float v) { for (int o = 32; o >= 1; o >>= 1) v += __shfl_xor(v, o); return v; }
DI void unpack8(const uint4& v, float (&f)[8]) {
    f[0] = __uint_as_float(v.x << 16); f[1] = __uint_as_float(v.x & 0xFFFF0000u);
    f[2] = __uint_as_float(v.y << 16); f[3] = __uint_as_float(v.y & 0xFFFF0000u);
    f[4] = __uint_as_float(v.z << 16); f[5] = __uint_as_float(v.z & 0xFFFF0000u);
    f[6] = __uint_as_float(v.w << 16); f[7] = __uint_as_float(v.w & 0xFFFF0000u);
}

#define XB_TMO      128
#define XB_XCNT(j)  (256  + 64 * (j))
#define XB_XSUB(j)  (1280 + 64 * (j))
#define XB_XGEN(j)  (2304 + 64 * (j))
#define XB_TOP      3328
#define XB_TOPGEN   3392
#define XCD_BAR_WORDS 3456
#define XB_SPIN_CAP (1u << 22)
static_assert(XCD_BAR_WORDS == XCD_BAR_WORDS_C, "bar words");

__device__ __forceinline__ unsigned xb_ld(unsigned* p)              { return __hip_atomic_load(p, __ATOMIC_RELAXED, __HIP_MEMORY_SCOPE_AGENT); }
__device__ __forceinline__ unsigned xb_add(unsigned* p, unsigned v) { return __hip_atomic_fetch_add(p, v, __ATOMIC_RELAXED, __HIP_MEMORY_SCOPE_AGENT); }
__device__ __forceinline__ unsigned xb_xcc_id() { return (unsigned)__builtin_amdgcn_s_getreg((3 << 11) | 20) & 0xFu; }
#define XB_SPIN(cond, bar) do { unsigned _sp = 0; while (cond) { __builtin_amdgcn_s_sleep(1); \
    if ((++_sp & 255u) == 0u) { if (xb_ld(&(bar)[XB_TMO])) break; if (_sp > XB_SPIN_CAP) { atomicAdd(&(bar)[XB_TMO], 1u); break; } } } } while (0)

struct XcdBarrier { unsigned* bar; unsigned x; volatile LAS unsigned* st; };

__device__ __forceinline__ XcdBarrier xcd_barrier_post(unsigned* bar, volatile LAS unsigned* st) {
    XcdBarrier b; b.bar = bar; b.x = xb_xcc_id(); b.st = st;
    if (threadIdx.x == 0) (void)xb_add(&bar[XB_XCNT(b.x)], 1u);
    return b;
}
__device__ __forceinline__ void xcd_barrier_complete(unsigned* bar, unsigned x, unsigned& nloc, unsigned& nx) {
    const unsigned G = gridDim.x * gridDim.y * gridDim.z;
    unsigned sum, cnt, mine, sp = 0u;
    for (;;) {
        sum = 0u; cnt = 0u; mine = 0u;
#pragma unroll
        for (unsigned j = 0; j < 16; ++j) { const unsigned c = xb_ld(&bar[XB_XCNT(j)]); sum += c; cnt += (c > 0u) ? 1u : 0u; mine = (j == x) ? c : mine; }
        if (sum == G) break;
        __builtin_amdgcn_s_sleep(1);
        if ((++sp & 255u) == 0u) { if (xb_ld(&bar[XB_TMO])) break; if (sp > XB_SPIN_CAP) { atomicAdd(&bar[XB_TMO], 1u); break; } }
    }
    nloc = mine > 0u ? mine : 1u; nx = cnt > 0u ? cnt : 1u;
}
__device__ __forceinline__ void xcd_barrier(const XcdBarrier& b) {
    asm volatile("s_waitcnt vmcnt(0)" ::: "memory");
    __syncthreads();
    if (threadIdx.x == 0) {
        unsigned* bar = b.bar;
        __builtin_amdgcn_s_waitcnt(0);
        unsigned nloc = b.st[0], nx = b.st[1];
        if (nloc == 0u) { xcd_barrier_complete(bar, b.x, nloc, nx); b.st[0] = nloc; b.st[1] = nx; }
        const unsigned old = xb_add(&bar[XB_XSUB(b.x)], 1u);
        const unsigned gen = old / nloc;
        if (old + 1u == (gen + 1u) * nloc) {
            __builtin_amdgcn_fence(__ATOMIC_RELEASE, "agent");
            asm volatile("s_waitcnt vmcnt(0)" ::: "memory");
            const unsigned og = xb_add(&bar[XB_TOP], 1u);
            const unsigned tg = og / nx;
            if (og + 1u == (tg + 1u) * nx) xb_add(&bar[XB_TOPGEN], 1u);
            else XB_SPIN(xb_ld(&bar[XB_TOPGEN]) == tg, bar);
            __builtin_amdgcn_fence(__ATOMIC_ACQUIRE, "agent");
            xb_add(&bar[XB_XGEN(b.x)], 1u);
            asm volatile("s_waitcnt vmcnt(0)" ::: "memory");
        } else {
            XB_SPIN(xb_ld(&bar[XB_XGEN(b.x)]) == gen, bar);
            __builtin_amdgcn_fence(__ATOMIC_ACQUIRE, "agent");
            asm volatile("s_waitcnt vmcnt(0)" ::: "memory");
        }
    }
    __syncthreads();
}

namespace pg8 {
constexpr int BM = 256, BK = 64, HALF = 128, HTB = HALF * BK * 2, STAGE_BYTES = 8 * HTB, NXCD = 8, WGM = 8;
__host__ __device__ __forceinline__ int lds_byte(int r, int c) { const int st = (r >> 4) * 2 + (c >> 5), rr = r & 15, cc = c & 31, ob = rr * 64 + cc * 2; return st * 1024 + (ob ^ (((ob >> 9) & 1) << 5)); }
__host__ __device__ __forceinline__ void stage_rc(int b, int& R, int& C) { const int st = b / 1024, sb = b % 1024, swz = sb ^ (((sb >> 9) & 1) << 5); R = (st >> 1) * 16 + swz / 64; C = (st & 1) * 32 + (swz % 64) / 2; }
__host__ __device__ __forceinline__ int perm32(int rho) { const int n = rho >> 4, i = rho & 15; return 8 * (i >> 2) + 4 * n + (i & 3); }
struct Unit { int pm, pn; };
struct Gemm { const bf16_t* A; const bf16_t* Bt; int M, N, K; };
struct StaticOrder {
    int nM, nN, nwg, G, c;
    __host__ __device__ __forceinline__ void init(int M, int N, int G_, int c_) { nM = M / BM; nN = N / BM; nwg = nM * nN; G = G_; c = c_; }
    __host__ __device__ __forceinline__ bool next(int i, Unit& u) const {
        const long L = (long)i * G + c; if (L >= nwg) return false;
        int wgid = (int)L; { const int q = nwg / NXCD, r = nwg % NXCD, xcd = wgid % NXCD, off = wgid / NXCD; wgid = (xcd < r ? xcd * (q + 1) : r * (q + 1) + (xcd - r) * q) + off; }
        const int nig = WGM * nN, gid = wgid / nig, fm = gid * WGM, gsz = (nM - fm) < WGM ? (nM - fm) : WGM;
        u.pm = fm + ((wgid % nig) % gsz); u.pn = (wgid % nig) / gsz; return true;
    }
    __device__ __forceinline__ void a_ready(const Unit&) const {}
    __device__ __forceinline__ void done(const Unit&) const {}
};
template <class Epi, class Sched>
__device__ __forceinline__ void gemm_phase(LAS unsigned char* lds, const Gemm g, const Sched& S, const Epi& E) {
    int tid_ = threadIdx.x; asm volatile("" : "+v"(tid_));
    const int tid = tid_, wid = __builtin_amdgcn_readfirstlane(tid >> 6), lane = tid & 63, wr = wid >> 2, wc = wid & 3, fr = lane & 15, fq = lane >> 4;
    const int K = g.K, nt = K / BK;
    unsigned voffA[2], voffB[2];
#pragma unroll
    for (int i = 0; i < 2; ++i) { int R, C; stage_rc(tid * 16 + i * 8192, R, C); const int Rb = Epi::PERM ? ((R & ~31) + perm32(R & 31)) : R;
        voffA[i] = (unsigned)(R * K + C) * 2u; voffB[i] = (unsigned)(Rb * K + C) * 2u; }
    const size_t kstep = (size_t)(BK * 2);
    const size_t hstep = (size_t)HALF * K * 2;
    const size_t tstep = 2 * hstep;
    const unsigned ldsw = (unsigned)wid * 1024u;
    const int aoff = lds_byte(wr * 64 + fr, fq * 8), boff = lds_byte(wc * 32 + fr, fq * 8);
#define PG8_SA(b, h) (((b) * 2 + (h)) * HTB)
#define PG8_SB(b, h) ((4 + (b) * 2 + (h)) * HTB)
#define PG8_STAGE(bufoff, gbase, voff) do { _Pragma("unroll") for (int _i = 0; _i < 2; ++_i) \
        __builtin_amdgcn_global_load_lds((const unsigned*)((const char*)(gbase) + (voff)[_i]), (LAS unsigned*)(lds + (bufoff) + ldsw + _i * 8192), 16, 0, 0); } while (0)
#define PG8_LDA(dst, b, h) do { _Pragma("unroll") for (int m = 0; m < 4; ++m) _Pragma("unroll") for (int k = 0; k < 2; ++k) dst[m][k] = *(const LAS bf16x8*)(lds + PG8_SA(b, h) + aoff + m * 2048 + k * 1024); } while (0)
#define PG8_LDB(dst, b, h) do { _Pragma("unroll") for (int n = 0; n < 2; ++n) _Pragma("unroll") for (int k = 0; k < 2; ++k) dst[n][k] = *(const LAS bf16x8*)(lds + PG8_SB(b, h) + boff + n * 2048 + k * 1024); } while (0)
#define PG8_MMA(ai, bj, At, Bt) do { __builtin_amdgcn_s_setprio(1); _Pragma("unroll") for (int m = 0; m < 4; ++m) _Pragma("unroll") for (int n = 0; n < 2; ++n) _Pragma("unroll") for (int k = 0; k < 2; ++k) \
        acc[ai][bj][m][n] = __builtin_amdgcn_mfma_f32_16x16x32_bf16(Bt[n][k], At[m][k], acc[ai][bj][m][n], 0, 0, 0); __builtin_amdgcn_s_setprio(0); } while (0)
#define PG8_WAIT_V(n) asm volatile("s_waitcnt vmcnt(" #n ")" ::: "memory")
#define PG8_WAIT_L(n) asm volatile("s_waitcnt lgkmcnt(" #n ")" ::: "memory")
#define PG8_BAR __builtin_amdgcn_s_barrier()
#define PG8_SCHED __builtin_amdgcn_sched_barrier(0)
    Unit cur, nxt; int ui = 0;
    if (!S.next(0, cur)) return;
    f32x4 acc[2][2][4][2];
#pragma unroll
    for (int a = 0; a < 2; ++a)
#pragma unroll
        for (int b = 0; b < 2; ++b)
#pragma unroll
            for (int m = 0; m < 4; ++m)
#pragma unroll
                for (int n = 0; n < 2; ++n) acc[a][b][m][n] = (f32x4){0.f, 0.f, 0.f, 0.f};
    bf16x8 At[4][2], B0[2][2], B1[2][2];
    const char* cA = (const char*)g.A + (size_t)cur.pm * tstep; const char* cB = (const char*)g.Bt + (size_t)cur.pn * tstep;
    S.a_ready(cur);
    PG8_STAGE(PG8_SB(0, 0), cB, voffB); PG8_STAGE(PG8_SA(0, 0), cA, voffA); PG8_STAGE(PG8_SB(0, 1), cB + hstep, voffB); PG8_STAGE(PG8_SA(0, 1), cA + hstep, voffA);
    if (wr == 1) PG8_BAR;
    PG8_WAIT_V(4); PG8_BAR;
    PG8_STAGE(PG8_SB(1, 0), cB + kstep, voffB); PG8_STAGE(PG8_SA(1, 0), cA + kstep, voffA); PG8_STAGE(PG8_SB(1, 1), cB + hstep + kstep, voffB);
    PG8_WAIT_V(6); PG8_BAR;
    for (;;) {
        const bool has_next = S.next(ui + 1, nxt);
        const char* nA = has_next ? (const char*)g.A + (size_t)nxt.pm * tstep : cA; const char* nB = has_next ? (const char*)g.Bt + (size_t)nxt.pn * tstep : cB;
        for (int t = 0; t < nt; t += 2) {
            const bool last = (t == nt - 2);
            const char* a1 = cA + (size_t)(t + 1) * kstep;
            const char* a2 = last ? nA : cA + (size_t)(t + 2) * kstep; const char* b2 = last ? nB : cB + (size_t)(t + 2) * kstep;
            const char* a3 = a2 + kstep; const char* b3 = b2 + kstep;
            if (last && has_next) S.a_ready(nxt);
            PG8_LDB(B0, 0, 0); PG8_SCHED; PG8_LDA(At, 0, 0); PG8_STAGE(PG8_SA(1, 1), a1 + hstep, voffA);
            PG8_WAIT_L(8); PG8_BAR; PG8_WAIT_L(0); PG8_MMA(0, 0, At, B0); PG8_BAR; PG8_SCHED;
            PG8_LDB(B1, 0, 1); PG8_STAGE(PG8_SB(0, 0), b2, voffB);
            PG8_BAR; PG8_WAIT_L(0); PG8_MMA(0, 1, At, B1); PG8_BAR;
            PG8_LDA(At, 0, 1); PG8_STAGE(PG8_SA(0, 0), a2, voffA);
            PG8_BAR; PG8_WAIT_L(0); PG8_MMA(1, 0, At, B0); PG8_BAR; PG8_SCHED;
            PG8_STAGE(PG8_SB(0, 1), b2 + hstep, voffB);
            PG8_WAIT_V(6); PG8_BAR; PG8_MMA(1, 1, At, B1); PG8_BAR;
            PG8_LDB(B0, 1, 0); PG8_SCHED; PG8_LDA(At, 1, 0); PG8_STAGE(PG8_SA(0, 1), a2 + hstep, voffA);
            PG8_WAIT_L(8); PG8_BAR; PG8_WAIT_L(0); PG8_MMA(0, 0, At, B0); PG8_BAR; PG8_SCHED;
            PG8_LDB(B1, 1, 1); PG8_STAGE(PG8_SB(1, 0), b3, voffB);
            PG8_BAR; PG8_WAIT_L(0); PG8_MMA(0, 1, At, B1); PG8_BAR;
            PG8_LDA(At, 1, 1); PG8_STAGE(PG8_SA(1, 0), a3, voffA);
            PG8_BAR; PG8_WAIT_L(0); PG8_MMA(1, 0, At, B0); PG8_BAR; PG8_SCHED;
            PG8_STAGE(PG8_SB(1, 1), b3 + hstep, voffB);
            PG8_WAIT_V(6); PG8_BAR; PG8_MMA(1, 1, At, B1); PG8_BAR;
        }
        E(acc, cur, wr, wc, fr, fq); S.done(cur);
        if (!has_next) break;
#pragma unroll
        for (int a = 0; a < 2; ++a)
#pragma unroll
            for (int b = 0; b < 2; ++b)
#pragma unroll
                for (int m = 0; m < 4; ++m)
#pragma unroll
                    for (int n = 0; n < 2; ++n) acc[a][b][m][n] = (f32x4){0.f, 0.f, 0.f, 0.f};
        cur = nxt; cA = nA; cB = nB; ++ui;
    }
    PG8_WAIT_V(0);
    if (wr == 0) PG8_BAR;
    PG8_BAR;
#undef PG8_SA
#undef PG8_SB
#undef PG8_STAGE
#undef PG8_LDA
#undef PG8_LDB
#undef PG8_MMA
#undef PG8_WAIT_V
#undef PG8_WAIT_L
#undef PG8_BAR
#undef PG8_SCHED
}

template <int ACT  > struct EpiBf16 {
    static constexpr bool PERM = true;
    bf16_t* O; int ldc;
    __device__ __forceinline__ void operator()(const f32x4 (&acc)[2][2][4][2], const Unit& u, int wr, int wc, int fr, int fq) const {
        const int row0 = u.pm * BM + wr * 64 + fr, col0 = u.pn * BM + wc * 32 + 8 * fq;
#pragma unroll
        for (int ai = 0; ai < 2; ++ai)
#pragma unroll
            for (int m = 0; m < 4; ++m) { bf16_t* rowp = O + (size_t)(row0 + ai * HALF + m * 16) * ldc + col0;
#pragma unroll
                for (int bj = 0; bj < 2; ++bj) { f32x4 v0 = acc[ai][bj][m][0], v1 = acc[ai][bj][m][1];
                    if (ACT == 1) { for (int i = 0; i < 4; ++i) { v0[i] = siluf_(v0[i]); v1[i] = siluf_(v1[i]); } }
                    uint4 o; o.x = pack2(v0[0], v0[1]); o.y = pack2(v0[2], v0[3]); o.z = pack2(v1[0], v1[1]); o.w = pack2(v1[2], v1[3]);
                    *(uint4*)(rowp + bj * HALF) = o; } }
    }
};
struct EpiF32 {
    static constexpr bool PERM = false;
    float* C; int ldc;
    __device__ __forceinline__ void operator()(const f32x4 (&acc)[2][2][4][2], const Unit& u, int wr, int wc, int fr, int fq) const {
        const int row0 = u.pm * BM + wr * 64 + fr, col0 = u.pn * BM + wc * 32 + 4 * fq;
#pragma unroll
        for (int ai = 0; ai < 2; ++ai)
#pragma unroll
            for (int m = 0; m < 4; ++m) { float* rowp = C + (size_t)(row0 + ai * HALF + m * 16) * ldc + col0;
#pragma unroll
                for (int bj = 0; bj < 2; ++bj)
#pragma unroll
                    for (int n = 0; n < 2; ++n) *(f32x4*)(rowp + bj * HALF + n * 16) = acc[ai][bj][m][n]; }
    }
};
struct EpiResid {
    static constexpr bool PERM = false;
    const float* Xi; float* Xo; bf16_t* Ob;
    __device__ __forceinline__ void operator()(const f32x4 (&acc)[2][2][4][2], const Unit& u, int wr, int wc, int fr, int fq) const {
        const int row0 = u.pm * BM + wr * 64 + fr, col0 = u.pn * BM + wc * 32 + 4 * fq;
#pragma unroll
        for (int ai = 0; ai < 2; ++ai)
#pragma unroll
            for (int m = 0; m < 4; ++m) { const size_t ro = (size_t)(row0 + ai * HALF + m * 16) * 1024 + col0;
#pragma unroll
                for (int bj = 0; bj < 2; ++bj)
#pragma unroll
                    for (int n = 0; n < 2; ++n) { const size_t o = ro + bj * HALF + n * 16;
                        const f32x4 xi = *(const f32x4*)(Xi + o); const f32x4 v = xi + acc[ai][bj][m][n];
                        *(f32x4*)(Xo + o) = v; uint2 pk; pk.x = pack2(v[0], v[1]); pk.y = pack2(v[2], v[3]); *(uint2*)(Ob + o) = pk; } }
    }
};
struct EpiGate {
    static constexpr bool PERM = true;
    float* X; const bf16_t* E;
    __device__ __forceinline__ void operator()(const f32x4 (&acc)[2][2][4][2], const Unit& u, int wr, int wc, int fr, int fq) const {
        const int row0 = u.pm * BM + wr * 64 + fr, col0 = u.pn * BM + wc * 32 + 8 * fq;
#pragma unroll
        for (int ai = 0; ai < 2; ++ai)
#pragma unroll
            for (int m = 0; m < 4; ++m) { const size_t ro = (size_t)(row0 + ai * HALF + m * 16) * 1024 + col0;
#pragma unroll
                for (int bj = 0; bj < 2; ++bj) { const size_t o = ro + bj * HALF;
                    const uint4 ev = *(const uint4*)(E + o); float ef[8]; unpack8(ev, ef);
#pragma unroll
                    for (int n = 0; n < 2; ++n) { const f32x4 xi = *(const f32x4*)(X + o + 4 * n); f32x4 v;
#pragma unroll
                        for (int i = 0; i < 4; ++i) v[i] = xi[i] + ef[4 * n + i] * sigmoidf_(acc[ai][bj][m][n][i]);
                        *(f32x4*)(X + o + 4 * n) = v; } } }
    }
};
}

struct Args { const float* in[28]; float* out; unsigned char* ws; int ph_lo, ph_hi; };

struct Frame {
    int tid, lane, wave, G, bid, gw, nw;
    unsigned char* lds;
    unsigned* ctl;
    const float* in[28]; float* out; unsigned char* ws;
    const LAS unsigned char* lut;
    const LAS float* tbl;
    const LAS float* biasL;
    LAS unsigned char* ldsl;
};
DI int t5b(const Frame& F, int n) { return n < 16 ? n : (n >= 113 ? 31 : (int)F.lut[n]); }

DI bool phase_refresh(Frame& F) { int t_ = threadIdx.x; asm volatile("" : "+v"(t_)); F.tid = t_; F.lane = t_ & 63; return true; }
struct TDesc { const float* src; bf16_t* dst; int K, Nsrc, Npad, mapk, ntiles; };
DI int tmap(int kind, int n) { return kind == 0 ? n : (kind == 1 ? map0(n) : (kind == 2 ? map1(n) : mapv(n))); }
DI void transpose_all(const Frame& F) {
    unsigned char* ws = F.ws;
    float* tile = (float*)F.lds;
    TDesc D[11];
    D[0] = TDesc{F.in[7], (bf16_t*)(ws + WS_WIN0), 1024, 3292, LD0, 1, 0};
    D[1] = TDesc{F.in[7], (bf16_t*)(ws + WS_WVT), 1024, 3292, 512, 3, 0};
    D[2] = TDesc{F.in[8], (bf16_t*)(ws + WS_WOUT0), 1024, 1024, 1024, 0, 0};
    D[3] = TDesc{F.in[5], (bf16_t*)(ws + WS_WG0), 1024, 1024, 1024, 0, 0};
    D[4] = TDesc{F.in[5] + (size_t)1024 * 1024, (bf16_t*)(ws + WS_WG1), 1024, 1024, 1024, 0, 0};
    D[5] = TDesc{F.in[4], (bf16_t*)(ws + WS_WP0), 256, 1024, 1024, 0, 0};
    D[6] = TDesc{F.in[4] + (size_t)256 * 1024, (bf16_t*)(ws + WS_WP1), 256, 1024, 1024, 0, 0};
    D[7] = TDesc{F.in[15], (bf16_t*)(ws + WS_WIN1), 1024, 3592, LD1, 2, 0};
    D[8] = TDesc{F.in[16], (bf16_t*)(ws + WS_WOUT1), 1024, 1024, 1024, 0, 0};
    D[9] = TDesc{F.in[10], (bf16_t*)(ws + WS_WC1K), 2048, 256, 256, 0, 0};
    D[10] = TDesc{F.in[13], (bf16_t*)(ws + WS_WC1V), 2048, 256, 256, 0, 0};
    int total = 0;
#pragma unroll
    for (int i = 0; i < 11; ++i) { D[i].ntiles = (D[i].Npad / 64) * (D[i].K / 64); total += D[i].ntiles; }
    float rg[8];
    auto locate = [&](int tix, TDesc& d, int& nt, int& kt) { int rem = tix;
#pragma unroll
        for (int i = 0; i < 11; ++i) { if (rem >= 0 && rem < D[i].ntiles) { d = D[i]; const int ntk = d.K / 64; nt = rem / ntk; kt = rem % ntk; rem = -1; } else if (rem >= 0) rem -= D[i].ntiles; } };
    auto load = [&](int tix) { TDesc d; int nt = 0, kt = 0; locate(tix, d, nt, kt);
#pragma unroll
        for (int q = 0; q < 8; ++q) { const int e = F.tid + q * 512; const int kk = e >> 6, nn = e & 63; const int col = tmap(d.mapk, nt * 64 + nn);
            rg[q] = col >= 0 ? d.src[(size_t)(kt * 64 + kk) * d.Nsrc + col] : 0.f; } };
    int tix = F.bid; int buf = 0;
    if (tix < total) load(tix);
    for (; tix < total; tix += F.G) {
        float* tl = tile + buf * (64 * 65);
#pragma unroll
        for (int q = 0; q < 8; ++q) { const int e = F.tid + q * 512; tl[(e >> 6) * 65 + (e & 63)] = rg[q]; }
        __syncthreads();
        TDesc d; int nt = 0, kt = 0; locate(tix, d, nt, kt);
        if (tix + F.G < total) load(tix + F.G);
#pragma unroll
        for (int q = 0; q < 8; ++q) { const int e = F.tid + q * 512; const int nn = e >> 6, kk = e & 63;
            d.dst[(size_t)(nt * 64 + nn) * d.K + kt * 64 + kk] = f2bf(tl[kk * 65 + nn]); }
        buf ^= 1;
    }
    __syncthreads();
}
template <int OUTF>
DI void rmsnorm_rows(const Frame& F, const float* X, const float* g, bf16_t* Ob, float* Of) {
    for (int row = F.gw; row < MT; row += F.nw) {
        const float* xr = X + (size_t)row * 1024;
        f32x4 v[4]; float ss = 0.f;
#pragma unroll
        for (int i = 0; i < 4; ++i) { v[i] = *(const f32x4*)(xr + i * 256 + F.lane * 4); ss += v[i][0] * v[i][0] + v[i][1] * v[i][1] + v[i][2] * v[i][2] + v[i][3] * v[i][3]; }
        ss = wave_sum(ss);
        const float rs = rsqrtf(ss * (1.0f / 1024.0f) + 1e-6f);
#pragma unroll
        for (int i = 0; i < 4; ++i) { const f32x4 gg = *(const f32x4*)(g + i * 256 + F.lane * 4); f32x4 y;
            for (int j = 0; j < 4; ++j) y[j] = v[i][j] * rs * gg[j];
            if (OUTF) *(f32x4*)(Of + (size_t)row * 1024 + i * 256 + F.lane * 4) = y;
            else { uint2 pk; pk.x = pack2(y[0], y[1]); pk.y = pack2(y[2], y[3]); *(uint2*)(Ob + (size_t)row * 1024 + i * 256 + F.lane * 4) = pk; } }
    }
}
DI void p0_prologue(const Frame& F) {
    unsigned char* ws = F.ws;
    transpose_all(F);
    { bf16_t* wat = (bf16_t*)(ws + WS_WAT); bf16_t* wxt = (bf16_t*)(ws + WS_WXT);
      for (int idx = F.bid * 512 + F.tid; idx < 8 * 64 * 64; idx += F.G * 512) { const int g = idx >> 12, j = (idx >> 6) & 63, i = idx & 63;
          wat[idx] = f2bf(F.in[19][(size_t)(g * 64 + i) * 64 + j]); wxt[idx] = f2bf(F.in[21][(size_t)(g * 64 + i) * 64 + j]); } }
    rmsnorm_rows<0>(F, F.in[0], F.in[2], (bf16_t*)(ws + WS_BFA), nullptr);
    { const float* p = F.in[1]; bf16_t* pb = (bf16_t*)(ws + WS_PBF); const size_t n8 = (size_t)2 * MT * 256 / 8;
      for (size_t i = (size_t)F.bid * 512 + F.tid; i < n8; i += (size_t)F.G * 512) {
          const f32x4 a = *(const f32x4*)(p + i * 8), b = *(const f32x4*)(p + i * 8 + 4);
          uint4 o; o.x = pack2(a[0], a[1]); o.y = pack2(a[2], a[3]); o.z = pack2(b[0], b[1]); o.w = pack2(b[2], b[3]); *(uint4*)(pb + i * 8) = o; } }
}

DI void p2a_build_blocks(const Frame& F) {
    { const int gt = F.bid * 512 + F.tid;
      if (gt < 1024) { const int bg = gt >> 6, d = gt & 63; ((float*)(F.ws + WS_KCMP))[((size_t)bg * 256 + 255) * 64 + d] = 0.f; ((float*)(F.ws + WS_VCMP))[((size_t)bg * 256 + 255) * 64 + d] = 0.f;
          ((bf16_t*)(F.ws + WS_VCT))[((size_t)bg * 64 + d) * 256 + 255] = 0; } }
    const bf16_t* U = (const bf16_t*)(F.ws + WS_U);
    bf16_t* AK = (bf16_t*)(F.ws + WS_AK); bf16_t* AV = (bf16_t*)(F.ws + WS_AV);
    const float* posk = F.in[9]; const float* posv = F.in[12];
    const size_t nitem = (size_t)2 * 4096 * 32 * 8;
    for (size_t it = (size_t)F.bid * 512 + F.tid; it < nitem; it += (size_t)F.G * 512) {
        const int c8 = (int)(it & 7), l = (int)((it >> 3) & 31), r = (int)((it >> 8) & 4095), which = (int)(it >> 20);
        bf16_t* dst = (which ? AV : AK) + (size_t)r * 2048 + l * 64 + c8 * 8;
        uint4 o = make_uint4(0u, 0u, 0u, 0u);
        if (r < 4080) {
            const int b = r / 510, rem = r % 510, i = rem >> 1, g = rem & 1;
            const bf16_t* sp = U + ((size_t)b * SEQ + 16 * i + l) * LD0 + (which ? C_VC : C_KC) + g * 64 + c8 * 8;
            const float* pp = (which ? posv : posk) + l * 64 + c8 * 8;
            const uint4 v = *(const uint4*)sp; float f[8]; unpack8(v, f);
            o.x = pack2(f[0] + pp[0], f[1] + pp[1]); o.y = pack2(f[2] + pp[2], f[3] + pp[3]); o.z = pack2(f[4] + pp[4], f[5] + pp[5]); o.w = pack2(f[6] + pp[6], f[7] + pp[7]);
        }
        *(uint4*)dst = o;
    }
}
DI void p2c_compress_rows(const Frame& F, int which, int row0) {
    const bf16_t* H = (const bf16_t*)(F.ws + (which ? WS_HV : WS_HK));
    float* OUT = (float*)(F.ws + (which ? WS_VCMP : WS_KCMP));
    const float* w2 = which ? F.in[14] : F.in[11];
    for (int rr = F.wave; rr < 256; rr += 8) {
        const int r = row0 + rr; if (r >= 4080) break;
        const int b = r / 510, rem = r % 510, i = rem >> 1, g = rem & 1, bg = b * 2 + g;
        const bf16_t* hr = H + (size_t)r * 256; float acc = 0.f;
        for (int j = 0; j < 256; j += 8) { const uint4 hv = *(const uint4*)(hr + j); float hf[8]; unpack8(hv, hf);
#pragma unroll
            for (int q = 0; q < 8; ++q) acc += hf[q] * w2[(size_t)(j + q) * 64 + F.lane]; }
        OUT[((size_t)bg * 256 + i) * 64 + F.lane] = acc;
        if (which) ((bf16_t*)(F.ws + WS_VCT))[((size_t)bg * 64 + F.lane) * 256 + i] = f2bf(acc);
    }
}

template <int NH>
DI void dotn_bf(const bf16_t* kp, const float* qs, float (&acc)[NH]) {
#pragma unroll
    for (int h = 0; h < NH; ++h) acc[h] = 0.f;
#pragma unroll 2
    for (int c = 0; c < 8; ++c) { const uint4 v = *(const uint4*)(kp + c * 8); float kf[8]; unpack8(v, kf);
#pragma unroll
        for (int h = 0; h < NH; ++h) { const f32x4 q0 = *(const f32x4*)(qs + h * 64 + c * 8), q1 = *(const f32x4*)(qs + h * 64 + c * 8 + 4);
            acc[h] += q0[0] * kf[0] + q0[1] * kf[1] + q0[2] * kf[2] + q0[3] * kf[3] + q1[0] * kf[4] + q1[1] * kf[5] + q1[2] * kf[6] + q1[3] * kf[7]; } }
}
DI void dot4_bf(const bf16_t* kp, const float* qs, float (&acc)[4]) { dotn_bf<4>(kp, qs, acc); }
DI void dot4_f32(const float* kp, const float* qs, float (&acc)[4]) {
    acc[0] = acc[1] = acc[2] = acc[3] = 0.f;
#pragma unroll 4
    for (int c = 0; c < 16; ++c) { const f32x4 kv = *(const f32x4*)(kp + c * 4);
#pragma unroll
        for (int h = 0; h < 4; ++h) { const f32x4 q0 = *(const f32x4*)(qs + h * 64 + c * 4);
            acc[h] += q0[0] * kv[0] + q0[1] * kv[1] + q0[2] * kv[2] + q0[3] * kv[3]; } }
}

template <int NH, int HS>
DI void softmax_lds(float* ps, int nr, int lane, float (&inv)[NH]) {
#pragma unroll
    for (int h = 0; h < NH; ++h) {
        float mx = NEG_INF;
#pragma unroll 1
        for (int r = 0; r < nr; ++r) mx = fmaxf(mx, ps[h * HS + r * 64 + lane]);
        mx = wave_max(mx);
        float sm = 0.f;
#pragma unroll 1
        for (int r = 0; r < nr; ++r) { const float sv = ps[h * HS + r * 64 + lane]; const float e = sv > NEG_INF ? expf(sv - mx) : 0.f; ps[h * HS + r * 64 + lane] = e; sm += e; }
        sm = wave_sum(sm);
        inv[h] = sm > 0.f ? 1.0f / sm : 0.f;
    }
}

DI void nsa_task(const Frame& F, int b, int g, int t, float* wl) {
    int lane = F.lane; asm volatile("" : "+v"(lane)); asm volatile("" : "+v"(wl));
    const bf16_t* U = (const bf16_t*)(F.ws + WS_U);
    const float* KC = (const float*)(F.ws + WS_KCMP) + (size_t)(b * 2 + g) * 256 * 64;
    const float* VC = (const float*)(F.ws + WS_VCMP) + (size_t)(b * 2 + g) * 256 * 64;
    bf16_t* Y = (bf16_t*)(F.ws + WS_BFB);
    const size_t row = (size_t)b * SEQ + t;
    const bf16_t* Ur = U + row * LD0;
    float* qs = wl; float* ps = wl + 256;
    const LAS float* tb = F.tbl + (g * 4) * 32;
    __builtin_amdgcn_wave_barrier();
#pragma unroll
    for (int h = 0; h < 4; ++h) qs[h * 64 + lane] = bf2f(Ur[C_AQ + (g * 4 + h) * 64 + lane]);
    __builtin_amdgcn_wave_barrier();
    float oc[4] = {0.f, 0.f, 0.f, 0.f}, os[4] = {0.f, 0.f, 0.f, 0.f}, ow[4] = {0.f, 0.f, 0.f, 0.f};
    float inv[4];

    const int nv = t >= 31 ? ((t - 31) >> 4) + 1 : 0;
#pragma unroll 1
    for (int r = 0; r < 4; ++r) {
        const int i = r * 64 + lane; const bool valid = i < nv;
        float sc[4] = {NEG_INF, NEG_INF, NEG_INF, NEG_INF};
        if (r * 64 < nv) {
            float acc[4]; dot4_f32(KC + (size_t)(valid ? i : 0) * 64, qs, acc);
            if (valid) { const int bk = t5b(F, t - (16 * i + 31));
#pragma unroll
                for (int h = 0; h < 4; ++h) sc[h] = acc[h] * 0.125f + tb[h * 32 + bk]; }
        }
#pragma unroll
        for (int h = 0; h < 4; ++h) ps[h * 512 + i] = sc[h];
    }
    __builtin_amdgcn_wave_barrier();
    softmax_lds<4, 512>(ps, 4, lane, inv);
#pragma unroll 1
    for (int r = 0; r < 4; ++r) {
#pragma unroll
        for (int h = 0; h < 4; ++h) ps[h * 512 + r * 64 + lane] *= inv[h];
    }
    __builtin_amdgcn_wave_barrier();
#pragma unroll 8
    for (int i = 0; i < nv; ++i) { const float v = VC[(size_t)i * 64 + lane];
#pragma unroll
        for (int h = 0; h < 4; ++h) oc[h] += ps[h * 512 + i] * v; }
#ifndef NSA_STAGE
#define NSA_STAGE 4
#endif
    if (NSA_STAGE < 2) return;
    const int cur = t >> 6;
    unsigned long long selmask = 0ull; const int npick = (cur + 1) < 8 ? (cur + 1) : 8;
    {
        float imp = 0.f;
        const int i0 = 4 * lane - 1 < 0 ? 0 : 4 * lane - 1, i1 = 4 * lane + 3 > 254 ? 254 : 4 * lane + 3;
#pragma unroll
        for (int h = 0; h < 4; ++h) for (int i = i0; i <= i1; ++i) imp += ps[h * 512 + i];
        const bool adm = lane <= cur; const bool forced = (lane == 0) || (lane == cur) || (lane == cur - 1);
        float score = adm ? imp + (forced ? 1.0e4f : 0.f) : NEG_INF;
#pragma unroll 1
        for (int k = 0; k < npick; ++k) {
            const float mx = wave_max(score);
            const unsigned long long cand = __ballot(score == mx);
            const int j = cand ? __builtin_ctzll(cand) : 0;
            selmask |= 1ull << j;
            if (lane == j) score = NEG_INF;
        }
    }
    __builtin_amdgcn_wave_barrier();
    {
        unsigned long long m = selmask;
#pragma unroll 1
        for (int k = 0; k < npick; ++k) {
            const int j = __builtin_ctzll(m); m &= m - 1;
            const int pos = j * 64 + lane;
            float sc[4] = {NEG_INF, NEG_INF, NEG_INF, NEG_INF};
            float acc[4]; dot4_bf(U + ((size_t)b * SEQ + pos) * LD0 + C_KS + g * 64, qs, acc);
            if (pos <= t) { const int bk = t5b(F, t - pos);
#pragma unroll
                for (int h = 0; h < 4; ++h) sc[h] = acc[h] * 0.125f + tb[h * 32 + bk]; }
#pragma unroll
            for (int h = 0; h < 4; ++h) ps[h * 512 + k * 64 + lane] = sc[h];
        }
        __builtin_amdgcn_wave_barrier();
        softmax_lds<4, 512>(ps, npick, lane, inv);
        __builtin_amdgcn_wave_barrier();
        m = selmask;
#pragma unroll 1
        for (int k = 0; k < npick; ++k) {
            const int j = __builtin_ctzll(m); m &= m - 1;
            const int kend = (j * 64 + 63 <= t) ? 64 : (t - j * 64 + 1);
#pragma unroll 8
            for (int kk = 0; kk < kend; ++kk) {
                const float v = bf2f(U[((size_t)b * SEQ + j * 64 + kk) * LD0 + C_VS + g * 64 + lane]);
#pragma unroll
                for (int h = 0; h < 4; ++h) os[h] += ps[h * 512 + k * 64 + kk] * v; }
        }
#pragma unroll
        for (int h = 0; h < 4; ++h) os[h] *= inv[h];
    }
    __builtin_amdgcn_wave_barrier();
    if (NSA_STAGE < 3) return;
    {
#pragma unroll 1
        for (int r = 0; r < 8; ++r) {
            const int pos = t - 511 + r * 64 + lane;
            float sc[4] = {NEG_INF, NEG_INF, NEG_INF, NEG_INF};
            if (t - 511 + r * 64 + 63 >= 0) {
                float acc[4]; dot4_bf(U + ((size_t)b * SEQ + (pos < 0 ? 0 : pos)) * LD0 + C_KW + g * 64, qs, acc);
                if (pos >= 0) { const int bk = t5b(F, t - pos);
#pragma unroll
                    for (int h = 0; h < 4; ++h) sc[h] = acc[h] * 0.125f + tb[h * 32 + bk]; }
            }
#pragma unroll
            for (int h = 0; h < 4; ++h) ps[h * 512 + r * 64 + lane] = sc[h];
        }
        __builtin_amdgcn_wave_barrier();
        softmax_lds<4, 512>(ps, 8, lane, inv);
        __builtin_amdgcn_wave_barrier();
        const int pi0 = (t >= 511 ? 0 : 511 - t) & ~7;
#pragma unroll 8
        for (int pi = pi0; pi < 512; ++pi) {
            const int pos = t - 511 + pi;
            const float v = bf2f(U[((size_t)b * SEQ + (pos < 0 ? 0 : pos)) * LD0 + C_VW + g * 64 + lane]);
#pragma unroll
            for (int h = 0; h < 4; ++h) ow[h] += ps[h * 512 + pi] * v; }
#pragma unroll
        for (int h = 0; h < 4; ++h) ow[h] *= inv[h];
    }
    if (NSA_STAGE < 4) return;
    const float gsig = sigmoidf_(bf2f(Ur[C_AG + g * 12 + (lane < 12 ? lane : 0)]));
#pragma unroll
    for (int h = 0; h < 4; ++h) {
        const int hh = g * 4 + h;
        const float g0 = __shfl(gsig, h * 3 + 0), g1 = __shfl(gsig, h * 3 + 1), g2 = __shfl(gsig, h * 3 + 2);
        const float oa = g0 * oc[h] + g1 * os[h] + g2 * ow[h];
        const float z = bf2f(Ur[C_AZ + hh * 64 + lane]);
        Y[row * 1024 + hh * 64 + lane] = f2bf(oa * siluf_(z));
    }
    __builtin_amdgcn_wave_barrier();
}

DI unsigned okey(float x) { unsigned u = __float_as_uint(x); if ((u << 1) == 0u) u = 0u; return (u >> 31) ? ~u : (u | 0x80000000u); }

DI void dsa_task(const Frame& F, int b, int t, float* wl, unsigned* keys) {
    int lane = F.lane; asm volatile("" : "+v"(lane)); asm volatile("" : "+v"(wl)); asm volatile("" : "+v"(keys));
    const bf16_t* U = (const bf16_t*)(F.ws + WS_U);
    bf16_t* Y = (bf16_t*)(F.ws + WS_BFB);
    const size_t row = (size_t)b * SEQ + t;
    const bf16_t* Ur = U + row * LD0;
    float* qis = wl; float* qds = wl + 256; int* idx = (int*)(wl + 768); float* pb = (float*)keys;
    const LAS float* tb = F.tbl + 8 * 32;
    __builtin_amdgcn_wave_barrier();
#pragma unroll
    for (int h = 0; h < 4; ++h) qis[h * 64 + lane] = bf2f(Ur[C_BQI + h * 64 + lane]);
#pragma unroll
    for (int h = 0; h < 8; ++h) qds[h * 64 + lane] = bf2f(Ur[C_BQ + h * 64 + lane]);
    float wi[4];
#pragma unroll
    for (int h = 0; h < 4; ++h) wi[h] = bf2f(Ur[C_BWI + h]) * 0.0625f;
    __builtin_amdgcn_wave_barrier();
    const int nk = t + 1, nr = (nk + 63) >> 6;
    int nsel;
    if (nk <= 256) {
#pragma unroll 1
        for (int r = 0; r < nr; ++r) { const int s = r * 64 + lane; if (s < nk) idx[s] = s; }
        nsel = nk;
    } else {
#pragma unroll 1
        for (int r = 0; r < nr; ++r) {
            const int s = r * 64 + lane; unsigned key = 0u;
            float acc[4]; dot4_bf(U + ((size_t)b * SEQ + (s < nk ? s : t)) * LD0 + C_BKI, qis, acc);
            if (s < nk) { const float scv = wi[0] * fmaxf(acc[0], 0.f) + wi[1] * fmaxf(acc[1], 0.f) + wi[2] * fmaxf(acc[2], 0.f) + wi[3] * fmaxf(acc[3], 0.f); key = okey(scv); }
            keys[s] = key;
        }
        __builtin_amdgcn_wave_barrier();
        unsigned tau = 0u;
#pragma unroll 1
        for (int bit = 31; bit >= 0; --bit) {
            const unsigned trial = tau | (1u << bit); int cnt = 0;
#pragma unroll 8
            for (int r = 0; r < nr; ++r) cnt += keys[r * 64 + lane] >= trial ? 1 : 0;
            cnt = (int)wave_sum((float)cnt);
            if (cnt >= 256) tau = trial;
        }
        int cgt = 0;
#pragma unroll 1
        for (int r = 0; r < nr; ++r) cgt += keys[r * 64 + lane] > tau ? 1 : 0;
        cgt = (int)wave_sum((float)cgt);
        const int quota = 256 - cgt;
        int base = 0, taken = 0;
        const unsigned long long ltmask = (1ull << lane) - 1ull;
#pragma unroll 1
        for (int r = 0; r < nr; ++r) {
            const unsigned key = keys[r * 64 + lane];
            const bool eq = key == tau;
            const unsigned long long eqm = __ballot(eq);
            const int erank = __popcll(eqm & ltmask);
            const bool sel = (key > tau) || (eq && (taken + erank < quota));
            const unsigned long long sm = __ballot(sel);
            if (sel) idx[base + __popcll(sm & ltmask)] = r * 64 + lane;
            base += __popcll(sm); taken += __popcll(eqm);
        }
        nsel = 256;
    }
    __builtin_amdgcn_wave_barrier();
    const int nr2 = (nsel + 63) >> 6;
#pragma unroll 1
    for (int r = 0; r < nr2; ++r) {
        const int j = r * 64 + lane; const bool valid = j < nsel; const int s = valid ? idx[j] : 0;
        const bf16_t* kp = U + ((size_t)b * SEQ + s) * LD0 + C_BK;
        float a0[8]; dotn_bf<8>(kp, qds, a0);
        const int bk = t5b(F, valid ? t - s : 0);
#pragma unroll
        for (int h = 0; h < 8; ++h) pb[h * 256 + j] = valid ? a0[h] * 0.125f + tb[h * 32 + bk] : NEG_INF;
    }
    __builtin_amdgcn_wave_barrier();
    float inv[8];
    softmax_lds<8, 256>(pb, nr2, lane, inv);
    __builtin_amdgcn_wave_barrier();
    float ob[8] = {0.f, 0.f, 0.f, 0.f, 0.f, 0.f, 0.f, 0.f};
#pragma unroll 8
    for (int j = 0; j < nsel; ++j) {
        const int s = idx[j];
        const float v = bf2f(U[((size_t)b * SEQ + s) * LD0 + C_BV + lane]);
#pragma unroll
        for (int h = 0; h < 8; ++h) ob[h] += pb[h * 256 + j] * v;
    }
#pragma unroll
    for (int h = 0; h < 8; ++h) {
        const float z = bf2f(Ur[C_BZ + h * 64 + lane]);
        Y[row * 1024 + 512 + h * 64 + lane] = f2bf(ob[h] * inv[h] * siluf_(z));
    }
    __builtin_amdgcn_wave_barrier();
}

#ifndef ATT_NAIVE
#define ATT_NAIVE 0
#endif
#if ATT_NAIVE
DI void p3_attention(const Frame& F) {
    unsigned char* base = F.lds;
    constexpr int DSA_W = 4;
    float* wl_nsa; float* wl_dsa = nullptr; unsigned* keys = nullptr;
    if (F.wave < DSA_W) { unsigned char* R = base + F.wave * 20480; keys = (unsigned*)R; wl_dsa = (float*)(R + 16384); wl_nsa = (float*)R; }
    else wl_nsa = (float*)(base + DSA_W * 20480 + (F.wave - DSA_W) * 9216);
    unsigned* qn = F.ctl + CW_QNSA; unsigned* qd = F.ctl + CW_QDSA;
    const int NDSA = NB * SEQ, NNSA = NB * 2 * SEQ;
#ifndef ATT_MASK
#define ATT_MASK 3
#endif
    if ((ATT_MASK & 1) && F.wave < DSA_W) {
        for (;;) {
            unsigned k = 0; if (F.lane == 0) k = __hip_atomic_fetch_add(qd, 1u, __ATOMIC_RELAXED, __HIP_MEMORY_SCOPE_AGENT);
            k = __builtin_amdgcn_readfirstlane(k);
            if (k >= (unsigned)NDSA) break;
            const int t = SEQ - 1 - (int)(k >> 3), b = (int)(k & 7);
            dsa_task(F, b, t, wl_dsa, keys);
        }
    }
    if (ATT_MASK & 2) for (;;) {
        unsigned k = 0; if (F.lane == 0) k = __hip_atomic_fetch_add(qn, 1u, __ATOMIC_RELAXED, __HIP_MEMORY_SCOPE_AGENT);
        k = __builtin_amdgcn_readfirstlane(k);
        if (k >= (unsigned)NNSA) break;
        const int t = SEQ - 1 - (int)(k >> 4), bg = (int)(k & 15);
        nsa_task(F, bg >> 1, bg & 1, t, wl_nsa);
    }
}

#else
typedef float f32x16 __attribute__((ext_vector_type(16)));
#define MFMA32(a, b, c) __builtin_amdgcn_mfma_f32_32x32x16_bf16((a), (b), (c), 0, 0, 0)
constexpr float LOG2E = 1.4426950408889634f;
constexpr float QK_C1 = 0.125f * LOG2E;
constexpr int AT_BUF = 0;
constexpr int AT_PSUM = 32768;
constexpr int AT_SELM = AT_PSUM + 65536;
constexpr int AT_MISC = AT_SELM + 1024;
constexpr int AT_END = AT_MISC + 64 + 2048;
static_assert(AT_END + LDS_WORK_OFF <= LDS_BYTES - 12288, "attention lds");
enum { FL_NEAR = 1, FL_CAUSAL = 2, FL_WINLO = 4, FL_BITS = 8, FL_LANE = 16 };

struct Att { float m, l; f32x16 o0, o1; };
DI void att_init(Att& a) { a.m = NEG_INF; a.l = 0.f;
#pragma unroll
    for (int i = 0; i < 16; ++i) { a.o0[i] = 0.f; a.o1[i] = 0.f; } }

typedef unsigned u32x4 __attribute__((ext_vector_type(4)));
#define OPAQUE(x) asm volatile("" : "+v"(x))
DI void st_write_K(LAS unsigned char* Kt, int tid, const uint4& rg) {
    OPAQUE(tid);
    const int key = tid >> 3, c = tid & 7;
    const u32x4 v = {rg.x, rg.y, rg.z, rg.w};
    *(LAS u32x4*)(Kt + key * 128 + ((c ^ (key & 7)) << 4)) = v;
}
DI void st_write_VT(LAS unsigned char* Vt, int tid, const uint4& rg) {
    OPAQUE(tid);
    const int d = tid >> 3, m = tid & 7, G = m >> 1, a = m & 1, sw = (d >> 1) & 7;
    typedef unsigned u32x2 __attribute__((ext_vector_type(2)));
    const u32x2 lo = {rg.x, rg.y}, hi = {rg.z, rg.w};
    *(LAS u32x2*)(Vt + d * 128 + (((2 * G) ^ sw) << 4) + 8 * a) = lo;
    *(LAS u32x2*)(Vt + d * 128 + (((2 * G + 1) ^ sw) << 4) + 8 * a) = hi;
}
DI void qk_tile(const LAS unsigned char* Kt, const bf16x8 (&qf)[4], int r, int hf, f32x16& s0, f32x16& s1) {
    OPAQUE(r); OPAQUE(hf);
#pragma unroll
    for (int i = 0; i < 16; ++i) { s0[i] = 0.f; s1[i] = 0.f; }
#pragma unroll
    for (int s = 0; s < 4; ++s) {
        const int c = 2 * s + hf;
        const bf16x8 a0 = *(const LAS bf16x8*)(Kt + r * 128 + ((c ^ (r & 7)) << 4));
        const bf16x8 a1 = *(const LAS bf16x8*)(Kt + (32 + r) * 128 + ((c ^ (r & 7)) << 4));
        s0 = MFMA32(a0, qf[s], s0); s1 = MFMA32(a1, qf[s], s1);
    }
}
template <int FLAGS>
DI void fix_scores(f32x16& s, int posb, int kstep, int tq, const LAS float* bl, float bfar, unsigned mword, bool laneok, int hf) {
    OPAQUE(hf); OPAQUE(tq);
#pragma unroll
    for (int i = 0; i < 16; ++i) {
        const int koff = (i & 3) + 8 * (i >> 2) + 4 * hf;
        const int dist = tq - (posb + kstep * koff);
        float bias = bfar;
        if (FLAGS & FL_NEAR) { int dd = dist < 0 ? 0 : dist; dd = dd > 127 ? 127 : dd; bias = bl[dd]; }
        const float v = s[i] * QK_C1 + bias;
        bool ok = true;
        if (FLAGS & FL_CAUSAL) ok = ok && (dist >= 0);
        if (FLAGS & FL_WINLO) ok = ok && (dist < 512);
        if (FLAGS & FL_BITS) ok = ok && (((mword >> koff) & 1u) != 0u);
        if (FLAGS & FL_LANE) ok = ok && laneok;
        s[i] = ok ? v : NEG_INF;
    }
}
DI bf16x8 pack8(const f32x16& x, int s) {
    typedef unsigned u32x4 __attribute__((ext_vector_type(4)));
    u32x4 p;
    p[0] = pack2(x[8 * s + 0], x[8 * s + 1]); p[1] = pack2(x[8 * s + 2], x[8 * s + 3]); p[2] = pack2(x[8 * s + 4], x[8 * s + 5]); p[3] = pack2(x[8 * s + 6], x[8 * s + 7]);
    return __builtin_bit_cast(bf16x8, p);
}
DI void pv_tile(const LAS unsigned char* Vt, const f32x16& p0, const f32x16& p1, int r, int hf, f32x16& o0, f32x16& o1) {
    OPAQUE(r); OPAQUE(hf);
#pragma unroll
    for (int G = 0; G < 4; ++G) {
        const bf16x8 pb = pack8((G >> 1) ? p1 : p0, G & 1);
        const int cc = 2 * G + hf;
        const bf16x8 a0 = *(const LAS bf16x8*)(Vt + r * 128 + ((cc ^ ((r >> 1) & 7)) << 4));
        const bf16x8 a1 = *(const LAS bf16x8*)(Vt + (32 + r) * 128 + ((cc ^ ((r >> 1) & 7)) << 4));
        o0 = MFMA32(a0, pb, o0); o1 = MFMA32(a1, pb, o1);
    }
}
DI void online_pv(Att& st, f32x16& s0, f32x16& s1, const LAS unsigned char* Vt, int r, int hf) {
    float tm = NEG_INF;
#pragma unroll
    for (int i = 0; i < 16; ++i) tm = fmaxf(tm, fmaxf(s0[i], s1[i]));
    tm = fmaxf(tm, __shfl_xor(tm, 32));
    const float mn = fmaxf(st.m, tm);
    const float mu = (mn == NEG_INF) ? 0.f : mn;
    const float alpha = __builtin_amdgcn_exp2f(st.m - mu);
    float ls = 0.f;
#pragma unroll
    for (int i = 0; i < 16; ++i) { s0[i] = __builtin_amdgcn_exp2f(s0[i] - mu); s1[i] = __builtin_amdgcn_exp2f(s1[i] - mu); ls += s0[i] + s1[i]; }
    st.l = st.l * alpha + ls;
    if (__ballot(mn != st.m) != 0ull) {
#pragma unroll
        for (int i = 0; i < 16; ++i) { st.o0[i] *= alpha; st.o1[i] *= alpha; } }
    st.m = mn;
    pv_tile(Vt, s0, s1, r, hf, st.o0, st.o1);
}
template <bool BITS>
DI void far_tile(Att& st, const LAS unsigned char* Kt, const LAS unsigned char* Vt, const bf16x8 (&qf)[4], int r, int hf, float bfar, bool laneok, unsigned m0, unsigned m1) {
    f32x16 s0, s1; qk_tile(Kt, qf, r, hf, s0, s1);
    OPAQUE(hf);
    const float cb = laneok ? bfar - st.m : NEG_INF;
    const unsigned w0 = m0 >> (4 * hf), w1 = m1 >> (4 * hf);
    float ls = 0.f;
#pragma unroll
    for (int i = 0; i < 16; ++i) { float p0 = __builtin_amdgcn_exp2f(s0[i] * QK_C1 + cb);
        if (BITS) p0 = __uint_as_float(__float_as_uint(p0) & (unsigned)__builtin_amdgcn_sbfe((int)w0, (i & 3) + 8 * (i >> 2), 1));
        s0[i] = p0; ls += p0; }
    int rr = r; OPAQUE(rr);
#pragma unroll
    for (int G = 0; G < 2; ++G) { const bf16x8 pb = pack8(s0, G); const int cc = 2 * G + hf;
        const bf16x8 a0 = *(const LAS bf16x8*)(Vt + rr * 128 + ((cc ^ ((rr >> 1) & 7)) << 4)); const bf16x8 a1 = *(const LAS bf16x8*)(Vt + (32 + rr) * 128 + ((cc ^ ((rr >> 1) & 7)) << 4));
        st.o0 = MFMA32(a0, pb, st.o0); st.o1 = MFMA32(a1, pb, st.o1); }
#pragma unroll
    for (int i = 0; i < 16; ++i) { float p1 = __builtin_amdgcn_exp2f(s1[i] * QK_C1 + cb);
        if (BITS) p1 = __uint_as_float(__float_as_uint(p1) & (unsigned)__builtin_amdgcn_sbfe((int)w1, (i & 3) + 8 * (i >> 2), 1));
        s1[i] = p1; ls += p1; }
#pragma unroll
    for (int G = 2; G < 4; ++G) { const bf16x8 pb = pack8(s1, G & 1); const int cc = 2 * G + hf;
        const bf16x8 a0 = *(const LAS bf16x8*)(Vt + rr * 128 + ((cc ^ ((rr >> 1) & 7)) << 4)); const bf16x8 a1 = *(const LAS bf16x8*)(Vt + (32 + rr) * 128 + ((cc ^ ((rr >> 1) & 7)) << 4));
        st.o0 = MFMA32(a0, pb, st.o0); st.o1 = MFMA32(a1, pb, st.o1); }
    st.l += ls;
}
#define LDS_BARRIER() do { asm volatile("s_waitcnt lgkmcnt(0)" ::: "memory"); __builtin_amdgcn_s_barrier(); asm volatile("" ::: "memory"); } while (0)
template <class LD, class BODY>
DI void tile_stream(int n, LAS unsigned char* buf, int tid, bool useV, LD ld, BODY body) {
    if (n <= 0) return;
    uint4 rk, rv = make_uint4(0u, 0u, 0u, 0u);
    ld(0, rk, rv);
    st_write_K(buf, tid, rk); if (useV) st_write_VT(buf + 8192, tid, rv);
    if (n > 1) ld(1, rk, rv);
    LDS_BARRIER();
#pragma unroll 1
    for (int i = 0; i < n; ++i) {
        LAS unsigned char* cur = buf + (i & 1) * 16384;
        if (i + 1 < n) { LAS unsigned char* nxt = buf + ((i + 1) & 1) * 16384; st_write_K(nxt, tid, rk); if (useV) st_write_VT(nxt + 8192, tid, rv); if (i + 2 < n) ld(i + 2, rk, rv); }
        body(i, cur, cur + 8192);
        LDS_BARRIER();
    }
}
DI uint4 cvt8_f32(const float* p) { const f32x4 a = *(const f32x4*)p, b = *(const f32x4*)(p + 4); uint4 o; o.x = pack2(a[0], a[1]); o.y = pack2(a[2], a[3]); o.z = pack2(b[0], b[1]); o.w = pack2(b[2], b[3]); return o; }

DI void nsa_unit(const Frame& F, int b, int g, int qb) {
    const int tid = F.tid, lane = F.lane, w = F.wave, r = lane & 31, hf = lane >> 5;
    LAS unsigned char* L = F.ldsl;
    LAS unsigned char* buf = L + AT_BUF;
    LAS float* psum = (LAS float*)(L + AT_PSUM);
    LAS unsigned long long* selm = (LAS unsigned long long*)(L + AT_SELM);
    LAS unsigned char* tlist = L + AT_SELM + 528;
    LAS int* tcnt = (LAS int*)(L + AT_SELM + 520);
    const bf16_t* U = (const bf16_t*)(F.ws + WS_U);
    const float* KC = (const float*)(F.ws + WS_KCMP) + (size_t)(b * 2 + g) * 256 * 64;
    const bf16_t* VCT = (const bf16_t*)(F.ws + WS_VCT) + (size_t)(b * 2 + g) * 64 * 256;
    const bf16_t* VT = (const bf16_t*)(F.ws + WS_VT);
    bf16_t* Y = (bf16_t*)(F.ws + WS_BFB);
    const int t0 = qb * 64;
    const int ql = r >> 2, h = r & 3, hh = g * 4 + h;
    const int tq = t0 + 8 * w + ql;
    const size_t row = (size_t)b * SEQ + tq;
    const bf16_t* Ur = U + row * LD0;
    bf16x8 qf[4];
#pragma unroll
    for (int s = 0; s < 4; ++s) qf[s] = *(const bf16x8*)(Ur + C_AQ + hh * 64 + 16 * s + 8 * hf);
    const LAS float* bl = F.biasL + hh * 128; const float bfar = bl[127];
    float gate[3];
    { const unsigned* gp = (const unsigned*)(Ur + C_AG);
#pragma unroll
      for (int j = 0; j < 3; ++j) { const int e = hh * 3 + j; const unsigned wv = gp[e >> 1]; gate[j] = sigmoidf_((e & 1) ? __uint_as_float(wv & 0xFFFF0000u) : __uint_as_float(wv << 16)); } }
    LAS float* opark = psum + w * 2048 + lane;

    const int nvmax = ((t0 + 63 - 31) >> 4) + 1;
    const int ntc = (nvmax + 63) >> 6;
    for (int e = tid; e < 64 * 256; e += 512) psum[e] = 0.f;
    float cm = NEG_INF, cl = 0.f;
    {
        auto ldc = [&](int i, uint4& rk, uint4& rv) { const int key = tid >> 3, c = tid & 7; rk = cvt8_f32(KC + (size_t)(i * 64 + key) * 64 + c * 8); (void)rv; };
        auto body = [&](int i, LAS unsigned char* Kt, LAS unsigned char* Vt) { (void)Vt;
            f32x16 s0, s1; qk_tile(Kt, qf, r, hf, s0, s1);
            fix_scores<FL_NEAR | FL_CAUSAL>(s0, 16 * (i * 64) + 31, 16, tq, bl, bfar, 0u, true, hf);
            fix_scores<FL_NEAR | FL_CAUSAL>(s1, 16 * (i * 64 + 32) + 31, 16, tq, bl, bfar, 0u, true, hf);
            float tm = NEG_INF;
#pragma unroll
            for (int k = 0; k < 16; ++k) tm = fmaxf(tm, fmaxf(s0[k], s1[k]));
            tm = fmaxf(tm, __shfl_xor(tm, 32));
            const float mn = fmaxf(cm, tm); const float mu = (mn == NEG_INF) ? 0.f : mn;
            float ls = 0.f;
#pragma unroll
            for (int k = 0; k < 16; ++k) ls += __builtin_amdgcn_exp2f(s0[k] - mu) + __builtin_amdgcn_exp2f(s1[k] - mu);
            cl = cl * __builtin_amdgcn_exp2f(cm - mu) + ls; cm = mn; };
        tile_stream(ntc, buf, tid, false, ldc, body);
    }
    f32x16 c0, c1;
    {
        cl += __shfl_xor(cl, 32);
        const float cinv = cl > 0.f ? 1.0f / cl : 0.f; const float cmu = (cm == NEG_INF) ? 0.f : cm;
#pragma unroll
        for (int i = 0; i < 16; ++i) { c0[i] = 0.f; c1[i] = 0.f; }
        auto ldc = [&](int i, uint4& rk, uint4& rv) { const int key = tid >> 3, c = tid & 7; rk = cvt8_f32(KC + (size_t)(i * 64 + key) * 64 + c * 8); rv = *(const uint4*)(VCT + (size_t)key * 256 + i * 64 + c * 8); };
        auto body = [&](int i, LAS unsigned char* Kt, LAS unsigned char* Vt) {
            f32x16 s0, s1; qk_tile(Kt, qf, r, hf, s0, s1);
            fix_scores<FL_NEAR | FL_CAUSAL>(s0, 16 * (i * 64) + 31, 16, tq, bl, bfar, 0u, true, hf);
            fix_scores<FL_NEAR | FL_CAUSAL>(s1, 16 * (i * 64 + 32) + 31, 16, tq, bl, bfar, 0u, true, hf);
#pragma unroll
            for (int k = 0; k < 16; ++k) { s0[k] = __builtin_amdgcn_exp2f(s0[k] - cmu) * cinv; s1[k] = __builtin_amdgcn_exp2f(s1[k] - cmu) * cinv; }
#pragma unroll
            for (int k = 0; k < 16; ++k) {
                float a0 = s0[k], a1 = s1[k];
                a0 += __shfl_xor(a0, 1); a0 += __shfl_xor(a0, 2); a1 += __shfl_xor(a1, 1); a1 += __shfl_xor(a1, 2);
                const int koff = (k & 3) + 8 * (k >> 2) + 4 * hf;
                if (h == 0) { psum[(8 * w + ql) * 256 + i * 64 + koff] = a0; psum[(8 * w + ql) * 256 + i * 64 + 32 + koff] = a1; }
            }
            pv_tile(Vt, s0, s1, r, hf, c0, c1); };
        tile_stream(ntc, buf, tid, true, ldc, body);
    }
    {
        const int cur = qb; const int npick = (cur + 1) < 8 ? (cur + 1) : 8;
        LAS float* scw = (LAS float*)(L + AT_MISC + 64) + w * 64;
#pragma unroll 1
        for (int q = 0; q < 8; ++q) {
            const LAS float* pr = psum + (8 * w + q) * 256;
            float imp = 0.f;
            const int i0 = 4 * lane - 1 < 0 ? 0 : 4 * lane - 1, i1 = 4 * lane + 3 > 254 ? 254 : 4 * lane + 3;
            for (int i = i0; i <= i1; ++i) imp += pr[i];
            const bool adm = lane <= cur; const bool forced = (lane == 0) || (lane == cur) || (lane == cur - 1);
            const float score = adm ? imp + (forced ? 1.0e4f : 0.f) : NEG_INF;
            __builtin_amdgcn_wave_barrier();
            scw[lane] = score;
            __builtin_amdgcn_wave_barrier();
            int rank = 0;
#pragma unroll
            for (int j4 = 0; j4 < 16; ++j4) { const f32x4 o = *(const LAS f32x4*)(scw + 4 * j4);
#pragma unroll
                for (int e = 0; e < 4; ++e) { const int j = 4 * j4 + e; rank += (o[e] > score || (o[e] == score && j < lane)) ? 1 : 0; } }
            const unsigned long long sm = __ballot(adm && rank < npick);
            if (lane == 0) selm[8 * w + q] = sm;
        }
    }
    __syncthreads();
    if (w == 0) {
        unsigned long long m = selm[lane];
        unsigned lo = (unsigned)m, hi = (unsigned)(m >> 32);
        for (int o = 32; o >= 1; o >>= 1) { lo |= __shfl_xor(lo, o); hi |= __shfl_xor(hi, o); }
        const unsigned long long un = ((unsigned long long)hi << 32) | lo;
        const bool mine = (un >> lane) & 1ull;
        const int pos = __popcll(un & ((1ull << lane) - 1ull));
        if (mine) tlist[pos] = (unsigned char)lane;
        if (lane == 0) tcnt[0] = __popcll(un);
    }
    __syncthreads();
#pragma unroll
    for (int i = 0; i < 16; ++i) { opark[i * 64] = gate[0] * c0[i]; opark[(16 + i) * 64] = gate[0] * c1[i]; }
    const unsigned long long mysel = selm[8 * w + ql];
    {
        Att st; att_init(st);
        const int nts = tcnt[0];
        auto lds_ = [&](int i, uint4& rk, uint4& rv) { const int j = tlist[i]; const int key = tid >> 3, c = tid & 7;
            const bf16_t* p = U + ((size_t)b * SEQ + j * 64 + key) * LD0 + g * 64 + c * 8; rk = *(const uint4*)(p + C_KS); rv = *(const uint4*)(VT + (size_t)(g * 64 + key) * MT + (size_t)b * SEQ + j * 64 + c * 8); };
        auto body = [&](int i, LAS unsigned char* Kt, LAS unsigned char* Vt) {
            const int j = tlist[i];
            const bool laneok = (mysel >> j) & 1ull;
            if (__ballot(laneok) == 0ull) return;
            if (j < qb - 2 && __ballot(st.m == NEG_INF) == 0ull) { far_tile<false>(st, Kt, Vt, qf, r, hf, bfar, laneok, 0u, 0u); return; }
            f32x16 s0, s1; qk_tile(Kt, qf, r, hf, s0, s1);
            if (j >= qb - 2) { fix_scores<FL_NEAR | FL_CAUSAL | FL_LANE>(s0, j * 64, 1, tq, bl, bfar, 0u, laneok, hf); fix_scores<FL_NEAR | FL_CAUSAL | FL_LANE>(s1, j * 64 + 32, 1, tq, bl, bfar, 0u, laneok, hf); }
            else { fix_scores<FL_LANE>(s0, j * 64, 1, tq, bl, bfar, 0u, laneok, hf); fix_scores<FL_LANE>(s1, j * 64 + 32, 1, tq, bl, bfar, 0u, laneok, hf); }
            online_pv(st, s0, s1, Vt, r, hf); };
        tile_stream(nts, buf, tid, true, lds_, body);
        float l = st.l + __shfl_xor(st.l, 32);
        const float sc = l > 0.f ? gate[1] / l : 0.f;
#pragma unroll
        for (int i = 0; i < 16; ++i) { opark[i * 64] += sc * st.o0[i]; opark[(16 + i) * 64] += sc * st.o1[i]; }
    }
    {
        Att st; att_init(st);
        const int j0 = qb - 8 < 0 ? 0 : qb - 8; const int ntw = qb - j0 + 1;
        auto ldw = [&](int i, uint4& rk, uint4& rv) { const int j = j0 + i; const int key = tid >> 3, c = tid & 7;
            const bf16_t* p = U + ((size_t)b * SEQ + j * 64 + key) * LD0 + g * 64 + c * 8; rk = *(const uint4*)(p + C_KW); rv = *(const uint4*)(VT + (size_t)(128 + g * 64 + key) * MT + (size_t)b * SEQ + j * 64 + c * 8); };
        auto body = [&](int i, LAS unsigned char* Kt, LAS unsigned char* Vt) {
            const int j = j0 + i;
            if (j < qb - 2 && j != qb - 8 && __ballot(st.m == NEG_INF) == 0ull) { far_tile<false>(st, Kt, Vt, qf, r, hf, bfar, true, 0u, 0u); return; }
            f32x16 s0, s1; qk_tile(Kt, qf, r, hf, s0, s1);
            if (j >= qb - 2) { fix_scores<FL_NEAR | FL_CAUSAL>(s0, j * 64, 1, tq, bl, bfar, 0u, true, hf); fix_scores<FL_NEAR | FL_CAUSAL>(s1, j * 64 + 32, 1, tq, bl, bfar, 0u, true, hf); }
            else if (j == qb - 8) { fix_scores<FL_WINLO>(s0, j * 64, 1, tq, bl, bfar, 0u, true, hf); fix_scores<FL_WINLO>(s1, j * 64 + 32, 1, tq, bl, bfar, 0u, true, hf); }
            else { fix_scores<0>(s0, j * 64, 1, tq, bl, bfar, 0u, true, hf); fix_scores<0>(s1, j * 64 + 32, 1, tq, bl, bfar, 0u, true, hf); }
            online_pv(st, s0, s1, Vt, r, hf); };
        tile_stream(ntw, buf, tid, true, ldw, body);
        float l = st.l + __shfl_xor(st.l, 32);
        const float sc = l > 0.f ? gate[2] / l : 0.f;
#pragma unroll
        for (int i = 0; i < 16; ++i) { c0[i] = opark[i * 64] + sc * st.o0[i]; c1[i] = opark[(16 + i) * 64] + sc * st.o1[i]; }
    }
#pragma unroll
    for (int dh = 0; dh < 2; ++dh)
#pragma unroll
        for (int k = 0; k < 4; ++k) {
            const int d = 32 * dh + 8 * k + 4 * hf;
            const uint2 zz = *(const uint2*)(Ur + C_AZ + hh * 64 + d);
            const float z0 = __uint_as_float(zz.x << 16), z1 = __uint_as_float(zz.x & 0xFFFF0000u), z2 = __uint_as_float(zz.y << 16), z3 = __uint_as_float(zz.y & 0xFFFF0000u);
            const f32x16& o = dh ? c1 : c0;
            uint2 pk; pk.x = pack2(o[4 * k + 0] * siluf_(z0), o[4 * k + 1] * siluf_(z1)); pk.y = pack2(o[4 * k + 2] * siluf_(z2), o[4 * k + 3] * siluf_(z3));
            *(uint2*)(Y + row * 1024 + hh * 64 + d) = pk;
        }
    __syncthreads();
}

DI unsigned short okey16(float x) {
    const _Float16 hx = (_Float16)x; unsigned short u = __builtin_bit_cast(unsigned short, hx);
    if ((u & 0x7FFFu) == 0u) u = 0u;
    return (u & 0x8000u) ? (unsigned short)~u : (unsigned short)(u | 0x8000u);
}
DI void dsa_unit(const Frame& F, int b, int qt) {
    const int tid = F.tid, lane = F.lane, w = F.wave, r = lane & 31, hf = lane >> 5, fr = lane & 15, fq = lane >> 4;
    LAS unsigned char* L = F.ldsl;
    LAS unsigned char* buf = L + AT_BUF;
    LAS unsigned* mask = (LAS unsigned*)(L + AT_PSUM);
    const bf16_t* U = (const bf16_t*)(F.ws + WS_U);
    bf16_t* Y = (bf16_t*)(F.ws + WS_BFB);
    const bf16_t* VT = (const bf16_t*)(F.ws + WS_VT);
    unsigned short* KS = (unsigned short*)(F.ws + WS_BFA) + (size_t)F.bid * 32 * 4096;
    const int t0 = qt * 32;
    const int nt = ((t0 + 31) >> 6) + 1;
    {
        bf16x8 qi[2]; float wi[4];
        { const bf16_t* Uq = U + ((size_t)b * SEQ + t0 + 4 * w + (fr >> 2)) * LD0;
#pragma unroll
          for (int ks = 0; ks < 2; ++ks) qi[ks] = *(const bf16x8*)(Uq + C_BQI + (fr & 3) * 64 + 32 * ks + 8 * fq);
          const uint2 wv = *(const uint2*)(U + ((size_t)b * SEQ + t0 + 4 * w + fq) * LD0 + C_BWI);
          wi[0] = __uint_as_float(wv.x << 16) * 0.0625f; wi[1] = __uint_as_float(wv.x & 0xFFFF0000u) * 0.0625f; wi[2] = __uint_as_float(wv.y << 16) * 0.0625f; wi[3] = __uint_as_float(wv.y & 0xFFFF0000u) * 0.0625f; }
        const int tqi = t0 + 4 * w + fq;
        auto ldi = [&](int i, uint4& rk, uint4& rv) { const int key = tid >> 3, c = tid & 7; rk = *(const uint4*)(U + ((size_t)b * SEQ + i * 64 + key) * LD0 + C_BKI + c * 8); (void)rv; };
        auto body = [&](int i, LAS unsigned char* Kt, LAS unsigned char* Vt) { (void)Vt;
#pragma unroll
            for (int kg = 0; kg < 4; ++kg) {
                const int kk = 16 * kg + fr;
                f32x4 acc = {0.f, 0.f, 0.f, 0.f};
#pragma unroll
                for (int ks = 0; ks < 2; ++ks) { const int c = 4 * ks + fq;
                    const bf16x8 kb = *(const LAS bf16x8*)(Kt + kk * 128 + ((c ^ (kk & 7)) << 4));
                    acc = __builtin_amdgcn_mfma_f32_16x16x32_bf16(qi[ks], kb, acc, 0, 0, 0); }
                const float sc = wi[0] * fmaxf(acc[0], 0.f) + wi[1] * fmaxf(acc[1], 0.f) + wi[2] * fmaxf(acc[2], 0.f) + wi[3] * fmaxf(acc[3], 0.f);
                const int pos = i * 64 + kk;
                KS[(size_t)(4 * w + fq) * 4096 + pos] = pos <= tqi ? okey16(sc) : (unsigned short)0;
            } };
        tile_stream(nt, buf, tid, false, ldi, body);
    }
    asm volatile("s_waitcnt vmcnt(0)" ::: "memory");
    __syncthreads();
    __builtin_amdgcn_fence(__ATOMIC_ACQUIRE, "agent");
    asm volatile("s_waitcnt vmcnt(0)" ::: "memory");
    {
    LAS unsigned char* maskb = (LAS unsigned char*)mask;
#pragma unroll 1
    for (int q = 0; q < 4; ++q) {
        const int qq = 4 * w + q; const int tqq = t0 + qq; const int nk = tqq + 1;
        const unsigned short* kq = KS + (size_t)qq * 4096;
        if (nk <= 256) {
#pragma unroll
            for (int c = 0; c < 8; ++c) { unsigned selb = 0u;
#pragma unroll
                for (int e = 0; e < 8; ++e) if (c * 512 + lane * 8 + e < nk) selb |= 1u << e;
                maskb[qq * 512 + c * 64 + lane] = (unsigned char)selb; }
            continue;
        }
        unsigned T[32];
#pragma unroll
        for (int c = 0; c < 8; ++c) { uint4 kv = make_uint4(0u, 0u, 0u, 0u); if (c * 512 < nk) kv = *(const uint4*)(kq + c * 512 + lane * 8);
            T[4 * c] = kv.x; T[4 * c + 1] = kv.y; T[4 * c + 2] = kv.z; T[4 * c + 3] = kv.w; }
#pragma unroll
        for (int e = 0; e < 32; ++e) { const int idx = (e >> 2) * 512 + lane * 8 + (e & 3) * 2;
            unsigned lo = T[e] & 0xFFFFu, hi = T[e] >> 16; if (idx >= nk) lo = 0u; if (idx + 1 >= nk) hi = 0u; T[e] = lo | (hi << 16); }
#pragma unroll
        for (int st = 0; st < 5; ++st) { const int j = 16 >> st; const unsigned m = st == 0 ? 0x0000FFFFu : st == 1 ? 0x00FF00FFu : st == 2 ? 0x0F0F0F0Fu : st == 3 ? 0x33333333u : 0x55555555u;
#pragma unroll
            for (int k0 = 0; k0 < 32; k0 += 2 * j)
#pragma unroll
                for (int i = 0; i < j; ++i) { const int k = k0 + i; const unsigned t = ((T[k] >> j) ^ T[k + j]) & m; T[k] ^= (t << j); T[k + j] ^= t; } }
        unsigned ce = 0xFFFFFFFFu, co = 0xFFFFFFFFu, ge = 0u, go = 0u; int above = 0;
#pragma unroll
        for (int bit = 15; bit >= 0; --bit) {
            const unsigned oe = ce & T[bit], oo = co & T[16 + bit];
            const int cnt = __popc(oe) + __popc(oo);
            int tot = 0;
#pragma unroll
            for (int bb = 0; bb < 7; ++bb) tot += __popcll(__ballot((cnt >> bb) & 1)) << bb;
            if (above + tot >= 256) { ce = oe; co = oo; }
            else { above += tot; ge |= oe; go |= oo; ce &= ~T[bit]; co &= ~T[16 + bit]; }
        }
        const int quota = 256 - above; int taken = 0;
#pragma unroll
        for (int c = 0; c < 8; ++c) {
            unsigned xe = (ge >> (4 * c)) & 0xFu, xo = (go >> (4 * c)) & 0xFu;
            xe = (xe | (xe << 2)) & 0x33u; xe = (xe | (xe << 1)) & 0x55u; xo = (xo | (xo << 2)) & 0x33u; xo = (xo | (xo << 1)) & 0x55u;
            unsigned selb = xe | (xo << 1);
            unsigned ye = (ce >> (4 * c)) & 0xFu, yo = (co >> (4 * c)) & 0xFu;
            ye = (ye | (ye << 2)) & 0x33u; ye = (ye | (ye << 1)) & 0x55u; yo = (yo | (yo << 2)) & 0x33u; yo = (yo | (yo << 1)) & 0x55u;
            const unsigned eqb = ye | (yo << 1);
            if (__ballot(eqb != 0u) != 0ull) {
                const int ne = __popc(eqb);
                int excl = 0, totc = 0;
#pragma unroll
                for (int bb = 0; bb < 4; ++bb) { const unsigned long long bl_ = __ballot((ne >> bb) & 1);
                    excl += (int)__builtin_amdgcn_mbcnt_hi((unsigned)(bl_ >> 32), __builtin_amdgcn_mbcnt_lo((unsigned)bl_, 0u)) << bb; totc += __popcll(bl_) << bb; }
                int rank = taken + excl;
#pragma unroll
                for (int e = 0; e < 8; ++e) if ((eqb >> e) & 1u) { if (rank < quota) selb |= 1u << e; ++rank; }
                taken += totc;
            }
            maskb[qq * 512 + c * 64 + lane] = (unsigned char)selb;
        }
    }
    }
    __syncthreads();
    {
        const int ql = r >> 3, h = r & 7;
        const int tq = t0 + 4 * w + ql;
        const size_t row = (size_t)b * SEQ + tq;
        const bf16_t* Ur = U + row * LD0;
        bf16x8 qf[4];
#pragma unroll
        for (int s = 0; s < 4; ++s) qf[s] = *(const bf16x8*)(Ur + C_BQ + h * 64 + 16 * s + 8 * hf);
        const LAS float* bl = F.biasL + (8 + h) * 128; const float bfar = bl[127];
        const LAS unsigned* mq = mask + (4 * w + ql) * 128;
        Att st; att_init(st);
        auto lda = [&](int i, uint4& rk, uint4& rv) { const int key = tid >> 3, c = tid & 7;
            const bf16_t* p = U + ((size_t)b * SEQ + i * 64 + key) * LD0 + c * 8; rk = *(const uint4*)(p + C_BK); rv = *(const uint4*)(VT + (size_t)(256 + key) * MT + (size_t)b * SEQ + i * 64 + c * 8); };
        auto body = [&](int i, LAS unsigned char* Kt, LAS unsigned char* Vt) {
            const unsigned m0 = mq[2 * i], m1 = mq[2 * i + 1];
            if (i < nt - 4 && __ballot(st.m == NEG_INF) == 0ull) { far_tile<true>(st, Kt, Vt, qf, r, hf, bfar, true, m0, m1); return; }
            f32x16 s0, s1; qk_tile(Kt, qf, r, hf, s0, s1);
            if (i >= nt - 4) { fix_scores<FL_NEAR | FL_CAUSAL | FL_BITS>(s0, i * 64, 1, tq, bl, bfar, m0, true, hf); fix_scores<FL_NEAR | FL_CAUSAL | FL_BITS>(s1, i * 64 + 32, 1, tq, bl, bfar, m1, true, hf); }
            else { fix_scores<FL_BITS>(s0, i * 64, 1, tq, bl, bfar, m0, true, hf); fix_scores<FL_BITS>(s1, i * 64 + 32, 1, tq, bl, bfar, m1, true, hf); }
            online_pv(st, s0, s1, Vt, r, hf); };
        tile_stream(nt, buf, tid, true, lda, body);
        float l = st.l + __shfl_xor(st.l, 32);
        const float sc = l > 0.f ? 1.0f / l : 0.f;
#pragma unroll
        for (int dh = 0; dh < 2; ++dh)
#pragma unroll
            for (int k = 0; k < 4; ++k) {
                const int d = 32 * dh + 8 * k + 4 * hf;
                const uint2 zz = *(const uint2*)(Ur + C_BZ + h * 64 + d);
                const float z0 = __uint_as_float(zz.x << 16), z1 = __uint_as_float(zz.x & 0xFFFF0000u), z2 = __uint_as_float(zz.y << 16), z3 = __uint_as_float(zz.y & 0xFFFF0000u);
                const f32x16& o = dh ? st.o1 : st.o0;
                uint2 pk; pk.x = pack2(o[4 * k + 0] * sc * siluf_(z0), o[4 * k + 1] * sc * siluf_(z1)); pk.y = pack2(o[4 * k + 2] * sc * siluf_(z2), o[4 * k + 3] * sc * siluf_(z3));
                *(uint2*)(Y + row * 1024 + 512 + h * 64 + d) = pk;
            }
    }
    __syncthreads();
}

DI void att_dsa(const Frame& F) {
    LAS int* ub = (LAS int*)(F.ldsl + AT_MISC);
    unsigned* qd = F.ctl + CW_QDSA;
    const int NDSA = NB * (SEQ / 32);
    for (;;) {
        __syncthreads();
        if (F.tid == 0) ub[0] = (int)__hip_atomic_fetch_add(qd, 1u, __ATOMIC_RELAXED, __HIP_MEMORY_SCOPE_AGENT);
        __syncthreads();
        const int k = ub[0];
        if (k >= NDSA) break;
        dsa_unit(F, k & 7, (SEQ / 32) - 1 - (k >> 3));
    }
}
DI void att_nsa(const Frame& F) {
    LAS int* ub = (LAS int*)(F.ldsl + AT_MISC);
    unsigned* qn = F.ctl + CW_QNSA;
    const int NNSA = NB * 2 * (SEQ / 64);
    for (;;) {
        __syncthreads();
        if (F.tid == 0) ub[0] = (int)__hip_atomic_fetch_add(qn, 1u, __ATOMIC_RELAXED, __HIP_MEMORY_SCOPE_AGENT);
        __syncthreads();
        const int k = ub[0];
        if (k >= NNSA) break;
        const int bg = k & 15;
        nsa_unit(F, bg >> 1, bg & 1, 63 - (k >> 4));
    }
}
#endif

DI f32x4 mma16(const bf16_t* A, int lda, const bf16_t* Bt, int ldb, int K, int lane) {
    const int fr = lane & 15, fq = lane >> 4;
    f32x4 acc = {0.f, 0.f, 0.f, 0.f};
    for (int k = 0; k < K; k += 32) {
        const bf16x8 a = *(const bf16x8*)(A + fr * lda + k + fq * 8);
        const bf16x8 b = *(const bf16x8*)(Bt + fr * ldb + k + fq * 8);
        acc = __builtin_amdgcn_mfma_f32_16x16x32_bf16(a, b, acc, 0, 0, 0);
    }
    return acc;
}
DI void conv8(const bf16_t* U1, int b, int t, int col, const float* cw  , int nch, const float* cb, float (&y)[8]) {
#pragma unroll
    for (int i = 0; i < 8; ++i) y[i] = cb[i];
#pragma unroll
    for (int j = 0; j < 4; ++j) { const int tt = t - 3 + j;
        if (tt >= 0) { const uint4 v = *(const uint4*)(U1 + ((size_t)b * SEQ + tt) * LD1 + col); float f[8]; unpack8(v, f);
#pragma unroll
            for (int i = 0; i < 8; ++i) y[i] += cw[(size_t)j * nch + i] * f[i]; } }
}
DI void mlstm_gates(const Frame& F, const bf16_t* U1, int b, int h, int c, float* li, float* bc) {
    if (F.wave == 0) {
        const size_t row = (size_t)b * SEQ + c * 64 + F.lane;
        const float ip = bf2f(U1[row * LD1 + C_DI + h]) + F.in[26][h];
        const float fp = bf2f(U1[row * LD1 + C_DF + h]) + F.in[27][h];
        const float lf = fminf(fp, 0.f) - log1pf(expf(-fabsf(fp)));
        float cs = lf;
        for (int o = 1; o < 64; o <<= 1) { const float n = __shfl_up(cs, o); if (F.lane >= o) cs += n; }
        li[F.lane] = ip; bc[F.lane] = cs;
    }
    __syncthreads();
}
constexpr int ML_LI = 0, ML_BC = 256, ML_WK = 512, ML_MT = 768, ML_DQ = 1024, ML_RS = 1280, ML_NIN = 1536, ML_Q = 2048, ML_K = ML_Q + 64 * 136 * 2, ML_VT = ML_K + 64 * 136 * 2,
              ML_CT = ML_VT + 128 * 72 * 2, ML_W = ML_CT + 128 * 136 * 2, ML_KT = ML_W + 64 * 72 * 2, ML_END = ML_KT + 128 * 72 * 2;
static_assert(ML_END + 5120 + LDS_WORK_OFF <= LDS_BYTES - 12288, "mlstm lds");

DI void p8a_mlstm_local(const Frame& F) {
    const bf16_t* U1 = (const bf16_t*)(F.ws + WS_U);
    bf16_t* ST = (bf16_t*)(F.ws + WS_BFB);
    float* zloc = (float*)(F.ws + WS_ZLOC); float* scal = (float*)(F.ws + WS_SCAL);
    unsigned char* L = F.lds;
    float* li = (float*)(L + ML_LI); float* bc = (float*)(L + ML_BC); float* wk = (float*)(L + ML_WK);
    bf16_t* kT = (bf16_t*)(L + ML_KT); bf16_t* vT = (bf16_t*)(L + ML_VT); float* cwl = (float*)(L + ML_END);
    const float* cw = F.in[24]; const float* cb = F.in[25];
    for (int unit = F.bid; unit < 2048; unit += F.G) {
        const int c = unit & 63, h = (unit >> 6) & 3, b = unit >> 8;
        mlstm_gates(F, U1, b, h, c, li, bc);
        if (F.wave == 0) {
            const float bl = bc[63]; const float dec = bl - bc[F.lane] + li[F.lane];
            const float dmx = wave_max(dec);
            wk[F.lane] = expf(dec - dmx);
            if (F.lane == 0) { scal[unit] = bl; scal[2048 + unit] = dmx; }
        }
        for (int e = F.tid; e < 640; e += 512) cwl[e] = e < 512 ? cw[(size_t)(e >> 7) * 1024 + 512 + h * 128 + (e & 127)] : cb[512 + h * 128 + (e - 512)];
        __syncthreads();
        for (int it = F.tid; it < 1024; it += 512) {
            const int s = it & 63, d0 = (it >> 6) * 8; const int t = c * 64 + s;
            float y[8]; conv8(U1, b, t, C_DK + h * 128 + d0, cwl + d0, 128, cwl + 512 + d0, y);
            const float w = wk[s] * 0.08838834764831845f;
#pragma unroll
            for (int i = 0; i < 8; ++i) kT[(d0 + i) * 72 + s] = f2bf(siluf_(y[i]) * w);
            const uint4 vv = *(const uint4*)(U1 + ((size_t)b * SEQ + t) * LD1 + C_DV + h * 128 + d0); float vf[8]; unpack8(vv, vf);
#pragma unroll
            for (int i = 0; i < 8; ++i) vT[(d0 + i) * 72 + s] = f2bf(vf[i]);
        }
        __syncthreads();
        for (int tix = F.wave * 8; tix < F.wave * 8 + 8; ++tix) {
            const int et = tix >> 3, dt = tix & 7;
            const f32x4 a = mma16(vT + et * 16 * 72, 72, kT + dt * 16 * 72, 72, 64, F.lane);
            const int fr = F.lane & 15, fq = F.lane >> 4;
#pragma unroll
            for (int r = 0; r < 4; ++r) ST[(size_t)unit * 16384 + (size_t)(et * 16 + 4 * fq + r) * 128 + dt * 16 + fr] = f2bf(a[r]);
        }
        if (F.tid < 128) { float z = 0.f; for (int s = 0; s < 64; ++s) z += bf2f(kT[F.tid * 72 + s]); zloc[(size_t)unit * 128 + F.tid] = z; }
        __syncthreads();
    }
}

DI void p8a_lru_local(const Frame& F) {
    const bf16_t* U1 = (const bf16_t*)(F.ws + WS_U);
    bf16_t* LA = (bf16_t*)(F.ws + WS_LRUA); bf16_t* LH = (bf16_t*)(F.ws + WS_LRUH);
    float* Aend = (float*)(F.ws + WS_AEND); float* Hend = (float*)(F.ws + WS_HEND);
    const bf16_t* WAT = (const bf16_t*)(F.ws + WS_WAT); const bf16_t* WXT = (const bf16_t*)(F.ws + WS_WXT);
    bf16_t* xcb = (bf16_t*)F.lds;
    float* cwL = (float*)(F.lds + 16640);
    const int g = F.wave, lane = F.lane, fr = lane & 15, fq = lane >> 4;
    __syncthreads();
    for (int e = F.tid; e < 2048; e += 512) cwL[e] = F.in[17][e];
    cwL[2048 + F.tid] = F.in[18][F.tid];
    bf16x8 wa[4][2], wx[4][2]; float ba[4], bx[4], sp[4];
#pragma unroll
    for (int ct = 0; ct < 4; ++ct) { const int ch = g * 64 + ct * 16 + fr;
#pragma unroll
        for (int ks = 0; ks < 2; ++ks) { wa[ct][ks] = *(const bf16x8*)(WAT + (size_t)ch * 64 + 32 * ks + 8 * fq); wx[ct][ks] = *(const bf16x8*)(WXT + (size_t)ch * 64 + 32 * ks + 8 * fq); }
        ba[ct] = F.in[20][ch]; bx[ct] = F.in[22][ch]; sp[ct] = log1pf(expf(-F.in[23][ch])); }
    __syncthreads();
    for (int unit = F.bid; unit < 512; unit += F.G) {
        const int b = unit >> 6, c = unit & 63, t0 = c * 64;
        float Ac[4] = {1.f, 1.f, 1.f, 1.f}, hl[4] = {0.f, 0.f, 0.f, 0.f};
#pragma unroll 1
        for (int sub = 0; sub < 4; ++sub) {
            for (int it = F.tid; it < 1024; it += 512) {
                const int tk = it >> 6, c8 = (it & 63) * 8; const int t = t0 + sub * 16 + tk;
                float y[8];
#pragma unroll
                for (int i = 0; i < 8; ++i) y[i] = cwL[2048 + c8 + i];
#pragma unroll
                for (int j = 0; j < 4; ++j) { const int tt = t - 3 + j;
                    if (tt >= 0) { const uint4 v = *(const uint4*)(U1 + ((size_t)b * SEQ + tt) * LD1 + C_CX + c8); float f[8]; unpack8(v, f);
#pragma unroll
                        for (int i = 0; i < 8; ++i) y[i] += cwL[j * 512 + c8 + i] * f[i]; } }
                uint4 o; o.x = pack2(y[0], y[1]); o.y = pack2(y[2], y[3]); o.z = pack2(y[4], y[5]); o.w = pack2(y[6], y[7]);
                *(uint4*)(xcb + tk * 520 + c8) = o;
            }
            __syncthreads();
            bf16x8 af[2];
#pragma unroll
            for (int ks = 0; ks < 2; ++ks) af[ks] = *(const bf16x8*)(xcb + fr * 520 + g * 64 + 32 * ks + 8 * fq);
#pragma unroll
            for (int ct = 0; ct < 4; ++ct) {
                const int ch = g * 64 + ct * 16 + fr;
                f32x4 accA = {0.f, 0.f, 0.f, 0.f}, accX = {0.f, 0.f, 0.f, 0.f};
#pragma unroll
                for (int ks = 0; ks < 2; ++ks) { accA = __builtin_amdgcn_mfma_f32_16x16x32_bf16(af[ks], wa[ct][ks], accA, 0, 0, 0); accX = __builtin_amdgcn_mfma_f32_16x16x32_bf16(af[ks], wx[ct][ks], accX, 0, 0, 0); }
                float Ap[4], Hp[4]; float A4 = 1.f, H4 = 0.f;
#pragma unroll
                for (int rg = 0; rg < 4; ++rg) {
                    const float xc = bf2f(xcb[(4 * fq + rg) * 520 + ch]);
                    const float r = sigmoidf_(accA[rg] + ba[ct]), ig = sigmoidf_(accX[rg] + bx[ct]);
                    const float a = fexp_(-8.0f * r * sp[ct]);
                    const float bt = sqrtf(fmaxf(1.0f - a * a, 0.f)) * (ig * xc);
                    H4 = a * H4 + bt; A4 *= a; Ap[rg] = A4; Hp[rg] = H4;
                }
                float iA = A4, iH = H4;
                { const float pA = __shfl_up(iA, 16), pH = __shfl_up(iH, 16); if (fq >= 1) { iH = iA * pH + iH; iA = pA * iA; } }
                { const float pA = __shfl_up(iA, 32), pH = __shfl_up(iH, 32); if (fq >= 2) { iH = iA * pH + iH; iA = pA * iA; } }
                float eA = __shfl_up(iA, 16), eH = __shfl_up(iH, 16); if (fq == 0) { eA = 1.f; eH = 0.f; }
                const float tA = __shfl(iA, 48 + fr), tH = __shfl(iH, 48 + fr);
                const float cA = Ac[ct] * eA, cH = eA * hl[ct] + eH;
#pragma unroll
                for (int rg = 0; rg < 4; ++rg) { const size_t row = (size_t)b * SEQ + t0 + sub * 16 + 4 * fq + rg;
                    LA[row * 512 + ch] = f2bf(cA * Ap[rg]); LH[row * 512 + ch] = f2bf(Ap[rg] * cH + Hp[rg]); }
                hl[ct] = tA * hl[ct] + tH; Ac[ct] = Ac[ct] * tA;
            }
            __syncthreads();
        }
        if (fq == 0) {
#pragma unroll
            for (int ct = 0; ct < 4; ++ct) { const int ch = g * 64 + ct * 16 + fr; Aend[((size_t)b * 64 + c) * 512 + ch] = Ac[ct]; Hend[((size_t)b * 64 + c) * 512 + ch] = hl[ct]; } }
    }
    __syncthreads();
}

DI void p8b_scans(const Frame& F) {
    const int gt = F.bid * 512 + F.tid, nthr = F.G * 512;
    if (gt < 4096) {
        const int b = gt >> 9, ch = gt & 511;
        const float* Aend = (const float*)(F.ws + WS_AEND); const float* Hend = (const float*)(F.ws + WS_HEND); float* Hin = (float*)(F.ws + WS_HIN);
        float H = 0.f;
#pragma unroll 1
        for (int c0 = 0; c0 < 64; c0 += 8) {
            float av[8], hv[8];
#pragma unroll
            for (int j = 0; j < 8; ++j) { const size_t o = ((size_t)b * 64 + c0 + j) * 512 + ch; av[j] = Aend[o]; hv[j] = Hend[o]; }
#pragma unroll
            for (int j = 0; j < 8; ++j) { const size_t o = ((size_t)b * 64 + c0 + j) * 512 + ch; Hin[o] = H; H = av[j] * H + hv[j]; }
        }
    }
    const float* scal = (const float*)(F.ws + WS_SCAL); float* minp = (float*)(F.ws + WS_SCAL) + 4096;
    if (gt >= nthr - 4096) {
        const int q = gt - (nthr - 4096); const int bh = q >> 7, d = q & 127;
        const float* zloc = (const float*)(F.ws + WS_ZLOC); float* nin = (float*)(F.ws + WS_NIN);
        float m = 0.f, n = 0.f;
#pragma unroll 1
        for (int c0 = 0; c0 < 64; c0 += 8) {
            float zv[8];
#pragma unroll
            for (int j = 0; j < 8; ++j) zv[j] = zloc[(size_t)(bh * 64 + c0 + j) * 128 + d];
#pragma unroll
            for (int j = 0; j < 8; ++j) { const int unit = bh * 64 + c0 + j; const float bl = scal[unit], dm = scal[2048 + unit];
                const float mn = fmaxf(bl + m, dm); const float keep = expf(bl + m - mn), add = expf(dm - mn);
                nin[(size_t)unit * 128 + d] = n; if (d == 0) minp[unit] = m;
                n = keep * n + add * zv[j]; m = mn; }
        }
    }
    bf16_t* ST = (bf16_t*)(F.ws + WS_BFB);
    float* kp = (float*)F.lds; float* ad = kp + 64;
    for (int k = 0; k < 4; ++k) {
        const int el = gt + k * nthr; const int bh = el >> 14, ed = el & 16383;
        __syncthreads();
        if (F.tid == 0) { float m = 0.f;
            for (int c = 0; c < 64; ++c) { const int unit = bh * 64 + c; const float bl = scal[unit], dm = scal[2048 + unit];
                const float mn = fmaxf(bl + m, dm); kp[c] = expf(bl + m - mn); ad[c] = expf(dm - mn); m = mn; } }
        __syncthreads();
        float C = 0.f;
#pragma unroll 1
        for (int c0 = 0; c0 < 64; c0 += 16) {
            bf16_t sv[16];
#pragma unroll
            for (int j = 0; j < 16; ++j) sv[j] = ST[(size_t)(bh * 64 + c0 + j) * 16384 + ed];
#pragma unroll
            for (int j = 0; j < 16; ++j) { ST[(size_t)(bh * 64 + c0 + j) * 16384 + ed] = f2bf(C); C = kp[c0 + j] * C + ad[c0 + j] * bf2f(sv[j]); }
        }
    }
}

DI void p8c_mlstm_out(const Frame& F) {
    const bf16_t* U1 = (const bf16_t*)(F.ws + WS_U);
    const bf16_t* ST = (const bf16_t*)(F.ws + WS_BFB);
    bf16_t* Y = (bf16_t*)(F.ws + WS_BFA);
    const float* nin_g = (const float*)(F.ws + WS_NIN); const float* minp = (const float*)(F.ws + WS_SCAL) + 4096;
    unsigned char* L = F.lds;
    float* li = (float*)(L + ML_LI); float* bc = (float*)(L + ML_BC); float* wkk = (float*)(L + ML_WK); float* mt = (float*)(L + ML_MT); float* dq = (float*)(L + ML_DQ); float* rs = (float*)(L + ML_RS); float* nin = (float*)(L + ML_NIN);
    bf16_t* q = (bf16_t*)(L + ML_Q); bf16_t* k = (bf16_t*)(L + ML_K); bf16_t* vT = (bf16_t*)(L + ML_VT); bf16_t* CT = (bf16_t*)(L + ML_CT); bf16_t* W = (bf16_t*)(L + ML_W); float* cwl = (float*)(L + ML_END);
    const float* cw = F.in[24]; const float* cb = F.in[25];
    for (int unit = F.bid; unit < 2048; unit += F.G) {
        const int c = unit & 63, h = (unit >> 6) & 3, b = unit >> 8;
        const float m_in = minp[unit];
        for (int e = F.tid; e < 1280; e += 512) { float v;
            if (e < 512) v = cw[(size_t)(e >> 7) * 1024 + h * 128 + (e & 127)]; else if (e < 1024) v = cw[(size_t)((e - 512) >> 7) * 1024 + 512 + h * 128 + (e & 127)];
            else if (e < 1152) v = cb[h * 128 + (e - 1024)]; else v = cb[512 + h * 128 + (e - 1152)];
            cwl[e] = v; }
        mlstm_gates(F, U1, b, h, c, li, bc);
        for (int it = F.tid; it < 1024; it += 512) {
            const int s = it & 63, d0 = (it >> 6) * 8; const int t = c * 64 + s;
            float y[8];
            conv8(U1, b, t, C_DQ + h * 128 + d0, cwl + d0, 128, cwl + 1024 + d0, y);
            uint4 o; o.x = pack2(siluf_(y[0]), siluf_(y[1])); o.y = pack2(siluf_(y[2]), siluf_(y[3])); o.z = pack2(siluf_(y[4]), siluf_(y[5])); o.w = pack2(siluf_(y[6]), siluf_(y[7]));
            *(uint4*)(q + s * 136 + d0) = o;
            conv8(U1, b, t, C_DK + h * 128 + d0, cwl + 512 + d0, 128, cwl + 1152 + d0, y);
            const float sc = 0.08838834764831845f;
            o.x = pack2(siluf_(y[0]) * sc, siluf_(y[1]) * sc); o.y = pack2(siluf_(y[2]) * sc, siluf_(y[3]) * sc); o.z = pack2(siluf_(y[4]) * sc, siluf_(y[5]) * sc); o.w = pack2(siluf_(y[6]) * sc, siluf_(y[7]) * sc);
            *(uint4*)(k + s * 136 + d0) = o;
            const uint4 vv = *(const uint4*)(U1 + ((size_t)b * SEQ + t) * LD1 + C_DV + h * 128 + d0);
            const bf16_t* vp = (const bf16_t*)&vv;
#pragma unroll
            for (int i = 0; i < 8; ++i) vT[(d0 + i) * 72 + s] = vp[i];
        }
        for (int it = F.tid; it < 2048; it += 512) { const int e = it >> 4, d0 = (it & 15) * 8;
            *(uint4*)(CT + e * 136 + d0) = *(const uint4*)(ST + (size_t)unit * 16384 + e * 128 + d0); }
        if (F.tid < 128) nin[F.tid] = nin_g[(size_t)unit * 128 + F.tid];
        if (F.tid >= 128 && F.tid < 192) { const int l = F.tid - 128; float mx = bc[l] + m_in;
            for (int s = 0; s <= l; ++s) mx = fmaxf(mx, bc[l] - bc[s] + li[s]);
            mt[l] = mx; }
        __syncthreads();
        if (F.tid < 64) { float a = 0.f; for (int d = 0; d < 128; ++d) a += bf2f(q[F.tid * 136 + d]) * nin[d]; dq[F.tid] = a; }
        for (int tix = F.wave * 2; tix < F.wave * 2 + 2; ++tix) {
            const int lt = tix >> 2, st = tix & 3;
            const f32x4 a = mma16(q + lt * 16 * 136, 136, k + st * 16 * 136, 136, 128, F.lane);
            const int fr = F.lane & 15, fq = F.lane >> 4; const int s = st * 16 + fr;
#pragma unroll
            for (int r = 0; r < 4; ++r) { const int l = lt * 16 + 4 * fq + r;
                const float w = s <= l ? a[r] * expf(bc[l] - bc[s] + li[s] - mt[l]) : 0.f;
                W[l * 72 + s] = f2bf(w); }
        }
        __syncthreads();
        if (F.tid < 64) { float a = 0.f; for (int s = 0; s < 64; ++s) a += bf2f(W[F.tid * 72 + s]); rs[F.tid] = a; }
        if (F.tid >= 64 && F.tid < 128) { const int l = F.tid - 64; li[l] = expf(bc[l] + m_in - mt[l]); }
        if (F.tid >= 128 && F.tid < 192) { const int l = F.tid - 128; wkk[l] = expf(-mt[l]); }
        __syncthreads();
        for (int tix = F.wave * 4; tix < F.wave * 4 + 4; ++tix) {
            const int lt = tix >> 3, et = tix & 7;
            const f32x4 qc = mma16(q + lt * 16 * 136, 136, CT + et * 16 * 136, 136, 128, F.lane);
            const f32x4 wv = mma16(W + lt * 16 * 72, 72, vT + et * 16 * 72, 72, 64, F.lane);
            const int fr = F.lane & 15, fq = F.lane >> 4; const int e = et * 16 + fr;
#pragma unroll
            for (int r = 0; r < 4; ++r) { const int l = lt * 16 + 4 * fq + r;
                const float prev = li[l];
                const float num = prev * qc[r] + wv[r];
                const float den = prev * dq[l] + rs[l];
                const float hv = num * __builtin_amdgcn_rcpf(fmaxf(fabsf(den), wkk[l]));
                const size_t row = (size_t)b * SEQ + c * 64 + l;
                const float og = sigmoidf_(bf2f(U1[row * LD1 + C_DO + h * 128 + e]));
                const float zz = siluf_(bf2f(U1[row * LD1 + C_DZ + h * 128 + e]));
                Y[row * 1024 + 512 + h * 128 + e] = f2bf(og * hv * zz); }
        }
        __syncthreads();
    }
}
DI void p8c_lru_out(const Frame& F) {
    const bf16_t* U1 = (const bf16_t*)(F.ws + WS_U);
    const bf16_t* LA = (const bf16_t*)(F.ws + WS_LRUA); const bf16_t* LH = (const bf16_t*)(F.ws + WS_LRUH);
    const float* Hin = (const float*)(F.ws + WS_HIN);
    bf16_t* Y = (bf16_t*)(F.ws + WS_BFA);
    const size_t n8 = (size_t)MT * 64;
    for (size_t it = (size_t)F.bid * 512 + F.tid; it < n8; it += (size_t)F.G * 512) {
        const size_t row = it >> 6; const int c0 = (int)(it & 63) * 8; const int b = (int)(row >> 12), t = (int)(row & 4095), c = t >> 6;
        const uint4 av = *(const uint4*)(LA + row * 512 + c0), hv = *(const uint4*)(LH + row * 512 + c0), zv = *(const uint4*)(U1 + row * LD1 + C_CZ + c0);
        float af[8], hf[8], zf[8]; unpack8(av, af); unpack8(hv, hf); unpack8(zv, zf);
        const float* hi = Hin + ((size_t)b * 64 + c) * 512 + c0; float y[8];
#pragma unroll
        for (int i = 0; i < 8; ++i) y[i] = (af[i] * hi[i] + hf[i]) * siluf_(zf[i]);
        uint4 o; o.x = pack2(y[0], y[1]); o.y = pack2(y[2], y[3]); o.z = pack2(y[4], y[5]); o.w = pack2(y[6], y[7]);
        *(uint4*)(Y + row * 1024 + c0) = o;
    }
}

constexpr int N_PHASES = 16;
__global__ void __launch_bounds__(512, 2) mk_fwd(Args args) {
    extern __shared__ __attribute__((aligned(16))) unsigned char smem[];
    Frame F;
    F.tid = threadIdx.x; F.lane = F.tid & 63; F.wave = __builtin_amdgcn_readfirstlane(F.tid >> 6);
    F.G = gridDim.x; F.bid = blockIdx.x; F.gw = F.bid * 8 + F.wave; F.nw = F.G * 8;
    F.lds = smem + LDS_WORK_OFF; F.ws = args.ws; F.out = args.out; F.ctl = (unsigned*)args.ws;
#pragma unroll
    for (int i = 0; i < 28; ++i) F.in[i] = args.in[i];
    LAS unsigned char* lsm = (LAS unsigned char*)smem;
    LAS unsigned char* lut = lsm + (LDS_BYTES - 12288);
    LAS float* tbl = (LAS float*)(lsm + (LDS_BYTES - 12288 + 256));
    LAS float* biasL = (LAS float*)(lsm + (LDS_BYTES - 8192));
    if (F.tid < 4) ((LAS unsigned*)lsm)[F.tid] = 0u;
    if (F.tid < 128) { const int n = F.tid; int bk;
        if (n < 16) bk = n; else { bk = 16; const int thr[15] = {19, 21, 24, 27, 31, 35, 40, 46, 52, 59, 67, 77, 87, 99, 113};
#pragma unroll
            for (int j = 0; j < 15; ++j) bk += (n >= thr[j]) ? 1 : 0; }
        lut[n] = (unsigned char)bk; }
    { const int hd = F.tid >> 5, bk = F.tid & 31; tbl[hd * 32 + bk] = args.in[6][bk * 16 + hd]; }
    F.lut = lut; F.tbl = tbl; F.biasL = biasL; F.ldsl = lsm + LDS_WORK_OFF;
    __syncthreads();
    for (int e = F.tid; e < 16 * 128; e += 512) { const int hd = e >> 7, n = e & 127; const int bk = n < 16 ? n : (n >= 113 ? 31 : (int)lut[n]); biasL[e] = tbl[hd * 32 + bk] * 1.4426950408889634f; }
    __syncthreads();
    const int lo = args.ph_lo, hi = args.ph_hi;
    XcdBarrier bar; bar.bar = F.ctl; bar.x = 0; bar.st = nullptr;
#if !MK_PER_PHASE
    bar = xcd_barrier_post(F.ctl, (volatile LAS unsigned*)lsm);
#endif
#ifndef PH_MASK
#define PH_MASK 0xFFFF
#endif
#define IN(k) (phase_refresh(F), ((PH_MASK >> (k)) & 1) && lo <= (k) && (k) < hi)
#ifndef DLY_LO
#define DLY_LO -1
#define DLY_HI -1
#endif
#ifndef DLY_MULT
#define DLY_MULT 4
#endif
    unsigned long long dly_t0 = 0ull;
#define DLY_START(k) do { if ((k) == DLY_LO && F.bid == 0 && F.tid == 0) dly_t0 = __builtin_amdgcn_s_memrealtime(); } while (0)
#define DLY_END(k) do { if ((k) == DLY_HI && F.bid == 0) { if (F.tid == 0) { const unsigned long long t1 = __builtin_amdgcn_s_memrealtime(); const unsigned long long until = t1 + DLY_MULT * (t1 - dly_t0); \
        while (__builtin_amdgcn_s_memrealtime() < until) __builtin_amdgcn_s_sleep(16); } __syncthreads(); } } while (0)
#if MK_PER_PHASE
#define SEAM(k) do { } while (0)
#else
#define SEAM(k) do { if (IN(k) && IN((k) + 1)) xcd_barrier(bar); DLY_END(k); DLY_START((k) + 1); } while (0)
#endif
    LAS unsigned char* glds = lsm + LDS_WORK_OFF;
    unsigned char* ws = args.ws;
    bf16_t* BFA = (bf16_t*)(ws + WS_BFA); bf16_t* BFB = (bf16_t*)(ws + WS_BFB); bf16_t* U = (bf16_t*)(ws + WS_U); bf16_t* Ef = (bf16_t*)(ws + WS_U);

    DLY_START(0);
    if (IN(0)) { p0_prologue(F); }
    SEAM(0);
    if (IN(1)) {
        pg8::Gemm g{BFA, (const bf16_t*)(ws + WS_WIN0), MT, LD0, 1024}; pg8::StaticOrder S; S.init(MT, LD0, F.G, F.bid);
        pg8::EpiBf16<0> E{U, LD0};
        pg8::gemm_phase(glds, g, S, E);
        pg8::Gemm g2{(const bf16_t*)(ws + WS_WVT), BFA, 512, MT, 1024}; pg8::StaticOrder S2; S2.init(512, MT, F.G, F.bid);
        pg8::EpiBf16<0> E2{(bf16_t*)(ws + WS_VT), MT};
        pg8::gemm_phase(glds, g2, S2, E2);
    }
    SEAM(1);
    if (IN(2)) { p2a_build_blocks(F); }
    SEAM(2);
    if (IN(3)) {
        if (F.bid < 32) {
            const int which = F.bid >> 4;
            pg8::Gemm g{(const bf16_t*)(ws + (which ? WS_AV : WS_AK)), (const bf16_t*)(ws + (which ? WS_WC1V : WS_WC1K)), 4096, 256, 2048}; pg8::StaticOrder S; S.init(4096, 256, F.G, F.bid & 15);
            pg8::EpiBf16<1> E{(bf16_t*)(ws + (which ? WS_HV : WS_HK)), 256}; pg8::gemm_phase(glds, g, S, E);
            asm volatile("s_waitcnt vmcnt(0)" ::: "memory"); __syncthreads();
            pg8::Unit u; S.next(0, u);
            p2c_compress_rows(F, which, u.pm * 256);
            __syncthreads();
        }
        att_dsa(F);
    }
    SEAM(3);
    if (IN(5)) { att_nsa(F); }
    if (IN(3) && IN(6)) xcd_barrier(bar);
    if (IN(6)) {
        pg8::Gemm g{BFB, (const bf16_t*)(ws + WS_WOUT0), MT, 1024, 1024}; pg8::StaticOrder S; S.init(MT, 1024, F.G, F.bid);
        pg8::EpiResid E{F.in[0], F.out, BFA};
        pg8::gemm_phase(glds, g, S, E);
    }
    SEAM(6);
    if (IN(7)) {
        { pg8::Gemm g{(const bf16_t*)(ws + WS_PBF), (const bf16_t*)(ws + WS_WP0), MT, 1024, 256}; pg8::StaticOrder S; S.init(MT, 1024, F.G, F.bid);
          pg8::EpiBf16<0> E{Ef, 1024}; pg8::gemm_phase(glds, g, S, E); }
        asm volatile("s_waitcnt vmcnt(0)" ::: "memory"); __syncthreads();
        { pg8::Gemm g{BFA, (const bf16_t*)(ws + WS_WG0), MT, 1024, 1024}; pg8::StaticOrder S; S.init(MT, 1024, F.G, F.bid);
          pg8::EpiGate E{F.out, Ef}; pg8::gemm_phase(glds, g, S, E); }
    }
    SEAM(7);
    if (IN(8)) { rmsnorm_rows<0>(F, F.out, F.in[2] + 1024, BFB, nullptr); }
    SEAM(8);
    if (IN(9)) {
        pg8::Gemm g{BFB, (const bf16_t*)(ws + WS_WIN1), MT, LD1, 1024}; pg8::StaticOrder S; S.init(MT, LD1, F.G, F.bid);
        pg8::EpiBf16<0> E{U, LD1};
        pg8::gemm_phase(glds, g, S, E);
    }
    SEAM(9);
    if (IN(10)) { p8a_mlstm_local(F); p8a_lru_local(F); }
    SEAM(10);
    if (IN(11)) { p8b_scans(F); }
    SEAM(11);
    if (IN(12)) { p8c_mlstm_out(F); p8c_lru_out(F); }
    SEAM(12);

    if (IN(13)) {
        pg8::Gemm g{BFA, (const bf16_t*)(ws + WS_WOUT1), MT, 1024, 1024}; pg8::StaticOrder S; S.init(MT, 1024, F.G, F.bid);
        pg8::EpiResid E{F.out, F.out, BFB};
        pg8::gemm_phase(glds, g, S, E);
    }
    SEAM(13);
    if (IN(14)) {
        { pg8::Gemm g{(const bf16_t*)(ws + WS_PBF) + (size_t)MT * 256, (const bf16_t*)(ws + WS_WP1), MT, 1024, 256}; pg8::StaticOrder S; S.init(MT, 1024, F.G, F.bid);
          pg8::EpiBf16<0> E{Ef, 1024}; pg8::gemm_phase(glds, g, S, E); }
        asm volatile("s_waitcnt vmcnt(0)" ::: "memory"); __syncthreads();
        { pg8::Gemm g{BFB, (const bf16_t*)(ws + WS_WG1), MT, 1024, 1024}; pg8::StaticOrder S; S.init(MT, 1024, F.G, F.bid);
          pg8::EpiGate E{F.out, Ef}; pg8::gemm_phase(glds, g, S, E); }
    }
    SEAM(14);
    if (IN(15)) { rmsnorm_rows<1>(F, F.out, F.in[3], nullptr, F.out); }
#undef IN
#undef SEAM
}

extern "C" void kernel_launch(void* const* d_in, const int* in_sizes, int n_in, void* d_out, int out_size, void* d_ws, size_t ws_size, hipStream_t stream) {
    static int grid = 0;
    if (grid == 0) {
        if (n_in != 28 || out_size != MT * DM || ws_size < WS_END) { fprintf(stderr, "kernel_launch: unexpected shapes (n_in %d, out %d, ws %zu < %zu)\n", n_in, out_size, ws_size, (size_t)WS_END); grid = -1; return; }
        int dev = 0, cus = 0, per_cu = 0;
        if (hipGetDevice(&dev) != hipSuccess || hipDeviceGetAttribute(&cus, hipDeviceAttributeMultiprocessorCount, dev) != hipSuccess) { grid = -1; return; }
        if (hipFuncSetAttribute((const void*)mk_fwd, hipFuncAttributeMaxDynamicSharedMemorySize, LDS_BYTES) != hipSuccess) { fprintf(stderr, "kernel_launch: hipFuncSetAttribute failed\n"); grid = -1; return; }
        if (hipOccupancyMaxActiveBlocksPerMultiprocessor(&per_cu, (const void*)mk_fwd, 512, LDS_BYTES) != hipSuccess || per_cu < 1)
            fprintf(stderr, "kernel_launch: occupancy query reports %d workgroups per CU\n", per_cu);
        (void)hipGetLastError();
        grid = cus;
    }
    if (grid < 0) return;
    if (hipMemsetAsync(d_ws, 0, CTL_BYTES, stream) != hipSuccess) return;
    Args a{};
    for (int i = 0; i < 28; ++i) a.in[i] = (const float*)d_in[i];
    a.out = (float*)d_out; a.ws = (unsigned char*)d_ws;
#if MK_PER_PHASE
    for (int p = 0; p < N_PHASES; ++p) { a.ph_lo = p; a.ph_hi = p + 1; hipLaunchKernelGGL(mk_fwd, dim3(grid), dim3(512), LDS_BYTES, stream, a); }
#else
    a.ph_lo = 0; a.ph_hi = N_PHASES;
    hipLaunchKernelGGL(mk_fwd, dim3(grid), dim3(512), LDS_BYTES, stream, a);
#endif
}
```

```cpp
#include <hip/hip_runtime.h>
#include <cstdio>
#include <cstdint>

#ifndef MK_PER_PHASE
#define MK_PER_PHASE 0
#endif

#define LAS __attribute__((address_space(3)))
typedef unsigned short bf16_t;
typedef short bf16x8 __attribute__((ext_vector_type(8)));
typedef float f32x4 __attribute__((ext_vector_type(4)));
#define DI __device__ __forceinline__

constexpr int NB = 8, SEQ = 4096, DM = 1024, MT = NB * SEQ;
constexpr int LD0 = 3072, LD1 = 3840;
constexpr int C_AQ = 0, C_KC = 512, C_VC = 640, C_KS = 768, C_KW = 896, C_AZ = 1024, C_BQ = 1536, C_BZ = 2048,
              C_BK = 2560, C_BKI = 2624, C_BQI = 2688, C_AG = 2944, C_BWI = 2968;
constexpr int C_VS = 0, C_VW = 0, C_BV = 0;
constexpr int C_CX = 0, C_CZ = 512, C_DQ = 1024, C_DK = 1536, C_DV = 2048, C_DO = 2560, C_DZ = 3072, C_DI = 3584, C_DF = 3588;
constexpr int NCMP = 255;
constexpr float NEG_INF = -__builtin_inff();

DI int map0(int n) {
    if (n < 896) return n;
    if (n < 1024) return 1024 + (n - 896);
    if (n < 1536) return 1304 + (n - 1024);
    if (n < 2048) return 1816 + (n - 1536);
    if (n < 2560) return 2780 + (n - 2048);
    if (n < 2624) return 2328 + (n - 2560);
    if (n < 2688) return 2712 + (n - 2624);
    if (n < 2944) return 2456 + (n - 2688);
    if (n < 2968) return 1280 + (n - 2944);
    if (n < 2972) return 2776 + (n - 2968);
    return -1;
}
DI int map1(int n) {
    if (n < 2560) return n;
    if (n < 3072) return 2568 + (n - 2560);
    if (n < 3584) return 3080 + (n - 3072);
    if (n < 3588) return 2560 + (n - 3584);
    if (n < 3592) return 2564 + (n - 3588);
    return -1;
}
DI int mapid(int n) { return n; }
DI int mapv(int f) { return f < 128 ? 896 + f : (f < 256 ? 1152 + (f - 128) : (f < 320 ? 2392 + (f - 256) : -1)); }

constexpr size_t CTL_BYTES = 16384;
constexpr size_t WS_WIN0  = CTL_BYTES;
constexpr size_t WS_WOUT0 = WS_WIN0  + (size_t)LD0 * 1024 * 2;
constexpr size_t WS_WG0   = WS_WOUT0 + (size_t)1024 * 1024 * 2;
constexpr size_t WS_WP0   = WS_WG0   + (size_t)1024 * 1024 * 2;
constexpr size_t WS_WIN1  = WS_WP0   + (size_t)1024 * 256 * 2;
constexpr size_t WS_WOUT1 = WS_WIN1  + (size_t)LD1 * 1024 * 2;
constexpr size_t WS_WG1   = WS_WOUT1 + (size_t)1024 * 1024 * 2;
constexpr size_t WS_WP1   = WS_WG1   + (size_t)1024 * 1024 * 2;
constexpr size_t WS_WC1K  = WS_WP1   + (size_t)1024 * 256 * 2;
constexpr size_t WS_WC1V  = WS_WC1K  + (size_t)256 * 2048 * 2;
constexpr size_t WS_WVT   = WS_WC1V  + (size_t)256 * 2048 * 2;
constexpr size_t WS_BFA   = WS_WVT   + (size_t)512 * 1024 * 2;
constexpr size_t WS_BFB   = WS_BFA   + (size_t)MT * 1024 * 2;
constexpr size_t WS_PBF   = WS_BFB   + (size_t)MT * 1024 * 2;
constexpr size_t WS_U     = WS_PBF   + (size_t)2 * MT * 256 * 2;
constexpr size_t WS_X     = WS_U     + (size_t)MT * LD1 * 2;
constexpr size_t WS_AK    = WS_X;
constexpr size_t WS_AV    = WS_AK    + (size_t)4096 * 2048 * 2;
constexpr size_t WS_HK    = WS_AV    + (size_t)4096 * 2048 * 2;
constexpr size_t WS_HV    = WS_HK    + (size_t)4096 * 256 * 2;
constexpr size_t WS_LRUA  = WS_X;
constexpr size_t WS_LRUH  = WS_LRUA  + (size_t)MT * 512 * 2;
constexpr size_t WS_S     = WS_X     + (size_t)64 * 1024 * 1024;
constexpr size_t WS_KCMP  = WS_S;
constexpr size_t WS_VCMP  = WS_KCMP  + (size_t)16 * 256 * 64 * 4;
constexpr size_t WS_AEND  = WS_VCMP  + (size_t)16 * 256 * 64 * 4;
constexpr size_t WS_HEND  = WS_AEND  + (size_t)8 * 64 * 512 * 4;
constexpr size_t WS_HIN   = WS_HEND  + (size_t)8 * 64 * 512 * 4;
constexpr size_t WS_ZLOC  = WS_HIN   + (size_t)8 * 64 * 512 * 4;
constexpr size_t WS_NIN   = WS_ZLOC  + (size_t)2048 * 128 * 4;
constexpr size_t WS_SCAL  = WS_NIN   + (size_t)2048 * 128 * 4;
constexpr size_t WS_VCT   = WS_SCAL  + (size_t)3 * 2048 * 4;
constexpr size_t WS_WAT   = WS_VCT   + (size_t)16 * 64 * 256 * 2;
constexpr size_t WS_WXT   = WS_WAT   + (size_t)8 * 64 * 64 * 2;
constexpr size_t WS_END   = WS_WXT   + (size_t)8 * 64 * 64 * 2;
constexpr size_t WS_VT    = WS_U     + (size_t)MT * LD0 * 2;
static_assert(WS_VT + (size_t)512 * MT * 2 <= WS_X, "VT region");
static_assert(WS_HV + (size_t)4096 * 256 * 2 <= WS_S, "compress region");
static_assert(WS_LRUH + (size_t)MT * 512 * 2 <= WS_S, "lru region");

constexpr int XCD_BAR_WORDS_C = 3456;
constexpr int CW_QNSA = 3520, CW_QDSA = 3584;

constexpr int LDS_BYTES = 147456;
constexpr int LDS_CTL_OFF = 0;
constexpr int LDS_WORK_OFF = 128;

DI float bf2f(bf16_t v) { return __uint_as_float(((unsigned)v) << 16); }
DI bf16_t f2bf(float f) { unsigned u = __float_as_uint(f); u += 0x7FFFu + ((u >> 16) & 1u); return (bf16_t)(u >> 16); }
typedef __bf16 bf16v2 __attribute__((ext_vector_type(2)));
typedef float f32x2 __attribute__((ext_vector_type(2)));
DI unsigned pack2(float lo, float hi) { const f32x2 v = {lo, hi}; return __builtin_bit_cast(unsigned, __builtin_convertvector(v, bf16v2)); }
DI float fexp_(float x) { return __builtin_amdgcn_exp2f(x * 1.4426950408889634f); }
DI float sigmoidf_(float x) { return __builtin_amdgcn_rcpf(1.0f + fexp_(-x)); }
DI float siluf_(float x) { return x * __builtin_amdgcn_rcpf(1.0f + fexp_(-x)); }
DI float wave_max(float v) { for (int o = 32; o >= 1; o >>= 1) v = fmaxf(v, __shfl_xor(v, o)); return v; }
DI float wave_sum(float v) { for (int o = 32; o >= 1; o >>= 1) v += __shfl_xor(v, o); return v; }
DI void unpack8(const uint4& v, float (&f)[8]) {
    f[0] = __uint_as_float(v.x << 16); f[1] = __uint_as_float(v.x & 0xFFFF0000u);
    f[2] = __uint_as_float(v.y << 16); f[3] = __uint_as_float(v.y & 0xFFFF0000u);
    f[4] = __uint_as_float(v.z << 16); f[5] = __uint_as_float(v.z & 0xFFFF0000u);
    f[6] = __uint_as_float(v.w << 16); f[7] = __uint_as_float(v.w & 0xFFFF0000u);
}

#define XB_TMO      128
#define XB_XCNT(j)  (256  + 64 * (j))
#define XB_XSUB(j)  (1280 + 64 * (j))
#define XB_XGEN(j)  (2304 + 64 * (j))
#define XB_TOP      3328
#define XB_TOPGEN   3392
#define XCD_BAR_WORDS 3456
#define XB_SPIN_CAP (1u << 22)
static_assert(XCD_BAR_WORDS == XCD_BAR_WORDS_C, "bar words");

__device__ __forceinline__ unsigned xb_ld(unsigned* p)              { return __hip_atomic_load(p, __ATOMIC_RELAXED, __HIP_MEMORY_SCOPE_AGENT); }
__device__ __forceinline__ unsigned xb_add(unsigned* p, unsigned v) { return __hip_atomic_fetch_add(p, v, __ATOMIC_RELAXED, __HIP_MEMORY_SCOPE_AGENT); }
__device__ __forceinline__ unsigned xb_xcc_id() { return (unsigned)__builtin_amdgcn_s_getreg((3 << 11) | 20) & 0xFu; }
#define XB_SPIN(cond, bar) do { unsigned _sp = 0; while (cond) { __builtin_amdgcn_s_sleep(1); \
    if ((++_sp & 255u) == 0u) { if (xb_ld(&(bar)[XB_TMO])) break; if (_sp > XB_SPIN_CAP) { atomicAdd(&(bar)[XB_TMO], 1u); break; } } } } while (0)

struct XcdBarrier { unsigned* bar; unsigned x; volatile LAS unsigned* st; };

__device__ __forceinline__ XcdBarrier xcd_barrier_post(unsigned* bar, volatile LAS unsigned* st) {
    XcdBarrier b; b.bar = bar; b.x = xb_xcc_id(); b.st = st;
    if (threadIdx.x == 0) (void)xb_add(&bar[XB_XCNT(b.x)], 1u);
    return b;
}
__device__ __forceinline__ void xcd_barrier_complete(unsigned* bar, unsigned x, unsigned& nloc, unsigned& nx) {
    const unsigned G = gridDim.x * gridDim.y * gridDim.z;
    unsigned sum, cnt, mine, sp = 0u;
    for (;;) {
        sum = 0u; cnt = 0u; mine = 0u;
#pragma unroll
        for (unsigned j = 0; j < 16; ++j) { const unsigned c = xb_ld(&bar[XB_XCNT(j)]); sum += c; cnt += (c > 0u) ? 1u : 0u; mine = (j == x) ? c : mine; }
        if (sum == G) break;
        __builtin_amdgcn_s_sleep(1);
        if ((++sp & 255u) == 0u) { if (xb_ld(&bar[XB_TMO])) break; if (sp > XB_SPIN_CAP) { atomicAdd(&bar[XB_TMO], 1u); break; } }
    }
    nloc = mine > 0u ? mine : 1u; nx = cnt > 0u ? cnt : 1u;
}
__device__ __forceinline__ void xcd_barrier(const XcdBarrier& b) {
    asm volatile("s_waitcnt vmcnt(0)" ::: "memory");
    __syncthreads();
    if (threadIdx.x == 0) {
        unsigned* bar = b.bar;
        __builtin_amdgcn_s_waitcnt(0);
        unsigned nloc = b.st[0], nx = b.st[1];
        if (nloc == 0u) { xcd_barrier_complete(bar, b.x, nloc, nx); b.st[0] = nloc; b.st[1] = nx; }
        const unsigned old = xb_add(&bar[XB_XSUB(b.x)], 1u);
        const unsigned gen = old / nloc;
        if (old + 1u == (gen + 1u) * nloc) {
            __builtin_amdgcn_fence(__ATOMIC_RELEASE, "agent");
            asm volatile("s_waitcnt vmcnt(0)" ::: "memory");
            const unsigned og = xb_add(&bar[XB_TOP], 1u);
            const unsigned tg = og / nx;
            if (og + 1u == (tg + 1u) * nx) xb_add(&bar[XB_TOPGEN], 1u);
            else XB_SPIN(xb_ld(&bar[XB_TOPGEN]) == tg, bar);
            __builtin_amdgcn_fence(__ATOMIC_ACQUIRE, "agent");
            xb_add(&bar[XB_XGEN(b.x)], 1u);
            asm volatile("s_waitcnt vmcnt(0)" ::: "memory");
        } else {
            XB_SPIN(xb_ld(&bar[XB_XGEN(b.x)]) == gen, bar);
            __builtin_amdgcn_fence(__ATOMIC_ACQUIRE, "agent");
            asm volatile("s_waitcnt vmcnt(0)" ::: "memory");
        }
    }
    __syncthreads();
}

namespace pg8 {
constexpr int BM = 256, BK = 64, HALF = 128, HTB = HALF * BK * 2, STAGE_BYTES = 8 * HTB, NXCD = 8, WGM = 8;
__host__ __device__ __forceinline__ int lds_byte(int r, int c) { const int st = (r >> 4) * 2 + (c >> 5), rr = r & 15, cc = c & 31, ob = rr * 64 + cc * 2; return st * 1024 + (ob ^ (((ob >> 9) & 1) << 5)); }
__host__ __device__ __forceinline__ void stage_rc(int b, int& R, int& C) { const int st = b / 1024, sb = b % 1024, swz = sb ^ (((sb >> 9) & 1) << 5); R = (st >> 1) * 16 + swz / 64; C = (st & 1) * 32 + (swz % 64) / 2; }
__host__ __device__ __forceinline__ int perm32(int rho) { const int n = rho >> 4, i = rho & 15; return 8 * (i >> 2) + 4 * n + (i & 3); }
struct Unit { int pm, pn; };
struct Gemm { const bf16_t* A; const bf16_t* Bt; int M, N, K; };
struct StaticOrder {
    int nM, nN, nwg, G, c;
    __host__ __device__ __forceinline__ void init(int M, int N, int G_, int c_) { nM = M / BM; nN = N / BM; nwg = nM * nN; G = G_; c = c_; }
    __host__ __device__ __forceinline__ bool next(int i, Unit& u) const {
        const long L = (long)i * G + c; if (L >= nwg) return false;
        int wgid = (int)L; { const int q = nwg / NXCD, r = nwg % NXCD, xcd = wgid % NXCD, off = wgid / NXCD; wgid = (xcd < r ? xcd * (q + 1) : r * (q + 1) + (xcd - r) * q) + off; }
        const int nig = WGM * nN, gid = wgid / nig, fm = gid * WGM, gsz = (nM - fm) < WGM ? (nM - fm) : WGM;
        u.pm = fm + ((wgid % nig) % gsz); u.pn = (wgid % nig) / gsz; return true;
    }
    __device__ __forceinline__ void a_ready(const Unit&) const {}
    __device__ __forceinline__ void done(const Unit&) const {}
};
template <class Epi, class Sched>
__device__ __forceinline__ void gemm_phase(LAS unsigned char* lds, const Gemm g, const Sched& S, const Epi& E) {
    int tid_ = threadIdx.x; asm volatile("" : "+v"(tid_));
    const int tid = tid_, wid = __builtin_amdgcn_readfirstlane(tid >> 6), lane = tid & 63, wr = wid >> 2, wc = wid & 3, fr = lane & 15, fq = lane >> 4;
    const int K = g.K, nt = K / BK;
    unsigned voffA[2], voffB[2];
#pragma unroll
    for (int i = 0; i < 2; ++i) { int R, C; stage_rc(tid * 16 + i * 8192, R, C); const int Rb = Epi::PERM ? ((R & ~31) + perm32(R & 31)) : R;
        voffA[i] = (unsigned)(R * K + C) * 2u; voffB[i] = (unsigned)(Rb * K + C) * 2u; }
    const size_t kstep = (size_t)(BK * 2);
    const size_t hstep = (size_t)HALF * K * 2;
    const size_t tstep = 2 * hstep;
    const unsigned ldsw = (unsigned)wid * 1024u;
    const int aoff = lds_byte(wr * 64 + fr, fq * 8), boff = lds_byte(wc * 32 + fr, fq * 8);
#define PG8_SA(b, h) (((b) * 2 + (h)) * HTB)
#define PG8_SB(b, h) ((4 + (b) * 2 + (h)) * HTB)
#define PG8_STAGE(bufoff, gbase, voff) do { _Pragma("unroll") for (int _i = 0; _i < 2; ++_i) \
        __builtin_amdgcn_global_load_lds((const unsigned*)((const char*)(gbase) + (voff)[_i]), (LAS unsigned*)(lds + (bufoff) + ldsw + _i * 8192), 16, 0, 0); } while (0)
#define PG8_LDA(dst, b, h) do { _Pragma("unroll") for (int m = 0; m < 4; ++m) _Pragma("unroll") for (int k = 0; k < 2; ++k) dst[m][k] = *(const LAS bf16x8*)(lds + PG8_SA(b, h) + aoff + m * 2048 + k * 1024); } while (0)
#define PG8_LDB(dst, b, h) do { _Pragma("unroll") for (int n = 0; n < 2; ++n) _Pragma("unroll") for (int k = 0; k < 2; ++k) dst[n][k] = *(const LAS bf16x8*)(lds + PG8_SB(b, h) + boff + n * 2048 + k * 1024); } while (0)
#define PG8_MMA(ai, bj, At, Bt) do { __builtin_amdgcn_s_setprio(1); _Pragma("unroll") for (int m = 0; m < 4; ++m) _Pragma("unroll") for (int n = 0; n < 2; ++n) _Pragma("unroll") for (int k = 0; k < 2; ++k) \
        acc[ai][bj][m][n] = __builtin_amdgcn_mfma_f32_16x16x32_bf16(Bt[n][k], At[m][k], acc[ai][bj][m][n], 0, 0, 0); __builtin_amdgcn_s_setprio(0); } while (0)
#define PG8_WAIT_V(n) asm volatile("s_waitcnt vmcnt(" #n ")" ::: "memory")
#define PG8_WAIT_L(n) asm volatile("s_waitcnt lgkmcnt(" #n ")" ::: "memory")
#define PG8_BAR __builtin_amdgcn_s_barrier()
#define PG8_SCHED __builtin_amdgcn_sched_barrier(0)
    Unit cur, nxt; int ui = 0;
    if (!S.next(0, cur)) return;
    f32x4 acc[2][2][4][2];
#pragma unroll
    for (int a = 0; a < 2; ++a)
#pragma unroll
        for (int b = 0; b < 2; ++b)
#pragma unroll
            for (int m = 0; m < 4; ++m)
#pragma unroll
                for (int n = 0; n < 2; ++n) acc[a][b][m][n] = (f32x4){0.f, 0.f, 0.f, 0.f};
    bf16x8 At[4][2], B0[2][2], B1[2][2];
    const char* cA = (const char*)g.A + (size_t)cur.pm * tstep; const char* cB = (const char*)g.Bt + (size_t)cur.pn * tstep;
    S.a_ready(cur);
    PG8_STAGE(PG8_SB(0, 0), cB, voffB); PG8_STAGE(PG8_SA(0, 0), cA, voffA); PG8_STAGE(PG8_SB(0, 1), cB + hstep, voffB); PG8_STAGE(PG8_SA(0, 1), cA + hstep, voffA);
    if (wr == 1) PG8_BAR;
    PG8_WAIT_V(4); PG8_BAR;
    PG8_STAGE(PG8_SB(1, 0), cB + kstep, voffB); PG8_STAGE(PG8_SA(1, 0), cA + kstep, voffA); PG8_STAGE(PG8_SB(1, 1), cB + hstep + kstep, voffB);
    PG8_WAIT_V(6); PG8_BAR;
    for (;;) {
        const bool has_next = S.next(ui + 1, nxt);
        const char* nA = has_next ? (const char*)g.A + (size_t)nxt.pm * tstep : cA; const char* nB = has_next ? (const char*)g.Bt + (size_t)nxt.pn * tstep : cB;
        for (int t = 0; t < nt; t += 2) {
            const bool last = (t == nt - 2);
            const char* a1 = cA + (size_t)(t + 1) * kstep;
            const char* a2 = last ? nA : cA + (size_t)(t + 2) * kstep; const char* b2 = last ? nB : cB + (size_t)(t + 2) * kstep;
            const char* a3 = a2 + kstep; const char* b3 = b2 + kstep;
            if (last && has_next) S.a_ready(nxt);
            PG8_LDB(B0, 0, 0); PG8_SCHED; PG8_LDA(At, 0, 0); PG8_STAGE(PG8_SA(1, 1), a1 + hstep, voffA);
            PG8_WAIT_L(8); PG8_BAR; PG8_WAIT_L(0); PG8_MMA(0, 0, At, B0); PG8_BAR; PG8_SCHED;
            PG8_LDB(B1, 0, 1); PG8_STAGE(PG8_SB(0, 0), b2, voffB);
            PG8_BAR; PG8_WAIT_L(0); PG8_MMA(0, 1, At, B1); PG8_BAR;
            PG8_LDA(At, 0, 1); PG8_STAGE(PG8_SA(0, 0), a2, voffA);
            PG8_BAR; PG8_WAIT_L(0); PG8_MMA(1, 0, At, B0); PG8_BAR; PG8_SCHED;
            PG8_STAGE(PG8_SB(0, 1), b2 + hstep, voffB);
            PG8_WAIT_V(6); PG8_BAR; PG8_MMA(1, 1, At, B1); PG8_BAR;
            PG8_LDB(B0, 1, 0); PG8_SCHED; PG8_LDA(At, 1, 0); PG8_STAGE(PG8_SA(0, 1), a2 + hstep, voffA);
            PG8_WAIT_L(8); PG8_BAR; PG8_WAIT_L(0); PG8_MMA(0, 0, At, B0); PG8_BAR; PG8_SCHED;
            PG8_LDB(B1, 1, 1); PG8_STAGE(PG8_SB(1, 0), b3, voffB);
            PG8_BAR; PG8_WAIT_L(0); PG8_MMA(0, 1, At, B1); PG8_BAR;
            PG8_LDA(At, 1, 1); PG8_STAGE(PG8_SA(1, 0), a3, voffA);
            PG8_BAR; PG8_WAIT_L(0); PG8_MMA(1, 0, At, B0); PG8_BAR; PG8_SCHED;
            PG8_STAGE(PG8_SB(1, 1), b3 + hstep, voffB);
            PG8_WAIT_V(6); PG8_BAR; PG8_MMA(1, 1, At, B1); PG8_BAR;
        }
        E(acc, cur, wr, wc, fr, fq); S.done(cur);
        if (!has_next) break;
#pragma unroll
        for (int a = 0; a < 2; ++a)
#pragma unroll
            for (int b = 0; b < 2; ++b)
#pragma unroll
                for (int m = 0; m < 4; ++m)
#pragma unroll
                    for (int n = 0; n < 2; ++n) acc[a][b][m][n] = (f32x4){0.f, 0.f, 0.f, 0.f};
        cur = nxt; cA = nA; cB = nB; ++ui;
    }
    PG8_WAIT_V(0);
    if (wr == 0) PG8_BAR;
    PG8_BAR;
#undef PG8_SA
#undef PG8_SB
#undef PG8_STAGE
#undef PG8_LDA
#undef PG8_LDB
#undef PG8_MMA
#undef PG8_WAIT_V
#undef PG8_WAIT_L
#undef PG8_BAR
#undef PG8_SCHED
}

template <int ACT  > struct EpiBf16 {
    static constexpr bool PERM = true;
    bf16_t* O; int ldc;
    __device__ __forceinline__ void operator()(const f32x4 (&acc)[2][2][4][2], const Unit& u, int wr, int wc, int fr, int fq) const {
        const int row0 = u.pm * BM + wr * 64 + fr, col0 = u.pn * BM + wc * 32 + 8 * fq;
#pragma unroll
        for (int ai = 0; ai < 2; ++ai)
#pragma unroll
            for (int m = 0; m < 4; ++m) { bf16_t* rowp = O + (size_t)(row0 + ai * HALF + m * 16) * ldc + col0;
#pragma unroll
                for (int bj = 0; bj < 2; ++bj) { f32x4 v0 = acc[ai][bj][m][0], v1 = acc[ai][bj][m][1];
                    if (ACT == 1) { for (int i = 0; i < 4; ++i) { v0[i] = siluf_(v0[i]); v1[i] = siluf_(v1[i]); } }
                    uint4 o; o.x = pack2(v0[0], v0[1]); o.y = pack2(v0[2], v0[3]); o.z = pack2(v1[0], v1[1]); o.w = pack2(v1[2], v1[3]);
                    *(uint4*)(rowp + bj * HALF) = o; } }
    }
};
struct EpiF32 {
    static constexpr bool PERM = false;
    float* C; int ldc;
    __device__ __forceinline__ void operator()(const f32x4 (&acc)[2][2][4][2], const Unit& u, int wr, int wc, int fr, int fq) const {
        const int row0 = u.pm * BM + wr * 64 + fr, col0 = u.pn * BM + wc * 32 + 4 * fq;
#pragma unroll
        for (int ai = 0; ai < 2; ++ai)
#pragma unroll
            for (int m = 0; m < 4; ++m) { float* rowp = C + (size_t)(row0 + ai * HALF + m * 16) * ldc + col0;
#pragma unroll
                for (int bj = 0; bj < 2; ++bj)
#pragma unroll
                    for (int n = 0; n < 2; ++n) *(f32x4*)(rowp + bj * HALF + n * 16) = acc[ai][bj][m][n]; }
    }
};
struct EpiResid {
    static constexpr bool PERM = true;
    const float* Xi; bf16_t* Ob;
    __device__ __forceinline__ void operator()(const f32x4 (&acc)[2][2][4][2], const Unit& u, int wr, int wc, int fr, int fq) const {
        const int row0 = u.pm * BM + wr * 64 + fr, col0 = u.pn * BM + wc * 32 + 8 * fq;
#pragma unroll
        for (int ai = 0; ai < 2; ++ai)
#pragma unroll
            for (int m = 0; m < 4; ++m) { const size_t ro = (size_t)(row0 + ai * HALF + m * 16) * 1024 + col0;
#pragma unroll
                for (int bj = 0; bj < 2; ++bj) { const size_t o = ro + bj * HALF;
                    const f32x4 x0 = *(const f32x4*)(Xi + o), x1 = *(const f32x4*)(Xi + o + 4);
                    const f32x4 v0 = x0 + acc[ai][bj][m][0], v1 = x1 + acc[ai][bj][m][1];
                    uint4 pk; pk.x = pack2(v0[0], v0[1]); pk.y = pack2(v0[2], v0[3]); pk.z = pack2(v1[0], v1[1]); pk.w = pack2(v1[2], v1[3]); *(uint4*)(Ob + o) = pk; } }
    }
};
struct EpiGate {
    static constexpr bool PERM = true;
    float* X; const bf16_t* R; const bf16_t* E;
    __device__ __forceinline__ void operator()(const f32x4 (&acc)[2][2][4][2], const Unit& u, int wr, int wc, int fr, int fq) const {
        const int row0 = u.pm * BM + wr * 64 + fr, col0 = u.pn * BM + wc * 32 + 8 * fq;
#pragma unroll
        for (int ai = 0; ai < 2; ++ai)
#pragma unroll
            for (int m = 0; m < 4; ++m) { const size_t ro = (size_t)(row0 + ai * HALF + m * 16) * 1024 + col0;
#pragma unroll
                for (int bj = 0; bj < 2; ++bj) { const size_t o = ro + bj * HALF;
                    const uint4 ev = *(const uint4*)(E + o), rv = *(const uint4*)(R + o); float ef[8], rf[8]; unpack8(ev, ef); unpack8(rv, rf);
#pragma unroll
                    for (int n = 0; n < 2; ++n) { f32x4 v;
#pragma unroll
                        for (int i = 0; i < 4; ++i) v[i] = rf[4 * n + i] + ef[4 * n + i] * sigmoidf_(acc[ai][bj][m][n][i]);
                        *(f32x4*)(X + o + 4 * n) = v; } } }
    }
};
}

struct Args { const float* in[28]; float* out; unsigned char* ws; int ph_lo, ph_hi; };

struct Frame {
    int tid, lane, wave, G, bid, gw, nw;
    unsigned char* lds;
    unsigned* ctl;
    const float* in[28]; float* out; unsigned char* ws;
    const LAS unsigned char* lut;
    const LAS float* tbl;
    const LAS float* biasL;
    LAS unsigned char* ldsl;
};
DI int t5b(const Frame& F, int n) { return n < 16 ? n : (n >= 113 ? 31 : (int)F.lut[n]); }

DI bool phase_refresh(Frame& F) { int t_ = threadIdx.x; asm volatile("" : "+v"(t_)); F.tid = t_; F.lane = t_ & 63; return true; }
struct TDesc { const float* src; bf16_t* dst; int K, Nsrc, Npad, mapk, ntiles; };
DI int tmap(int kind, int n) { return kind == 0 ? n : (kind == 1 ? map0(n) : (kind == 2 ? map1(n) : mapv(n))); }
DI void transpose_all(const Frame& F) {
    unsigned char* ws = F.ws;
    float* tile = (float*)F.lds;
    TDesc D[11];
    D[0] = TDesc{F.in[7], (bf16_t*)(ws + WS_WIN0), 1024, 3292, LD0, 1, 0};
    D[1] = TDesc{F.in[7], (bf16_t*)(ws + WS_WVT), 1024, 3292, 512, 3, 0};
    D[2] = TDesc{F.in[8], (bf16_t*)(ws + WS_WOUT0), 1024, 1024, 1024, 0, 0};
    D[3] = TDesc{F.in[5], (bf16_t*)(ws + WS_WG0), 1024, 1024, 1024, 0, 0};
    D[4] = TDesc{F.in[5] + (size_t)1024 * 1024, (bf16_t*)(ws + WS_WG1), 1024, 1024, 1024, 0, 0};
    D[5] = TDesc{F.in[4], (bf16_t*)(ws + WS_WP0), 256, 1024, 1024, 0, 0};
    D[6] = TDesc{F.in[4] + (size_t)256 * 1024, (bf16_t*)(ws + WS_WP1), 256, 1024, 1024, 0, 0};
    D[7] = TDesc{F.in[15], (bf16_t*)(ws + WS_WIN1), 1024, 3592, LD1, 2, 0};
    D[8] = TDesc{F.in[16], (bf16_t*)(ws + WS_WOUT1), 1024, 1024, 1024, 0, 0};
    D[9] = TDesc{F.in[10], (bf16_t*)(ws + WS_WC1K), 2048, 256, 256, 0, 0};
    D[10] = TDesc{F.in[13], (bf16_t*)(ws + WS_WC1V), 2048, 256, 256, 0, 0};
    int total = 0;
#pragma unroll
    for (int i = 0; i < 11; ++i) { D[i].ntiles = (D[i].Npad / 64) * (D[i].K / 64); total += D[i].ntiles; }
    float rg[8];
    auto locate = [&](int tix, TDesc& d, int& nt, int& kt) { int rem = tix;
#pragma unroll
        for (int i = 0; i < 11; ++i) { if (rem >= 0 && rem < D[i].ntiles) { d = D[i]; const int ntk = d.K / 64; nt = rem / ntk; kt = rem % ntk; rem = -1; } else if (rem >= 0) rem -= D[i].ntiles; } };
    auto load = [&](int tix) { TDesc d; int nt = 0, kt = 0; locate(tix, d, nt, kt);
#pragma unroll
        for (int q = 0; q < 8; ++q) { const int e = F.tid + q * 512; const int kk = e >> 6, nn = e & 63; const int col = tmap(d.mapk, nt * 64 + nn);
            rg[q] = col >= 0 ? d.src[(size_t)(kt * 64 + kk) * d.Nsrc + col] : 0.f; } };
    int tix = F.bid; int buf = 0;
    if (tix < total) load(tix);
    for (; tix < total; tix += F.G) {
        float* tl = tile + buf * (64 * 65);
#pragma unroll
        for (int q = 0; q < 8; ++q) { const int e = F.tid + q * 512; tl[(e >> 6) * 65 + (e & 63)] = rg[q]; }
        __syncthreads();
        TDesc d; int nt = 0, kt = 0; locate(tix, d, nt, kt);
        if (tix + F.G < total) load(tix + F.G);
#pragma unroll
        for (int q = 0; q < 8; ++q) { const int e = F.tid + q * 512; const int nn = e >> 6, kk = e & 63;
            d.dst[(size_t)(nt * 64 + nn) * d.K + kt * 64 + kk] = f2bf(tl[kk * 65 + nn]); }
        buf ^= 1;
    }
    __syncthreads();
}
template <int OUTF>
DI void rmsnorm_rows(const Frame& F, const float* X, const float* g, bf16_t* Ob, float* Of) {
    for (int row = F.gw; row < MT; row += F.nw) {
        const float* xr = X + (size_t)row * 1024;
        f32x4 v[4]; float ss = 0.f;
#pragma unroll
        for (int i = 0; i < 4; ++i) { v[i] = *(const f32x4*)(xr + i * 256 + F.lane * 4); ss += v[i][0] * v[i][0] + v[i][1] * v[i][1] + v[i][2] * v[i][2] + v[i][3] * v[i][3]; }
        ss = wave_sum(ss);
        const float rs = rsqrtf(ss * (1.0f / 1024.0f) + 1e-6f);
#pragma unroll
        for (int i = 0; i < 4; ++i) { const f32x4 gg = *(const f32x4*)(g + i * 256 + F.lane * 4); f32x4 y;
            for (int j = 0; j < 4; ++j) y[j] = v[i][j] * rs * gg[j];
            if (OUTF) *(f32x4*)(Of + (size_t)row * 1024 + i * 256 + F.lane * 4) = y;
            else { uint2 pk; pk.x = pack2(y[0], y[1]); pk.y = pack2(y[2], y[3]); *(uint2*)(Ob + (size_t)row * 1024 + i * 256 + F.lane * 4) = pk; } }
    }
}
DI void p0_prologue(const Frame& F) {
    unsigned char* ws = F.ws;
    transpose_all(F);
    { bf16_t* wat = (bf16_t*)(ws + WS_WAT); bf16_t* wxt = (bf16_t*)(ws + WS_WXT);
      for (int idx = F.bid * 512 + F.tid; idx < 8 * 64 * 64; idx += F.G * 512) { const int g = idx >> 12, j = (idx >> 6) & 63, i = idx & 63;
          wat[idx] = f2bf(F.in[19][(size_t)(g * 64 + i) * 64 + j]); wxt[idx] = f2bf(F.in[21][(size_t)(g * 64 + i) * 64 + j]); } }
    rmsnorm_rows<0>(F, F.in[0], F.in[2], (bf16_t*)(ws + WS_BFA), nullptr);
    { const float* p = F.in[1]; bf16_t* pb = (bf16_t*)(ws + WS_PBF); const size_t n8 = (size_t)2 * MT * 256 / 8;
      for (size_t i = (size_t)F.bid * 512 + F.tid; i < n8; i += (size_t)F.G * 512) {
          const f32x4 a = *(const f32x4*)(p + i * 8), b = *(const f32x4*)(p + i * 8 + 4);
          uint4 o; o.x = pack2(a[0], a[1]); o.y = pack2(a[2], a[3]); o.z = pack2(b[0], b[1]); o.w = pack2(b[2], b[3]); *(uint4*)(pb + i * 8) = o; } }
}

DI void p2a_build_blocks(const Frame& F) {
    { const int gt = F.bid * 512 + F.tid;
      if (gt < 1024) { const int bg = gt >> 6, d = gt & 63; ((float*)(F.ws + WS_KCMP))[((size_t)bg * 256 + 255) * 64 + d] = 0.f; ((float*)(F.ws + WS_VCMP))[((size_t)bg * 256 + 255) * 64 + d] = 0.f;
          ((bf16_t*)(F.ws + WS_VCT))[((size_t)bg * 64 + d) * 256 + 255] = 0; } }
    const bf16_t* U = (const bf16_t*)(F.ws + WS_U);
    bf16_t* AK = (bf16_t*)(F.ws + WS_AK); bf16_t* AV = (bf16_t*)(F.ws + WS_AV);
    const float* posk = F.in[9]; const float* posv = F.in[12];
    const size_t nitem = (size_t)2 * 4096 * 32 * 8;
    for (size_t it = (size_t)F.bid * 512 + F.tid; it < nitem; it += (size_t)F.G * 512) {
        const int c8 = (int)(it & 7), l = (int)((it >> 3) & 31), r = (int)((it >> 8) & 4095), which = (int)(it >> 20);
        bf16_t* dst = (which ? AV : AK) + (size_t)r * 2048 + l * 64 + c8 * 8;
        uint4 o = make_uint4(0u, 0u, 0u, 0u);
        if (r < 4080) {
            const int b = r / 510, rem = r % 510, i = rem >> 1, g = rem & 1;
            const bf16_t* sp = U + ((size_t)b * SEQ + 16 * i + l) * LD0 + (which ? C_VC : C_KC) + g * 64 + c8 * 8;
            const float* pp = (which ? posv : posk) + l * 64 + c8 * 8;
            const uint4 v = *(const uint4*)sp; float f[8]; unpack8(v, f);
            o.x = pack2(f[0] + pp[0], f[1] + pp[1]); o.y = pack2(f[2] + pp[2], f[3] + pp[3]); o.z = pack2(f[4] + pp[4], f[5] + pp[5]); o.w = pack2(f[6] + pp[6], f[7] + pp[7]);
        }
        *(uint4*)dst = o;
    }
}
DI void p2c_compress_rows(const Frame& F, int which, int row0) {
    const bf16_t* H = (const bf16_t*)(F.ws + (which ? WS_HV : WS_HK));
    float* OUT = (float*)(F.ws + (which ? WS_VCMP : WS_KCMP));
    const float* w2 = which ? F.in[14] : F.in[11];
    for (int rr = F.wave; rr < 256; rr += 8) {
        const int r = row0 + rr; if (r >= 4080) break;
        const int b = r / 510, rem = r % 510, i = rem >> 1, g = rem & 1, bg = b * 2 + g;
        const bf16_t* hr = H + (size_t)r * 256; float acc = 0.f;
        for (int j = 0; j < 256; j += 8) { const uint4 hv = *(const uint4*)(hr + j); float hf[8]; unpack8(hv, hf);
#pragma unroll
            for (int q = 0; q < 8; ++q) acc += hf[q] * w2[(size_t)(j + q) * 64 + F.lane]; }
        OUT[((size_t)bg * 256 + i) * 64 + F.lane] = acc;
        if (which) ((bf16_t*)(F.ws + WS_VCT))[((size_t)bg * 64 + F.lane) * 256 + i] = f2bf(acc);
    }
}

template <int NH>
DI void dotn_bf(const bf16_t* kp, const float* qs, float (&acc)[NH]) {
#pragma unroll
    for (int h = 0; h < NH; ++h) acc[h] = 0.f;
#pragma unroll 2
    for (int c = 0; c < 8; ++c) { const uint4 v = *(const uint4*)(kp + c * 8); float kf[8]; unpack8(v, kf);
#pragma unroll
        for (int h = 0; h < NH; ++h) { const f32x4 q0 = *(const f32x4*)(qs + h * 64 + c * 8), q1 = *(const f32x4*)(qs + h * 64 + c * 8 + 4);
            acc[h] += q0[0] * kf[0] + q0[1] * kf[1] + q0[2] * kf[2] + q0[3] * kf[3] + q1[0] * kf[4] + q1[1] * kf[5] + q1[2] * kf[6] + q1[3] * kf[7]; } }
}
DI void dot4_bf(const bf16_t* kp, const float* qs, float (&acc)[4]) { dotn_bf<4>(kp, qs, acc); }
DI void dot4_f32(const float* kp, const float* qs, float (&acc)[4]) {
    acc[0] = acc[1] = acc[2] = acc[3] = 0.f;
#pragma unroll 4
    for (int c = 0; c < 16; ++c) { const f32x4 kv = *(const f32x4*)(kp + c * 4);
#pragma unroll
        for (int h = 0; h < 4; ++h) { const f32x4 q0 = *(const f32x4*)(qs + h * 64 + c * 4);
            acc[h] += q0[0] * kv[0] + q0[1] * kv[1] + q0[2] * kv[2] + q0[3] * kv[3]; } }
}

template <int NH, int HS>
DI void softmax_lds(float* ps, int nr, int lane, float (&inv)[NH]) {
#pragma unroll
    for (int h = 0; h < NH; ++h) {
        float mx = NEG_INF;
#pragma unroll 1
        for (int r = 0; r < nr; ++r) mx = fmaxf(mx, ps[h * HS + r * 64 + lane]);
        mx = wave_max(mx);
        float sm = 0.f;
#pragma unroll 1
        for (int r = 0; r < nr; ++r) { const float sv = ps[h * HS + r * 64 + lane]; const float e = sv > NEG_INF ? expf(sv - mx) : 0.f; ps[h * HS + r * 64 + lane] = e; sm += e; }
        sm = wave_sum(sm);
        inv[h] = sm > 0.f ? 1.0f / sm : 0.f;
    }
}

DI void nsa_task(const Frame& F, int b, int g, int t, float* wl) {
    int lane = F.lane; asm volatile("" : "+v"(lane)); asm volatile("" : "+v"(wl));
    const bf16_t* U = (const bf16_t*)(F.ws + WS_U);
    const float* KC = (const float*)(F.ws + WS_KCMP) + (size_t)(b * 2 + g) * 256 * 64;
    const float* VC = (const float*)(F.ws + WS_VCMP) + (size_t)(b * 2 + g) * 256 * 64;
    bf16_t* Y = (bf16_t*)(F.ws + WS_BFB);
    const size_t row = (size_t)b * SEQ + t;
    const bf16_t* Ur = U + row * LD0;
    float* qs = wl; float* ps = wl + 256;
    const LAS float* tb = F.tbl + (g * 4) * 32;
    __builtin_amdgcn_wave_barrier();
#pragma unroll
    for (int h = 0; h < 4; ++h) qs[h * 64 + lane] = bf2f(Ur[C_AQ + (g * 4 + h) * 64 + lane]);
    __builtin_amdgcn_wave_barrier();
    float oc[4] = {0.f, 0.f, 0.f, 0.f}, os[4] = {0.f, 0.f, 0.f, 0.f}, ow[4] = {0.f, 0.f, 0.f, 0.f};
    float inv[4];

    const int nv = t >= 31 ? ((t - 31) >> 4) + 1 : 0;
#pragma unroll 1
    for (int r = 0; r < 4; ++r) {
        const int i = r * 64 + lane; const bool valid = i < nv;
        float sc[4] = {NEG_INF, NEG_INF, NEG_INF, NEG_INF};
        if (r * 64 < nv) {
            float acc[4]; dot4_f32(KC + (size_t)(valid ? i : 0) * 64, qs, acc);
            if (valid) { const int bk = t5b(F, t - (16 * i + 31));
#pragma unroll
                for (int h = 0; h < 4; ++h) sc[h] = acc[h] * 0.125f + tb[h * 32 + bk]; }
        }
#pragma unroll
        for (int h = 0; h < 4; ++h) ps[h * 512 + i] = sc[h];
    }
    __builtin_amdgcn_wave_barrier();
    softmax_lds<4, 512>(ps, 4, lane, inv);
#pragma unroll 1
    for (int r = 0; r < 4; ++r) {
#pragma unroll
        for (int h = 0; h < 4; ++h) ps[h * 512 + r * 64 + lane] *= inv[h];
    }
    __builtin_amdgcn_wave_barrier();
#pragma unroll 8
    for (int i = 0; i < nv; ++i) { const float v = VC[(size_t)i * 64 + lane];
#pragma unroll
        for (int h = 0; h < 4; ++h) oc[h] += ps[h * 512 + i] * v; }
#ifndef NSA_STAGE
#define NSA_STAGE 4
#endif
    if (NSA_STAGE < 2) return;
    const int cur = t >> 6;
    unsigned long long selmask = 0ull; const int npick = (cur + 1) < 8 ? (cur + 1) : 8;
    {
        float imp = 0.f;
        const int i0 = 4 * lane - 1 < 0 ? 0 : 4 * lane - 1, i1 = 4 * lane + 3 > 254 ? 254 : 4 * lane + 3;
#pragma unroll
        for (int h = 0; h < 4; ++h) for (int i = i0; i <= i1; ++i) imp += ps[h * 512 + i];
        const bool adm = lane <= cur; const bool forced = (lane == 0) || (lane == cur) || (lane == cur - 1);
        float score = adm ? imp + (forced ? 1.0e4f : 0.f) : NEG_INF;
#pragma unroll 1
        for (int k = 0; k < npick; ++k) {
            const float mx = wave_max(score);
            const unsigned long long cand = __ballot(score == mx);
            const int j = cand ? __builtin_ctzll(cand) : 0;
            selmask |= 1ull << j;
            if (lane == j) score = NEG_INF;
        }
    }
    __builtin_amdgcn_wave_barrier();
    {
        unsigned long long m = selmask;
#pragma unroll 1
        for (int k = 0; k < npick; ++k) {
            const int j = __builtin_ctzll(m); m &= m - 1;
            const int pos = j * 64 + lane;
            float sc[4] = {NEG_INF, NEG_INF, NEG_INF, NEG_INF};
            float acc[4]; dot4_bf(U + ((size_t)b * SEQ + pos) * LD0 + C_KS + g * 64, qs, acc);
            if (pos <= t) { const int bk = t5b(F, t - pos);
#pragma unroll
                for (int h = 0; h < 4; ++h) sc[h] = acc[h] * 0.125f + tb[h * 32 + bk]; }
#pragma unroll
            for (int h = 0; h < 4; ++h) ps[h * 512 + k * 64 + lane] = sc[h];
        }
        __builtin_amdgcn_wave_barrier();
        softmax_lds<4, 512>(ps, npick, lane, inv);
        __builtin_amdgcn_wave_barrier();
        m = selmask;
#pragma unroll 1
        for (int k = 0; k < npick; ++k) {
            const int j = __builtin_ctzll(m); m &= m - 1;
            const int kend = (j * 64 + 63 <= t) ? 64 : (t - j * 64 + 1);
#pragma unroll 8
            for (int kk = 0; kk < kend; ++kk) {
                const float v = bf2f(U[((size_t)b * SEQ + j * 64 + kk) * LD0 + C_VS + g * 64 + lane]);
#pragma unroll
                for (int h = 0; h < 4; ++h) os[h] += ps[h * 512 + k * 64 + kk] * v; }
        }
#pragma unroll
        for (int h = 0; h < 4; ++h) os[h] *= inv[h];
    }
    __builtin_amdgcn_wave_barrier();
    if (NSA_STAGE < 3) return;
    {
#pragma unroll 1
        for (int r = 0; r < 8; ++r) {
            const int pos = t - 511 + r * 64 + lane;
            float sc[4] = {NEG_INF, NEG_INF, NEG_INF, NEG_INF};
            if (t - 511 + r * 64 + 63 >= 0) {
                float acc[4]; dot4_bf(U + ((size_t)b * SEQ + (pos < 0 ? 0 : pos)) * LD0 + C_KW + g * 64, qs, acc);
                if (pos >= 0) { const int bk = t5b(F, t - pos);
#pragma unroll
                    for (int h = 0; h < 4; ++h) sc[h] = acc[h] * 0.125f + tb[h * 32 + bk]; }
            }
#pragma unroll
            for (int h = 0; h < 4; ++h) ps[h * 512 + r * 64 + lane] = sc[h];
        }
        __builtin_amdgcn_wave_barrier();
        softmax_lds<4, 512>(ps, 8, lane, inv);
        __builtin_amdgcn_wave_barrier();
        const int pi0 = (t >= 511 ? 0 : 511 - t) & ~7;
#pragma unroll 8
        for (int pi = pi0; pi < 512; ++pi) {
            const int pos = t - 511 + pi;
            const float v = bf2f(U[((size_t)b * SEQ + (pos < 0 ? 0 : pos)) * LD0 + C_VW + g * 64 + lane]);
#pragma unroll
            for (int h = 0; h < 4; ++h) ow[h] += ps[h * 512 + pi] * v; }
#pragma unroll
        for (int h = 0; h < 4; ++h) ow[h] *= inv[h];
    }
    if (NSA_STAGE < 4) return;
    const float gsig = sigmoidf_(bf2f(Ur[C_AG + g * 12 + (lane < 12 ? lane : 0)]));
#pragma unroll
    for (int h = 0; h < 4; ++h) {
        const int hh = g * 4 + h;
        const float g0 = __shfl(gsig, h * 3 + 0), g1 = __shfl(gsig, h * 3 + 1), g2 = __shfl(gsig, h * 3 + 2);
        const float oa = g0 * oc[h] + g1 * os[h] + g2 * ow[h];
        const float z = bf2f(Ur[C_AZ + hh * 64 + lane]);
        Y[row * 1024 + hh * 64 + lane] = f2bf(oa * siluf_(z));
    }
    __builtin_amdgcn_wave_barrier();
}

DI unsigned okey(float x) { unsigned u = __float_as_uint(x); if ((u << 1) == 0u) u = 0u; return (u >> 31) ? ~u : (u | 0x80000000u); }

DI void dsa_task(const Frame& F, int b, int t, float* wl, unsigned* keys) {
    int lane = F.lane; asm volatile("" : "+v"(lane)); asm volatile("" : "+v"(wl)); asm volatile("" : "+v"(keys));
    const bf16_t* U = (const bf16_t*)(F.ws + WS_U);
    bf16_t* Y = (bf16_t*)(F.ws + WS_BFB);
    const size_t row = (size_t)b * SEQ + t;
    const bf16_t* Ur = U + row * LD0;
    float* qis = wl; float* qds = wl + 256; int* idx = (int*)(wl + 768); float* pb = (float*)keys;
    const LAS float* tb = F.tbl + 8 * 32;
    __builtin_amdgcn_wave_barrier();
#pragma unroll
    for (int h = 0; h < 4; ++h) qis[h * 64 + lane] = bf2f(Ur[C_BQI + h * 64 + lane]);
#pragma unroll
    for (int h = 0; h < 8; ++h) qds[h * 64 + lane] = bf2f(Ur[C_BQ + h * 64 + lane]);
    float wi[4];
#pragma unroll
    for (int h = 0; h < 4; ++h) wi[h] = bf2f(Ur[C_BWI + h]) * 0.0625f;
    __builtin_amdgcn_wave_barrier();
    const int nk = t + 1, nr = (nk + 63) >> 6;
    int nsel;
    if (nk <= 256) {
#pragma unroll 1
        for (int r = 0; r < nr; ++r) { const int s = r * 64 + lane; if (s < nk) idx[s] = s; }
        nsel = nk;
    } else {
#pragma unroll 1
        for (int r = 0; r < nr; ++r) {
            const int s = r * 64 + lane; unsigned key = 0u;
            float acc[4]; dot4_bf(U + ((size_t)b * SEQ + (s < nk ? s : t)) * LD0 + C_BKI, qis, acc);
            if (s < nk) { const float scv = wi[0] * fmaxf(acc[0], 0.f) + wi[1] * fmaxf(acc[1], 0.f) + wi[2] * fmaxf(acc[2], 0.f) + wi[3] * fmaxf(acc[3], 0.f); key = okey(scv); }
            keys[s] = key;
        }
        __builtin_amdgcn_wave_barrier();
        unsigned tau = 0u;
#pragma unroll 1
        for (int bit = 31; bit >= 0; --bit) {
            const unsigned trial = tau | (1u << bit); int cnt = 0;
#pragma unroll 8
            for (int r = 0; r < nr; ++r) cnt += keys[r * 64 + lane] >= trial ? 1 : 0;
            cnt = (int)wave_sum((float)cnt);
            if (cnt >= 256) tau = trial;
        }
        int cgt = 0;
#pragma unroll 1
        for (int r = 0; r < nr; ++r) cgt += keys[r * 64 + lane] > tau ? 1 : 0;
        cgt = (int)wave_sum((float)cgt);
        const int quota = 256 - cgt;
        int base = 0, taken = 0;
        const unsigned long long ltmask = (1ull << lane) - 1ull;
#pragma unroll 1
        for (int r = 0; r < nr; ++r) {
            const unsigned key = keys[r * 64 + lane];
            const bool eq = key == tau;
            const unsigned long long eqm = __ballot(eq);
            const int erank = __popcll(eqm & ltmask);
            const bool sel = (key > tau) || (eq && (taken + erank < quota));
            const unsigned long long sm = __ballot(sel);
            if (sel) idx[base + __popcll(sm & ltmask)] = r * 64 + lane;
            base += __popcll(sm); taken += __popcll(eqm);
        }
        nsel = 256;
    }
    __builtin_amdgcn_wave_barrier();
    const int nr2 = (nsel + 63) >> 6;
#pragma unroll 1
    for (int r = 0; r < nr2; ++r) {
        const int j = r * 64 + lane; const bool valid = j < nsel; const int s = valid ? idx[j] : 0;
        const bf16_t* kp = U + ((size_t)b * SEQ + s) * LD0 + C_BK;
        float a0[8]; dotn_bf<8>(kp, qds, a0);
        const int bk = t5b(F, valid ? t - s : 0);
#pragma unroll
        for (int h = 0; h < 8; ++h) pb[h * 256 + j] = valid ? a0[h] * 0.125f + tb[h * 32 + bk] : NEG_INF;
    }
    __builtin_amdgcn_wave_barrier();
    float inv[8];
    softmax_lds<8, 256>(pb, nr2, lane, inv);
    __builtin_amdgcn_wave_barrier();
    float ob[8] = {0.f, 0.f, 0.f, 0.f, 0.f, 0.f, 0.f, 0.f};
#pragma unroll 8
    for (int j = 0; j < nsel; ++j) {
        const int s = idx[j];
        const float v = bf2f(U[((size_t)b * SEQ + s) * LD0 + C_BV + lane]);
#pragma unroll
        for (int h = 0; h < 8; ++h) ob[h] += pb[h * 256 + j] * v;
    }
#pragma unroll
    for (int h = 0; h < 8; ++h) {
        const float z = bf2f(Ur[C_BZ + h * 64 + lane]);
        Y[row * 1024 + 512 + h * 64 + lane] = f2bf(ob[h] * inv[h] * siluf_(z));
    }
    __builtin_amdgcn_wave_barrier();
}

#ifndef ATT_NAIVE
#define ATT_NAIVE 0
#endif
#if ATT_NAIVE
DI void p3_attention(const Frame& F) {
    unsigned char* base = F.lds;
    constexpr int DSA_W = 4;
    float* wl_nsa; float* wl_dsa = nullptr; unsigned* keys = nullptr;
    if (F.wave < DSA_W) { unsigned char* R = base + F.wave * 20480; keys = (unsigned*)R; wl_dsa = (float*)(R + 16384); wl_nsa = (float*)R; }
    else wl_nsa = (float*)(base + DSA_W * 20480 + (F.wave - DSA_W) * 9216);
    unsigned* qn = F.ctl + CW_QNSA; unsigned* qd = F.ctl + CW_QDSA;
    const int NDSA = NB * SEQ, NNSA = NB * 2 * SEQ;
#ifndef ATT_MASK
#define ATT_MASK 3
#endif
    if ((ATT_MASK & 1) && F.wave < DSA_W) {
        for (;;) {
            unsigned k = 0; if (F.lane == 0) k = __hip_atomic_fetch_add(qd, 1u, __ATOMIC_RELAXED, __HIP_MEMORY_SCOPE_AGENT);
            k = __builtin_amdgcn_readfirstlane(k);
            if (k >= (unsigned)NDSA) break;
            const int t = SEQ - 1 - (int)(k >> 3), b = (int)(k & 7);
            dsa_task(F, b, t, wl_dsa, keys);
        }
    }
    if (ATT_MASK & 2) for (;;) {
        unsigned k = 0; if (F.lane == 0) k = __hip_atomic_fetch_add(qn, 1u, __ATOMIC_RELAXED, __HIP_MEMORY_SCOPE_AGENT);
        k = __builtin_amdgcn_readfirstlane(k);
        if (k >= (unsigned)NNSA) break;
        const int t = SEQ - 1 - (int)(k >> 4), bg = (int)(k & 15);
        nsa_task(F, bg >> 1, bg & 1, t, wl_nsa);
    }
}

#else
typedef float f32x16 __attribute__((ext_vector_type(16)));
#define MFMA32(a, b, c) __builtin_amdgcn_mfma_f32_32x32x16_bf16((a), (b), (c), 0, 0, 0)
constexpr float LOG2E = 1.4426950408889634f;
constexpr float QK_C1 = 0.125f * LOG2E;
constexpr int AT_BUF = 0;
constexpr int AT_PSUM = 65536;
constexpr int AT_SELM = AT_PSUM + 65536;
constexpr int AT_MISC = AT_SELM + 1024;
constexpr int AT_END = AT_MISC + 64 + 2048;
static_assert(AT_END + LDS_WORK_OFF <= LDS_BYTES - 12288, "attention lds");
enum { FL_NEAR = 1, FL_CAUSAL = 2, FL_WINLO = 4, FL_BITS = 8, FL_LANE = 16 };

struct Att { float m, l; f32x16 o0, o1; };
DI void att_init(Att& a) { a.m = NEG_INF; a.l = 0.f;
#pragma unroll
    for (int i = 0; i < 16; ++i) { a.o0[i] = 0.f; a.o1[i] = 0.f; } }

typedef unsigned u32x4 __attribute__((ext_vector_type(4)));
#define OPAQUE(x) asm volatile("" : "+v"(x))
DI void st_write_K(LAS unsigned char* Kt, int tid, const uint4& rg) {
    OPAQUE(tid);
    const int key = tid >> 3, c = tid & 7;
    const u32x4 v = {rg.x, rg.y, rg.z, rg.w};
    *(LAS u32x4*)(Kt + key * 128 + ((c ^ (key & 7)) << 4)) = v;
}
DI void st_write_VT(LAS unsigned char* Vt, int tid, const uint4& rg) {
    OPAQUE(tid);
    const int d = tid >> 3, m = tid & 7, G = m >> 1, a = m & 1, sw = (d >> 1) & 7;
    typedef unsigned u32x2 __attribute__((ext_vector_type(2)));
    const u32x2 lo = {rg.x, rg.y}, hi = {rg.z, rg.w};
    *(LAS u32x2*)(Vt + d * 128 + (((2 * G) ^ sw) << 4) + 8 * a) = lo;
    *(LAS u32x2*)(Vt + d * 128 + (((2 * G + 1) ^ sw) << 4) + 8 * a) = hi;
}
DI void qk_tile(const LAS unsigned char* Kt, const bf16x8 (&qf)[4], int r, int hf, f32x16& s0, f32x16& s1) {
    OPAQUE(r); OPAQUE(hf);
#pragma unroll
    for (int i = 0; i < 16; ++i) { s0[i] = 0.f; s1[i] = 0.f; }
#pragma unroll
    for (int s = 0; s < 4; ++s) {
        const int c = 2 * s + hf;
        const bf16x8 a0 = *(const LAS bf16x8*)(Kt + r * 128 + ((c ^ (r & 7)) << 4));
        const bf16x8 a1 = *(const LAS bf16x8*)(Kt + (32 + r) * 128 + ((c ^ (r & 7)) << 4));
        s0 = MFMA32(a0, qf[s], s0); s1 = MFMA32(a1, qf[s], s1);
    }
}
template <int FLAGS>
DI void fix_scores(f32x16& s, int posb, int kstep, int tq, const LAS float* bl, float bfar, unsigned mword, bool laneok, int hf) {
    OPAQUE(hf); OPAQUE(tq);
#pragma unroll
    for (int i = 0; i < 16; ++i) {
        const int koff = (i & 3) + 8 * (i >> 2) + 4 * hf;
        const int dist = tq - (posb + kstep * koff);
        float bias = bfar;
        if (FLAGS & FL_NEAR) { int dd = dist < 0 ? 0 : dist; dd = dd > 127 ? 127 : dd; bias = bl[dd]; }
        const float v = s[i] * QK_C1 + bias;
        bool ok = true;
        if (FLAGS & FL_CAUSAL) ok = ok && (dist >= 0);
        if (FLAGS & FL_WINLO) ok = ok && (dist < 512);
        if (FLAGS & FL_BITS) ok = ok && (((mword >> koff) & 1u) != 0u);
        if (FLAGS & FL_LANE) ok = ok && laneok;
        s[i] = ok ? v : NEG_INF;
    }
}
DI bf16x8 pack8(const f32x16& x, int s) {
    typedef unsigned u32x4 __attribute__((ext_vector_type(4)));
    u32x4 p;
    p[0] = pack2(x[8 * s + 0], x[8 * s + 1]); p[1] = pack2(x[8 * s + 2], x[8 * s + 3]); p[2] = pack2(x[8 * s + 4], x[8 * s + 5]); p[3] = pack2(x[8 * s + 6], x[8 * s + 7]);
    return __builtin_bit_cast(bf16x8, p);
}
DI void pv_tile(const LAS unsigned char* Vt, const f32x16& p0, const f32x16& p1, int r, int hf, f32x16& o0, f32x16& o1) {
    OPAQUE(r); OPAQUE(hf);
#pragma unroll
    for (int G = 0; G < 4; ++G) {
        const bf16x8 pb = pack8((G >> 1) ? p1 : p0, G & 1);
        const int cc = 2 * G + hf;
        const bf16x8 a0 = *(const LAS bf16x8*)(Vt + r * 128 + ((cc ^ ((r >> 1) & 7)) << 4));
        const bf16x8 a1 = *(const LAS bf16x8*)(Vt + (32 + r) * 128 + ((cc ^ ((r >> 1) & 7)) << 4));
        o0 = MFMA32(a0, pb, o0); o1 = MFMA32(a1, pb, o1);
    }
}
DI void online_pv(Att& st, f32x16& s0, f32x16& s1, const LAS unsigned char* Vt, int r, int hf) {
    float tm = NEG_INF;
#pragma unroll
    for (int i = 0; i < 16; ++i) tm = fmaxf(tm, fmaxf(s0[i], s1[i]));
    tm = fmaxf(tm, __shfl_xor(tm, 32));
    const float mn = fmaxf(st.m, tm);
    const float mu = (mn == NEG_INF) ? 0.f : mn;
    const float alpha = __builtin_amdgcn_exp2f(st.m - mu);
    float ls = 0.f;
#pragma unroll
    for (int i = 0; i < 16; ++i) { s0[i] = __builtin_amdgcn_exp2f(s0[i] - mu); s1[i] = __builtin_amdgcn_exp2f(s1[i] - mu); ls += s0[i] + s1[i]; }
    st.l = st.l * alpha + ls;
    if (__ballot(mn != st.m) != 0ull) {
#pragma unroll
        for (int i = 0; i < 16; ++i) { st.o0[i] *= alpha; st.o1[i] *= alpha; } }
    st.m = mn;
    pv_tile(Vt, s0, s1, r, hf, st.o0, st.o1);
}
template <bool BITS>
DI void far_tile(Att& st, const LAS unsigned char* Kt, const LAS unsigned char* Vt, const bf16x8 (&qf)[4], int r, int hf, float bfar, bool laneok, unsigned m0, unsigned m1) {
    f32x16 s0, s1; qk_tile(Kt, qf, r, hf, s0, s1);
    OPAQUE(hf);
    const float cb = laneok ? bfar - st.m : NEG_INF;
    const unsigned w0 = m0 >> (4 * hf), w1 = m1 >> (4 * hf);
    float ls = 0.f;
#pragma unroll
    for (int i = 0; i < 16; ++i) { float p0 = __builtin_amdgcn_exp2f(s0[i] * QK_C1 + cb);
        if (BITS) p0 = __uint_as_float(__float_as_uint(p0) & (unsigned)__builtin_amdgcn_sbfe((int)w0, (i & 3) + 8 * (i >> 2), 1));
        s0[i] = p0; ls += p0; }
    int rr = r; OPAQUE(rr);
#pragma unroll
    for (int G = 0; G < 2; ++G) { const bf16x8 pb = pack8(s0, G); const int cc = 2 * G + hf;
        const bf16x8 a0 = *(const LAS bf16x8*)(Vt + rr * 128 + ((cc ^ ((rr >> 1) & 7)) << 4)); const bf16x8 a1 = *(const LAS bf16x8*)(Vt + (32 + rr) * 128 + ((cc ^ ((rr >> 1) & 7)) << 4));
        st.o0 = MFMA32(a0, pb, st.o0); st.o1 = MFMA32(a1, pb, st.o1); }
#pragma unroll
    for (int i = 0; i < 16; ++i) { float p1 = __builtin_amdgcn_exp2f(s1[i] * QK_C1 + cb);
        if (BITS) p1 = __uint_as_float(__float_as_uint(p1) & (unsigned)__builtin_amdgcn_sbfe((int)w1, (i & 3) + 8 * (i >> 2), 1));
        s1[i] = p1; ls += p1; }
#pragma unroll
    for (int G = 2; G < 4; ++G) { const bf16x8 pb = pack8(s1, G & 1); const int cc = 2 * G + hf;
        const bf16x8 a0 = *(const LAS bf16x8*)(Vt + rr * 128 + ((cc ^ ((rr >> 1) & 7)) << 4)); const bf16x8 a1 = *(const LAS bf16x8*)(Vt + (32 + rr) * 128 + ((cc ^ ((rr >> 1) & 7)) << 4));
        st.o0 = MFMA32(a0, pb, st.o0); st.o1 = MFMA32(a1, pb, st.o1); }
    st.l += ls;
}
#define LDS_BARRIER() do { asm volatile("s_waitcnt lgkmcnt(0)" ::: "memory"); __builtin_amdgcn_s_barrier(); asm volatile("" ::: "memory"); } while (0)
template <class LD, class BODY>
DI void tile_stream(int n, LAS unsigned char* buf, int tid, bool useV, LD ld, BODY body) {
    if (n <= 0) return;
    uint4 rk0, rk1 = make_uint4(0u, 0u, 0u, 0u), rv0 = make_uint4(0u, 0u, 0u, 0u), rv1 = make_uint4(0u, 0u, 0u, 0u);
    ld(0, rk0, rv0); if (n > 1) ld(1, rk1, rv1);
    st_write_K(buf, tid, rk0); if (useV) st_write_VT(buf + 8192, tid, rv0);
    if (n > 1) { st_write_K(buf + 16384, tid, rk1); if (useV) st_write_VT(buf + 24576, tid, rv1); }
    if (n > 2) ld(2, rk0, rv0); if (n > 3) ld(3, rk1, rv1);
    LDS_BARRIER();
#pragma unroll 1
    for (int i = 0; i < n; i += 2) {
        LAS unsigned char* cur = buf + ((i >> 1) & 1) * 32768;
        if (i + 2 < n) { LAS unsigned char* nxt = buf + (((i >> 1) + 1) & 1) * 32768;
            st_write_K(nxt, tid, rk0); if (useV) st_write_VT(nxt + 8192, tid, rv0);
            if (i + 3 < n) { st_write_K(nxt + 16384, tid, rk1); if (useV) st_write_VT(nxt + 24576, tid, rv1); }
            if (i + 4 < n) ld(i + 4, rk0, rv0); if (i + 5 < n) ld(i + 5, rk1, rv1); }
        body(i, cur, cur + 8192);
        if (i + 1 < n) body(i + 1, cur + 16384, cur + 24576);
        LDS_BARRIER();
    }
}
template <class LD, class BODY>
DI void tile_stream_k4(int n, LAS unsigned char* buf, int tid, LD ld, BODY body) {
    if (n <= 0) return;
    uint4 r0, r1 = make_uint4(0u, 0u, 0u, 0u), r2 = make_uint4(0u, 0u, 0u, 0u), r3 = make_uint4(0u, 0u, 0u, 0u), dv;
    ld(0, r0, dv); if (n > 1) ld(1, r1, dv); if (n > 2) ld(2, r2, dv); if (n > 3) ld(3, r3, dv);
    st_write_K(buf, tid, r0); if (n > 1) st_write_K(buf + 8192, tid, r1); if (n > 2) st_write_K(buf + 16384, tid, r2); if (n > 3) st_write_K(buf + 24576, tid, r3);
    if (n > 4) ld(4, r0, dv); if (n > 5) ld(5, r1, dv); if (n > 6) ld(6, r2, dv); if (n > 7) ld(7, r3, dv);
    LDS_BARRIER();
#pragma unroll 1
    for (int i = 0; i < n; i += 4) {
        LAS unsigned char* cur = buf + ((i >> 2) & 1) * 32768;
        if (i + 4 < n) { LAS unsigned char* nxt = buf + (((i >> 2) + 1) & 1) * 32768;
            st_write_K(nxt, tid, r0); if (i + 5 < n) st_write_K(nxt + 8192, tid, r1); if (i + 6 < n) st_write_K(nxt + 16384, tid, r2); if (i + 7 < n) st_write_K(nxt + 24576, tid, r3);
            if (i + 8 < n) ld(i + 8, r0, dv); if (i + 9 < n) ld(i + 9, r1, dv); if (i + 10 < n) ld(i + 10, r2, dv); if (i + 11 < n) ld(i + 11, r3, dv); }
#pragma unroll 1
        for (int j = 0; j < 4; ++j) if (i + j < n) body(i + j, cur + j * 8192, cur);
        LDS_BARRIER();
    }
}
DI uint4 cvt8_f32(const float* p) { const f32x4 a = *(const f32x4*)p, b = *(const f32x4*)(p + 4); uint4 o; o.x = pack2(a[0], a[1]); o.y = pack2(a[2], a[3]); o.z = pack2(b[0], b[1]); o.w = pack2(b[2], b[3]); return o; }

DI void nsa_unit(const Frame& F, int b, int g, int qb) {
    const int tid = F.tid, lane = F.lane, w = F.wave, r = lane & 31, hf = lane >> 5;
    LAS unsigned char* L = F.ldsl;
    LAS unsigned char* buf = L + AT_BUF;
    LAS float* psum = (LAS float*)(L + AT_PSUM);
    LAS unsigned long long* selm = (LAS unsigned long long*)(L + AT_SELM);
    LAS unsigned char* tlist = L + AT_SELM + 528;
    LAS int* tcnt = (LAS int*)(L + AT_SELM + 520);
    const bf16_t* U = (const bf16_t*)(F.ws + WS_U);
    const float* KC = (const float*)(F.ws + WS_KCMP) + (size_t)(b * 2 + g) * 256 * 64;
    const bf16_t* VCT = (const bf16_t*)(F.ws + WS_VCT) + (size_t)(b * 2 + g) * 64 * 256;
    const bf16_t* VT = (const bf16_t*)(F.ws + WS_VT);
    bf16_t* Y = (bf16_t*)(F.ws + WS_BFB);
    const int t0 = qb * 64;
    const int ql = r >> 2, h = r & 3, hh = g * 4 + h;
    const int tq = t0 + 8 * w + ql;
    const size_t row = (size_t)b * SEQ + tq;
    const bf16_t* Ur = U + row * LD0;
    bf16x8 qf[4];
#pragma unroll
    for (int s = 0; s < 4; ++s) qf[s] = *(const bf16x8*)(Ur + C_AQ + hh * 64 + 16 * s + 8 * hf);
    const LAS float* bl = F.biasL + hh * 128; const float bfar = bl[127];
    float gate[3];
    { const unsigned* gp = (const unsigned*)(Ur + C_AG);
#pragma unroll
      for (int j = 0; j < 3; ++j) { const int e = hh * 3 + j; const unsigned wv = gp[e >> 1]; gate[j] = sigmoidf_((e & 1) ? __uint_as_float(wv & 0xFFFF0000u) : __uint_as_float(wv << 16)); } }
    LAS float* opark = psum + w * 2048 + lane;

    const int nvmax = ((t0 + 63 - 31) >> 4) + 1;
    const int ntc = (nvmax + 63) >> 6;
    for (int e = tid; e < 64 * 256; e += 512) psum[e] = 0.f;
    float cm = NEG_INF, cl = 0.f;
    {
#pragma unroll 1
        for (int i = 0; i < ntc; ++i) { const int key = tid >> 3, c = tid & 7;
            const uint4 rk = cvt8_f32(KC + (size_t)(i * 64 + key) * 64 + c * 8); const uint4 rv = *(const uint4*)(VCT + (size_t)key * 256 + i * 64 + c * 8);
            st_write_K(buf + i * 8192, tid, rk); st_write_VT(buf + 32768 + i * 8192, tid, rv); }
        __syncthreads();
        auto body = [&](int i, LAS unsigned char* Kt, LAS unsigned char* Vt) { (void)Vt;
            f32x16 s0, s1; qk_tile(Kt, qf, r, hf, s0, s1);
            fix_scores<FL_NEAR | FL_CAUSAL>(s0, 16 * (i * 64) + 31, 16, tq, bl, bfar, 0u, true, hf);
            fix_scores<FL_NEAR | FL_CAUSAL>(s1, 16 * (i * 64 + 32) + 31, 16, tq, bl, bfar, 0u, true, hf);
            float tm = NEG_INF;
#pragma unroll
            for (int k = 0; k < 16; ++k) tm = fmaxf(tm, fmaxf(s0[k], s1[k]));
            tm = fmaxf(tm, __shfl_xor(tm, 32));
            const float mn = fmaxf(cm, tm); const float mu = (mn == NEG_INF) ? 0.f : mn;
            float ls = 0.f;
#pragma unroll
            for (int k = 0; k < 16; ++k) ls += __builtin_amdgcn_exp2f(s0[k] - mu) + __builtin_amdgcn_exp2f(s1[k] - mu);
            cl = cl * __builtin_amdgcn_exp2f(cm - mu) + ls; cm = mn; };
#pragma unroll 1
        for (int i = 0; i < ntc; ++i) body(i, buf + i * 8192, buf + 32768 + i * 8192);
    }
    f32x16 c0, c1;
    {
        cl += __shfl_xor(cl, 32);
        const float cinv = cl > 0.f ? 1.0f / cl : 0.f; const float cmu = (cm == NEG_INF) ? 0.f : cm;
#pragma unroll
        for (int i = 0; i < 16; ++i) { c0[i] = 0.f; c1[i] = 0.f; }
        auto body = [&](int i, LAS unsigned char* Kt, LAS unsigned char* Vt) {
            f32x16 s0, s1; qk_tile(Kt, qf, r, hf, s0, s1);
            fix_scores<FL_NEAR | FL_CAUSAL>(s0, 16 * (i * 64) + 31, 16, tq, bl, bfar, 0u, true, hf);
            fix_scores<FL_NEAR | FL_CAUSAL>(s1, 16 * (i * 64 + 32) + 31, 16, tq, bl, bfar, 0u, true, hf);
#pragma unroll
            for (int k = 0; k < 16; ++k) { s0[k] = __builtin_amdgcn_exp2f(s0[k] - cmu) * cinv; s1[k] = __builtin_amdgcn_exp2f(s1[k] - cmu) * cinv; }
#pragma unroll
            for (int k = 0; k < 16; ++k) {
                float a0 = s0[k], a1 = s1[k];
                a0 += __shfl_xor(a0, 1); a0 += __shfl_xor(a0, 2); a1 += __shfl_xor(a1, 1); a1 += __shfl_xor(a1, 2);
                const int koff = (k & 3) + 8 * (k >> 2) + 4 * hf;
                if (h == 0) { psum[(8 * w + ql) * 256 + i * 64 + koff] = a0; psum[(8 * w + ql) * 256 + i * 64 + 32 + koff] = a1; }
            }
            pv_tile(Vt, s0, s1, r, hf, c0, c1); };
#pragma unroll 1
        for (int i = 0; i < ntc; ++i) body(i, buf + i * 8192, buf + 32768 + i * 8192);
        __syncthreads();
    }
    {
        const int cur = qb; const int npick = (cur + 1) < 8 ? (cur + 1) : 8;
        LAS float* scw = (LAS float*)(L + AT_MISC + 64) + w * 64;
#pragma unroll 1
        for (int q = 0; q < 8; ++q) {
            const LAS float* pr = psum + (8 * w + q) * 256;
            float imp = 0.f;
            const int i0 = 4 * lane - 1 < 0 ? 0 : 4 * lane - 1, i1 = 4 * lane + 3 > 254 ? 254 : 4 * lane + 3;
            for (int i = i0; i <= i1; ++i) imp += pr[i];
            const bool adm = lane <= cur; const bool forced = (lane == 0) || (lane == cur) || (lane == cur - 1);
            const float score = adm ? imp + (forced ? 1.0e4f : 0.f) : NEG_INF;
            __builtin_amdgcn_wave_barrier();
            scw[lane] = score;
            __builtin_amdgcn_wave_barrier();
            int rank = 0;
#pragma unroll
            for (int j4 = 0; j4 < 16; ++j4) { const f32x4 o = *(const LAS f32x4*)(scw + 4 * j4);
#pragma unroll
                for (int e = 0; e < 4; ++e) { const int j = 4 * j4 + e; rank += (o[e] > score || (o[e] == score && j < lane)) ? 1 : 0; } }
            const unsigned long long sm = __ballot(adm && rank < npick);
            if (lane == 0) selm[8 * w + q] = sm;
        }
    }
    __syncthreads();
    if (w == 0) {
        unsigned long long m = selm[lane];
        unsigned lo = (unsigned)m, hi = (unsigned)(m >> 32);
        for (int o = 32; o >= 1; o >>= 1) { lo |= __shfl_xor(lo, o); hi |= __shfl_xor(hi, o); }
        const unsigned long long un = ((unsigned long long)hi << 32) | lo;
        const bool mine = (un >> lane) & 1ull;
        const int pos = __popcll(un & ((1ull << lane) - 1ull));
        if (mine) tlist[pos] = (unsigned char)lane;
        if (lane == 0) tcnt[0] = __popcll(un);
    }
    __syncthreads();
#pragma unroll
    for (int i = 0; i < 16; ++i) { opark[i * 64] = gate[0] * c0[i]; opark[(16 + i) * 64] = gate[0] * c1[i]; }
    const unsigned long long mysel = selm[8 * w + ql];
    {
        Att st; att_init(st);
        const int nts = tcnt[0];
        auto lds_ = [&](int i, uint4& rk, uint4& rv) { const int j = tlist[i]; const int key = tid >> 3, c = tid & 7;
            const bf16_t* p = U + ((size_t)b * SEQ + j * 64 + key) * LD0 + g * 64 + c * 8; rk = *(const uint4*)(p + C_KS); rv = *(const uint4*)(VT + (size_t)(g * 64 + key) * MT + (size_t)b * SEQ + j * 64 + c * 8); };
        auto body = [&](int i, LAS unsigned char* Kt, LAS unsigned char* Vt) {
            const int j = tlist[i];
            const bool laneok = (mysel >> j) & 1ull;
            if (__ballot(laneok) == 0ull) return;
            if (j < qb - 2 && __ballot(st.m == NEG_INF) == 0ull) { far_tile<false>(st, Kt, Vt, qf, r, hf, bfar, laneok, 0u, 0u); return; }
            f32x16 s0, s1; qk_tile(Kt, qf, r, hf, s0, s1);
            if (j >= qb - 2) { fix_scores<FL_NEAR | FL_CAUSAL | FL_LANE>(s0, j * 64, 1, tq, bl, bfar, 0u, laneok, hf); fix_scores<FL_NEAR | FL_CAUSAL | FL_LANE>(s1, j * 64 + 32, 1, tq, bl, bfar, 0u, laneok, hf); }
            else { fix_scores<FL_LANE>(s0, j * 64, 1, tq, bl, bfar, 0u, laneok, hf); fix_scores<FL_LANE>(s1, j * 64 + 32, 1, tq, bl, bfar, 0u, laneok, hf); }
            online_pv(st, s0, s1, Vt, r, hf); };
        tile_stream(nts, buf, tid, true, lds_, body);
        float l = st.l + __shfl_xor(st.l, 32);
        const float sc = l > 0.f ? gate[1] / l : 0.f;
#pragma unroll
        for (int i = 0; i < 16; ++i) { opark[i * 64] += sc * st.o0[i]; opark[(16 + i) * 64] += sc * st.o1[i]; }
    }
    {
        Att st; att_init(st);
        const int j0 = qb - 8 < 0 ? 0 : qb - 8; const int ntw = qb - j0 + 1;
        auto ldw = [&](int i, uint4& rk, uint4& rv) { const int j = j0 + i; const int key = tid >> 3, c = tid & 7;
            const bf16_t* p = U + ((size_t)b * SEQ + j * 64 + key) * LD0 + g * 64 + c * 8; rk = *(const uint4*)(p + C_KW); rv = *(const uint4*)(VT + (size_t)(128 + g * 64 + key) * MT + (size_t)b * SEQ + j * 64 + c * 8); };
        auto body = [&](int i, LAS unsigned char* Kt, LAS unsigned char* Vt) {
            const int j = j0 + i;
            if (j < qb - 2 && j != qb - 8 && __ballot(st.m == NEG_INF) == 0ull) { far_tile<false>(st, Kt, Vt, qf, r, hf, bfar, true, 0u, 0u); return; }
            f32x16 s0, s1; qk_tile(Kt, qf, r, hf, s0, s1);
            if (j >= qb - 2) { fix_scores<FL_NEAR | FL_CAUSAL>(s0, j * 64, 1, tq, bl, bfar, 0u, true, hf); fix_scores<FL_NEAR | FL_CAUSAL>(s1, j * 64 + 32, 1, tq, bl, bfar, 0u, true, hf); }
            else if (j == qb - 8) { fix_scores<FL_WINLO>(s0, j * 64, 1, tq, bl, bfar, 0u, true, hf); fix_scores<FL_WINLO>(s1, j * 64 + 32, 1, tq, bl, bfar, 0u, true, hf); }
            else { fix_scores<0>(s0, j * 64, 1, tq, bl, bfar, 0u, true, hf); fix_scores<0>(s1, j * 64 + 32, 1, tq, bl, bfar, 0u, true, hf); }
            online_pv(st, s0, s1, Vt, r, hf); };
        tile_stream(ntw, buf, tid, true, ldw, body);
        float l = st.l + __shfl_xor(st.l, 32);
        const float sc = l > 0.f ? gate[2] / l : 0.f;
#pragma unroll
        for (int i = 0; i < 16; ++i) { c0[i] = opark[i * 64] + sc * st.o0[i]; c1[i] = opark[(16 + i) * 64] + sc * st.o1[i]; }
    }
#pragma unroll
    for (int dh = 0; dh < 2; ++dh)
#pragma unroll
        for (int k = 0; k < 4; ++k) {
            const int d = 32 * dh + 8 * k + 4 * hf;
            const uint2 zz = *(const uint2*)(Ur + C_AZ + hh * 64 + d);
            const float z0 = __uint_as_float(zz.x << 16), z1 = __uint_as_float(zz.x & 0xFFFF0000u), z2 = __uint_as_float(zz.y << 16), z3 = __uint_as_float(zz.y & 0xFFFF0000u);
            const f32x16& o = dh ? c1 : c0;
            uint2 pk; pk.x = pack2(o[4 * k + 0] * siluf_(z0), o[4 * k + 1] * siluf_(z1)); pk.y = pack2(o[4 * k + 2] * siluf_(z2), o[4 * k + 3] * siluf_(z3));
            *(uint2*)(Y + row * 1024 + hh * 64 + d) = pk;
        }
    __syncthreads();
}

DI unsigned short okey16(float x) {
    const _Float16 hx = (_Float16)x; unsigned short u = __builtin_bit_cast(unsigned short, hx);
    if ((u & 0x7FFFu) == 0u) u = 0u;
    return (u & 0x8000u) ? (unsigned short)~u : (unsigned short)(u | 0x8000u);
}
DI void dsa_unit(const Frame& F, int b, int qt) {
    const int tid = F.tid, lane = F.lane, w = F.wave, r = lane & 31, hf = lane >> 5, fr = lane & 15, fq = lane >> 4;
    LAS unsigned char* L = F.ldsl;
    LAS unsigned char* buf = L + AT_BUF;
    LAS unsigned* mask = (LAS unsigned*)(L + AT_PSUM);
    const bf16_t* U = (const bf16_t*)(F.ws + WS_U);
    bf16_t* Y = (bf16_t*)(F.ws + WS_BFB);
    const bf16_t* VT = (const bf16_t*)(F.ws + WS_VT);
    unsigned short* KS = (unsigned short*)(F.ws + WS_BFA) + (size_t)F.bid * 32 * 4096;
    const int t0 = qt * 32;
    const int nt = ((t0 + 31) >> 6) + 1;
    {
        bf16x8 qi[2]; float wi[4];
        { const bf16_t* Uq = U + ((size_t)b * SEQ + t0 + 4 * w + (fr >> 2)) * LD0;
#pragma unroll
          for (int ks = 0; ks < 2; ++ks) qi[ks] = *(const bf16x8*)(Uq + C_BQI + (fr & 3) * 64 + 32 * ks + 8 * fq);
          const uint2 wv = *(const uint2*)(U + ((size_t)b * SEQ + t0 + 4 * w + fq) * LD0 + C_BWI);
          wi[0] = __uint_as_float(wv.x << 16) * 0.0625f; wi[1] = __uint_as_float(wv.x & 0xFFFF0000u) * 0.0625f; wi[2] = __uint_as_float(wv.y << 16) * 0.0625f; wi[3] = __uint_as_float(wv.y & 0xFFFF0000u) * 0.0625f; }
        const int tqi = t0 + 4 * w + fq;
        auto ldi = [&](int i, uint4& rk, uint4& rv) { const int key = tid >> 3, c = tid & 7; rk = *(const uint4*)(U + ((size_t)b * SEQ + i * 64 + key) * LD0 + C_BKI + c * 8); (void)rv; };
        auto body = [&](int i, LAS unsigned char* Kt, LAS unsigned char* Vt) { (void)Vt;
#pragma unroll
            for (int kg = 0; kg < 4; ++kg) {
                const int kk = 16 * kg + fr;
                f32x4 acc = {0.f, 0.f, 0.f, 0.f};
#pragma unroll
                for (int ks = 0; ks < 2; ++ks) { const int c = 4 * ks + fq;
                    const bf16x8 kb = *(const LAS bf16x8*)(Kt + kk * 128 + ((c ^ (kk & 7)) << 4));
                    acc = __builtin_amdgcn_mfma_f32_16x16x32_bf16(qi[ks], kb, acc, 0, 0, 0); }
                const float sc = wi[0] * fmaxf(acc[0], 0.f) + wi[1] * fmaxf(acc[1], 0.f) + wi[2] * fmaxf(acc[2], 0.f) + wi[3] * fmaxf(acc[3], 0.f);
                const int pos = i * 64 + kk;
                KS[(size_t)(4 * w + fq) * 4096 + pos] = pos <= tqi ? okey16(sc) : (unsigned short)0;
            } };
        tile_stream_k4(nt, buf, tid, ldi, body);
    }
    asm volatile("s_waitcnt vmcnt(0)" ::: "memory");
    __syncthreads();
    __builtin_amdgcn_fence(__ATOMIC_ACQUIRE, "agent");
    asm volatile("s_waitcnt vmcnt(0)" ::: "memory");
    {
    LAS unsigned char* maskb = (LAS unsigned char*)mask;
    unsigned Tn[32];
    auto ldkeys = [&](int q) { const int qq = 4 * w + q; const int nk = t0 + qq + 1; int ln = lane; OPAQUE(ln); const unsigned short* kq = KS + (size_t)qq * 4096 + ln * 8;
#pragma unroll
        for (int c = 0; c < 8; ++c) { uint4 kv = make_uint4(0u, 0u, 0u, 0u); if (c * 512 < nk) kv = *(const uint4*)(kq + c * 512);
            Tn[4 * c] = kv.x; Tn[4 * c + 1] = kv.y; Tn[4 * c + 2] = kv.z; Tn[4 * c + 3] = kv.w; } };
    ldkeys(0);
#pragma unroll 1
    for (int q = 0; q < 4; ++q) {
        const int qq = 4 * w + q; const int tqq = t0 + qq; const int nk = tqq + 1;
        unsigned T[32];
#pragma unroll
        for (int e = 0; e < 32; ++e) T[e] = Tn[e];
        if (q < 3) ldkeys(q + 1);
        if (nk <= 256) {
#pragma unroll
            for (int c = 0; c < 8; ++c) { unsigned selb = 0u;
#pragma unroll
                for (int e = 0; e < 8; ++e) if (c * 512 + lane * 8 + e < nk) selb |= 1u << e;
                maskb[qq * 512 + c * 64 + lane] = (unsigned char)selb; }
            continue;
        }
#pragma unroll
        for (int e = 0; e < 32; ++e) { const int idx = (e >> 2) * 512 + lane * 8 + (e & 3) * 2;
            unsigned lo = T[e] & 0xFFFFu, hi = T[e] >> 16; if (idx >= nk) lo = 0u; if (idx + 1 >= nk) hi = 0u; T[e] = lo | (hi << 16); }
#pragma unroll
        for (int st = 0; st < 5; ++st) { const int j = 16 >> st; const unsigned m = st == 0 ? 0x0000FFFFu : st == 1 ? 0x00FF00FFu : st == 2 ? 0x0F0F0F0Fu : st == 3 ? 0x33333333u : 0x55555555u;
#pragma unroll
            for (int k0 = 0; k0 < 32; k0 += 2 * j)
#pragma unroll
                for (int i = 0; i < j; ++i) { const int k = k0 + i; const unsigned t = ((T[k] >> j) ^ T[k + j]) & m; T[k] ^= (t << j); T[k + j] ^= t; } }
        unsigned ce = 0xFFFFFFFFu, co = 0xFFFFFFFFu, ge = 0u, go = 0u; int above = 0;
#pragma unroll
        for (int bit = 15; bit >= 0; --bit) {
            const unsigned oe = ce & T[bit], oo = co & T[16 + bit];
            const int cnt = __popc(oe) + __popc(oo);
            int tot = 0;
#pragma unroll
            for (int bb = 0; bb < 7; ++bb) tot += __popcll(__ballot((cnt >> bb) & 1)) << bb;
            if (above + tot >= 256) { ce = oe; co = oo; }
            else { above += tot; ge |= oe; go |= oo; ce &= ~T[bit]; co &= ~T[16 + bit]; }
        }
        const int quota = 256 - above; int taken = 0;
#pragma unroll
        for (int c = 0; c < 8; ++c) {
            unsigned xe = (ge >> (4 * c)) & 0xFu, xo = (go >> (4 * c)) & 0xFu;
            xe = (xe | (xe << 2)) & 0x33u; xe = (xe | (xe << 1)) & 0x55u; xo = (xo | (xo << 2)) & 0x33u; xo = (xo | (xo << 1)) & 0x55u;
            unsigned selb = xe | (xo << 1);
            unsigned ye = (ce >> (4 * c)) & 0xFu, yo = (co >> (4 * c)) & 0xFu;
            ye = (ye | (ye << 2)) & 0x33u; ye = (ye | (ye << 1)) & 0x55u; yo = (yo | (yo << 2)) & 0x33u; yo = (yo | (yo << 1)) & 0x55u;
            const unsigned eqb = ye | (yo << 1);
            if (__ballot(eqb != 0u) != 0ull) {
                const int ne = __popc(eqb);
                int excl = 0, totc = 0;
#pragma unroll
                for (int bb = 0; bb < 4; ++bb) { const unsigned long long bl_ = __ballot((ne >> bb) & 1);
                    excl += (int)__builtin_amdgcn_mbcnt_hi((unsigned)(bl_ >> 32), __builtin_amdgcn_mbcnt_lo((unsigned)bl_, 0u)) << bb; totc += __popcll(bl_) << bb; }
                int rank = taken + excl;
#pragma unroll
                for (int e = 0; e < 8; ++e) if ((eqb >> e) & 1u) { if (rank < quota) selb |= 1u << e; ++rank; }
                taken += totc;
            }
            maskb[qq * 512 + c * 64 + lane] = (unsigned char)selb;
        }
    }
    }
    __syncthreads();
    {
        const int ql = r >> 3, h = r & 7;
        const int tq = t0 + 4 * w + ql;
        const size_t row = (size_t)b * SEQ + tq;
        const bf16_t* Ur = U + row * LD0;
        bf16x8 qf[4];
#pragma unroll
        for (int s = 0; s < 4; ++s) qf[s] = *(const bf16x8*)(Ur + C_BQ + h * 64 + 16 * s + 8 * hf);
        const LAS float* bl = F.biasL + (8 + h) * 128; const float bfar = bl[127];
        const LAS unsigned* mq = mask + (4 * w + ql) * 128;
        Att st; att_init(st);
        auto lda = [&](int i, uint4& rk, uint4& rv) { const int key = tid >> 3, c = tid & 7;
            const bf16_t* p = U + ((size_t)b * SEQ + i * 64 + key) * LD0 + c * 8; rk = *(const uint4*)(p + C_BK); rv = *(const uint4*)(VT + (size_t)(256 + key) * MT + (size_t)b * SEQ + i * 64 + c * 8); };
        auto body = [&](int i, LAS unsigned char* Kt, LAS unsigned char* Vt) {
            const unsigned m0 = mq[2 * i], m1 = mq[2 * i + 1];
            if (i < nt - 4 && __ballot(st.m == NEG_INF) == 0ull) { far_tile<true>(st, Kt, Vt, qf, r, hf, bfar, true, m0, m1); return; }
            f32x16 s0, s1; qk_tile(Kt, qf, r, hf, s0, s1);
            if (i >= nt - 4) { fix_scores<FL_NEAR | FL_CAUSAL | FL_BITS>(s0, i * 64, 1, tq, bl, bfar, m0, true, hf); fix_scores<FL_NEAR | FL_CAUSAL | FL_BITS>(s1, i * 64 + 32, 1, tq, bl, bfar, m1, true, hf); }
            else { fix_scores<FL_BITS>(s0, i * 64, 1, tq, bl, bfar, m0, true, hf); fix_scores<FL_BITS>(s1, i * 64 + 32, 1, tq, bl, bfar, m1, true, hf); }
            online_pv(st, s0, s1, Vt, r, hf); };
        tile_stream(nt, buf, tid, true, lda, body);
        float l = st.l + __shfl_xor(st.l, 32);
        const float sc = l > 0.f ? 1.0f / l : 0.f;
#pragma unroll
        for (int dh = 0; dh < 2; ++dh)
#pragma unroll
            for (int k = 0; k < 4; ++k) {
                const int d = 32 * dh + 8 * k + 4 * hf;
                const uint2 zz = *(const uint2*)(Ur + C_BZ + h * 64 + d);
                const float z0 = __uint_as_float(zz.x << 16), z1 = __uint_as_float(zz.x & 0xFFFF0000u), z2 = __uint_as_float(zz.y << 16), z3 = __uint_as_float(zz.y & 0xFFFF0000u);
                const f32x16& o = dh ? st.o1 : st.o0;
                uint2 pk; pk.x = pack2(o[4 * k + 0] * sc * siluf_(z0), o[4 * k + 1] * sc * siluf_(z1)); pk.y = pack2(o[4 * k + 2] * sc * siluf_(z2), o[4 * k + 3] * sc * siluf_(z3));
                *(uint2*)(Y + row * 1024 + 512 + h * 64 + d) = pk;
            }
    }
    __syncthreads();
}

DI void att_dsa(const Frame& F) {
    LAS int* ub = (LAS int*)(F.ldsl + AT_MISC);
    unsigned* qd = F.ctl + CW_QDSA;
    const int NDSA = NB * (SEQ / 32);
    for (;;) {
        __syncthreads();
        if (F.tid == 0) ub[0] = (int)__hip_atomic_fetch_add(qd, 1u, __ATOMIC_RELAXED, __HIP_MEMORY_SCOPE_AGENT);
        __syncthreads();
        const int k = ub[0];
        if (k >= NDSA) break;
        dsa_unit(F, k & 7, (SEQ / 32) - 1 - (k >> 3));
    }
}
DI void att_nsa(const Frame& F) {
    LAS int* ub = (LAS int*)(F.ldsl + AT_MISC);
    unsigned* qn = F.ctl + CW_QNSA;
    const int NNSA = NB * 2 * (SEQ / 64);
    for (;;) {
        __syncthreads();
        if (F.tid == 0) ub[0] = (int)__hip_atomic_fetch_add(qn, 1u, __ATOMIC_RELAXED, __HIP_MEMORY_SCOPE_AGENT);
        __syncthreads();
        const int k = ub[0];
        if (k >= NNSA) break;
        const int bg = k & 15;
        nsa_unit(F, bg >> 1, bg & 1, 63 - (k >> 4));
    }
}
#endif

DI f32x4 mma16(const bf16_t* A, int lda, const bf16_t* Bt, int ldb, int K, int lane) {
    const int fr = lane & 15, fq = lane >> 4;
    f32x4 acc = {0.f, 0.f, 0.f, 0.f};
    for (int k = 0; k < K; k += 32) {
        const bf16x8 a = *(const bf16x8*)(A + fr * lda + k + fq * 8);
        const bf16x8 b = *(const bf16x8*)(Bt + fr * ldb + k + fq * 8);
        acc = __builtin_amdgcn_mfma_f32_16x16x32_bf16(a, b, acc, 0, 0, 0);
    }
    return acc;
}
DI void conv8(const bf16_t* U1, int b, int t, int col, const float* cw  , int nch, const float* cb, float (&y)[8]) {
#pragma unroll
    for (int i = 0; i < 8; ++i) y[i] = cb[i];
#pragma unroll
    for (int j = 0; j < 4; ++j) { const int tt = t - 3 + j;
        if (tt >= 0) { const uint4 v = *(const uint4*)(U1 + ((size_t)b * SEQ + tt) * LD1 + col); float f[8]; unpack8(v, f);
#pragma unroll
            for (int i = 0; i < 8; ++i) y[i] += cw[(size_t)j * nch + i] * f[i]; } }
}
DI void stage_raw128(const Frame& F, const bf16_t* U1, int b, int t_first, int nrows, int col, bf16_t* raw) {
    for (int it = F.tid; it < nrows * 16; it += 512) { const int row = it >> 4, ch = it & 15; const int t = t_first + row;
        uint4 v = make_uint4(0u, 0u, 0u, 0u); if (t >= 0) v = *(const uint4*)(U1 + ((size_t)b * SEQ + t) * LD1 + col + ch * 8);
        *(uint4*)(raw + row * 136 + ch * 8) = v; }
}
DI void load_raw128(const Frame& F, const bf16_t* U1, int b, int t_first, int nrows, int col, uint4 (&rg)[3]) {
#pragma unroll
    for (int j = 0; j < 3; ++j) { const int it = F.tid + j * 512; const int row = it >> 4, ch = it & 15; const int t = t_first + row;
        rg[j] = make_uint4(0u, 0u, 0u, 0u); if (it < nrows * 16 && t >= 0) rg[j] = *(const uint4*)(U1 + ((size_t)b * SEQ + t) * LD1 + col + ch * 8); }
}
DI void write_raw128(const Frame& F, int nrows, const uint4 (&rg)[3], bf16_t* raw) {
#pragma unroll
    for (int j = 0; j < 3; ++j) { const int it = F.tid + j * 512; const int row = it >> 4, ch = it & 15; if (it < nrows * 16) *(uint4*)(raw + row * 136 + ch * 8) = rg[j]; }
}
DI void conv8_lds(const bf16_t* raw, int s, int d0, const float* cw  , const float* cb  , float (&y)[8]) {
#pragma unroll
    for (int i = 0; i < 8; ++i) y[i] = cb[d0 + i];
#pragma unroll
    for (int j = 0; j < 4; ++j) { const uint4 v = *(const uint4*)(raw + (s + j) * 136 + d0); float f[8]; unpack8(v, f);
#pragma unroll
        for (int i = 0; i < 8; ++i) y[i] += cw[j * 128 + d0 + i] * f[i]; }
}
DI void mlstm_gates(const Frame& F, const bf16_t* U1, int b, int h, int c, float* li, float* bc) {
    if (F.wave == 0) {
        const size_t row = (size_t)b * SEQ + c * 64 + F.lane;
        const float ip = bf2f(U1[row * LD1 + C_DI + h]) + F.in[26][h];
        const float fp = bf2f(U1[row * LD1 + C_DF + h]) + F.in[27][h];
        const float lf = fminf(fp, 0.f) - log1pf(expf(-fabsf(fp)));
        float cs = lf;
        for (int o = 1; o < 64; o <<= 1) { const float n = __shfl_up(cs, o); if (F.lane >= o) cs += n; }
        li[F.lane] = ip; bc[F.lane] = cs;
    }
    __syncthreads();
}
constexpr int ML_LI = 0, ML_BC = 256, ML_WK = 512, ML_MT = 768, ML_DQ = 1024, ML_RS = 1280, ML_NIN = 1536, ML_Q = 2048, ML_K = ML_Q + 64 * 136 * 2, ML_VT = ML_K + 64 * 136 * 2,
              ML_CT = ML_VT + 128 * 72 * 2, ML_W = ML_CT + 128 * 136 * 2, ML_KT = ML_W + 64 * 72 * 2, ML_END = ML_KT + 128 * 72 * 2;
static_assert(ML_END + 5120 + LDS_WORK_OFF <= LDS_BYTES - 12288, "mlstm lds");

DI void p8a_mlstm_local(const Frame& F) {
    const bf16_t* U1 = (const bf16_t*)(F.ws + WS_U);
    bf16_t* ST = (bf16_t*)(F.ws + WS_BFB);
    float* zloc = (float*)(F.ws + WS_ZLOC); float* scal = (float*)(F.ws + WS_SCAL);
    unsigned char* L = F.lds;
    float* li = (float*)(L + ML_LI); float* bc = (float*)(L + ML_BC); float* wk = (float*)(L + ML_WK);
    bf16_t* kT = (bf16_t*)(L + ML_KT); bf16_t* vT = (bf16_t*)(L + ML_VT); float* cwl = (float*)(L + ML_END); bf16_t* raw = (bf16_t*)(L + ML_Q);
    const float* cw = F.in[24]; const float* cb = F.in[25];
    uint4 rk3[3], rv3[3];
    auto prefetch = [&](int unit) { const int c = unit & 63, h = (unit >> 6) & 3, b = unit >> 8;
        load_raw128(F, U1, b, c * 64 - 3, 67, C_DK + h * 128, rk3); load_raw128(F, U1, b, c * 64, 64, C_DV + h * 128, rv3); };
    if (F.bid < 2048) prefetch(F.bid);
    for (int unit = F.bid; unit < 2048; unit += F.G) {
        const int c = unit & 63, h = (unit >> 6) & 3, b = unit >> 8;
        mlstm_gates(F, U1, b, h, c, li, bc);
        if (F.wave == 0) {
            const float bl = bc[63]; const float dec = bl - bc[F.lane] + li[F.lane];
            const float dmx = wave_max(dec);
            wk[F.lane] = expf(dec - dmx);
            if (F.lane == 0) { scal[unit] = bl; scal[2048 + unit] = dmx; }
        }
        for (int e = F.tid; e < 640; e += 512) cwl[e] = e < 512 ? cw[(size_t)(e >> 7) * 1024 + 512 + h * 128 + (e & 127)] : cb[512 + h * 128 + (e - 512)];
        write_raw128(F, 67, rk3, raw);
        __syncthreads();
        for (int it = F.tid; it < 1024; it += 512) {
            const int s = it & 63, d0 = (it >> 6) * 8;
            float y[8]; conv8_lds(raw, s, d0, cwl, cwl + 512, y);
            const float w = wk[s] * 0.08838834764831845f;
#pragma unroll
            for (int i = 0; i < 8; ++i) kT[(d0 + i) * 72 + s] = f2bf(siluf_(y[i]) * w);
        }
        __syncthreads();
        write_raw128(F, 64, rv3, raw);
        if (unit + F.G < 2048) prefetch(unit + F.G);
        __syncthreads();
        for (int it = F.tid; it < 1024; it += 512) {
            const int s = it & 63, d0 = (it >> 6) * 8;
            const uint4 vv = *(const uint4*)(raw + s * 136 + d0); const unsigned wv[4] = {vv.x, vv.y, vv.z, vv.w};
#pragma unroll
            for (int i = 0; i < 8; ++i) vT[(d0 + i) * 72 + s] = (bf16_t)((i & 1) ? (wv[i >> 1] >> 16) : (wv[i >> 1] & 0xFFFFu));
        }
        __syncthreads();
        for (int tix = F.wave * 8; tix < F.wave * 8 + 8; ++tix) {
            const int et = tix >> 3, dt = tix & 7;
            const f32x4 a = mma16(vT + et * 16 * 72, 72, kT + dt * 16 * 72, 72, 64, F.lane);
            const int fr = F.lane & 15, fq = F.lane >> 4;
#pragma unroll
            for (int r = 0; r < 4; ++r) ST[(size_t)unit * 16384 + (size_t)(et * 16 + 4 * fq + r) * 128 + dt * 16 + fr] = f2bf(a[r]);
        }
        { const int d = F.tid >> 2, part = F.tid & 3; float z = 0.f;
#pragma unroll
          for (int s = 0; s < 16; ++s) z += bf2f(kT[d * 72 + part * 16 + s]);
          z += __shfl_xor(z, 1); z += __shfl_xor(z, 2);
          if (part == 0) zloc[(size_t)unit * 128 + d] = z; }
        __syncthreads();
    }
}

DI void p8a_lru_local(const Frame& F) {
    const bf16_t* U1 = (const bf16_t*)(F.ws + WS_U);
    bf16_t* LA = (bf16_t*)(F.ws + WS_LRUA); bf16_t* LH = (bf16_t*)(F.ws + WS_LRUH);
    float* Aend = (float*)(F.ws + WS_AEND); float* Hend = (float*)(F.ws + WS_HEND);
    const bf16_t* WAT = (const bf16_t*)(F.ws + WS_WAT); const bf16_t* WXT = (const bf16_t*)(F.ws + WS_WXT);
    bf16_t* xcb = (bf16_t*)F.lds;
    float* cwL = (float*)(F.lds + 16640);
    bf16_t* rawl = (bf16_t*)(F.lds + 16640 + 10240);
    const int g = F.wave, lane = F.lane, fr = lane & 15, fq = lane >> 4;
    __syncthreads();
    for (int e = F.tid; e < 2048; e += 512) cwL[e] = F.in[17][e];
    cwL[2048 + F.tid] = F.in[18][F.tid];
    bf16x8 wa[4][2], wx[4][2]; float ba[4], bx[4], sp[4];
#pragma unroll
    for (int ct = 0; ct < 4; ++ct) { const int ch = g * 64 + ct * 16 + fr;
#pragma unroll
        for (int ks = 0; ks < 2; ++ks) { wa[ct][ks] = *(const bf16x8*)(WAT + (size_t)ch * 64 + 32 * ks + 8 * fq); wx[ct][ks] = *(const bf16x8*)(WXT + (size_t)ch * 64 + 32 * ks + 8 * fq); }
        ba[ct] = F.in[20][ch]; bx[ct] = F.in[22][ch]; sp[ct] = log1pf(expf(-F.in[23][ch])); }
    __syncthreads();
    for (int unit = F.bid; unit < 512; unit += F.G) {
        const int b = unit >> 6, c = unit & 63, t0 = c * 64;
        float Ac[4] = {1.f, 1.f, 1.f, 1.f}, hl[4] = {0.f, 0.f, 0.f, 0.f};
        uint4 rr[3];
        auto ldraw = [&](int sub) {
#pragma unroll
            for (int j = 0; j < 3; ++j) { const int it = F.tid + j * 512; const int row = it >> 6, c8 = (it & 63) * 8; const int t = t0 + sub * 16 - 3 + row;
                rr[j] = make_uint4(0u, 0u, 0u, 0u); if (it < 19 * 64 && t >= 0) rr[j] = *(const uint4*)(U1 + ((size_t)b * SEQ + t) * LD1 + C_CX + c8); } };
        ldraw(0);
#pragma unroll 1
        for (int sub = 0; sub < 4; ++sub) {
#pragma unroll
            for (int j = 0; j < 3; ++j) { const int it = F.tid + j * 512; if (it < 19 * 64) *(uint4*)(rawl + (it >> 6) * 520 + (it & 63) * 8) = rr[j]; }
            __syncthreads();
            if (sub < 3) ldraw(sub + 1);
            for (int it = F.tid; it < 1024; it += 512) {
                const int tk = it >> 6, c8 = (it & 63) * 8;
                float y[8];
#pragma unroll
                for (int i = 0; i < 8; ++i) y[i] = cwL[2048 + c8 + i];
#pragma unroll
                for (int j = 0; j < 4; ++j) { const uint4 v = *(const uint4*)(rawl + (tk + j) * 520 + c8); float f[8]; unpack8(v, f);
#pragma unroll
                    for (int i = 0; i < 8; ++i) y[i] += cwL[j * 512 + c8 + i] * f[i]; }
                uint4 o; o.x = pack2(y[0], y[1]); o.y = pack2(y[2], y[3]); o.z = pack2(y[4], y[5]); o.w = pack2(y[6], y[7]);
                *(uint4*)(xcb + tk * 520 + c8) = o;
            }
            __syncthreads();
            bf16x8 af[2];
#pragma unroll
            for (int ks = 0; ks < 2; ++ks) af[ks] = *(const bf16x8*)(xcb + fr * 520 + g * 64 + 32 * ks + 8 * fq);
#pragma unroll
            for (int ct = 0; ct < 4; ++ct) {
                const int ch = g * 64 + ct * 16 + fr;
                f32x4 accA = {0.f, 0.f, 0.f, 0.f}, accX = {0.f, 0.f, 0.f, 0.f};
#pragma unroll
                for (int ks = 0; ks < 2; ++ks) { accA = __builtin_amdgcn_mfma_f32_16x16x32_bf16(af[ks], wa[ct][ks], accA, 0, 0, 0); accX = __builtin_amdgcn_mfma_f32_16x16x32_bf16(af[ks], wx[ct][ks], accX, 0, 0, 0); }
                float Ap[4], Hp[4]; float A4 = 1.f, H4 = 0.f;
#pragma unroll
                for (int rg = 0; rg < 4; ++rg) {
                    const float xc = bf2f(xcb[(4 * fq + rg) * 520 + ch]);
                    const float r = sigmoidf_(accA[rg] + ba[ct]), ig = sigmoidf_(accX[rg] + bx[ct]);
                    const float a = fexp_(-8.0f * r * sp[ct]);
                    const float bt = sqrtf(fmaxf(1.0f - a * a, 0.f)) * (ig * xc);
                    H4 = a * H4 + bt; A4 *= a; Ap[rg] = A4; Hp[rg] = H4;
                }
                float iA = A4, iH = H4;
                { const float pA = __shfl_up(iA, 16), pH = __shfl_up(iH, 16); if (fq >= 1) { iH = iA * pH + iH; iA = pA * iA; } }
                { const float pA = __shfl_up(iA, 32), pH = __shfl_up(iH, 32); if (fq >= 2) { iH = iA * pH + iH; iA = pA * iA; } }
                float eA = __shfl_up(iA, 16), eH = __shfl_up(iH, 16); if (fq == 0) { eA = 1.f; eH = 0.f; }
                const float tA = __shfl(iA, 48 + fr), tH = __shfl(iH, 48 + fr);
                const float cA = Ac[ct] * eA, cH = eA * hl[ct] + eH;
#pragma unroll
                for (int rg = 0; rg < 4; ++rg) { const size_t row = (size_t)b * SEQ + t0 + sub * 16 + 4 * fq + rg;
                    LA[row * 512 + ch] = f2bf(cA * Ap[rg]); LH[row * 512 + ch] = f2bf(Ap[rg] * cH + Hp[rg]); }
                hl[ct] = tA * hl[ct] + tH; Ac[ct] = Ac[ct] * tA;
            }
            __syncthreads();
        }
        if (fq == 0) {
#pragma unroll
            for (int ct = 0; ct < 4; ++ct) { const int ch = g * 64 + ct * 16 + fr; Aend[((size_t)b * 64 + c) * 512 + ch] = Ac[ct]; Hend[((size_t)b * 64 + c) * 512 + ch] = hl[ct]; } }
    }
    __syncthreads();
}

DI void p8b_scans(const Frame& F) {
    const int gt = F.bid * 512 + F.tid, nthr = F.G * 512;
    if (gt < 4096) {
        const int b = gt >> 9, ch = gt & 511;
        const float* Aend = (const float*)(F.ws + WS_AEND); const float* Hend = (const float*)(F.ws + WS_HEND); float* Hin = (float*)(F.ws + WS_HIN);
        float H = 0.f;
#pragma unroll 1
        for (int c0 = 0; c0 < 64; c0 += 8) {
            float av[8], hv[8];
#pragma unroll
            for (int j = 0; j < 8; ++j) { const size_t o = ((size_t)b * 64 + c0 + j) * 512 + ch; av[j] = Aend[o]; hv[j] = Hend[o]; }
#pragma unroll
            for (int j = 0; j < 8; ++j) { const size_t o = ((size_t)b * 64 + c0 + j) * 512 + ch; Hin[o] = H; H = av[j] * H + hv[j]; }
        }
    }
    const float* scal = (const float*)(F.ws + WS_SCAL); float* minp = (float*)(F.ws + WS_SCAL) + 4096;
    if (gt >= nthr - 4096) {
        const int q = gt - (nthr - 4096); const int bh = q >> 7, d = q & 127;
        const float* zloc = (const float*)(F.ws + WS_ZLOC); float* nin = (float*)(F.ws + WS_NIN);
        float m = 0.f, n = 0.f;
#pragma unroll 1
        for (int c0 = 0; c0 < 64; c0 += 8) {
            float zv[8];
#pragma unroll
            for (int j = 0; j < 8; ++j) zv[j] = zloc[(size_t)(bh * 64 + c0 + j) * 128 + d];
#pragma unroll
            for (int j = 0; j < 8; ++j) { const int unit = bh * 64 + c0 + j; const float bl = scal[unit], dm = scal[2048 + unit];
                const float mn = fmaxf(bl + m, dm); const float keep = expf(bl + m - mn), add = expf(dm - mn);
                nin[(size_t)unit * 128 + d] = n; if (d == 0) minp[unit] = m;
                n = keep * n + add * zv[j]; m = mn; }
        }
    }
    bf16_t* ST = (bf16_t*)(F.ws + WS_BFB);
    float* kp = (float*)F.lds; float* ad = kp + 64;
    if (gt < 65536) {
        const int bh = gt >> 11, ed = (gt & 2047) * 8;
        if (F.wave == 0) { const int c = F.lane; const int unit = bh * 64 + c; const float bl = scal[unit], dm = scal[2048 + unit];
            float Bi = bl;
            for (int o = 1; o < 64; o <<= 1) { const float n = __shfl_up(Bi, o); if (c >= o) Bi += n; }
            float pm = dm - Bi;
            for (int o = 1; o < 64; o <<= 1) { const float n = __shfl_up(pm, o); if (c >= o) pm = fmaxf(pm, n); }
            const float mnext = Bi + fmaxf(0.f, pm);
            float mcur = __shfl_up(mnext, 1); if (c == 0) mcur = 0.f;
            kp[c] = expf(bl + mcur - mnext); ad[c] = expf(dm - mnext); }
        __syncthreads();
        float C[8] = {0.f, 0.f, 0.f, 0.f, 0.f, 0.f, 0.f, 0.f};
#pragma unroll 1
        for (int c0 = 0; c0 < 64; c0 += 8) {
            uint4 sv[8];
#pragma unroll
            for (int j = 0; j < 8; ++j) sv[j] = *(const uint4*)(ST + (size_t)(bh * 64 + c0 + j) * 16384 + ed);
#pragma unroll
            for (int j = 0; j < 8; ++j) { float sf[8]; unpack8(sv[j], sf);
                uint4 o; o.x = pack2(C[0], C[1]); o.y = pack2(C[2], C[3]); o.z = pack2(C[4], C[5]); o.w = pack2(C[6], C[7]);
                *(uint4*)(ST + (size_t)(bh * 64 + c0 + j) * 16384 + ed) = o;
                const float kk = kp[c0 + j], aa = ad[c0 + j];
#pragma unroll
                for (int i = 0; i < 8; ++i) C[i] = kk * C[i] + aa * sf[i]; }
        }
    }
}

DI void p8c_mlstm_out(const Frame& F) {
    const bf16_t* U1 = (const bf16_t*)(F.ws + WS_U);
    const bf16_t* ST = (const bf16_t*)(F.ws + WS_BFB);
    bf16_t* Y = (bf16_t*)(F.ws + WS_BFA);
    const float* nin_g = (const float*)(F.ws + WS_NIN); const float* minp = (const float*)(F.ws + WS_SCAL) + 4096;
    unsigned char* L = F.lds;
    float* li = (float*)(L + ML_LI); float* bc = (float*)(L + ML_BC); float* wkk = (float*)(L + ML_WK); float* mt = (float*)(L + ML_MT); float* dq = (float*)(L + ML_DQ); float* rs = (float*)(L + ML_RS); float* nin = (float*)(L + ML_NIN);
    bf16_t* q = (bf16_t*)(L + ML_Q); bf16_t* k = (bf16_t*)(L + ML_K); bf16_t* vT = (bf16_t*)(L + ML_VT); bf16_t* CT = (bf16_t*)(L + ML_CT); bf16_t* W = (bf16_t*)(L + ML_W); float* cwl = (float*)(L + ML_END); bf16_t* raw = (bf16_t*)(L + ML_KT); float* HT = (float*)(L + ML_Q);
    const float* cw = F.in[24]; const float* cb = F.in[25];
    uint4 rq3[3], rk3[3], rv3[3]; u32x4 rc4[4];
    auto prefetch = [&](int unit) { const int c = unit & 63, h = (unit >> 6) & 3, b = unit >> 8;
        load_raw128(F, U1, b, c * 64 - 3, 67, C_DQ + h * 128, rq3);
        load_raw128(F, U1, b, c * 64 - 3, 67, C_DK + h * 128, rk3);
        load_raw128(F, U1, b, c * 64, 64, C_DV + h * 128, rv3);
#pragma unroll
        for (int j = 0; j < 4; ++j) { const int it = F.tid + j * 512; rc4[j] = *(const u32x4*)(ST + (size_t)unit * 16384 + (it >> 4) * 128 + (it & 15) * 8); } };
    if (F.bid < 2048) prefetch(F.bid);
    for (int unit = F.bid; unit < 2048; unit += F.G) {
        const int c = unit & 63, h = (unit >> 6) & 3, b = unit >> 8;
        const float m_in = minp[unit];
        for (int e = F.tid; e < 1280; e += 512) { float v;
            if (e < 512) v = cw[(size_t)(e >> 7) * 1024 + h * 128 + (e & 127)]; else if (e < 1024) v = cw[(size_t)((e - 512) >> 7) * 1024 + 512 + h * 128 + (e & 127)];
            else if (e < 1152) v = cb[h * 128 + (e - 1024)]; else v = cb[512 + h * 128 + (e - 1152)];
            cwl[e] = v; }
        mlstm_gates(F, U1, b, h, c, li, bc);
        write_raw128(F, 67, rq3, raw);
        __syncthreads();
        for (int it = F.tid; it < 1024; it += 512) { const int s = it & 63, d0 = (it >> 6) * 8;
            float y[8]; conv8_lds(raw, s, d0, cwl, cwl + 1024, y);
            uint4 o; o.x = pack2(siluf_(y[0]), siluf_(y[1])); o.y = pack2(siluf_(y[2]), siluf_(y[3])); o.z = pack2(siluf_(y[4]), siluf_(y[5])); o.w = pack2(siluf_(y[6]), siluf_(y[7]));
            *(uint4*)(q + s * 136 + d0) = o; }
        __syncthreads();
        write_raw128(F, 67, rk3, raw);
        __syncthreads();
        for (int it = F.tid; it < 1024; it += 512) { const int s = it & 63, d0 = (it >> 6) * 8;
            float y[8]; conv8_lds(raw, s, d0, cwl + 512, cwl + 1152, y);
            const float sc = 0.08838834764831845f; uint4 o;
            o.x = pack2(siluf_(y[0]) * sc, siluf_(y[1]) * sc); o.y = pack2(siluf_(y[2]) * sc, siluf_(y[3]) * sc); o.z = pack2(siluf_(y[4]) * sc, siluf_(y[5]) * sc); o.w = pack2(siluf_(y[6]) * sc, siluf_(y[7]) * sc);
            *(uint4*)(k + s * 136 + d0) = o; }
        __syncthreads();
        write_raw128(F, 64, rv3, raw);
        __syncthreads();
        for (int it = F.tid; it < 1024; it += 512) { const int s = it & 63, d0 = (it >> 6) * 8;
            const uint4 vv = *(const uint4*)(raw + s * 136 + d0); const unsigned wv[4] = {vv.x, vv.y, vv.z, vv.w};
#pragma unroll
            for (int i = 0; i < 8; ++i) vT[(d0 + i) * 72 + s] = (bf16_t)((i & 1) ? (wv[i >> 1] >> 16) : (wv[i >> 1] & 0xFFFFu)); }
#pragma unroll
        for (int j = 0; j < 4; ++j) { const int it = F.tid + j * 512; *(u32x4*)(CT + (it >> 4) * 136 + (it & 15) * 8) = rc4[j]; }
        if (unit + F.G < 2048) prefetch(unit + F.G);
        if (F.tid < 128) nin[F.tid] = nin_g[(size_t)unit * 128 + F.tid];
        if (F.tid >= 128 && F.tid < 192) { const int l = F.tid - 128;
            float pm = li[l] - bc[l];
            for (int o = 1; o < 64; o <<= 1) { const float n = __shfl_up(pm, o); if (l >= o) pm = fmaxf(pm, n); }
            mt[l] = bc[l] + fmaxf(m_in, pm); }
        __syncthreads();
        { const int l = F.tid >> 3, part = F.tid & 7; float a = 0.f;
#pragma unroll
          for (int d = 0; d < 16; ++d) a += bf2f(q[l * 136 + part * 16 + d]) * nin[part * 16 + d];
          a += __shfl_xor(a, 1); a += __shfl_xor(a, 2); a += __shfl_xor(a, 4);
          if (part == 0) dq[l] = a; }
        for (int tix = F.wave * 2; tix < F.wave * 2 + 2; ++tix) {
            const int lt = tix >> 2, st = tix & 3;
            const f32x4 a = mma16(q + lt * 16 * 136, 136, k + st * 16 * 136, 136, 128, F.lane);
            const int fr = F.lane & 15, fq = F.lane >> 4; const int s = st * 16 + fr;
#pragma unroll
            for (int r = 0; r < 4; ++r) { const int l = lt * 16 + 4 * fq + r;
                const float w = s <= l ? a[r] * expf(bc[l] - bc[s] + li[s] - mt[l]) : 0.f;
                W[l * 72 + s] = f2bf(w); }
        }
        __syncthreads();
        { const int l = F.tid >> 3, part = F.tid & 7; float a = 0.f;
#pragma unroll
          for (int s = 0; s < 8; ++s) a += bf2f(W[l * 72 + part * 8 + s]);
          a += __shfl_xor(a, 1); a += __shfl_xor(a, 2); a += __shfl_xor(a, 4);
          if (part == 0) rs[l] = a; }
        if (F.tid >= 64 && F.tid < 128) { const int l = F.tid - 64; li[l] = expf(bc[l] + m_in - mt[l]); }
        if (F.tid >= 128 && F.tid < 192) { const int l = F.tid - 128; wkk[l] = expf(-mt[l]); }
        __syncthreads();
        uint4 ro2[2], rz2[2];
#pragma unroll
        for (int j = 0; j < 2; ++j) { const int it = F.tid + j * 512; const size_t row = (size_t)b * SEQ + c * 64 + (it >> 4);
            ro2[j] = *(const uint4*)(U1 + row * LD1 + C_DO + h * 128 + (it & 15) * 8); rz2[j] = *(const uint4*)(U1 + row * LD1 + C_DZ + h * 128 + (it & 15) * 8); }
        f32x4 hres[4];
#pragma unroll
        for (int ti = 0; ti < 4; ++ti) { const int tix = F.wave * 4 + ti;
            const int lt = tix >> 3, et = tix & 7;
            const f32x4 qc = mma16(q + lt * 16 * 136, 136, CT + et * 16 * 136, 136, 128, F.lane);
            const f32x4 wv = mma16(W + lt * 16 * 72, 72, vT + et * 16 * 72, 72, 64, F.lane);
            const int fq = F.lane >> 4;
#pragma unroll
            for (int r = 0; r < 4; ++r) { const int l = lt * 16 + 4 * fq + r;
                const float prev = li[l];
                const float num = prev * qc[r] + wv[r];
                const float den = prev * dq[l] + rs[l];
                hres[ti][r] = num * __builtin_amdgcn_rcpf(fmaxf(fabsf(den), wkk[l])); }
        }
        __syncthreads();
#pragma unroll
        for (int ti = 0; ti < 4; ++ti) { const int tix = F.wave * 4 + ti; const int lt = tix >> 3, et = tix & 7; const int fr = F.lane & 15, fq = F.lane >> 4;
#pragma unroll
            for (int r = 0; r < 4; ++r) HT[(lt * 16 + 4 * fq + r) * 132 + et * 16 + fr] = hres[ti][r]; }
        __syncthreads();
#pragma unroll
        for (int j = 0; j < 2; ++j) { const int it = F.tid + j * 512; const int l = it >> 4, e0 = (it & 15) * 8;
            const size_t row = (size_t)b * SEQ + c * 64 + l;
            float of[8], zf[8]; unpack8(ro2[j], of); unpack8(rz2[j], zf);
            const f32x4 h0 = *(const f32x4*)(HT + l * 132 + e0), h1 = *(const f32x4*)(HT + l * 132 + e0 + 4);
            float y[8];
#pragma unroll
            for (int i = 0; i < 4; ++i) { y[i] = sigmoidf_(of[i]) * h0[i] * siluf_(zf[i]); y[4 + i] = sigmoidf_(of[4 + i]) * h1[i] * siluf_(zf[4 + i]); }
            uint4 o; o.x = pack2(y[0], y[1]); o.y = pack2(y[2], y[3]); o.z = pack2(y[4], y[5]); o.w = pack2(y[6], y[7]);
            *(uint4*)(Y + row * 1024 + 512 + h * 128 + e0) = o; }
        __syncthreads();
    }
}
DI void p8c_lru_out(const Frame& F) {
    const bf16_t* U1 = (const bf16_t*)(F.ws + WS_U);
    const bf16_t* LA = (const bf16_t*)(F.ws + WS_LRUA); const bf16_t* LH = (const bf16_t*)(F.ws + WS_LRUH);
    const float* Hin = (const float*)(F.ws + WS_HIN);
    bf16_t* Y = (bf16_t*)(F.ws + WS_BFA);
    const size_t n8 = (size_t)MT * 64;
    for (size_t it = (size_t)F.bid * 512 + F.tid; it < n8; it += (size_t)F.G * 512) {
        const size_t row = it >> 6; const int c0 = (int)(it & 63) * 8; const int b = (int)(row >> 12), t = (int)(row & 4095), c = t >> 6;
        const uint4 av = *(const uint4*)(LA + row * 512 + c0), hv = *(const uint4*)(LH + row * 512 + c0), zv = *(const uint4*)(U1 + row * LD1 + C_CZ + c0);
        float af[8], hf[8], zf[8]; unpack8(av, af); unpack8(hv, hf); unpack8(zv, zf);
        const float* hi = Hin + ((size_t)b * 64 + c) * 512 + c0; float y[8];
#pragma unroll
        for (int i = 0; i < 8; ++i) y[i] = (af[i] * hi[i] + hf[i]) * siluf_(zf[i]);
        uint4 o; o.x = pack2(y[0], y[1]); o.y = pack2(y[2], y[3]); o.z = pack2(y[4], y[5]); o.w = pack2(y[6], y[7]);
        *(uint4*)(Y + row * 1024 + c0) = o;
    }
}

constexpr int N_PHASES = 16;
__global__ void __launch_bounds__(512, 2) mk_fwd(Args args) {
    extern __shared__ __attribute__((aligned(16))) unsigned char smem[];
    Frame F;
    F.tid = threadIdx.x; F.lane = F.tid & 63; F.wave = __builtin_amdgcn_readfirstlane(F.tid >> 6);
    F.G = gridDim.x; F.bid = blockIdx.x; F.gw = F.bid * 8 + F.wave; F.nw = F.G * 8;
    F.lds = smem + LDS_WORK_OFF; F.ws = args.ws; F.out = args.out; F.ctl = (unsigned*)args.ws;
#pragma unroll
    for (int i = 0; i < 28; ++i) F.in[i] = args.in[i];
    LAS unsigned char* lsm = (LAS unsigned char*)smem;
    LAS unsigned char* lut = lsm + (LDS_BYTES - 12288);
    LAS float* tbl = (LAS float*)(lsm + (LDS_BYTES - 12288 + 256));
    LAS float* biasL = (LAS float*)(lsm + (LDS_BYTES - 8192));
    if (F.tid < 4) ((LAS unsigned*)lsm)[F.tid] = 0u;
    if (F.tid < 128) { const int n = F.tid; int bk;
        if (n < 16) bk = n; else { bk = 16; const int thr[15] = {19, 21, 24, 27, 31, 35, 40, 46, 52, 59, 67, 77, 87, 99, 113};
#pragma unroll
            for (int j = 0; j < 15; ++j) bk += (n >= thr[j]) ? 1 : 0; }
        lut[n] = (unsigned char)bk; }
    { const int hd = F.tid >> 5, bk = F.tid & 31; tbl[hd * 32 + bk] = args.in[6][bk * 16 + hd]; }
    F.lut = lut; F.tbl = tbl; F.biasL = biasL; F.ldsl = lsm + LDS_WORK_OFF;
    __syncthreads();
    for (int e = F.tid; e < 16 * 128; e += 512) { const int hd = e >> 7, n = e & 127; const int bk = n < 16 ? n : (n >= 113 ? 31 : (int)lut[n]); biasL[e] = tbl[hd * 32 + bk] * 1.4426950408889634f; }
    __syncthreads();
    const int lo = args.ph_lo, hi = args.ph_hi;
    XcdBarrier bar; bar.bar = F.ctl; bar.x = 0; bar.st = nullptr;
#if !MK_PER_PHASE
    bar = xcd_barrier_post(F.ctl, (volatile LAS unsigned*)lsm);
#endif
#ifndef PH_MASK
#define PH_MASK 0xFFFF
#endif
#define IN(k) (phase_refresh(F), ((PH_MASK >> (k)) & 1) && lo <= (k) && (k) < hi)
#ifndef DLY_LO
#define DLY_LO -1
#define DLY_HI -1
#endif
#ifndef DLY_MULT
#define DLY_MULT 4
#endif
    unsigned long long dly_t0 = 0ull;
#define DLY_START(k) do { if ((k) == DLY_LO && F.bid == 0 && F.tid == 0) dly_t0 = __builtin_amdgcn_s_memrealtime(); } while (0)
#define DLY_END(k) do { if ((k) == DLY_HI && F.bid == 0) { if (F.tid == 0) { const unsigned long long t1 = __builtin_amdgcn_s_memrealtime(); const unsigned long long until = t1 + DLY_MULT * (t1 - dly_t0); \
        while (__builtin_amdgcn_s_memrealtime() < until) __builtin_amdgcn_s_sleep(16); } __syncthreads(); } } while (0)
#if MK_PER_PHASE
#define SEAM(k) do { } while (0)
#else
#define SEAM(k) do { if (IN(k) && IN((k) + 1)) xcd_barrier(bar); DLY_END(k); DLY_START((k) + 1); } while (0)
#endif
    LAS unsigned char* glds = lsm + LDS_WORK_OFF;
    unsigned char* ws = args.ws;
    bf16_t* BFA = (bf16_t*)(ws + WS_BFA); bf16_t* BFB = (bf16_t*)(ws + WS_BFB); bf16_t* U = (bf16_t*)(ws + WS_U); bf16_t* Ef = (bf16_t*)(ws + WS_U);

    DLY_START(0);
    if (IN(0)) { p0_prologue(F); }
    SEAM(0);
    if (IN(1)) {
        pg8::Gemm g{BFA, (const bf16_t*)(ws + WS_WIN0), MT, LD0, 1024}; pg8::StaticOrder S; S.init(MT, LD0, F.G, F.bid);
        pg8::EpiBf16<0> E{U, LD0};
        pg8::gemm_phase(glds, g, S, E);
        pg8::Gemm g2{(const bf16_t*)(ws + WS_WVT), BFA, 512, MT, 1024}; pg8::StaticOrder S2; S2.init(512, MT, F.G, F.bid);
        pg8::EpiBf16<0> E2{(bf16_t*)(ws + WS_VT), MT};
        pg8::gemm_phase(glds, g2, S2, E2);
    }
    SEAM(1);
    if (IN(2)) { p2a_build_blocks(F); }
    SEAM(2);
    if (IN(3)) {
        if (F.bid < 32) {
            const int which = F.bid >> 4;
            pg8::Gemm g{(const bf16_t*)(ws + (which ? WS_AV : WS_AK)), (const bf16_t*)(ws + (which ? WS_WC1V : WS_WC1K)), 4096, 256, 2048}; pg8::StaticOrder S; S.init(4096, 256, F.G, F.bid & 15);
            pg8::EpiBf16<1> E{(bf16_t*)(ws + (which ? WS_HV : WS_HK)), 256}; pg8::gemm_phase(glds, g, S, E);
            asm volatile("s_waitcnt vmcnt(0)" ::: "memory"); __syncthreads();
            pg8::Unit u; S.next(0, u);
            p2c_compress_rows(F, which, u.pm * 256);
            __syncthreads();
        }
        att_dsa(F);
    }
    SEAM(3);
    if (IN(5)) { att_nsa(F); }
    if (IN(3) && IN(6)) xcd_barrier(bar);
    if (IN(6)) {
        pg8::Gemm g{BFB, (const bf16_t*)(ws + WS_WOUT0), MT, 1024, 1024}; pg8::StaticOrder S; S.init(MT, 1024, F.G, F.bid);
        pg8::EpiResid E{F.in[0], BFA};
        pg8::gemm_phase(glds, g, S, E);
    }
    SEAM(6);
    if (IN(7)) {
        { pg8::Gemm g{(const bf16_t*)(ws + WS_PBF), (const bf16_t*)(ws + WS_WP0), MT, 1024, 256}; pg8::StaticOrder S; S.init(MT, 1024, F.G, F.bid);
          pg8::EpiBf16<0> E{Ef, 1024}; pg8::gemm_phase(glds, g, S, E); }
        asm volatile("s_waitcnt vmcnt(0)" ::: "memory"); __syncthreads();
        { pg8::Gemm g{BFA, (const bf16_t*)(ws + WS_WG0), MT, 1024, 1024}; pg8::StaticOrder S; S.init(MT, 1024, F.G, F.bid);
          pg8::EpiGate E{F.out, BFA, Ef}; pg8::gemm_phase(glds, g, S, E); }
    }
    SEAM(7);
    if (IN(8)) { rmsnorm_rows<0>(F, F.out, F.in[2] + 1024, BFB, nullptr); }
    SEAM(8);
    if (IN(9)) {
        pg8::Gemm g{BFB, (const bf16_t*)(ws + WS_WIN1), MT, LD1, 1024}; pg8::StaticOrder S; S.init(MT, LD1, F.G, F.bid);
        pg8::EpiBf16<0> E{U, LD1};
        pg8::gemm_phase(glds, g, S, E);
    }
    SEAM(9);
    if (IN(10)) { p8a_mlstm_local(F); p8a_lru_local(F); }
    SEAM(10);
    if (IN(11)) { p8b_scans(F); }
    SEAM(11);
    if (IN(12)) { p8c_mlstm_out(F); p8c_lru_out(F); }
    SEAM(12);

    if (IN(13)) {
        pg8::Gemm g{BFA, (const bf16_t*)(ws + WS_WOUT1), MT, 1024, 1024}; pg8::StaticOrder S; S.init(MT, 1024, F.G, F.bid);
        pg8::EpiResid E{F.out, BFB};
        pg8::gemm_phase(glds, g, S, E);
    }
    SEAM(13);
    if (IN(14)) {
        { pg8::Gemm g{(const bf16_t*)(ws + WS_PBF) + (size_t)MT * 256, (const bf16_t*)(ws + WS_WP1), MT, 1024, 256}; pg8::StaticOrder S; S.init(MT, 1024, F.G, F.bid);
          pg8::EpiBf16<0> E{Ef, 1024}; pg8::gemm_phase(glds, g, S, E); }
        asm volatile("s_waitcnt vmcnt(0)" ::: "memory"); __syncthreads();
        { pg8::Gemm g{BFB, (const bf16_t*)(ws + WS_WG1), MT, 1024, 1024}; pg8::StaticOrder S; S.init(MT, 1024, F.G, F.bid);
          pg8::EpiGate E{F.out, BFB, Ef}; pg8::gemm_phase(glds, g, S, E); }
    }
    SEAM(14);
    if (IN(15)) { rmsnorm_rows<1>(F, F.out, F.in[3], nullptr, F.out); }
#undef IN
#undef SEAM
}

extern "C" void kernel_launch(void* const* d_in, const int* in_sizes, int n_in, void* d_out, int out_size, void* d_ws, size_t ws_size, hipStream_t stream) {
    static int grid = 0;
    if (grid == 0) {
        if (n_in != 28 || out_size != MT * DM || ws_size < WS_END) { fprintf(stderr, "kernel_launch: unexpected shapes (n_in %d, out %d, ws %zu < %zu)\n", n_in, out_size, ws_size, (size_t)WS_END); grid = -1; return; }
        int dev = 0, cus = 0, per_cu = 0;
        if (hipGetDevice(&dev) != hipSuccess || hipDeviceGetAttribute(&cus, hipDeviceAttributeMultiprocessorCount, dev) != hipSuccess) { grid = -1; return; }
        if (hipFuncSetAttribute((const void*)mk_fwd, hipFuncAttributeMaxDynamicSharedMemorySize, LDS_BYTES) != hipSuccess) { fprintf(stderr, "kernel_launch: hipFuncSetAttribute failed\n"); grid = -1; return; }
        if (hipOccupancyMaxActiveBlocksPerMultiprocessor(&per_cu, (const void*)mk_fwd, 512, LDS_BYTES) != hipSuccess || per_cu < 1)
            fprintf(stderr, "kernel_launch: occupancy query reports %d workgroups per CU\n", per_cu);
        (void)hipGetLastError();
        grid = cus;
    }
    if (grid < 0) return;
    if (hipMemsetAsync(d_ws, 0, CTL_BYTES, stream) != hipSuccess) return;
    Args a{};
    for (int i = 0; i < 28; ++i) a.in[i] = (const float*)d_in[i];
    a.out = (float*)d_out; a.ws = (unsigned char*)d_ws;
#if MK_PER_PHASE
    for (int p = 0; p < N_PHASES; ++p) { a.ph_lo = p; a.ph_hi = p + 1; hipLaunchKernelGGL(mk_fwd, dim3(grid), dim3(512), LDS_BYTES, stream, a); }
#else
    a.ph_lo = 0; a.ph_hi = N_PHASES;
    hipLaunchKernelGGL(mk_fwd, dim3(grid), dim3(512), LDS_BYTES, stream, a);
#endif
}
```

```cpp
#include <hip/hip_runtime.h>
#include <cstdio>
#include <cstdint>

#ifndef MK_PER_PHASE
#define MK_PER_PHASE 0
#endif

#define LAS __attribute__((address_space(3)))
typedef unsigned short bf16_t;
typedef short bf16x8 __attribute__((ext_vector_type(8)));
typedef float f32x4 __attribute__((ext_vector_type(4)));
#define DI __device__ __forceinline__

constexpr int NB = 8, SEQ = 4096, DM = 1024, MT = NB * SEQ;
constexpr int LD0 = 3072, LD1 = 3584;
constexpr int C_AQ = 0, C_KC = 512, C_VC = 640, C_KS = 768, C_KW = 896, C_AZ = 1024, C_BQ = 1536, C_BZ = 2048,
              C_BK = 2560, C_BKI = 2624, C_BQI = 2688, C_AG = 2944, C_BWI = 2968;
constexpr int C_VS = 0, C_VW = 0, C_BV = 0;
constexpr int C_CX = 0, C_CZ = 512, C_DQ = 1024, C_DK = 1536, C_DV = 2048, C_DO = 2560, C_DZ = 3072;
constexpr int NCMP = 255;
constexpr float NEG_INF = -__builtin_inff();

DI int map0(int n) {
    if (n < 896) return n;
    if (n < 1024) return 1024 + (n - 896);
    if (n < 1536) return 1304 + (n - 1024);
    if (n < 2048) return 1816 + (n - 1536);
    if (n < 2560) return 2780 + (n - 2048);
    if (n < 2624) return 2328 + (n - 2560);
    if (n < 2688) return 2712 + (n - 2624);
    if (n < 2944) return 2456 + (n - 2688);
    if (n < 2968) return 1280 + (n - 2944);
    if (n < 2972) return 2776 + (n - 2968);
    return -1;
}
DI int map1(int n) {
    if (n < 2560) return n;
    if (n < 3072) return 2568 + (n - 2560);
    if (n < 3584) return 3080 + (n - 3072);
    return -1;
}
DI int mapid(int n) { return n; }
DI int mapv(int f) { return f < 128 ? 896 + f : (f < 256 ? 1152 + (f - 128) : (f < 320 ? 2392 + (f - 256) : -1)); }

constexpr size_t CTL_BYTES = 16384;
constexpr size_t WS_WIN0  = CTL_BYTES;
constexpr size_t WS_WOUT0 = WS_WIN0  + (size_t)LD0 * 1024 * 2;
constexpr size_t WS_WG0   = WS_WOUT0 + (size_t)1024 * 1024 * 2;
constexpr size_t WS_WP0   = WS_WG0   + (size_t)1024 * 1024 * 2;
constexpr size_t WS_WIN1  = WS_WP0   + (size_t)1024 * 256 * 2;
constexpr size_t WS_WOUT1 = WS_WIN1  + (size_t)LD1 * 1024 * 2;
constexpr size_t WS_WG1   = WS_WOUT1 + (size_t)1024 * 1024 * 2;
constexpr size_t WS_WP1   = WS_WG1   + (size_t)1024 * 1024 * 2;
constexpr size_t WS_WC1K  = WS_WP1   + (size_t)1024 * 256 * 2;
constexpr size_t WS_WC1V  = WS_WC1K  + (size_t)256 * 2048 * 2;
constexpr size_t WS_WVT   = WS_WC1V  + (size_t)256 * 2048 * 2;
constexpr size_t WS_BFA   = WS_WVT   + (size_t)512 * 1024 * 2;
constexpr size_t WS_BFB   = WS_BFA   + (size_t)MT * 1024 * 2;
constexpr size_t WS_PBF   = WS_BFB   + (size_t)MT * 1024 * 2;
constexpr size_t WS_U     = WS_PBF   + (size_t)2 * MT * 256 * 2;
constexpr size_t WS_X     = WS_U     + (size_t)MT * LD1 * 2;
constexpr size_t WS_AK    = WS_X;
constexpr size_t WS_AV    = WS_AK    + (size_t)4096 * 2048 * 2;
constexpr size_t WS_HK    = WS_AV    + (size_t)4096 * 2048 * 2;
constexpr size_t WS_HV    = WS_HK    + (size_t)4096 * 256 * 2;
constexpr size_t WS_LRUA  = WS_X;
constexpr size_t WS_LRUH  = WS_LRUA  + (size_t)MT * 512 * 2;
constexpr size_t WS_S     = WS_X     + (size_t)64 * 1024 * 1024;
constexpr size_t WS_KCMP  = WS_S;
constexpr size_t WS_VCMP  = WS_KCMP  + (size_t)16 * 256 * 64 * 4;
constexpr size_t WS_AEND  = WS_VCMP  + (size_t)16 * 256 * 64 * 4;
constexpr size_t WS_HEND  = WS_AEND  + (size_t)8 * 64 * 512 * 4;
constexpr size_t WS_HIN   = WS_HEND  + (size_t)8 * 64 * 512 * 4;
constexpr size_t WS_ZLOC  = WS_HIN   + (size_t)8 * 64 * 512 * 4;
constexpr size_t WS_NIN   = WS_ZLOC  + (size_t)2048 * 128 * 4;
constexpr size_t WS_SCAL  = WS_NIN   + (size_t)2048 * 128 * 4;
constexpr size_t WS_VCT   = WS_SCAL  + (size_t)3 * 2048 * 4;
constexpr size_t WS_WAT   = WS_VCT   + (size_t)16 * 64 * 256 * 2;
constexpr size_t WS_WXT   = WS_WAT   + (size_t)8 * 64 * 64 * 2;
constexpr size_t WS_GATES = WS_WXT   + (size_t)8 * 64 * 64 * 2;
constexpr size_t WS_END   = WS_GATES + (size_t)MT * 8 * 4;
constexpr size_t WS_VT    = WS_U     + (size_t)MT * LD0 * 2;
static_assert(WS_VT + (size_t)512 * MT * 2 <= WS_X, "VT region");
static_assert(WS_HV + (size_t)4096 * 256 * 2 <= WS_S, "compress region");
static_assert(WS_LRUH + (size_t)MT * 512 * 2 <= WS_S, "lru region");

constexpr int XCD_BAR_WORDS_C = 3456;
constexpr int CW_QNSA = 3520, CW_QDSA = 3584;
constexpr int CW_CMPDONE = 3648;

constexpr int LDS_BYTES = 147456;
constexpr int LDS_CTL_OFF = 0;
constexpr int LDS_WORK_OFF = 128;

DI float bf2f(bf16_t v) { return __uint_as_float(((unsigned)v) << 16); }
DI bf16_t f2bf(float f) { unsigned u = __float_as_uint(f); u += 0x7FFFu + ((u >> 16) & 1u); return (bf16_t)(u >> 16); }
typedef __bf16 bf16v2 __attribute__((ext_vector_type(2)));
typedef float f32x2 __attribute__((ext_vector_type(2)));
DI unsigned pack2(float lo, float hi) { const f32x2 v = {lo, hi}; return __builtin_bit_cast(unsigned, __builtin_convertvector(v, bf16v2)); }
DI float fexp_(float x) { return __builtin_amdgcn_exp2f(x * 1.4426950408889634f); }
DI float sigmoidf_(float x) { return __builtin_amdgcn_rcpf(1.0f + fexp_(-x)); }
DI float siluf_(float x) { return x * __builtin_amdgcn_rcpf(1.0f + fexp_(-x)); }
DI float wave_max(float v) { for (int o = 32; o >= 1; o >>= 1) v = fmaxf(v, __shfl_xor(v, o)); return v; }
DI float wave_sum(float v) { for (int o = 32; o >= 1; o >>= 1) v += __shfl_xor(v, o); return v; }
DI void unpack8(const uint4& v, float (&f)[8]) {
    f[0] = __uint_as_float(v.x << 16); f[1] = __uint_as_float(v.x & 0xFFFF0000u);
    f[2] = __uint_as_float(v.y << 16); f[3] = __uint_as_float(v.y & 0xFFFF0000u);
    f[4] = __uint_as_float(v.z << 16); f[5] = __uint_as_float(v.z & 0xFFFF0000u);
    f[6] = __uint_as_float(v.w << 16); f[7] = __uint_as_float(v.w & 0xFFFF0000u);
}

#define XB_TMO      128
#define XB_XCNT(j)  (256  + 64 * (j))
#define XB_XSUB(j)  (1280 + 64 * (j))
#define XB_XGEN(j)  (2304 + 64 * (j))
#define XB_TOP      3328
#define XB_TOPGEN   3392
#define XCD_BAR_WORDS 3456
#define XB_SPIN_CAP (1u << 22)
static_assert(XCD_BAR_WORDS == XCD_BAR_WORDS_C, "bar words");

__device__ __forceinline__ unsigned xb_ld(unsigned* p)              { return __hip_atomic_load(p, __ATOMIC_RELAXED, __HIP_MEMORY_SCOPE_AGENT); }
__device__ __forceinline__ unsigned xb_add(unsigned* p, unsigned v) { return __hip_atomic_fetch_add(p, v, __ATOMIC_RELAXED, __HIP_MEMORY_SCOPE_AGENT); }
__device__ __forceinline__ unsigned xb_xcc_id() { return (unsigned)__builtin_amdgcn_s_getreg((3 << 11) | 20) & 0xFu; }
#define XB_SPIN(cond, bar) do { unsigned _sp = 0; while (cond) { __builtin_amdgcn_s_sleep(1); \
    if ((++_sp & 255u) == 0u) { if (xb_ld(&(bar)[XB_TMO])) break; if (_sp > XB_SPIN_CAP) { atomicAdd(&(bar)[XB_TMO], 1u); break; } } } } while (0)

struct XcdBarrier { unsigned* bar; unsigned x; volatile LAS unsigned* st; };

__device__ __forceinline__ XcdBarrier xcd_barrier_post(unsigned* bar, volatile LAS unsigned* st) {
    XcdBarrier b; b.bar = bar; b.x = xb_xcc_id(); b.st = st;
    if (threadIdx.x == 0) (void)xb_add(&bar[XB_XCNT(b.x)], 1u);
    return b;
}
__device__ __forceinline__ void xcd_barrier_complete(unsigned* bar, unsigned x, unsigned& nloc, unsigned& nx) {
    const unsigned G = gridDim.x * gridDim.y * gridDim.z;
    unsigned sum, cnt, mine, sp = 0u;
    for (;;) {
        sum = 0u; cnt = 0u; mine = 0u;
#pragma unroll
        for (unsigned j = 0; j < 16; ++j) { const unsigned c = xb_ld(&bar[XB_XCNT(j)]); sum += c; cnt += (c > 0u) ? 1u : 0u; mine = (j == x) ? c : mine; }
        if (sum == G) break;
        __builtin_amdgcn_s_sleep(1);
        if ((++sp & 255u) == 0u) { if (xb_ld(&bar[XB_TMO])) break; if (sp > XB_SPIN_CAP) { atomicAdd(&bar[XB_TMO], 1u); break; } }
    }
    nloc = mine > 0u ? mine : 1u; nx = cnt > 0u ? cnt : 1u;
}
__device__ __forceinline__ void xcd_barrier(const XcdBarrier& b) {
    asm volatile("s_waitcnt vmcnt(0)" ::: "memory");
    __syncthreads();
    if (threadIdx.x == 0) {
        unsigned* bar = b.bar;
        __builtin_amdgcn_s_waitcnt(0);
        unsigned nloc = b.st[0], nx = b.st[1];
        if (nloc == 0u) { xcd_barrier_complete(bar, b.x, nloc, nx); b.st[0] = nloc; b.st[1] = nx; }
        const unsigned old = xb_add(&bar[XB_XSUB(b.x)], 1u);
        const unsigned gen = old / nloc;
        if (old + 1u == (gen + 1u) * nloc) {
            __builtin_amdgcn_fence(__ATOMIC_RELEASE, "agent");
            asm volatile("s_waitcnt vmcnt(0)" ::: "memory");
            const unsigned og = xb_add(&bar[XB_TOP], 1u);
            const unsigned tg = og / nx;
            if (og + 1u == (tg + 1u) * nx) xb_add(&bar[XB_TOPGEN], 1u);
            else XB_SPIN(xb_ld(&bar[XB_TOPGEN]) == tg, bar);
            __builtin_amdgcn_fence(__ATOMIC_ACQUIRE, "agent");
            xb_add(&bar[XB_XGEN(b.x)], 1u);
            asm volatile("s_waitcnt vmcnt(0)" ::: "memory");
        } else {
            XB_SPIN(xb_ld(&bar[XB_XGEN(b.x)]) == gen, bar);
            __builtin_amdgcn_fence(__ATOMIC_ACQUIRE, "agent");
            asm volatile("s_waitcnt vmcnt(0)" ::: "memory");
        }
    }
    __syncthreads();
}

namespace pg8 {
constexpr int BM = 256, BK = 64, HALF = 128, HTB = HALF * BK * 2, STAGE_BYTES = 8 * HTB, NXCD = 8, WGM = 8;
__host__ __device__ __forceinline__ int lds_byte(int r, int c) { const int st = (r >> 4) * 2 + (c >> 5), rr = r & 15, cc = c & 31, ob = rr * 64 + cc * 2; return st * 1024 + (ob ^ (((ob >> 9) & 1) << 5)); }
__host__ __device__ __forceinline__ void stage_rc(int b, int& R, int& C) { const int st = b / 1024, sb = b % 1024, swz = sb ^ (((sb >> 9) & 1) << 5); R = (st >> 1) * 16 + swz / 64; C = (st & 1) * 32 + (swz % 64) / 2; }
__host__ __device__ __forceinline__ int perm32(int rho) { const int n = rho >> 4, i = rho & 15; return 8 * (i >> 2) + 4 * n + (i & 3); }
struct Unit { int pm, pn; };
struct Gemm { const bf16_t* A; const bf16_t* Bt; int M, N, K; };
struct StaticOrder {
    int nM, nN, nwg, G, c;
    __host__ __device__ __forceinline__ void init(int M, int N, int G_, int c_) { nM = M / BM; nN = N / BM; nwg = nM * nN; G = G_; c = c_; }
    __host__ __device__ __forceinline__ bool next(int i, Unit& u) const {
        const long L = (long)i * G + c; if (L >= nwg) return false;
        int wgid = (int)L; { const int q = nwg / NXCD, r = nwg % NXCD, xcd = wgid % NXCD, off = wgid / NXCD; wgid = (xcd < r ? xcd * (q + 1) : r * (q + 1) + (xcd - r) * q) + off; }
        const int nig = WGM * nN, gid = wgid / nig, fm = gid * WGM, gsz = (nM - fm) < WGM ? (nM - fm) : WGM;
        u.pm = fm + ((wgid % nig) % gsz); u.pn = (wgid % nig) / gsz; return true;
    }
    __device__ __forceinline__ void a_ready(const Unit&) const {}
    __device__ __forceinline__ void done(const Unit&) const {}
};
template <class Epi, class Sched>
__device__ __forceinline__ void gemm_phase(LAS unsigned char* lds, const Gemm g, const Sched& S, const Epi& E) {
    int tid_ = threadIdx.x; asm volatile("" : "+v"(tid_));
    const int tid = tid_, wid = __builtin_amdgcn_readfirstlane(tid >> 6), lane = tid & 63, wr = wid >> 2, wc = wid & 3, fr = lane & 15, fq = lane >> 4;
    const int K = g.K, nt = K / BK;
    unsigned voffA[2], voffB[2];
#pragma unroll
    for (int i = 0; i < 2; ++i) { int R, C; stage_rc(tid * 16 + i * 8192, R, C); const int Rb = Epi::PERM ? ((R & ~31) + perm32(R & 31)) : R;
        voffA[i] = (unsigned)(R * K + C) * 2u; voffB[i] = (unsigned)(Rb * K + C) * 2u; }
    const size_t kstep = (size_t)(BK * 2);
    const size_t hstep = (size_t)HALF * K * 2;
    const size_t tstep = 2 * hstep;
    const unsigned ldsw = (unsigned)wid * 1024u;
    const int aoff = lds_byte(wr * 64 + fr, fq * 8), boff = lds_byte(wc * 32 + fr, fq * 8);
#define PG8_SA(b, h) (((b) * 2 + (h)) * HTB)
#define PG8_SB(b, h) ((4 + (b) * 2 + (h)) * HTB)
#define PG8_STAGE(bufoff, gbase, voff) do { _Pragma("unroll") for (int _i = 0; _i < 2; ++_i) \
        __builtin_amdgcn_global_load_lds((const unsigned*)((const char*)(gbase) + (voff)[_i]), (LAS unsigned*)(lds + (bufoff) + ldsw + _i * 8192), 16, 0, 0); } while (0)
#define PG8_LDA(dst, b, h) do { _Pragma("unroll") for (int m = 0; m < 4; ++m) _Pragma("unroll") for (int k = 0; k < 2; ++k) dst[m][k] = *(const LAS bf16x8*)(lds + PG8_SA(b, h) + aoff + m * 2048 + k * 1024); } while (0)
#define PG8_LDB(dst, b, h) do { _Pragma("unroll") for (int n = 0; n < 2; ++n) _Pragma("unroll") for (int k = 0; k < 2; ++k) dst[n][k] = *(const LAS bf16x8*)(lds + PG8_SB(b, h) + boff + n * 2048 + k * 1024); } while (0)
#define PG8_MMA(ai, bj, At, Bt) do { __builtin_amdgcn_s_setprio(1); _Pragma("unroll") for (int m = 0; m < 4; ++m) _Pragma("unroll") for (int n = 0; n < 2; ++n) _Pragma("unroll") for (int k = 0; k < 2; ++k) \
        acc[ai][bj][m][n] = __builtin_amdgcn_mfma_f32_16x16x32_bf16(Bt[n][k], At[m][k], acc[ai][bj][m][n], 0, 0, 0); __builtin_amdgcn_s_setprio(0); } while (0)
#define PG8_WAIT_V(n) asm volatile("s_waitcnt vmcnt(" #n ")" ::: "memory")
#define PG8_WAIT_L(n) asm volatile("s_waitcnt lgkmcnt(" #n ")" ::: "memory")
#define PG8_BAR __builtin_amdgcn_s_barrier()
#define PG8_SCHED __builtin_amdgcn_sched_barrier(0)
    Unit cur, nxt; int ui = 0;
    if (!S.next(0, cur)) return;
    f32x4 acc[2][2][4][2];
#pragma unroll
    for (int a = 0; a < 2; ++a)
#pragma unroll
        for (int b = 0; b < 2; ++b)
#pragma unroll
            for (int m = 0; m < 4; ++m)
#pragma unroll
                for (int n = 0; n < 2; ++n) acc[a][b][m][n] = (f32x4){0.f, 0.f, 0.f, 0.f};
    bf16x8 At[4][2], B0[2][2], B1[2][2];
    const char* cA = (const char*)g.A + (size_t)cur.pm * tstep; const char* cB = (const char*)g.Bt + (size_t)cur.pn * tstep;
    S.a_ready(cur);
    PG8_STAGE(PG8_SB(0, 0), cB, voffB); PG8_STAGE(PG8_SA(0, 0), cA, voffA); PG8_STAGE(PG8_SB(0, 1), cB + hstep, voffB); PG8_STAGE(PG8_SA(0, 1), cA + hstep, voffA);
    if (wr == 1) PG8_BAR;
    PG8_WAIT_V(4); PG8_BAR;
    PG8_STAGE(PG8_SB(1, 0), cB + kstep, voffB); PG8_STAGE(PG8_SA(1, 0), cA + kstep, voffA); PG8_STAGE(PG8_SB(1, 1), cB + hstep + kstep, voffB);
    PG8_WAIT_V(6); PG8_BAR;
    for (;;) {
        const bool has_next = S.next(ui + 1, nxt);
        const char* nA = has_next ? (const char*)g.A + (size_t)nxt.pm * tstep : cA; const char* nB = has_next ? (const char*)g.Bt + (size_t)nxt.pn * tstep : cB;
        for (int t = 0; t < nt; t += 2) {
            const bool last = (t == nt - 2);
            const char* a1 = cA + (size_t)(t + 1) * kstep;
            const char* a2 = last ? nA : cA + (size_t)(t + 2) * kstep; const char* b2 = last ? nB : cB + (size_t)(t + 2) * kstep;
            const char* a3 = a2 + kstep; const char* b3 = b2 + kstep;
            if (last && has_next) S.a_ready(nxt);
            PG8_LDB(B0, 0, 0); PG8_SCHED; PG8_LDA(At, 0, 0); PG8_STAGE(PG8_SA(1, 1), a1 + hstep, voffA);
            PG8_WAIT_L(8); PG8_BAR; PG8_WAIT_L(0); PG8_MMA(0, 0, At, B0); PG8_BAR; PG8_SCHED;
            PG8_LDB(B1, 0, 1); PG8_STAGE(PG8_SB(0, 0), b2, voffB);
            PG8_BAR; PG8_WAIT_L(0); PG8_MMA(0, 1, At, B1); PG8_BAR;
            PG8_LDA(At, 0, 1); PG8_STAGE(PG8_SA(0, 0), a2, voffA);
            PG8_BAR; PG8_WAIT_L(0); PG8_MMA(1, 0, At, B0); PG8_BAR; PG8_SCHED;
            PG8_STAGE(PG8_SB(0, 1), b2 + hstep, voffB);
            PG8_WAIT_V(6); PG8_BAR; PG8_MMA(1, 1, At, B1); PG8_BAR;
            PG8_LDB(B0, 1, 0); PG8_SCHED; PG8_LDA(At, 1, 0); PG8_STAGE(PG8_SA(0, 1), a2 + hstep, voffA);
            PG8_WAIT_L(8); PG8_BAR; PG8_WAIT_L(0); PG8_MMA(0, 0, At, B0); PG8_BAR; PG8_SCHED;
            PG8_LDB(B1, 1, 1); PG8_STAGE(PG8_SB(1, 0), b3, voffB);
            PG8_BAR; PG8_WAIT_L(0); PG8_MMA(0, 1, At, B1); PG8_BAR;
            PG8_LDA(At, 1, 1); PG8_STAGE(PG8_SA(1, 0), a3, voffA);
            PG8_BAR; PG8_WAIT_L(0); PG8_MMA(1, 0, At, B0); PG8_BAR; PG8_SCHED;
            PG8_STAGE(PG8_SB(1, 1), b3 + hstep, voffB);
            PG8_WAIT_V(6); PG8_BAR; PG8_MMA(1, 1, At, B1); PG8_BAR;
        }
        E(acc, cur, wr, wc, fr, fq); S.done(cur);
        if (!has_next) break;
#pragma unroll
        for (int a = 0; a < 2; ++a)
#pragma unroll
            for (int b = 0; b < 2; ++b)
#pragma unroll
                for (int m = 0; m < 4; ++m)
#pragma unroll
                    for (int n = 0; n < 2; ++n) acc[a][b][m][n] = (f32x4){0.f, 0.f, 0.f, 0.f};
        cur = nxt; cA = nA; cB = nB; ++ui;
    }
    PG8_WAIT_V(0);
    if (wr == 0) PG8_BAR;
    PG8_BAR;
#undef PG8_SA
#undef PG8_SB
#undef PG8_STAGE
#undef PG8_LDA
#undef PG8_LDB
#undef PG8_MMA
#undef PG8_WAIT_V
#undef PG8_WAIT_L
#undef PG8_BAR
#undef PG8_SCHED
}

template <int ACT  > struct EpiBf16 {
    static constexpr bool PERM = true;
    bf16_t* O; int ldc;
    __device__ __forceinline__ void operator()(const f32x4 (&acc)[2][2][4][2], const Unit& u, int wr, int wc, int fr, int fq) const {
        const int row0 = u.pm * BM + wr * 64 + fr, col0 = u.pn * BM + wc * 32 + 8 * fq;
#pragma unroll
        for (int ai = 0; ai < 2; ++ai)
#pragma unroll
            for (int m = 0; m < 4; ++m) { bf16_t* rowp = O + (size_t)(row0 + ai * HALF + m * 16) * ldc + col0;
#pragma unroll
                for (int bj = 0; bj < 2; ++bj) { f32x4 v0 = acc[ai][bj][m][0], v1 = acc[ai][bj][m][1];
                    if (ACT == 1) { for (int i = 0; i < 4; ++i) { v0[i] = siluf_(v0[i]); v1[i] = siluf_(v1[i]); } }
                    uint4 o; o.x = pack2(v0[0], v0[1]); o.y = pack2(v0[2], v0[3]); o.z = pack2(v1[0], v1[1]); o.w = pack2(v1[2], v1[3]);
                    *(uint4*)(rowp + bj * HALF) = o; } }
    }
};
struct EpiF32 {
    static constexpr bool PERM = false;
    float* C; int ldc;
    __device__ __forceinline__ void operator()(const f32x4 (&acc)[2][2][4][2], const Unit& u, int wr, int wc, int fr, int fq) const {
        const int row0 = u.pm * BM + wr * 64 + fr, col0 = u.pn * BM + wc * 32 + 4 * fq;
#pragma unroll
        for (int ai = 0; ai < 2; ++ai)
#pragma unroll
            for (int m = 0; m < 4; ++m) { float* rowp = C + (size_t)(row0 + ai * HALF + m * 16) * ldc + col0;
#pragma unroll
                for (int bj = 0; bj < 2; ++bj)
#pragma unroll
                    for (int n = 0; n < 2; ++n) *(f32x4*)(rowp + bj * HALF + n * 16) = acc[ai][bj][m][n]; }
    }
};
template <int IN_BF16> struct EpiResid {
    static constexpr bool PERM = true;
    const float* Xi; const bf16_t* Xib; bf16_t* Ob;
    __device__ __forceinline__ void operator()(const f32x4 (&acc)[2][2][4][2], const Unit& u, int wr, int wc, int fr, int fq) const {
        const int row0 = u.pm * BM + wr * 64 + fr, col0 = u.pn * BM + wc * 32 + 8 * fq;
#pragma unroll
        for (int ai = 0; ai < 2; ++ai)
#pragma unroll
            for (int m = 0; m < 4; ++m) { const size_t ro = (size_t)(row0 + ai * HALF + m * 16) * 1024 + col0;
#pragma unroll
                for (int bj = 0; bj < 2; ++bj) { const size_t o = ro + bj * HALF;
                    f32x4 x0, x1;
                    if (IN_BF16) { const uint4 xv = *(const uint4*)(Xib + o); float xf[8]; unpack8(xv, xf); x0 = (f32x4){xf[0], xf[1], xf[2], xf[3]}; x1 = (f32x4){xf[4], xf[5], xf[6], xf[7]}; }
                    else { x0 = *(const f32x4*)(Xi + o); x1 = *(const f32x4*)(Xi + o + 4); }
                    const f32x4 v0 = x0 + acc[ai][bj][m][0], v1 = x1 + acc[ai][bj][m][1];
                    uint4 pk; pk.x = pack2(v0[0], v0[1]); pk.y = pack2(v0[2], v0[3]); pk.z = pack2(v1[0], v1[1]); pk.w = pack2(v1[2], v1[3]); *(uint4*)(Ob + o) = pk; } }
    }
};
template <int OUT_BF16> struct EpiGate {
    static constexpr bool PERM = true;
    float* X; bf16_t* Xb; const bf16_t* R; const bf16_t* E;
    __device__ __forceinline__ void operator()(const f32x4 (&acc)[2][2][4][2], const Unit& u, int wr, int wc, int fr, int fq) const {
        const int row0 = u.pm * BM + wr * 64 + fr, col0 = u.pn * BM + wc * 32 + 8 * fq;
#pragma unroll
        for (int ai = 0; ai < 2; ++ai)
#pragma unroll
            for (int m = 0; m < 4; ++m) { const size_t ro = (size_t)(row0 + ai * HALF + m * 16) * 1024 + col0;
#pragma unroll
                for (int bj = 0; bj < 2; ++bj) { const size_t o = ro + bj * HALF;
                    const uint4 ev = *(const uint4*)(E + o), rv = *(const uint4*)(R + o); float ef[8], rf[8]; unpack8(ev, ef); unpack8(rv, rf);
                    float v[8];
#pragma unroll
                    for (int n = 0; n < 2; ++n)
#pragma unroll
                        for (int i = 0; i < 4; ++i) v[4 * n + i] = rf[4 * n + i] + ef[4 * n + i] * sigmoidf_(acc[ai][bj][m][n][i]);
                    if (OUT_BF16) { uint4 pk; pk.x = pack2(v[0], v[1]); pk.y = pack2(v[2], v[3]); pk.z = pack2(v[4], v[5]); pk.w = pack2(v[6], v[7]); *(uint4*)(Xb + o) = pk; }
                    else { *(f32x4*)(X + o) = (f32x4){v[0], v[1], v[2], v[3]}; *(f32x4*)(X + o + 4) = (f32x4){v[4], v[5], v[6], v[7]}; } } }
    }
};
}

struct Args { const float* in[28]; float* out; unsigned char* ws; int ph_lo, ph_hi; };

struct Frame {
    int tid, lane, wave, G, bid, gw, nw;
    unsigned char* lds;
    unsigned* ctl;
    const float* in[28]; float* out; unsigned char* ws;
    const LAS unsigned char* lut;
    const LAS float* tbl;
    const LAS float* biasL;
    LAS unsigned char* ldsl;
};
DI int t5b(const Frame& F, int n) { return n < 16 ? n : (n >= 113 ? 31 : (int)F.lut[n]); }

DI bool phase_refresh(Frame& F) { int t_ = threadIdx.x; asm volatile("" : "+v"(t_)); F.tid = t_; F.lane = t_ & 63; return true; }
struct TDesc { const float* src; bf16_t* dst; int K, Nsrc, Npad, mapk, ntiles; };
DI int tmap(int kind, int n) { return kind == 0 ? n : (kind == 1 ? map0(n) : (kind == 2 ? map1(n) : mapv(n))); }
DI void transpose_all(const Frame& F) {
    unsigned char* ws = F.ws;
    float* tile = (float*)F.lds;
    TDesc D[11];
    D[0] = TDesc{F.in[7], (bf16_t*)(ws + WS_WIN0), 1024, 3292, LD0, 1, 0};
    D[1] = TDesc{F.in[7], (bf16_t*)(ws + WS_WVT), 1024, 3292, 512, 3, 0};
    D[2] = TDesc{F.in[8], (bf16_t*)(ws + WS_WOUT0), 1024, 1024, 1024, 0, 0};
    D[3] = TDesc{F.in[5], (bf16_t*)(ws + WS_WG0), 1024, 1024, 1024, 0, 0};
    D[4] = TDesc{F.in[5] + (size_t)1024 * 1024, (bf16_t*)(ws + WS_WG1), 1024, 1024, 1024, 0, 0};
    D[5] = TDesc{F.in[4], (bf16_t*)(ws + WS_WP0), 256, 1024, 1024, 0, 0};
    D[6] = TDesc{F.in[4] + (size_t)256 * 1024, (bf16_t*)(ws + WS_WP1), 256, 1024, 1024, 0, 0};
    D[7] = TDesc{F.in[15], (bf16_t*)(ws + WS_WIN1), 1024, 3592, LD1, 2, 0};
    D[8] = TDesc{F.in[16], (bf16_t*)(ws + WS_WOUT1), 1024, 1024, 1024, 0, 0};
    D[9] = TDesc{F.in[10], (bf16_t*)(ws + WS_WC1K), 2048, 256, 256, 0, 0};
    D[10] = TDesc{F.in[13], (bf16_t*)(ws + WS_WC1V), 2048, 256, 256, 0, 0};
    int total = 0;
#pragma unroll
    for (int i = 0; i < 11; ++i) { D[i].ntiles = (D[i].Npad / 64) * (D[i].K / 64); total += D[i].ntiles; }
    float rg[8];
    auto locate = [&](int tix, TDesc& d, int& nt, int& kt) { int rem = tix;
#pragma unroll
        for (int i = 0; i < 11; ++i) { if (rem >= 0 && rem < D[i].ntiles) { d = D[i]; const int ntk = d.K / 64; nt = rem / ntk; kt = rem % ntk; rem = -1; } else if (rem >= 0) rem -= D[i].ntiles; } };
    auto load = [&](int tix) { TDesc d; int nt = 0, kt = 0; locate(tix, d, nt, kt);
#pragma unroll
        for (int q = 0; q < 8; ++q) { const int e = F.tid + q * 512; const int kk = e >> 6, nn = e & 63; const int col = tmap(d.mapk, nt * 64 + nn);
            rg[q] = col >= 0 ? d.src[(size_t)(kt * 64 + kk) * d.Nsrc + col] : 0.f; } };
    int tix = F.bid; int buf = 0;
    if (tix < total) load(tix);
    for (; tix < total; tix += F.G) {
        float* tl = tile + buf * (64 * 65);
#pragma unroll
        for (int q = 0; q < 8; ++q) { const int e = F.tid + q * 512; tl[(e >> 6) * 65 + (e & 63)] = rg[q]; }
        __syncthreads();
        TDesc d; int nt = 0, kt = 0; locate(tix, d, nt, kt);
        if (tix + F.G < total) load(tix + F.G);
#pragma unroll
        for (int q = 0; q < 8; ++q) { const int e = F.tid + q * 512; const int nn = e >> 6, kk = e & 63;
            d.dst[(size_t)(nt * 64 + nn) * d.K + kt * 64 + kk] = f2bf(tl[kk * 65 + nn]); }
        buf ^= 1;
    }
    __syncthreads();
}
template <int OUTF>
DI void rmsnorm_rows(const Frame& F, const float* X, const float* g, bf16_t* Ob, float* Of) {
    f32x4 gg[4];
#pragma unroll
    for (int i = 0; i < 4; ++i) gg[i] = *(const f32x4*)(g + i * 256 + F.lane * 4);
    for (int row0 = F.gw * 4; row0 < MT; row0 += F.nw * 4) {
        f32x4 v[4][4]; float ss[4];
#pragma unroll
        for (int r = 0; r < 4; ++r)
#pragma unroll
            for (int i = 0; i < 4; ++i) v[r][i] = *(const f32x4*)(X + (size_t)(row0 + r) * 1024 + i * 256 + F.lane * 4);
#pragma unroll
        for (int r = 0; r < 4; ++r) { float a = 0.f;
#pragma unroll
            for (int i = 0; i < 4; ++i) a += v[r][i][0] * v[r][i][0] + v[r][i][1] * v[r][i][1] + v[r][i][2] * v[r][i][2] + v[r][i][3] * v[r][i][3];
            ss[r] = a; }
#pragma unroll
        for (int o = 32; o >= 1; o >>= 1) {
#pragma unroll
            for (int r = 0; r < 4; ++r) ss[r] += __shfl_xor(ss[r], o); }
#pragma unroll
        for (int r = 0; r < 4; ++r) { const float rs = rsqrtf(ss[r] * (1.0f / 1024.0f) + 1e-6f);
#pragma unroll
            for (int i = 0; i < 4; ++i) { f32x4 y;
#pragma unroll
                for (int j = 0; j < 4; ++j) y[j] = v[r][i][j] * rs * gg[i][j];
                if (OUTF) *(f32x4*)(Of + (size_t)(row0 + r) * 1024 + i * 256 + F.lane * 4) = y;
                else { uint2 pk; pk.x = pack2(y[0], y[1]); pk.y = pack2(y[2], y[3]); *(uint2*)(Ob + (size_t)(row0 + r) * 1024 + i * 256 + F.lane * 4) = pk; } } }
    }
}
DI void rmsnorm_gates(const Frame& F, const bf16_t* X, const float* g, bf16_t* Ob) {
    const float* W = F.in[15]; float* gts = (float*)(F.ws + WS_GATES);
    float wg[2][8][8]; float gg[2][8];
#pragma unroll
    for (int i = 0; i < 2; ++i)
#pragma unroll
        for (int e = 0; e < 8; ++e) { const int k = i * 512 + F.lane * 8 + e; const f32x4 a = *(const f32x4*)(W + (size_t)k * 3592 + 2560), b = *(const f32x4*)(W + (size_t)k * 3592 + 2564);
            wg[i][e][0] = a[0]; wg[i][e][1] = a[1]; wg[i][e][2] = a[2]; wg[i][e][3] = a[3]; wg[i][e][4] = b[0]; wg[i][e][5] = b[1]; wg[i][e][6] = b[2]; wg[i][e][7] = b[3]; gg[i][e] = g[k]; }
    for (int row0 = F.gw * 2; row0 < MT; row0 += F.nw * 2) {
        uint4 xv[2][2]; float ss[2];
#pragma unroll
        for (int r = 0; r < 2; ++r)
#pragma unroll
            for (int i = 0; i < 2; ++i) xv[r][i] = *(const uint4*)(X + (size_t)(row0 + r) * 1024 + i * 512 + F.lane * 8);
        float xf[2][2][8];
#pragma unroll
        for (int r = 0; r < 2; ++r) { float a = 0.f;
#pragma unroll
            for (int i = 0; i < 2; ++i) { unpack8(xv[r][i], xf[r][i]);
#pragma unroll
                for (int e = 0; e < 8; ++e) a += xf[r][i][e] * xf[r][i][e]; }
            ss[r] = a; }
#pragma unroll
        for (int o = 32; o >= 1; o >>= 1) { ss[0] += __shfl_xor(ss[0], o); ss[1] += __shfl_xor(ss[1], o); }
#pragma unroll
        for (int r = 0; r < 2; ++r) { const int row = row0 + r;
            const float rs = rsqrtf(ss[r] * (1.0f / 1024.0f) + 1e-6f);
            float pg[8] = {0.f, 0.f, 0.f, 0.f, 0.f, 0.f, 0.f, 0.f};
#pragma unroll
            for (int i = 0; i < 2; ++i) { float y[8];
#pragma unroll
                for (int e = 0; e < 8; ++e) { y[e] = xf[r][i][e] * rs * gg[i][e];
#pragma unroll
                    for (int j = 0; j < 8; ++j) pg[j] += y[e] * wg[i][e][j]; }
                uint4 pk; pk.x = pack2(y[0], y[1]); pk.y = pack2(y[2], y[3]); pk.z = pack2(y[4], y[5]); pk.w = pack2(y[6], y[7]); *(uint4*)(Ob + (size_t)row * 1024 + i * 512 + F.lane * 8) = pk; }
#pragma unroll
            for (int o = 32; o >= 1; o >>= 1) {
#pragma unroll
                for (int j = 0; j < 8; ++j) pg[j] += __shfl_xor(pg[j], o); }
            float mine = 0.f;
#pragma unroll
            for (int j = 0; j < 8; ++j) if (F.lane == j) mine = pg[j];
            if (F.lane < 8) gts[(size_t)row * 8 + F.lane] = mine; }
    }
}
DI void p0_prologue(const Frame& F) {
    unsigned char* ws = F.ws;
    transpose_all(F);
    { bf16_t* wat = (bf16_t*)(ws + WS_WAT); bf16_t* wxt = (bf16_t*)(ws + WS_WXT);
      for (int idx = F.bid * 512 + F.tid; idx < 8 * 64 * 64; idx += F.G * 512) { const int g = idx >> 12, j = (idx >> 6) & 63, i = idx & 63;
          wat[idx] = f2bf(F.in[19][(size_t)(g * 64 + i) * 64 + j]); wxt[idx] = f2bf(F.in[21][(size_t)(g * 64 + i) * 64 + j]); } }
    rmsnorm_rows<0>(F, F.in[0], F.in[2], (bf16_t*)(ws + WS_BFA), nullptr);
    { const float* p = F.in[1]; bf16_t* pb = (bf16_t*)(ws + WS_PBF); const size_t n8 = (size_t)2 * MT * 256 / 8;
      for (size_t i = (size_t)F.bid * 512 + F.tid; i < n8; i += (size_t)F.G * 512) {
          const f32x4 a = *(const f32x4*)(p + i * 8), b = *(const f32x4*)(p + i * 8 + 4);
          uint4 o; o.x = pack2(a[0], a[1]); o.y = pack2(a[2], a[3]); o.z = pack2(b[0], b[1]); o.w = pack2(b[2], b[3]); *(uint4*)(pb + i * 8) = o; } }
}

DI void p2a_build_blocks(const Frame& F) {
    { const int gt = F.bid * 512 + F.tid;
      if (gt < 1024) { const int bg = gt >> 6, d = gt & 63; ((float*)(F.ws + WS_KCMP))[((size_t)bg * 256 + 255) * 64 + d] = 0.f; ((float*)(F.ws + WS_VCMP))[((size_t)bg * 256 + 255) * 64 + d] = 0.f;
          ((bf16_t*)(F.ws + WS_VCT))[((size_t)bg * 64 + d) * 256 + 255] = 0; } }
    const bf16_t* U = (const bf16_t*)(F.ws + WS_U);
    bf16_t* AK = (bf16_t*)(F.ws + WS_AK); bf16_t* AV = (bf16_t*)(F.ws + WS_AV);
    const float* posk = F.in[9]; const float* posv = F.in[12];
    const size_t nitem = (size_t)2 * 4096 * 32 * 8;
    for (size_t it = (size_t)F.bid * 512 + F.tid; it < nitem; it += (size_t)F.G * 512) {
        const int c8 = (int)(it & 7), l = (int)((it >> 3) & 31), r = (int)((it >> 8) & 4095), which = (int)(it >> 20);
        bf16_t* dst = (which ? AV : AK) + (size_t)r * 2048 + l * 64 + c8 * 8;
        uint4 o = make_uint4(0u, 0u, 0u, 0u);
        if (r < 4080) {
            const int b = r / 510, rem = r % 510, i = rem >> 1, g = rem & 1;
            const bf16_t* sp = U + ((size_t)b * SEQ + 16 * i + l) * LD0 + (which ? C_VC : C_KC) + g * 64 + c8 * 8;
            const float* pp = (which ? posv : posk) + l * 64 + c8 * 8;
            const uint4 v = *(const uint4*)sp; float f[8]; unpack8(v, f);
            o.x = pack2(f[0] + pp[0], f[1] + pp[1]); o.y = pack2(f[2] + pp[2], f[3] + pp[3]); o.z = pack2(f[4] + pp[4], f[5] + pp[5]); o.w = pack2(f[6] + pp[6], f[7] + pp[7]);
        }
        *(uint4*)dst = o;
    }
}
DI void p2c_compress_rows(const Frame& F, int which, int row0) {
    const bf16_t* H = (const bf16_t*)(F.ws + (which ? WS_HV : WS_HK));
    float* OUT = (float*)(F.ws + (which ? WS_VCMP : WS_KCMP));
    const float* w2 = which ? F.in[14] : F.in[11];
    for (int rr = F.wave; rr < 256; rr += 8) {
        const int r = row0 + rr; if (r >= 4080) break;
        const int b = r / 510, rem = r % 510, i = rem >> 1, g = rem & 1, bg = b * 2 + g;
        const bf16_t* hr = H + (size_t)r * 256; float acc = 0.f;
        for (int j = 0; j < 256; j += 8) { const uint4 hv = *(const uint4*)(hr + j); float hf[8]; unpack8(hv, hf);
#pragma unroll
            for (int q = 0; q < 8; ++q) acc += hf[q] * w2[(size_t)(j + q) * 64 + F.lane]; }
        OUT[((size_t)bg * 256 + i) * 64 + F.lane] = acc;
        if (which) ((bf16_t*)(F.ws + WS_VCT))[((size_t)bg * 64 + F.lane) * 256 + i] = f2bf(acc);
    }
}

typedef float f32x16 __attribute__((ext_vector_type(16)));
#define MFMA32(a, b, c) __builtin_amdgcn_mfma_f32_32x32x16_bf16((a), (b), (c), 0, 0, 0)
constexpr float LOG2E = 1.4426950408889634f;
constexpr float QK_C1 = 0.125f * LOG2E;
constexpr int AT_BUF = 0;
constexpr int AT_PSUM = 65536;
constexpr int AT_SELM = AT_PSUM + 65536;
constexpr int AT_MISC = AT_SELM + 1024;
constexpr int AT_END = AT_MISC + 64 + 2048;
static_assert(AT_END + LDS_WORK_OFF <= LDS_BYTES - 12288, "attention lds");
enum { FL_NEAR = 1, FL_CAUSAL = 2, FL_WINLO = 4, FL_BITS = 8, FL_LANE = 16 };

struct Att { float m, l; f32x16 o0, o1; };
DI void att_init(Att& a) { a.m = NEG_INF; a.l = 0.f;
#pragma unroll
    for (int i = 0; i < 16; ++i) { a.o0[i] = 0.f; a.o1[i] = 0.f; } }

typedef unsigned u32x4 __attribute__((ext_vector_type(4)));
#define OPAQUE(x) asm volatile("" : "+v"(x))
DI void st_write_K(LAS unsigned char* Kt, int tid, const uint4& rg) {
    OPAQUE(tid);
    const int key = tid >> 3, c = tid & 7;
    const u32x4 v = {rg.x, rg.y, rg.z, rg.w};
    *(LAS u32x4*)(Kt + (key ^ ((key >> 3) & 1)) * 128 + ((c ^ (key & 7)) << 4)) = v;
}
DI void st_write_VT(LAS unsigned char* Vt, int tid, const uint4& rg) {
    OPAQUE(tid);
    const int d = tid >> 3, m = tid & 7, G = m >> 1, a = m & 1, sw = (d >> 1) & 7;
    typedef unsigned u32x2 __attribute__((ext_vector_type(2)));
    const u32x2 lo = {rg.x, rg.y}, hi = {rg.z, rg.w};
    *(LAS u32x2*)(Vt + d * 128 + (((2 * G) ^ sw) << 4) + 8 * a) = lo;
    *(LAS u32x2*)(Vt + d * 128 + (((2 * G + 1) ^ sw) << 4) + 8 * a) = hi;
}
DI void qk_tile(const LAS unsigned char* Kt, const bf16x8 (&qf)[4], int r, int hf, f32x16& s0, f32x16& s1) {
    OPAQUE(r); OPAQUE(hf);
    const f32x16 zero16 = {0.f, 0.f, 0.f, 0.f, 0.f, 0.f, 0.f, 0.f, 0.f, 0.f, 0.f, 0.f, 0.f, 0.f, 0.f, 0.f};
#pragma unroll
    for (int s = 0; s < 4; ++s) {
        const int c = 2 * s + hf;
        const int pr = r ^ ((r >> 3) & 1);
        const bf16x8 a0 = *(const LAS bf16x8*)(Kt + pr * 128 + ((c ^ (r & 7)) << 4));
        const bf16x8 a1 = *(const LAS bf16x8*)(Kt + (32 + pr) * 128 + ((c ^ (r & 7)) << 4));
        if (s == 0) { s0 = MFMA32(a0, qf[0], zero16); s1 = MFMA32(a1, qf[0], zero16); }
        else { s0 = MFMA32(a0, qf[s], s0); s1 = MFMA32(a1, qf[s], s1); }
    }
}
template <int FLAGS>
DI void fix_scores(f32x16& s, int posb, int kstep, int tq, const LAS float* bl, float bfar, unsigned mword, bool laneok, int hf) {
    OPAQUE(hf); OPAQUE(tq);
#pragma unroll
    for (int i = 0; i < 16; ++i) {
        const int koff = (i & 3) + 8 * (i >> 2) + 4 * hf;
        const int dist = tq - (posb + kstep * koff);
        float bias = bfar;
        if (FLAGS & FL_NEAR) { int dd = dist < 0 ? 0 : dist; dd = dd > 127 ? 127 : dd; bias = bl[dd]; }
        const float v = s[i] * QK_C1 + bias;
        bool ok = true;
        if (FLAGS & FL_CAUSAL) ok = ok && (dist >= 0);
        if (FLAGS & FL_WINLO) ok = ok && (dist < 512);
        if (FLAGS & FL_BITS) ok = ok && (((mword >> koff) & 1u) != 0u);
        if (FLAGS & FL_LANE) ok = ok && laneok;
        s[i] = ok ? v : NEG_INF;
    }
}
DI bf16x8 pack8(const f32x16& x, int s) {
    typedef unsigned u32x4 __attribute__((ext_vector_type(4)));
    u32x4 p;
    p[0] = pack2(x[8 * s + 0], x[8 * s + 1]); p[1] = pack2(x[8 * s + 2], x[8 * s + 3]); p[2] = pack2(x[8 * s + 4], x[8 * s + 5]); p[3] = pack2(x[8 * s + 6], x[8 * s + 7]);
    return __builtin_bit_cast(bf16x8, p);
}
DI void pv_tile(const LAS unsigned char* Vt, const f32x16& p0, const f32x16& p1, int r, int hf, f32x16& o0, f32x16& o1) {
    OPAQUE(r); OPAQUE(hf);
#pragma unroll
    for (int G = 0; G < 4; ++G) {
        const bf16x8 pb = pack8((G >> 1) ? p1 : p0, G & 1);
        const int cc = 2 * G + hf;
        const bf16x8 a0 = *(const LAS bf16x8*)(Vt + r * 128 + ((cc ^ ((r >> 1) & 7)) << 4));
        const bf16x8 a1 = *(const LAS bf16x8*)(Vt + (32 + r) * 128 + ((cc ^ ((r >> 1) & 7)) << 4));
        o0 = MFMA32(a0, pb, o0); o1 = MFMA32(a1, pb, o1);
    }
}
DI void online_pv(Att& st, f32x16& s0, f32x16& s1, const LAS unsigned char* Vt, int r, int hf) {
    float tm = NEG_INF;
#pragma unroll
    for (int i = 0; i < 16; ++i) tm = fmaxf(tm, fmaxf(s0[i], s1[i]));
    tm = fmaxf(tm, __shfl_xor(tm, 32));
    const float mn = fmaxf(st.m, tm);
    const float mu = (mn == NEG_INF) ? 0.f : mn;
    const float alpha = __builtin_amdgcn_exp2f(st.m - mu);
    float ls = 0.f;
#pragma unroll
    for (int i = 0; i < 16; ++i) { s0[i] = __builtin_amdgcn_exp2f(s0[i] - mu); s1[i] = __builtin_amdgcn_exp2f(s1[i] - mu); ls += s0[i] + s1[i]; }
    st.l = st.l * alpha + ls;
    if (__ballot(mn != st.m) != 0ull) {
#pragma unroll
        for (int i = 0; i < 16; ++i) { st.o0[i] *= alpha; st.o1[i] *= alpha; } }
    st.m = mn;
    pv_tile(Vt, s0, s1, r, hf, st.o0, st.o1);
}
DI unsigned bitmask32(unsigned w, int pos) { unsigned m; asm("v_bfe_i32 %0, %1, %2, 1" : "=v"(m) : "v"(w), "n"(pos)); return m; }
template <bool BITS, bool NEARB, bool CAUSAL = false>
DI void far_tile(Att& st, const LAS unsigned char* Kt, const LAS unsigned char* Vt, const bf16x8 (&qf)[4], int r, int hf, float bfar, bool laneok, unsigned m0, unsigned m1,
                 int tq, int posb, const LAS float* bl) {
    f32x16 s0, s1; qk_tile(Kt, qf, r, hf, s0, s1);
    OPAQUE(hf);
    const float cb = laneok ? bfar - st.m : NEG_INF;
    const float nm = laneok ? -st.m : NEG_INF;
    const int dbase = tq - posb - 4 * hf;
    const unsigned w0 = m0 >> (4 * hf), w1 = m1 >> (4 * hf);
    const f32x2 c1v = {QK_C1, QK_C1}; f32x2 cbv = {cb, cb}; f32x2 ls2 = {0.f, 0.f};
#pragma unroll
    for (int i = 0; i < 16; i += 2) { const f32x2 sv = {s0[i], s0[i + 1]};
        if (NEARB) { int d0 = dbase - ((i & 3) + 8 * (i >> 2)), d1 = dbase - (((i + 1) & 3) + 8 * ((i + 1) >> 2)); const bool k0 = d0 >= 0, k1 = d1 >= 0;
            d0 = d0 > 127 ? 127 : d0; d1 = d1 > 127 ? 127 : d1; if (CAUSAL) { d0 = d0 < 0 ? 0 : d0; d1 = d1 < 0 ? 0 : d1; }
            cbv[0] = bl[d0] + nm; cbv[1] = bl[d1] + nm; if (CAUSAL) { cbv[0] = k0 ? cbv[0] : NEG_INF; cbv[1] = k1 ? cbv[1] : NEG_INF; } }
        const f32x2 av = sv * c1v + cbv;
        f32x2 pv; pv[0] = __builtin_amdgcn_exp2f(av[0]); pv[1] = __builtin_amdgcn_exp2f(av[1]);
        if (BITS) { pv[0] = __uint_as_float(__float_as_uint(pv[0]) & bitmask32(w0, (i & 3) + 8 * (i >> 2)));
                    pv[1] = __uint_as_float(__float_as_uint(pv[1]) & bitmask32(w0, ((i + 1) & 3) + 8 * ((i + 1) >> 2))); }
        s0[i] = pv[0]; s0[i + 1] = pv[1]; ls2 += pv; }
    int rr = r; OPAQUE(rr);
#pragma unroll
    for (int G = 0; G < 2; ++G) { const bf16x8 pb = pack8(s0, G); const int cc = 2 * G + hf;
        const bf16x8 a0 = *(const LAS bf16x8*)(Vt + rr * 128 + ((cc ^ ((rr >> 1) & 7)) << 4)); const bf16x8 a1 = *(const LAS bf16x8*)(Vt + (32 + rr) * 128 + ((cc ^ ((rr >> 1) & 7)) << 4));
        st.o0 = MFMA32(a0, pb, st.o0); st.o1 = MFMA32(a1, pb, st.o1); }
#pragma unroll
    for (int i = 0; i < 16; i += 2) { const f32x2 sv = {s1[i], s1[i + 1]};
        if (NEARB) { int d0 = dbase - 32 - ((i & 3) + 8 * (i >> 2)), d1 = dbase - 32 - (((i + 1) & 3) + 8 * ((i + 1) >> 2)); const bool k0 = d0 >= 0, k1 = d1 >= 0;
            d0 = d0 > 127 ? 127 : d0; d1 = d1 > 127 ? 127 : d1; if (CAUSAL) { d0 = d0 < 0 ? 0 : d0; d1 = d1 < 0 ? 0 : d1; }
            cbv[0] = bl[d0] + nm; cbv[1] = bl[d1] + nm; if (CAUSAL) { cbv[0] = k0 ? cbv[0] : NEG_INF; cbv[1] = k1 ? cbv[1] : NEG_INF; } }
        const f32x2 av = sv * c1v + cbv;
        f32x2 pv; pv[0] = __builtin_amdgcn_exp2f(av[0]); pv[1] = __builtin_amdgcn_exp2f(av[1]);
        if (BITS) { pv[0] = __uint_as_float(__float_as_uint(pv[0]) & bitmask32(w1, (i & 3) + 8 * (i >> 2)));
                    pv[1] = __uint_as_float(__float_as_uint(pv[1]) & bitmask32(w1, ((i + 1) & 3) + 8 * ((i + 1) >> 2))); }
        s1[i] = pv[0]; s1[i + 1] = pv[1]; ls2 += pv; }
#pragma unroll
    for (int G = 2; G < 4; ++G) { const bf16x8 pb = pack8(s1, G & 1); const int cc = 2 * G + hf;
        const bf16x8 a0 = *(const LAS bf16x8*)(Vt + rr * 128 + ((cc ^ ((rr >> 1) & 7)) << 4)); const bf16x8 a1 = *(const LAS bf16x8*)(Vt + (32 + rr) * 128 + ((cc ^ ((rr >> 1) & 7)) << 4));
        st.o0 = MFMA32(a0, pb, st.o0); st.o1 = MFMA32(a1, pb, st.o1); }
    st.l += ls2[0] + ls2[1];
}
#define LDS_BARRIER() do { asm volatile("s_waitcnt lgkmcnt(0)" ::: "memory"); __builtin_amdgcn_s_barrier(); asm volatile("" ::: "memory"); } while (0)
template <class LD, class BODY>
DI void tile_stream(int n, LAS unsigned char* buf, int tid, bool useV, LD ld, BODY body) {
    if (n <= 0) return;
    uint4 rk0, rk1 = make_uint4(0u, 0u, 0u, 0u), rv0 = make_uint4(0u, 0u, 0u, 0u), rv1 = make_uint4(0u, 0u, 0u, 0u);
    ld(0, rk0, rv0); if (n > 1) ld(1, rk1, rv1);
    st_write_K(buf, tid, rk0); if (useV) st_write_VT(buf + 8192, tid, rv0);
    if (n > 1) { st_write_K(buf + 16384, tid, rk1); if (useV) st_write_VT(buf + 24576, tid, rv1); }
    if (n > 2) ld(2, rk0, rv0); if (n > 3) ld(3, rk1, rv1);
    LDS_BARRIER();
#pragma unroll 1
    for (int i = 0; i < n; i += 2) {
        LAS unsigned char* cur = buf + ((i >> 1) & 1) * 32768;
        if (i + 2 < n) { LAS unsigned char* nxt = buf + (((i >> 1) + 1) & 1) * 32768;
            st_write_K(nxt, tid, rk0); if (useV) st_write_VT(nxt + 8192, tid, rv0);
            if (i + 3 < n) { st_write_K(nxt + 16384, tid, rk1); if (useV) st_write_VT(nxt + 24576, tid, rv1); }
            if (i + 4 < n) ld(i + 4, rk0, rv0); if (i + 5 < n) ld(i + 5, rk1, rv1); }
        body(i, cur, cur + 8192);
        if (i + 1 < n) body(i + 1, cur + 16384, cur + 24576);
        LDS_BARRIER();
    }
}
template <class LD, class BODY>
DI void tile_stream_k4(int n, LAS unsigned char* buf, int tid, LD ld, BODY body) {
    if (n <= 0) return;
    uint4 r0, r1 = make_uint4(0u, 0u, 0u, 0u), r2 = make_uint4(0u, 0u, 0u, 0u), r3 = make_uint4(0u, 0u, 0u, 0u), dv;
    ld(0, r0, dv); if (n > 1) ld(1, r1, dv); if (n > 2) ld(2, r2, dv); if (n > 3) ld(3, r3, dv);
    st_write_K(buf, tid, r0); if (n > 1) st_write_K(buf + 8192, tid, r1); if (n > 2) st_write_K(buf + 16384, tid, r2); if (n > 3) st_write_K(buf + 24576, tid, r3);
    if (n > 4) ld(4, r0, dv); if (n > 5) ld(5, r1, dv); if (n > 6) ld(6, r2, dv); if (n > 7) ld(7, r3, dv);
    LDS_BARRIER();
#pragma unroll 1
    for (int i = 0; i < n; i += 4) {
        LAS unsigned char* cur = buf + ((i >> 2) & 1) * 32768;
        if (i + 4 < n) { LAS unsigned char* nxt = buf + (((i >> 2) + 1) & 1) * 32768;
            st_write_K(nxt, tid, r0); if (i + 5 < n) st_write_K(nxt + 8192, tid, r1); if (i + 6 < n) st_write_K(nxt + 16384, tid, r2); if (i + 7 < n) st_write_K(nxt + 24576, tid, r3);
            if (i + 8 < n) ld(i + 8, r0, dv); if (i + 9 < n) ld(i + 9, r1, dv); if (i + 10 < n) ld(i + 10, r2, dv); if (i + 11 < n) ld(i + 11, r3, dv); }
#pragma unroll 1
        for (int j = 0; j < 4; ++j) if (i + j < n) body(i + j, cur + j * 8192, cur);
        LDS_BARRIER();
    }
}
DI uint4 cvt8_f32(const float* p) { const f32x4 a = *(const f32x4*)p, b = *(const f32x4*)(p + 4); uint4 o; o.x = pack2(a[0], a[1]); o.y = pack2(a[2], a[3]); o.z = pack2(b[0], b[1]); o.w = pack2(b[2], b[3]); return o; }

DI void nsa_unit(const Frame& F, int b, int g, int qb) {
    const int tid = F.tid, lane = F.lane, w = F.wave, r = lane & 31, hf = lane >> 5;
    LAS unsigned char* L = F.ldsl;
    LAS unsigned char* buf = L + AT_BUF;
    LAS float* psum = (LAS float*)(L + AT_PSUM);
    LAS unsigned long long* selm = (LAS unsigned long long*)(L + AT_SELM);
    LAS unsigned char* tlist = L + AT_SELM + 528;
    LAS int* tcnt = (LAS int*)(L + AT_SELM + 520);
    const bf16_t* U = (const bf16_t*)(F.ws + WS_U);
    const float* KC = (const float*)(F.ws + WS_KCMP) + (size_t)(b * 2 + g) * 256 * 64;
    const bf16_t* VCT = (const bf16_t*)(F.ws + WS_VCT) + (size_t)(b * 2 + g) * 64 * 256;
    const bf16_t* VT = (const bf16_t*)(F.ws + WS_VT);
    bf16_t* Y = (bf16_t*)(F.ws + WS_BFB);
    const int t0 = qb * 64;
    const int ql = r >> 2, h = r & 3, hh = g * 4 + h;
    const int tq = t0 + 8 * w + ql;
    const size_t row = (size_t)b * SEQ + tq;
    const bf16_t* Ur = U + row * LD0;
    bf16x8 qf[4];
#pragma unroll
    for (int s = 0; s < 4; ++s) qf[s] = *(const bf16x8*)(Ur + C_AQ + hh * 64 + 16 * s + 8 * hf);
    const LAS float* bl = F.biasL + hh * 128; const float bfar = bl[127];
    float gate[3];
    { const unsigned* gp = (const unsigned*)(Ur + C_AG);
#pragma unroll
      for (int j = 0; j < 3; ++j) { const int e = hh * 3 + j; const unsigned wv = gp[e >> 1]; gate[j] = sigmoidf_((e & 1) ? __uint_as_float(wv & 0xFFFF0000u) : __uint_as_float(wv << 16)); } }
    LAS float* opark = psum + w * 2048 + lane;

    const int nvmax = ((t0 + 63 - 31) >> 4) + 1;
    const int ntc = (nvmax + 63) >> 6;
    for (int e = tid; e < 64 * 256; e += 512) psum[e] = 0.f;
    float cm = NEG_INF, cl = 0.f;
    {
#pragma unroll 1
        for (int i = 0; i < ntc; ++i) { const int key = tid >> 3, c = tid & 7;
            const uint4 rk = cvt8_f32(KC + (size_t)(i * 64 + key) * 64 + c * 8); const uint4 rv = *(const uint4*)(VCT + (size_t)key * 256 + i * 64 + c * 8);
            st_write_K(buf + i * 8192, tid, rk); st_write_VT(buf + 32768 + i * 8192, tid, rv); }
        __syncthreads();
        auto body = [&](int i, LAS unsigned char* Kt, LAS unsigned char* Vt) { (void)Vt;
            f32x16 s0, s1; qk_tile(Kt, qf, r, hf, s0, s1);
            if (16 * (i * 64 + 63) + 31 + 113 <= t0 + 8 * w) { fix_scores<0>(s0, 0, 16, tq, bl, bfar, 0u, true, hf); fix_scores<0>(s1, 0, 16, tq, bl, bfar, 0u, true, hf); }
            else { fix_scores<FL_NEAR | FL_CAUSAL>(s0, 16 * (i * 64) + 31, 16, tq, bl, bfar, 0u, true, hf); fix_scores<FL_NEAR | FL_CAUSAL>(s1, 16 * (i * 64 + 32) + 31, 16, tq, bl, bfar, 0u, true, hf); }
            float tm = NEG_INF;
#pragma unroll
            for (int k = 0; k < 16; ++k) tm = fmaxf(tm, fmaxf(s0[k], s1[k]));
            tm = fmaxf(tm, __shfl_xor(tm, 32));
            const float mn = fmaxf(cm, tm); const float mu = (mn == NEG_INF) ? 0.f : mn;
            float ls = 0.f;
#pragma unroll
            for (int k = 0; k < 16; ++k) ls += __builtin_amdgcn_exp2f(s0[k] - mu) + __builtin_amdgcn_exp2f(s1[k] - mu);
            cl = cl * __builtin_amdgcn_exp2f(cm - mu) + ls; cm = mn; };
#pragma unroll 1
        for (int i = 0; i < ntc; ++i) body(i, buf + i * 8192, buf + 32768 + i * 8192);
    }
    f32x16 c0, c1;
    {
        cl += __shfl_xor(cl, 32);
        const float cinv = cl > 0.f ? 1.0f / cl : 0.f; const float cmu = (cm == NEG_INF) ? 0.f : cm;
#pragma unroll
        for (int i = 0; i < 16; ++i) { c0[i] = 0.f; c1[i] = 0.f; }
        auto body = [&](int i, LAS unsigned char* Kt, LAS unsigned char* Vt) {
            f32x16 s0, s1; qk_tile(Kt, qf, r, hf, s0, s1);
            if (16 * (i * 64 + 63) + 31 + 113 <= t0 + 8 * w) { fix_scores<0>(s0, 0, 16, tq, bl, bfar, 0u, true, hf); fix_scores<0>(s1, 0, 16, tq, bl, bfar, 0u, true, hf); }
            else { fix_scores<FL_NEAR | FL_CAUSAL>(s0, 16 * (i * 64) + 31, 16, tq, bl, bfar, 0u, true, hf); fix_scores<FL_NEAR | FL_CAUSAL>(s1, 16 * (i * 64 + 32) + 31, 16, tq, bl, bfar, 0u, true, hf); }
#pragma unroll
            for (int k = 0; k < 16; ++k) { s0[k] = __builtin_amdgcn_exp2f(s0[k] - cmu) * cinv; s1[k] = __builtin_amdgcn_exp2f(s1[k] - cmu) * cinv; }
#pragma unroll
            for (int k = 0; k < 16; ++k) {
                float a0 = s0[k], a1 = s1[k];
                a0 += __shfl_xor(a0, 1); a0 += __shfl_xor(a0, 2); a1 += __shfl_xor(a1, 1); a1 += __shfl_xor(a1, 2);
                const int koff = (k & 3) + 8 * (k >> 2) + 4 * hf;
                if (h == 0) { psum[(8 * w + ql) * 256 + i * 64 + koff] = a0; psum[(8 * w + ql) * 256 + i * 64 + 32 + koff] = a1; }
            }
            pv_tile(Vt, s0, s1, r, hf, c0, c1); };
#pragma unroll 1
        for (int i = 0; i < ntc; ++i) body(i, buf + i * 8192, buf + 32768 + i * 8192);
        __syncthreads();
    }
    {
        const int cur = qb; const int npick = (cur + 1) < 8 ? (cur + 1) : 8;
        LAS float* scw = (LAS float*)(L + AT_MISC + 64) + w * 64;
#pragma unroll 1
        for (int q = 0; q < 8; ++q) {
            const LAS float* pr = psum + (8 * w + q) * 256;
            float imp = 0.f;
            const int i0 = 4 * lane - 1 < 0 ? 0 : 4 * lane - 1, i1 = 4 * lane + 3 > 254 ? 254 : 4 * lane + 3;
            for (int i = i0; i <= i1; ++i) imp += pr[i];
            const bool adm = lane <= cur; const bool forced = (lane == 0) || (lane == cur) || (lane == cur - 1);
            const float score = adm ? imp + (forced ? 1.0e4f : 0.f) : NEG_INF;
            __builtin_amdgcn_wave_barrier();
            scw[lane] = score;
            __builtin_amdgcn_wave_barrier();
            int rank = 0;
#pragma unroll
            for (int j4 = 0; j4 < 16; ++j4) { const f32x4 o = *(const LAS f32x4*)(scw + 4 * j4);
#pragma unroll
                for (int e = 0; e < 4; ++e) { const int j = 4 * j4 + e; rank += (o[e] > score || (o[e] == score && j < lane)) ? 1 : 0; } }
            const unsigned long long sm = __ballot(adm && rank < npick);
            if (lane == 0) selm[8 * w + q] = sm;
        }
    }
    __syncthreads();
    if (w == 0) {
        unsigned long long m = selm[lane];
        unsigned lo = (unsigned)m, hi = (unsigned)(m >> 32);
        for (int o = 32; o >= 1; o >>= 1) { lo |= __shfl_xor(lo, o); hi |= __shfl_xor(hi, o); }
        const unsigned long long un = ((unsigned long long)hi << 32) | lo;
        const bool mine = (un >> lane) & 1ull;
        const int pos = __popcll(un & ((1ull << lane) - 1ull));
        if (mine) tlist[pos] = (unsigned char)lane;
        if (lane == 0) tcnt[0] = __popcll(un);
    }
    __syncthreads();
#pragma unroll
    for (int i = 0; i < 16; ++i) { opark[i * 64] = gate[0] * c0[i]; opark[(16 + i) * 64] = gate[0] * c1[i]; }
    const unsigned long long mysel = selm[8 * w + ql];
    {
        Att st; att_init(st);
        const int nts = tcnt[0];
        auto lds_ = [&](int i, uint4& rk, uint4& rv) { const int j = tlist[i]; const int key = tid >> 3, c = tid & 7;
            const bf16_t* p = U + ((size_t)b * SEQ + j * 64 + key) * LD0 + g * 64 + c * 8; rk = *(const uint4*)(p + C_KS); rv = *(const uint4*)(VT + (size_t)(g * 64 + key) * MT + (size_t)b * SEQ + j * 64 + c * 8); };
        auto body = [&](int i, LAS unsigned char* Kt, LAS unsigned char* Vt) {
            const int j = tlist[i];
            const bool laneok = (mysel >> j) & 1ull;
            if (__ballot(laneok) == 0ull) return;
            if (__ballot(st.m == NEG_INF) == 0ull) {
                if (j < qb - 2) far_tile<false, false>(st, Kt, Vt, qf, r, hf, bfar, laneok, 0u, 0u, tq, j * 64, bl); else if (j < qb) far_tile<false, true>(st, Kt, Vt, qf, r, hf, bfar, laneok, 0u, 0u, tq, j * 64, bl);
                else far_tile<false, true, true>(st, Kt, Vt, qf, r, hf, bfar, laneok, 0u, 0u, tq, j * 64, bl);
                return; }
            f32x16 s0, s1; qk_tile(Kt, qf, r, hf, s0, s1);
            if (j >= qb - 2) { fix_scores<FL_NEAR | FL_CAUSAL | FL_LANE>(s0, j * 64, 1, tq, bl, bfar, 0u, laneok, hf); fix_scores<FL_NEAR | FL_CAUSAL | FL_LANE>(s1, j * 64 + 32, 1, tq, bl, bfar, 0u, laneok, hf); }
            else { fix_scores<FL_LANE>(s0, j * 64, 1, tq, bl, bfar, 0u, laneok, hf); fix_scores<FL_LANE>(s1, j * 64 + 32, 1, tq, bl, bfar, 0u, laneok, hf); }
            online_pv(st, s0, s1, Vt, r, hf); };
        tile_stream(nts, buf, tid, true, lds_, body);
        float l = st.l + __shfl_xor(st.l, 32);
        const float sc = l > 0.f ? gate[1] / l : 0.f;
#pragma unroll
        for (int i = 0; i < 16; ++i) { opark[i * 64] += sc * st.o0[i]; opark[(16 + i) * 64] += sc * st.o1[i]; }
    }
    {
        Att st; att_init(st);
        const int j0 = qb - 8 < 0 ? 0 : qb - 8; const int ntw = qb - j0 + 1;
        auto ldw = [&](int i, uint4& rk, uint4& rv) { const int j = j0 + i; const int key = tid >> 3, c = tid & 7;
            const bf16_t* p = U + ((size_t)b * SEQ + j * 64 + key) * LD0 + g * 64 + c * 8; rk = *(const uint4*)(p + C_KW); rv = *(const uint4*)(VT + (size_t)(128 + g * 64 + key) * MT + (size_t)b * SEQ + j * 64 + c * 8); };
        auto body = [&](int i, LAS unsigned char* Kt, LAS unsigned char* Vt) {
            const int j = j0 + i;
            if (j != qb - 8 && __ballot(st.m == NEG_INF) == 0ull) {
                if (j < qb - 2) far_tile<false, false>(st, Kt, Vt, qf, r, hf, bfar, true, 0u, 0u, tq, j * 64, bl); else if (j < qb) far_tile<false, true>(st, Kt, Vt, qf, r, hf, bfar, true, 0u, 0u, tq, j * 64, bl);
                else far_tile<false, true, true>(st, Kt, Vt, qf, r, hf, bfar, true, 0u, 0u, tq, j * 64, bl);
                return; }
            f32x16 s0, s1; qk_tile(Kt, qf, r, hf, s0, s1);
            if (j >= qb - 2) { fix_scores<FL_NEAR | FL_CAUSAL>(s0, j * 64, 1, tq, bl, bfar, 0u, true, hf); fix_scores<FL_NEAR | FL_CAUSAL>(s1, j * 64 + 32, 1, tq, bl, bfar, 0u, true, hf); }
            else if (j == qb - 8) { fix_scores<FL_WINLO>(s0, j * 64, 1, tq, bl, bfar, 0u, true, hf); fix_scores<FL_WINLO>(s1, j * 64 + 32, 1, tq, bl, bfar, 0u, true, hf); }
            else { fix_scores<0>(s0, j * 64, 1, tq, bl, bfar, 0u, true, hf); fix_scores<0>(s1, j * 64 + 32, 1, tq, bl, bfar, 0u, true, hf); }
            online_pv(st, s0, s1, Vt, r, hf); };
        tile_stream(ntw, buf, tid, true, ldw, body);
        float l = st.l + __shfl_xor(st.l, 32);
        const float sc = l > 0.f ? gate[2] / l : 0.f;
#pragma unroll
        for (int i = 0; i < 16; ++i) { c0[i] = opark[i * 64] + sc * st.o0[i]; c1[i] = opark[(16 + i) * 64] + sc * st.o1[i]; }
    }
#pragma unroll
    for (int dh = 0; dh < 2; ++dh)
#pragma unroll
        for (int k = 0; k < 4; ++k) {
            const int d = 32 * dh + 8 * k + 4 * hf;
            const uint2 zz = *(const uint2*)(Ur + C_AZ + hh * 64 + d);
            const float z0 = __uint_as_float(zz.x << 16), z1 = __uint_as_float(zz.x & 0xFFFF0000u), z2 = __uint_as_float(zz.y << 16), z3 = __uint_as_float(zz.y & 0xFFFF0000u);
            const f32x16& o = dh ? c1 : c0;
            uint2 pk; pk.x = pack2(o[4 * k + 0] * siluf_(z0), o[4 * k + 1] * siluf_(z1)); pk.y = pack2(o[4 * k + 2] * siluf_(z2), o[4 * k + 3] * siluf_(z3));
            *(uint2*)(Y + row * 1024 + hh * 64 + d) = pk;
        }
    __syncthreads();
}

DI unsigned short okey16(float x) {
    const _Float16 hx = (_Float16)x; unsigned short u = __builtin_bit_cast(unsigned short, hx);
    if ((u & 0x7FFFu) == 0u) u = 0u;
    return (u & 0x8000u) ? (unsigned short)~u : (unsigned short)(u | 0x8000u);
}
DI void dsa_unit(const Frame& F, int b, int qt) {
    const int tid = F.tid, lane = F.lane, w = F.wave, r = lane & 31, hf = lane >> 5, fr = lane & 15, fq = lane >> 4;
    LAS unsigned char* L = F.ldsl;
    LAS unsigned char* buf = L + AT_BUF;
    LAS unsigned* mask = (LAS unsigned*)(L + AT_PSUM);
    const bf16_t* U = (const bf16_t*)(F.ws + WS_U);
    bf16_t* Y = (bf16_t*)(F.ws + WS_BFB);
    const bf16_t* VT = (const bf16_t*)(F.ws + WS_VT);
    unsigned short* KS = (unsigned short*)(F.ws + WS_BFA) + (size_t)F.bid * 32 * 4096;
    const int t0 = qt * 32;
    const int nt = ((t0 + 31) >> 6) + 1;
    {
        bf16x8 qi[2]; float wi[4];
        { const bf16_t* Uq = U + ((size_t)b * SEQ + t0 + 4 * w + (fr >> 2)) * LD0;
#pragma unroll
          for (int ks = 0; ks < 2; ++ks) qi[ks] = *(const bf16x8*)(Uq + C_BQI + (fr & 3) * 64 + 32 * ks + 8 * fq);
          const uint2 wv = *(const uint2*)(U + ((size_t)b * SEQ + t0 + 4 * w + fq) * LD0 + C_BWI);
          wi[0] = __uint_as_float(wv.x << 16) * 0.0625f; wi[1] = __uint_as_float(wv.x & 0xFFFF0000u) * 0.0625f; wi[2] = __uint_as_float(wv.y << 16) * 0.0625f; wi[3] = __uint_as_float(wv.y & 0xFFFF0000u) * 0.0625f; }
        const int tqi = t0 + 4 * w + fq;
        auto ldi = [&](int i, uint4& rk, uint4& rv) { const int key = tid >> 3, c = tid & 7; rk = *(const uint4*)(U + ((size_t)b * SEQ + i * 64 + key) * LD0 + C_BKI + c * 8); (void)rv; };
        auto body = [&](int i, LAS unsigned char* Kt, LAS unsigned char* Vt) { (void)Vt;
#pragma unroll
            for (int kg = 0; kg < 4; ++kg) {
                const int kk = 16 * kg + fr;
                f32x4 acc = {0.f, 0.f, 0.f, 0.f};
#pragma unroll
                for (int ks = 0; ks < 2; ++ks) { const int c = 4 * ks + fq;
                    const bf16x8 kb = *(const LAS bf16x8*)(Kt + (kk ^ ((kk >> 3) & 1)) * 128 + ((c ^ (kk & 7)) << 4));
                    acc = __builtin_amdgcn_mfma_f32_16x16x32_bf16(qi[ks], kb, acc, 0, 0, 0); }
                const float sc = wi[0] * fmaxf(acc[0], 0.f) + wi[1] * fmaxf(acc[1], 0.f) + wi[2] * fmaxf(acc[2], 0.f) + wi[3] * fmaxf(acc[3], 0.f);
                const int pos = i * 64 + kk;
                KS[(size_t)(4 * w + fq) * 4096 + pos] = pos <= tqi ? okey16(sc) : (unsigned short)0;
            } };
        tile_stream_k4(nt, buf, tid, ldi, body);
    }
    asm volatile("s_waitcnt vmcnt(0)" ::: "memory");
    __syncthreads();
    __builtin_amdgcn_fence(__ATOMIC_ACQUIRE, "agent");
    asm volatile("s_waitcnt vmcnt(0)" ::: "memory");
    {
    LAS unsigned char* maskb = (LAS unsigned char*)mask;
    unsigned Tn[32];
    auto ldkeys = [&](int q) { const int qq = 4 * w + q; const int nk = t0 + qq + 1; int ln = lane; OPAQUE(ln); const unsigned short* kq = KS + (size_t)qq * 4096 + ln * 8;
#pragma unroll
        for (int c = 0; c < 8; ++c) { uint4 kv = make_uint4(0u, 0u, 0u, 0u); if (c * 512 < nk) kv = *(const uint4*)(kq + c * 512);
            Tn[4 * c] = kv.x; Tn[4 * c + 1] = kv.y; Tn[4 * c + 2] = kv.z; Tn[4 * c + 3] = kv.w; } };
    ldkeys(0);
#pragma unroll 1
    for (int q = 0; q < 4; ++q) {
        const int qq = 4 * w + q; const int tqq = t0 + qq; const int nk = tqq + 1;
        unsigned T[32];
#pragma unroll
        for (int e = 0; e < 32; ++e) T[e] = Tn[e];
        if (q < 3) ldkeys(q + 1);
        if (nk <= 256) {
#pragma unroll
            for (int c = 0; c < 8; ++c) { unsigned selb = 0u;
#pragma unroll
                for (int e = 0; e < 8; ++e) if (c * 512 + lane * 8 + e < nk) selb |= 1u << e;
                maskb[qq * 512 + c * 64 + lane] = (unsigned char)selb; }
            continue;
        }
#pragma unroll
        for (int e = 0; e < 32; ++e) { const int idx = (e >> 2) * 512 + lane * 8 + (e & 3) * 2;
            unsigned lo = T[e] & 0xFFFFu, hi = T[e] >> 16; if (idx >= nk) lo = 0u; if (idx + 1 >= nk) hi = 0u; T[e] = lo | (hi << 16); }
#pragma unroll
        for (int st = 0; st < 5; ++st) { const int j = 16 >> st; const unsigned m = st == 0 ? 0x0000FFFFu : st == 1 ? 0x00FF00FFu : st == 2 ? 0x0F0F0F0Fu : st == 3 ? 0x33333333u : 0x55555555u;
#pragma unroll
            for (int k0 = 0; k0 < 32; k0 += 2 * j)
#pragma unroll
                for (int i = 0; i < j; ++i) { const int k = k0 + i; const unsigned t = ((T[k] >> j) ^ T[k + j]) & m; T[k] ^= (t << j); T[k + j] ^= t; } }
        unsigned ce = 0xFFFFFFFFu, co = 0xFFFFFFFFu, ge = 0u, go = 0u; int above = 0;
#pragma unroll
        for (int bit = 15; bit >= 0; --bit) {
            const unsigned oe = ce & T[bit], oo = co & T[16 + bit];
            const int cnt = __popc(oe) + __popc(oo);
            int tot = 0;
#pragma unroll
            for (int bb = 0; bb < 7; ++bb) tot += __popcll(__ballot((cnt >> bb) & 1)) << bb;
            if (above + tot >= 256) { ce = oe; co = oo; }
            else { above += tot; ge |= oe; go |= oo; ce &= ~T[bit]; co &= ~T[16 + bit]; }
        }
        const int quota = 256 - above; int taken = 0;
#pragma unroll
        for (int c = 0; c < 8; ++c) {
            unsigned xe = (ge >> (4 * c)) & 0xFu, xo = (go >> (4 * c)) & 0xFu;
            xe = (xe | (xe << 2)) & 0x33u; xe = (xe | (xe << 1)) & 0x55u; xo = (xo | (xo << 2)) & 0x33u; xo = (xo | (xo << 1)) & 0x55u;
            unsigned selb = xe | (xo << 1);
            unsigned ye = (ce >> (4 * c)) & 0xFu, yo = (co >> (4 * c)) & 0xFu;
            ye = (ye | (ye << 2)) & 0x33u; ye = (ye | (ye << 1)) & 0x55u; yo = (yo | (yo << 2)) & 0x33u; yo = (yo | (yo << 1)) & 0x55u;
            const unsigned eqb = ye | (yo << 1);
            if (__ballot(eqb != 0u) != 0ull) {
                const int ne = __popc(eqb);
                int excl = 0, totc = 0;
#pragma unroll
                for (int bb = 0; bb < 4; ++bb) { const unsigned long long bl_ = __ballot((ne >> bb) & 1);
                    excl += (int)__builtin_amdgcn_mbcnt_hi((unsigned)(bl_ >> 32), __builtin_amdgcn_mbcnt_lo((unsigned)bl_, 0u)) << bb; totc += __popcll(bl_) << bb; }
                int rank = taken + excl;
#pragma unroll
                for (int e = 0; e < 8; ++e) if ((eqb >> e) & 1u) { if (rank < quota) selb |= 1u << e; ++rank; }
                taken += totc;
            }
            maskb[qq * 512 + c * 64 + lane] = (unsigned char)selb;
        }
    }
    }
    __syncthreads();
    {
        const int ql = r >> 3, h = r & 7;
        const int tq = t0 + 4 * w + ql;
        const size_t row = (size_t)b * SEQ + tq;
        const bf16_t* Ur = U + row * LD0;
        bf16x8 qf[4];
#pragma unroll
        for (int s = 0; s < 4; ++s) qf[s] = *(const bf16x8*)(Ur + C_BQ + h * 64 + 16 * s + 8 * hf);
        const LAS float* bl = F.biasL + (8 + h) * 128; const float bfar = bl[127];
        const LAS unsigned* mq = mask + (4 * w + ql) * 128;
        Att st; att_init(st);
        auto lda = [&](int i, uint4& rk, uint4& rv) { const int key = tid >> 3, c = tid & 7;
            const bf16_t* p = U + ((size_t)b * SEQ + i * 64 + key) * LD0 + c * 8; rk = *(const uint4*)(p + C_BK); rv = *(const uint4*)(VT + (size_t)(256 + key) * MT + (size_t)b * SEQ + i * 64 + c * 8); };
        auto body = [&](int i, LAS unsigned char* Kt, LAS unsigned char* Vt) {
            const unsigned m0 = mq[2 * i], m1 = mq[2 * i + 1];
            if (__ballot(st.m == NEG_INF) == 0ull) {
                if (i < nt - 4) far_tile<true, false>(st, Kt, Vt, qf, r, hf, bfar, true, m0, m1, tq, i * 64, bl); else if (i < nt - 1) far_tile<true, true>(st, Kt, Vt, qf, r, hf, bfar, true, m0, m1, tq, i * 64, bl);
                else far_tile<true, true, true>(st, Kt, Vt, qf, r, hf, bfar, true, m0, m1, tq, i * 64, bl);
                return; }
            f32x16 s0, s1; qk_tile(Kt, qf, r, hf, s0, s1);
            if (i >= nt - 4) { fix_scores<FL_NEAR | FL_CAUSAL | FL_BITS>(s0, i * 64, 1, tq, bl, bfar, m0, true, hf); fix_scores<FL_NEAR | FL_CAUSAL | FL_BITS>(s1, i * 64 + 32, 1, tq, bl, bfar, m1, true, hf); }
            else { fix_scores<FL_BITS>(s0, i * 64, 1, tq, bl, bfar, m0, true, hf); fix_scores<FL_BITS>(s1, i * 64 + 32, 1, tq, bl, bfar, m1, true, hf); }
            online_pv(st, s0, s1, Vt, r, hf); };
        tile_stream(nt, buf, tid, true, lda, body);
        float l = st.l + __shfl_xor(st.l, 32);
        const float sc = l > 0.f ? 1.0f / l : 0.f;
#pragma unroll
        for (int dh = 0; dh < 2; ++dh)
#pragma unroll
            for (int k = 0; k < 4; ++k) {
                const int d = 32 * dh + 8 * k + 4 * hf;
                const uint2 zz = *(const uint2*)(Ur + C_BZ + h * 64 + d);
                const float z0 = __uint_as_float(zz.x << 16), z1 = __uint_as_float(zz.x & 0xFFFF0000u), z2 = __uint_as_float(zz.y << 16), z3 = __uint_as_float(zz.y & 0xFFFF0000u);
                const f32x16& o = dh ? st.o1 : st.o0;
                uint2 pk; pk.x = pack2(o[4 * k + 0] * sc * siluf_(z0), o[4 * k + 1] * sc * siluf_(z1)); pk.y = pack2(o[4 * k + 2] * sc * siluf_(z2), o[4 * k + 3] * sc * siluf_(z3));
                *(uint2*)(Y + row * 1024 + 512 + h * 64 + d) = pk;
            }
    }
    __syncthreads();
}

DI void att_dsa(const Frame& F) {
    LAS int* ub = (LAS int*)(F.ldsl + AT_MISC);
    unsigned* qd = F.ctl + CW_QDSA;
    const int NDSA = NB * (SEQ / 32);
    __syncthreads();
    if (F.tid == 0) ub[0] = (int)__hip_atomic_fetch_add(qd, 1u, __ATOMIC_RELAXED, __HIP_MEMORY_SCOPE_AGENT);
    for (;;) {
        __syncthreads();
        const int k = ub[0];
        __syncthreads();
        if (k >= NDSA) break;
        int nxt = 0; if (F.tid == 0) nxt = (int)__hip_atomic_fetch_add(qd, 1u, __ATOMIC_RELAXED, __HIP_MEMORY_SCOPE_AGENT);
        dsa_unit(F, k & 7, (SEQ / 32) - 1 - (k >> 3));
        if (F.tid == 0) ub[0] = nxt;
    }
}
DI void att_nsa(const Frame& F) {
    LAS int* ub = (LAS int*)(F.ldsl + AT_MISC);
    unsigned* qn = F.ctl + CW_QNSA;
    const int NNSA = NB * 2 * (SEQ / 64);
    __syncthreads();
    if (F.tid == 0) ub[0] = (int)__hip_atomic_fetch_add(qn, 1u, __ATOMIC_RELAXED, __HIP_MEMORY_SCOPE_AGENT);
    for (;;) {
        __syncthreads();
        const int k = ub[0];
        __syncthreads();
        if (k >= NNSA) break;
        int nxt = 0; if (F.tid == 0) nxt = (int)__hip_atomic_fetch_add(qn, 1u, __ATOMIC_RELAXED, __HIP_MEMORY_SCOPE_AGENT);
        const int bg = k & 15;
        nsa_unit(F, bg >> 1, bg & 1, 63 - (k >> 4));
        if (F.tid == 0) ub[0] = nxt;
    }
}

DI f32x4 mma16(const bf16_t* A, int lda, const bf16_t* Bt, int ldb, int K, int lane) {
    const int fr = lane & 15, fq = lane >> 4;
    f32x4 acc = {0.f, 0.f, 0.f, 0.f};
    for (int k = 0; k < K; k += 32) {
        const bf16x8 a = *(const bf16x8*)(A + fr * lda + k + fq * 8);
        const bf16x8 b = *(const bf16x8*)(Bt + fr * ldb + k + fq * 8);
        acc = __builtin_amdgcn_mfma_f32_16x16x32_bf16(a, b, acc, 0, 0, 0);
    }
    return acc;
}
DI void conv8(const bf16_t* U1, int b, int t, int col, const float* cw  , int nch, const float* cb, float (&y)[8]) {
#pragma unroll
    for (int i = 0; i < 8; ++i) y[i] = cb[i];
#pragma unroll
    for (int j = 0; j < 4; ++j) { const int tt = t - 3 + j;
        if (tt >= 0) { const uint4 v = *(const uint4*)(U1 + ((size_t)b * SEQ + tt) * LD1 + col); float f[8]; unpack8(v, f);
#pragma unroll
            for (int i = 0; i < 8; ++i) y[i] += cw[(size_t)j * nch + i] * f[i]; } }
}
DI void stage_raw128(const Frame& F, const bf16_t* U1, int b, int t_first, int nrows, int col, bf16_t* raw) {
    for (int it = F.tid; it < nrows * 16; it += 512) { const int row = it >> 4, ch = it & 15; const int t = t_first + row;
        uint4 v = make_uint4(0u, 0u, 0u, 0u); if (t >= 0) v = *(const uint4*)(U1 + ((size_t)b * SEQ + t) * LD1 + col + ch * 8);
        *(uint4*)(raw + row * 136 + ch * 8) = v; }
}
DI void load_raw128(const Frame& F, const bf16_t* U1, int b, int t_first, int nrows, int col, uint4 (&rg)[3]) {
#pragma unroll
    for (int j = 0; j < 3; ++j) { const int it = F.tid + j * 512; const int row = it >> 4, ch = it & 15; const int t = t_first + row;
        rg[j] = make_uint4(0u, 0u, 0u, 0u); if (it < nrows * 16 && t >= 0) rg[j] = *(const uint4*)(U1 + ((size_t)b * SEQ + t) * LD1 + col + ch * 8); }
}
DI void write_raw128(const Frame& F, int nrows, const uint4 (&rg)[3], bf16_t* raw) {
#pragma unroll
    for (int j = 0; j < 3; ++j) { const int it = F.tid + j * 512; const int row = it >> 4, ch = it & 15; if (it < nrows * 16) *(uint4*)(raw + row * 136 + ch * 8) = rg[j]; }
}
DI void conv8_lds(const bf16_t* raw, int s, int d0, const float* cw  , const float* cb  , float (&y)[8]) {
#pragma unroll
    for (int i = 0; i < 8; ++i) y[i] = cb[d0 + i];
#pragma unroll
    for (int j = 0; j < 4; ++j) { const uint4 v = *(const uint4*)(raw + (s + j) * 136 + d0); float f[8]; unpack8(v, f);
#pragma unroll
        for (int i = 0; i < 8; ++i) y[i] += cw[j * 128 + d0 + i] * f[i]; }
}
DI void mlstm_gates(const Frame& F, const bf16_t* U1, int b, int h, int c, float* li, float* bc) {
    if (F.wave == 0) {
        const size_t row = (size_t)b * SEQ + c * 64 + F.lane;
        const float* gts = (const float*)(F.ws + WS_GATES);
        const float ip = gts[row * 8 + h] + F.in[26][h];
        const float fp = gts[row * 8 + 4 + h] + F.in[27][h];
        const float lf = fminf(fp, 0.f) - log1pf(expf(-fabsf(fp)));
        float cs = lf;
        for (int o = 1; o < 64; o <<= 1) { const float n = __shfl_up(cs, o); if (F.lane >= o) cs += n; }
        li[F.lane] = ip; bc[F.lane] = cs;
    }
    __syncthreads();
}
constexpr int ML_LI = 0, ML_BC = 256, ML_WK = 512, ML_MT = 768, ML_DQ = 1024, ML_RS = 1280, ML_NIN = 1536, ML_Q = 2048, ML_K = ML_Q + 64 * 136 * 2, ML_VT = ML_K + 64 * 136 * 2,
              ML_CT = ML_VT + 128 * 72 * 2, ML_W = ML_CT + 128 * 136 * 2, ML_KT = ML_W + 64 * 72 * 2, ML_END = ML_KT + 128 * 72 * 2;
static_assert(ML_END + 5120 + LDS_WORK_OFF <= LDS_BYTES - 12288, "mlstm lds");

DI void p8a_mlstm_local(const Frame& F) {
    const bf16_t* U1 = (const bf16_t*)(F.ws + WS_U);
    bf16_t* ST = (bf16_t*)(F.ws + WS_BFB);
    float* zloc = (float*)(F.ws + WS_ZLOC); float* scal = (float*)(F.ws + WS_SCAL);
    unsigned char* L = F.lds;
    float* li = (float*)(L + ML_LI); float* bc = (float*)(L + ML_BC); float* wk = (float*)(L + ML_WK);
    bf16_t* kT = (bf16_t*)(L + ML_KT); bf16_t* vT = (bf16_t*)(L + ML_VT); float* cwl = (float*)(L + ML_END); bf16_t* raw = (bf16_t*)(L + ML_Q);
    const float* cw = F.in[24]; const float* cb = F.in[25];
    uint4 rk3[3], rv3[3];
    auto prefetch = [&](int unit) { const int c = unit & 63, h = (unit >> 6) & 3, b = unit >> 8;
        load_raw128(F, U1, b, c * 64 - 3, 67, C_DK + h * 128, rk3); load_raw128(F, U1, b, c * 64, 64, C_DV + h * 128, rv3); };
    if (F.bid < 2048) prefetch(F.bid);
    for (int unit = F.bid; unit < 2048; unit += F.G) {
        const int c = unit & 63, h = (unit >> 6) & 3, b = unit >> 8;
        mlstm_gates(F, U1, b, h, c, li, bc);
        if (F.wave == 0) {
            const float bl = bc[63]; const float dec = bl - bc[F.lane] + li[F.lane];
            const float dmx = wave_max(dec);
            wk[F.lane] = expf(dec - dmx);
            if (F.lane == 0) { scal[unit] = bl; scal[2048 + unit] = dmx; }
        }
        for (int e = F.tid; e < 640; e += 512) cwl[e] = e < 512 ? cw[(size_t)(e >> 7) * 1024 + 512 + h * 128 + (e & 127)] : cb[512 + h * 128 + (e - 512)];
        write_raw128(F, 67, rk3, raw);
        __syncthreads();
        for (int it = F.tid; it < 1024; it += 512) {
            const int s = it & 63, d0 = (it >> 6) * 8;
            float y[8]; conv8_lds(raw, s, d0, cwl, cwl + 512, y);
            const float w = wk[s] * 0.08838834764831845f;
#pragma unroll
            for (int i = 0; i < 8; ++i) kT[(d0 + i) * 72 + s] = f2bf(siluf_(y[i]) * w);
        }
        __syncthreads();
        write_raw128(F, 64, rv3, raw);
        if (unit + F.G < 2048) prefetch(unit + F.G);
        __syncthreads();
        for (int it = F.tid; it < 1024; it += 512) {
            const int s = it & 63, d0 = (it >> 6) * 8;
            const uint4 vv = *(const uint4*)(raw + s * 136 + d0); const unsigned wv[4] = {vv.x, vv.y, vv.z, vv.w};
#pragma unroll
            for (int i = 0; i < 8; ++i) vT[(d0 + i) * 72 + s] = (bf16_t)((i & 1) ? (wv[i >> 1] >> 16) : (wv[i >> 1] & 0xFFFFu));
        }
        __syncthreads();
        for (int tix = F.wave * 8; tix < F.wave * 8 + 8; ++tix) {
            const int et = tix >> 3, dt = tix & 7;
            const f32x4 a = mma16(vT + et * 16 * 72, 72, kT + dt * 16 * 72, 72, 64, F.lane);
            const int fr = F.lane & 15, fq = F.lane >> 4;
#pragma unroll
            for (int r = 0; r < 4; ++r) ST[(size_t)unit * 16384 + (size_t)(et * 16 + 4 * fq + r) * 128 + dt * 16 + fr] = f2bf(a[r]);
        }
        { const int d = F.tid >> 2, part = F.tid & 3; float z = 0.f;
#pragma unroll
          for (int s = 0; s < 16; ++s) z += bf2f(kT[d * 72 + part * 16 + s]);
          z += __shfl_xor(z, 1); z += __shfl_xor(z, 2);
          if (part == 0) zloc[(size_t)unit * 128 + d] = z; }
        __syncthreads();
    }
}

DI void p8a_lru_local(const Frame& F) {
    const bf16_t* U1 = (const bf16_t*)(F.ws + WS_U);
    bf16_t* LA = (bf16_t*)(F.ws + WS_LRUA); bf16_t* LH = (bf16_t*)(F.ws + WS_LRUH);
    float* Aend = (float*)(F.ws + WS_AEND); float* Hend = (float*)(F.ws + WS_HEND);
    const bf16_t* WAT = (const bf16_t*)(F.ws + WS_WAT); const bf16_t* WXT = (const bf16_t*)(F.ws + WS_WXT);
    bf16_t* xcb = (bf16_t*)F.lds;
    float* cwL = (float*)(F.lds + 16640);
    bf16_t* rawl = (bf16_t*)(F.lds + 16640 + 10240);
    const int g = F.wave, lane = F.lane, fr = lane & 15, fq = lane >> 4;
    __syncthreads();
    for (int e = F.tid; e < 2048; e += 512) cwL[e] = F.in[17][e];
    cwL[2048 + F.tid] = F.in[18][F.tid];
    bf16x8 wa[4][2], wx[4][2]; float ba[4], bx[4], sp[4];
#pragma unroll
    for (int ct = 0; ct < 4; ++ct) { const int ch = g * 64 + ct * 16 + fr;
#pragma unroll
        for (int ks = 0; ks < 2; ++ks) { wa[ct][ks] = *(const bf16x8*)(WAT + (size_t)ch * 64 + 32 * ks + 8 * fq); wx[ct][ks] = *(const bf16x8*)(WXT + (size_t)ch * 64 + 32 * ks + 8 * fq); }
        ba[ct] = F.in[20][ch]; bx[ct] = F.in[22][ch]; sp[ct] = log1pf(expf(-F.in[23][ch])); }
    __syncthreads();
    for (int unit = F.bid; unit < 512; unit += F.G) {
        const int b = unit >> 6, c = unit & 63, t0 = c * 64;
        float Ac[4] = {1.f, 1.f, 1.f, 1.f}, hl[4] = {0.f, 0.f, 0.f, 0.f};
        uint4 rr[3];
        auto ldraw = [&](int sub) {
#pragma unroll
            for (int j = 0; j < 3; ++j) { const int it = F.tid + j * 512; const int row = it >> 6, c8 = (it & 63) * 8; const int t = t0 + sub * 16 - 3 + row;
                rr[j] = make_uint4(0u, 0u, 0u, 0u); if (it < 19 * 64 && t >= 0) rr[j] = *(const uint4*)(U1 + ((size_t)b * SEQ + t) * LD1 + C_CX + c8); } };
        ldraw(0);
#pragma unroll 1
        for (int sub = 0; sub < 4; ++sub) {
#pragma unroll
            for (int j = 0; j < 3; ++j) { const int it = F.tid + j * 512; if (it < 19 * 64) *(uint4*)(rawl + (it >> 6) * 520 + (it & 63) * 8) = rr[j]; }
            __syncthreads();
            if (sub < 3) ldraw(sub + 1);
            for (int it = F.tid; it < 1024; it += 512) {
                const int tk = it >> 6, c8 = (it & 63) * 8;
                float y[8];
#pragma unroll
                for (int i = 0; i < 8; ++i) y[i] = cwL[2048 + c8 + i];
#pragma unroll
                for (int j = 0; j < 4; ++j) { const uint4 v = *(const uint4*)(rawl + (tk + j) * 520 + c8); float f[8]; unpack8(v, f);
#pragma unroll
                    for (int i = 0; i < 8; ++i) y[i] += cwL[j * 512 + c8 + i] * f[i]; }
                uint4 o; o.x = pack2(y[0], y[1]); o.y = pack2(y[2], y[3]); o.z = pack2(y[4], y[5]); o.w = pack2(y[6], y[7]);
                *(uint4*)(xcb + tk * 520 + c8) = o;
            }
            __syncthreads();
            bf16x8 af[2];
#pragma unroll
            for (int ks = 0; ks < 2; ++ks) af[ks] = *(const bf16x8*)(xcb + fr * 520 + g * 64 + 32 * ks + 8 * fq);
#pragma unroll
            for (int ct = 0; ct < 4; ++ct) {
                const int ch = g * 64 + ct * 16 + fr;
                f32x4 accA = {0.f, 0.f, 0.f, 0.f}, accX = {0.f, 0.f, 0.f, 0.f};
#pragma unroll
                for (int ks = 0; ks < 2; ++ks) { accA = __builtin_amdgcn_mfma_f32_16x16x32_bf16(af[ks], wa[ct][ks], accA, 0, 0, 0); accX = __builtin_amdgcn_mfma_f32_16x16x32_bf16(af[ks], wx[ct][ks], accX, 0, 0, 0); }
                float Ap[4], Hp[4]; float A4 = 1.f, H4 = 0.f;
#pragma unroll
                for (int rg = 0; rg < 4; ++rg) {
                    const float xc = bf2f(xcb[(4 * fq + rg) * 520 + ch]);
                    const float r = sigmoidf_(accA[rg] + ba[ct]), ig = sigmoidf_(accX[rg] + bx[ct]);
                    const float a = fexp_(-8.0f * r * sp[ct]);
                    const float bt = sqrtf(fmaxf(1.0f - a * a, 0.f)) * (ig * xc);
                    H4 = a * H4 + bt; A4 *= a; Ap[rg] = A4; Hp[rg] = H4;
                }
                float iA = A4, iH = H4;
                { const float pA = __shfl_up(iA, 16), pH = __shfl_up(iH, 16); if (fq >= 1) { iH = iA * pH + iH; iA = pA * iA; } }
                { const float pA = __shfl_up(iA, 32), pH = __shfl_up(iH, 32); if (fq >= 2) { iH = iA * pH + iH; iA = pA * iA; } }
                float eA = __shfl_up(iA, 16), eH = __shfl_up(iH, 16); if (fq == 0) { eA = 1.f; eH = 0.f; }
                const float tA = __shfl(iA, 48 + fr), tH = __shfl(iH, 48 + fr);
                const float cA = Ac[ct] * eA, cH = eA * hl[ct] + eH;
#pragma unroll
                for (int rg = 0; rg < 4; ++rg) { const size_t row = (size_t)b * SEQ + t0 + sub * 16 + 4 * fq + rg;
                    LA[row * 512 + ch] = f2bf(cA * Ap[rg]); LH[row * 512 + ch] = f2bf(Ap[rg] * cH + Hp[rg]); }
                hl[ct] = tA * hl[ct] + tH; Ac[ct] = Ac[ct] * tA;
            }
            __syncthreads();
        }
        if (fq == 0) {
#pragma unroll
            for (int ct = 0; ct < 4; ++ct) { const int ch = g * 64 + ct * 16 + fr; Aend[((size_t)b * 64 + c) * 512 + ch] = Ac[ct]; Hend[((size_t)b * 64 + c) * 512 + ch] = hl[ct]; } }
    }
    __syncthreads();
}

DI void p8b_scans(const Frame& F) {
    const int gt = F.bid * 512 + F.tid, nthr = F.G * 512;
    if (gt < 4096) {
        const int b = gt >> 9, ch = gt & 511;
        const float* Aend = (const float*)(F.ws + WS_AEND); const float* Hend = (const float*)(F.ws + WS_HEND); float* Hin = (float*)(F.ws + WS_HIN);
        float H = 0.f;
#pragma unroll 1
        for (int c0 = 0; c0 < 64; c0 += 8) {
            float av[8], hv[8];
#pragma unroll
            for (int j = 0; j < 8; ++j) { const size_t o = ((size_t)b * 64 + c0 + j) * 512 + ch; av[j] = Aend[o]; hv[j] = Hend[o]; }
#pragma unroll
            for (int j = 0; j < 8; ++j) { const size_t o = ((size_t)b * 64 + c0 + j) * 512 + ch; Hin[o] = H; H = av[j] * H + hv[j]; }
        }
    }
    const float* scal = (const float*)(F.ws + WS_SCAL); float* minp = (float*)(F.ws + WS_SCAL) + 4096;
    if (gt >= nthr - 4096) {
        const int q = gt - (nthr - 4096); const int bh = q >> 7, d = q & 127;
        const float* zloc = (const float*)(F.ws + WS_ZLOC); float* nin = (float*)(F.ws + WS_NIN);
        float m = 0.f, n = 0.f;
#pragma unroll 1
        for (int c0 = 0; c0 < 64; c0 += 8) {
            float zv[8];
#pragma unroll
            for (int j = 0; j < 8; ++j) zv[j] = zloc[(size_t)(bh * 64 + c0 + j) * 128 + d];
#pragma unroll
            for (int j = 0; j < 8; ++j) { const int unit = bh * 64 + c0 + j; const float bl = scal[unit], dm = scal[2048 + unit];
                const float mn = fmaxf(bl + m, dm); const float keep = expf(bl + m - mn), add = expf(dm - mn);
                nin[(size_t)unit * 128 + d] = n; if (d == 0) minp[unit] = m;
                n = keep * n + add * zv[j]; m = mn; }
        }
    }
    bf16_t* ST = (bf16_t*)(F.ws + WS_BFB);
    float* kp = (float*)F.lds; float* ad = kp + 64;
    if (gt < 65536) {
        const int bh = gt >> 11, ed = (gt & 2047) * 8;
        if (F.wave == 0) { const int c = F.lane; const int unit = bh * 64 + c; const float bl = scal[unit], dm = scal[2048 + unit];
            float Bi = bl;
            for (int o = 1; o < 64; o <<= 1) { const float n = __shfl_up(Bi, o); if (c >= o) Bi += n; }
            float pm = dm - Bi;
            for (int o = 1; o < 64; o <<= 1) { const float n = __shfl_up(pm, o); if (c >= o) pm = fmaxf(pm, n); }
            const float mnext = Bi + fmaxf(0.f, pm);
            float mcur = __shfl_up(mnext, 1); if (c == 0) mcur = 0.f;
            kp[c] = expf(bl + mcur - mnext); ad[c] = expf(dm - mnext); }
        __syncthreads();
        float C[8] = {0.f, 0.f, 0.f, 0.f, 0.f, 0.f, 0.f, 0.f};
#pragma unroll 1
        for (int c0 = 0; c0 < 64; c0 += 8) {
            uint4 sv[8];
#pragma unroll
            for (int j = 0; j < 8; ++j) sv[j] = *(const uint4*)(ST + (size_t)(bh * 64 + c0 + j) * 16384 + ed);
#pragma unroll
            for (int j = 0; j < 8; ++j) { float sf[8]; unpack8(sv[j], sf);
                uint4 o; o.x = pack2(C[0], C[1]); o.y = pack2(C[2], C[3]); o.z = pack2(C[4], C[5]); o.w = pack2(C[6], C[7]);
                *(uint4*)(ST + (size_t)(bh * 64 + c0 + j) * 16384 + ed) = o;
                const float kk = kp[c0 + j], aa = ad[c0 + j];
#pragma unroll
                for (int i = 0; i < 8; ++i) C[i] = kk * C[i] + aa * sf[i]; }
        }
    }
}

DI void p8c_mlstm_out(const Frame& F) {
    const bf16_t* U1 = (const bf16_t*)(F.ws + WS_U);
    const bf16_t* ST = (const bf16_t*)(F.ws + WS_BFB);
    bf16_t* Y = (bf16_t*)(F.ws + WS_BFA);
    const float* nin_g = (const float*)(F.ws + WS_NIN); const float* minp = (const float*)(F.ws + WS_SCAL) + 4096;
    unsigned char* L = F.lds;
    float* li = (float*)(L + ML_LI); float* bc = (float*)(L + ML_BC); float* wkk = (float*)(L + ML_WK); float* mt = (float*)(L + ML_MT); float* dq = (float*)(L + ML_DQ); float* rs = (float*)(L + ML_RS); float* nin = (float*)(L + ML_NIN);
    bf16_t* q = (bf16_t*)(L + ML_Q); bf16_t* k = (bf16_t*)(L + ML_K); bf16_t* vT = (bf16_t*)(L + ML_VT); bf16_t* CT = (bf16_t*)(L + ML_CT); bf16_t* W = (bf16_t*)(L + ML_W); float* cwl = (float*)(L + ML_END); bf16_t* raw = (bf16_t*)(L + ML_KT); float* HT = (float*)(L + ML_Q);
    const float* cw = F.in[24]; const float* cb = F.in[25];
    uint4 rq3[3], rk3[3], rv3[3]; u32x4 rc4[4];
    auto prefetch = [&](int unit) { const int c = unit & 63, h = (unit >> 6) & 3, b = unit >> 8;
        load_raw128(F, U1, b, c * 64 - 3, 67, C_DQ + h * 128, rq3);
        load_raw128(F, U1, b, c * 64 - 3, 67, C_DK + h * 128, rk3);
        load_raw128(F, U1, b, c * 64, 64, C_DV + h * 128, rv3);
#pragma unroll
        for (int j = 0; j < 4; ++j) { const int it = F.tid + j * 512; rc4[j] = *(const u32x4*)(ST + (size_t)unit * 16384 + (it >> 4) * 128 + (it & 15) * 8); } };
    if (F.bid < 2048) prefetch(F.bid);
    for (int unit = F.bid; unit < 2048; unit += F.G) {
        const int c = unit & 63, h = (unit >> 6) & 3, b = unit >> 8;
        const float m_in = minp[unit];
        for (int e = F.tid; e < 1280; e += 512) { float v;
            if (e < 512) v = cw[(size_t)(e >> 7) * 1024 + h * 128 + (e & 127)]; else if (e < 1024) v = cw[(size_t)((e - 512) >> 7) * 1024 + 512 + h * 128 + (e & 127)];
            else if (e < 1152) v = cb[h * 128 + (e - 1024)]; else v = cb[512 + h * 128 + (e - 1152)];
            cwl[e] = v; }
        mlstm_gates(F, U1, b, h, c, li, bc);
        write_raw128(F, 67, rq3, raw);
        __syncthreads();
        for (int it = F.tid; it < 1024; it += 512) { const int s = it & 63, d0 = (it >> 6) * 8;
            float y[8]; conv8_lds(raw, s, d0, cwl, cwl + 1024, y);
            uint4 o; o.x = pack2(siluf_(y[0]), siluf_(y[1])); o.y = pack2(siluf_(y[2]), siluf_(y[3])); o.z = pack2(siluf_(y[4]), siluf_(y[5])); o.w = pack2(siluf_(y[6]), siluf_(y[7]));
            *(uint4*)(q + s * 136 + d0) = o; }
        __syncthreads();
        write_raw128(F, 67, rk3, raw);
        __syncthreads();
        for (int it = F.tid; it < 1024; it += 512) { const int s = it & 63, d0 = (it >> 6) * 8;
            float y[8]; conv8_lds(raw, s, d0, cwl + 512, cwl + 1152, y);
            const float sc = 0.08838834764831845f; uint4 o;
            o.x = pack2(siluf_(y[0]) * sc, siluf_(y[1]) * sc); o.y = pack2(siluf_(y[2]) * sc, siluf_(y[3]) * sc); o.z = pack2(siluf_(y[4]) * sc, siluf_(y[5]) * sc); o.w = pack2(siluf_(y[6]) * sc, siluf_(y[7]) * sc);
            *(uint4*)(k + s * 136 + d0) = o; }
        __syncthreads();
        write_raw128(F, 64, rv3, raw);
        __syncthreads();
        for (int it = F.tid; it < 1024; it += 512) { const int s = it & 63, d0 = (it >> 6) * 8;
            const uint4 vv = *(const uint4*)(raw + s * 136 + d0); const unsigned wv[4] = {vv.x, vv.y, vv.z, vv.w};
#pragma unroll
            for (int i = 0; i < 8; ++i) vT[(d0 + i) * 72 + s] = (bf16_t)((i & 1) ? (wv[i >> 1] >> 16) : (wv[i >> 1] & 0xFFFFu)); }
#pragma unroll
        for (int j = 0; j < 4; ++j) { const int it = F.tid + j * 512; *(u32x4*)(CT + (it >> 4) * 136 + (it & 15) * 8) = rc4[j]; }
        if (unit + F.G < 2048) prefetch(unit + F.G);
        if (F.tid < 128) nin[F.tid] = nin_g[(size_t)unit * 128 + F.tid];
        if (F.tid >= 128 && F.tid < 192) { const int l = F.tid - 128;
            float pm = li[l] - bc[l];
            for (int o = 1; o < 64; o <<= 1) { const float n = __shfl_up(pm, o); if (l >= o) pm = fmaxf(pm, n); }
            mt[l] = bc[l] + fmaxf(m_in, pm); }
        __syncthreads();
        { const int l = F.tid >> 3, part = F.tid & 7; float a = 0.f;
#pragma unroll
          for (int d = 0; d < 16; ++d) a += bf2f(q[l * 136 + part * 16 + d]) * nin[part * 16 + d];
          a += __shfl_xor(a, 1); a += __shfl_xor(a, 2); a += __shfl_xor(a, 4);
          if (part == 0) dq[l] = a; }
        for (int tix = F.wave * 2; tix < F.wave * 2 + 2; ++tix) {
            const int lt = tix >> 2, st = tix & 3;
            const f32x4 a = mma16(q + lt * 16 * 136, 136, k + st * 16 * 136, 136, 128, F.lane);
            const int fr = F.lane & 15, fq = F.lane >> 4; const int s = st * 16 + fr;
#pragma unroll
            for (int r = 0; r < 4; ++r) { const int l = lt * 16 + 4 * fq + r;
                const float w = s <= l ? a[r] * expf(bc[l] - bc[s] + li[s] - mt[l]) : 0.f;
                W[l * 72 + s] = f2bf(w); }
        }
        __syncthreads();
        { const int l = F.tid >> 3, part = F.tid & 7; float a = 0.f;
#pragma unroll
          for (int s = 0; s < 8; ++s) a += bf2f(W[l * 72 + part * 8 + s]);
          a += __shfl_xor(a, 1); a += __shfl_xor(a, 2); a += __shfl_xor(a, 4);
          if (part == 0) rs[l] = a; }
        if (F.tid >= 64 && F.tid < 128) { const int l = F.tid - 64; li[l] = expf(bc[l] + m_in - mt[l]); }
        if (F.tid >= 128 && F.tid < 192) { const int l = F.tid - 128; wkk[l] = expf(-mt[l]); }
        __syncthreads();
        uint4 ro2[2], rz2[2];
#pragma unroll
        for (int j = 0; j < 2; ++j) { const int it = F.tid + j * 512; const size_t row = (size_t)b * SEQ + c * 64 + (it >> 4);
            ro2[j] = *(const uint4*)(U1 + row * LD1 + C_DO + h * 128 + (it & 15) * 8); rz2[j] = *(const uint4*)(U1 + row * LD1 + C_DZ + h * 128 + (it & 15) * 8); }
        f32x4 hres[4];
#pragma unroll
        for (int ti = 0; ti < 4; ++ti) { const int tix = F.wave * 4 + ti;
            const int lt = tix >> 3, et = tix & 7;
            const f32x4 qc = mma16(q + lt * 16 * 136, 136, CT + et * 16 * 136, 136, 128, F.lane);
            const f32x4 wv = mma16(W + lt * 16 * 72, 72, vT + et * 16 * 72, 72, 64, F.lane);
            const int fq = F.lane >> 4;
#pragma unroll
            for (int r = 0; r < 4; ++r) { const int l = lt * 16 + 4 * fq + r;
                const float prev = li[l];
                const float num = prev * qc[r] + wv[r];
                const float den = prev * dq[l] + rs[l];
                hres[ti][r] = num * __builtin_amdgcn_rcpf(fmaxf(fabsf(den), wkk[l])); }
        }
        __syncthreads();
#pragma unroll
        for (int ti = 0; ti < 4; ++ti) { const int tix = F.wave * 4 + ti; const int lt = tix >> 3, et = tix & 7; const int fr = F.lane & 15, fq = F.lane >> 4;
#pragma unroll
            for (int r = 0; r < 4; ++r) HT[(lt * 16 + 4 * fq + r) * 132 + et * 16 + fr] = hres[ti][r]; }
        __syncthreads();
#pragma unroll
        for (int j = 0; j < 2; ++j) { const int it = F.tid + j * 512; const int l = it >> 4, e0 = (it & 15) * 8;
            const size_t row = (size_t)b * SEQ + c * 64 + l;
            float of[8], zf[8]; unpack8(ro2[j], of); unpack8(rz2[j], zf);
            const f32x4 h0 = *(const f32x4*)(HT + l * 132 + e0), h1 = *(const f32x4*)(HT + l * 132 + e0 + 4);
            float y[8];
#pragma unroll
            for (int i = 0; i < 4; ++i) { y[i] = sigmoidf_(of[i]) * h0[i] * siluf_(zf[i]); y[4 + i] = sigmoidf_(of[4 + i]) * h1[i] * siluf_(zf[4 + i]); }
            uint4 o; o.x = pack2(y[0], y[1]); o.y = pack2(y[2], y[3]); o.z = pack2(y[4], y[5]); o.w = pack2(y[6], y[7]);
            *(uint4*)(Y + row * 1024 + 512 + h * 128 + e0) = o; }
        __syncthreads();
    }
}
DI void p8c_lru_out(const Frame& F) {
    const bf16_t* U1 = (const bf16_t*)(F.ws + WS_U);
    const bf16_t* LA = (const bf16_t*)(F.ws + WS_LRUA); const bf16_t* LH = (const bf16_t*)(F.ws + WS_LRUH);
    const float* Hin = (const float*)(F.ws + WS_HIN);
    bf16_t* Y = (bf16_t*)(F.ws + WS_BFA);
    const size_t n8 = (size_t)MT * 64;
    for (size_t it = (size_t)F.bid * 512 + F.tid; it < n8; it += (size_t)F.G * 512) {
        const size_t row = it >> 6; const int c0 = (int)(it & 63) * 8; const int b = (int)(row >> 12), t = (int)(row & 4095), c = t >> 6;
        const uint4 av = *(const uint4*)(LA + row * 512 + c0), hv = *(const uint4*)(LH + row * 512 + c0), zv = *(const uint4*)(U1 + row * LD1 + C_CZ + c0);
        float af[8], hf[8], zf[8]; unpack8(av, af); unpack8(hv, hf); unpack8(zv, zf);
        const float* hi = Hin + ((size_t)b * 64 + c) * 512 + c0; float y[8];
#pragma unroll
        for (int i = 0; i < 8; ++i) y[i] = (af[i] * hi[i] + hf[i]) * siluf_(zf[i]);
        uint4 o; o.x = pack2(y[0], y[1]); o.y = pack2(y[2], y[3]); o.z = pack2(y[4], y[5]); o.w = pack2(y[6], y[7]);
        *(uint4*)(Y + row * 1024 + c0) = o;
    }
}

constexpr int N_PHASES = 16;
__global__ void __launch_bounds__(512, 2) mk_fwd(Args args) {
    extern __shared__ __attribute__((aligned(16))) unsigned char smem[];
    Frame F;
    F.tid = threadIdx.x; F.lane = F.tid & 63; F.wave = __builtin_amdgcn_readfirstlane(F.tid >> 6);
    F.G = gridDim.x; F.bid = blockIdx.x; F.gw = F.bid * 8 + F.wave; F.nw = F.G * 8;
    F.lds = smem + LDS_WORK_OFF; F.ws = args.ws; F.out = args.out; F.ctl = (unsigned*)args.ws;
#pragma unroll
    for (int i = 0; i < 28; ++i) F.in[i] = args.in[i];
    LAS unsigned char* lsm = (LAS unsigned char*)smem;
    LAS unsigned char* lut = lsm + (LDS_BYTES - 12288);
    LAS float* tbl = (LAS float*)(lsm + (LDS_BYTES - 12288 + 256));
    LAS float* biasL = (LAS float*)(lsm + (LDS_BYTES - 8192));
    if (F.tid < 4) ((LAS unsigned*)lsm)[F.tid] = 0u;
    if (F.tid < 128) { const int n = F.tid; int bk;
        if (n < 16) bk = n; else { bk = 16; const int thr[15] = {19, 21, 24, 27, 31, 35, 40, 46, 52, 59, 67, 77, 87, 99, 113};
#pragma unroll
            for (int j = 0; j < 15; ++j) bk += (n >= thr[j]) ? 1 : 0; }
        lut[n] = (unsigned char)bk; }
    { const int hd = F.tid >> 5, bk = F.tid & 31; tbl[hd * 32 + bk] = args.in[6][bk * 16 + hd]; }
    F.lut = lut; F.tbl = tbl; F.biasL = biasL; F.ldsl = lsm + LDS_WORK_OFF;
    __syncthreads();
    for (int e = F.tid; e < 16 * 128; e += 512) { const int hd = e >> 7, n = e & 127; const int bk = n < 16 ? n : (n >= 113 ? 31 : (int)lut[n]); biasL[e] = tbl[hd * 32 + bk] * 1.4426950408889634f; }
    __syncthreads();
    const int lo = args.ph_lo, hi = args.ph_hi;
    XcdBarrier bar; bar.bar = F.ctl; bar.x = 0; bar.st = nullptr;
#if !MK_PER_PHASE
    bar = xcd_barrier_post(F.ctl, (volatile LAS unsigned*)lsm);
#endif
#ifndef PH_MASK
#define PH_MASK 0xFFFF
#endif
#define IN(k) (phase_refresh(F), ((PH_MASK >> (k)) & 1) && lo <= (k) && (k) < hi)
#ifndef DLY_LO
#define DLY_LO -1
#define DLY_HI -1
#endif
#ifndef DLY_MULT
#define DLY_MULT 4
#endif
    unsigned long long dly_t0 = 0ull;
#define DLY_START(k) do { if ((k) == DLY_LO && F.bid == 0 && F.tid == 0) dly_t0 = __builtin_amdgcn_s_memrealtime(); } while (0)
#define DLY_END(k) do { if ((k) == DLY_HI && F.bid == 0) { if (F.tid == 0) { const unsigned long long t1 = __builtin_amdgcn_s_memrealtime(); const unsigned long long until = t1 + DLY_MULT * (t1 - dly_t0); \
        while (__builtin_amdgcn_s_memrealtime() < until) __builtin_amdgcn_s_sleep(16); } __syncthreads(); } } while (0)
#if MK_PER_PHASE
#define SEAM(k) do { } while (0)
#else
#define SEAM(k) do { if (IN(k) && IN((k) + 1)) xcd_barrier(bar); DLY_END(k); DLY_START((k) + 1); } while (0)
#endif
    LAS unsigned char* glds = lsm + LDS_WORK_OFF;
    unsigned char* ws = args.ws;
    bf16_t* BFA = (bf16_t*)(ws + WS_BFA); bf16_t* BFB = (bf16_t*)(ws + WS_BFB); bf16_t* U = (bf16_t*)(ws + WS_U); bf16_t* Ef = (bf16_t*)(ws + WS_U); bf16_t* X1b = (bf16_t*)F.out;

    DLY_START(0);
    if (IN(0)) { p0_prologue(F); }
    SEAM(0);
    if (IN(1)) {
        pg8::Gemm g{BFA, (const bf16_t*)(ws + WS_WIN0), MT, LD0, 1024}; pg8::StaticOrder S; S.init(MT, LD0, F.G, F.bid);
        pg8::EpiBf16<0> E{U, LD0};
        pg8::gemm_phase(glds, g, S, E);
        pg8::Gemm g2{(const bf16_t*)(ws + WS_WVT), BFA, 512, MT, 1024}; pg8::StaticOrder S2; S2.init(512, MT, F.G, F.bid);
        pg8::EpiBf16<0> E2{(bf16_t*)(ws + WS_VT), MT};
        pg8::gemm_phase(glds, g2, S2, E2);
    }
    SEAM(1);
    if (IN(2)) { p2a_build_blocks(F); }
    SEAM(2);
    if (IN(3)) {
        if (F.bid < 32) {
            const int which = F.bid >> 4;
            pg8::Gemm g{(const bf16_t*)(ws + (which ? WS_AV : WS_AK)), (const bf16_t*)(ws + (which ? WS_WC1V : WS_WC1K)), 4096, 256, 2048}; pg8::StaticOrder S; S.init(4096, 256, F.G, F.bid & 15);
            pg8::EpiBf16<1> E{(bf16_t*)(ws + (which ? WS_HV : WS_HK)), 256}; pg8::gemm_phase(glds, g, S, E);
            asm volatile("s_waitcnt vmcnt(0)" ::: "memory"); __syncthreads();
            pg8::Unit u; S.next(0, u);
            p2c_compress_rows(F, which, u.pm * 256);
            asm volatile("s_waitcnt vmcnt(0)" ::: "memory"); __syncthreads();
            if (F.tid == 0) { __builtin_amdgcn_fence(__ATOMIC_RELEASE, "agent"); asm volatile("s_waitcnt vmcnt(0)" ::: "memory");
                (void)__hip_atomic_fetch_add(F.ctl + CW_CMPDONE, 1u, __ATOMIC_RELAXED, __HIP_MEMORY_SCOPE_AGENT); }
        }
        att_dsa(F);
    }
    if (IN(5)) {
        if (F.tid == 0) { unsigned sp = 0;
            while (__hip_atomic_load(F.ctl + CW_CMPDONE, __ATOMIC_RELAXED, __HIP_MEMORY_SCOPE_AGENT) < 32u) { __builtin_amdgcn_s_sleep(2);
                if (++sp > (1u << 22)) { atomicAdd(F.ctl + XB_TMO, 1u); break; } }
            __builtin_amdgcn_fence(__ATOMIC_ACQUIRE, "agent"); asm volatile("s_waitcnt vmcnt(0)" ::: "memory"); }
        __syncthreads();
        att_nsa(F); }
    if (IN(3) && IN(6)) xcd_barrier(bar);
    if (IN(6)) {
        pg8::Gemm g{BFB, (const bf16_t*)(ws + WS_WOUT0), MT, 1024, 1024}; pg8::StaticOrder S; S.init(MT, 1024, F.G, F.bid);
        pg8::EpiResid<0> E{F.in[0], nullptr, BFA};
        pg8::gemm_phase(glds, g, S, E);
    }
    SEAM(6);
    if (IN(7)) {
        { pg8::Gemm g{(const bf16_t*)(ws + WS_PBF), (const bf16_t*)(ws + WS_WP0), MT, 1024, 256}; pg8::StaticOrder S; S.init(MT, 1024, F.G, F.bid);
          pg8::EpiBf16<0> E{Ef, 1024}; pg8::gemm_phase(glds, g, S, E); }
        asm volatile("s_waitcnt vmcnt(0)" ::: "memory"); __syncthreads();
        { pg8::Gemm g{BFA, (const bf16_t*)(ws + WS_WG0), MT, 1024, 1024}; pg8::StaticOrder S; S.init(MT, 1024, F.G, F.bid);
          pg8::EpiGate<1> E{nullptr, X1b, BFA, Ef}; pg8::gemm_phase(glds, g, S, E); }
    }
    SEAM(7);
    if (IN(8)) { rmsnorm_gates(F, X1b, F.in[2] + 1024, BFB); }
    SEAM(8);
    if (IN(9)) {
        pg8::Gemm g{BFB, (const bf16_t*)(ws + WS_WIN1), MT, LD1, 1024}; pg8::StaticOrder S; S.init(MT, LD1, F.G, F.bid);
        pg8::EpiBf16<0> E{U, LD1};
        pg8::gemm_phase(glds, g, S, E);
    }
    SEAM(9);
    if (IN(10)) { p8a_mlstm_local(F); p8a_lru_local(F); }
    SEAM(10);
    if (IN(11)) { p8b_scans(F); }
    SEAM(11);
    if (IN(12)) { p8c_mlstm_out(F); p8c_lru_out(F); }
    SEAM(12);

    if (IN(13)) {
        pg8::Gemm g{BFA, (const bf16_t*)(ws + WS_WOUT1), MT, 1024, 1024}; pg8::StaticOrder S; S.init(MT, 1024, F.G, F.bid);
        pg8::EpiResid<1> E{nullptr, X1b, BFB};
        pg8::gemm_phase(glds, g, S, E);
    }
    SEAM(13);
    if (IN(14)) {
        { pg8::Gemm g{(const bf16_t*)(ws + WS_PBF) + (size_t)MT * 256, (const bf16_t*)(ws + WS_WP1), MT, 1024, 256}; pg8::StaticOrder S; S.init(MT, 1024, F.G, F.bid);
          pg8::EpiBf16<0> E{Ef, 1024}; pg8::gemm_phase(glds, g, S, E); }
        asm volatile("s_waitcnt vmcnt(0)" ::: "memory"); __syncthreads();
        { pg8::Gemm g{BFB, (const bf16_t*)(ws + WS_WG1), MT, 1024, 1024}; pg8::StaticOrder S; S.init(MT, 1024, F.G, F.bid);
          pg8::EpiGate<0> E{F.out, nullptr, BFB, Ef}; pg8::gemm_phase(glds, g, S, E); }
    }
    SEAM(14);
    if (IN(15)) { rmsnorm_rows<1>(F, F.out, F.in[3], nullptr, F.out); }
#undef IN
#undef SEAM
}

extern "C" void kernel_launch(void* const* d_in, const int* in_sizes, int n_in, void* d_out, int out_size, void* d_ws, size_t ws_size, hipStream_t stream) {
    static int grid = 0;
    if (grid == 0) {
        if (n_in != 28 || out_size != MT * DM || ws_size < WS_END) { fprintf(stderr, "kernel_launch: unexpected shapes (n_in %d, out %d, ws %zu < %zu)\n", n_in, out_size, ws_size, (size_t)WS_END); grid = -1; return; }
        int dev = 0, cus = 0, per_cu = 0;
        if (hipGetDevice(&dev) != hipSuccess || hipDeviceGetAttribute(&cus, hipDeviceAttributeMultiprocessorCount, dev) != hipSuccess) { grid = -1; return; }
        if (hipFuncSetAttribute((const void*)mk_fwd, hipFuncAttributeMaxDynamicSharedMemorySize, LDS_BYTES) != hipSuccess) { fprintf(stderr, "kernel_launch: hipFuncSetAttribute failed\n"); grid = -1; return; }
        if (hipOccupancyMaxActiveBlocksPerMultiprocessor(&per_cu, (const void*)mk_fwd, 512, LDS_BYTES) != hipSuccess || per_cu < 1)
            fprintf(stderr, "kernel_launch: occupancy query reports %d workgroups per CU\n", per_cu);
        (void)hipGetLastError();
        grid = cus;
    }
    if (grid < 0) return;
    if (hipMemsetAsync(d_ws, 0, CTL_BYTES, stream) != hipSuccess) return;
    Args a{};
    for (int i = 0; i < 28; ++i) a.in[i] = (const float*)d_in[i];
    a.out = (float*)d_out; a.ws = (unsigned char*)d_ws;
#if MK_PER_PHASE
    for (int p = 0; p < N_PHASES; ++p) { a.ph_lo = p; a.ph_hi = p + 1; hipLaunchKernelGGL(mk_fwd, dim3(grid), dim3(512), LDS_BYTES, stream, a); }
#else
    a.ph_lo = 0; a.ph_hi = N_PHASES;
    hipLaunchKernelGGL(mk_fwd, dim3(grid), dim3(512), LDS_BYTES, stream, a);
#endif
}
```

```cpp
#include <hip/hip_runtime.h>
#include <cstdio>
#include <cstdint>

#ifndef MK_PER_PHASE
#define MK_PER_PHASE 0
#endif

#define LAS __attribute__((address_space(3)))
typedef unsigned short bf16_t;
typedef short bf16x8 __attribute__((ext_vector_type(8)));
typedef float f32x4 __attribute__((ext_vector_type(4)));
#define DI __device__ __forceinline__

constexpr int NB = 8, SEQ = 4096, DM = 1024, MT = NB * SEQ;
constexpr int LD0 = 3072, LD1 = 3584;
constexpr int C_AQ = 0, C_KC = 512, C_VC = 640, C_KS = 768, C_KW = 896, C_AZ = 1024, C_BQ = 1536, C_BZ = 2048,
              C_BK = 2560, C_BKI = 2624, C_BQI = 2688, C_AG = 2944, C_BWI = 2968;
constexpr int C_VS = 0, C_VW = 0, C_BV = 0;
constexpr int C_CX = 0, C_CZ = 512, C_DQ = 1024, C_DK = 1536, C_DV = 2048, C_DO = 2560, C_DZ = 3072;
constexpr int NCMP = 255;
constexpr float NEG_INF = -__builtin_inff();

DI int map0(int n) {
    if (n < 896) return n;
    if (n < 1024) return 1024 + (n - 896);
    if (n < 1536) return 1304 + (n - 1024);
    if (n < 2048) return 1816 + (n - 1536);
    if (n < 2560) return 2780 + (n - 2048);
    if (n < 2624) return 2328 + (n - 2560);
    if (n < 2688) return 2712 + (n - 2624);
    if (n < 2944) return 2456 + (n - 2688);
    if (n < 2968) return 1280 + (n - 2944);
    if (n < 2972) return 2776 + (n - 2968);
    return -1;
}
DI int map1(int n) {
    if (n < 2560) return n;
    if (n < 3072) return 2568 + (n - 2560);
    if (n < 3584) return 3080 + (n - 3072);
    return -1;
}
DI int mapid(int n) { return n; }
DI int mapv(int f) { return f < 128 ? 896 + f : (f < 256 ? 1152 + (f - 128) : (f < 320 ? 2392 + (f - 256) : -1)); }

constexpr size_t CTL_BYTES = 16384;
constexpr size_t WS_WIN0  = CTL_BYTES;
constexpr size_t WS_WOUT0 = WS_WIN0  + (size_t)LD0 * 1024 * 2;
constexpr size_t WS_WG0   = WS_WOUT0 + (size_t)1024 * 1024 * 2;
constexpr size_t WS_WP0   = WS_WG0   + (size_t)1024 * 1024 * 2;
constexpr size_t WS_WIN1  = WS_WP0   + (size_t)1024 * 256 * 2;
constexpr size_t WS_WOUT1 = WS_WIN1  + (size_t)LD1 * 1024 * 2;
constexpr size_t WS_WG1   = WS_WOUT1 + (size_t)1024 * 1024 * 2;
constexpr size_t WS_WP1   = WS_WG1   + (size_t)1024 * 1024 * 2;
constexpr size_t WS_WC1K  = WS_WP1   + (size_t)1024 * 256 * 2;
constexpr size_t WS_WC1V  = WS_WC1K  + (size_t)256 * 2048 * 2;
constexpr size_t WS_WVT   = WS_WC1V  + (size_t)256 * 2048 * 2;
constexpr size_t WS_BFA   = WS_WVT   + (size_t)512 * 1024 * 2;
constexpr size_t WS_BFB   = WS_BFA   + (size_t)MT * 1024 * 2;
constexpr size_t WS_PBF   = WS_BFB   + (size_t)MT * 1024 * 2;
constexpr size_t WS_U     = WS_PBF   + (size_t)2 * MT * 256 * 2;
constexpr size_t WS_X     = WS_U     + (size_t)MT * LD1 * 2;
constexpr size_t WS_AK    = WS_X;
constexpr size_t WS_AV    = WS_AK    + (size_t)4096 * 2048 * 2;
constexpr size_t WS_HK    = WS_AV    + (size_t)4096 * 2048 * 2;
constexpr size_t WS_HV    = WS_HK    + (size_t)4096 * 256 * 2;
constexpr size_t WS_LRUA  = WS_X;
constexpr size_t WS_LRUH  = WS_LRUA  + (size_t)MT * 512 * 2;
constexpr size_t WS_S     = WS_X     + (size_t)64 * 1024 * 1024;
constexpr size_t WS_KCMP  = WS_S;
constexpr size_t WS_VCMP  = WS_KCMP  + (size_t)16 * 256 * 64 * 4;
constexpr size_t WS_AEND  = WS_VCMP  + (size_t)16 * 256 * 64 * 4;
constexpr size_t WS_HEND  = WS_AEND  + (size_t)8 * 64 * 512 * 4;
constexpr size_t WS_HIN   = WS_HEND  + (size_t)8 * 64 * 512 * 4;
constexpr size_t WS_ZLOC  = WS_HIN   + (size_t)8 * 64 * 512 * 4;
constexpr size_t WS_NIN   = WS_ZLOC  + (size_t)2048 * 128 * 4;
constexpr size_t WS_SCAL  = WS_NIN   + (size_t)2048 * 128 * 4;
constexpr size_t WS_VCT   = WS_SCAL  + (size_t)3 * 2048 * 4;
constexpr size_t WS_WAT   = WS_VCT   + (size_t)16 * 64 * 256 * 2;
constexpr size_t WS_WXT   = WS_WAT   + (size_t)8 * 64 * 64 * 2;
constexpr size_t WS_GATES = WS_WXT   + (size_t)8 * 64 * 64 * 2;
constexpr size_t WS_END   = WS_GATES + (size_t)MT * 8 * 4;
constexpr size_t WS_VT    = WS_U     + (size_t)MT * LD0 * 2;
static_assert(WS_VT + (size_t)512 * MT * 2 <= WS_X, "VT region");
static_assert(WS_HV + (size_t)4096 * 256 * 2 <= WS_S, "compress region");
static_assert(WS_LRUH + (size_t)MT * 512 * 2 <= WS_S, "lru region");

constexpr int XCD_BAR_WORDS_C = 3456;
constexpr int CW_QNSA = 3520, CW_QDSA = 3584;
constexpr int CW_CMPDONE = 3648;

constexpr int LDS_BYTES = 147456;
constexpr int LDS_CTL_OFF = 0;
constexpr int LDS_WORK_OFF = 128;

DI float bf2f(bf16_t v) { return __uint_as_float(((unsigned)v) << 16); }
DI bf16_t f2bf(float f) { unsigned u = __float_as_uint(f); u += 0x7FFFu + ((u >> 16) & 1u); return (bf16_t)(u >> 16); }
typedef __bf16 bf16v2 __attribute__((ext_vector_type(2)));
typedef float f32x2 __attribute__((ext_vector_type(2)));
DI unsigned pack2(float lo, float hi) { const f32x2 v = {lo, hi}; return __builtin_bit_cast(unsigned, __builtin_convertvector(v, bf16v2)); }
DI float fexp_(float x) { return __builtin_amdgcn_exp2f(x * 1.4426950408889634f); }
DI float sigmoidf_(float x) { return __builtin_amdgcn_rcpf(1.0f + fexp_(-x)); }
DI float siluf_(float x) { return x * __builtin_amdgcn_rcpf(1.0f + fexp_(-x)); }
DI float wave_max(float v) { for (int o = 32; o >= 1; o >>= 1) v = fmaxf(v, __shfl_xor(v, o)); return v; }
DI float wave_sum(float v) { for (int o = 32; o >= 1; o >>= 1) v += __shfl_xor(v, o); return v; }
DI void unpack8(const uint4& v, float (&f)[8]) {
    f[0] = __uint_as_float(v.x << 16); f[1] = __uint_as_float(v.x & 0xFFFF0000u);
    f[2] = __uint_as_float(v.y << 16); f[3] = __uint_as_float(v.y & 0xFFFF0000u);
    f[4] = __uint_as_float(v.z << 16); f[5] = __uint_as_float(v.z & 0xFFFF0000u);
    f[6] = __uint_as_float(v.w << 16); f[7] = __uint_as_float(v.w & 0xFFFF0000u);
}

#define XB_TMO      128
#define XB_XCNT(j)  (256  + 64 * (j))
#define XB_XSUB(j)  (1280 + 64 * (j))
#define XB_XGEN(j)  (2304 + 64 * (j))
#define XB_TOP      3328
#define XB_TOPGEN   3392
#define XCD_BAR_WORDS 3456
#define XB_SPIN_CAP (1u << 22)
static_assert(XCD_BAR_WORDS == XCD_BAR_WORDS_C, "bar words");

__device__ __forceinline__ unsigned xb_ld(unsigned* p)              { return __hip_atomic_load(p, __ATOMIC_RELAXED, __HIP_MEMORY_SCOPE_AGENT); }
__device__ __forceinline__ unsigned xb_add(unsigned* p, unsigned v) { return __hip_atomic_fetch_add(p, v, __ATOMIC_RELAXED, __HIP_MEMORY_SCOPE_AGENT); }
__device__ __forceinline__ unsigned xb_xcc_id() { return (unsigned)__builtin_amdgcn_s_getreg((3 << 11) | 20) & 0xFu; }
#define XB_SPIN(cond, bar) do { unsigned _sp = 0; while (cond) { __builtin_amdgcn_s_sleep(1); \
    if ((++_sp & 255u) == 0u) { if (xb_ld(&(bar)[XB_TMO])) break; if (_sp > XB_SPIN_CAP) { atomicAdd(&(bar)[XB_TMO], 1u); break; } } } } while (0)

struct XcdBarrier { unsigned* bar; unsigned x; volatile LAS unsigned* st; };

__device__ __forceinline__ XcdBarrier xcd_barrier_post(unsigned* bar, volatile LAS unsigned* st) {
    XcdBarrier b; b.bar = bar; b.x = xb_xcc_id(); b.st = st;
    if (threadIdx.x == 0) (void)xb_add(&bar[XB_XCNT(b.x)], 1u);
    return b;
}
__device__ __forceinline__ void xcd_barrier_complete(unsigned* bar, unsigned x, unsigned& nloc, unsigned& nx) {
    const unsigned G = gridDim.x * gridDim.y * gridDim.z;
    unsigned sum, cnt, mine, sp = 0u;
    for (;;) {
        sum = 0u; cnt = 0u; mine = 0u;
#pragma unroll
        for (unsigned j = 0; j < 16; ++j) { const unsigned c = xb_ld(&bar[XB_XCNT(j)]); sum += c; cnt += (c > 0u) ? 1u : 0u; mine = (j == x) ? c : mine; }
        if (sum == G) break;
        __builtin_amdgcn_s_sleep(1);
        if ((++sp & 255u) == 0u) { if (xb_ld(&bar[XB_TMO])) break; if (sp > XB_SPIN_CAP) { atomicAdd(&bar[XB_TMO], 1u); break; } }
    }
    nloc = mine > 0u ? mine : 1u; nx = cnt > 0u ? cnt : 1u;
}
__device__ __forceinline__ void xcd_barrier(const XcdBarrier& b) {
    asm volatile("s_waitcnt vmcnt(0)" ::: "memory");
    __syncthreads();
    if (threadIdx.x == 0) {
        unsigned* bar = b.bar;
        __builtin_amdgcn_s_waitcnt(0);
        unsigned nloc = b.st[0], nx = b.st[1];
        if (nloc == 0u) { xcd_barrier_complete(bar, b.x, nloc, nx); b.st[0] = nloc; b.st[1] = nx; }
        const unsigned old = xb_add(&bar[XB_XSUB(b.x)], 1u);
        const unsigned gen = old / nloc;
        if (old + 1u == (gen + 1u) * nloc) {
            __builtin_amdgcn_fence(__ATOMIC_RELEASE, "agent");
            asm volatile("s_waitcnt vmcnt(0)" ::: "memory");
            const unsigned og = xb_add(&bar[XB_TOP], 1u);
            const unsigned tg = og / nx;
            if (og + 1u == (tg + 1u) * nx) xb_add(&bar[XB_TOPGEN], 1u);
            else XB_SPIN(xb_ld(&bar[XB_TOPGEN]) == tg, bar);
            __builtin_amdgcn_fence(__ATOMIC_ACQUIRE, "agent");
            xb_add(&bar[XB_XGEN(b.x)], 1u);
            asm volatile("s_waitcnt vmcnt(0)" ::: "memory");
        } else {
            XB_SPIN(xb_ld(&bar[XB_XGEN(b.x)]) == gen, bar);
            __builtin_amdgcn_fence(__ATOMIC_ACQUIRE, "agent");
            asm volatile("s_waitcnt vmcnt(0)" ::: "memory");
        }
    }
    __syncthreads();
}

namespace pg8 {
constexpr int BM = 256, BK = 64, HALF = 128, HTB = HALF * BK * 2, STAGE_BYTES = 8 * HTB, NXCD = 8, WGM = 8;
__host__ __device__ __forceinline__ int lds_byte(int r, int c) { const int st = (r >> 4) * 2 + (c >> 5), rr = r & 15, cc = c & 31, ob = rr * 64 + cc * 2; return st * 1024 + (ob ^ (((ob >> 9) & 1) << 5)); }
__host__ __device__ __forceinline__ void stage_rc(int b, int& R, int& C) { const int st = b / 1024, sb = b % 1024, swz = sb ^ (((sb >> 9) & 1) << 5); R = (st >> 1) * 16 + swz / 64; C = (st & 1) * 32 + (swz % 64) / 2; }
__host__ __device__ __forceinline__ int perm32(int rho) { const int n = rho >> 4, i = rho & 15; return 8 * (i >> 2) + 4 * n + (i & 3); }
struct Unit { int pm, pn; };
struct Gemm { const bf16_t* A; const bf16_t* Bt; int M, N, K; };
struct StaticOrder {
    int nM, nN, nwg, G, c;
    __host__ __device__ __forceinline__ void init(int M, int N, int G_, int c_) { nM = M / BM; nN = N / BM; nwg = nM * nN; G = G_; c = c_; }
    __host__ __device__ __forceinline__ bool next(int i, Unit& u) const {
        const long L = (long)i * G + c; if (L >= nwg) return false;
        int wgid = (int)L; { const int q = nwg / NXCD, r = nwg % NXCD, xcd = wgid % NXCD, off = wgid / NXCD; wgid = (xcd < r ? xcd * (q + 1) : r * (q + 1) + (xcd - r) * q) + off; }
        const int nig = WGM * nN, gid = wgid / nig, fm = gid * WGM, gsz = (nM - fm) < WGM ? (nM - fm) : WGM;
        u.pm = fm + ((wgid % nig) % gsz); u.pn = (wgid % nig) / gsz; return true;
    }
    __device__ __forceinline__ void a_ready(const Unit&) const {}
    __device__ __forceinline__ void done(const Unit&) const {}
};
template <class Epi, class Sched>
__device__ __forceinline__ void gemm_phase(LAS unsigned char* lds, const Gemm g, const Sched& S, const Epi& E) {
    int tid_ = threadIdx.x; asm volatile("" : "+v"(tid_));
    const int tid = tid_, wid = __builtin_amdgcn_readfirstlane(tid >> 6), lane = tid & 63, wr = wid >> 2, wc = wid & 3, fr = lane & 15, fq = lane >> 4;
    const int K = g.K, nt = K / BK;
    unsigned voffA[2], voffB[2];
#pragma unroll
    for (int i = 0; i < 2; ++i) { int R, C; stage_rc(tid * 16 + i * 8192, R, C); const int Rb = Epi::PERM ? ((R & ~31) + perm32(R & 31)) : R;
        voffA[i] = (unsigned)(R * K + C) * 2u; voffB[i] = (unsigned)(Rb * K + C) * 2u; }
    const size_t kstep = (size_t)(BK * 2);
    const size_t hstep = (size_t)HALF * K * 2;
    const size_t tstep = 2 * hstep;
    const unsigned ldsw = (unsigned)wid * 1024u;
    const int aoff = lds_byte(wr * 64 + fr, fq * 8), boff = lds_byte(wc * 32 + fr, fq * 8);
#define PG8_SA(b, h) (((b) * 2 + (h)) * HTB)
#define PG8_SB(b, h) ((4 + (b) * 2 + (h)) * HTB)
#define PG8_STAGE(bufoff, gbase, voff) do { _Pragma("unroll") for (int _i = 0; _i < 2; ++_i) \
        __builtin_amdgcn_global_load_lds((const unsigned*)((const char*)(gbase) + (voff)[_i]), (LAS unsigned*)(lds + (bufoff) + ldsw + _i * 8192), 16, 0, 0); } while (0)
#define PG8_LDA(dst, b, h) do { _Pragma("unroll") for (int m = 0; m < 4; ++m) _Pragma("unroll") for (int k = 0; k < 2; ++k) dst[m][k] = *(const LAS bf16x8*)(lds + PG8_SA(b, h) + aoff + m * 2048 + k * 1024); } while (0)
#define PG8_LDB(dst, b, h) do { _Pragma("unroll") for (int n = 0; n < 2; ++n) _Pragma("unroll") for (int k = 0; k < 2; ++k) dst[n][k] = *(const LAS bf16x8*)(lds + PG8_SB(b, h) + boff + n * 2048 + k * 1024); } while (0)
#define PG8_MMA(ai, bj, At, Bt) do { __builtin_amdgcn_s_setprio(1); _Pragma("unroll") for (int m = 0; m < 4; ++m) _Pragma("unroll") for (int n = 0; n < 2; ++n) _Pragma("unroll") for (int k = 0; k < 2; ++k) \
        acc[ai][bj][m][n] = __builtin_amdgcn_mfma_f32_16x16x32_bf16(Bt[n][k], At[m][k], acc[ai][bj][m][n], 0, 0, 0); __builtin_amdgcn_s_setprio(0); } while (0)
#define PG8_WAIT_V(n) asm volatile("s_waitcnt vmcnt(" #n ")" ::: "memory")
#define PG8_WAIT_L(n) asm volatile("s_waitcnt lgkmcnt(" #n ")" ::: "memory")
#define PG8_BAR __builtin_amdgcn_s_barrier()
#define PG8_SCHED __builtin_amdgcn_sched_barrier(0)
    Unit cur, nxt; int ui = 0;
    if (!S.next(0, cur)) return;
    f32x4 acc[2][2][4][2];
#pragma unroll
    for (int a = 0; a < 2; ++a)
#pragma unroll
        for (int b = 0; b < 2; ++b)
#pragma unroll
            for (int m = 0; m < 4; ++m)
#pragma unroll
                for (int n = 0; n < 2; ++n) acc[a][b][m][n] = (f32x4){0.f, 0.f, 0.f, 0.f};
    bf16x8 At[4][2], B0[2][2], B1[2][2];
    const char* cA = (const char*)g.A + (size_t)cur.pm * tstep; const char* cB = (const char*)g.Bt + (size_t)cur.pn * tstep;
    S.a_ready(cur);
    PG8_STAGE(PG8_SB(0, 0), cB, voffB); PG8_STAGE(PG8_SA(0, 0), cA, voffA); PG8_STAGE(PG8_SB(0, 1), cB + hstep, voffB); PG8_STAGE(PG8_SA(0, 1), cA + hstep, voffA);
    if (wr == 1) PG8_BAR;
    PG8_WAIT_V(4); PG8_BAR;
    PG8_STAGE(PG8_SB(1, 0), cB + kstep, voffB); PG8_STAGE(PG8_SA(1, 0), cA + kstep, voffA); PG8_STAGE(PG8_SB(1, 1), cB + hstep + kstep, voffB);
    PG8_WAIT_V(6); PG8_BAR;
    for (;;) {
        const bool has_next = S.next(ui + 1, nxt);
        const char* nA = has_next ? (const char*)g.A + (size_t)nxt.pm * tstep : cA; const char* nB = has_next ? (const char*)g.Bt + (size_t)nxt.pn * tstep : cB;
        for (int t = 0; t < nt; t += 2) {
            const bool last = (t == nt - 2);
            const char* a1 = cA + (size_t)(t + 1) * kstep;
            const char* a2 = last ? nA : cA + (size_t)(t + 2) * kstep; const char* b2 = last ? nB : cB + (size_t)(t + 2) * kstep;
            const char* a3 = a2 + kstep; const char* b3 = b2 + kstep;
            if (last && has_next) S.a_ready(nxt);
            PG8_LDB(B0, 0, 0); PG8_SCHED; PG8_LDA(At, 0, 0); PG8_STAGE(PG8_SA(1, 1), a1 + hstep, voffA);
            PG8_WAIT_L(8); PG8_BAR; PG8_WAIT_L(0); PG8_MMA(0, 0, At, B0); PG8_BAR; PG8_SCHED;
            PG8_LDB(B1, 0, 1); PG8_STAGE(PG8_SB(0, 0), b2, voffB);
            PG8_BAR; PG8_WAIT_L(0); PG8_MMA(0, 1, At, B1); PG8_BAR;
            PG8_LDA(At, 0, 1); PG8_STAGE(PG8_SA(0, 0), a2, voffA);
            PG8_BAR; PG8_WAIT_L(0); PG8_MMA(1, 0, At, B0); PG8_BAR; PG8_SCHED;
            PG8_STAGE(PG8_SB(0, 1), b2 + hstep, voffB);
            PG8_WAIT_V(6); PG8_BAR; PG8_MMA(1, 1, At, B1); PG8_BAR;
            PG8_LDB(B0, 1, 0); PG8_SCHED; PG8_LDA(At, 1, 0); PG8_STAGE(PG8_SA(0, 1), a2 + hstep, voffA);
            PG8_WAIT_L(8); PG8_BAR; PG8_WAIT_L(0); PG8_MMA(0, 0, At, B0); PG8_BAR; PG8_SCHED;
            PG8_LDB(B1, 1, 1); PG8_STAGE(PG8_SB(1, 0), b3, voffB);
            PG8_BAR; PG8_WAIT_L(0); PG8_MMA(0, 1, At, B1); PG8_BAR;
            PG8_LDA(At, 1, 1); PG8_STAGE(PG8_SA(1, 0), a3, voffA);
            PG8_BAR; PG8_WAIT_L(0); PG8_MMA(1, 0, At, B0); PG8_BAR; PG8_SCHED;
            PG8_STAGE(PG8_SB(1, 1), b3 + hstep, voffB);
            PG8_WAIT_V(6); PG8_BAR; PG8_MMA(1, 1, At, B1); PG8_BAR;
        }
        E(acc, cur, wr, wc, fr, fq); S.done(cur);
        if (!has_next) break;
#pragma unroll
        for (int a = 0; a < 2; ++a)
#pragma unroll
            for (int b = 0; b < 2; ++b)
#pragma unroll
                for (int m = 0; m < 4; ++m)
#pragma unroll
                    for (int n = 0; n < 2; ++n) acc[a][b][m][n] = (f32x4){0.f, 0.f, 0.f, 0.f};
        cur = nxt; cA = nA; cB = nB; ++ui;
    }
    PG8_WAIT_V(0);
    if (wr == 0) PG8_BAR;
    PG8_BAR;
#undef PG8_SA
#undef PG8_SB
#undef PG8_STAGE
#undef PG8_LDA
#undef PG8_LDB
#undef PG8_MMA
#undef PG8_WAIT_V
#undef PG8_WAIT_L
#undef PG8_BAR
#undef PG8_SCHED
}

template <int ACT  > struct EpiBf16 {
    static constexpr bool PERM = true;
    bf16_t* O; int ldc;
    __device__ __forceinline__ void operator()(const f32x4 (&acc)[2][2][4][2], const Unit& u, int wr, int wc, int fr, int fq) const {
        const int row0 = u.pm * BM + wr * 64 + fr, col0 = u.pn * BM + wc * 32 + 8 * fq;
#pragma unroll
        for (int ai = 0; ai < 2; ++ai)
#pragma unroll
            for (int m = 0; m < 4; ++m) { bf16_t* rowp = O + (size_t)(row0 + ai * HALF + m * 16) * ldc + col0;
#pragma unroll
                for (int bj = 0; bj < 2; ++bj) { f32x4 v0 = acc[ai][bj][m][0], v1 = acc[ai][bj][m][1];
                    if (ACT == 1) { for (int i = 0; i < 4; ++i) { v0[i] = siluf_(v0[i]); v1[i] = siluf_(v1[i]); } }
                    uint4 o; o.x = pack2(v0[0], v0[1]); o.y = pack2(v0[2], v0[3]); o.z = pack2(v1[0], v1[1]); o.w = pack2(v1[2], v1[3]);
                    *(uint4*)(rowp + bj * HALF) = o; } }
    }
};
struct EpiF32 {
    static constexpr bool PERM = false;
    float* C; int ldc;
    __device__ __forceinline__ void operator()(const f32x4 (&acc)[2][2][4][2], const Unit& u, int wr, int wc, int fr, int fq) const {
        const int row0 = u.pm * BM + wr * 64 + fr, col0 = u.pn * BM + wc * 32 + 4 * fq;
#pragma unroll
        for (int ai = 0; ai < 2; ++ai)
#pragma unroll
            for (int m = 0; m < 4; ++m) { float* rowp = C + (size_t)(row0 + ai * HALF + m * 16) * ldc + col0;
#pragma unroll
                for (int bj = 0; bj < 2; ++bj)
#pragma unroll
                    for (int n = 0; n < 2; ++n) *(f32x4*)(rowp + bj * HALF + n * 16) = acc[ai][bj][m][n]; }
    }
};
template <int IN_BF16> struct EpiResid {
    static constexpr bool PERM = true;
    const float* Xi; const bf16_t* Xib; bf16_t* Ob;
    __device__ __forceinline__ void operator()(const f32x4 (&acc)[2][2][4][2], const Unit& u, int wr, int wc, int fr, int fq) const {
        const int row0 = u.pm * BM + wr * 64 + fr, col0 = u.pn * BM + wc * 32 + 8 * fq;
#pragma unroll
        for (int ai = 0; ai < 2; ++ai)
#pragma unroll
            for (int m = 0; m < 4; ++m) { const size_t ro = (size_t)(row0 + ai * HALF + m * 16) * 1024 + col0;
#pragma unroll
                for (int bj = 0; bj < 2; ++bj) { const size_t o = ro + bj * HALF;
                    f32x4 x0, x1;
                    if (IN_BF16) { const uint4 xv = *(const uint4*)(Xib + o); float xf[8]; unpack8(xv, xf); x0 = (f32x4){xf[0], xf[1], xf[2], xf[3]}; x1 = (f32x4){xf[4], xf[5], xf[6], xf[7]}; }
                    else { x0 = *(const f32x4*)(Xi + o); x1 = *(const f32x4*)(Xi + o + 4); }
                    const f32x4 v0 = x0 + acc[ai][bj][m][0], v1 = x1 + acc[ai][bj][m][1];
                    uint4 pk; pk.x = pack2(v0[0], v0[1]); pk.y = pack2(v0[2], v0[3]); pk.z = pack2(v1[0], v1[1]); pk.w = pack2(v1[2], v1[3]); *(uint4*)(Ob + o) = pk; } }
    }
};
template <int OUT_BF16> struct EpiGate {
    static constexpr bool PERM = true;
    float* X; bf16_t* Xb; const bf16_t* R; const bf16_t* E;
    __device__ __forceinline__ void operator()(const f32x4 (&acc)[2][2][4][2], const Unit& u, int wr, int wc, int fr, int fq) const {
        const int row0 = u.pm * BM + wr * 64 + fr, col0 = u.pn * BM + wc * 32 + 8 * fq;
#pragma unroll
        for (int ai = 0; ai < 2; ++ai)
#pragma unroll
            for (int m = 0; m < 4; ++m) { const size_t ro = (size_t)(row0 + ai * HALF + m * 16) * 1024 + col0;
#pragma unroll
                for (int bj = 0; bj < 2; ++bj) { const size_t o = ro + bj * HALF;
                    const uint4 ev = *(const uint4*)(E + o), rv = *(const uint4*)(R + o); float ef[8], rf[8]; unpack8(ev, ef); unpack8(rv, rf);
                    float v[8];
#pragma unroll
                    for (int n = 0; n < 2; ++n)
#pragma unroll
                        for (int i = 0; i < 4; ++i) v[4 * n + i] = rf[4 * n + i] + ef[4 * n + i] * sigmoidf_(acc[ai][bj][m][n][i]);
                    if (OUT_BF16) { uint4 pk; pk.x = pack2(v[0], v[1]); pk.y = pack2(v[2], v[3]); pk.z = pack2(v[4], v[5]); pk.w = pack2(v[6], v[7]); *(uint4*)(Xb + o) = pk; }
                    else { *(f32x4*)(X + o) = (f32x4){v[0], v[1], v[2], v[3]}; *(f32x4*)(X + o + 4) = (f32x4){v[4], v[5], v[6], v[7]}; } } }
    }
};
}

struct Args { const float* in[28]; float* out; unsigned char* ws; int ph_lo, ph_hi; };

struct Frame {
    int tid, lane, wave, G, bid, gw, nw;
    unsigned char* lds;
    unsigned* ctl;
    const float* in[28]; float* out; unsigned char* ws;
    const LAS unsigned char* lut;
    const LAS float* tbl;
    const LAS float* biasL;
    LAS unsigned char* ldsl;
};
DI int t5b(const Frame& F, int n) { return n < 16 ? n : (n >= 113 ? 31 : (int)F.lut[n]); }

DI bool phase_refresh(Frame& F) { int t_ = threadIdx.x; asm volatile("" : "+v"(t_)); F.tid = t_; F.lane = t_ & 63; return true; }
struct TDesc { const float* src; bf16_t* dst; int K, Nsrc, Npad, mapk, ntiles; };
DI int tmap(int kind, int n) { return kind == 0 ? n : (kind == 1 ? map0(n) : (kind == 2 ? map1(n) : mapv(n))); }
DI void transpose_all(const Frame& F) {
    unsigned char* ws = F.ws;
    float* tile = (float*)F.lds;
    TDesc D[11];
    D[0] = TDesc{F.in[7], (bf16_t*)(ws + WS_WIN0), 1024, 3292, LD0, 1, 0};
    D[1] = TDesc{F.in[7], (bf16_t*)(ws + WS_WVT), 1024, 3292, 512, 3, 0};
    D[2] = TDesc{F.in[8], (bf16_t*)(ws + WS_WOUT0), 1024, 1024, 1024, 0, 0};
    D[3] = TDesc{F.in[5], (bf16_t*)(ws + WS_WG0), 1024, 1024, 1024, 0, 0};
    D[4] = TDesc{F.in[5] + (size_t)1024 * 1024, (bf16_t*)(ws + WS_WG1), 1024, 1024, 1024, 0, 0};
    D[5] = TDesc{F.in[4], (bf16_t*)(ws + WS_WP0), 256, 1024, 1024, 0, 0};
    D[6] = TDesc{F.in[4] + (size_t)256 * 1024, (bf16_t*)(ws + WS_WP1), 256, 1024, 1024, 0, 0};
    D[7] = TDesc{F.in[15], (bf16_t*)(ws + WS_WIN1), 1024, 3592, LD1, 2, 0};
    D[8] = TDesc{F.in[16], (bf16_t*)(ws + WS_WOUT1), 1024, 1024, 1024, 0, 0};
    D[9] = TDesc{F.in[10], (bf16_t*)(ws + WS_WC1K), 2048, 256, 256, 0, 0};
    D[10] = TDesc{F.in[13], (bf16_t*)(ws + WS_WC1V), 2048, 256, 256, 0, 0};
    int total = 0;
#pragma unroll
    for (int i = 0; i < 11; ++i) { D[i].ntiles = (D[i].Npad / 64) * (D[i].K / 64); total += D[i].ntiles; }
    float rg[8];
    auto locate = [&](int tix, TDesc& d, int& nt, int& kt) { int rem = tix;
#pragma unroll
        for (int i = 0; i < 11; ++i) { if (rem >= 0 && rem < D[i].ntiles) { d = D[i]; const int ntk = d.K / 64; nt = rem / ntk; kt = rem % ntk; rem = -1; } else if (rem >= 0) rem -= D[i].ntiles; } };
    auto load = [&](int tix) { TDesc d; int nt = 0, kt = 0; locate(tix, d, nt, kt);
#pragma unroll
        for (int q = 0; q < 8; ++q) { const int e = F.tid + q * 512; const int kk = e >> 6, nn = e & 63; const int col = tmap(d.mapk, nt * 64 + nn);
            rg[q] = col >= 0 ? d.src[(size_t)(kt * 64 + kk) * d.Nsrc + col] : 0.f; } };
    int tix = F.bid; int buf = 0;
    if (tix < total) load(tix);
    for (; tix < total; tix += F.G) {
        float* tl = tile + buf * (64 * 65);
#pragma unroll
        for (int q = 0; q < 8; ++q) { const int e = F.tid + q * 512; tl[(e >> 6) * 65 + (e & 63)] = rg[q]; }
        __syncthreads();
        TDesc d; int nt = 0, kt = 0; locate(tix, d, nt, kt);
        if (tix + F.G < total) load(tix + F.G);
#pragma unroll
        for (int q = 0; q < 8; ++q) { const int e = F.tid + q * 512; const int nn = e >> 6, kk = e & 63;
            d.dst[(size_t)(nt * 64 + nn) * d.K + kt * 64 + kk] = f2bf(tl[kk * 65 + nn]); }
        buf ^= 1;
    }
    __syncthreads();
}
template <int OUTF>
DI void rmsnorm_rows(const Frame& F, const float* X, const float* g, bf16_t* Ob, float* Of) {
    f32x4 gg[4];
#pragma unroll
    for (int i = 0; i < 4; ++i) gg[i] = *(const f32x4*)(g + i * 256 + F.lane * 4);
    for (int row0 = F.gw * 4; row0 < MT; row0 += F.nw * 4) {
        f32x4 v[4][4]; float ss[4];
#pragma unroll
        for (int r = 0; r < 4; ++r)
#pragma unroll
            for (int i = 0; i < 4; ++i) v[r][i] = *(const f32x4*)(X + (size_t)(row0 + r) * 1024 + i * 256 + F.lane * 4);
#pragma unroll
        for (int r = 0; r < 4; ++r) { float a = 0.f;
#pragma unroll
            for (int i = 0; i < 4; ++i) a += v[r][i][0] * v[r][i][0] + v[r][i][1] * v[r][i][1] + v[r][i][2] * v[r][i][2] + v[r][i][3] * v[r][i][3];
            ss[r] = a; }
#pragma unroll
        for (int o = 32; o >= 1; o >>= 1) {
#pragma unroll
            for (int r = 0; r < 4; ++r) ss[r] += __shfl_xor(ss[r], o); }
#pragma unroll
        for (int r = 0; r < 4; ++r) { const float rs = rsqrtf(ss[r] * (1.0f / 1024.0f) + 1e-6f);
#pragma unroll
            for (int i = 0; i < 4; ++i) { f32x4 y;
#pragma unroll
                for (int j = 0; j < 4; ++j) y[j] = v[r][i][j] * rs * gg[i][j];
                if (OUTF) *(f32x4*)(Of + (size_t)(row0 + r) * 1024 + i * 256 + F.lane * 4) = y;
                else { uint2 pk; pk.x = pack2(y[0], y[1]); pk.y = pack2(y[2], y[3]); *(uint2*)(Ob + (size_t)(row0 + r) * 1024 + i * 256 + F.lane * 4) = pk; } } }
    }
}
DI void rmsnorm_gates(const Frame& F, const bf16_t* X, const float* g, bf16_t* Ob) {
    const float* W = F.in[15]; float* gts = (float*)(F.ws + WS_GATES);
    float wg[2][8][8]; float gg[2][8];
#pragma unroll
    for (int i = 0; i < 2; ++i)
#pragma unroll
        for (int e = 0; e < 8; ++e) { const int k = i * 512 + F.lane * 8 + e; const f32x4 a = *(const f32x4*)(W + (size_t)k * 3592 + 2560), b = *(const f32x4*)(W + (size_t)k * 3592 + 2564);
            wg[i][e][0] = a[0]; wg[i][e][1] = a[1]; wg[i][e][2] = a[2]; wg[i][e][3] = a[3]; wg[i][e][4] = b[0]; wg[i][e][5] = b[1]; wg[i][e][6] = b[2]; wg[i][e][7] = b[3]; gg[i][e] = g[k]; }
    for (int row0 = F.gw * 2; row0 < MT; row0 += F.nw * 2) {
        uint4 xv[2][2]; float ss[2];
#pragma unroll
        for (int r = 0; r < 2; ++r)
#pragma unroll
            for (int i = 0; i < 2; ++i) xv[r][i] = *(const uint4*)(X + (size_t)(row0 + r) * 1024 + i * 512 + F.lane * 8);
        float xf[2][2][8];
#pragma unroll
        for (int r = 0; r < 2; ++r) { float a = 0.f;
#pragma unroll
            for (int i = 0; i < 2; ++i) { unpack8(xv[r][i], xf[r][i]);
#pragma unroll
                for (int e = 0; e < 8; ++e) a += xf[r][i][e] * xf[r][i][e]; }
            ss[r] = a; }
#pragma unroll
        for (int o = 32; o >= 1; o >>= 1) { ss[0] += __shfl_xor(ss[0], o); ss[1] += __shfl_xor(ss[1], o); }
#pragma unroll
        for (int r = 0; r < 2; ++r) { const int row = row0 + r;
            const float rs = rsqrtf(ss[r] * (1.0f / 1024.0f) + 1e-6f);
            float pg[8] = {0.f, 0.f, 0.f, 0.f, 0.f, 0.f, 0.f, 0.f};
#pragma unroll
            for (int i = 0; i < 2; ++i) { float y[8];
#pragma unroll
                for (int e = 0; e < 8; ++e) { y[e] = xf[r][i][e] * rs * gg[i][e];
#pragma unroll
                    for (int j = 0; j < 8; ++j) pg[j] += y[e] * wg[i][e][j]; }
                uint4 pk; pk.x = pack2(y[0], y[1]); pk.y = pack2(y[2], y[3]); pk.z = pack2(y[4], y[5]); pk.w = pack2(y[6], y[7]); *(uint4*)(Ob + (size_t)row * 1024 + i * 512 + F.lane * 8) = pk; }
#pragma unroll
            for (int o = 32; o >= 1; o >>= 1) {
#pragma unroll
                for (int j = 0; j < 8; ++j) pg[j] += __shfl_xor(pg[j], o); }
            float mine = 0.f;
#pragma unroll
            for (int j = 0; j < 8; ++j) if (F.lane == j) mine = pg[j];
            if (F.lane < 8) gts[(size_t)row * 8 + F.lane] = mine; }
    }
}
DI void p0_prologue(const Frame& F) {
    unsigned char* ws = F.ws;
    transpose_all(F);
    { bf16_t* wat = (bf16_t*)(ws + WS_WAT); bf16_t* wxt = (bf16_t*)(ws + WS_WXT);
      for (int idx = F.bid * 512 + F.tid; idx < 8 * 64 * 64; idx += F.G * 512) { const int g = idx >> 12, j = (idx >> 6) & 63, i = idx & 63;
          wat[idx] = f2bf(F.in[19][(size_t)(g * 64 + i) * 64 + j]); wxt[idx] = f2bf(F.in[21][(size_t)(g * 64 + i) * 64 + j]); } }
    rmsnorm_rows<0>(F, F.in[0], F.in[2], (bf16_t*)(ws + WS_BFA), nullptr);
    { const float* p = F.in[1]; bf16_t* pb = (bf16_t*)(ws + WS_PBF); const size_t n8 = (size_t)2 * MT * 256 / 8;
      for (size_t i = (size_t)F.bid * 512 + F.tid; i < n8; i += (size_t)F.G * 512) {
          const f32x4 a = *(const f32x4*)(p + i * 8), b = *(const f32x4*)(p + i * 8 + 4);
          uint4 o; o.x = pack2(a[0], a[1]); o.y = pack2(a[2], a[3]); o.z = pack2(b[0], b[1]); o.w = pack2(b[2], b[3]); *(uint4*)(pb + i * 8) = o; } }
}

DI void p2a_build_blocks(const Frame& F) {
    { const int gt = F.bid * 512 + F.tid;
      if (gt < 1024) { const int bg = gt >> 6, d = gt & 63; ((float*)(F.ws + WS_KCMP))[((size_t)bg * 256 + 255) * 64 + d] = 0.f; ((float*)(F.ws + WS_VCMP))[((size_t)bg * 256 + 255) * 64 + d] = 0.f;
          ((bf16_t*)(F.ws + WS_VCT))[((size_t)bg * 64 + d) * 256 + 255] = 0; } }
    const bf16_t* U = (const bf16_t*)(F.ws + WS_U);
    bf16_t* AK = (bf16_t*)(F.ws + WS_AK); bf16_t* AV = (bf16_t*)(F.ws + WS_AV);
    const float* posk = F.in[9]; const float* posv = F.in[12];
    const size_t nitem = (size_t)2 * 4096 * 32 * 8;
    for (size_t it = (size_t)F.bid * 512 + F.tid; it < nitem; it += (size_t)F.G * 512) {
        const int c8 = (int)(it & 7), l = (int)((it >> 3) & 31), r = (int)((it >> 8) & 4095), which = (int)(it >> 20);
        bf16_t* dst = (which ? AV : AK) + (size_t)r * 2048 + l * 64 + c8 * 8;
        uint4 o = make_uint4(0u, 0u, 0u, 0u);
        if (r < 4080) {
            const int b = r / 510, rem = r % 510, i = rem >> 1, g = rem & 1;
            const bf16_t* sp = U + ((size_t)b * SEQ + 16 * i + l) * LD0 + (which ? C_VC : C_KC) + g * 64 + c8 * 8;
            const float* pp = (which ? posv : posk) + l * 64 + c8 * 8;
            const uint4 v = *(const uint4*)sp; float f[8]; unpack8(v, f);
            o.x = pack2(f[0] + pp[0], f[1] + pp[1]); o.y = pack2(f[2] + pp[2], f[3] + pp[3]); o.z = pack2(f[4] + pp[4], f[5] + pp[5]); o.w = pack2(f[6] + pp[6], f[7] + pp[7]);
        }
        *(uint4*)dst = o;
    }
}
DI void p2c_compress_rows(const Frame& F, int which, int row0) {
    const bf16_t* H = (const bf16_t*)(F.ws + (which ? WS_HV : WS_HK));
    float* OUT = (float*)(F.ws + (which ? WS_VCMP : WS_KCMP));
    const float* w2 = which ? F.in[14] : F.in[11];
    for (int rr = F.wave; rr < 256; rr += 8) {
        const int r = row0 + rr; if (r >= 4080) break;
        const int b = r / 510, rem = r % 510, i = rem >> 1, g = rem & 1, bg = b * 2 + g;
        const bf16_t* hr = H + (size_t)r * 256; float acc = 0.f;
        for (int j = 0; j < 256; j += 8) { const uint4 hv = *(const uint4*)(hr + j); float hf[8]; unpack8(hv, hf);
#pragma unroll
            for (int q = 0; q < 8; ++q) acc += hf[q] * w2[(size_t)(j + q) * 64 + F.lane]; }
        OUT[((size_t)bg * 256 + i) * 64 + F.lane] = acc;
        if (which) ((bf16_t*)(F.ws + WS_VCT))[((size_t)bg * 64 + F.lane) * 256 + i] = f2bf(acc);
    }
}

typedef float f32x16 __attribute__((ext_vector_type(16)));
#define MFMA32(a, b, c) __builtin_amdgcn_mfma_f32_32x32x16_bf16((a), (b), (c), 0, 0, 0)
constexpr float LOG2E = 1.4426950408889634f;
constexpr float QK_C1 = 0.125f * LOG2E;
constexpr int AT_BUF = 0;
constexpr int AT_PSUM = 65536;
constexpr int AT_SELM = AT_PSUM + 65536;
constexpr int AT_MISC = AT_SELM + 1024;
constexpr int AT_END = AT_MISC + 64 + 2048;
static_assert(AT_END + LDS_WORK_OFF <= LDS_BYTES - 12288, "attention lds");
enum { FL_NEAR = 1, FL_CAUSAL = 2, FL_WINLO = 4, FL_BITS = 8, FL_LANE = 16 };

struct Att { float m, l; f32x16 o0, o1; };
DI void att_init(Att& a) { a.m = NEG_INF; a.l = 0.f;
#pragma unroll
    for (int i = 0; i < 16; ++i) { a.o0[i] = 0.f; a.o1[i] = 0.f; } }

typedef unsigned u32x4 __attribute__((ext_vector_type(4)));
#define OPAQUE(x) asm volatile("" : "+v"(x))
DI void st_write_K(LAS unsigned char* Kt, int tid, const uint4& rg) {
    OPAQUE(tid);
    const int key = tid >> 3, c = tid & 7;
    const u32x4 v = {rg.x, rg.y, rg.z, rg.w};
    *(LAS u32x4*)(Kt + (key ^ ((key >> 3) & 1)) * 128 + ((c ^ (key & 7)) << 4)) = v;
}
DI void st_write_VT(LAS unsigned char* Vt, int tid, const uint4& rg) {
    OPAQUE(tid);
    const int d = tid >> 3, m = tid & 7, G = m >> 1, a = m & 1, sw = (d >> 1) & 7;
    typedef unsigned u32x2 __attribute__((ext_vector_type(2)));
    const u32x2 lo = {rg.x, rg.y}, hi = {rg.z, rg.w};
    *(LAS u32x2*)(Vt + d * 128 + (((2 * G) ^ sw) << 4) + 8 * a) = lo;
    *(LAS u32x2*)(Vt + d * 128 + (((2 * G + 1) ^ sw) << 4) + 8 * a) = hi;
}
DI void qk_tile(const LAS unsigned char* Kt, const bf16x8 (&qf)[4], int r, int hf, f32x16& s0, f32x16& s1) {
    OPAQUE(r); OPAQUE(hf);
    const f32x16 zero16 = {0.f, 0.f, 0.f, 0.f, 0.f, 0.f, 0.f, 0.f, 0.f, 0.f, 0.f, 0.f, 0.f, 0.f, 0.f, 0.f};
#pragma unroll
    for (int s = 0; s < 4; ++s) {
        const int c = 2 * s + hf;
        const int pr = r ^ ((r >> 3) & 1);
        const bf16x8 a0 = *(const LAS bf16x8*)(Kt + pr * 128 + ((c ^ (r & 7)) << 4));
        const bf16x8 a1 = *(const LAS bf16x8*)(Kt + (32 + pr) * 128 + ((c ^ (r & 7)) << 4));
        if (s == 0) { s0 = MFMA32(a0, qf[0], zero16); s1 = MFMA32(a1, qf[0], zero16); }
        else { s0 = MFMA32(a0, qf[s], s0); s1 = MFMA32(a1, qf[s], s1); }
    }
}
template <int FLAGS>
DI void fix_scores(f32x16& s, int posb, int kstep, int tq, const LAS float* bl, float bfar, unsigned mword, bool laneok, int hf) {
    OPAQUE(hf); OPAQUE(tq);
#pragma unroll
    for (int i = 0; i < 16; ++i) {
        const int koff = (i & 3) + 8 * (i >> 2) + 4 * hf;
        const int dist = tq - (posb + kstep * koff);
        float bias = bfar;
        if (FLAGS & FL_NEAR) { int dd = dist < 0 ? 0 : dist; dd = dd > 127 ? 127 : dd; bias = bl[dd]; }
        const float v = s[i] * QK_C1 + bias;
        bool ok = true;
        if (FLAGS & FL_CAUSAL) ok = ok && (dist >= 0);
        if (FLAGS & FL_WINLO) ok = ok && (dist < 512);
        if (FLAGS & FL_BITS) ok = ok && (((mword >> koff) & 1u) != 0u);
        if (FLAGS & FL_LANE) ok = ok && laneok;
        s[i] = ok ? v : NEG_INF;
    }
}
DI bf16x8 pack8(const f32x16& x, int s) {
    typedef unsigned u32x4 __attribute__((ext_vector_type(4)));
    u32x4 p;
    p[0] = pack2(x[8 * s + 0], x[8 * s + 1]); p[1] = pack2(x[8 * s + 2], x[8 * s + 3]); p[2] = pack2(x[8 * s + 4], x[8 * s + 5]); p[3] = pack2(x[8 * s + 6], x[8 * s + 7]);
    return __builtin_bit_cast(bf16x8, p);
}
DI void pv_tile(const LAS unsigned char* Vt, const f32x16& p0, const f32x16& p1, int r, int hf, f32x16& o0, f32x16& o1) {
#pragma unroll
    for (int G = 0; G < 4; ++G) {
        const bf16x8 pb = pack8((G >> 1) ? p1 : p0, G & 1);
        const int cc = 2 * G + hf;
        const bf16x8 a0 = *(const LAS bf16x8*)(Vt + r * 128 + ((cc ^ ((r >> 1) & 7)) << 4));
        const bf16x8 a1 = *(const LAS bf16x8*)(Vt + (32 + r) * 128 + ((cc ^ ((r >> 1) & 7)) << 4));
        o0 = MFMA32(a0, pb, o0); o1 = MFMA32(a1, pb, o1);
    }
}
DI void online_pv(Att& st, f32x16& s0, f32x16& s1, const LAS unsigned char* Vt, int r, int hf) {
    float tm = NEG_INF;
#pragma unroll
    for (int i = 0; i < 16; ++i) tm = fmaxf(tm, fmaxf(s0[i], s1[i]));
    tm = fmaxf(tm, __shfl_xor(tm, 32));
    const float mn = fmaxf(st.m, tm);
    const float mu = (mn == NEG_INF) ? 0.f : mn;
    const float alpha = __builtin_amdgcn_exp2f(st.m - mu);
    float ls = 0.f;
#pragma unroll
    for (int i = 0; i < 16; ++i) { s0[i] = __builtin_amdgcn_exp2f(s0[i] - mu); s1[i] = __builtin_amdgcn_exp2f(s1[i] - mu); ls += s0[i] + s1[i]; }
    st.l = st.l * alpha + ls;
    if (__ballot(mn != st.m) != 0ull) {
#pragma unroll
        for (int i = 0; i < 16; ++i) { st.o0[i] *= alpha; st.o1[i] *= alpha; } }
    st.m = mn;
    pv_tile(Vt, s0, s1, r, hf, st.o0, st.o1);
}
DI unsigned bitmask32(unsigned w, int pos) { unsigned m; asm("v_bfe_i32 %0, %1, %2, 1" : "=v"(m) : "v"(w), "n"(pos)); return m; }
template <bool BITS, bool NEARB, bool CAUSAL = false>
DI void far_tile(Att& st, const LAS unsigned char* Kt, const LAS unsigned char* Vt, const bf16x8 (&qf)[4], int r, int hf, float bfar, bool laneok, unsigned m0, unsigned m1,
                 int tq, int posb, const LAS float* bl) {
    f32x16 s0, s1; qk_tile(Kt, qf, r, hf, s0, s1);
    const float cb = laneok ? bfar - st.m : NEG_INF;
    const float nm = laneok ? -st.m : NEG_INF;
    const int dbase = tq - posb - 4 * hf;
    const unsigned w0 = m0 >> (4 * hf), w1 = m1 >> (4 * hf);
    const f32x2 c1v = {QK_C1, QK_C1}; f32x2 cbv = {cb, cb}; f32x2 ls2 = {0.f, 0.f};
#pragma unroll
    for (int i = 0; i < 16; i += 2) { const f32x2 sv = {s0[i], s0[i + 1]};
        if (NEARB) { int d0 = dbase - ((i & 3) + 8 * (i >> 2)), d1 = dbase - (((i + 1) & 3) + 8 * ((i + 1) >> 2)); const bool k0 = d0 >= 0, k1 = d1 >= 0;
            d0 = d0 > 127 ? 127 : d0; d1 = d1 > 127 ? 127 : d1; if (CAUSAL) { d0 = d0 < 0 ? 0 : d0; d1 = d1 < 0 ? 0 : d1; }
            cbv[0] = bl[d0] + nm; cbv[1] = bl[d1] + nm; if (CAUSAL) { cbv[0] = k0 ? cbv[0] : NEG_INF; cbv[1] = k1 ? cbv[1] : NEG_INF; } }
        const f32x2 av = sv * c1v + cbv;
        f32x2 pv; pv[0] = __builtin_amdgcn_exp2f(av[0]); pv[1] = __builtin_amdgcn_exp2f(av[1]);
        if (BITS) { pv[0] = __uint_as_float(__float_as_uint(pv[0]) & bitmask32(w0, (i & 3) + 8 * (i >> 2)));
                    pv[1] = __uint_as_float(__float_as_uint(pv[1]) & bitmask32(w0, ((i + 1) & 3) + 8 * ((i + 1) >> 2))); }
        s0[i] = pv[0]; s0[i + 1] = pv[1]; ls2 += pv; }
    const int rr = r;
#pragma unroll
    for (int G = 0; G < 2; ++G) { const bf16x8 pb = pack8(s0, G); const int cc = 2 * G + hf;
        const bf16x8 a0 = *(const LAS bf16x8*)(Vt + rr * 128 + ((cc ^ ((rr >> 1) & 7)) << 4)); const bf16x8 a1 = *(const LAS bf16x8*)(Vt + (32 + rr) * 128 + ((cc ^ ((rr >> 1) & 7)) << 4));
        st.o0 = MFMA32(a0, pb, st.o0); st.o1 = MFMA32(a1, pb, st.o1); }
#pragma unroll
    for (int i = 0; i < 16; i += 2) { const f32x2 sv = {s1[i], s1[i + 1]};
        if (NEARB) { int d0 = dbase - 32 - ((i & 3) + 8 * (i >> 2)), d1 = dbase - 32 - (((i + 1) & 3) + 8 * ((i + 1) >> 2)); const bool k0 = d0 >= 0, k1 = d1 >= 0;
            d0 = d0 > 127 ? 127 : d0; d1 = d1 > 127 ? 127 : d1; if (CAUSAL) { d0 = d0 < 0 ? 0 : d0; d1 = d1 < 0 ? 0 : d1; }
            cbv[0] = bl[d0] + nm; cbv[1] = bl[d1] + nm; if (CAUSAL) { cbv[0] = k0 ? cbv[0] : NEG_INF; cbv[1] = k1 ? cbv[1] : NEG_INF; } }
        const f32x2 av = sv * c1v + cbv;
        f32x2 pv; pv[0] = __builtin_amdgcn_exp2f(av[0]); pv[1] = __builtin_amdgcn_exp2f(av[1]);
        if (BITS) { pv[0] = __uint_as_float(__float_as_uint(pv[0]) & bitmask32(w1, (i & 3) + 8 * (i >> 2)));
                    pv[1] = __uint_as_float(__float_as_uint(pv[1]) & bitmask32(w1, ((i + 1) & 3) + 8 * ((i + 1) >> 2))); }
        s1[i] = pv[0]; s1[i + 1] = pv[1]; ls2 += pv; }
#pragma unroll
    for (int G = 2; G < 4; ++G) { const bf16x8 pb = pack8(s1, G & 1); const int cc = 2 * G + hf;
        const bf16x8 a0 = *(const LAS bf16x8*)(Vt + rr * 128 + ((cc ^ ((rr >> 1) & 7)) << 4)); const bf16x8 a1 = *(const LAS bf16x8*)(Vt + (32 + rr) * 128 + ((cc ^ ((rr >> 1) & 7)) << 4));
        st.o0 = MFMA32(a0, pb, st.o0); st.o1 = MFMA32(a1, pb, st.o1); }
    st.l += ls2[0] + ls2[1];
}
#define LDS_BARRIER() do { asm volatile("s_waitcnt lgkmcnt(0)" ::: "memory"); __builtin_amdgcn_s_barrier(); asm volatile("" ::: "memory"); } while (0)
template <class LD, class BODY>
DI void tile_stream(int n, LAS unsigned char* buf, int tid, bool useV, LD ld, BODY body) {
    if (n <= 0) return;
    uint4 rk0, rk1 = make_uint4(0u, 0u, 0u, 0u), rv0 = make_uint4(0u, 0u, 0u, 0u), rv1 = make_uint4(0u, 0u, 0u, 0u);
    ld(0, rk0, rv0); if (n > 1) ld(1, rk1, rv1);
    st_write_K(buf, tid, rk0); if (useV) st_write_VT(buf + 8192, tid, rv0);
    if (n > 1) { st_write_K(buf + 16384, tid, rk1); if (useV) st_write_VT(buf + 24576, tid, rv1); }
    if (n > 2) ld(2, rk0, rv0); if (n > 3) ld(3, rk1, rv1);
    LDS_BARRIER();
#pragma unroll 1
    for (int i = 0; i < n; i += 2) {
        LAS unsigned char* cur = buf + ((i >> 1) & 1) * 32768;
        if (i + 2 < n) { LAS unsigned char* nxt = buf + (((i >> 1) + 1) & 1) * 32768;
            st_write_K(nxt, tid, rk0); if (useV) st_write_VT(nxt + 8192, tid, rv0);
            if (i + 3 < n) { st_write_K(nxt + 16384, tid, rk1); if (useV) st_write_VT(nxt + 24576, tid, rv1); }
            if (i + 4 < n) ld(i + 4, rk0, rv0); if (i + 5 < n) ld(i + 5, rk1, rv1); }
        body(i, cur, cur + 8192);
        if (i + 1 < n) body(i + 1, cur + 16384, cur + 24576);
        LDS_BARRIER();
    }
}
template <class LD, class BODY>
DI void tile_stream_k4(int n, LAS unsigned char* buf, int tid, LD ld, BODY body) {
    if (n <= 0) return;
    uint4 r0, r1 = make_uint4(0u, 0u, 0u, 0u), r2 = make_uint4(0u, 0u, 0u, 0u), r3 = make_uint4(0u, 0u, 0u, 0u), dv;
    ld(0, r0, dv); if (n > 1) ld(1, r1, dv); if (n > 2) ld(2, r2, dv); if (n > 3) ld(3, r3, dv);
    st_write_K(buf, tid, r0); if (n > 1) st_write_K(buf + 8192, tid, r1); if (n > 2) st_write_K(buf + 16384, tid, r2); if (n > 3) st_write_K(buf + 24576, tid, r3);
    if (n > 4) ld(4, r0, dv); if (n > 5) ld(5, r1, dv); if (n > 6) ld(6, r2, dv); if (n > 7) ld(7, r3, dv);
    LDS_BARRIER();
#pragma unroll 1
    for (int i = 0; i < n; i += 4) {
        LAS unsigned char* cur = buf + ((i >> 2) & 1) * 32768;
        if (i + 4 < n) { LAS unsigned char* nxt = buf + (((i >> 2) + 1) & 1) * 32768;
            st_write_K(nxt, tid, r0); if (i + 5 < n) st_write_K(nxt + 8192, tid, r1); if (i + 6 < n) st_write_K(nxt + 16384, tid, r2); if (i + 7 < n) st_write_K(nxt + 24576, tid, r3);
            if (i + 8 < n) ld(i + 8, r0, dv); if (i + 9 < n) ld(i + 9, r1, dv); if (i + 10 < n) ld(i + 10, r2, dv); if (i + 11 < n) ld(i + 11, r3, dv); }
#pragma unroll 1
        for (int j = 0; j < 4; ++j) if (i + j < n) body(i + j, cur + j * 8192, cur);
        LDS_BARRIER();
    }
}
DI uint4 cvt8_f32(const float* p) { const f32x4 a = *(const f32x4*)p, b = *(const f32x4*)(p + 4); uint4 o; o.x = pack2(a[0], a[1]); o.y = pack2(a[2], a[3]); o.z = pack2(b[0], b[1]); o.w = pack2(b[2], b[3]); return o; }

DI void nsa_unit(const Frame& F, int b, int g, int qb) {
    int tid_ = F.tid; OPAQUE(tid_);
    const int tid = tid_, lane = tid & 63, w = F.wave, r = lane & 31, hf = lane >> 5;
    LAS unsigned char* L = F.ldsl;
    LAS unsigned char* buf = L + AT_BUF;
    LAS float* psum = (LAS float*)(L + AT_PSUM);
    LAS unsigned long long* selm = (LAS unsigned long long*)(L + AT_SELM);
    LAS unsigned char* tlist = L + AT_SELM + 528;
    LAS int* tcnt = (LAS int*)(L + AT_SELM + 520);
    const bf16_t* U = (const bf16_t*)(F.ws + WS_U);
    const float* KC = (const float*)(F.ws + WS_KCMP) + (size_t)(b * 2 + g) * 256 * 64;
    const bf16_t* VCT = (const bf16_t*)(F.ws + WS_VCT) + (size_t)(b * 2 + g) * 64 * 256;
    const bf16_t* VT = (const bf16_t*)(F.ws + WS_VT);
    bf16_t* Y = (bf16_t*)(F.ws + WS_BFB);
    const int t0 = qb * 64;
    const int ql = r >> 2, h = r & 3, hh = g * 4 + h;
    const int tq = t0 + 8 * w + ql;
    const size_t row = (size_t)b * SEQ + tq;
    const bf16_t* Ur = U + row * LD0;
    bf16x8 qf[4];
#pragma unroll
    for (int s = 0; s < 4; ++s) qf[s] = *(const bf16x8*)(Ur + C_AQ + hh * 64 + 16 * s + 8 * hf);
    const LAS float* bl = F.biasL + hh * 128; const float bfar = bl[127];
    float gate[3];
    { const unsigned* gp = (const unsigned*)(Ur + C_AG);
#pragma unroll
      for (int j = 0; j < 3; ++j) { const int e = hh * 3 + j; const unsigned wv = gp[e >> 1]; gate[j] = sigmoidf_((e & 1) ? __uint_as_float(wv & 0xFFFF0000u) : __uint_as_float(wv << 16)); } }
    LAS float* opark = psum + w * 2048 + lane;

    const int nvmax = ((t0 + 63 - 31) >> 4) + 1;
    const int ntc = (nvmax + 63) >> 6;
    for (int e = tid; e < 64 * 256; e += 512) psum[e] = 0.f;
    float cm = NEG_INF, cl = 0.f;
    {
#pragma unroll 1
        for (int i = 0; i < ntc; ++i) { const int key = tid >> 3, c = tid & 7;
            const uint4 rk = cvt8_f32(KC + (size_t)(i * 64 + key) * 64 + c * 8); const uint4 rv = *(const uint4*)(VCT + (size_t)key * 256 + i * 64 + c * 8);
            st_write_K(buf + i * 8192, tid, rk); st_write_VT(buf + 32768 + i * 8192, tid, rv); }
        __syncthreads();
        auto body = [&](int i, LAS unsigned char* Kt, LAS unsigned char* Vt) { (void)Vt;
            f32x16 s0, s1; qk_tile(Kt, qf, r, hf, s0, s1);
            if (16 * (i * 64 + 63) + 31 + 113 <= t0 + 8 * w) { fix_scores<0>(s0, 0, 16, tq, bl, bfar, 0u, true, hf); fix_scores<0>(s1, 0, 16, tq, bl, bfar, 0u, true, hf); }
            else { fix_scores<FL_NEAR | FL_CAUSAL>(s0, 16 * (i * 64) + 31, 16, tq, bl, bfar, 0u, true, hf); fix_scores<FL_NEAR | FL_CAUSAL>(s1, 16 * (i * 64 + 32) + 31, 16, tq, bl, bfar, 0u, true, hf); }
            float tm = NEG_INF;
#pragma unroll
            for (int k = 0; k < 16; ++k) tm = fmaxf(tm, fmaxf(s0[k], s1[k]));
            tm = fmaxf(tm, __shfl_xor(tm, 32));
            const float mn = fmaxf(cm, tm); const float mu = (mn == NEG_INF) ? 0.f : mn;
            float ls = 0.f;
#pragma unroll
            for (int k = 0; k < 16; ++k) ls += __builtin_amdgcn_exp2f(s0[k] - mu) + __builtin_amdgcn_exp2f(s1[k] - mu);
            cl = cl * __builtin_amdgcn_exp2f(cm - mu) + ls; cm = mn; };
#pragma unroll 1
        for (int i = 0; i < ntc; ++i) body(i, buf + i * 8192, buf + 32768 + i * 8192);
    }
    f32x16 c0, c1;
    {
        cl += __shfl_xor(cl, 32);
        const float cinv = cl > 0.f ? 1.0f / cl : 0.f; const float cmu = (cm == NEG_INF) ? 0.f : cm;
#pragma unroll
        for (int i = 0; i < 16; ++i) { c0[i] = 0.f; c1[i] = 0.f; }
        auto body = [&](int i, LAS unsigned char* Kt, LAS unsigned char* Vt) {
            f32x16 s0, s1; qk_tile(Kt, qf, r, hf, s0, s1);
            if (16 * (i * 64 + 63) + 31 + 113 <= t0 + 8 * w) { fix_scores<0>(s0, 0, 16, tq, bl, bfar, 0u, true, hf); fix_scores<0>(s1, 0, 16, tq, bl, bfar, 0u, true, hf); }
            else { fix_scores<FL_NEAR | FL_CAUSAL>(s0, 16 * (i * 64) + 31, 16, tq, bl, bfar, 0u, true, hf); fix_scores<FL_NEAR | FL_CAUSAL>(s1, 16 * (i * 64 + 32) + 31, 16, tq, bl, bfar, 0u, true, hf); }
#pragma unroll
            for (int k = 0; k < 16; ++k) { s0[k] = __builtin_amdgcn_exp2f(s0[k] - cmu) * cinv; s1[k] = __builtin_amdgcn_exp2f(s1[k] - cmu) * cinv; }
#pragma unroll
            for (int k = 0; k < 16; ++k) {
                float a0 = s0[k], a1 = s1[k];
                a0 += __shfl_xor(a0, 1); a0 += __shfl_xor(a0, 2); a1 += __shfl_xor(a1, 1); a1 += __shfl_xor(a1, 2);
                const int koff = (k & 3) + 8 * (k >> 2) + 4 * hf;
                if (h == 0) { psum[(8 * w + ql) * 256 + i * 64 + koff] = a0; psum[(8 * w + ql) * 256 + i * 64 + 32 + koff] = a1; }
            }
            pv_tile(Vt, s0, s1, r, hf, c0, c1); };
#pragma unroll 1
        for (int i = 0; i < ntc; ++i) body(i, buf + i * 8192, buf + 32768 + i * 8192);
        __syncthreads();
    }
    {
        const int cur = qb; const int npick = (cur + 1) < 8 ? (cur + 1) : 8;
        LAS float* scw = (LAS float*)(L + AT_MISC + 64) + w * 64;
#pragma unroll 1
        for (int q = 0; q < 8; ++q) {
            const LAS float* pr = psum + (8 * w + q) * 256;
            float imp = 0.f;
            const int i0 = 4 * lane - 1 < 0 ? 0 : 4 * lane - 1, i1 = 4 * lane + 3 > 254 ? 254 : 4 * lane + 3;
            for (int i = i0; i <= i1; ++i) imp += pr[i];
            const bool adm = lane <= cur; const bool forced = (lane == 0) || (lane == cur) || (lane == cur - 1);
            const float score = adm ? imp + (forced ? 1.0e4f : 0.f) : NEG_INF;
            __builtin_amdgcn_wave_barrier();
            scw[lane] = score;
            __builtin_amdgcn_wave_barrier();
            int rank = 0;
#pragma unroll
            for (int j4 = 0; j4 < 16; ++j4) { const f32x4 o = *(const LAS f32x4*)(scw + 4 * j4);
#pragma unroll
                for (int e = 0; e < 4; ++e) { const int j = 4 * j4 + e; rank += (o[e] > score || (o[e] == score && j < lane)) ? 1 : 0; } }
            const unsigned long long sm = __ballot(adm && rank < npick);
            if (lane == 0) selm[8 * w + q] = sm;
        }
    }
    __syncthreads();
    if (w == 0) {
        unsigned long long m = selm[lane];
        unsigned lo = (unsigned)m, hi = (unsigned)(m >> 32);
        for (int o = 32; o >= 1; o >>= 1) { lo |= __shfl_xor(lo, o); hi |= __shfl_xor(hi, o); }
        const unsigned long long un = ((unsigned long long)hi << 32) | lo;
        const bool mine = (un >> lane) & 1ull;
        const int pos = __popcll(un & ((1ull << lane) - 1ull));
        if (mine) tlist[pos] = (unsigned char)lane;
        if (lane == 0) tcnt[0] = __popcll(un);
    }
    __syncthreads();
#pragma unroll
    for (int i = 0; i < 16; ++i) { opark[i * 64] = gate[0] * c0[i]; opark[(16 + i) * 64] = gate[0] * c1[i]; }
    const unsigned long long mysel = selm[8 * w + ql];
    {
        Att st; att_init(st);
        const int nts = tcnt[0];
        auto lds_ = [&](int i, uint4& rk, uint4& rv) { const int j = tlist[i]; const int key = tid >> 3, c = tid & 7;
            const bf16_t* p = U + ((size_t)b * SEQ + j * 64 + key) * LD0 + g * 64 + c * 8; rk = *(const uint4*)(p + C_KS); rv = *(const uint4*)(VT + (size_t)(g * 64 + key) * MT + (size_t)b * SEQ + j * 64 + c * 8); };
        auto body = [&](int i, LAS unsigned char* Kt, LAS unsigned char* Vt) {
            const int j = tlist[i];
            const bool laneok = (mysel >> j) & 1ull;
            if (__ballot(laneok) == 0ull) return;
            if (__ballot(st.m == NEG_INF) == 0ull) {
                if (j < qb - 2) far_tile<false, false>(st, Kt, Vt, qf, r, hf, bfar, laneok, 0u, 0u, tq, j * 64, bl); else if (j < qb) far_tile<false, true>(st, Kt, Vt, qf, r, hf, bfar, laneok, 0u, 0u, tq, j * 64, bl);
                else far_tile<false, true, true>(st, Kt, Vt, qf, r, hf, bfar, laneok, 0u, 0u, tq, j * 64, bl);
                return; }
            f32x16 s0, s1; qk_tile(Kt, qf, r, hf, s0, s1);
            if (j >= qb - 2) { fix_scores<FL_NEAR | FL_CAUSAL | FL_LANE>(s0, j * 64, 1, tq, bl, bfar, 0u, laneok, hf); fix_scores<FL_NEAR | FL_CAUSAL | FL_LANE>(s1, j * 64 + 32, 1, tq, bl, bfar, 0u, laneok, hf); }
            else { fix_scores<FL_LANE>(s0, j * 64, 1, tq, bl, bfar, 0u, laneok, hf); fix_scores<FL_LANE>(s1, j * 64 + 32, 1, tq, bl, bfar, 0u, laneok, hf); }
            online_pv(st, s0, s1, Vt, r, hf); };
        tile_stream(nts, buf, tid, true, lds_, body);
        float l = st.l + __shfl_xor(st.l, 32);
        const float sc = l > 0.f ? gate[1] / l : 0.f;
#pragma unroll
        for (int i = 0; i < 16; ++i) { opark[i * 64] += sc * st.o0[i]; opark[(16 + i) * 64] += sc * st.o1[i]; }
    }
    {
        Att st; att_init(st);
        const int j0 = qb - 8 < 0 ? 0 : qb - 8; const int ntw = qb - j0 + 1;
        auto ldw = [&](int i, uint4& rk, uint4& rv) { const int j = j0 + i; const int key = tid >> 3, c = tid & 7;
            const bf16_t* p = U + ((size_t)b * SEQ + j * 64 + key) * LD0 + g * 64 + c * 8; rk = *(const uint4*)(p + C_KW); rv = *(const uint4*)(VT + (size_t)(128 + g * 64 + key) * MT + (size_t)b * SEQ + j * 64 + c * 8); };
        auto body = [&](int i, LAS unsigned char* Kt, LAS unsigned char* Vt) {
            const int j = j0 + i;
            if (j != qb - 8 && __ballot(st.m == NEG_INF) == 0ull) {
                if (j < qb - 2) far_tile<false, false>(st, Kt, Vt, qf, r, hf, bfar, true, 0u, 0u, tq, j * 64, bl); else if (j < qb) far_tile<false, true>(st, Kt, Vt, qf, r, hf, bfar, true, 0u, 0u, tq, j * 64, bl);
                else far_tile<false, true, true>(st, Kt, Vt, qf, r, hf, bfar, true, 0u, 0u, tq, j * 64, bl);
                return; }
            f32x16 s0, s1; qk_tile(Kt, qf, r, hf, s0, s1);
            if (j >= qb - 2) { fix_scores<FL_NEAR | FL_CAUSAL>(s0, j * 64, 1, tq, bl, bfar, 0u, true, hf); fix_scores<FL_NEAR | FL_CAUSAL>(s1, j * 64 + 32, 1, tq, bl, bfar, 0u, true, hf); }
            else if (j == qb - 8) { fix_scores<FL_WINLO>(s0, j * 64, 1, tq, bl, bfar, 0u, true, hf); fix_scores<FL_WINLO>(s1, j * 64 + 32, 1, tq, bl, bfar, 0u, true, hf); }
            else { fix_scores<0>(s0, j * 64, 1, tq, bl, bfar, 0u, true, hf); fix_scores<0>(s1, j * 64 + 32, 1, tq, bl, bfar, 0u, true, hf); }
            online_pv(st, s0, s1, Vt, r, hf); };
        tile_stream(ntw, buf, tid, true, ldw, body);
        float l = st.l + __shfl_xor(st.l, 32);
        const float sc = l > 0.f ? gate[2] / l : 0.f;
#pragma unroll
        for (int i = 0; i < 16; ++i) { c0[i] = opark[i * 64] + sc * st.o0[i]; c1[i] = opark[(16 + i) * 64] + sc * st.o1[i]; }
    }
#pragma unroll
    for (int dh = 0; dh < 2; ++dh)
#pragma unroll
        for (int k = 0; k < 4; ++k) {
            const int d = 32 * dh + 8 * k + 4 * hf;
            const uint2 zz = *(const uint2*)(Ur + C_AZ + hh * 64 + d);
            const float z0 = __uint_as_float(zz.x << 16), z1 = __uint_as_float(zz.x & 0xFFFF0000u), z2 = __uint_as_float(zz.y << 16), z3 = __uint_as_float(zz.y & 0xFFFF0000u);
            const f32x16& o = dh ? c1 : c0;
            uint2 pk; pk.x = pack2(o[4 * k + 0] * siluf_(z0), o[4 * k + 1] * siluf_(z1)); pk.y = pack2(o[4 * k + 2] * siluf_(z2), o[4 * k + 3] * siluf_(z3));
            *(uint2*)(Y + row * 1024 + hh * 64 + d) = pk;
        }
    __syncthreads();
}

DI unsigned short okey16(float x) {
    const _Float16 hx = (_Float16)x; unsigned short u = __builtin_bit_cast(unsigned short, hx);
    if ((u & 0x7FFFu) == 0u) u = 0u;
    return (u & 0x8000u) ? (unsigned short)~u : (unsigned short)(u | 0x8000u);
}
DI void dsa_unit(const Frame& F, int b, int qt) {
    int tid_ = F.tid; OPAQUE(tid_);
    const int tid = tid_, lane = tid & 63, w = F.wave, r = lane & 31, hf = lane >> 5, fr = lane & 15, fq = lane >> 4;
    LAS unsigned char* L = F.ldsl;
    LAS unsigned char* buf = L + AT_BUF;
    LAS unsigned* mask = (LAS unsigned*)(L + AT_PSUM);
    const bf16_t* U = (const bf16_t*)(F.ws + WS_U);
    bf16_t* Y = (bf16_t*)(F.ws + WS_BFB);
    const bf16_t* VT = (const bf16_t*)(F.ws + WS_VT);
    unsigned short* KS = (unsigned short*)(F.ws + WS_BFA) + (size_t)F.bid * 32 * 4096;
    const int t0 = qt * 32;
    const int nt = ((t0 + 31) >> 6) + 1;
    {
        bf16x8 qi[2]; float wi[4];
        { const bf16_t* Uq = U + ((size_t)b * SEQ + t0 + 4 * w + (fr >> 2)) * LD0;
#pragma unroll
          for (int ks = 0; ks < 2; ++ks) qi[ks] = *(const bf16x8*)(Uq + C_BQI + (fr & 3) * 64 + 32 * ks + 8 * fq);
          const uint2 wv = *(const uint2*)(U + ((size_t)b * SEQ + t0 + 4 * w + fq) * LD0 + C_BWI);
          wi[0] = __uint_as_float(wv.x << 16) * 0.0625f; wi[1] = __uint_as_float(wv.x & 0xFFFF0000u) * 0.0625f; wi[2] = __uint_as_float(wv.y << 16) * 0.0625f; wi[3] = __uint_as_float(wv.y & 0xFFFF0000u) * 0.0625f; }
        const int tqi = t0 + 4 * w + fq;
        auto ldi = [&](int i, uint4& rk, uint4& rv) { const int key = tid >> 3, c = tid & 7; rk = *(const uint4*)(U + ((size_t)b * SEQ + i * 64 + key) * LD0 + C_BKI + c * 8); (void)rv; };
        auto body = [&](int i, LAS unsigned char* Kt, LAS unsigned char* Vt) { (void)Vt;
#pragma unroll
            for (int kg = 0; kg < 4; ++kg) {
                const int kk = 16 * kg + fr;
                f32x4 acc = {0.f, 0.f, 0.f, 0.f};
#pragma unroll
                for (int ks = 0; ks < 2; ++ks) { const int c = 4 * ks + fq;
                    const bf16x8 kb = *(const LAS bf16x8*)(Kt + (kk ^ ((kk >> 3) & 1)) * 128 + ((c ^ (kk & 7)) << 4));
                    acc = __builtin_amdgcn_mfma_f32_16x16x32_bf16(qi[ks], kb, acc, 0, 0, 0); }
                const float sc = wi[0] * fmaxf(acc[0], 0.f) + wi[1] * fmaxf(acc[1], 0.f) + wi[2] * fmaxf(acc[2], 0.f) + wi[3] * fmaxf(acc[3], 0.f);
                const int pos = i * 64 + kk;
                KS[(size_t)(4 * w + fq) * 4096 + pos] = pos <= tqi ? okey16(sc) : (unsigned short)0;
            } };
        tile_stream_k4(nt, buf, tid, ldi, body);
    }
    asm volatile("s_waitcnt vmcnt(0)" ::: "memory");
    __syncthreads();
    __builtin_amdgcn_fence(__ATOMIC_ACQUIRE, "agent");
    asm volatile("s_waitcnt vmcnt(0)" ::: "memory");
    {
    LAS unsigned char* maskb = (LAS unsigned char*)mask;
    unsigned Tn[32];
    auto ldkeys = [&](int q) { const int qq = 4 * w + q; const int nk = t0 + qq + 1; int ln = lane; OPAQUE(ln); const unsigned short* kq = KS + (size_t)qq * 4096 + ln * 8;
#pragma unroll
        for (int c = 0; c < 8; ++c) { uint4 kv = make_uint4(0u, 0u, 0u, 0u); if (c * 512 < nk) kv = *(const uint4*)(kq + c * 512);
            Tn[4 * c] = kv.x; Tn[4 * c + 1] = kv.y; Tn[4 * c + 2] = kv.z; Tn[4 * c + 3] = kv.w; } };
    ldkeys(0);
#pragma unroll 1
    for (int q = 0; q < 4; ++q) {
        const int qq = 4 * w + q; const int tqq = t0 + qq; const int nk = tqq + 1;
        unsigned T[32];
#pragma unroll
        for (int e = 0; e < 32; ++e) T[e] = Tn[e];
        if (q < 3) ldkeys(q + 1);
        if (nk <= 256) {
#pragma unroll
            for (int c = 0; c < 8; ++c) { unsigned selb = 0u;
#pragma unroll
                for (int e = 0; e < 8; ++e) if (c * 512 + lane * 8 + e < nk) selb |= 1u << e;
                maskb[qq * 512 + c * 64 + lane] = (unsigned char)selb; }
            continue;
        }
#pragma unroll
        for (int e = 0; e < 32; ++e) { const int idx = (e >> 2) * 512 + lane * 8 + (e & 3) * 2;
            unsigned lo = T[e] & 0xFFFFu, hi = T[e] >> 16; if (idx >= nk) lo = 0u; if (idx + 1 >= nk) hi = 0u; T[e] = lo | (hi << 16); }
#pragma unroll
        for (int st = 0; st < 5; ++st) { const int j = 16 >> st; const unsigned m = st == 0 ? 0x0000FFFFu : st == 1 ? 0x00FF00FFu : st == 2 ? 0x0F0F0F0Fu : st == 3 ? 0x33333333u : 0x55555555u;
#pragma unroll
            for (int k0 = 0; k0 < 32; k0 += 2 * j)
#pragma unroll
                for (int i = 0; i < j; ++i) { const int k = k0 + i; const unsigned t = ((T[k] >> j) ^ T[k + j]) & m; T[k] ^= (t << j); T[k + j] ^= t; } }
        unsigned ce = 0xFFFFFFFFu, co = 0xFFFFFFFFu, ge = 0u, go = 0u; int above = 0;
#pragma unroll
        for (int bit = 15; bit >= 0; --bit) {
            const unsigned oe = ce & T[bit], oo = co & T[16 + bit];
            const int cnt = __popc(oe) + __popc(oo);
            int tot = 0;
#pragma unroll
            for (int bb = 0; bb < 7; ++bb) tot += __popcll(__ballot((cnt >> bb) & 1)) << bb;
            if (above + tot >= 256) { ce = oe; co = oo; }
            else { above += tot; ge |= oe; go |= oo; ce &= ~T[bit]; co &= ~T[16 + bit]; }
        }
        const int quota = 256 - above; int taken = 0;
#pragma unroll
        for (int c = 0; c < 8; ++c) {
            unsigned xe = (ge >> (4 * c)) & 0xFu, xo = (go >> (4 * c)) & 0xFu;
            xe = (xe | (xe << 2)) & 0x33u; xe = (xe | (xe << 1)) & 0x55u; xo = (xo | (xo << 2)) & 0x33u; xo = (xo | (xo << 1)) & 0x55u;
            unsigned selb = xe | (xo << 1);
            unsigned ye = (ce >> (4 * c)) & 0xFu, yo = (co >> (4 * c)) & 0xFu;
            ye = (ye | (ye << 2)) & 0x33u; ye = (ye | (ye << 1)) & 0x55u; yo = (yo | (yo << 2)) & 0x33u; yo = (yo | (yo << 1)) & 0x55u;
            const unsigned eqb = ye | (yo << 1);
            if (__ballot(eqb != 0u) != 0ull) {
                const int ne = __popc(eqb);
                int excl = 0, totc = 0;
#pragma unroll
                for (int bb = 0; bb < 4; ++bb) { const unsigned long long bl_ = __ballot((ne >> bb) & 1);
                    excl += (int)__builtin_amdgcn_mbcnt_hi((unsigned)(bl_ >> 32), __builtin_amdgcn_mbcnt_lo((unsigned)bl_, 0u)) << bb; totc += __popcll(bl_) << bb; }
                int rank = taken + excl;
#pragma unroll
                for (int e = 0; e < 8; ++e) if ((eqb >> e) & 1u) { if (rank < quota) selb |= 1u << e; ++rank; }
                taken += totc;
            }
            maskb[qq * 512 + c * 64 + lane] = (unsigned char)selb;
        }
    }
    }
    __syncthreads();
    {
        const int ql = r >> 3, h = r & 7;
        const int tq = t0 + 4 * w + ql;
        const size_t row = (size_t)b * SEQ + tq;
        const bf16_t* Ur = U + row * LD0;
        bf16x8 qf[4];
#pragma unroll
        for (int s = 0; s < 4; ++s) qf[s] = *(const bf16x8*)(Ur + C_BQ + h * 64 + 16 * s + 8 * hf);
        const LAS float* bl = F.biasL + (8 + h) * 128; const float bfar = bl[127];
        const LAS unsigned* mq = mask + (4 * w + ql) * 128;
        Att st; att_init(st);
        auto lda = [&](int i, uint4& rk, uint4& rv) { const int key = tid >> 3, c = tid & 7;
            const bf16_t* p = U + ((size_t)b * SEQ + i * 64 + key) * LD0 + c * 8; rk = *(const uint4*)(p + C_BK); rv = *(const uint4*)(VT + (size_t)(256 + key) * MT + (size_t)b * SEQ + i * 64 + c * 8); };
        auto body = [&](int i, LAS unsigned char* Kt, LAS unsigned char* Vt) {
            const unsigned m0 = mq[2 * i], m1 = mq[2 * i + 1];
            if (__ballot(st.m == NEG_INF) == 0ull) {
                if (i < nt - 4) far_tile<true, false>(st, Kt, Vt, qf, r, hf, bfar, true, m0, m1, tq, i * 64, bl); else if (i < nt - 1) far_tile<true, true>(st, Kt, Vt, qf, r, hf, bfar, true, m0, m1, tq, i * 64, bl);
                else far_tile<true, true, true>(st, Kt, Vt, qf, r, hf, bfar, true, m0, m1, tq, i * 64, bl);
                return; }
            f32x16 s0, s1; qk_tile(Kt, qf, r, hf, s0, s1);
            if (i >= nt - 4) { fix_scores<FL_NEAR | FL_CAUSAL | FL_BITS>(s0, i * 64, 1, tq, bl, bfar, m0, true, hf); fix_scores<FL_NEAR | FL_CAUSAL | FL_BITS>(s1, i * 64 + 32, 1, tq, bl, bfar, m1, true, hf); }
            else { fix_scores<FL_BITS>(s0, i * 64, 1, tq, bl, bfar, m0, true, hf); fix_scores<FL_BITS>(s1, i * 64 + 32, 1, tq, bl, bfar, m1, true, hf); }
            online_pv(st, s0, s1, Vt, r, hf); };
        tile_stream(nt, buf, tid, true, lda, body);
        float l = st.l + __shfl_xor(st.l, 32);
        const float sc = l > 0.f ? 1.0f / l : 0.f;
#pragma unroll
        for (int dh = 0; dh < 2; ++dh)
#pragma unroll
            for (int k = 0; k < 4; ++k) {
                const int d = 32 * dh + 8 * k + 4 * hf;
                const uint2 zz = *(const uint2*)(Ur + C_BZ + h * 64 + d);
                const float z0 = __uint_as_float(zz.x << 16), z1 = __uint_as_float(zz.x & 0xFFFF0000u), z2 = __uint_as_float(zz.y << 16), z3 = __uint_as_float(zz.y & 0xFFFF0000u);
                const f32x16& o = dh ? st.o1 : st.o0;
                uint2 pk; pk.x = pack2(o[4 * k + 0] * sc * siluf_(z0), o[4 * k + 1] * sc * siluf_(z1)); pk.y = pack2(o[4 * k + 2] * sc * siluf_(z2), o[4 * k + 3] * sc * siluf_(z3));
                *(uint2*)(Y + row * 1024 + 512 + h * 64 + d) = pk;
            }
    }
    __syncthreads();
}

DI void att_dsa(const Frame& F) {
    LAS int* ub = (LAS int*)(F.ldsl + AT_MISC);
    unsigned* qd = F.ctl + CW_QDSA;
    const int NDSA = NB * (SEQ / 32);
    __syncthreads();
    if (F.tid == 0) ub[0] = (int)__hip_atomic_fetch_add(qd, 1u, __ATOMIC_RELAXED, __HIP_MEMORY_SCOPE_AGENT);
    for (;;) {
        __syncthreads();
        const int k = ub[0];
        __syncthreads();
        if (k >= NDSA) break;
        int nxt = 0; if (F.tid == 0) nxt = (int)__hip_atomic_fetch_add(qd, 1u, __ATOMIC_RELAXED, __HIP_MEMORY_SCOPE_AGENT);
        dsa_unit(F, k & 7, (SEQ / 32) - 1 - (k >> 3));
        if (F.tid == 0) ub[0] = nxt;
    }
}
DI void att_nsa(const Frame& F) {
    LAS int* ub = (LAS int*)(F.ldsl + AT_MISC);
    unsigned* qn = F.ctl + CW_QNSA;
    const int NNSA = NB * 2 * (SEQ / 64);
    __syncthreads();
    if (F.tid == 0) ub[0] = (int)__hip_atomic_fetch_add(qn, 1u, __ATOMIC_RELAXED, __HIP_MEMORY_SCOPE_AGENT);
    for (;;) {
        __syncthreads();
        const int k = ub[0];
        __syncthreads();
        if (k >= NNSA) break;
        int nxt = 0; if (F.tid == 0) nxt = (int)__hip_atomic_fetch_add(qn, 1u, __ATOMIC_RELAXED, __HIP_MEMORY_SCOPE_AGENT);
        const int bg = k & 15;
        nsa_unit(F, bg >> 1, bg & 1, 63 - (k >> 4));
        if (F.tid == 0) ub[0] = nxt;
    }
}

DI f32x4 mma16(const bf16_t* A, int lda, const bf16_t* Bt, int ldb, int K, int lane) {
    const int fr = lane & 15, fq = lane >> 4;
    f32x4 acc = {0.f, 0.f, 0.f, 0.f};
    for (int k = 0; k < K; k += 32) {
        const bf16x8 a = *(const bf16x8*)(A + fr * lda + k + fq * 8);
        const bf16x8 b = *(const bf16x8*)(Bt + fr * ldb + k + fq * 8);
        acc = __builtin_amdgcn_mfma_f32_16x16x32_bf16(a, b, acc, 0, 0, 0);
    }
    return acc;
}
DI void conv8(const bf16_t* U1, int b, int t, int col, const float* cw  , int nch, const float* cb, float (&y)[8]) {
#pragma unroll
    for (int i = 0; i < 8; ++i) y[i] = cb[i];
#pragma unroll
    for (int j = 0; j < 4; ++j) { const int tt = t - 3 + j;
        if (tt >= 0) { const uint4 v = *(const uint4*)(U1 + ((size_t)b * SEQ + tt) * LD1 + col); float f[8]; unpack8(v, f);
#pragma unroll
            for (int i = 0; i < 8; ++i) y[i] += cw[(size_t)j * nch + i] * f[i]; } }
}
DI void stage_raw128(const Frame& F, const bf16_t* U1, int b, int t_first, int nrows, int col, bf16_t* raw) {
    for (int it = F.tid; it < nrows * 16; it += 512) { const int row = it >> 4, ch = it & 15; const int t = t_first + row;
        uint4 v = make_uint4(0u, 0u, 0u, 0u); if (t >= 0) v = *(const uint4*)(U1 + ((size_t)b * SEQ + t) * LD1 + col + ch * 8);
        *(uint4*)(raw + row * 136 + ch * 8) = v; }
}
DI void load_raw128(const Frame& F, const bf16_t* U1, int b, int t_first, int nrows, int col, uint4 (&rg)[3]) {
#pragma unroll
    for (int j = 0; j < 3; ++j) { const int it = F.tid + j * 512; const int row = it >> 4, ch = it & 15; const int t = t_first + row;
        rg[j] = make_uint4(0u, 0u, 0u, 0u); if (it < nrows * 16 && t >= 0) rg[j] = *(const uint4*)(U1 + ((size_t)b * SEQ + t) * LD1 + col + ch * 8); }
}
DI void write_raw128(const Frame& F, int nrows, const uint4 (&rg)[3], bf16_t* raw) {
#pragma unroll
    for (int j = 0; j < 3; ++j) { const int it = F.tid + j * 512; const int row = it >> 4, ch = it & 15; if (it < nrows * 16) *(uint4*)(raw + row * 136 + ch * 8) = rg[j]; }
}
DI void conv8_lds(const bf16_t* raw, int s, int d0, const float* cw  , const float* cb  , float (&y)[8]) {
#pragma unroll
    for (int i = 0; i < 8; ++i) y[i] = cb[d0 + i];
#pragma unroll
    for (int j = 0; j < 4; ++j) { const uint4 v = *(const uint4*)(raw + (s + j) * 136 + d0); float f[8]; unpack8(v, f);
#pragma unroll
        for (int i = 0; i < 8; ++i) y[i] += cw[j * 128 + d0 + i] * f[i]; }
}
DI void mlstm_gates(const Frame& F, const bf16_t* U1, int b, int h, int c, float* li, float* bc) {
    if (F.wave == 0) {
        const size_t row = (size_t)b * SEQ + c * 64 + F.lane;
        const float* gts = (const float*)(F.ws + WS_GATES);
        const float ip = gts[row * 8 + h] + F.in[26][h];
        const float fp = gts[row * 8 + 4 + h] + F.in[27][h];
        const float lf = fminf(fp, 0.f) - log1pf(expf(-fabsf(fp)));
        float cs = lf;
        for (int o = 1; o < 64; o <<= 1) { const float n = __shfl_up(cs, o); if (F.lane >= o) cs += n; }
        li[F.lane] = ip; bc[F.lane] = cs;
    }
    __syncthreads();
}
constexpr int ML_LI = 0, ML_BC = 256, ML_WK = 512, ML_MT = 768, ML_DQ = 1024, ML_RS = 1280, ML_NIN = 1536, ML_Q = 2048, ML_K = ML_Q + 64 * 136 * 2, ML_VT = ML_K + 64 * 136 * 2,
              ML_CT = ML_VT + 128 * 72 * 2, ML_W = ML_CT + 128 * 136 * 2, ML_KT = ML_W + 64 * 72 * 2, ML_END = ML_KT + 128 * 72 * 2;
static_assert(ML_END + 5120 + LDS_WORK_OFF <= LDS_BYTES - 12288, "mlstm lds");

DI void p8a_mlstm_local(const Frame& F) {
    const bf16_t* U1 = (const bf16_t*)(F.ws + WS_U);
    bf16_t* ST = (bf16_t*)(F.ws + WS_BFB);
    float* zloc = (float*)(F.ws + WS_ZLOC); float* scal = (float*)(F.ws + WS_SCAL);
    unsigned char* L = F.lds;
    float* li = (float*)(L + ML_LI); float* bc = (float*)(L + ML_BC); float* wk = (float*)(L + ML_WK);
    bf16_t* kT = (bf16_t*)(L + ML_KT); bf16_t* vT = (bf16_t*)(L + ML_VT); float* cwl = (float*)(L + ML_END); bf16_t* raw = (bf16_t*)(L + ML_Q);
    const float* cw = F.in[24]; const float* cb = F.in[25];
    uint4 rk3[3], rv3[3];
    auto prefetch = [&](int unit) { const int c = unit & 63, h = (unit >> 6) & 3, b = unit >> 8;
        load_raw128(F, U1, b, c * 64 - 3, 67, C_DK + h * 128, rk3); load_raw128(F, U1, b, c * 64, 64, C_DV + h * 128, rv3); };
    if (F.bid < 2048) prefetch(F.bid);
    for (int unit = F.bid; unit < 2048; unit += F.G) {
        const int c = unit & 63, h = (unit >> 6) & 3, b = unit >> 8;
        mlstm_gates(F, U1, b, h, c, li, bc);
        if (F.wave == 0) {
            const float bl = bc[63]; const float dec = bl - bc[F.lane] + li[F.lane];
            const float dmx = wave_max(dec);
            wk[F.lane] = expf(dec - dmx);
            if (F.lane == 0) { scal[unit] = bl; scal[2048 + unit] = dmx; }
        }
        for (int e = F.tid; e < 640; e += 512) cwl[e] = e < 512 ? cw[(size_t)(e >> 7) * 1024 + 512 + h * 128 + (e & 127)] : cb[512 + h * 128 + (e - 512)];
        write_raw128(F, 67, rk3, raw);
        __syncthreads();
        for (int it = F.tid; it < 1024; it += 512) {
            const int s = it & 63, d0 = (it >> 6) * 8;
            float y[8]; conv8_lds(raw, s, d0, cwl, cwl + 512, y);
            const float w = wk[s] * 0.08838834764831845f;
#pragma unroll
            for (int i = 0; i < 8; ++i) kT[(d0 + i) * 72 + s] = f2bf(siluf_(y[i]) * w);
        }
        __syncthreads();
        write_raw128(F, 64, rv3, raw);
        if (unit + F.G < 2048) prefetch(unit + F.G);
        __syncthreads();
        for (int it = F.tid; it < 1024; it += 512) {
            const int s = it & 63, d0 = (it >> 6) * 8;
            const uint4 vv = *(const uint4*)(raw + s * 136 + d0); const unsigned wv[4] = {vv.x, vv.y, vv.z, vv.w};
#pragma unroll
            for (int i = 0; i < 8; ++i) vT[(d0 + i) * 72 + s] = (bf16_t)((i & 1) ? (wv[i >> 1] >> 16) : (wv[i >> 1] & 0xFFFFu));
        }
        __syncthreads();
        for (int tix = F.wave * 8; tix < F.wave * 8 + 8; ++tix) {
            const int et = tix >> 3, dt = tix & 7;
            const f32x4 a = mma16(vT + et * 16 * 72, 72, kT + dt * 16 * 72, 72, 64, F.lane);
            const int fr = F.lane & 15, fq = F.lane >> 4;
#pragma unroll
            for (int r = 0; r < 4; ++r) ST[(size_t)unit * 16384 + (size_t)(et * 16 + 4 * fq + r) * 128 + dt * 16 + fr] = f2bf(a[r]);
        }
        { const int d = F.tid >> 2, part = F.tid & 3; float z = 0.f;
#pragma unroll
          for (int s = 0; s < 16; ++s) z += bf2f(kT[d * 72 + part * 16 + s]);
          z += __shfl_xor(z, 1); z += __shfl_xor(z, 2);
          if (part == 0) zloc[(size_t)unit * 128 + d] = z; }
        __syncthreads();
    }
}

DI void p8a_lru_local(const Frame& F) {
    const bf16_t* U1 = (const bf16_t*)(F.ws + WS_U);
    bf16_t* LA = (bf16_t*)(F.ws + WS_LRUA); bf16_t* LH = (bf16_t*)(F.ws + WS_LRUH);
    float* Aend = (float*)(F.ws + WS_AEND); float* Hend = (float*)(F.ws + WS_HEND);
    const bf16_t* WAT = (const bf16_t*)(F.ws + WS_WAT); const bf16_t* WXT = (const bf16_t*)(F.ws + WS_WXT);
    bf16_t* xcb = (bf16_t*)F.lds;
    float* cwL = (float*)(F.lds + 16640);
    bf16_t* rawl = (bf16_t*)(F.lds + 16640 + 10240);
    const int g = F.wave, lane = F.lane, fr = lane & 15, fq = lane >> 4;
    __syncthreads();
    for (int e = F.tid; e < 2048; e += 512) cwL[e] = F.in[17][e];
    cwL[2048 + F.tid] = F.in[18][F.tid];
    bf16x8 wa[4][2], wx[4][2]; float ba[4], bx[4], sp[4];
#pragma unroll
    for (int ct = 0; ct < 4; ++ct) { const int ch = g * 64 + ct * 16 + fr;
#pragma unroll
        for (int ks = 0; ks < 2; ++ks) { wa[ct][ks] = *(const bf16x8*)(WAT + (size_t)ch * 64 + 32 * ks + 8 * fq); wx[ct][ks] = *(const bf16x8*)(WXT + (size_t)ch * 64 + 32 * ks + 8 * fq); }
        ba[ct] = F.in[20][ch]; bx[ct] = F.in[22][ch]; sp[ct] = log1pf(expf(-F.in[23][ch])); }
    __syncthreads();
    for (int unit = F.bid; unit < 512; unit += F.G) {
        const int b = unit >> 6, c = unit & 63, t0 = c * 64;
        float Ac[4] = {1.f, 1.f, 1.f, 1.f}, hl[4] = {0.f, 0.f, 0.f, 0.f};
        uint4 rr[3];
        auto ldraw = [&](int sub) {
#pragma unroll
            for (int j = 0; j < 3; ++j) { const int it = F.tid + j * 512; const int row = it >> 6, c8 = (it & 63) * 8; const int t = t0 + sub * 16 - 3 + row;
                rr[j] = make_uint4(0u, 0u, 0u, 0u); if (it < 19 * 64 && t >= 0) rr[j] = *(const uint4*)(U1 + ((size_t)b * SEQ + t) * LD1 + C_CX + c8); } };
        ldraw(0);
#pragma unroll 1
        for (int sub = 0; sub < 4; ++sub) {
#pragma unroll
            for (int j = 0; j < 3; ++j) { const int it = F.tid + j * 512; if (it < 19 * 64) *(uint4*)(rawl + (it >> 6) * 520 + (it & 63) * 8) = rr[j]; }
            __syncthreads();
            if (sub < 3) ldraw(sub + 1);
            for (int it = F.tid; it < 1024; it += 512) {
                const int tk = it >> 6, c8 = (it & 63) * 8;
                float y[8];
#pragma unroll
                for (int i = 0; i < 8; ++i) y[i] = cwL[2048 + c8 + i];
#pragma unroll
                for (int j = 0; j < 4; ++j) { const uint4 v = *(const uint4*)(rawl + (tk + j) * 520 + c8); float f[8]; unpack8(v, f);
#pragma unroll
                    for (int i = 0; i < 8; ++i) y[i] += cwL[j * 512 + c8 + i] * f[i]; }
                uint4 o; o.x = pack2(y[0], y[1]); o.y = pack2(y[2], y[3]); o.z = pack2(y[4], y[5]); o.w = pack2(y[6], y[7]);
                *(uint4*)(xcb + tk * 520 + c8) = o;
            }
            __syncthreads();
            bf16x8 af[2];
#pragma unroll
            for (int ks = 0; ks < 2; ++ks) af[ks] = *(const bf16x8*)(xcb + fr * 520 + g * 64 + 32 * ks + 8 * fq);
#pragma unroll
            for (int ct = 0; ct < 4; ++ct) {
                const int ch = g * 64 + ct * 16 + fr;
                f32x4 accA = {0.f, 0.f, 0.f, 0.f}, accX = {0.f, 0.f, 0.f, 0.f};
#pragma unroll
                for (int ks = 0; ks < 2; ++ks) { accA = __builtin_amdgcn_mfma_f32_16x16x32_bf16(af[ks], wa[ct][ks], accA, 0, 0, 0); accX = __builtin_amdgcn_mfma_f32_16x16x32_bf16(af[ks], wx[ct][ks], accX, 0, 0, 0); }
                float Ap[4], Hp[4]; float A4 = 1.f, H4 = 0.f;
#pragma unroll
                for (int rg = 0; rg < 4; ++rg) {
                    const float xc = bf2f(xcb[(4 * fq + rg) * 520 + ch]);
                    const float r = sigmoidf_(accA[rg] + ba[ct]), ig = sigmoidf_(accX[rg] + bx[ct]);
                    const float a = fexp_(-8.0f * r * sp[ct]);
                    const float bt = sqrtf(fmaxf(1.0f - a * a, 0.f)) * (ig * xc);
                    H4 = a * H4 + bt; A4 *= a; Ap[rg] = A4; Hp[rg] = H4;
                }
                float iA = A4, iH = H4;
                { const float pA = __shfl_up(iA, 16), pH = __shfl_up(iH, 16); if (fq >= 1) { iH = iA * pH + iH; iA = pA * iA; } }
                { const float pA = __shfl_up(iA, 32), pH = __shfl_up(iH, 32); if (fq >= 2) { iH = iA * pH + iH; iA = pA * iA; } }
                float eA = __shfl_up(iA, 16), eH = __shfl_up(iH, 16); if (fq == 0) { eA = 1.f; eH = 0.f; }
                const float tA = __shfl(iA, 48 + fr), tH = __shfl(iH, 48 + fr);
                const float cA = Ac[ct] * eA, cH = eA * hl[ct] + eH;
#pragma unroll
                for (int rg = 0; rg < 4; ++rg) { const size_t row = (size_t)b * SEQ + t0 + sub * 16 + 4 * fq + rg;
                    LA[row * 512 + ch] = f2bf(cA * Ap[rg]); LH[row * 512 + ch] = f2bf(Ap[rg] * cH + Hp[rg]); }
                hl[ct] = tA * hl[ct] + tH; Ac[ct] = Ac[ct] * tA;
            }
            __syncthreads();
        }
        if (fq == 0) {
#pragma unroll
            for (int ct = 0; ct < 4; ++ct) { const int ch = g * 64 + ct * 16 + fr; Aend[((size_t)b * 64 + c) * 512 + ch] = Ac[ct]; Hend[((size_t)b * 64 + c) * 512 + ch] = hl[ct]; } }
    }
    __syncthreads();
}

DI void p8b_scans(const Frame& F) {
    const int gt = F.bid * 512 + F.tid, nthr = F.G * 512;
    if (gt < 4096) {
        const int b = gt >> 9, ch = gt & 511;
        const float* Aend = (const float*)(F.ws + WS_AEND); const float* Hend = (const float*)(F.ws + WS_HEND); float* Hin = (float*)(F.ws + WS_HIN);
        float H = 0.f;
#pragma unroll 1
        for (int c0 = 0; c0 < 64; c0 += 8) {
            float av[8], hv[8];
#pragma unroll
            for (int j = 0; j < 8; ++j) { const size_t o = ((size_t)b * 64 + c0 + j) * 512 + ch; av[j] = Aend[o]; hv[j] = Hend[o]; }
#pragma unroll
            for (int j = 0; j < 8; ++j) { const size_t o = ((size_t)b * 64 + c0 + j) * 512 + ch; Hin[o] = H; H = av[j] * H + hv[j]; }
        }
    }
    const float* scal = (const float*)(F.ws + WS_SCAL); float* minp = (float*)(F.ws + WS_SCAL) + 4096;
    if (gt >= nthr - 4096) {
        const int q = gt - (nthr - 4096); const int bh = q >> 7, d = q & 127;
        const float* zloc = (const float*)(F.ws + WS_ZLOC); float* nin = (float*)(F.ws + WS_NIN);
        float m = 0.f, n = 0.f;
#pragma unroll 1
        for (int c0 = 0; c0 < 64; c0 += 8) {
            float zv[8];
#pragma unroll
            for (int j = 0; j < 8; ++j) zv[j] = zloc[(size_t)(bh * 64 + c0 + j) * 128 + d];
#pragma unroll
            for (int j = 0; j < 8; ++j) { const int unit = bh * 64 + c0 + j; const float bl = scal[unit], dm = scal[2048 + unit];
                const float mn = fmaxf(bl + m, dm); const float keep = expf(bl + m - mn), add = expf(dm - mn);
                nin[(size_t)unit * 128 + d] = n; if (d == 0) minp[unit] = m;
                n = keep * n + add * zv[j]; m = mn; }
        }
    }
    bf16_t* ST = (bf16_t*)(F.ws + WS_BFB);
    float* kp = (float*)F.lds; float* ad = kp + 64;
    if (gt < 65536) {
        const int bh = gt >> 11, ed = (gt & 2047) * 8;
        if (F.wave == 0) { const int c = F.lane; const int unit = bh * 64 + c; const float bl = scal[unit], dm = scal[2048 + unit];
            float Bi = bl;
            for (int o = 1; o < 64; o <<= 1) { const float n = __shfl_up(Bi, o); if (c >= o) Bi += n; }
            float pm = dm - Bi;
            for (int o = 1; o < 64; o <<= 1) { const float n = __shfl_up(pm, o); if (c >= o) pm = fmaxf(pm, n); }
            const float mnext = Bi + fmaxf(0.f, pm);
            float mcur = __shfl_up(mnext, 1); if (c == 0) mcur = 0.f;
            kp[c] = expf(bl + mcur - mnext); ad[c] = expf(dm - mnext); }
        __syncthreads();
        float C[8] = {0.f, 0.f, 0.f, 0.f, 0.f, 0.f, 0.f, 0.f};
#pragma unroll 1
        for (int c0 = 0; c0 < 64; c0 += 8) {
            uint4 sv[8];
#pragma unroll
            for (int j = 0; j < 8; ++j) sv[j] = *(const uint4*)(ST + (size_t)(bh * 64 + c0 + j) * 16384 + ed);
#pragma unroll
            for (int j = 0; j < 8; ++j) { float sf[8]; unpack8(sv[j], sf);
                uint4 o; o.x = pack2(C[0], C[1]); o.y = pack2(C[2], C[3]); o.z = pack2(C[4], C[5]); o.w = pack2(C[6], C[7]);
                *(uint4*)(ST + (size_t)(bh * 64 + c0 + j) * 16384 + ed) = o;
                const float kk = kp[c0 + j], aa = ad[c0 + j];
#pragma unroll
                for (int i = 0; i < 8; ++i) C[i] = kk * C[i] + aa * sf[i]; }
        }
    }
}

DI void p8c_mlstm_out(const Frame& F) {
    const bf16_t* U1 = (const bf16_t*)(F.ws + WS_U);
    const bf16_t* ST = (const bf16_t*)(F.ws + WS_BFB);
    bf16_t* Y = (bf16_t*)(F.ws + WS_BFA);
    const float* nin_g = (const float*)(F.ws + WS_NIN); const float* minp = (const float*)(F.ws + WS_SCAL) + 4096;
    unsigned char* L = F.lds;
    float* li = (float*)(L + ML_LI); float* bc = (float*)(L + ML_BC); float* wkk = (float*)(L + ML_WK); float* mt = (float*)(L + ML_MT); float* dq = (float*)(L + ML_DQ); float* rs = (float*)(L + ML_RS); float* nin = (float*)(L + ML_NIN);
    bf16_t* q = (bf16_t*)(L + ML_Q); bf16_t* k = (bf16_t*)(L + ML_K); bf16_t* vT = (bf16_t*)(L + ML_VT); bf16_t* CT = (bf16_t*)(L + ML_CT); bf16_t* W = (bf16_t*)(L + ML_W); float* cwl = (float*)(L + ML_END); bf16_t* raw = (bf16_t*)(L + ML_KT); float* HT = (float*)(L + ML_Q);
    const float* cw = F.in[24]; const float* cb = F.in[25];
    uint4 rq3[3], rk3[3], rv3[3]; u32x4 rc4[4];
    auto prefetch = [&](int unit) { const int c = unit & 63, h = (unit >> 6) & 3, b = unit >> 8;
        load_raw128(F, U1, b, c * 64 - 3, 67, C_DQ + h * 128, rq3);
        load_raw128(F, U1, b, c * 64 - 3, 67, C_DK + h * 128, rk3);
        load_raw128(F, U1, b, c * 64, 64, C_DV + h * 128, rv3);
#pragma unroll
        for (int j = 0; j < 4; ++j) { const int it = F.tid + j * 512; rc4[j] = *(const u32x4*)(ST + (size_t)unit * 16384 + (it >> 4) * 128 + (it & 15) * 8); } };
    if (F.bid < 2048) prefetch(F.bid);
    for (int unit = F.bid; unit < 2048; unit += F.G) {
        const int c = unit & 63, h = (unit >> 6) & 3, b = unit >> 8;
        const float m_in = minp[unit];
        for (int e = F.tid; e < 1280; e += 512) { float v;
            if (e < 512) v = cw[(size_t)(e >> 7) * 1024 + h * 128 + (e & 127)]; else if (e < 1024) v = cw[(size_t)((e - 512) >> 7) * 1024 + 512 + h * 128 + (e & 127)];
            else if (e < 1152) v = cb[h * 128 + (e - 1024)]; else v = cb[512 + h * 128 + (e - 1152)];
            cwl[e] = v; }
        mlstm_gates(F, U1, b, h, c, li, bc);
        write_raw128(F, 67, rq3, raw);
        __syncthreads();
        for (int it = F.tid; it < 1024; it += 512) { const int s = it & 63, d0 = (it >> 6) * 8;
            float y[8]; conv8_lds(raw, s, d0, cwl, cwl + 1024, y);
            uint4 o; o.x = pack2(siluf_(y[0]), siluf_(y[1])); o.y = pack2(siluf_(y[2]), siluf_(y[3])); o.z = pack2(siluf_(y[4]), siluf_(y[5])); o.w = pack2(siluf_(y[6]), siluf_(y[7]));
            *(uint4*)(q + s * 136 + d0) = o; }
        __syncthreads();
        write_raw128(F, 67, rk3, raw);
        __syncthreads();
        for (int it = F.tid; it < 1024; it += 512) { const int s = it & 63, d0 = (it >> 6) * 8;
            float y[8]; conv8_lds(raw, s, d0, cwl + 512, cwl + 1152, y);
            const float sc = 0.08838834764831845f; uint4 o;
            o.x = pack2(siluf_(y[0]) * sc, siluf_(y[1]) * sc); o.y = pack2(siluf_(y[2]) * sc, siluf_(y[3]) * sc); o.z = pack2(siluf_(y[4]) * sc, siluf_(y[5]) * sc); o.w = pack2(siluf_(y[6]) * sc, siluf_(y[7]) * sc);
            *(uint4*)(k + s * 136 + d0) = o; }
        __syncthreads();
        write_raw128(F, 64, rv3, raw);
        __syncthreads();
        for (int it = F.tid; it < 1024; it += 512) { const int s = it & 63, d0 = (it >> 6) * 8;
            const uint4 vv = *(const uint4*)(raw + s * 136 + d0); const unsigned wv[4] = {vv.x, vv.y, vv.z, vv.w};
#pragma unroll
            for (int i = 0; i < 8; ++i) vT[(d0 + i) * 72 + s] = (bf16_t)((i & 1) ? (wv[i >> 1] >> 16) : (wv[i >> 1] & 0xFFFFu)); }
#pragma unroll
        for (int j = 0; j < 4; ++j) { const int it = F.tid + j * 512; *(u32x4*)(CT + (it >> 4) * 136 + (it & 15) * 8) = rc4[j]; }
        if (unit + F.G < 2048) prefetch(unit + F.G);
        if (F.tid < 128) nin[F.tid] = nin_g[(size_t)unit * 128 + F.tid];
        if (F.tid >= 128 && F.tid < 192) { const int l = F.tid - 128;
            float pm = li[l] - bc[l];
            for (int o = 1; o < 64; o <<= 1) { const float n = __shfl_up(pm, o); if (l >= o) pm = fmaxf(pm, n); }
            mt[l] = bc[l] + fmaxf(m_in, pm); }
        __syncthreads();
        { const int l = F.tid >> 3, part = F.tid & 7; float a = 0.f;
#pragma unroll
          for (int d = 0; d < 16; ++d) a += bf2f(q[l * 136 + part * 16 + d]) * nin[part * 16 + d];
          a += __shfl_xor(a, 1); a += __shfl_xor(a, 2); a += __shfl_xor(a, 4);
          if (part == 0) dq[l] = a; }
        for (int tix = F.wave * 2; tix < F.wave * 2 + 2; ++tix) {
            const int lt = tix >> 2, st = tix & 3;
            const f32x4 a = mma16(q + lt * 16 * 136, 136, k + st * 16 * 136, 136, 128, F.lane);
            const int fr = F.lane & 15, fq = F.lane >> 4; const int s = st * 16 + fr;
#pragma unroll
            for (int r = 0; r < 4; ++r) { const int l = lt * 16 + 4 * fq + r;
                const float w = s <= l ? a[r] * expf(bc[l] - bc[s] + li[s] - mt[l]) : 0.f;
                W[l * 72 + s] = f2bf(w); }
        }
        __syncthreads();
        { const int l = F.tid >> 3, part = F.tid & 7; float a = 0.f;
#pragma unroll
          for (int s = 0; s < 8; ++s) a += bf2f(W[l * 72 + part * 8 + s]);
          a += __shfl_xor(a, 1); a += __shfl_xor(a, 2); a += __shfl_xor(a, 4);
          if (part == 0) rs[l] = a; }
        if (F.tid >= 64 && F.tid < 128) { const int l = F.tid - 64; li[l] = expf(bc[l] + m_in - mt[l]); }
        if (F.tid >= 128 && F.tid < 192) { const int l = F.tid - 128; wkk[l] = expf(-mt[l]); }
        __syncthreads();
        uint4 ro2[2], rz2[2];
#pragma unroll
        for (int j = 0; j < 2; ++j) { const int it = F.tid + j * 512; const size_t row = (size_t)b * SEQ + c * 64 + (it >> 4);
            ro2[j] = *(const uint4*)(U1 + row * LD1 + C_DO + h * 128 + (it & 15) * 8); rz2[j] = *(const uint4*)(U1 + row * LD1 + C_DZ + h * 128 + (it & 15) * 8); }
        f32x4 hres[4];
#pragma unroll
        for (int ti = 0; ti < 4; ++ti) { const int tix = F.wave * 4 + ti;
            const int lt = tix >> 3, et = tix & 7;
            const f32x4 qc = mma16(q + lt * 16 * 136, 136, CT + et * 16 * 136, 136, 128, F.lane);
            const f32x4 wv = mma16(W + lt * 16 * 72, 72, vT + et * 16 * 72, 72, 64, F.lane);
            const int fq = F.lane >> 4;
#pragma unroll
            for (int r = 0; r < 4; ++r) { const int l = lt * 16 + 4 * fq + r;
                const float prev = li[l];
                const float num = prev * qc[r] + wv[r];
                const float den = prev * dq[l] + rs[l];
                hres[ti][r] = num * __builtin_amdgcn_rcpf(fmaxf(fabsf(den), wkk[l])); }
        }
        __syncthreads();
#pragma unroll
        for (int ti = 0; ti < 4; ++ti) { const int tix = F.wave * 4 + ti; const int lt = tix >> 3, et = tix & 7; const int fr = F.lane & 15, fq = F.lane >> 4;
#pragma unroll
            for (int r = 0; r < 4; ++r) HT[(lt * 16 + 4 * fq + r) * 132 + et * 16 + fr] = hres[ti][r]; }
        __syncthreads();
#pragma unroll
        for (int j = 0; j < 2; ++j) { const int it = F.tid + j * 512; const int l = it >> 4, e0 = (it & 15) * 8;
            const size_t row = (size_t)b * SEQ + c * 64 + l;
            float of[8], zf[8]; unpack8(ro2[j], of); unpack8(rz2[j], zf);
            const f32x4 h0 = *(const f32x4*)(HT + l * 132 + e0), h1 = *(const f32x4*)(HT + l * 132 + e0 + 4);
            float y[8];
#pragma unroll
            for (int i = 0; i < 4; ++i) { y[i] = sigmoidf_(of[i]) * h0[i] * siluf_(zf[i]); y[4 + i] = sigmoidf_(of[4 + i]) * h1[i] * siluf_(zf[4 + i]); }
            uint4 o; o.x = pack2(y[0], y[1]); o.y = pack2(y[2], y[3]); o.z = pack2(y[4], y[5]); o.w = pack2(y[6], y[7]);
            *(uint4*)(Y + row * 1024 + 512 + h * 128 + e0) = o; }
        __syncthreads();
    }
}
DI void p8c_lru_out(const Frame& F) {
    const bf16_t* U1 = (const bf16_t*)(F.ws + WS_U);
    const bf16_t* LA = (const bf16_t*)(F.ws + WS_LRUA); const bf16_t* LH = (const bf16_t*)(F.ws + WS_LRUH);
    const float* Hin = (const float*)(F.ws + WS_HIN);
    bf16_t* Y = (bf16_t*)(F.ws + WS_BFA);
    const size_t n8 = (size_t)MT * 64;
    for (size_t it = (size_t)F.bid * 512 + F.tid; it < n8; it += (size_t)F.G * 512) {
        const size_t row = it >> 6; const int c0 = (int)(it & 63) * 8; const int b = (int)(row >> 12), t = (int)(row & 4095), c = t >> 6;
        const uint4 av = *(const uint4*)(LA + row * 512 + c0), hv = *(const uint4*)(LH + row * 512 + c0), zv = *(const uint4*)(U1 + row * LD1 + C_CZ + c0);
        float af[8], hf[8], zf[8]; unpack8(av, af); unpack8(hv, hf); unpack8(zv, zf);
        const float* hi = Hin + ((size_t)b * 64 + c) * 512 + c0; float y[8];
#pragma unroll
        for (int i = 0; i < 8; ++i) y[i] = (af[i] * hi[i] + hf[i]) * siluf_(zf[i]);
        uint4 o; o.x = pack2(y[0], y[1]); o.y = pack2(y[2], y[3]); o.z = pack2(y[4], y[5]); o.w = pack2(y[6], y[7]);
        *(uint4*)(Y + row * 1024 + c0) = o;
    }
}

constexpr int N_PHASES = 16;
__global__ void __launch_bounds__(512, 2) mk_fwd(Args args) {
    extern __shared__ __attribute__((aligned(16))) unsigned char smem[];
    Frame F;
    F.tid = threadIdx.x; F.lane = F.tid & 63; F.wave = __builtin_amdgcn_readfirstlane(F.tid >> 6);
    F.G = gridDim.x; F.bid = blockIdx.x; F.gw = F.bid * 8 + F.wave; F.nw = F.G * 8;
    F.lds = smem + LDS_WORK_OFF; F.ws = args.ws; F.out = args.out; F.ctl = (unsigned*)args.ws;
#pragma unroll
    for (int i = 0; i < 28; ++i) F.in[i] = args.in[i];
    LAS unsigned char* lsm = (LAS unsigned char*)smem;
    LAS unsigned char* lut = lsm + (LDS_BYTES - 12288);
    LAS float* tbl = (LAS float*)(lsm + (LDS_BYTES - 12288 + 256));
    LAS float* biasL = (LAS float*)(lsm + (LDS_BYTES - 8192));
    if (F.tid < 4) ((LAS unsigned*)lsm)[F.tid] = 0u;
    if (F.tid < 128) { const int n = F.tid; int bk;
        if (n < 16) bk = n; else { bk = 16; const int thr[15] = {19, 21, 24, 27, 31, 35, 40, 46, 52, 59, 67, 77, 87, 99, 113};
#pragma unroll
            for (int j = 0; j < 15; ++j) bk += (n >= thr[j]) ? 1 : 0; }
        lut[n] = (unsigned char)bk; }
    { const int hd = F.tid >> 5, bk = F.tid & 31; tbl[hd * 32 + bk] = args.in[6][bk * 16 + hd]; }
    F.lut = lut; F.tbl = tbl; F.biasL = biasL; F.ldsl = lsm + LDS_WORK_OFF;
    __syncthreads();
    for (int e = F.tid; e < 16 * 128; e += 512) { const int hd = e >> 7, n = e & 127; const int bk = n < 16 ? n : (n >= 113 ? 31 : (int)lut[n]); biasL[e] = tbl[hd * 32 + bk] * 1.4426950408889634f; }
    __syncthreads();
    const int lo = args.ph_lo, hi = args.ph_hi;
    XcdBarrier bar; bar.bar = F.ctl; bar.x = 0; bar.st = nullptr;
#if !MK_PER_PHASE
    bar = xcd_barrier_post(F.ctl, (volatile LAS unsigned*)lsm);
#endif
#ifndef PH_MASK
#define PH_MASK 0xFFFF
#endif
#define IN(k) (phase_refresh(F), ((PH_MASK >> (k)) & 1) && lo <= (k) && (k) < hi)
#ifndef DLY_LO
#define DLY_LO -1
#define DLY_HI -1
#endif
#ifndef DLY_MULT
#define DLY_MULT 4
#endif
    unsigned long long dly_t0 = 0ull;
#define DLY_START(k) do { if ((k) == DLY_LO && F.bid == 0 && F.tid == 0) dly_t0 = __builtin_amdgcn_s_memrealtime(); } while (0)
#define DLY_END(k) do { if ((k) == DLY_HI && F.bid == 0) { if (F.tid == 0) { const unsigned long long t1 = __builtin_amdgcn_s_memrealtime(); const unsigned long long until = t1 + DLY_MULT * (t1 - dly_t0); \
        while (__builtin_amdgcn_s_memrealtime() < until) __builtin_amdgcn_s_sleep(16); } __syncthreads(); } } while (0)
#if MK_PER_PHASE
#define SEAM(k) do { } while (0)
#else
#define SEAM(k) do { if (IN(k) && IN((k) + 1)) xcd_barrier(bar); DLY_END(k); DLY_START((k) + 1); } while (0)
#endif
    LAS unsigned char* glds = lsm + LDS_WORK_OFF;
    unsigned char* ws = args.ws;
    bf16_t* BFA = (bf16_t*)(ws + WS_BFA); bf16_t* BFB = (bf16_t*)(ws + WS_BFB); bf16_t* U = (bf16_t*)(ws + WS_U); bf16_t* Ef = (bf16_t*)(ws + WS_U); bf16_t* X1b = (bf16_t*)F.out;

    DLY_START(0);
    if (IN(0)) { p0_prologue(F); }
    SEAM(0);
    if (IN(1)) {
        pg8::Gemm g{BFA, (const bf16_t*)(ws + WS_WIN0), MT, LD0, 1024}; pg8::StaticOrder S; S.init(MT, LD0, F.G, F.bid);
        pg8::EpiBf16<0> E{U, LD0};
        pg8::gemm_phase(glds, g, S, E);
        pg8::Gemm g2{(const bf16_t*)(ws + WS_WVT), BFA, 512, MT, 1024}; pg8::StaticOrder S2; S2.init(512, MT, F.G, F.bid);
        pg8::EpiBf16<0> E2{(bf16_t*)(ws + WS_VT), MT};
        pg8::gemm_phase(glds, g2, S2, E2);
    }
    SEAM(1);
    if (IN(2)) { p2a_build_blocks(F); }
    SEAM(2);
    if (IN(3)) {
        if (F.bid < 32) {
            const int which = F.bid >> 4;
            pg8::Gemm g{(const bf16_t*)(ws + (which ? WS_AV : WS_AK)), (const bf16_t*)(ws + (which ? WS_WC1V : WS_WC1K)), 4096, 256, 2048}; pg8::StaticOrder S; S.init(4096, 256, F.G, F.bid & 15);
            pg8::EpiBf16<1> E{(bf16_t*)(ws + (which ? WS_HV : WS_HK)), 256}; pg8::gemm_phase(glds, g, S, E);
            asm volatile("s_waitcnt vmcnt(0)" ::: "memory"); __syncthreads();
            pg8::Unit u; S.next(0, u);
            p2c_compress_rows(F, which, u.pm * 256);
            asm volatile("s_waitcnt vmcnt(0)" ::: "memory"); __syncthreads();
            if (F.tid == 0) { __builtin_amdgcn_fence(__ATOMIC_RELEASE, "agent"); asm volatile("s_waitcnt vmcnt(0)" ::: "memory");
                (void)__hip_atomic_fetch_add(F.ctl + CW_CMPDONE, 1u, __ATOMIC_RELAXED, __HIP_MEMORY_SCOPE_AGENT); }
        }
        att_dsa(F);
    }
    if (IN(5)) {
        if (F.tid == 0) { unsigned sp = 0;
            while (__hip_atomic_load(F.ctl + CW_CMPDONE, __ATOMIC_RELAXED, __HIP_MEMORY_SCOPE_AGENT) < 32u) { __builtin_amdgcn_s_sleep(2);
                if (++sp > (1u << 22)) { atomicAdd(F.ctl + XB_TMO, 1u); break; } }
            __builtin_amdgcn_fence(__ATOMIC_ACQUIRE, "agent"); asm volatile("s_waitcnt vmcnt(0)" ::: "memory"); }
        __syncthreads();
        att_nsa(F); }
    if (IN(3) && IN(6)) xcd_barrier(bar);
    if (IN(6)) {
        pg8::Gemm g{BFB, (const bf16_t*)(ws + WS_WOUT0), MT, 1024, 1024}; pg8::StaticOrder S; S.init(MT, 1024, F.G, F.bid);
        pg8::EpiResid<0> E{F.in[0], nullptr, BFA};
        pg8::gemm_phase(glds, g, S, E);
    }
    SEAM(6);
    if (IN(7)) {
        { pg8::Gemm g{(const bf16_t*)(ws + WS_PBF), (const bf16_t*)(ws + WS_WP0), MT, 1024, 256}; pg8::StaticOrder S; S.init(MT, 1024, F.G, F.bid);
          pg8::EpiBf16<0> E{Ef, 1024}; pg8::gemm_phase(glds, g, S, E); }
        asm volatile("s_waitcnt vmcnt(0)" ::: "memory"); __syncthreads();
        { pg8::Gemm g{BFA, (const bf16_t*)(ws + WS_WG0), MT, 1024, 1024}; pg8::StaticOrder S; S.init(MT, 1024, F.G, F.bid);
          pg8::EpiGate<1> E{nullptr, X1b, BFA, Ef}; pg8::gemm_phase(glds, g, S, E); }
    }
    SEAM(7);
    if (IN(8)) { rmsnorm_gates(F, X1b, F.in[2] + 1024, BFB); }
    SEAM(8);
    if (IN(9)) {
        pg8::Gemm g{BFB, (const bf16_t*)(ws + WS_WIN1), MT, LD1, 1024}; pg8::StaticOrder S; S.init(MT, LD1, F.G, F.bid);
        pg8::EpiBf16<0> E{U, LD1};
        pg8::gemm_phase(glds, g, S, E);
    }
    SEAM(9);
    if (IN(10)) { p8a_mlstm_local(F); p8a_lru_local(F); }
    SEAM(10);
    if (IN(11)) { p8b_scans(F); }
    SEAM(11);
    if (IN(12)) { p8c_mlstm_out(F); p8c_lru_out(F); }
    SEAM(12);

    if (IN(13)) {
        pg8::Gemm g{BFA, (const bf16_t*)(ws + WS_WOUT1), MT, 1024, 1024}; pg8::StaticOrder S; S.init(MT, 1024, F.G, F.bid);
        pg8::EpiResid<1> E{nullptr, X1b, BFB};
        pg8::gemm_phase(glds, g, S, E);
    }
    SEAM(13);
    if (IN(14)) {
        { pg8::Gemm g{(const bf16_t*)(ws + WS_PBF) + (size_t)MT * 256, (const bf16_t*)(ws + WS_WP1), MT, 1024, 256}; pg8::StaticOrder S; S.init(MT, 1024, F.G, F.bid);
          pg8::EpiBf16<0> E{Ef, 1024}; pg8::gemm_phase(glds, g, S, E); }
        asm volatile("s_waitcnt vmcnt(0)" ::: "memory"); __syncthreads();
        { pg8::Gemm g{BFB, (const bf16_t*)(ws + WS_WG1), MT, 1024, 1024}; pg8::StaticOrder S; S.init(MT, 1024, F.G, F.bid);
          pg8::EpiGate<0> E{F.out, nullptr, BFB, Ef}; pg8::gemm_phase(glds, g, S, E); }
    }
    SEAM(14);
    if (IN(15)) { rmsnorm_rows<1>(F, F.out, F.in[3], nullptr, F.out); }
#undef IN
#undef SEAM
}

extern "C" void kernel_launch(void* const* d_in, const int* in_sizes, int n_in, void* d_out, int out_size, void* d_ws, size_t ws_size, hipStream_t stream) {
    static int grid = 0;
    if (grid == 0) {
        if (n_in != 28 || out_size != MT * DM || ws_size < WS_END) { fprintf(stderr, "kernel_launch: unexpected shapes (n_in %d, out %d, ws %zu < %zu)\n", n_in, out_size, ws_size, (size_t)WS_END); grid = -1; return; }
        int dev = 0, cus = 0, per_cu = 0;
        if (hipGetDevice(&dev) != hipSuccess || hipDeviceGetAttribute(&cus, hipDeviceAttributeMultiprocessorCount, dev) != hipSuccess) { grid = -1; return; }
        if (hipFuncSetAttribute((const void*)mk_fwd, hipFuncAttributeMaxDynamicSharedMemorySize, LDS_BYTES) != hipSuccess) { fprintf(stderr, "kernel_launch: hipFuncSetAttribute failed\n"); grid = -1; return; }
        if (hipOccupancyMaxActiveBlocksPerMultiprocessor(&per_cu, (const void*)mk_fwd, 512, LDS_BYTES) != hipSuccess || per_cu < 1)
            fprintf(stderr, "kernel_launch: occupancy query reports %d workgroups per CU\n", per_cu);
        (void)hipGetLastError();
        grid = cus;
    }
    if (grid < 0) return;
    if (hipMemsetAsync(d_ws, 0, CTL_BYTES, stream) != hipSuccess) return;
    Args a{};
    for (int i = 0; i < 28; ++i) a.in[i] = (const float*)d_in[i];
    a.out = (float*)d_out; a.ws = (unsigned char*)d_ws;
#if MK_PER_PHASE
    for (int p = 0; p < N_PHASES; ++p) { a.ph_lo = p; a.ph_hi = p + 1; hipLaunchKernelGGL(mk_fwd, dim3(grid), dim3(512), LDS_BYTES, stream, a); }
#else
    a.ph_lo = 0; a.ph_hi = N_PHASES;
    hipLaunchKernelGGL(mk_fwd, dim3(grid), dim3(512), LDS_BYTES, stream, a);
#endif
}
```

```cpp
#include <hip/hip_runtime.h>
#include <cstdio>
#include <cstdint>

#ifndef MK_PER_PHASE
#define MK_PER_PHASE 0
#endif

#define LAS __attribute__((address_space(3)))
typedef unsigned short bf16_t;
typedef short bf16x8 __attribute__((ext_vector_type(8)));
typedef float f32x4 __attribute__((ext_vector_type(4)));
#define DI __device__ __forceinline__

constexpr int NB = 8, SEQ = 4096, DM = 1024, MT = NB * SEQ;
constexpr int LD0 = 3072, LD1 = 3584;
constexpr int C_AQ = 0, C_KC = 512, C_VC = 640, C_KS = 768, C_KW = 896, C_AZ = 1024, C_BQ = 1536, C_BZ = 2048,
              C_BK = 2560, C_BKI = 2624, C_BQI = 2688, C_AG = 2944, C_BWI = 2968;
constexpr int C_VS = 0, C_VW = 0, C_BV = 0;
constexpr int C_CX = 0, C_CZ = 512, C_DQ = 1024, C_DK = 1536, C_DV = 2048, C_DO = 2560, C_DZ = 3072;
constexpr int NCMP = 255;
constexpr float NEG_INF = -__builtin_inff();

DI int map0(int n) {
    if (n < 896) return n;
    if (n < 1024) return 1024 + (n - 896);
    if (n < 1536) return 1304 + (n - 1024);
    if (n < 2048) return 1816 + (n - 1536);
    if (n < 2560) return 2780 + (n - 2048);
    if (n < 2624) return 2328 + (n - 2560);
    if (n < 2688) return 2712 + (n - 2624);
    if (n < 2944) return 2456 + (n - 2688);
    if (n < 2968) return 1280 + (n - 2944);
    if (n < 2972) return 2776 + (n - 2968);
    return -1;
}
DI int map1(int n) {
    if (n < 2560) return n;
    if (n < 3072) return 2568 + (n - 2560);
    if (n < 3584) return 3080 + (n - 3072);
    return -1;
}
DI int mapid(int n) { return n; }
DI int mapv(int f) { return f < 128 ? 896 + f : (f < 256 ? 1152 + (f - 128) : (f < 320 ? 2392 + (f - 256) : -1)); }

constexpr size_t CTL_BYTES = 16384;
constexpr size_t WS_WIN0  = CTL_BYTES;
constexpr size_t WS_WOUT0 = WS_WIN0  + (size_t)LD0 * 1024 * 2;
constexpr size_t WS_WG0   = WS_WOUT0 + (size_t)1024 * 1024 * 2;
constexpr size_t WS_WP0   = WS_WG0   + (size_t)1024 * 1024 * 2;
constexpr size_t WS_WIN1  = WS_WP0   + (size_t)1024 * 256 * 2;
constexpr size_t WS_WOUT1 = WS_WIN1  + (size_t)LD1 * 1024 * 2;
constexpr size_t WS_WG1   = WS_WOUT1 + (size_t)1024 * 1024 * 2;
constexpr size_t WS_WP1   = WS_WG1   + (size_t)1024 * 1024 * 2;
constexpr size_t WS_WC1K  = WS_WP1   + (size_t)1024 * 256 * 2;
constexpr size_t WS_WC1V  = WS_WC1K  + (size_t)256 * 2048 * 2;
constexpr size_t WS_WVT   = WS_WC1V  + (size_t)256 * 2048 * 2;
constexpr size_t WS_BFA   = WS_WVT   + (size_t)512 * 1024 * 2;
constexpr size_t WS_BFB   = WS_BFA   + (size_t)MT * 1024 * 2;
constexpr size_t WS_PBF   = WS_BFB   + (size_t)MT * 1024 * 2;
constexpr size_t WS_U     = WS_PBF   + (size_t)2 * MT * 256 * 2;
constexpr size_t WS_X     = WS_U     + (size_t)MT * LD1 * 2;
constexpr size_t WS_AK    = WS_X;
constexpr size_t WS_AV    = WS_AK    + (size_t)4096 * 2048 * 2;
constexpr size_t WS_HK    = WS_AV    + (size_t)4096 * 2048 * 2;
constexpr size_t WS_HV    = WS_HK    + (size_t)4096 * 256 * 2;
constexpr size_t WS_LRUA  = WS_X;
constexpr size_t WS_LRUH  = WS_LRUA  + (size_t)MT * 512 * 2;
constexpr size_t WS_S     = WS_X     + (size_t)64 * 1024 * 1024;
constexpr size_t WS_KCMP  = WS_S;
constexpr size_t WS_VCMP  = WS_KCMP  + (size_t)16 * 256 * 64 * 4;
constexpr size_t WS_AEND  = WS_VCMP  + (size_t)16 * 256 * 64 * 4;
constexpr size_t WS_HEND  = WS_AEND  + (size_t)8 * 64 * 512 * 4;
constexpr size_t WS_HIN   = WS_HEND  + (size_t)8 * 64 * 512 * 4;
constexpr size_t WS_ZLOC  = WS_HIN   + (size_t)8 * 64 * 512 * 4;
constexpr size_t WS_NIN   = WS_ZLOC  + (size_t)2048 * 128 * 4;
constexpr size_t WS_SCAL  = WS_NIN   + (size_t)2048 * 128 * 4;
constexpr size_t WS_VCT   = WS_SCAL  + (size_t)3 * 2048 * 4;
constexpr size_t WS_WAT   = WS_VCT   + (size_t)16 * 64 * 256 * 2;
constexpr size_t WS_WXT   = WS_WAT   + (size_t)8 * 64 * 64 * 2;
constexpr size_t WS_GATES = WS_WXT   + (size_t)8 * 64 * 64 * 2;
constexpr size_t WS_SS    = WS_GATES + (size_t)MT * 8 * 4;
constexpr size_t WS_END   = WS_SS    + (size_t)MT * 4;
constexpr size_t WS_VT    = WS_U     + (size_t)MT * LD0 * 2;
static_assert(WS_VT + (size_t)512 * MT * 2 <= WS_X, "VT region");
static_assert(WS_HV + (size_t)4096 * 256 * 2 <= WS_S, "compress region");
static_assert(WS_LRUH + (size_t)MT * 512 * 2 <= WS_S, "lru region");

constexpr int XCD_BAR_WORDS_C = 3456;
constexpr int CW_QNSA = 3520, CW_QDSA = 3584;
constexpr int CW_NORMCNT = 3712;
constexpr int CW_CMPDONE = 3648;

constexpr int LDS_BYTES = 147456;
constexpr int LDS_CTL_OFF = 0;
constexpr int LDS_WORK_OFF = 128;

DI float bf2f(bf16_t v) { return __uint_as_float(((unsigned)v) << 16); }
DI bf16_t f2bf(float f) { unsigned u = __float_as_uint(f); u += 0x7FFFu + ((u >> 16) & 1u); return (bf16_t)(u >> 16); }
typedef __bf16 bf16v2 __attribute__((ext_vector_type(2)));
typedef float f32x2 __attribute__((ext_vector_type(2)));
DI unsigned pack2(float lo, float hi) { const f32x2 v = {lo, hi}; return __builtin_bit_cast(unsigned, __builtin_convertvector(v, bf16v2)); }
DI float fexp_(float x) { return __builtin_amdgcn_exp2f(x * 1.4426950408889634f); }
DI float sigmoidf_(float x) { return __builtin_amdgcn_rcpf(1.0f + fexp_(-x)); }
DI float siluf_(float x) { return x * __builtin_amdgcn_rcpf(1.0f + fexp_(-x)); }
DI float wave_max(float v) { for (int o = 32; o >= 1; o >>= 1) v = fmaxf(v, __shfl_xor(v, o)); return v; }
DI float wave_sum(float v) { for (int o = 32; o >= 1; o >>= 1) v += __shfl_xor(v, o); return v; }
DI void unpack8(const uint4& v, float (&f)[8]) {
    f[0] = __uint_as_float(v.x << 16); f[1] = __uint_as_float(v.x & 0xFFFF0000u);
    f[2] = __uint_as_float(v.y << 16); f[3] = __uint_as_float(v.y & 0xFFFF0000u);
    f[4] = __uint_as_float(v.z << 16); f[5] = __uint_as_float(v.z & 0xFFFF0000u);
    f[6] = __uint_as_float(v.w << 16); f[7] = __uint_as_float(v.w & 0xFFFF0000u);
}

#define XB_TMO      128
#define XB_XCNT(j)  (256  + 64 * (j))
#define XB_XSUB(j)  (1280 + 64 * (j))
#define XB_XGEN(j)  (2304 + 64 * (j))
#define XB_TOP      3328
#define XB_TOPGEN   3392
#define XCD_BAR_WORDS 3456
#define XB_SPIN_CAP (1u << 22)
static_assert(XCD_BAR_WORDS == XCD_BAR_WORDS_C, "bar words");

__device__ __forceinline__ unsigned xb_ld(unsigned* p)              { return __hip_atomic_load(p, __ATOMIC_RELAXED, __HIP_MEMORY_SCOPE_AGENT); }
__device__ __forceinline__ unsigned xb_add(unsigned* p, unsigned v) { return __hip_atomic_fetch_add(p, v, __ATOMIC_RELAXED, __HIP_MEMORY_SCOPE_AGENT); }
__device__ __forceinline__ unsigned xb_xcc_id() { return (unsigned)__builtin_amdgcn_s_getreg((3 << 11) | 20) & 0xFu; }
#define XB_SPIN(cond, bar) do { unsigned _sp = 0; while (cond) { __builtin_amdgcn_s_sleep(1); \
    if ((++_sp & 255u) == 0u) { if (xb_ld(&(bar)[XB_TMO])) break; if (_sp > XB_SPIN_CAP) { atomicAdd(&(bar)[XB_TMO], 1u); break; } } } } while (0)

struct XcdBarrier { unsigned* bar; unsigned x; volatile LAS unsigned* st; };

__device__ __forceinline__ XcdBarrier xcd_barrier_post(unsigned* bar, volatile LAS unsigned* st) {
    XcdBarrier b; b.bar = bar; b.x = xb_xcc_id(); b.st = st;
    if (threadIdx.x == 0) (void)xb_add(&bar[XB_XCNT(b.x)], 1u);
    return b;
}
__device__ __forceinline__ void xcd_barrier_complete(unsigned* bar, unsigned x, unsigned& nloc, unsigned& nx) {
    const unsigned G = gridDim.x * gridDim.y * gridDim.z;
    unsigned sum, cnt, mine, sp = 0u;
    for (;;) {
        sum = 0u; cnt = 0u; mine = 0u;
#pragma unroll
        for (unsigned j = 0; j < 16; ++j) { const unsigned c = xb_ld(&bar[XB_XCNT(j)]); sum += c; cnt += (c > 0u) ? 1u : 0u; mine = (j == x) ? c : mine; }
        if (sum == G) break;
        __builtin_amdgcn_s_sleep(1);
        if ((++sp & 255u) == 0u) { if (xb_ld(&bar[XB_TMO])) break; if (sp > XB_SPIN_CAP) { atomicAdd(&bar[XB_TMO], 1u); break; } }
    }
    nloc = mine > 0u ? mine : 1u; nx = cnt > 0u ? cnt : 1u;
}
__device__ __forceinline__ void xcd_barrier(const XcdBarrier& b) {
    asm volatile("s_waitcnt vmcnt(0)" ::: "memory");
    __syncthreads();
    if (threadIdx.x == 0) {
        unsigned* bar = b.bar;
        __builtin_amdgcn_s_waitcnt(0);
        unsigned nloc = b.st[0], nx = b.st[1];
        if (nloc == 0u) { xcd_barrier_complete(bar, b.x, nloc, nx); b.st[0] = nloc; b.st[1] = nx; }
        const unsigned old = xb_add(&bar[XB_XSUB(b.x)], 1u);
        const unsigned gen = old / nloc;
        if (old + 1u == (gen + 1u) * nloc) {
            __builtin_amdgcn_fence(__ATOMIC_RELEASE, "agent");
            asm volatile("s_waitcnt vmcnt(0)" ::: "memory");
            const unsigned og = xb_add(&bar[XB_TOP], 1u);
            const unsigned tg = og / nx;
            if (og + 1u == (tg + 1u) * nx) xb_add(&bar[XB_TOPGEN], 1u);
            else XB_SPIN(xb_ld(&bar[XB_TOPGEN]) == tg, bar);
            __builtin_amdgcn_fence(__ATOMIC_ACQUIRE, "agent");
            xb_add(&bar[XB_XGEN(b.x)], 1u);
            asm volatile("s_waitcnt vmcnt(0)" ::: "memory");
        } else {
            XB_SPIN(xb_ld(&bar[XB_XGEN(b.x)]) == gen, bar);
            __builtin_amdgcn_fence(__ATOMIC_ACQUIRE, "agent");
            asm volatile("s_waitcnt vmcnt(0)" ::: "memory");
        }
    }
    __syncthreads();
}

namespace pg8 {
constexpr int BM = 256, BK = 64, HALF = 128, HTB = HALF * BK * 2, STAGE_BYTES = 8 * HTB, NXCD = 8, WGM = 8;
__host__ __device__ __forceinline__ int lds_byte(int r, int c) { const int st = (r >> 4) * 2 + (c >> 5), rr = r & 15, cc = c & 31, ob = rr * 64 + cc * 2; return st * 1024 + (ob ^ (((ob >> 9) & 1) << 5)); }
__host__ __device__ __forceinline__ void stage_rc(int b, int& R, int& C) { const int st = b / 1024, sb = b % 1024, swz = sb ^ (((sb >> 9) & 1) << 5); R = (st >> 1) * 16 + swz / 64; C = (st & 1) * 32 + (swz % 64) / 2; }
__host__ __device__ __forceinline__ int perm32(int rho) { const int n = rho >> 4, i = rho & 15; return 8 * (i >> 2) + 4 * n + (i & 3); }
struct Unit { int pm, pn; };
struct Gemm { const bf16_t* A; const bf16_t* Bt; int M, N, K; };
struct StaticOrder {
    int nM, nN, nwg, G, c;
    __host__ __device__ __forceinline__ void init(int M, int N, int G_, int c_) { nM = M / BM; nN = N / BM; nwg = nM * nN; G = G_; c = c_; }
    __host__ __device__ __forceinline__ bool next(int i, Unit& u) const {
        const long L = (long)i * G + c; if (L >= nwg) return false;
        int wgid = (int)L; { const int q = nwg / NXCD, r = nwg % NXCD, xcd = wgid % NXCD, off = wgid / NXCD; wgid = (xcd < r ? xcd * (q + 1) : r * (q + 1) + (xcd - r) * q) + off; }
        const int nig = WGM * nN, gid = wgid / nig, fm = gid * WGM, gsz = (nM - fm) < WGM ? (nM - fm) : WGM;
        u.pm = fm + ((wgid % nig) % gsz); u.pn = (wgid % nig) / gsz; return true;
    }
    __device__ __forceinline__ void a_ready(const Unit&) const {}
    __device__ __forceinline__ void done(const Unit&) const {}
};
template <class Epi, class Sched>
__device__ __forceinline__ void gemm_phase(LAS unsigned char* lds, const Gemm g, const Sched& S, const Epi& E) {
    int tid_ = threadIdx.x; asm volatile("" : "+v"(tid_));
    const int tid = tid_, wid = __builtin_amdgcn_readfirstlane(tid >> 6), lane = tid & 63, wr = wid >> 2, wc = wid & 3, fr = lane & 15, fq = lane >> 4;
    const int K = g.K, nt = K / BK;
    unsigned voffA[2], voffB[2];
#pragma unroll
    for (int i = 0; i < 2; ++i) { int R, C; stage_rc(tid * 16 + i * 8192, R, C); const int Rb = Epi::PERM ? ((R & ~31) + perm32(R & 31)) : R;
        voffA[i] = (unsigned)(R * K + C) * 2u; voffB[i] = (unsigned)(Rb * K + C) * 2u; }
    const size_t kstep = (size_t)(BK * 2);
    const size_t hstep = (size_t)HALF * K * 2;
    const size_t tstep = 2 * hstep;
    const unsigned ldsw = (unsigned)wid * 1024u;
    const int aoff = lds_byte(wr * 64 + fr, fq * 8), boff = lds_byte(wc * 32 + fr, fq * 8);
#define PG8_SA(b, h) (((b) * 2 + (h)) * HTB)
#define PG8_SB(b, h) ((4 + (b) * 2 + (h)) * HTB)
#define PG8_STAGE(bufoff, gbase, voff) do { _Pragma("unroll") for (int _i = 0; _i < 2; ++_i) \
        __builtin_amdgcn_global_load_lds((const unsigned*)((const char*)(gbase) + (voff)[_i]), (LAS unsigned*)(lds + (bufoff) + ldsw + _i * 8192), 16, 0, 0); } while (0)
#define PG8_LDA(dst, b, h) do { _Pragma("unroll") for (int m = 0; m < 4; ++m) _Pragma("unroll") for (int k = 0; k < 2; ++k) dst[m][k] = *(const LAS bf16x8*)(lds + PG8_SA(b, h) + aoff + m * 2048 + k * 1024); } while (0)
#define PG8_LDB(dst, b, h) do { _Pragma("unroll") for (int n = 0; n < 2; ++n) _Pragma("unroll") for (int k = 0; k < 2; ++k) dst[n][k] = *(const LAS bf16x8*)(lds + PG8_SB(b, h) + boff + n * 2048 + k * 1024); } while (0)
#define PG8_MMA(ai, bj, At, Bt) do { __builtin_amdgcn_s_setprio(1); _Pragma("unroll") for (int m = 0; m < 4; ++m) _Pragma("unroll") for (int n = 0; n < 2; ++n) _Pragma("unroll") for (int k = 0; k < 2; ++k) \
        acc[ai][bj][m][n] = __builtin_amdgcn_mfma_f32_16x16x32_bf16(Bt[n][k], At[m][k], acc[ai][bj][m][n], 0, 0, 0); __builtin_amdgcn_s_setprio(0); } while (0)
#define PG8_WAIT_V(n) asm volatile("s_waitcnt vmcnt(" #n ")" ::: "memory")
#define PG8_WAIT_L(n) asm volatile("s_waitcnt lgkmcnt(" #n ")" ::: "memory")
#define PG8_BAR __builtin_amdgcn_s_barrier()
#define PG8_SCHED __builtin_amdgcn_sched_barrier(0)
    Unit cur, nxt; int ui = 0;
    if (!S.next(0, cur)) return;
    f32x4 acc[2][2][4][2];
#pragma unroll
    for (int a = 0; a < 2; ++a)
#pragma unroll
        for (int b = 0; b < 2; ++b)
#pragma unroll
            for (int m = 0; m < 4; ++m)
#pragma unroll
                for (int n = 0; n < 2; ++n) acc[a][b][m][n] = (f32x4){0.f, 0.f, 0.f, 0.f};
    bf16x8 At[4][2], B0[2][2], B1[2][2];
    const char* cA = (const char*)g.A + (size_t)cur.pm * tstep; const char* cB = (const char*)g.Bt + (size_t)cur.pn * tstep;
    S.a_ready(cur);
    PG8_STAGE(PG8_SB(0, 0), cB, voffB); PG8_STAGE(PG8_SA(0, 0), cA, voffA); PG8_STAGE(PG8_SB(0, 1), cB + hstep, voffB); PG8_STAGE(PG8_SA(0, 1), cA + hstep, voffA);
    if (wr == 1) PG8_BAR;
    PG8_WAIT_V(4); PG8_BAR;
    PG8_STAGE(PG8_SB(1, 0), cB + kstep, voffB); PG8_STAGE(PG8_SA(1, 0), cA + kstep, voffA); PG8_STAGE(PG8_SB(1, 1), cB + hstep + kstep, voffB);
    PG8_WAIT_V(6); PG8_BAR;
    for (;;) {
        const bool has_next = S.next(ui + 1, nxt);
        const char* nA = has_next ? (const char*)g.A + (size_t)nxt.pm * tstep : cA; const char* nB = has_next ? (const char*)g.Bt + (size_t)nxt.pn * tstep : cB;
        for (int t = 0; t < nt; t += 2) {
            const bool last = (t == nt - 2);
            const char* a1 = cA + (size_t)(t + 1) * kstep;
            const char* a2 = last ? nA : cA + (size_t)(t + 2) * kstep; const char* b2 = last ? nB : cB + (size_t)(t + 2) * kstep;
            const char* a3 = a2 + kstep; const char* b3 = b2 + kstep;
            if (last && has_next) S.a_ready(nxt);
            PG8_LDB(B0, 0, 0); PG8_SCHED; PG8_LDA(At, 0, 0); PG8_STAGE(PG8_SA(1, 1), a1 + hstep, voffA);
            PG8_WAIT_L(8); PG8_BAR; PG8_WAIT_L(0); PG8_MMA(0, 0, At, B0); PG8_BAR; PG8_SCHED;
            PG8_LDB(B1, 0, 1); PG8_STAGE(PG8_SB(0, 0), b2, voffB);
            PG8_BAR; PG8_WAIT_L(0); PG8_MMA(0, 1, At, B1); PG8_BAR;
            PG8_LDA(At, 0, 1); PG8_STAGE(PG8_SA(0, 0), a2, voffA);
            PG8_BAR; PG8_WAIT_L(0); PG8_MMA(1, 0, At, B0); PG8_BAR; PG8_SCHED;
            PG8_STAGE(PG8_SB(0, 1), b2 + hstep, voffB);
            PG8_WAIT_V(6); PG8_BAR; PG8_MMA(1, 1, At, B1); PG8_BAR;
            PG8_LDB(B0, 1, 0); PG8_SCHED; PG8_LDA(At, 1, 0); PG8_STAGE(PG8_SA(0, 1), a2 + hstep, voffA);
            PG8_WAIT_L(8); PG8_BAR; PG8_WAIT_L(0); PG8_MMA(0, 0, At, B0); PG8_BAR; PG8_SCHED;
            PG8_LDB(B1, 1, 1); PG8_STAGE(PG8_SB(1, 0), b3, voffB);
            PG8_BAR; PG8_WAIT_L(0); PG8_MMA(0, 1, At, B1); PG8_BAR;
            PG8_LDA(At, 1, 1); PG8_STAGE(PG8_SA(1, 0), a3, voffA);
            PG8_BAR; PG8_WAIT_L(0); PG8_MMA(1, 0, At, B0); PG8_BAR; PG8_SCHED;
            PG8_STAGE(PG8_SB(1, 1), b3 + hstep, voffB);
            PG8_WAIT_V(6); PG8_BAR; PG8_MMA(1, 1, At, B1); PG8_BAR;
        }
        E(acc, cur, wr, wc, fr, fq); S.done(cur);
        if (!has_next) break;
#pragma unroll
        for (int a = 0; a < 2; ++a)
#pragma unroll
            for (int b = 0; b < 2; ++b)
#pragma unroll
                for (int m = 0; m < 4; ++m)
#pragma unroll
                    for (int n = 0; n < 2; ++n) acc[a][b][m][n] = (f32x4){0.f, 0.f, 0.f, 0.f};
        cur = nxt; cA = nA; cB = nB; ++ui;
    }
    PG8_WAIT_V(0);
    if (wr == 0) PG8_BAR;
    PG8_BAR;
#undef PG8_SA
#undef PG8_SB
#undef PG8_STAGE
#undef PG8_LDA
#undef PG8_LDB
#undef PG8_MMA
#undef PG8_WAIT_V
#undef PG8_WAIT_L
#undef PG8_BAR
#undef PG8_SCHED
}

template <int ACT  > struct EpiBf16 {
    static constexpr bool PERM = true;
    bf16_t* O; int ldc;
    __device__ __forceinline__ void operator()(const f32x4 (&acc)[2][2][4][2], const Unit& u, int wr, int wc, int fr, int fq) const {
        const int row0 = u.pm * BM + wr * 64 + fr, col0 = u.pn * BM + wc * 32 + 8 * fq;
#pragma unroll
        for (int ai = 0; ai < 2; ++ai)
#pragma unroll
            for (int m = 0; m < 4; ++m) { bf16_t* rowp = O + (size_t)(row0 + ai * HALF + m * 16) * ldc + col0;
#pragma unroll
                for (int bj = 0; bj < 2; ++bj) { f32x4 v0 = acc[ai][bj][m][0], v1 = acc[ai][bj][m][1];
                    if (ACT == 1) { for (int i = 0; i < 4; ++i) { v0[i] = siluf_(v0[i]); v1[i] = siluf_(v1[i]); } }
                    uint4 o; o.x = pack2(v0[0], v0[1]); o.y = pack2(v0[2], v0[3]); o.z = pack2(v1[0], v1[1]); o.w = pack2(v1[2], v1[3]);
                    *(uint4*)(rowp + bj * HALF) = o; } }
    }
};
struct EpiF32 {
    static constexpr bool PERM = false;
    float* C; int ldc;
    __device__ __forceinline__ void operator()(const f32x4 (&acc)[2][2][4][2], const Unit& u, int wr, int wc, int fr, int fq) const {
        const int row0 = u.pm * BM + wr * 64 + fr, col0 = u.pn * BM + wc * 32 + 4 * fq;
#pragma unroll
        for (int ai = 0; ai < 2; ++ai)
#pragma unroll
            for (int m = 0; m < 4; ++m) { float* rowp = C + (size_t)(row0 + ai * HALF + m * 16) * ldc + col0;
#pragma unroll
                for (int bj = 0; bj < 2; ++bj)
#pragma unroll
                    for (int n = 0; n < 2; ++n) *(f32x4*)(rowp + bj * HALF + n * 16) = acc[ai][bj][m][n]; }
    }
};
template <int IN_BF16> struct EpiResid {
    static constexpr bool PERM = true;
    const float* Xi; const bf16_t* Xib; bf16_t* Ob;
    __device__ __forceinline__ void operator()(const f32x4 (&acc)[2][2][4][2], const Unit& u, int wr, int wc, int fr, int fq) const {
        const int row0 = u.pm * BM + wr * 64 + fr, col0 = u.pn * BM + wc * 32 + 8 * fq;
#pragma unroll
        for (int ai = 0; ai < 2; ++ai)
#pragma unroll
            for (int m = 0; m < 4; ++m) { const size_t ro = (size_t)(row0 + ai * HALF + m * 16) * 1024 + col0;
#pragma unroll
                for (int bj = 0; bj < 2; ++bj) { const size_t o = ro + bj * HALF;
                    f32x4 x0, x1;
                    if (IN_BF16) { const uint4 xv = *(const uint4*)(Xib + o); float xf[8]; unpack8(xv, xf); x0 = (f32x4){xf[0], xf[1], xf[2], xf[3]}; x1 = (f32x4){xf[4], xf[5], xf[6], xf[7]}; }
                    else { x0 = *(const f32x4*)(Xi + o); x1 = *(const f32x4*)(Xi + o + 4); }
                    const f32x4 v0 = x0 + acc[ai][bj][m][0], v1 = x1 + acc[ai][bj][m][1];
                    uint4 pk; pk.x = pack2(v0[0], v0[1]); pk.y = pack2(v0[2], v0[3]); pk.z = pack2(v1[0], v1[1]); pk.w = pack2(v1[2], v1[3]); *(uint4*)(Ob + o) = pk; } }
    }
};
template <int OUT_BF16> struct EpiGate {
    static constexpr bool PERM = true;
    float* X; bf16_t* Xb; const bf16_t* R; const bf16_t* E;
    __device__ __forceinline__ void operator()(const f32x4 (&acc)[2][2][4][2], const Unit& u, int wr, int wc, int fr, int fq) const {
        const int row0 = u.pm * BM + wr * 64 + fr, col0 = u.pn * BM + wc * 32 + 8 * fq;
#pragma unroll
        for (int ai = 0; ai < 2; ++ai)
#pragma unroll
            for (int m = 0; m < 4; ++m) { const size_t ro = (size_t)(row0 + ai * HALF + m * 16) * 1024 + col0;
#pragma unroll
                for (int bj = 0; bj < 2; ++bj) { const size_t o = ro + bj * HALF;
                    const uint4 ev = *(const uint4*)(E + o), rv = *(const uint4*)(R + o); float ef[8], rf[8]; unpack8(ev, ef); unpack8(rv, rf);
                    float v[8];
#pragma unroll
                    for (int n = 0; n < 2; ++n)
#pragma unroll
                        for (int i = 0; i < 4; ++i) v[4 * n + i] = rf[4 * n + i] + ef[4 * n + i] * sigmoidf_(acc[ai][bj][m][n][i]);
                    if (OUT_BF16) { uint4 pk; pk.x = pack2(v[0], v[1]); pk.y = pack2(v[2], v[3]); pk.z = pack2(v[4], v[5]); pk.w = pack2(v[6], v[7]); *(uint4*)(Xb + o) = pk; }
                    else { *(f32x4*)(X + o) = (f32x4){v[0], v[1], v[2], v[3]}; *(f32x4*)(X + o + 4) = (f32x4){v[4], v[5], v[6], v[7]}; } } }
    }
};
struct EpiGateNorm {
    static constexpr bool PERM = true;
    float* X; const bf16_t* R; const bf16_t* E; const float* wn; float* SS; unsigned* cnt; unsigned* tmo;
    __device__ __forceinline__ void operator()(f32x4 (&acc)[2][2][4][2], const Unit& u, int wr, int wc, int fr, int fq) const {
        const int row0 = u.pm * BM + wr * 64 + fr, col0 = u.pn * BM + wc * 32 + 8 * fq;
#pragma unroll
        for (int ai = 0; ai < 2; ++ai)
#pragma unroll
            for (int m = 0; m < 4; ++m) { const int row = row0 + ai * HALF + m * 16; const size_t ro = (size_t)row * 1024 + col0; float ss = 0.f;
#pragma unroll
                for (int bj = 0; bj < 2; ++bj) { const size_t o = ro + bj * HALF;
                    const uint4 ev = *(const uint4*)(E + o), rv = *(const uint4*)(R + o); float ef[8], rf[8]; unpack8(ev, ef); unpack8(rv, rf);
#pragma unroll
                    for (int n = 0; n < 2; ++n)
#pragma unroll
                        for (int i = 0; i < 4; ++i) { const float v = rf[4 * n + i] + ef[4 * n + i] * sigmoidf_(acc[ai][bj][m][n][i]); acc[ai][bj][m][n][i] = v; ss += v * v; } }
                ss += __shfl_xor(ss, 16); ss += __shfl_xor(ss, 32);
                if (fq == 0) (void)__hip_atomic_fetch_add(SS + row, ss, __ATOMIC_RELAXED, __HIP_MEMORY_SCOPE_AGENT); }
        asm volatile("s_waitcnt vmcnt(0)" ::: "memory");
        if ((fr | fq) == 0) (void)__hip_atomic_fetch_add(cnt + 2 * u.pm + wr, 1u, __ATOMIC_RELAXED, __HIP_MEMORY_SCOPE_AGENT);
        f32x4 w[2][2];
#pragma unroll
        for (int bj = 0; bj < 2; ++bj) { w[bj][0] = *(const f32x4*)(wn + col0 + bj * HALF); w[bj][1] = *(const f32x4*)(wn + col0 + bj * HALF + 4); }
        { unsigned sp = 0;
          while (__hip_atomic_load(cnt + 2 * u.pm + wr, __ATOMIC_RELAXED, __HIP_MEMORY_SCOPE_AGENT) < 16u) { __builtin_amdgcn_s_sleep(1);
              if (++sp > (1u << 22)) { if ((fr | fq) == 0) atomicAdd(tmo, 1u); break; } } }
        asm volatile("" ::: "memory");
#pragma unroll
        for (int ai = 0; ai < 2; ++ai)
#pragma unroll
            for (int m = 0; m < 4; ++m) { const int row = row0 + ai * HALF + m * 16; const size_t ro = (size_t)row * 1024 + col0;
                const float rs = rsqrtf(__hip_atomic_load(SS + row, __ATOMIC_RELAXED, __HIP_MEMORY_SCOPE_AGENT) * (1.0f / 1024.0f) + 1e-6f);
#pragma unroll
                for (int bj = 0; bj < 2; ++bj) { const size_t o = ro + bj * HALF;
                    *(f32x4*)(X + o) = acc[ai][bj][m][0] * rs * w[bj][0]; *(f32x4*)(X + o + 4) = acc[ai][bj][m][1] * rs * w[bj][1]; } }
    }
};
}

struct Args { const float* in[28]; float* out; unsigned char* ws; int ph_lo, ph_hi; };

struct Frame {
    int tid, lane, wave, G, bid, gw, nw;
    unsigned char* lds;
    unsigned* ctl;
    const float* in[28]; float* out; unsigned char* ws;
    const LAS unsigned char* lut;
    const LAS float* tbl;
    const LAS float* biasL;
    LAS unsigned char* ldsl;
};
DI int t5b(const Frame& F, int n) { return n < 16 ? n : (n >= 113 ? 31 : (int)F.lut[n]); }

DI bool phase_refresh(Frame& F) { int t_ = threadIdx.x; asm volatile("" : "+v"(t_)); F.tid = t_; F.lane = t_ & 63; return true; }
struct TDesc { const float* src; bf16_t* dst; int K, Nsrc, Npad, mapk, ntiles; };
DI int tmap(int kind, int n) { return kind == 0 ? n : (kind == 1 ? map0(n) : (kind == 2 ? map1(n) : mapv(n))); }
DI void transpose_all(const Frame& F) {
    unsigned char* ws = F.ws;
    float* tile = (float*)F.lds;
    TDesc D[11];
    D[0] = TDesc{F.in[7], (bf16_t*)(ws + WS_WIN0), 1024, 3292, LD0, 1, 0};
    D[1] = TDesc{F.in[7], (bf16_t*)(ws + WS_WVT), 1024, 3292, 512, 3, 0};
    D[2] = TDesc{F.in[8], (bf16_t*)(ws + WS_WOUT0), 1024, 1024, 1024, 0, 0};
    D[3] = TDesc{F.in[5], (bf16_t*)(ws + WS_WG0), 1024, 1024, 1024, 0, 0};
    D[4] = TDesc{F.in[5] + (size_t)1024 * 1024, (bf16_t*)(ws + WS_WG1), 1024, 1024, 1024, 0, 0};
    D[5] = TDesc{F.in[4], (bf16_t*)(ws + WS_WP0), 256, 1024, 1024, 0, 0};
    D[6] = TDesc{F.in[4] + (size_t)256 * 1024, (bf16_t*)(ws + WS_WP1), 256, 1024, 1024, 0, 0};
    D[7] = TDesc{F.in[15], (bf16_t*)(ws + WS_WIN1), 1024, 3592, LD1, 2, 0};
    D[8] = TDesc{F.in[16], (bf16_t*)(ws + WS_WOUT1), 1024, 1024, 1024, 0, 0};
    D[9] = TDesc{F.in[10], (bf16_t*)(ws + WS_WC1K), 2048, 256, 256, 0, 0};
    D[10] = TDesc{F.in[13], (bf16_t*)(ws + WS_WC1V), 2048, 256, 256, 0, 0};
    int total = 0;
#pragma unroll
    for (int i = 0; i < 11; ++i) { D[i].ntiles = (D[i].Npad / 64) * (D[i].K / 64); total += D[i].ntiles; }
    float rg[8];
    auto locate = [&](int tix, TDesc& d, int& nt, int& kt) { int rem = tix;
#pragma unroll
        for (int i = 0; i < 11; ++i) { if (rem >= 0 && rem < D[i].ntiles) { d = D[i]; const int ntk = d.K / 64; nt = rem / ntk; kt = rem % ntk; rem = -1; } else if (rem >= 0) rem -= D[i].ntiles; } };
    auto load = [&](int tix) { TDesc d; int nt = 0, kt = 0; locate(tix, d, nt, kt);
#pragma unroll
        for (int q = 0; q < 8; ++q) { const int e = F.tid + q * 512; const int kk = e >> 6, nn = e & 63; const int col = tmap(d.mapk, nt * 64 + nn);
            rg[q] = col >= 0 ? d.src[(size_t)(kt * 64 + kk) * d.Nsrc + col] : 0.f; } };
    int tix = F.bid; int buf = 0;
    if (tix < total) load(tix);
    for (; tix < total; tix += F.G) {
        float* tl = tile + buf * (64 * 65);
#pragma unroll
        for (int q = 0; q < 8; ++q) { const int e = F.tid + q * 512; tl[(e >> 6) * 65 + (e & 63)] = rg[q]; }
        __syncthreads();
        TDesc d; int nt = 0, kt = 0; locate(tix, d, nt, kt);
        if (tix + F.G < total) load(tix + F.G);
#pragma unroll
        for (int q = 0; q < 8; ++q) { const int e = F.tid + q * 512; const int nn = e >> 6, kk = e & 63;
            d.dst[(size_t)(nt * 64 + nn) * d.K + kt * 64 + kk] = f2bf(tl[kk * 65 + nn]); }
        buf ^= 1;
    }
    __syncthreads();
}
template <int OUTF>
DI void rmsnorm_rows(const Frame& F, const float* X, const float* g, bf16_t* Ob, float* Of) {
    f32x4 gg[4];
#pragma unroll
    for (int i = 0; i < 4; ++i) gg[i] = *(const f32x4*)(g + i * 256 + F.lane * 4);
    for (int row0 = F.gw * 4; row0 < MT; row0 += F.nw * 4) {
        f32x4 v[4][4]; float ss[4];
#pragma unroll
        for (int r = 0; r < 4; ++r)
#pragma unroll
            for (int i = 0; i < 4; ++i) v[r][i] = *(const f32x4*)(X + (size_t)(row0 + r) * 1024 + i * 256 + F.lane * 4);
#pragma unroll
        for (int r = 0; r < 4; ++r) { float a = 0.f;
#pragma unroll
            for (int i = 0; i < 4; ++i) a += v[r][i][0] * v[r][i][0] + v[r][i][1] * v[r][i][1] + v[r][i][2] * v[r][i][2] + v[r][i][3] * v[r][i][3];
            ss[r] = a; }
#pragma unroll
        for (int o = 32; o >= 1; o >>= 1) {
#pragma unroll
            for (int r = 0; r < 4; ++r) ss[r] += __shfl_xor(ss[r], o); }
#pragma unroll
        for (int r = 0; r < 4; ++r) { const float rs = rsqrtf(ss[r] * (1.0f / 1024.0f) + 1e-6f);
#pragma unroll
            for (int i = 0; i < 4; ++i) { f32x4 y;
#pragma unroll
                for (int j = 0; j < 4; ++j) y[j] = v[r][i][j] * rs * gg[i][j];
                if (OUTF) *(f32x4*)(Of + (size_t)(row0 + r) * 1024 + i * 256 + F.lane * 4) = y;
                else { uint2 pk; pk.x = pack2(y[0], y[1]); pk.y = pack2(y[2], y[3]); *(uint2*)(Ob + (size_t)(row0 + r) * 1024 + i * 256 + F.lane * 4) = pk; } } }
    }
}
DI void rmsnorm_gates(const Frame& F, const bf16_t* X, const float* g, bf16_t* Ob) {
    const float* W = F.in[15]; float* gts = (float*)(F.ws + WS_GATES);
    float wg[2][8][8]; float gg[2][8];
#pragma unroll
    for (int i = 0; i < 2; ++i)
#pragma unroll
        for (int e = 0; e < 8; ++e) { const int k = i * 512 + F.lane * 8 + e; const f32x4 a = *(const f32x4*)(W + (size_t)k * 3592 + 2560), b = *(const f32x4*)(W + (size_t)k * 3592 + 2564);
            wg[i][e][0] = a[0]; wg[i][e][1] = a[1]; wg[i][e][2] = a[2]; wg[i][e][3] = a[3]; wg[i][e][4] = b[0]; wg[i][e][5] = b[1]; wg[i][e][6] = b[2]; wg[i][e][7] = b[3]; gg[i][e] = g[k]; }
    for (int row0 = F.gw * 2; row0 < MT; row0 += F.nw * 2) {
        uint4 xv[2][2]; float ss[2];
#pragma unroll
        for (int r = 0; r < 2; ++r)
#pragma unroll
            for (int i = 0; i < 2; ++i) xv[r][i] = *(const uint4*)(X + (size_t)(row0 + r) * 1024 + i * 512 + F.lane * 8);
        float xf[2][2][8];
#pragma unroll
        for (int r = 0; r < 2; ++r) { float a = 0.f;
#pragma unroll
            for (int i = 0; i < 2; ++i) { unpack8(xv[r][i], xf[r][i]);
#pragma unroll
                for (int e = 0; e < 8; ++e) a += xf[r][i][e] * xf[r][i][e]; }
            ss[r] = a; }
#pragma unroll
        for (int o = 32; o >= 1; o >>= 1) { ss[0] += __shfl_xor(ss[0], o); ss[1] += __shfl_xor(ss[1], o); }
#pragma unroll
        for (int r = 0; r < 2; ++r) { const int row = row0 + r;
            const float rs = rsqrtf(ss[r] * (1.0f / 1024.0f) + 1e-6f);
            float pg[8] = {0.f, 0.f, 0.f, 0.f, 0.f, 0.f, 0.f, 0.f};
#pragma unroll
            for (int i = 0; i < 2; ++i) { float y[8];
#pragma unroll
                for (int e = 0; e < 8; ++e) { y[e] = xf[r][i][e] * rs * gg[i][e];
#pragma unroll
                    for (int j = 0; j < 8; ++j) pg[j] += y[e] * wg[i][e][j]; }
                uint4 pk; pk.x = pack2(y[0], y[1]); pk.y = pack2(y[2], y[3]); pk.z = pack2(y[4], y[5]); pk.w = pack2(y[6], y[7]); *(uint4*)(Ob + (size_t)row * 1024 + i * 512 + F.lane * 8) = pk; }
#pragma unroll
            for (int o = 32; o >= 1; o >>= 1) {
#pragma unroll
                for (int j = 0; j < 8; ++j) pg[j] += __shfl_xor(pg[j], o); }
            float mine = 0.f;
#pragma unroll
            for (int j = 0; j < 8; ++j) if (F.lane == j) mine = pg[j];
            if (F.lane < 8) gts[(size_t)row * 8 + F.lane] = mine; }
    }
}
DI void p0_prologue(const Frame& F) {
    unsigned char* ws = F.ws;
    transpose_all(F);
    { bf16_t* wat = (bf16_t*)(ws + WS_WAT); bf16_t* wxt = (bf16_t*)(ws + WS_WXT);
      for (int idx = F.bid * 512 + F.tid; idx < 8 * 64 * 64; idx += F.G * 512) { const int g = idx >> 12, j = (idx >> 6) & 63, i = idx & 63;
          wat[idx] = f2bf(F.in[19][(size_t)(g * 64 + i) * 64 + j]); wxt[idx] = f2bf(F.in[21][(size_t)(g * 64 + i) * 64 + j]); } }
    { float* ssz = (float*)(ws + WS_SS); for (int i = F.bid * 512 + F.tid; i < MT; i += F.G * 512) ssz[i] = 0.f; }
    rmsnorm_rows<0>(F, F.in[0], F.in[2], (bf16_t*)(ws + WS_BFA), nullptr);
    { const float* p = F.in[1]; bf16_t* pb = (bf16_t*)(ws + WS_PBF); const size_t n8 = (size_t)2 * MT * 256 / 8;
      for (size_t i = (size_t)F.bid * 512 + F.tid; i < n8; i += (size_t)F.G * 512) {
          const f32x4 a = *(const f32x4*)(p + i * 8), b = *(const f32x4*)(p + i * 8 + 4);
          uint4 o; o.x = pack2(a[0], a[1]); o.y = pack2(a[2], a[3]); o.z = pack2(b[0], b[1]); o.w = pack2(b[2], b[3]); *(uint4*)(pb + i * 8) = o; } }
}

DI void p2a_build_blocks(const Frame& F) {
    { const int gt = F.bid * 512 + F.tid;
      if (gt < 1024) { const int bg = gt >> 6, d = gt & 63; ((float*)(F.ws + WS_KCMP))[((size_t)bg * 256 + 255) * 64 + d] = 0.f; ((float*)(F.ws + WS_VCMP))[((size_t)bg * 256 + 255) * 64 + d] = 0.f;
          ((bf16_t*)(F.ws + WS_VCT))[((size_t)bg * 64 + d) * 256 + 255] = 0; } }
    const bf16_t* U = (const bf16_t*)(F.ws + WS_U);
    bf16_t* AK = (bf16_t*)(F.ws + WS_AK); bf16_t* AV = (bf16_t*)(F.ws + WS_AV);
    const float* posk = F.in[9]; const float* posv = F.in[12];
    const size_t nitem = (size_t)2 * 4096 * 32 * 8;
    for (size_t it = (size_t)F.bid * 512 + F.tid; it < nitem; it += (size_t)F.G * 512) {
        const int c8 = (int)(it & 7), l = (int)((it >> 3) & 31), r = (int)((it >> 8) & 4095), which = (int)(it >> 20);
        bf16_t* dst = (which ? AV : AK) + (size_t)r * 2048 + l * 64 + c8 * 8;
        uint4 o = make_uint4(0u, 0u, 0u, 0u);
        if (r < 4080) {
            const int b = r / 510, rem = r % 510, i = rem >> 1, g = rem & 1;
            const bf16_t* sp = U + ((size_t)b * SEQ + 16 * i + l) * LD0 + (which ? C_VC : C_KC) + g * 64 + c8 * 8;
            const float* pp = (which ? posv : posk) + l * 64 + c8 * 8;
            const uint4 v = *(const uint4*)sp; float f[8]; unpack8(v, f);
            o.x = pack2(f[0] + pp[0], f[1] + pp[1]); o.y = pack2(f[2] + pp[2], f[3] + pp[3]); o.z = pack2(f[4] + pp[4], f[5] + pp[5]); o.w = pack2(f[6] + pp[6], f[7] + pp[7]);
        }
        *(uint4*)dst = o;
    }
}
DI void p2c_compress_rows(const Frame& F, int which, int row0) {
    const bf16_t* H = (const bf16_t*)(F.ws + (which ? WS_HV : WS_HK));
    float* OUT = (float*)(F.ws + (which ? WS_VCMP : WS_KCMP));
    const float* w2 = which ? F.in[14] : F.in[11];
    for (int rr = F.wave; rr < 256; rr += 8) {
        const int r = row0 + rr; if (r >= 4080) break;
        const int b = r / 510, rem = r % 510, i = rem >> 1, g = rem & 1, bg = b * 2 + g;
        const bf16_t* hr = H + (size_t)r * 256; float acc = 0.f;
        for (int j = 0; j < 256; j += 8) { const uint4 hv = *(const uint4*)(hr + j); float hf[8]; unpack8(hv, hf);
#pragma unroll
            for (int q = 0; q < 8; ++q) acc += hf[q] * w2[(size_t)(j + q) * 64 + F.lane]; }
        OUT[((size_t)bg * 256 + i) * 64 + F.lane] = acc;
        if (which) ((bf16_t*)(F.ws + WS_VCT))[((size_t)bg * 64 + F.lane) * 256 + i] = f2bf(acc);
    }
}

typedef float f32x16 __attribute__((ext_vector_type(16)));
#define MFMA32(a, b, c) __builtin_amdgcn_mfma_f32_32x32x16_bf16((a), (b), (c), 0, 0, 0)
constexpr float LOG2E = 1.4426950408889634f;
constexpr float QK_C1 = 0.125f * LOG2E;
constexpr int AT_BUF = 0;
constexpr int AT_PSUM = 65536;
constexpr int AT_SELM = AT_PSUM + 65536;
constexpr int AT_MISC = AT_SELM + 1024;
constexpr int AT_END = AT_MISC + 64 + 2048;
static_assert(AT_END + LDS_WORK_OFF <= LDS_BYTES - 12288, "attention lds");
enum { FL_NEAR = 1, FL_CAUSAL = 2, FL_WINLO = 4, FL_BITS = 8, FL_LANE = 16 };

struct Att { float m, l; f32x16 o0, o1; };
DI void att_init(Att& a) { a.m = NEG_INF; a.l = 0.f;
#pragma unroll
    for (int i = 0; i < 16; ++i) { a.o0[i] = 0.f; a.o1[i] = 0.f; } }

typedef unsigned u32x4 __attribute__((ext_vector_type(4)));
#define OPAQUE(x) asm volatile("" : "+v"(x))
DI void st_write_K(LAS unsigned char* Kt, int tid, const uint4& rg) {
    OPAQUE(tid);
    const int key = tid >> 3, c = tid & 7;
    const u32x4 v = {rg.x, rg.y, rg.z, rg.w};
    *(LAS u32x4*)(Kt + (key ^ ((key >> 3) & 1)) * 128 + ((c ^ (key & 7)) << 4)) = v;
}
DI void st_write_VT(LAS unsigned char* Vt, int tid, const uint4& rg) {
    OPAQUE(tid);
    const int d = tid >> 3, m = tid & 7, G = m >> 1, a = m & 1, sw = (d >> 1) & 7;
    typedef unsigned u32x2 __attribute__((ext_vector_type(2)));
    const u32x2 lo = {rg.x, rg.y}, hi = {rg.z, rg.w};
    *(LAS u32x2*)(Vt + d * 128 + (((2 * G) ^ sw) << 4) + 8 * a) = lo;
    *(LAS u32x2*)(Vt + d * 128 + (((2 * G + 1) ^ sw) << 4) + 8 * a) = hi;
}
DI void qk_tile(const LAS unsigned char* Kt, const bf16x8 (&qf)[4], int r, int hf, f32x16& s0, f32x16& s1) {
    OPAQUE(r); OPAQUE(hf);
    const f32x16 zero16 = {0.f, 0.f, 0.f, 0.f, 0.f, 0.f, 0.f, 0.f, 0.f, 0.f, 0.f, 0.f, 0.f, 0.f, 0.f, 0.f};
#pragma unroll
    for (int s = 0; s < 4; ++s) {
        const int c = 2 * s + hf;
        const int pr = r ^ ((r >> 3) & 1);
        const bf16x8 a0 = *(const LAS bf16x8*)(Kt + pr * 128 + ((c ^ (r & 7)) << 4));
        const bf16x8 a1 = *(const LAS bf16x8*)(Kt + (32 + pr) * 128 + ((c ^ (r & 7)) << 4));
        if (s == 0) { s0 = MFMA32(a0, qf[0], zero16); s1 = MFMA32(a1, qf[0], zero16); }
        else { s0 = MFMA32(a0, qf[s], s0); s1 = MFMA32(a1, qf[s], s1); }
    }
}
template <int FLAGS>
DI void fix_scores(f32x16& s, int posb, int kstep, int tq, const LAS float* bl, float bfar, unsigned mword, bool laneok, int hf) {
    OPAQUE(hf); OPAQUE(tq);
#pragma unroll
    for (int i = 0; i < 16; ++i) {
        const int koff = (i & 3) + 8 * (i >> 2) + 4 * hf;
        const int dist = tq - (posb + kstep * koff);
        float bias = bfar;
        if (FLAGS & FL_NEAR) { int dd = dist < 0 ? 0 : dist; dd = dd > 127 ? 127 : dd; bias = bl[dd]; }
        const float v = s[i] * QK_C1 + bias;
        bool ok = true;
        if (FLAGS & FL_CAUSAL) ok = ok && (dist >= 0);
        if (FLAGS & FL_WINLO) ok = ok && (dist < 512);
        if (FLAGS & FL_BITS) ok = ok && (((mword >> koff) & 1u) != 0u);
        if (FLAGS & FL_LANE) ok = ok && laneok;
        s[i] = ok ? v : NEG_INF;
    }
}
DI bf16x8 pack8(const f32x16& x, int s) {
    typedef unsigned u32x4 __attribute__((ext_vector_type(4)));
    u32x4 p;
    p[0] = pack2(x[8 * s + 0], x[8 * s + 1]); p[1] = pack2(x[8 * s + 2], x[8 * s + 3]); p[2] = pack2(x[8 * s + 4], x[8 * s + 5]); p[3] = pack2(x[8 * s + 6], x[8 * s + 7]);
    return __builtin_bit_cast(bf16x8, p);
}
DI void pv_tile(const LAS unsigned char* Vt, const f32x16& p0, const f32x16& p1, int r, int hf, f32x16& o0, f32x16& o1) {
#pragma unroll
    for (int G = 0; G < 4; ++G) {
        const bf16x8 pb = pack8((G >> 1) ? p1 : p0, G & 1);
        const int cc = 2 * G + hf;
        const bf16x8 a0 = *(const LAS bf16x8*)(Vt + r * 128 + ((cc ^ ((r >> 1) & 7)) << 4));
        const bf16x8 a1 = *(const LAS bf16x8*)(Vt + (32 + r) * 128 + ((cc ^ ((r >> 1) & 7)) << 4));
        o0 = MFMA32(a0, pb, o0); o1 = MFMA32(a1, pb, o1);
    }
}
DI void online_pv(Att& st, f32x16& s0, f32x16& s1, const LAS unsigned char* Vt, int r, int hf) {
    float tm = NEG_INF;
#pragma unroll
    for (int i = 0; i < 16; ++i) tm = fmaxf(tm, fmaxf(s0[i], s1[i]));
    tm = fmaxf(tm, __shfl_xor(tm, 32));
    const float mn = fmaxf(st.m, tm);
    const float mu = (mn == NEG_INF) ? 0.f : mn;
    const float alpha = __builtin_amdgcn_exp2f(st.m - mu);
    float ls = 0.f;
#pragma unroll
    for (int i = 0; i < 16; ++i) { s0[i] = __builtin_amdgcn_exp2f(s0[i] - mu); s1[i] = __builtin_amdgcn_exp2f(s1[i] - mu); ls += s0[i] + s1[i]; }
    st.l = st.l * alpha + ls;
    if (__ballot(mn != st.m) != 0ull) {
#pragma unroll
        for (int i = 0; i < 16; ++i) { st.o0[i] *= alpha; st.o1[i] *= alpha; } }
    st.m = mn;
    pv_tile(Vt, s0, s1, r, hf, st.o0, st.o1);
}
DI unsigned bitmask32(unsigned w, int pos) { unsigned m; asm("v_bfe_i32 %0, %1, %2, 1" : "=v"(m) : "v"(w), "n"(pos)); return m; }
template <bool BITS, bool NEARB, bool CAUSAL = false>
DI void far_tile(Att& st, const LAS unsigned char* Kt, const LAS unsigned char* Vt, const bf16x8 (&qf)[4], int r, int hf, float bfar, bool laneok, unsigned m0, unsigned m1,
                 int tq, int posb, const LAS float* bl) {
    f32x16 s0, s1; qk_tile(Kt, qf, r, hf, s0, s1);
    const float cb = laneok ? bfar - st.m : NEG_INF;
    const float nm = laneok ? -st.m : NEG_INF;
    const int dbase = tq - posb - 4 * hf;
    const unsigned w0 = m0 >> (4 * hf), w1 = m1 >> (4 * hf);
    const f32x2 c1v = {QK_C1, QK_C1}; f32x2 cbv = {cb, cb}; f32x2 ls2 = {0.f, 0.f};
#pragma unroll
    for (int i = 0; i < 16; i += 2) { const f32x2 sv = {s0[i], s0[i + 1]};
        if (NEARB) { int d0 = dbase - ((i & 3) + 8 * (i >> 2)), d1 = dbase - (((i + 1) & 3) + 8 * ((i + 1) >> 2)); const bool k0 = d0 >= 0, k1 = d1 >= 0;
            d0 = d0 > 127 ? 127 : d0; d1 = d1 > 127 ? 127 : d1; if (CAUSAL) { d0 = d0 < 0 ? 0 : d0; d1 = d1 < 0 ? 0 : d1; }
            cbv[0] = bl[d0] + nm; cbv[1] = bl[d1] + nm; if (CAUSAL) { cbv[0] = k0 ? cbv[0] : NEG_INF; cbv[1] = k1 ? cbv[1] : NEG_INF; } }
        const f32x2 av = sv * c1v + cbv;
        f32x2 pv; pv[0] = __builtin_amdgcn_exp2f(av[0]); pv[1] = __builtin_amdgcn_exp2f(av[1]);
        if (BITS) { pv[0] = __uint_as_float(__float_as_uint(pv[0]) & bitmask32(w0, (i & 3) + 8 * (i >> 2)));
                    pv[1] = __uint_as_float(__float_as_uint(pv[1]) & bitmask32(w0, ((i + 1) & 3) + 8 * ((i + 1) >> 2))); }
        s0[i] = pv[0]; s0[i + 1] = pv[1]; ls2 += pv; }
    const int rr = r;
#pragma unroll
    for (int G = 0; G < 2; ++G) { const bf16x8 pb = pack8(s0, G); const int cc = 2 * G + hf;
        const bf16x8 a0 = *(const LAS bf16x8*)(Vt + rr * 128 + ((cc ^ ((rr >> 1) & 7)) << 4)); const bf16x8 a1 = *(const LAS bf16x8*)(Vt + (32 + rr) * 128 + ((cc ^ ((rr >> 1) & 7)) << 4));
        st.o0 = MFMA32(a0, pb, st.o0); st.o1 = MFMA32(a1, pb, st.o1); }
#pragma unroll
    for (int i = 0; i < 16; i += 2) { const f32x2 sv = {s1[i], s1[i + 1]};
        if (NEARB) { int d0 = dbase - 32 - ((i & 3) + 8 * (i >> 2)), d1 = dbase - 32 - (((i + 1) & 3) + 8 * ((i + 1) >> 2)); const bool k0 = d0 >= 0, k1 = d1 >= 0;
            d0 = d0 > 127 ? 127 : d0; d1 = d1 > 127 ? 127 : d1; if (CAUSAL) { d0 = d0 < 0 ? 0 : d0; d1 = d1 < 0 ? 0 : d1; }
            cbv[0] = bl[d0] + nm; cbv[1] = bl[d1] + nm; if (CAUSAL) { cbv[0] = k0 ? cbv[0] : NEG_INF; cbv[1] = k1 ? cbv[1] : NEG_INF; } }
        const f32x2 av = sv * c1v + cbv;
        f32x2 pv; pv[0] = __builtin_amdgcn_exp2f(av[0]); pv[1] = __builtin_amdgcn_exp2f(av[1]);
        if (BITS) { pv[0] = __uint_as_float(__float_as_uint(pv[0]) & bitmask32(w1, (i & 3) + 8 * (i >> 2)));
                    pv[1] = __uint_as_float(__float_as_uint(pv[1]) & bitmask32(w1, ((i + 1) & 3) + 8 * ((i + 1) >> 2))); }
        s1[i] = pv[0]; s1[i + 1] = pv[1]; ls2 += pv; }
#pragma unroll
    for (int G = 2; G < 4; ++G) { const bf16x8 pb = pack8(s1, G & 1); const int cc = 2 * G + hf;
        const bf16x8 a0 = *(const LAS bf16x8*)(Vt + rr * 128 + ((cc ^ ((rr >> 1) & 7)) << 4)); const bf16x8 a1 = *(const LAS bf16x8*)(Vt + (32 + rr) * 128 + ((cc ^ ((rr >> 1) & 7)) << 4));
        st.o0 = MFMA32(a0, pb, st.o0); st.o1 = MFMA32(a1, pb, st.o1); }
    st.l += ls2[0] + ls2[1];
}
#define LDS_BARRIER() do { asm volatile("s_waitcnt lgkmcnt(0)" ::: "memory"); __builtin_amdgcn_s_barrier(); asm volatile("" ::: "memory"); } while (0)
#ifndef STAG_N
#define STAG_N 0
#endif
template <class LD, class BODY>
DI void tile_stream(int n, LAS unsigned char* buf, int tid, bool useV, LD ld, BODY body) {
    if (n <= 0) return;
    const bool late = __builtin_amdgcn_readfirstlane(tid >> 8) != 0;
    uint4 rk0, rk1 = make_uint4(0u, 0u, 0u, 0u), rv0 = make_uint4(0u, 0u, 0u, 0u), rv1 = make_uint4(0u, 0u, 0u, 0u);
    ld(0, rk0, rv0); if (n > 1) ld(1, rk1, rv1);
    st_write_K(buf, tid, rk0); if (useV) st_write_VT(buf + 8192, tid, rv0);
    if (n > 1) { st_write_K(buf + 16384, tid, rk1); if (useV) st_write_VT(buf + 24576, tid, rv1); }
    if (n > 2) ld(2, rk0, rv0); if (n > 3) ld(3, rk1, rv1);
    LDS_BARRIER();
#pragma unroll 1
    for (int i = 0; i < n; i += 2) {
        LAS unsigned char* cur = buf + ((i >> 1) & 1) * 32768;
        if (i + 2 < n) { LAS unsigned char* nxt = buf + (((i >> 1) + 1) & 1) * 32768;
            st_write_K(nxt, tid, rk0); if (useV) st_write_VT(nxt + 8192, tid, rv0);
            if (i + 3 < n) { st_write_K(nxt + 16384, tid, rk1); if (useV) st_write_VT(nxt + 24576, tid, rv1); }
            if (i + 4 < n) ld(i + 4, rk0, rv0); if (i + 5 < n) ld(i + 5, rk1, rv1); }
        if (late) __builtin_amdgcn_s_sleep(STAG_N);
        body(i, cur, cur + 8192);
        if (i + 1 < n) body(i + 1, cur + 16384, cur + 24576);
        LDS_BARRIER();
    }
}
template <class LD, class BODY>
DI void tile_stream_k4(int n, LAS unsigned char* buf, int tid, LD ld, BODY body) {
    if (n <= 0) return;
    uint4 r0, r1 = make_uint4(0u, 0u, 0u, 0u), r2 = make_uint4(0u, 0u, 0u, 0u), r3 = make_uint4(0u, 0u, 0u, 0u), dv;
    ld(0, r0, dv); if (n > 1) ld(1, r1, dv); if (n > 2) ld(2, r2, dv); if (n > 3) ld(3, r3, dv);
    st_write_K(buf, tid, r0); if (n > 1) st_write_K(buf + 8192, tid, r1); if (n > 2) st_write_K(buf + 16384, tid, r2); if (n > 3) st_write_K(buf + 24576, tid, r3);
    if (n > 4) ld(4, r0, dv); if (n > 5) ld(5, r1, dv); if (n > 6) ld(6, r2, dv); if (n > 7) ld(7, r3, dv);
    LDS_BARRIER();
#pragma unroll 1
    for (int i = 0; i < n; i += 4) {
        LAS unsigned char* cur = buf + ((i >> 2) & 1) * 32768;
        if (i + 4 < n) { LAS unsigned char* nxt = buf + (((i >> 2) + 1) & 1) * 32768;
            st_write_K(nxt, tid, r0); if (i + 5 < n) st_write_K(nxt + 8192, tid, r1); if (i + 6 < n) st_write_K(nxt + 16384, tid, r2); if (i + 7 < n) st_write_K(nxt + 24576, tid, r3);
            if (i + 8 < n) ld(i + 8, r0, dv); if (i + 9 < n) ld(i + 9, r1, dv); if (i + 10 < n) ld(i + 10, r2, dv); if (i + 11 < n) ld(i + 11, r3, dv); }
#pragma unroll 1
        for (int j = 0; j < 4; ++j) if (i + j < n) body(i + j, cur + j * 8192, cur);
        LDS_BARRIER();
    }
}
DI uint4 cvt8_f32(const float* p) { const f32x4 a = *(const f32x4*)p, b = *(const f32x4*)(p + 4); uint4 o; o.x = pack2(a[0], a[1]); o.y = pack2(a[2], a[3]); o.z = pack2(b[0], b[1]); o.w = pack2(b[2], b[3]); return o; }

DI void nsa_unit(const Frame& F, int b, int g, int qb) {
    int tid_ = F.tid; OPAQUE(tid_);
    const int tid = tid_, lane = tid & 63, w = F.wave, r = lane & 31, hf = lane >> 5;
    LAS unsigned char* L = F.ldsl;
    LAS unsigned char* buf = L + AT_BUF;
    LAS float* psum = (LAS float*)(L + AT_PSUM);
    LAS unsigned long long* selm = (LAS unsigned long long*)(L + AT_SELM);
    LAS unsigned char* tlist = L + AT_SELM + 528;
    LAS int* tcnt = (LAS int*)(L + AT_SELM + 520);
    const bf16_t* U = (const bf16_t*)(F.ws + WS_U);
    const float* KC = (const float*)(F.ws + WS_KCMP) + (size_t)(b * 2 + g) * 256 * 64;
    const bf16_t* VCT = (const bf16_t*)(F.ws + WS_VCT) + (size_t)(b * 2 + g) * 64 * 256;
    const bf16_t* VT = (const bf16_t*)(F.ws + WS_VT);
    bf16_t* Y = (bf16_t*)(F.ws + WS_BFB);
    const int t0 = qb * 64;
    const int ql = r >> 2, h = r & 3, hh = g * 4 + h;
    const int tq = t0 + 8 * w + ql;
    const size_t row = (size_t)b * SEQ + tq;
    const bf16_t* Ur = U + row * LD0;
    bf16x8 qf[4];
#pragma unroll
    for (int s = 0; s < 4; ++s) qf[s] = *(const bf16x8*)(Ur + C_AQ + hh * 64 + 16 * s + 8 * hf);
    const LAS float* bl = F.biasL + hh * 128; const float bfar = bl[127];
    float gate[3];
    { const unsigned* gp = (const unsigned*)(Ur + C_AG);
#pragma unroll
      for (int j = 0; j < 3; ++j) { const int e = hh * 3 + j; const unsigned wv = gp[e >> 1]; gate[j] = sigmoidf_((e & 1) ? __uint_as_float(wv & 0xFFFF0000u) : __uint_as_float(wv << 16)); } }
    LAS float* opark = psum + w * 2048 + lane;

    const int nvmax = ((t0 + 63 - 31) >> 4) + 1;
    const int ntc = (nvmax + 63) >> 6;
    for (int e = tid; e < 64 * 256; e += 512) psum[e] = 0.f;
    float cm = NEG_INF, cl = 0.f;
    {
#pragma unroll 1
        for (int i = 0; i < ntc; ++i) { const int key = tid >> 3, c = tid & 7;
            const uint4 rk = cvt8_f32(KC + (size_t)(i * 64 + key) * 64 + c * 8); const uint4 rv = *(const uint4*)(VCT + (size_t)key * 256 + i * 64 + c * 8);
            st_write_K(buf + i * 8192, tid, rk); st_write_VT(buf + 32768 + i * 8192, tid, rv); }
        __syncthreads();
        auto body = [&](int i, LAS unsigned char* Kt, LAS unsigned char* Vt) { (void)Vt;
            f32x16 s0, s1; qk_tile(Kt, qf, r, hf, s0, s1);
            if (16 * (i * 64 + 63) + 31 + 113 <= t0 + 8 * w) { fix_scores<0>(s0, 0, 16, tq, bl, bfar, 0u, true, hf); fix_scores<0>(s1, 0, 16, tq, bl, bfar, 0u, true, hf); }
            else { fix_scores<FL_NEAR | FL_CAUSAL>(s0, 16 * (i * 64) + 31, 16, tq, bl, bfar, 0u, true, hf); fix_scores<FL_NEAR | FL_CAUSAL>(s1, 16 * (i * 64 + 32) + 31, 16, tq, bl, bfar, 0u, true, hf); }
            float tm = NEG_INF;
#pragma unroll
            for (int k = 0; k < 16; ++k) tm = fmaxf(tm, fmaxf(s0[k], s1[k]));
            tm = fmaxf(tm, __shfl_xor(tm, 32));
            const float mn = fmaxf(cm, tm); const float mu = (mn == NEG_INF) ? 0.f : mn;
            float ls = 0.f;
#pragma unroll
            for (int k = 0; k < 16; ++k) ls += __builtin_amdgcn_exp2f(s0[k] - mu) + __builtin_amdgcn_exp2f(s1[k] - mu);
            cl = cl * __builtin_amdgcn_exp2f(cm - mu) + ls; cm = mn; };
#pragma unroll 1
        for (int i = 0; i < ntc; ++i) body(i, buf + i * 8192, buf + 32768 + i * 8192);
    }
    f32x16 c0, c1;
    {
        cl += __shfl_xor(cl, 32);
        const float cinv = cl > 0.f ? 1.0f / cl : 0.f; const float cmu = (cm == NEG_INF) ? 0.f : cm;
#pragma unroll
        for (int i = 0; i < 16; ++i) { c0[i] = 0.f; c1[i] = 0.f; }
        auto body = [&](int i, LAS unsigned char* Kt, LAS unsigned char* Vt) {
            f32x16 s0, s1; qk_tile(Kt, qf, r, hf, s0, s1);
            if (16 * (i * 64 + 63) + 31 + 113 <= t0 + 8 * w) { fix_scores<0>(s0, 0, 16, tq, bl, bfar, 0u, true, hf); fix_scores<0>(s1, 0, 16, tq, bl, bfar, 0u, true, hf); }
            else { fix_scores<FL_NEAR | FL_CAUSAL>(s0, 16 * (i * 64) + 31, 16, tq, bl, bfar, 0u, true, hf); fix_scores<FL_NEAR | FL_CAUSAL>(s1, 16 * (i * 64 + 32) + 31, 16, tq, bl, bfar, 0u, true, hf); }
#pragma unroll
            for (int k = 0; k < 16; ++k) { s0[k] = __builtin_amdgcn_exp2f(s0[k] - cmu) * cinv; s1[k] = __builtin_amdgcn_exp2f(s1[k] - cmu) * cinv; }
#pragma unroll
            for (int k = 0; k < 16; ++k) {
                float a0 = s0[k], a1 = s1[k];
                a0 += __shfl_xor(a0, 1); a0 += __shfl_xor(a0, 2); a1 += __shfl_xor(a1, 1); a1 += __shfl_xor(a1, 2);
                const int koff = (k & 3) + 8 * (k >> 2) + 4 * hf;
                if (h == 0) { psum[(8 * w + ql) * 256 + i * 64 + koff] = a0; psum[(8 * w + ql) * 256 + i * 64 + 32 + koff] = a1; }
            }
            pv_tile(Vt, s0, s1, r, hf, c0, c1); };
#pragma unroll 1
        for (int i = 0; i < ntc; ++i) body(i, buf + i * 8192, buf + 32768 + i * 8192);
        __syncthreads();
    }
    {
        const int cur = qb; const int npick = (cur + 1) < 8 ? (cur + 1) : 8;
        LAS float* scw = (LAS float*)(L + AT_MISC + 64) + w * 64;
#pragma unroll 1
        for (int q = 0; q < 8; ++q) {
            const LAS float* pr = psum + (8 * w + q) * 256;
            float imp = 0.f;
            const int i0 = 4 * lane - 1 < 0 ? 0 : 4 * lane - 1, i1 = 4 * lane + 3 > 254 ? 254 : 4 * lane + 3;
            for (int i = i0; i <= i1; ++i) imp += pr[i];
            const bool adm = lane <= cur; const bool forced = (lane == 0) || (lane == cur) || (lane == cur - 1);
            const float score = adm ? imp + (forced ? 1.0e4f : 0.f) : NEG_INF;
            __builtin_amdgcn_wave_barrier();
            scw[lane] = score;
            __builtin_amdgcn_wave_barrier();
            int rank = 0;
#pragma unroll
            for (int j4 = 0; j4 < 16; ++j4) { const f32x4 o = *(const LAS f32x4*)(scw + 4 * j4);
#pragma unroll
                for (int e = 0; e < 4; ++e) { const int j = 4 * j4 + e; rank += (o[e] > score || (o[e] == score && j < lane)) ? 1 : 0; } }
            const unsigned long long sm = __ballot(adm && rank < npick);
            if (lane == 0) selm[8 * w + q] = sm;
        }
    }
    __syncthreads();
    if (w == 0) {
        unsigned long long m = selm[lane];
        unsigned lo = (unsigned)m, hi = (unsigned)(m >> 32);
        for (int o = 32; o >= 1; o >>= 1) { lo |= __shfl_xor(lo, o); hi |= __shfl_xor(hi, o); }
        const unsigned long long un = ((unsigned long long)hi << 32) | lo;
        const bool mine = (un >> lane) & 1ull;
        const int pos = __popcll(un & ((1ull << lane) - 1ull));
        if (mine) tlist[pos] = (unsigned char)lane;
        if (lane == 0) tcnt[0] = __popcll(un);
    }
    __syncthreads();
#pragma unroll
    for (int i = 0; i < 16; ++i) { opark[i * 64] = gate[0] * c0[i]; opark[(16 + i) * 64] = gate[0] * c1[i]; }
    const unsigned long long mysel = selm[8 * w + ql];
    {
        Att st; att_init(st);
        const int nts = tcnt[0];
        auto lds_ = [&](int i, uint4& rk, uint4& rv) { const int j = tlist[i]; const int key = tid >> 3, c = tid & 7;
            const bf16_t* p = U + ((size_t)b * SEQ + j * 64 + key) * LD0 + g * 64 + c * 8; rk = *(const uint4*)(p + C_KS); rv = *(const uint4*)(VT + (size_t)(g * 64 + key) * MT + (size_t)b * SEQ + j * 64 + c * 8); };
        auto body = [&](int i, LAS unsigned char* Kt, LAS unsigned char* Vt) {
            const int j = tlist[i];
            const bool laneok = (mysel >> j) & 1ull;
            if (__ballot(laneok) == 0ull) return;
            if (__ballot(st.m == NEG_INF) == 0ull) {
                if (j < qb - 2) far_tile<false, false>(st, Kt, Vt, qf, r, hf, bfar, laneok, 0u, 0u, tq, j * 64, bl); else if (j < qb) far_tile<false, true>(st, Kt, Vt, qf, r, hf, bfar, laneok, 0u, 0u, tq, j * 64, bl);
                else far_tile<false, true, true>(st, Kt, Vt, qf, r, hf, bfar, laneok, 0u, 0u, tq, j * 64, bl);
                return; }
            f32x16 s0, s1; qk_tile(Kt, qf, r, hf, s0, s1);
            if (j >= qb - 2) { fix_scores<FL_NEAR | FL_CAUSAL | FL_LANE>(s0, j * 64, 1, tq, bl, bfar, 0u, laneok, hf); fix_scores<FL_NEAR | FL_CAUSAL | FL_LANE>(s1, j * 64 + 32, 1, tq, bl, bfar, 0u, laneok, hf); }
            else { fix_scores<FL_LANE>(s0, j * 64, 1, tq, bl, bfar, 0u, laneok, hf); fix_scores<FL_LANE>(s1, j * 64 + 32, 1, tq, bl, bfar, 0u, laneok, hf); }
            online_pv(st, s0, s1, Vt, r, hf); };
        tile_stream(nts, buf, tid, true, lds_, body);
        float l = st.l + __shfl_xor(st.l, 32);
        const float sc = l > 0.f ? gate[1] / l : 0.f;
#pragma unroll
        for (int i = 0; i < 16; ++i) { opark[i * 64] += sc * st.o0[i]; opark[(16 + i) * 64] += sc * st.o1[i]; }
    }
    {
        Att st; att_init(st);
        const int j0 = qb - 8 < 0 ? 0 : qb - 8; const int ntw = qb - j0 + 1;
        auto ldw = [&](int i, uint4& rk, uint4& rv) { const int j = j0 + i; const int key = tid >> 3, c = tid & 7;
            const bf16_t* p = U + ((size_t)b * SEQ + j * 64 + key) * LD0 + g * 64 + c * 8; rk = *(const uint4*)(p + C_KW); rv = *(const uint4*)(VT + (size_t)(128 + g * 64 + key) * MT + (size_t)b * SEQ + j * 64 + c * 8); };
        auto body = [&](int i, LAS unsigned char* Kt, LAS unsigned char* Vt) {
            const int j = j0 + i;
            if (j != qb - 8 && __ballot(st.m == NEG_INF) == 0ull) {
                if (j < qb - 2) far_tile<false, false>(st, Kt, Vt, qf, r, hf, bfar, true, 0u, 0u, tq, j * 64, bl); else if (j < qb) far_tile<false, true>(st, Kt, Vt, qf, r, hf, bfar, true, 0u, 0u, tq, j * 64, bl);
                else far_tile<false, true, true>(st, Kt, Vt, qf, r, hf, bfar, true, 0u, 0u, tq, j * 64, bl);
                return; }
            f32x16 s0, s1; qk_tile(Kt, qf, r, hf, s0, s1);
            if (j >= qb - 2) { fix_scores<FL_NEAR | FL_CAUSAL>(s0, j * 64, 1, tq, bl, bfar, 0u, true, hf); fix_scores<FL_NEAR | FL_CAUSAL>(s1, j * 64 + 32, 1, tq, bl, bfar, 0u, true, hf); }
            else if (j == qb - 8) { fix_scores<FL_WINLO>(s0, j * 64, 1, tq, bl, bfar, 0u, true, hf); fix_scores<FL_WINLO>(s1, j * 64 + 32, 1, tq, bl, bfar, 0u, true, hf); }
            else { fix_scores<0>(s0, j * 64, 1, tq, bl, bfar, 0u, true, hf); fix_scores<0>(s1, j * 64 + 32, 1, tq, bl, bfar, 0u, true, hf); }
            online_pv(st, s0, s1, Vt, r, hf); };
        tile_stream(ntw, buf, tid, true, ldw, body);
        float l = st.l + __shfl_xor(st.l, 32);
        const float sc = l > 0.f ? gate[2] / l : 0.f;
#pragma unroll
        for (int i = 0; i < 16; ++i) { c0[i] = opark[i * 64] + sc * st.o0[i]; c1[i] = opark[(16 + i) * 64] + sc * st.o1[i]; }
    }
#pragma unroll
    for (int dh = 0; dh < 2; ++dh)
#pragma unroll
        for (int k = 0; k < 4; ++k) {
            const int d = 32 * dh + 8 * k + 4 * hf;
            const uint2 zz = *(const uint2*)(Ur + C_AZ + hh * 64 + d);
            const float z0 = __uint_as_float(zz.x << 16), z1 = __uint_as_float(zz.x & 0xFFFF0000u), z2 = __uint_as_float(zz.y << 16), z3 = __uint_as_float(zz.y & 0xFFFF0000u);
            const f32x16& o = dh ? c1 : c0;
            uint2 pk; pk.x = pack2(o[4 * k + 0] * siluf_(z0), o[4 * k + 1] * siluf_(z1)); pk.y = pack2(o[4 * k + 2] * siluf_(z2), o[4 * k + 3] * siluf_(z3));
            *(uint2*)(Y + row * 1024 + hh * 64 + d) = pk;
        }
    __syncthreads();
}

DI unsigned short okey16(float x) {
    const _Float16 hx = (_Float16)x; unsigned short u = __builtin_bit_cast(unsigned short, hx);
    if ((u & 0x7FFFu) == 0u) u = 0u;
    return (u & 0x8000u) ? (unsigned short)~u : (unsigned short)(u | 0x8000u);
}
DI void dsa_unit(const Frame& F, int b, int qt) {
    int tid_ = F.tid; OPAQUE(tid_);
    const int tid = tid_, lane = tid & 63, w = F.wave, r = lane & 31, hf = lane >> 5, fr = lane & 15, fq = lane >> 4;
    LAS unsigned char* L = F.ldsl;
    LAS unsigned char* buf = L + AT_BUF;
    LAS unsigned* mask = (LAS unsigned*)(L + AT_PSUM);
    const bf16_t* U = (const bf16_t*)(F.ws + WS_U);
    bf16_t* Y = (bf16_t*)(F.ws + WS_BFB);
    const bf16_t* VT = (const bf16_t*)(F.ws + WS_VT);
    unsigned short* KS = (unsigned short*)(F.ws + WS_BFA) + (size_t)F.bid * 32 * 4096;
    const int t0 = qt * 32;
    const int nt = ((t0 + 31) >> 6) + 1;
    {
        bf16x8 qi[2]; float wi[4];
        { const bf16_t* Uq = U + ((size_t)b * SEQ + t0 + 4 * w + (fr >> 2)) * LD0;
#pragma unroll
          for (int ks = 0; ks < 2; ++ks) qi[ks] = *(const bf16x8*)(Uq + C_BQI + (fr & 3) * 64 + 32 * ks + 8 * fq);
          const uint2 wv = *(const uint2*)(U + ((size_t)b * SEQ + t0 + 4 * w + fq) * LD0 + C_BWI);
          wi[0] = __uint_as_float(wv.x << 16) * 0.0625f; wi[1] = __uint_as_float(wv.x & 0xFFFF0000u) * 0.0625f; wi[2] = __uint_as_float(wv.y << 16) * 0.0625f; wi[3] = __uint_as_float(wv.y & 0xFFFF0000u) * 0.0625f; }
        const int tqi = t0 + 4 * w + fq;
        auto ldi = [&](int i, uint4& rk, uint4& rv) { const int key = tid >> 3, c = tid & 7; rk = *(const uint4*)(U + ((size_t)b * SEQ + i * 64 + key) * LD0 + C_BKI + c * 8); (void)rv; };
        auto body = [&](int i, LAS unsigned char* Kt, LAS unsigned char* Vt) { (void)Vt;
#pragma unroll
            for (int kg = 0; kg < 4; ++kg) {
                const int kk = 16 * kg + fr;
                f32x4 acc = {0.f, 0.f, 0.f, 0.f};
#pragma unroll
                for (int ks = 0; ks < 2; ++ks) { const int c = 4 * ks + fq;
                    const bf16x8 kb = *(const LAS bf16x8*)(Kt + (kk ^ ((kk >> 3) & 1)) * 128 + ((c ^ (kk & 7)) << 4));
                    acc = __builtin_amdgcn_mfma_f32_16x16x32_bf16(qi[ks], kb, acc, 0, 0, 0); }
                const float sc = wi[0] * fmaxf(acc[0], 0.f) + wi[1] * fmaxf(acc[1], 0.f) + wi[2] * fmaxf(acc[2], 0.f) + wi[3] * fmaxf(acc[3], 0.f);
                const int pos = i * 64 + kk;
                KS[(size_t)(4 * w + fq) * 4096 + pos] = pos <= tqi ? okey16(sc) : (unsigned short)0;
            } };
        tile_stream_k4(nt, buf, tid, ldi, body);
    }
    asm volatile("s_waitcnt vmcnt(0)" ::: "memory");
    __syncthreads();
    __builtin_amdgcn_fence(__ATOMIC_ACQUIRE, "agent");
    asm volatile("s_waitcnt vmcnt(0)" ::: "memory");
    {
    LAS unsigned char* maskb = (LAS unsigned char*)mask;
    unsigned Tn[32];
    auto ldkeys = [&](int q) { const int qq = 4 * w + q; const int nk = t0 + qq + 1; int ln = lane; OPAQUE(ln); const unsigned short* kq = KS + (size_t)qq * 4096 + ln * 8;
#pragma unroll
        for (int c = 0; c < 8; ++c) { uint4 kv = make_uint4(0u, 0u, 0u, 0u); if (c * 512 < nk) kv = *(const uint4*)(kq + c * 512);
            Tn[4 * c] = kv.x; Tn[4 * c + 1] = kv.y; Tn[4 * c + 2] = kv.z; Tn[4 * c + 3] = kv.w; } };
    ldkeys(0);
#pragma unroll 1
    for (int q = 0; q < 4; ++q) {
        const int qq = 4 * w + q; const int tqq = t0 + qq; const int nk = tqq + 1;
        unsigned T[32];
#pragma unroll
        for (int e = 0; e < 32; ++e) T[e] = Tn[e];
        if (q < 3) ldkeys(q + 1);
        if (nk <= 256) {
#pragma unroll
            for (int c = 0; c < 8; ++c) { unsigned selb = 0u;
#pragma unroll
                for (int e = 0; e < 8; ++e) if (c * 512 + lane * 8 + e < nk) selb |= 1u << e;
                maskb[qq * 512 + c * 64 + lane] = (unsigned char)selb; }
            continue;
        }
#pragma unroll
        for (int e = 0; e < 32; ++e) { const int idx = (e >> 2) * 512 + lane * 8 + (e & 3) * 2;
            unsigned lo = T[e] & 0xFFFFu, hi = T[e] >> 16; if (idx >= nk) lo = 0u; if (idx + 1 >= nk) hi = 0u; T[e] = lo | (hi << 16); }
#pragma unroll
        for (int st = 0; st < 5; ++st) { const int j = 16 >> st; const unsigned m = st == 0 ? 0x0000FFFFu : st == 1 ? 0x00FF00FFu : st == 2 ? 0x0F0F0F0Fu : st == 3 ? 0x33333333u : 0x55555555u;
#pragma unroll
            for (int k0 = 0; k0 < 32; k0 += 2 * j)
#pragma unroll
                for (int i = 0; i < j; ++i) { const int k = k0 + i; const unsigned t = ((T[k] >> j) ^ T[k + j]) & m; T[k] ^= (t << j); T[k + j] ^= t; } }
        unsigned ce = 0xFFFFFFFFu, co = 0xFFFFFFFFu, ge = 0u, go = 0u; int above = 0;
#pragma unroll
        for (int bit = 15; bit >= 0; --bit) {
            const unsigned oe = ce & T[bit], oo = co & T[16 + bit];
            const int cnt = __popc(oe) + __popc(oo);
            int tot = 0;
#pragma unroll
            for (int bb = 0; bb < 7; ++bb) tot += __popcll(__ballot((cnt >> bb) & 1)) << bb;
            if (above + tot >= 256) { ce = oe; co = oo; }
            else { above += tot; ge |= oe; go |= oo; ce &= ~T[bit]; co &= ~T[16 + bit]; }
        }
        const int quota = 256 - above; int taken = 0;
#pragma unroll
        for (int c = 0; c < 8; ++c) {
            unsigned xe = (ge >> (4 * c)) & 0xFu, xo = (go >> (4 * c)) & 0xFu;
            xe = (xe | (xe << 2)) & 0x33u; xe = (xe | (xe << 1)) & 0x55u; xo = (xo | (xo << 2)) & 0x33u; xo = (xo | (xo << 1)) & 0x55u;
            unsigned selb = xe | (xo << 1);
            unsigned ye = (ce >> (4 * c)) & 0xFu, yo = (co >> (4 * c)) & 0xFu;
            ye = (ye | (ye << 2)) & 0x33u; ye = (ye | (ye << 1)) & 0x55u; yo = (yo | (yo << 2)) & 0x33u; yo = (yo | (yo << 1)) & 0x55u;
            const unsigned eqb = ye | (yo << 1);
            if (__ballot(eqb != 0u) != 0ull) {
                const int ne = __popc(eqb);
                int excl = 0, totc = 0;
#pragma unroll
                for (int bb = 0; bb < 4; ++bb) { const unsigned long long bl_ = __ballot((ne >> bb) & 1);
                    excl += (int)__builtin_amdgcn_mbcnt_hi((unsigned)(bl_ >> 32), __builtin_amdgcn_mbcnt_lo((unsigned)bl_, 0u)) << bb; totc += __popcll(bl_) << bb; }
                int rank = taken + excl;
#pragma unroll
                for (int e = 0; e < 8; ++e) if ((eqb >> e) & 1u) { if (rank < quota) selb |= 1u << e; ++rank; }
                taken += totc;
            }
            maskb[qq * 512 + c * 64 + lane] = (unsigned char)selb;
        }
    }
    }
    __syncthreads();
    {
        const int ql = r >> 3, h = r & 7;
        const int tq = t0 + 4 * w + ql;
        const size_t row = (size_t)b * SEQ + tq;
        const bf16_t* Ur = U + row * LD0;
        bf16x8 qf[4];
#pragma unroll
        for (int s = 0; s < 4; ++s) qf[s] = *(const bf16x8*)(Ur + C_BQ + h * 64 + 16 * s + 8 * hf);
        const LAS float* bl = F.biasL + (8 + h) * 128; const float bfar = bl[127];
        const LAS unsigned* mq = mask + (4 * w + ql) * 128;
        Att st; att_init(st);
        auto lda = [&](int i, uint4& rk, uint4& rv) { const int key = tid >> 3, c = tid & 7;
            const bf16_t* p = U + ((size_t)b * SEQ + i * 64 + key) * LD0 + c * 8; rk = *(const uint4*)(p + C_BK); rv = *(const uint4*)(VT + (size_t)(256 + key) * MT + (size_t)b * SEQ + i * 64 + c * 8); };
        auto body = [&](int i, LAS unsigned char* Kt, LAS unsigned char* Vt) {
            const unsigned m0 = mq[2 * i], m1 = mq[2 * i + 1];
            if (__ballot(st.m == NEG_INF) == 0ull) {
                if (i < nt - 4) far_tile<true, false>(st, Kt, Vt, qf, r, hf, bfar, true, m0, m1, tq, i * 64, bl); else if (i < nt - 1) far_tile<true, true>(st, Kt, Vt, qf, r, hf, bfar, true, m0, m1, tq, i * 64, bl);
                else far_tile<true, true, true>(st, Kt, Vt, qf, r, hf, bfar, true, m0, m1, tq, i * 64, bl);
                return; }
            f32x16 s0, s1; qk_tile(Kt, qf, r, hf, s0, s1);
            if (i >= nt - 4) { fix_scores<FL_NEAR | FL_CAUSAL | FL_BITS>(s0, i * 64, 1, tq, bl, bfar, m0, true, hf); fix_scores<FL_NEAR | FL_CAUSAL | FL_BITS>(s1, i * 64 + 32, 1, tq, bl, bfar, m1, true, hf); }
            else { fix_scores<FL_BITS>(s0, i * 64, 1, tq, bl, bfar, m0, true, hf); fix_scores<FL_BITS>(s1, i * 64 + 32, 1, tq, bl, bfar, m1, true, hf); }
            online_pv(st, s0, s1, Vt, r, hf); };
        tile_stream(nt, buf, tid, true, lda, body);
        float l = st.l + __shfl_xor(st.l, 32);
        const float sc = l > 0.f ? 1.0f / l : 0.f;
#pragma unroll
        for (int dh = 0; dh < 2; ++dh)
#pragma unroll
            for (int k = 0; k < 4; ++k) {
                const int d = 32 * dh + 8 * k + 4 * hf;
                const uint2 zz = *(const uint2*)(Ur + C_BZ + h * 64 + d);
                const float z0 = __uint_as_float(zz.x << 16), z1 = __uint_as_float(zz.x & 0xFFFF0000u), z2 = __uint_as_float(zz.y << 16), z3 = __uint_as_float(zz.y & 0xFFFF0000u);
                const f32x16& o = dh ? st.o1 : st.o0;
                uint2 pk; pk.x = pack2(o[4 * k + 0] * sc * siluf_(z0), o[4 * k + 1] * sc * siluf_(z1)); pk.y = pack2(o[4 * k + 2] * sc * siluf_(z2), o[4 * k + 3] * sc * siluf_(z3));
                *(uint2*)(Y + row * 1024 + 512 + h * 64 + d) = pk;
            }
    }
    __syncthreads();
}

DI void att_dsa(const Frame& F) {
    LAS int* ub = (LAS int*)(F.ldsl + AT_MISC);
    unsigned* qd = F.ctl + CW_QDSA;
    const int NDSA = NB * (SEQ / 32);
    __syncthreads();
    if (F.tid == 0) ub[0] = (int)__hip_atomic_fetch_add(qd, 1u, __ATOMIC_RELAXED, __HIP_MEMORY_SCOPE_AGENT);
    for (;;) {
        __syncthreads();
        const int k = ub[0];
        __syncthreads();
        if (k >= NDSA) break;
        int nxt = 0; if (F.tid == 0) nxt = (int)__hip_atomic_fetch_add(qd, 1u, __ATOMIC_RELAXED, __HIP_MEMORY_SCOPE_AGENT);
        dsa_unit(F, k & 7, (SEQ / 32) - 1 - (k >> 3));
        if (F.tid == 0) ub[0] = nxt;
    }
}
DI void att_nsa(const Frame& F) {
    LAS int* ub = (LAS int*)(F.ldsl + AT_MISC);
    unsigned* qn = F.ctl + CW_QNSA;
    const int NNSA = NB * 2 * (SEQ / 64);
    __syncthreads();
    if (F.tid == 0) ub[0] = (int)__hip_atomic_fetch_add(qn, 1u, __ATOMIC_RELAXED, __HIP_MEMORY_SCOPE_AGENT);
    for (;;) {
        __syncthreads();
        const int k = ub[0];
        __syncthreads();
        if (k >= NNSA) break;
        int nxt = 0; if (F.tid == 0) nxt = (int)__hip_atomic_fetch_add(qn, 1u, __ATOMIC_RELAXED, __HIP_MEMORY_SCOPE_AGENT);
        const int bg = k & 15;
        nsa_unit(F, bg >> 1, bg & 1, 63 - (k >> 4));
        if (F.tid == 0) ub[0] = nxt;
    }
}

DI f32x4 mma16(const bf16_t* A, int lda, const bf16_t* Bt, int ldb, int K, int lane) {
    const int fr = lane & 15, fq = lane >> 4;
    f32x4 acc = {0.f, 0.f, 0.f, 0.f};
    for (int k = 0; k < K; k += 32) {
        const bf16x8 a = *(const bf16x8*)(A + fr * lda + k + fq * 8);
        const bf16x8 b = *(const bf16x8*)(Bt + fr * ldb + k + fq * 8);
        acc = __builtin_amdgcn_mfma_f32_16x16x32_bf16(a, b, acc, 0, 0, 0);
    }
    return acc;
}
DI void conv8(const bf16_t* U1, int b, int t, int col, const float* cw  , int nch, const float* cb, float (&y)[8]) {
#pragma unroll
    for (int i = 0; i < 8; ++i) y[i] = cb[i];
#pragma unroll
    for (int j = 0; j < 4; ++j) { const int tt = t - 3 + j;
        if (tt >= 0) { const uint4 v = *(const uint4*)(U1 + ((size_t)b * SEQ + tt) * LD1 + col); float f[8]; unpack8(v, f);
#pragma unroll
            for (int i = 0; i < 8; ++i) y[i] += cw[(size_t)j * nch + i] * f[i]; } }
}
DI void stage_raw128(const Frame& F, const bf16_t* U1, int b, int t_first, int nrows, int col, bf16_t* raw) {
    for (int it = F.tid; it < nrows * 16; it += 512) { const int row = it >> 4, ch = it & 15; const int t = t_first + row;
        uint4 v = make_uint4(0u, 0u, 0u, 0u); if (t >= 0) v = *(const uint4*)(U1 + ((size_t)b * SEQ + t) * LD1 + col + ch * 8);
        *(uint4*)(raw + row * 136 + ch * 8) = v; }
}
DI void load_raw128(const Frame& F, const bf16_t* U1, int b, int t_first, int nrows, int col, uint4 (&rg)[3]) {
#pragma unroll
    for (int j = 0; j < 3; ++j) { const int it = F.tid + j * 512; const int row = it >> 4, ch = it & 15; const int t = t_first + row;
        rg[j] = make_uint4(0u, 0u, 0u, 0u); if (it < nrows * 16 && t >= 0) rg[j] = *(const uint4*)(U1 + ((size_t)b * SEQ + t) * LD1 + col + ch * 8); }
}
DI void write_raw128(const Frame& F, int nrows, const uint4 (&rg)[3], bf16_t* raw) {
#pragma unroll
    for (int j = 0; j < 3; ++j) { const int it = F.tid + j * 512; const int row = it >> 4, ch = it & 15; if (it < nrows * 16) *(uint4*)(raw + row * 136 + ch * 8) = rg[j]; }
}
DI void conv8_lds(const bf16_t* raw, int s, int d0, const float* cw  , const float* cb  , float (&y)[8]) {
#pragma unroll
    for (int i = 0; i < 8; ++i) y[i] = cb[d0 + i];
#pragma unroll
    for (int j = 0; j < 4; ++j) { const uint4 v = *(const uint4*)(raw + (s + j) * 136 + d0); float f[8]; unpack8(v, f);
#pragma unroll
        for (int i = 0; i < 8; ++i) y[i] += cw[j * 128 + d0 + i] * f[i]; }
}
DI void mlstm_gates(const Frame& F, const bf16_t* U1, int b, int h, int c, float* li, float* bc) {
    if (F.wave == 0) {
        const size_t row = (size_t)b * SEQ + c * 64 + F.lane;
        const float* gts = (const float*)(F.ws + WS_GATES);
        const float ip = gts[row * 8 + h] + F.in[26][h];
        const float fp = gts[row * 8 + 4 + h] + F.in[27][h];
        const float lf = fminf(fp, 0.f) - log1pf(expf(-fabsf(fp)));
        float cs = lf;
        for (int o = 1; o < 64; o <<= 1) { const float n = __shfl_up(cs, o); if (F.lane >= o) cs += n; }
        li[F.lane] = ip; bc[F.lane] = cs;
    }
    __syncthreads();
}
constexpr int ML_LI = 0, ML_BC = 256, ML_WK = 512, ML_MT = 768, ML_DQ = 1024, ML_RS = 1280, ML_NIN = 1536, ML_Q = 2048, ML_K = ML_Q + 64 * 136 * 2, ML_VT = ML_K + 64 * 136 * 2,
              ML_CT = ML_VT + 128 * 72 * 2, ML_W = ML_CT + 128 * 136 * 2, ML_KT = ML_W + 64 * 72 * 2, ML_END = ML_KT + 128 * 72 * 2;
static_assert(ML_END + 5120 + LDS_WORK_OFF <= LDS_BYTES - 12288, "mlstm lds");

DI void p8a_mlstm_local(const Frame& F) {
    const bf16_t* U1 = (const bf16_t*)(F.ws + WS_U);
    bf16_t* ST = (bf16_t*)(F.ws + WS_BFB);
    float* zloc = (float*)(F.ws + WS_ZLOC); float* scal = (float*)(F.ws + WS_SCAL);
    unsigned char* L = F.lds;
    float* li = (float*)(L + ML_LI); float* bc = (float*)(L + ML_BC); float* wk = (float*)(L + ML_WK);
    bf16_t* kT = (bf16_t*)(L + ML_KT); bf16_t* vT = (bf16_t*)(L + ML_VT); float* cwl = (float*)(L + ML_END); bf16_t* raw = (bf16_t*)(L + ML_Q);
    const float* cw = F.in[24]; const float* cb = F.in[25];
    uint4 rk3[3], rv3[3];
    auto prefetch = [&](int unit) { const int c = unit & 63, h = (unit >> 6) & 3, b = unit >> 8;
        load_raw128(F, U1, b, c * 64 - 3, 67, C_DK + h * 128, rk3); load_raw128(F, U1, b, c * 64, 64, C_DV + h * 128, rv3); };
    if (F.bid < 2048) prefetch(F.bid);
    for (int unit = F.bid; unit < 2048; unit += F.G) {
        const int c = unit & 63, h = (unit >> 6) & 3, b = unit >> 8;
        mlstm_gates(F, U1, b, h, c, li, bc);
        if (F.wave == 0) {
            const float bl = bc[63]; const float dec = bl - bc[F.lane] + li[F.lane];
            const float dmx = wave_max(dec);
            wk[F.lane] = expf(dec - dmx);
            if (F.lane == 0) { scal[unit] = bl; scal[2048 + unit] = dmx; }
        }
        for (int e = F.tid; e < 640; e += 512) cwl[e] = e < 512 ? cw[(size_t)(e >> 7) * 1024 + 512 + h * 128 + (e & 127)] : cb[512 + h * 128 + (e - 512)];
        write_raw128(F, 67, rk3, raw);
        __syncthreads();
        for (int it = F.tid; it < 1024; it += 512) {
            const int s = it & 63, d0 = (it >> 6) * 8;
            float y[8]; conv8_lds(raw, s, d0, cwl, cwl + 512, y);
            const float w = wk[s] * 0.08838834764831845f;
#pragma unroll
            for (int i = 0; i < 8; ++i) kT[(d0 + i) * 72 + s] = f2bf(siluf_(y[i]) * w);
        }
        __syncthreads();
        write_raw128(F, 64, rv3, raw);
        if (unit + F.G < 2048) prefetch(unit + F.G);
        __syncthreads();
        for (int it = F.tid; it < 1024; it += 512) {
            const int s = it & 63, d0 = (it >> 6) * 8;
            const uint4 vv = *(const uint4*)(raw + s * 136 + d0); const unsigned wv[4] = {vv.x, vv.y, vv.z, vv.w};
#pragma unroll
            for (int i = 0; i < 8; ++i) vT[(d0 + i) * 72 + s] = (bf16_t)((i & 1) ? (wv[i >> 1] >> 16) : (wv[i >> 1] & 0xFFFFu));
        }
        __syncthreads();
        for (int tix = F.wave * 8; tix < F.wave * 8 + 8; ++tix) {
            const int et = tix >> 3, dt = tix & 7;
            const f32x4 a = mma16(vT + et * 16 * 72, 72, kT + dt * 16 * 72, 72, 64, F.lane);
            const int fr = F.lane & 15, fq = F.lane >> 4;
#pragma unroll
            for (int r = 0; r < 4; ++r) ST[(size_t)unit * 16384 + (size_t)(et * 16 + 4 * fq + r) * 128 + dt * 16 + fr] = f2bf(a[r]);
        }
        { const int d = F.tid >> 2, part = F.tid & 3; float z = 0.f;
#pragma unroll
          for (int s = 0; s < 16; ++s) z += bf2f(kT[d * 72 + part * 16 + s]);
          z += __shfl_xor(z, 1); z += __shfl_xor(z, 2);
          if (part == 0) zloc[(size_t)unit * 128 + d] = z; }
        __syncthreads();
    }
}

DI void p8a_lru_local(const Frame& F) {
    const bf16_t* U1 = (const bf16_t*)(F.ws + WS_U);
    bf16_t* LA = (bf16_t*)(F.ws + WS_LRUA); bf16_t* LH = (bf16_t*)(F.ws + WS_LRUH);
    float* Aend = (float*)(F.ws + WS_AEND); float* Hend = (float*)(F.ws + WS_HEND);
    const bf16_t* WAT = (const bf16_t*)(F.ws + WS_WAT); const bf16_t* WXT = (const bf16_t*)(F.ws + WS_WXT);
    bf16_t* xcb = (bf16_t*)F.lds;
    float* cwL = (float*)(F.lds + 16640);
    bf16_t* rawl = (bf16_t*)(F.lds + 16640 + 10240);
    const int g = F.wave, lane = F.lane, fr = lane & 15, fq = lane >> 4;
    __syncthreads();
    for (int e = F.tid; e < 2048; e += 512) cwL[e] = F.in[17][e];
    cwL[2048 + F.tid] = F.in[18][F.tid];
    bf16x8 wa[4][2], wx[4][2]; float ba[4], bx[4], sp[4];
#pragma unroll
    for (int ct = 0; ct < 4; ++ct) { const int ch = g * 64 + ct * 16 + fr;
#pragma unroll
        for (int ks = 0; ks < 2; ++ks) { wa[ct][ks] = *(const bf16x8*)(WAT + (size_t)ch * 64 + 32 * ks + 8 * fq); wx[ct][ks] = *(const bf16x8*)(WXT + (size_t)ch * 64 + 32 * ks + 8 * fq); }
        ba[ct] = F.in[20][ch]; bx[ct] = F.in[22][ch]; sp[ct] = log1pf(expf(-F.in[23][ch])); }
    __syncthreads();
    for (int unit = F.bid; unit < 512; unit += F.G) {
        const int b = unit >> 6, c = unit & 63, t0 = c * 64;
        float Ac[4] = {1.f, 1.f, 1.f, 1.f}, hl[4] = {0.f, 0.f, 0.f, 0.f};
        uint4 rr[3];
        auto ldraw = [&](int sub) {
#pragma unroll
            for (int j = 0; j < 3; ++j) { const int it = F.tid + j * 512; const int row = it >> 6, c8 = (it & 63) * 8; const int t = t0 + sub * 16 - 3 + row;
                rr[j] = make_uint4(0u, 0u, 0u, 0u); if (it < 19 * 64 && t >= 0) rr[j] = *(const uint4*)(U1 + ((size_t)b * SEQ + t) * LD1 + C_CX + c8); } };
        ldraw(0);
#pragma unroll 1
        for (int sub = 0; sub < 4; ++sub) {
#pragma unroll
            for (int j = 0; j < 3; ++j) { const int it = F.tid + j * 512; if (it < 19 * 64) *(uint4*)(rawl + (it >> 6) * 520 + (it & 63) * 8) = rr[j]; }
            __syncthreads();
            if (sub < 3) ldraw(sub + 1);
            for (int it = F.tid; it < 1024; it += 512) {
                const int tk = it >> 6, c8 = (it & 63) * 8;
                float y[8];
#pragma unroll
                for (int i = 0; i < 8; ++i) y[i] = cwL[2048 + c8 + i];
#pragma unroll
                for (int j = 0; j < 4; ++j) { const uint4 v = *(const uint4*)(rawl + (tk + j) * 520 + c8); float f[8]; unpack8(v, f);
#pragma unroll
                    for (int i = 0; i < 8; ++i) y[i] += cwL[j * 512 + c8 + i] * f[i]; }
                uint4 o; o.x = pack2(y[0], y[1]); o.y = pack2(y[2], y[3]); o.z = pack2(y[4], y[5]); o.w = pack2(y[6], y[7]);
                *(uint4*)(xcb + tk * 520 + c8) = o;
            }
            __syncthreads();
            bf16x8 af[2];
#pragma unroll
            for (int ks = 0; ks < 2; ++ks) af[ks] = *(const bf16x8*)(xcb + fr * 520 + g * 64 + 32 * ks + 8 * fq);
#pragma unroll
            for (int ct = 0; ct < 4; ++ct) {
                const int ch = g * 64 + ct * 16 + fr;
                f32x4 accA = {0.f, 0.f, 0.f, 0.f}, accX = {0.f, 0.f, 0.f, 0.f};
#pragma unroll
                for (int ks = 0; ks < 2; ++ks) { accA = __builtin_amdgcn_mfma_f32_16x16x32_bf16(af[ks], wa[ct][ks], accA, 0, 0, 0); accX = __builtin_amdgcn_mfma_f32_16x16x32_bf16(af[ks], wx[ct][ks], accX, 0, 0, 0); }
                float Ap[4], Hp[4]; float A4 = 1.f, H4 = 0.f;
#pragma unroll
                for (int rg = 0; rg < 4; ++rg) {
                    const float xc = bf2f(xcb[(4 * fq + rg) * 520 + ch]);
                    const float r = sigmoidf_(accA[rg] + ba[ct]), ig = sigmoidf_(accX[rg] + bx[ct]);
                    const float a = fexp_(-8.0f * r * sp[ct]);
                    const float bt = sqrtf(fmaxf(1.0f - a * a, 0.f)) * (ig * xc);
                    H4 = a * H4 + bt; A4 *= a; Ap[rg] = A4; Hp[rg] = H4;
                }
                float iA = A4, iH = H4;
                { const float pA = __shfl_up(iA, 16), pH = __shfl_up(iH, 16); if (fq >= 1) { iH = iA * pH + iH; iA = pA * iA; } }
                { const float pA = __shfl_up(iA, 32), pH = __shfl_up(iH, 32); if (fq >= 2) { iH = iA * pH + iH; iA = pA * iA; } }
                float eA = __shfl_up(iA, 16), eH = __shfl_up(iH, 16); if (fq == 0) { eA = 1.f; eH = 0.f; }
                const float tA = __shfl(iA, 48 + fr), tH = __shfl(iH, 48 + fr);
                const float cA = Ac[ct] * eA, cH = eA * hl[ct] + eH;
#pragma unroll
                for (int rg = 0; rg < 4; ++rg) { const size_t row = (size_t)b * SEQ + t0 + sub * 16 + 4 * fq + rg;
                    LA[row * 512 + ch] = f2bf(cA * Ap[rg]); LH[row * 512 + ch] = f2bf(Ap[rg] * cH + Hp[rg]); }
                hl[ct] = tA * hl[ct] + tH; Ac[ct] = Ac[ct] * tA;
            }
            __syncthreads();
        }
        if (fq == 0) {
#pragma unroll
            for (int ct = 0; ct < 4; ++ct) { const int ch = g * 64 + ct * 16 + fr; Aend[((size_t)b * 64 + c) * 512 + ch] = Ac[ct]; Hend[((size_t)b * 64 + c) * 512 + ch] = hl[ct]; } }
    }
    __syncthreads();
}

DI void p8b_scans(const Frame& F) {
    const int gt = F.bid * 512 + F.tid, nthr = F.G * 512;
    if (gt < 4096) {
        const int b = gt >> 9, ch = gt & 511;
        const float* Aend = (const float*)(F.ws + WS_AEND); const float* Hend = (const float*)(F.ws + WS_HEND); float* Hin = (float*)(F.ws + WS_HIN);
        float H = 0.f;
#pragma unroll 1
        for (int c0 = 0; c0 < 64; c0 += 8) {
            float av[8], hv[8];
#pragma unroll
            for (int j = 0; j < 8; ++j) { const size_t o = ((size_t)b * 64 + c0 + j) * 512 + ch; av[j] = Aend[o]; hv[j] = Hend[o]; }
#pragma unroll
            for (int j = 0; j < 8; ++j) { const size_t o = ((size_t)b * 64 + c0 + j) * 512 + ch; Hin[o] = H; H = av[j] * H + hv[j]; }
        }
    }
    const float* scal = (const float*)(F.ws + WS_SCAL); float* minp = (float*)(F.ws + WS_SCAL) + 4096;
    if (gt >= nthr - 4096) {
        const int q = gt - (nthr - 4096); const int bh = q >> 7, d = q & 127;
        const float* zloc = (const float*)(F.ws + WS_ZLOC); float* nin = (float*)(F.ws + WS_NIN);
        float m = 0.f, n = 0.f;
#pragma unroll 1
        for (int c0 = 0; c0 < 64; c0 += 8) {
            float zv[8];
#pragma unroll
            for (int j = 0; j < 8; ++j) zv[j] = zloc[(size_t)(bh * 64 + c0 + j) * 128 + d];
#pragma unroll
            for (int j = 0; j < 8; ++j) { const int unit = bh * 64 + c0 + j; const float bl = scal[unit], dm = scal[2048 + unit];
                const float mn = fmaxf(bl + m, dm); const float keep = expf(bl + m - mn), add = expf(dm - mn);
                nin[(size_t)unit * 128 + d] = n; if (d == 0) minp[unit] = m;
                n = keep * n + add * zv[j]; m = mn; }
        }
    }
    bf16_t* ST = (bf16_t*)(F.ws + WS_BFB);
    float* kp = (float*)F.lds; float* ad = kp + 64;
    if (gt < 65536) {
        const int bh = gt >> 11, ed = (gt & 2047) * 8;
        if (F.wave == 0) { const int c = F.lane; const int unit = bh * 64 + c; const float bl = scal[unit], dm = scal[2048 + unit];
            float Bi = bl;
            for (int o = 1; o < 64; o <<= 1) { const float n = __shfl_up(Bi, o); if (c >= o) Bi += n; }
            float pm = dm - Bi;
            for (int o = 1; o < 64; o <<= 1) { const float n = __shfl_up(pm, o); if (c >= o) pm = fmaxf(pm, n); }
            const float mnext = Bi + fmaxf(0.f, pm);
            float mcur = __shfl_up(mnext, 1); if (c == 0) mcur = 0.f;
            kp[c] = expf(bl + mcur - mnext); ad[c] = expf(dm - mnext); }
        __syncthreads();
        float C[8] = {0.f, 0.f, 0.f, 0.f, 0.f, 0.f, 0.f, 0.f};
#pragma unroll 1
        for (int c0 = 0; c0 < 64; c0 += 8) {
            uint4 sv[8];
#pragma unroll
            for (int j = 0; j < 8; ++j) sv[j] = *(const uint4*)(ST + (size_t)(bh * 64 + c0 + j) * 16384 + ed);
#pragma unroll
            for (int j = 0; j < 8; ++j) { float sf[8]; unpack8(sv[j], sf);
                uint4 o; o.x = pack2(C[0], C[1]); o.y = pack2(C[2], C[3]); o.z = pack2(C[4], C[5]); o.w = pack2(C[6], C[7]);
                *(uint4*)(ST + (size_t)(bh * 64 + c0 + j) * 16384 + ed) = o;
                const float kk = kp[c0 + j], aa = ad[c0 + j];
#pragma unroll
                for (int i = 0; i < 8; ++i) C[i] = kk * C[i] + aa * sf[i]; }
        }
    }
}

DI void p8c_mlstm_out(const Frame& F) {
    const bf16_t* U1 = (const bf16_t*)(F.ws + WS_U);
    const bf16_t* ST = (const bf16_t*)(F.ws + WS_BFB);
    bf16_t* Y = (bf16_t*)(F.ws + WS_BFA);
    const float* nin_g = (const float*)(F.ws + WS_NIN); const float* minp = (const float*)(F.ws + WS_SCAL) + 4096;
    unsigned char* L = F.lds;
    float* li = (float*)(L + ML_LI); float* bc = (float*)(L + ML_BC); float* wkk = (float*)(L + ML_WK); float* mt = (float*)(L + ML_MT); float* dq = (float*)(L + ML_DQ); float* rs = (float*)(L + ML_RS); float* nin = (float*)(L + ML_NIN);
    bf16_t* q = (bf16_t*)(L + ML_Q); bf16_t* k = (bf16_t*)(L + ML_K); bf16_t* vT = (bf16_t*)(L + ML_VT); bf16_t* CT = (bf16_t*)(L + ML_CT); bf16_t* W = (bf16_t*)(L + ML_W); float* cwl = (float*)(L + ML_END); bf16_t* raw = (bf16_t*)(L + ML_KT); float* HT = (float*)(L + ML_Q);
    const float* cw = F.in[24]; const float* cb = F.in[25];
    uint4 rq3[3], rk3[3], rv3[3]; u32x4 rc4[4];
    auto prefetch = [&](int unit) { const int c = unit & 63, h = (unit >> 6) & 3, b = unit >> 8;
        load_raw128(F, U1, b, c * 64 - 3, 67, C_DQ + h * 128, rq3);
        load_raw128(F, U1, b, c * 64 - 3, 67, C_DK + h * 128, rk3);
        load_raw128(F, U1, b, c * 64, 64, C_DV + h * 128, rv3);
#pragma unroll
        for (int j = 0; j < 4; ++j) { const int it = F.tid + j * 512; rc4[j] = *(const u32x4*)(ST + (size_t)unit * 16384 + (it >> 4) * 128 + (it & 15) * 8); } };
    if (F.bid < 2048) prefetch(F.bid);
    for (int unit = F.bid; unit < 2048; unit += F.G) {
        const int c = unit & 63, h = (unit >> 6) & 3, b = unit >> 8;
        const float m_in = minp[unit];
        for (int e = F.tid; e < 1280; e += 512) { float v;
            if (e < 512) v = cw[(size_t)(e >> 7) * 1024 + h * 128 + (e & 127)]; else if (e < 1024) v = cw[(size_t)((e - 512) >> 7) * 1024 + 512 + h * 128 + (e & 127)];
            else if (e < 1152) v = cb[h * 128 + (e - 1024)]; else v = cb[512 + h * 128 + (e - 1152)];
            cwl[e] = v; }
        mlstm_gates(F, U1, b, h, c, li, bc);
        write_raw128(F, 67, rq3, raw);
        __syncthreads();
        for (int it = F.tid; it < 1024; it += 512) { const int s = it & 63, d0 = (it >> 6) * 8;
            float y[8]; conv8_lds(raw, s, d0, cwl, cwl + 1024, y);
            uint4 o; o.x = pack2(siluf_(y[0]), siluf_(y[1])); o.y = pack2(siluf_(y[2]), siluf_(y[3])); o.z = pack2(siluf_(y[4]), siluf_(y[5])); o.w = pack2(siluf_(y[6]), siluf_(y[7]));
            *(uint4*)(q + s * 136 + d0) = o; }
        __syncthreads();
        write_raw128(F, 67, rk3, raw);
        __syncthreads();
        for (int it = F.tid; it < 1024; it += 512) { const int s = it & 63, d0 = (it >> 6) * 8;
            float y[8]; conv8_lds(raw, s, d0, cwl + 512, cwl + 1152, y);
            const float sc = 0.08838834764831845f; uint4 o;
            o.x = pack2(siluf_(y[0]) * sc, siluf_(y[1]) * sc); o.y = pack2(siluf_(y[2]) * sc, siluf_(y[3]) * sc); o.z = pack2(siluf_(y[4]) * sc, siluf_(y[5]) * sc); o.w = pack2(siluf_(y[6]) * sc, siluf_(y[7]) * sc);
            *(uint4*)(k + s * 136 + d0) = o; }
        __syncthreads();
        write_raw128(F, 64, rv3, raw);
        __syncthreads();
        for (int it = F.tid; it < 1024; it += 512) { const int s = it & 63, d0 = (it >> 6) * 8;
            const uint4 vv = *(const uint4*)(raw + s * 136 + d0); const unsigned wv[4] = {vv.x, vv.y, vv.z, vv.w};
#pragma unroll
            for (int i = 0; i < 8; ++i) vT[(d0 + i) * 72 + s] = (bf16_t)((i & 1) ? (wv[i >> 1] >> 16) : (wv[i >> 1] & 0xFFFFu)); }
#pragma unroll
        for (int j = 0; j < 4; ++j) { const int it = F.tid + j * 512; *(u32x4*)(CT + (it >> 4) * 136 + (it & 15) * 8) = rc4[j]; }
        if (unit + F.G < 2048) prefetch(unit + F.G);
        if (F.tid < 128) nin[F.tid] = nin_g[(size_t)unit * 128 + F.tid];
        if (F.tid >= 128 && F.tid < 192) { const int l = F.tid - 128;
            float pm = li[l] - bc[l];
            for (int o = 1; o < 64; o <<= 1) { const float n = __shfl_up(pm, o); if (l >= o) pm = fmaxf(pm, n); }
            mt[l] = bc[l] + fmaxf(m_in, pm); }
        __syncthreads();
        { const int l = F.tid >> 3, part = F.tid & 7; float a = 0.f;
#pragma unroll
          for (int d = 0; d < 16; ++d) a += bf2f(q[l * 136 + part * 16 + d]) * nin[part * 16 + d];
          a += __shfl_xor(a, 1); a += __shfl_xor(a, 2); a += __shfl_xor(a, 4);
          if (part == 0) dq[l] = a; }
        for (int tix = F.wave * 2; tix < F.wave * 2 + 2; ++tix) {
            const int lt = tix >> 2, st = tix & 3;
            const f32x4 a = mma16(q + lt * 16 * 136, 136, k + st * 16 * 136, 136, 128, F.lane);
            const int fr = F.lane & 15, fq = F.lane >> 4; const int s = st * 16 + fr;
#pragma unroll
            for (int r = 0; r < 4; ++r) { const int l = lt * 16 + 4 * fq + r;
                const float w = s <= l ? a[r] * expf(bc[l] - bc[s] + li[s] - mt[l]) : 0.f;
                W[l * 72 + s] = f2bf(w); }
        }
        __syncthreads();
        { const int l = F.tid >> 3, part = F.tid & 7; float a = 0.f;
#pragma unroll
          for (int s = 0; s < 8; ++s) a += bf2f(W[l * 72 + part * 8 + s]);
          a += __shfl_xor(a, 1); a += __shfl_xor(a, 2); a += __shfl_xor(a, 4);
          if (part == 0) rs[l] = a; }
        if (F.tid >= 64 && F.tid < 128) { const int l = F.tid - 64; li[l] = expf(bc[l] + m_in - mt[l]); }
        if (F.tid >= 128 && F.tid < 192) { const int l = F.tid - 128; wkk[l] = expf(-mt[l]); }
        __syncthreads();
        uint4 ro2[2], rz2[2];
#pragma unroll
        for (int j = 0; j < 2; ++j) { const int it = F.tid + j * 512; const size_t row = (size_t)b * SEQ + c * 64 + (it >> 4);
            ro2[j] = *(const uint4*)(U1 + row * LD1 + C_DO + h * 128 + (it & 15) * 8); rz2[j] = *(const uint4*)(U1 + row * LD1 + C_DZ + h * 128 + (it & 15) * 8); }
        f32x4 hres[4];
#pragma unroll
        for (int ti = 0; ti < 4; ++ti) { const int tix = F.wave * 4 + ti;
            const int lt = tix >> 3, et = tix & 7;
            const f32x4 qc = mma16(q + lt * 16 * 136, 136, CT + et * 16 * 136, 136, 128, F.lane);
            const f32x4 wv = mma16(W + lt * 16 * 72, 72, vT + et * 16 * 72, 72, 64, F.lane);
            const int fq = F.lane >> 4;
#pragma unroll
            for (int r = 0; r < 4; ++r) { const int l = lt * 16 + 4 * fq + r;
                const float prev = li[l];
                const float num = prev * qc[r] + wv[r];
                const float den = prev * dq[l] + rs[l];
                hres[ti][r] = num * __builtin_amdgcn_rcpf(fmaxf(fabsf(den), wkk[l])); }
        }
        __syncthreads();
#pragma unroll
        for (int ti = 0; ti < 4; ++ti) { const int tix = F.wave * 4 + ti; const int lt = tix >> 3, et = tix & 7; const int fr = F.lane & 15, fq = F.lane >> 4;
#pragma unroll
            for (int r = 0; r < 4; ++r) HT[(lt * 16 + 4 * fq + r) * 132 + et * 16 + fr] = hres[ti][r]; }
        __syncthreads();
#pragma unroll
        for (int j = 0; j < 2; ++j) { const int it = F.tid + j * 512; const int l = it >> 4, e0 = (it & 15) * 8;
            const size_t row = (size_t)b * SEQ + c * 64 + l;
            float of[8], zf[8]; unpack8(ro2[j], of); unpack8(rz2[j], zf);
            const f32x4 h0 = *(const f32x4*)(HT + l * 132 + e0), h1 = *(const f32x4*)(HT + l * 132 + e0 + 4);
            float y[8];
#pragma unroll
            for (int i = 0; i < 4; ++i) { y[i] = sigmoidf_(of[i]) * h0[i] * siluf_(zf[i]); y[4 + i] = sigmoidf_(of[4 + i]) * h1[i] * siluf_(zf[4 + i]); }
            uint4 o; o.x = pack2(y[0], y[1]); o.y = pack2(y[2], y[3]); o.z = pack2(y[4], y[5]); o.w = pack2(y[6], y[7]);
            *(uint4*)(Y + row * 1024 + 512 + h * 128 + e0) = o; }
        __syncthreads();
    }
}
DI void p8c_lru_out(const Frame& F) {
    const bf16_t* U1 = (const bf16_t*)(F.ws + WS_U);
    const bf16_t* LA = (const bf16_t*)(F.ws + WS_LRUA); const bf16_t* LH = (const bf16_t*)(F.ws + WS_LRUH);
    const float* Hin = (const float*)(F.ws + WS_HIN);
    bf16_t* Y = (bf16_t*)(F.ws + WS_BFA);
    const size_t n8 = (size_t)MT * 64;
    for (size_t it = (size_t)F.bid * 512 + F.tid; it < n8; it += (size_t)F.G * 512) {
        const size_t row = it >> 6; const int c0 = (int)(it & 63) * 8; const int b = (int)(row >> 12), t = (int)(row & 4095), c = t >> 6;
        const uint4 av = *(const uint4*)(LA + row * 512 + c0), hv = *(const uint4*)(LH + row * 512 + c0), zv = *(const uint4*)(U1 + row * LD1 + C_CZ + c0);
        float af[8], hf[8], zf[8]; unpack8(av, af); unpack8(hv, hf); unpack8(zv, zf);
        const float* hi = Hin + ((size_t)b * 64 + c) * 512 + c0; float y[8];
#pragma unroll
        for (int i = 0; i < 8; ++i) y[i] = (af[i] * hi[i] + hf[i]) * siluf_(zf[i]);
        uint4 o; o.x = pack2(y[0], y[1]); o.y = pack2(y[2], y[3]); o.z = pack2(y[4], y[5]); o.w = pack2(y[6], y[7]);
        *(uint4*)(Y + row * 1024 + c0) = o;
    }
}

constexpr int N_PHASES = 16;
__global__ void __launch_bounds__(512, 2) mk_fwd(Args args) {
    extern __shared__ __attribute__((aligned(16))) unsigned char smem[];
    Frame F;
    F.tid = threadIdx.x; F.lane = F.tid & 63; F.wave = __builtin_amdgcn_readfirstlane(F.tid >> 6);
    F.G = gridDim.x; F.bid = blockIdx.x; F.gw = F.bid * 8 + F.wave; F.nw = F.G * 8;
    F.lds = smem + LDS_WORK_OFF; F.ws = args.ws; F.out = args.out; F.ctl = (unsigned*)args.ws;
#pragma unroll
    for (int i = 0; i < 28; ++i) F.in[i] = args.in[i];
    LAS unsigned char* lsm = (LAS unsigned char*)smem;
    LAS unsigned char* lut = lsm + (LDS_BYTES - 12288);
    LAS float* tbl = (LAS float*)(lsm + (LDS_BYTES - 12288 + 256));
    LAS float* biasL = (LAS float*)(lsm + (LDS_BYTES - 8192));
    if (F.tid < 4) ((LAS unsigned*)lsm)[F.tid] = 0u;
    if (F.tid < 128) { const int n = F.tid; int bk;
        if (n < 16) bk = n; else { bk = 16; const int thr[15] = {19, 21, 24, 27, 31, 35, 40, 46, 52, 59, 67, 77, 87, 99, 113};
#pragma unroll
            for (int j = 0; j < 15; ++j) bk += (n >= thr[j]) ? 1 : 0; }
        lut[n] = (unsigned char)bk; }
    { const int hd = F.tid >> 5, bk = F.tid & 31; tbl[hd * 32 + bk] = args.in[6][bk * 16 + hd]; }
    F.lut = lut; F.tbl = tbl; F.biasL = biasL; F.ldsl = lsm + LDS_WORK_OFF;
    __syncthreads();
    for (int e = F.tid; e < 16 * 128; e += 512) { const int hd = e >> 7, n = e & 127; const int bk = n < 16 ? n : (n >= 113 ? 31 : (int)lut[n]); biasL[e] = tbl[hd * 32 + bk] * 1.4426950408889634f; }
    __syncthreads();
    const int lo = args.ph_lo, hi = args.ph_hi;
    XcdBarrier bar; bar.bar = F.ctl; bar.x = 0; bar.st = nullptr;
#if !MK_PER_PHASE
    bar = xcd_barrier_post(F.ctl, (volatile LAS unsigned*)lsm);
#endif
#ifndef PH_MASK
#define PH_MASK 0xFFFF
#endif
#define IN(k) (phase_refresh(F), ((PH_MASK >> (k)) & 1) && lo <= (k) && (k) < hi)
#ifndef DLY_LO
#define DLY_LO -1
#define DLY_HI -1
#endif
#ifndef DLY_MULT
#define DLY_MULT 4
#endif
    unsigned long long dly_t0 = 0ull;
#define DLY_START(k) do { if ((k) == DLY_LO && F.bid == 0 && F.tid == 0) dly_t0 = __builtin_amdgcn_s_memrealtime(); } while (0)
#define DLY_END(k) do { if ((k) == DLY_HI && F.bid == 0) { if (F.tid == 0) { const unsigned long long t1 = __builtin_amdgcn_s_memrealtime(); const unsigned long long until = t1 + DLY_MULT * (t1 - dly_t0); \
        while (__builtin_amdgcn_s_memrealtime() < until) __builtin_amdgcn_s_sleep(16); } __syncthreads(); } } while (0)
#if MK_PER_PHASE
#define SEAM(k) do { } while (0)
#else
#define SEAM(k) do { if (IN(k) && IN((k) + 1)) xcd_barrier(bar); DLY_END(k); DLY_START((k) + 1); } while (0)
#endif
    LAS unsigned char* glds = lsm + LDS_WORK_OFF;
    unsigned char* ws = args.ws;
    bf16_t* BFA = (bf16_t*)(ws + WS_BFA); bf16_t* BFB = (bf16_t*)(ws + WS_BFB); bf16_t* U = (bf16_t*)(ws + WS_U); bf16_t* Ef = (bf16_t*)(ws + WS_U); bf16_t* X1b = (bf16_t*)F.out;

    DLY_START(0);
    if (IN(0)) { p0_prologue(F); }
    SEAM(0);
    if (IN(1)) {
        pg8::Gemm g{BFA, (const bf16_t*)(ws + WS_WIN0), MT, LD0, 1024}; pg8::StaticOrder S; S.init(MT, LD0, F.G, F.bid);
        pg8::EpiBf16<0> E{U, LD0};
        pg8::gemm_phase(glds, g, S, E);
        pg8::Gemm g2{(const bf16_t*)(ws + WS_WVT), BFA, 512, MT, 1024}; pg8::StaticOrder S2; S2.init(512, MT, F.G, F.bid);
        pg8::EpiBf16<0> E2{(bf16_t*)(ws + WS_VT), MT};
        pg8::gemm_phase(glds, g2, S2, E2);
    }
    SEAM(1);
    if (IN(2)) { p2a_build_blocks(F); }
    SEAM(2);
    if (IN(3)) {
        if (F.bid < 32) {
            const int which = F.bid >> 4;
            pg8::Gemm g{(const bf16_t*)(ws + (which ? WS_AV : WS_AK)), (const bf16_t*)(ws + (which ? WS_WC1V : WS_WC1K)), 4096, 256, 2048}; pg8::StaticOrder S; S.init(4096, 256, F.G, F.bid & 15);
            pg8::EpiBf16<1> E{(bf16_t*)(ws + (which ? WS_HV : WS_HK)), 256}; pg8::gemm_phase(glds, g, S, E);
            asm volatile("s_waitcnt vmcnt(0)" ::: "memory"); __syncthreads();
            pg8::Unit u; S.next(0, u);
            p2c_compress_rows(F, which, u.pm * 256);
            asm volatile("s_waitcnt vmcnt(0)" ::: "memory"); __syncthreads();
            if (F.tid == 0) { __builtin_amdgcn_fence(__ATOMIC_RELEASE, "agent"); asm volatile("s_waitcnt vmcnt(0)" ::: "memory");
                (void)__hip_atomic_fetch_add(F.ctl + CW_CMPDONE, 1u, __ATOMIC_RELAXED, __HIP_MEMORY_SCOPE_AGENT); }
        }
        att_dsa(F);
    }
    if (IN(5)) {
        if (F.tid == 0) { unsigned sp = 0;
            while (__hip_atomic_load(F.ctl + CW_CMPDONE, __ATOMIC_RELAXED, __HIP_MEMORY_SCOPE_AGENT) < 32u) { __builtin_amdgcn_s_sleep(2);
                if (++sp > (1u << 22)) { atomicAdd(F.ctl + XB_TMO, 1u); break; } }
            __builtin_amdgcn_fence(__ATOMIC_ACQUIRE, "agent"); asm volatile("s_waitcnt vmcnt(0)" ::: "memory"); }
        __syncthreads();
        att_nsa(F); }
    if (IN(3) && IN(6)) xcd_barrier(bar);
    if (IN(6)) {
        pg8::Gemm g{BFB, (const bf16_t*)(ws + WS_WOUT0), MT, 1024, 1024}; pg8::StaticOrder S; S.init(MT, 1024, F.G, F.bid);
        pg8::EpiResid<0> E{F.in[0], nullptr, BFA};
        pg8::gemm_phase(glds, g, S, E);
    }
    SEAM(6);
    if (IN(7)) {
        { pg8::Gemm g{(const bf16_t*)(ws + WS_PBF), (const bf16_t*)(ws + WS_WP0), MT, 1024, 256}; pg8::StaticOrder S; S.init(MT, 1024, F.G, F.bid);
          pg8::EpiBf16<0> E{Ef, 1024}; pg8::gemm_phase(glds, g, S, E); }
        asm volatile("s_waitcnt vmcnt(0)" ::: "memory"); __syncthreads();
        { pg8::Gemm g{BFA, (const bf16_t*)(ws + WS_WG0), MT, 1024, 1024}; pg8::StaticOrder S; S.init(MT, 1024, F.G, F.bid);
          pg8::EpiGate<1> E{nullptr, X1b, BFA, Ef}; pg8::gemm_phase(glds, g, S, E); }
    }
    SEAM(7);
    if (IN(8)) { rmsnorm_gates(F, X1b, F.in[2] + 1024, BFB); }
    SEAM(8);
    if (IN(9)) {
        pg8::Gemm g{BFB, (const bf16_t*)(ws + WS_WIN1), MT, LD1, 1024}; pg8::StaticOrder S; S.init(MT, LD1, F.G, F.bid);
        pg8::EpiBf16<0> E{U, LD1};
        pg8::gemm_phase(glds, g, S, E);
    }
    SEAM(9);
    if (IN(10)) { p8a_mlstm_local(F); p8a_lru_local(F); }
    SEAM(10);
    if (IN(11)) { p8b_scans(F); }
    SEAM(11);
    if (IN(12)) { p8c_mlstm_out(F); p8c_lru_out(F); }
    SEAM(12);

    if (IN(13)) {
        pg8::Gemm g{BFA, (const bf16_t*)(ws + WS_WOUT1), MT, 1024, 1024}; pg8::StaticOrder S; S.init(MT, 1024, F.G, F.bid);
        pg8::EpiResid<1> E{nullptr, X1b, BFB};
        pg8::gemm_phase(glds, g, S, E);
    }
    SEAM(13);
    if (IN(14)) {
        { pg8::Gemm g{(const bf16_t*)(ws + WS_PBF) + (size_t)MT * 256, (const bf16_t*)(ws + WS_WP1), MT, 1024, 256}; pg8::StaticOrder S; S.init(MT, 1024, F.G, F.bid);
          pg8::EpiBf16<0> E{Ef, 1024}; pg8::gemm_phase(glds, g, S, E); }
        asm volatile("s_waitcnt vmcnt(0)" ::: "memory"); __syncthreads();
        { pg8::Gemm g{BFB, (const bf16_t*)(ws + WS_WG1), MT, 1024, 1024}; pg8::StaticOrder S; S.init(MT, 1024, F.G, F.bid);
          pg8::EpiGateNorm E{F.out, BFB, Ef, F.in[3], (float*)(ws + WS_SS), F.ctl + CW_NORMCNT, F.ctl + XB_TMO}; pg8::gemm_phase(glds, g, S, E); }
    }
#undef IN
#undef SEAM
}

extern "C" void kernel_launch(void* const* d_in, const int* in_sizes, int n_in, void* d_out, int out_size, void* d_ws, size_t ws_size, hipStream_t stream) {
    static int grid = 0;
    if (grid == 0) {
        if (n_in != 28 || out_size != MT * DM || ws_size < WS_END) { fprintf(stderr, "kernel_launch: unexpected shapes (n_in %d, out %d, ws %zu < %zu)\n", n_in, out_size, ws_size, (size_t)WS_END); grid = -1; return; }
        int dev = 0, cus = 0, per_cu = 0;
        if (hipGetDevice(&dev) != hipSuccess || hipDeviceGetAttribute(&cus, hipDeviceAttributeMultiprocessorCount, dev) != hipSuccess) { grid = -1; return; }
        if (hipFuncSetAttribute((const void*)mk_fwd, hipFuncAttributeMaxDynamicSharedMemorySize, LDS_BYTES) != hipSuccess) { fprintf(stderr, "kernel_launch: hipFuncSetAttribute failed\n"); grid = -1; return; }
        if (hipOccupancyMaxActiveBlocksPerMultiprocessor(&per_cu, (const void*)mk_fwd, 512, LDS_BYTES) != hipSuccess || per_cu < 1)
            fprintf(stderr, "kernel_launch: occupancy query reports %d workgroups per CU\n", per_cu);
        (void)hipGetLastError();
        grid = cus > 256 ? 256 : cus;
    }
    if (grid < 0) return;
    if (hipMemsetAsync(d_ws, 0, CTL_BYTES, stream) != hipSuccess) return;
    Args a{};
    for (int i = 0; i < 28; ++i) a.in[i] = (const float*)d_in[i];
    a.out = (float*)d_out; a.ws = (unsigned char*)d_ws;
#if MK_PER_PHASE
    for (int p = 0; p < N_PHASES; ++p) { a.ph_lo = p; a.ph_hi = p + 1; hipLaunchKernelGGL(mk_fwd, dim3(grid), dim3(512), LDS_BYTES, stream, a); }
#else
    a.ph_lo = 0; a.ph_hi = N_PHASES;
    hipLaunchKernelGGL(mk_fwd, dim3(grid), dim3(512), LDS_BYTES, stream, a);
#endif
}
```

```cpp
#include <hip/hip_runtime.h>
#include <cstdio>
#include <cstdint>

#ifndef MK_PER_PHASE
#define MK_PER_PHASE 0
#endif

#define LAS __attribute__((address_space(3)))
typedef unsigned short bf16_t;
typedef short bf16x8 __attribute__((ext_vector_type(8)));
typedef float f32x4 __attribute__((ext_vector_type(4)));
#define DI __device__ __forceinline__

constexpr int NB = 8, SEQ = 4096, DM = 1024, MT = NB * SEQ;
constexpr int LD0 = 3072, LD1 = 3584;
constexpr int C_AQ = 0, C_KC = 512, C_VC = 640, C_KS = 768, C_KW = 896, C_AZ = 1024, C_BQ = 1536, C_BZ = 2048,
              C_BK = 2560, C_BKI = 2624, C_BQI = 2688, C_AG = 2944, C_BWI = 2968;
constexpr int C_VS = 0, C_VW = 0, C_BV = 0;
constexpr int C_CX = 0, C_CZ = 512, C_DQ = 1024, C_DK = 1536, C_DV = 2048, C_DO = 2560, C_DZ = 3072;
constexpr int NCMP = 255;
constexpr float NEG_INF = -__builtin_inff();

DI int map0(int n) {
    if (n < 896) return n;
    if (n < 1024) return 1024 + (n - 896);
    if (n < 1536) return 1304 + (n - 1024);
    if (n < 2048) return 1816 + (n - 1536);
    if (n < 2560) return 2780 + (n - 2048);
    if (n < 2624) return 2328 + (n - 2560);
    if (n < 2688) return 2712 + (n - 2624);
    if (n < 2944) return 2456 + (n - 2688);
    if (n < 2968) return 1280 + (n - 2944);
    if (n < 2972) return 2776 + (n - 2968);
    return -1;
}
DI int map1(int n) {
    if (n < 2560) return n;
    if (n < 3072) return 2568 + (n - 2560);
    if (n < 3584) return 3080 + (n - 3072);
    return -1;
}
DI int mapid(int n) { return n; }
DI int mapv(int f) { return f < 128 ? 896 + f : (f < 256 ? 1152 + (f - 128) : (f < 320 ? 2392 + (f - 256) : -1)); }

constexpr size_t CTL_BYTES = 16384;
constexpr size_t WS_WIN0  = CTL_BYTES;
constexpr size_t WS_WOUT0 = WS_WIN0  + (size_t)LD0 * 1024 * 2;
constexpr size_t WS_WG0   = WS_WOUT0 + (size_t)1024 * 1024 * 2;
constexpr size_t WS_WP0   = WS_WG0   + (size_t)1024 * 1024 * 2;
constexpr size_t WS_WIN1  = WS_WP0   + (size_t)1024 * 256 * 2;
constexpr size_t WS_WOUT1 = WS_WIN1  + (size_t)LD1 * 1024 * 2;
constexpr size_t WS_WG1   = WS_WOUT1 + (size_t)1024 * 1024 * 2;
constexpr size_t WS_WP1   = WS_WG1   + (size_t)1024 * 1024 * 2;
constexpr size_t WS_WC1K  = WS_WP1   + (size_t)1024 * 256 * 2;
constexpr size_t WS_WC1V  = WS_WC1K  + (size_t)256 * 2048 * 2;
constexpr size_t WS_WVT   = WS_WC1V  + (size_t)256 * 2048 * 2;
constexpr size_t WS_BFA   = WS_WVT   + (size_t)512 * 1024 * 2;
constexpr size_t WS_BFB   = WS_BFA   + (size_t)MT * 1024 * 2;
constexpr size_t WS_PBF   = WS_BFB   + (size_t)MT * 1024 * 2;
constexpr size_t WS_U     = WS_PBF   + (size_t)2 * MT * 256 * 2;
constexpr size_t WS_X     = WS_U     + (size_t)MT * LD1 * 2;
constexpr size_t WS_AK    = WS_X;
constexpr size_t WS_AV    = WS_AK    + (size_t)4096 * 2048 * 2;
constexpr size_t WS_HK    = WS_AV    + (size_t)4096 * 2048 * 2;
constexpr size_t WS_HV    = WS_HK    + (size_t)4096 * 256 * 2;
constexpr size_t WS_LRUA  = WS_X;
constexpr size_t WS_LRUH  = WS_LRUA  + (size_t)MT * 512 * 2;
constexpr size_t WS_S     = WS_X     + (size_t)64 * 1024 * 1024;
constexpr size_t WS_KCMP  = WS_S;
constexpr size_t WS_VCMP  = WS_KCMP  + (size_t)16 * 256 * 64 * 4;
constexpr size_t WS_AEND  = WS_VCMP  + (size_t)16 * 256 * 64 * 4;
constexpr size_t WS_HEND  = WS_AEND  + (size_t)8 * 64 * 512 * 4;
constexpr size_t WS_HIN   = WS_HEND  + (size_t)8 * 64 * 512 * 4;
constexpr size_t WS_ZLOC  = WS_HIN   + (size_t)8 * 64 * 512 * 4;
constexpr size_t WS_NIN   = WS_ZLOC  + (size_t)2048 * 128 * 4;
constexpr size_t WS_SCAL  = WS_NIN   + (size_t)2048 * 128 * 4;
constexpr size_t WS_VCT   = WS_SCAL  + (size_t)3 * 2048 * 4;
constexpr size_t WS_WAT   = WS_VCT   + (size_t)16 * 64 * 256 * 2;
constexpr size_t WS_WXT   = WS_WAT   + (size_t)8 * 64 * 64 * 2;
constexpr size_t WS_GATES = WS_WXT   + (size_t)8 * 64 * 64 * 2;
constexpr size_t WS_SS    = WS_GATES + (size_t)MT * 8 * 4;
constexpr size_t WS_END   = WS_SS    + (size_t)MT * 4;
constexpr size_t WS_VT    = WS_U     + (size_t)MT * LD0 * 2;
static_assert(WS_VT + (size_t)512 * MT * 2 <= WS_X, "VT region");
static_assert(WS_HV + (size_t)4096 * 256 * 2 <= WS_S, "compress region");
static_assert(WS_LRUH + (size_t)MT * 512 * 2 <= WS_S, "lru region");

constexpr int XCD_BAR_WORDS_C = 3456;
constexpr int CW_QNSA = 3520, CW_QDSA = 3584;
constexpr int CW_NORMCNT = 3712;
constexpr int CW_CMPDONE = 3648;

constexpr int LDS_BYTES = 147456;
constexpr int LDS_CTL_OFF = 0;
constexpr int LDS_WORK_OFF = 128;

DI float bf2f(bf16_t v) { return __uint_as_float(((unsigned)v) << 16); }
DI bf16_t f2bf(float f) { unsigned u = __float_as_uint(f); u += 0x7FFFu + ((u >> 16) & 1u); return (bf16_t)(u >> 16); }
typedef __bf16 bf16v2 __attribute__((ext_vector_type(2)));
typedef float f32x2 __attribute__((ext_vector_type(2)));
DI unsigned pack2(float lo, float hi) { const f32x2 v = {lo, hi}; return __builtin_bit_cast(unsigned, __builtin_convertvector(v, bf16v2)); }
DI float fexp_(float x) { return __builtin_amdgcn_exp2f(x * 1.4426950408889634f); }
DI float sigmoidf_(float x) { return __builtin_amdgcn_rcpf(1.0f + fexp_(-x)); }
DI float siluf_(float x) { return x * __builtin_amdgcn_rcpf(1.0f + fexp_(-x)); }
DI float wave_max(float v) { for (int o = 32; o >= 1; o >>= 1) v = fmaxf(v, __shfl_xor(v, o)); return v; }
DI float wave_sum(float v) { for (int o = 32; o >= 1; o >>= 1) v += __shfl_xor(v, o); return v; }
DI void unpack8(const uint4& v, float (&f)[8]) {
    f[0] = __uint_as_float(v.x << 16); f[1] = __uint_as_float(v.x & 0xFFFF0000u);
    f[2] = __uint_as_float(v.y << 16); f[3] = __uint_as_float(v.y & 0xFFFF0000u);
    f[4] = __uint_as_float(v.z << 16); f[5] = __uint_as_float(v.z & 0xFFFF0000u);
    f[6] = __uint_as_float(v.w << 16); f[7] = __uint_as_float(v.w & 0xFFFF0000u);
}

#define XB_TMO      128
#define XB_XCNT(j)  (256  + 64 * (j))
#define XB_XSUB(j)  (1280 + 64 * (j))
#define XB_XGEN(j)  (2304 + 64 * (j))
#define XB_TOP      3328
#define XB_TOPGEN   3392
#define XCD_BAR_WORDS 3456
#define XB_SPIN_CAP (1u << 22)
static_assert(XCD_BAR_WORDS == XCD_BAR_WORDS_C, "bar words");

__device__ __forceinline__ unsigned xb_ld(unsigned* p)              { return __hip_atomic_load(p, __ATOMIC_RELAXED, __HIP_MEMORY_SCOPE_AGENT); }
__device__ __forceinline__ unsigned xb_add(unsigned* p, unsigned v) { return __hip_atomic_fetch_add(p, v, __ATOMIC_RELAXED, __HIP_MEMORY_SCOPE_AGENT); }
__device__ __forceinline__ unsigned xb_xcc_id() { return (unsigned)__builtin_amdgcn_s_getreg((3 << 11) | 20) & 0xFu; }
#define XB_SPIN(cond, bar) do { unsigned _sp = 0; while (cond) { __builtin_amdgcn_s_sleep(1); \
    if ((++_sp & 255u) == 0u) { if (xb_ld(&(bar)[XB_TMO])) break; if (_sp > XB_SPIN_CAP) { atomicAdd(&(bar)[XB_TMO], 1u); break; } } } } while (0)

struct XcdBarrier { unsigned* bar; unsigned x; volatile LAS unsigned* st; };

__device__ __forceinline__ XcdBarrier xcd_barrier_post(unsigned* bar, volatile LAS unsigned* st) {
    XcdBarrier b; b.bar = bar; b.x = xb_xcc_id(); b.st = st;
    if (threadIdx.x == 0) (void)xb_add(&bar[XB_XCNT(b.x)], 1u);
    return b;
}
__device__ __forceinline__ void xcd_barrier_complete(unsigned* bar, unsigned x, unsigned& nloc, unsigned& nx) {
    const unsigned G = gridDim.x * gridDim.y * gridDim.z;
    unsigned sum, cnt, mine, sp = 0u;
    for (;;) {
        sum = 0u; cnt = 0u; mine = 0u;
#pragma unroll
        for (unsigned j = 0; j < 16; ++j) { const unsigned c = xb_ld(&bar[XB_XCNT(j)]); sum += c; cnt += (c > 0u) ? 1u : 0u; mine = (j == x) ? c : mine; }
        if (sum == G) break;
        __builtin_amdgcn_s_sleep(1);
        if ((++sp & 255u) == 0u) { if (xb_ld(&bar[XB_TMO])) break; if (sp > XB_SPIN_CAP) { atomicAdd(&bar[XB_TMO], 1u); break; } }
    }
    nloc = mine > 0u ? mine : 1u; nx = cnt > 0u ? cnt : 1u;
}
__device__ __forceinline__ void xcd_barrier(const XcdBarrier& b) {
    asm volatile("s_waitcnt vmcnt(0)" ::: "memory");
    __syncthreads();
    if (threadIdx.x == 0) {
        unsigned* bar = b.bar;
        __builtin_amdgcn_s_waitcnt(0);
        unsigned nloc = b.st[0], nx = b.st[1];
        if (nloc == 0u) { xcd_barrier_complete(bar, b.x, nloc, nx); b.st[0] = nloc; b.st[1] = nx; }
        const unsigned old = xb_add(&bar[XB_XSUB(b.x)], 1u);
        const unsigned gen = old / nloc;
        if (old + 1u == (gen + 1u) * nloc) {
            __builtin_amdgcn_fence(__ATOMIC_RELEASE, "agent");
            asm volatile("s_waitcnt vmcnt(0)" ::: "memory");
            const unsigned og = xb_add(&bar[XB_TOP], 1u);
            const unsigned tg = og / nx;
            if (og + 1u == (tg + 1u) * nx) xb_add(&bar[XB_TOPGEN], 1u);
            else XB_SPIN(xb_ld(&bar[XB_TOPGEN]) == tg, bar);
            __builtin_amdgcn_fence(__ATOMIC_ACQUIRE, "agent");
            xb_add(&bar[XB_XGEN(b.x)], 1u);
            asm volatile("s_waitcnt vmcnt(0)" ::: "memory");
        } else {
            XB_SPIN(xb_ld(&bar[XB_XGEN(b.x)]) == gen, bar);
            __builtin_amdgcn_fence(__ATOMIC_ACQUIRE, "agent");
            asm volatile("s_waitcnt vmcnt(0)" ::: "memory");
        }
    }
    __syncthreads();
}

namespace pg8 {
constexpr int BM = 256, BK = 64, HALF = 128, HTB = HALF * BK * 2, STAGE_BYTES = 8 * HTB, NXCD = 8, WGM = 8;
__host__ __device__ __forceinline__ int lds_byte(int r, int c) { const int st = (r >> 4) * 2 + (c >> 5), rr = r & 15, cc = c & 31, ob = rr * 64 + cc * 2; return st * 1024 + (ob ^ (((ob >> 9) & 1) << 5)); }
__host__ __device__ __forceinline__ void stage_rc(int b, int& R, int& C) { const int st = b / 1024, sb = b % 1024, swz = sb ^ (((sb >> 9) & 1) << 5); R = (st >> 1) * 16 + swz / 64; C = (st & 1) * 32 + (swz % 64) / 2; }
__host__ __device__ __forceinline__ int perm32(int rho) { const int n = rho >> 4, i = rho & 15; return 8 * (i >> 2) + 4 * n + (i & 3); }
struct Unit { int pm, pn; };
struct Gemm { const bf16_t* A; const bf16_t* Bt; int M, N, K; };
struct StaticOrder {
    int nM, nN, nwg, G, c;
    __host__ __device__ __forceinline__ void init(int M, int N, int G_, int c_) { nM = M / BM; nN = N / BM; nwg = nM * nN; G = G_; c = c_; }
    __host__ __device__ __forceinline__ bool next(int i, Unit& u) const {
        const long L = (long)i * G + c; if (L >= nwg) return false;
        int wgid = (int)L; { const int q = nwg / NXCD, r = nwg % NXCD, xcd = wgid % NXCD, off = wgid / NXCD; wgid = (xcd < r ? xcd * (q + 1) : r * (q + 1) + (xcd - r) * q) + off; }
        const int nig = WGM * nN, gid = wgid / nig, fm = gid * WGM, gsz = (nM - fm) < WGM ? (nM - fm) : WGM;
        u.pm = fm + ((wgid % nig) % gsz); u.pn = (wgid % nig) / gsz; return true;
    }
    __device__ __forceinline__ void a_ready(const Unit&) const {}
    __device__ __forceinline__ void done(const Unit&) const {}
};
template <class Epi, class Sched>
__device__ __forceinline__ void gemm_phase(LAS unsigned char* lds, const Gemm g, const Sched& S, const Epi& E) {
    int tid_ = threadIdx.x; asm volatile("" : "+v"(tid_));
    const int tid = tid_, wid = __builtin_amdgcn_readfirstlane(tid >> 6), lane = tid & 63, wr = wid >> 2, wc = wid & 3, fr = lane & 15, fq = lane >> 4;
    const int K = g.K, nt = K / BK;
    unsigned voffA[2], voffB[2];
#pragma unroll
    for (int i = 0; i < 2; ++i) { int R, C; stage_rc(tid * 16 + i * 8192, R, C); const int Rb = Epi::PERM ? ((R & ~31) + perm32(R & 31)) : R;
        voffA[i] = (unsigned)(R * K + C) * 2u; voffB[i] = (unsigned)(Rb * K + C) * 2u; }
    const size_t kstep = (size_t)(BK * 2);
    const size_t hstep = (size_t)HALF * K * 2;
    const size_t tstep = 2 * hstep;
    const unsigned ldsw = (unsigned)wid * 1024u;
    const int aoff = lds_byte(wr * 64 + fr, fq * 8), boff = lds_byte(wc * 32 + fr, fq * 8);
#define PG8_SA(b, h) (((b) * 2 + (h)) * HTB)
#define PG8_SB(b, h) ((4 + (b) * 2 + (h)) * HTB)
#define PG8_STAGE(bufoff, gbase, voff) do { _Pragma("unroll") for (int _i = 0; _i < 2; ++_i) \
        __builtin_amdgcn_global_load_lds((const unsigned*)((const char*)(gbase) + (voff)[_i]), (LAS unsigned*)(lds + (bufoff) + ldsw + _i * 8192), 16, 0, 0); } while (0)
#define PG8_LDA(dst, b, h) do { _Pragma("unroll") for (int m = 0; m < 4; ++m) _Pragma("unroll") for (int k = 0; k < 2; ++k) dst[m][k] = *(const LAS bf16x8*)(lds + PG8_SA(b, h) + aoff + m * 2048 + k * 1024); } while (0)
#define PG8_LDB(dst, b, h) do { _Pragma("unroll") for (int n = 0; n < 2; ++n) _Pragma("unroll") for (int k = 0; k < 2; ++k) dst[n][k] = *(const LAS bf16x8*)(lds + PG8_SB(b, h) + boff + n * 2048 + k * 1024); } while (0)
#define PG8_MMA(ai, bj, At, Bt) do { __builtin_amdgcn_s_setprio(1); _Pragma("unroll") for (int m = 0; m < 4; ++m) _Pragma("unroll") for (int n = 0; n < 2; ++n) _Pragma("unroll") for (int k = 0; k < 2; ++k) \
        acc[ai][bj][m][n] = __builtin_amdgcn_mfma_f32_16x16x32_bf16(Bt[n][k], At[m][k], acc[ai][bj][m][n], 0, 0, 0); __builtin_amdgcn_s_setprio(0); } while (0)
#define PG8_WAIT_V(n) asm volatile("s_waitcnt vmcnt(" #n ")" ::: "memory")
#define PG8_WAIT_L(n) asm volatile("s_waitcnt lgkmcnt(" #n ")" ::: "memory")
#define PG8_BAR __builtin_amdgcn_s_barrier()
#define PG8_SCHED __builtin_amdgcn_sched_barrier(0)
    Unit cur, nxt; int ui = 0;
    if (!S.next(0, cur)) return;
    f32x4 acc[2][2][4][2];
#pragma unroll
    for (int a = 0; a < 2; ++a)
#pragma unroll
        for (int b = 0; b < 2; ++b)
#pragma unroll
            for (int m = 0; m < 4; ++m)
#pragma unroll
                for (int n = 0; n < 2; ++n) acc[a][b][m][n] = (f32x4){0.f, 0.f, 0.f, 0.f};
    bf16x8 At[4][2], B0[2][2], B1[2][2];
    const char* cA = (const char*)g.A + (size_t)cur.pm * tstep; const char* cB = (const char*)g.Bt + (size_t)cur.pn * tstep;
    S.a_ready(cur);
    PG8_STAGE(PG8_SB(0, 0), cB, voffB); PG8_STAGE(PG8_SA(0, 0), cA, voffA); PG8_STAGE(PG8_SB(0, 1), cB + hstep, voffB); PG8_STAGE(PG8_SA(0, 1), cA + hstep, voffA);
    if (wr == 1) PG8_BAR;
    PG8_WAIT_V(4); PG8_BAR;
    PG8_STAGE(PG8_SB(1, 0), cB + kstep, voffB); PG8_STAGE(PG8_SA(1, 0), cA + kstep, voffA); PG8_STAGE(PG8_SB(1, 1), cB + hstep + kstep, voffB);
    PG8_WAIT_V(6); PG8_BAR;
    for (;;) {
        const bool has_next = S.next(ui + 1, nxt);
        const char* nA = has_next ? (const char*)g.A + (size_t)nxt.pm * tstep : cA; const char* nB = has_next ? (const char*)g.Bt + (size_t)nxt.pn * tstep : cB;
        for (int t = 0; t < nt; t += 2) {
            const bool last = (t == nt - 2);
            const char* a1 = cA + (size_t)(t + 1) * kstep;
            const char* a2 = last ? nA : cA + (size_t)(t + 2) * kstep; const char* b2 = last ? nB : cB + (size_t)(t + 2) * kstep;
            const char* a3 = a2 + kstep; const char* b3 = b2 + kstep;
            if (last && has_next) S.a_ready(nxt);
            PG8_LDB(B0, 0, 0); PG8_SCHED; PG8_LDA(At, 0, 0); PG8_STAGE(PG8_SA(1, 1), a1 + hstep, voffA);
            PG8_WAIT_L(8); PG8_BAR; PG8_WAIT_L(0); PG8_MMA(0, 0, At, B0); PG8_BAR; PG8_SCHED;
            PG8_LDB(B1, 0, 1); PG8_STAGE(PG8_SB(0, 0), b2, voffB);
            PG8_BAR; PG8_WAIT_L(0); PG8_MMA(0, 1, At, B1); PG8_BAR;
            PG8_LDA(At, 0, 1); PG8_STAGE(PG8_SA(0, 0), a2, voffA);
            PG8_BAR; PG8_WAIT_L(0); PG8_MMA(1, 0, At, B0); PG8_BAR; PG8_SCHED;
            PG8_STAGE(PG8_SB(0, 1), b2 + hstep, voffB);
            PG8_WAIT_V(6); PG8_BAR; PG8_MMA(1, 1, At, B1); PG8_BAR;
            PG8_LDB(B0, 1, 0); PG8_SCHED; PG8_LDA(At, 1, 0); PG8_STAGE(PG8_SA(0, 1), a2 + hstep, voffA);
            PG8_WAIT_L(8); PG8_BAR; PG8_WAIT_L(0); PG8_MMA(0, 0, At, B0); PG8_BAR; PG8_SCHED;
            PG8_LDB(B1, 1, 1); PG8_STAGE(PG8_SB(1, 0), b3, voffB);
            PG8_BAR; PG8_WAIT_L(0); PG8_MMA(0, 1, At, B1); PG8_BAR;
            PG8_LDA(At, 1, 1); PG8_STAGE(PG8_SA(1, 0), a3, voffA);
            PG8_BAR; PG8_WAIT_L(0); PG8_MMA(1, 0, At, B0); PG8_BAR; PG8_SCHED;
            PG8_STAGE(PG8_SB(1, 1), b3 + hstep, voffB);
            PG8_WAIT_V(6); PG8_BAR; PG8_MMA(1, 1, At, B1); PG8_BAR;
        }
        E(acc, cur, wr, wc, fr, fq); S.done(cur);
        if (!has_next) break;
#pragma unroll
        for (int a = 0; a < 2; ++a)
#pragma unroll
            for (int b = 0; b < 2; ++b)
#pragma unroll
                for (int m = 0; m < 4; ++m)
#pragma unroll
                    for (int n = 0; n < 2; ++n) acc[a][b][m][n] = (f32x4){0.f, 0.f, 0.f, 0.f};
        cur = nxt; cA = nA; cB = nB; ++ui;
    }
    PG8_WAIT_V(0);
    if (wr == 0) PG8_BAR;
    PG8_BAR;
#undef PG8_SA
#undef PG8_SB
#undef PG8_STAGE
#undef PG8_LDA
#undef PG8_LDB
#undef PG8_MMA
#undef PG8_WAIT_V
#undef PG8_WAIT_L
#undef PG8_BAR
#undef PG8_SCHED
}

template <int ACT  > struct EpiBf16 {
    static constexpr bool PERM = true;
    bf16_t* O; int ldc;
    __device__ __forceinline__ void operator()(const f32x4 (&acc)[2][2][4][2], const Unit& u, int wr, int wc, int fr, int fq) const {
        const int row0 = u.pm * BM + wr * 64 + fr, col0 = u.pn * BM + wc * 32 + 8 * fq;
#pragma unroll
        for (int ai = 0; ai < 2; ++ai)
#pragma unroll
            for (int m = 0; m < 4; ++m) { bf16_t* rowp = O + (size_t)(row0 + ai * HALF + m * 16) * ldc + col0;
#pragma unroll
                for (int bj = 0; bj < 2; ++bj) { f32x4 v0 = acc[ai][bj][m][0], v1 = acc[ai][bj][m][1];
                    if (ACT == 1) { for (int i = 0; i < 4; ++i) { v0[i] = siluf_(v0[i]); v1[i] = siluf_(v1[i]); } }
                    uint4 o; o.x = pack2(v0[0], v0[1]); o.y = pack2(v0[2], v0[3]); o.z = pack2(v1[0], v1[1]); o.w = pack2(v1[2], v1[3]);
                    *(uint4*)(rowp + bj * HALF) = o; } }
    }
};
struct EpiF32 {
    static constexpr bool PERM = false;
    float* C; int ldc;
    __device__ __forceinline__ void operator()(const f32x4 (&acc)[2][2][4][2], const Unit& u, int wr, int wc, int fr, int fq) const {
        const int row0 = u.pm * BM + wr * 64 + fr, col0 = u.pn * BM + wc * 32 + 4 * fq;
#pragma unroll
        for (int ai = 0; ai < 2; ++ai)
#pragma unroll
            for (int m = 0; m < 4; ++m) { float* rowp = C + (size_t)(row0 + ai * HALF + m * 16) * ldc + col0;
#pragma unroll
                for (int bj = 0; bj < 2; ++bj)
#pragma unroll
                    for (int n = 0; n < 2; ++n) *(f32x4*)(rowp + bj * HALF + n * 16) = acc[ai][bj][m][n]; }
    }
};
template <int IN_BF16> struct EpiResid {
    static constexpr bool PERM = true;
    const float* Xi; const bf16_t* Xib; bf16_t* Ob;
    __device__ __forceinline__ void operator()(const f32x4 (&acc)[2][2][4][2], const Unit& u, int wr, int wc, int fr, int fq) const {
        const int row0 = u.pm * BM + wr * 64 + fr, col0 = u.pn * BM + wc * 32 + 8 * fq;
#pragma unroll
        for (int ai = 0; ai < 2; ++ai)
#pragma unroll
            for (int m = 0; m < 4; ++m) { const size_t ro = (size_t)(row0 + ai * HALF + m * 16) * 1024 + col0;
#pragma unroll
                for (int bj = 0; bj < 2; ++bj) { const size_t o = ro + bj * HALF;
                    f32x4 x0, x1;
                    if (IN_BF16) { const uint4 xv = *(const uint4*)(Xib + o); float xf[8]; unpack8(xv, xf); x0 = (f32x4){xf[0], xf[1], xf[2], xf[3]}; x1 = (f32x4){xf[4], xf[5], xf[6], xf[7]}; }
                    else { x0 = *(const f32x4*)(Xi + o); x1 = *(const f32x4*)(Xi + o + 4); }
                    const f32x4 v0 = x0 + acc[ai][bj][m][0], v1 = x1 + acc[ai][bj][m][1];
                    uint4 pk; pk.x = pack2(v0[0], v0[1]); pk.y = pack2(v0[2], v0[3]); pk.z = pack2(v1[0], v1[1]); pk.w = pack2(v1[2], v1[3]); *(uint4*)(Ob + o) = pk; } }
    }
};
template <int OUT_BF16> struct EpiGate {
    static constexpr bool PERM = true;
    float* X; bf16_t* Xb; const bf16_t* R; const bf16_t* E;
    __device__ __forceinline__ void operator()(const f32x4 (&acc)[2][2][4][2], const Unit& u, int wr, int wc, int fr, int fq) const {
        const int row0 = u.pm * BM + wr * 64 + fr, col0 = u.pn * BM + wc * 32 + 8 * fq;
#pragma unroll
        for (int ai = 0; ai < 2; ++ai)
#pragma unroll
            for (int m = 0; m < 4; ++m) { const size_t ro = (size_t)(row0 + ai * HALF + m * 16) * 1024 + col0;
#pragma unroll
                for (int bj = 0; bj < 2; ++bj) { const size_t o = ro + bj * HALF;
                    const uint4 ev = *(const uint4*)(E + o), rv = *(const uint4*)(R + o); float ef[8], rf[8]; unpack8(ev, ef); unpack8(rv, rf);
                    float v[8];
#pragma unroll
                    for (int n = 0; n < 2; ++n)
#pragma unroll
                        for (int i = 0; i < 4; ++i) v[4 * n + i] = rf[4 * n + i] + ef[4 * n + i] * sigmoidf_(acc[ai][bj][m][n][i]);
                    if (OUT_BF16) { uint4 pk; pk.x = pack2(v[0], v[1]); pk.y = pack2(v[2], v[3]); pk.z = pack2(v[4], v[5]); pk.w = pack2(v[6], v[7]); *(uint4*)(Xb + o) = pk; }
                    else { *(f32x4*)(X + o) = (f32x4){v[0], v[1], v[2], v[3]}; *(f32x4*)(X + o + 4) = (f32x4){v[4], v[5], v[6], v[7]}; } } }
    }
};
struct EpiGateNorm {
    static constexpr bool PERM = true;
    float* X; const bf16_t* R; const bf16_t* E; const float* wn; float* SS; unsigned* cnt; unsigned* tmo;
    __device__ __forceinline__ void operator()(f32x4 (&acc)[2][2][4][2], const Unit& u, int wr, int wc, int fr, int fq) const {
        const int row0 = u.pm * BM + wr * 64 + fr, col0 = u.pn * BM + wc * 32 + 8 * fq;
#pragma unroll
        for (int ai = 0; ai < 2; ++ai)
#pragma unroll
            for (int m = 0; m < 4; ++m) { const int row = row0 + ai * HALF + m * 16; const size_t ro = (size_t)row * 1024 + col0; float ss = 0.f;
#pragma unroll
                for (int bj = 0; bj < 2; ++bj) { const size_t o = ro + bj * HALF;
                    const uint4 ev = *(const uint4*)(E + o), rv = *(const uint4*)(R + o); float ef[8], rf[8]; unpack8(ev, ef); unpack8(rv, rf);
#pragma unroll
                    for (int n = 0; n < 2; ++n)
#pragma unroll
                        for (int i = 0; i < 4; ++i) { const float v = rf[4 * n + i] + ef[4 * n + i] * sigmoidf_(acc[ai][bj][m][n][i]); acc[ai][bj][m][n][i] = v; ss += v * v; } }
                ss += __shfl_xor(ss, 16); ss += __shfl_xor(ss, 32);
                if (fq == 0) (void)__hip_atomic_fetch_add(SS + row, ss, __ATOMIC_RELAXED, __HIP_MEMORY_SCOPE_AGENT); }
        asm volatile("s_waitcnt vmcnt(0)" ::: "memory");
        if ((fr | fq) == 0) (void)__hip_atomic_fetch_add(cnt + 2 * u.pm + wr, 1u, __ATOMIC_RELAXED, __HIP_MEMORY_SCOPE_AGENT);
        f32x4 w[2][2];
#pragma unroll
        for (int bj = 0; bj < 2; ++bj) { w[bj][0] = *(const f32x4*)(wn + col0 + bj * HALF); w[bj][1] = *(const f32x4*)(wn + col0 + bj * HALF + 4); }
        { unsigned sp = 0;
          while (__hip_atomic_load(cnt + 2 * u.pm + wr, __ATOMIC_RELAXED, __HIP_MEMORY_SCOPE_AGENT) < 16u) { __builtin_amdgcn_s_sleep(1);
              if (++sp > (1u << 22)) { if ((fr | fq) == 0) atomicAdd(tmo, 1u); break; } } }
        asm volatile("" ::: "memory");
#pragma unroll
        for (int ai = 0; ai < 2; ++ai)
#pragma unroll
            for (int m = 0; m < 4; ++m) { const int row = row0 + ai * HALF + m * 16; const size_t ro = (size_t)row * 1024 + col0;
                const float rs = rsqrtf(__hip_atomic_load(SS + row, __ATOMIC_RELAXED, __HIP_MEMORY_SCOPE_AGENT) * (1.0f / 1024.0f) + 1e-6f);
#pragma unroll
                for (int bj = 0; bj < 2; ++bj) { const size_t o = ro + bj * HALF;
                    *(f32x4*)(X + o) = acc[ai][bj][m][0] * rs * w[bj][0]; *(f32x4*)(X + o + 4) = acc[ai][bj][m][1] * rs * w[bj][1]; } }
    }
};
}

struct Args { const float* in[28]; float* out; unsigned char* ws; int ph_lo, ph_hi; };

struct Frame {
    int tid, lane, wave, G, bid, gw, nw;
    unsigned char* lds;
    unsigned* ctl;
    const float* in[28]; float* out; unsigned char* ws;
    const LAS unsigned char* lut;
    const LAS float* tbl;
    const LAS float* biasL;
    LAS unsigned char* ldsl;
};
DI int t5b(const Frame& F, int n) { return n < 16 ? n : (n >= 113 ? 31 : (int)F.lut[n]); }

DI bool phase_refresh(Frame& F) { int t_ = threadIdx.x; asm volatile("" : "+v"(t_)); F.tid = t_; F.lane = t_ & 63; return true; }
struct TDesc { const float* src; bf16_t* dst; int K, Nsrc, Npad, mapk, ntiles; };
DI int tmap(int kind, int n) { return kind == 0 ? n : (kind == 1 ? map0(n) : (kind == 2 ? map1(n) : mapv(n))); }
DI void transpose_all(const Frame& F) {
    unsigned char* ws = F.ws;
    float* tile = (float*)F.lds;
    TDesc D[11];
    D[0] = TDesc{F.in[7], (bf16_t*)(ws + WS_WIN0), 1024, 3292, LD0, 1, 0};
    D[1] = TDesc{F.in[7], (bf16_t*)(ws + WS_WVT), 1024, 3292, 512, 3, 0};
    D[2] = TDesc{F.in[8], (bf16_t*)(ws + WS_WOUT0), 1024, 1024, 1024, 0, 0};
    D[3] = TDesc{F.in[5], (bf16_t*)(ws + WS_WG0), 1024, 1024, 1024, 0, 0};
    D[4] = TDesc{F.in[5] + (size_t)1024 * 1024, (bf16_t*)(ws + WS_WG1), 1024, 1024, 1024, 0, 0};
    D[5] = TDesc{F.in[4], (bf16_t*)(ws + WS_WP0), 256, 1024, 1024, 0, 0};
    D[6] = TDesc{F.in[4] + (size_t)256 * 1024, (bf16_t*)(ws + WS_WP1), 256, 1024, 1024, 0, 0};
    D[7] = TDesc{F.in[15], (bf16_t*)(ws + WS_WIN1), 1024, 3592, LD1, 2, 0};
    D[8] = TDesc{F.in[16], (bf16_t*)(ws + WS_WOUT1), 1024, 1024, 1024, 0, 0};
    D[9] = TDesc{F.in[10], (bf16_t*)(ws + WS_WC1K), 2048, 256, 256, 0, 0};
    D[10] = TDesc{F.in[13], (bf16_t*)(ws + WS_WC1V), 2048, 256, 256, 0, 0};
    int total = 0;
#pragma unroll
    for (int i = 0; i < 11; ++i) { D[i].ntiles = (D[i].Npad / 64) * (D[i].K / 64); total += D[i].ntiles; }
    float rg[8];
    auto locate = [&](int tix, TDesc& d, int& nt, int& kt) { int rem = tix;
#pragma unroll
        for (int i = 0; i < 11; ++i) { if (rem >= 0 && rem < D[i].ntiles) { d = D[i]; const int ntk = d.K / 64; nt = rem / ntk; kt = rem % ntk; rem = -1; } else if (rem >= 0) rem -= D[i].ntiles; } };
    auto load = [&](int tix) { TDesc d; int nt = 0, kt = 0; locate(tix, d, nt, kt);
#pragma unroll
        for (int q = 0; q < 8; ++q) { const int e = F.tid + q * 512; const int kk = e >> 6, nn = e & 63; const int col = tmap(d.mapk, nt * 64 + nn);
            rg[q] = col >= 0 ? d.src[(size_t)(kt * 64 + kk) * d.Nsrc + col] : 0.f; } };
    int tix = F.bid; int buf = 0;
    if (tix < total) load(tix);
    for (; tix < total; tix += F.G) {
        float* tl = tile + buf * (64 * 65);
#pragma unroll
        for (int q = 0; q < 8; ++q) { const int e = F.tid + q * 512; tl[(e >> 6) * 65 + (e & 63)] = rg[q]; }
        __syncthreads();
        TDesc d; int nt = 0, kt = 0; locate(tix, d, nt, kt);
        if (tix + F.G < total) load(tix + F.G);
#pragma unroll
        for (int q = 0; q < 8; ++q) { const int e = F.tid + q * 512; const int nn = e >> 6, kk = e & 63;
            d.dst[(size_t)(nt * 64 + nn) * d.K + kt * 64 + kk] = f2bf(tl[kk * 65 + nn]); }
        buf ^= 1;
    }
    __syncthreads();
}
template <int OUTF>
DI void rmsnorm_rows(const Frame& F, const float* X, const float* g, bf16_t* Ob, float* Of) {
    f32x4 gg[4];
#pragma unroll
    for (int i = 0; i < 4; ++i) gg[i] = *(const f32x4*)(g + i * 256 + F.lane * 4);
    for (int row0 = F.gw * 4; row0 < MT; row0 += F.nw * 4) {
        f32x4 v[4][4]; float ss[4];
#pragma unroll
        for (int r = 0; r < 4; ++r)
#pragma unroll
            for (int i = 0; i < 4; ++i) v[r][i] = *(const f32x4*)(X + (size_t)(row0 + r) * 1024 + i * 256 + F.lane * 4);
#pragma unroll
        for (int r = 0; r < 4; ++r) { float a = 0.f;
#pragma unroll
            for (int i = 0; i < 4; ++i) a += v[r][i][0] * v[r][i][0] + v[r][i][1] * v[r][i][1] + v[r][i][2] * v[r][i][2] + v[r][i][3] * v[r][i][3];
            ss[r] = a; }
#pragma unroll
        for (int o = 32; o >= 1; o >>= 1) {
#pragma unroll
            for (int r = 0; r < 4; ++r) ss[r] += __shfl_xor(ss[r], o); }
#pragma unroll
        for (int r = 0; r < 4; ++r) { const float rs = rsqrtf(ss[r] * (1.0f / 1024.0f) + 1e-6f);
#pragma unroll
            for (int i = 0; i < 4; ++i) { f32x4 y;
#pragma unroll
                for (int j = 0; j < 4; ++j) y[j] = v[r][i][j] * rs * gg[i][j];
                if (OUTF) *(f32x4*)(Of + (size_t)(row0 + r) * 1024 + i * 256 + F.lane * 4) = y;
                else { uint2 pk; pk.x = pack2(y[0], y[1]); pk.y = pack2(y[2], y[3]); *(uint2*)(Ob + (size_t)(row0 + r) * 1024 + i * 256 + F.lane * 4) = pk; } } }
    }
}
DI void rmsnorm_gates(const Frame& F, const bf16_t* X, const float* g, bf16_t* Ob) {
    const float* W = F.in[15]; float* gts = (float*)(F.ws + WS_GATES);
    float wg[2][8][8]; float gg[2][8];
#pragma unroll
    for (int i = 0; i < 2; ++i)
#pragma unroll
        for (int e = 0; e < 8; ++e) { const int k = i * 512 + F.lane * 8 + e; const f32x4 a = *(const f32x4*)(W + (size_t)k * 3592 + 2560), b = *(const f32x4*)(W + (size_t)k * 3592 + 2564);
            wg[i][e][0] = a[0]; wg[i][e][1] = a[1]; wg[i][e][2] = a[2]; wg[i][e][3] = a[3]; wg[i][e][4] = b[0]; wg[i][e][5] = b[1]; wg[i][e][6] = b[2]; wg[i][e][7] = b[3]; gg[i][e] = g[k]; }
    for (int row0 = F.gw * 2; row0 < MT; row0 += F.nw * 2) {
        uint4 xv[2][2]; float ss[2];
#pragma unroll
        for (int r = 0; r < 2; ++r)
#pragma unroll
            for (int i = 0; i < 2; ++i) xv[r][i] = *(const uint4*)(X + (size_t)(row0 + r) * 1024 + i * 512 + F.lane * 8);
        float xf[2][2][8];
#pragma unroll
        for (int r = 0; r < 2; ++r) { float a = 0.f;
#pragma unroll
            for (int i = 0; i < 2; ++i) { unpack8(xv[r][i], xf[r][i]);
#pragma unroll
                for (int e = 0; e < 8; ++e) a += xf[r][i][e] * xf[r][i][e]; }
            ss[r] = a; }
#pragma unroll
        for (int o = 32; o >= 1; o >>= 1) { ss[0] += __shfl_xor(ss[0], o); ss[1] += __shfl_xor(ss[1], o); }
#pragma unroll
        for (int r = 0; r < 2; ++r) { const int row = row0 + r;
            const float rs = rsqrtf(ss[r] * (1.0f / 1024.0f) + 1e-6f);
            float pg[8] = {0.f, 0.f, 0.f, 0.f, 0.f, 0.f, 0.f, 0.f};
#pragma unroll
            for (int i = 0; i < 2; ++i) { float y[8];
#pragma unroll
                for (int e = 0; e < 8; ++e) { y[e] = xf[r][i][e] * rs * gg[i][e];
#pragma unroll
                    for (int j = 0; j < 8; ++j) pg[j] += y[e] * wg[i][e][j]; }
                uint4 pk; pk.x = pack2(y[0], y[1]); pk.y = pack2(y[2], y[3]); pk.z = pack2(y[4], y[5]); pk.w = pack2(y[6], y[7]); *(uint4*)(Ob + (size_t)row * 1024 + i * 512 + F.lane * 8) = pk; }
#pragma unroll
            for (int o = 32; o >= 1; o >>= 1) {
#pragma unroll
                for (int j = 0; j < 8; ++j) pg[j] += __shfl_xor(pg[j], o); }
            float mine = 0.f;
#pragma unroll
            for (int j = 0; j < 8; ++j) if (F.lane == j) mine = pg[j];
            if (F.lane < 8) gts[(size_t)row * 8 + F.lane] = mine; }
    }
}
DI void p0_prologue(const Frame& F) {
    unsigned char* ws = F.ws;
    transpose_all(F);
    { bf16_t* wat = (bf16_t*)(ws + WS_WAT); bf16_t* wxt = (bf16_t*)(ws + WS_WXT);
      for (int idx = F.bid * 512 + F.tid; idx < 8 * 64 * 64; idx += F.G * 512) { const int g = idx >> 12, j = (idx >> 6) & 63, i = idx & 63;
          wat[idx] = f2bf(F.in[19][(size_t)(g * 64 + i) * 64 + j]); wxt[idx] = f2bf(F.in[21][(size_t)(g * 64 + i) * 64 + j]); } }
    { float* ssz = (float*)(ws + WS_SS); for (int i = F.bid * 512 + F.tid; i < MT; i += F.G * 512) ssz[i] = 0.f; }
    rmsnorm_rows<0>(F, F.in[0], F.in[2], (bf16_t*)(ws + WS_BFA), nullptr);
    { const float* p = F.in[1]; bf16_t* pb = (bf16_t*)(ws + WS_PBF); const size_t n8 = (size_t)2 * MT * 256 / 8;
      for (size_t i = (size_t)F.bid * 512 + F.tid; i < n8; i += (size_t)F.G * 512) {
          const f32x4 a = *(const f32x4*)(p + i * 8), b = *(const f32x4*)(p + i * 8 + 4);
          uint4 o; o.x = pack2(a[0], a[1]); o.y = pack2(a[2], a[3]); o.z = pack2(b[0], b[1]); o.w = pack2(b[2], b[3]); *(uint4*)(pb + i * 8) = o; } }
}

DI void p2a_build_blocks(const Frame& F) {
    { const int gt = F.bid * 512 + F.tid;
      if (gt < 1024) { const int bg = gt >> 6, d = gt & 63; ((float*)(F.ws + WS_KCMP))[((size_t)bg * 256 + 255) * 64 + d] = 0.f; ((float*)(F.ws + WS_VCMP))[((size_t)bg * 256 + 255) * 64 + d] = 0.f;
          ((bf16_t*)(F.ws + WS_VCT))[((size_t)bg * 64 + d) * 256 + 255] = 0; } }
    const bf16_t* U = (const bf16_t*)(F.ws + WS_U);
    bf16_t* AK = (bf16_t*)(F.ws + WS_AK); bf16_t* AV = (bf16_t*)(F.ws + WS_AV);
    const float* posk = F.in[9]; const float* posv = F.in[12];
    const size_t nitem = (size_t)2 * 4096 * 32 * 8;
    for (size_t it = (size_t)F.bid * 512 + F.tid; it < nitem; it += (size_t)F.G * 512) {
        const int c8 = (int)(it & 7), l = (int)((it >> 3) & 31), r = (int)((it >> 8) & 4095), which = (int)(it >> 20);
        bf16_t* dst = (which ? AV : AK) + (size_t)r * 2048 + l * 64 + c8 * 8;
        uint4 o = make_uint4(0u, 0u, 0u, 0u);
        if (r < 4080) {
            const int b = r / 510, rem = r % 510, i = rem >> 1, g = rem & 1;
            const bf16_t* sp = U + ((size_t)b * SEQ + 16 * i + l) * LD0 + (which ? C_VC : C_KC) + g * 64 + c8 * 8;
            const float* pp = (which ? posv : posk) + l * 64 + c8 * 8;
            const uint4 v = *(const uint4*)sp; float f[8]; unpack8(v, f);
            o.x = pack2(f[0] + pp[0], f[1] + pp[1]); o.y = pack2(f[2] + pp[2], f[3] + pp[3]); o.z = pack2(f[4] + pp[4], f[5] + pp[5]); o.w = pack2(f[6] + pp[6], f[7] + pp[7]);
        }
        *(uint4*)dst = o;
    }
}
DI void p2c_compress_rows(const Frame& F, int which, int row0) {
    const bf16_t* H = (const bf16_t*)(F.ws + (which ? WS_HV : WS_HK));
    float* OUT = (float*)(F.ws + (which ? WS_VCMP : WS_KCMP));
    const float* w2 = which ? F.in[14] : F.in[11];
    for (int rr = F.wave; rr < 256; rr += 8) {
        const int r = row0 + rr; if (r >= 4080) break;
        const int b = r / 510, rem = r % 510, i = rem >> 1, g = rem & 1, bg = b * 2 + g;
        const bf16_t* hr = H + (size_t)r * 256; float acc = 0.f;
        for (int j = 0; j < 256; j += 8) { const uint4 hv = *(const uint4*)(hr + j); float hf[8]; unpack8(hv, hf);
#pragma unroll
            for (int q = 0; q < 8; ++q) acc += hf[q] * w2[(size_t)(j + q) * 64 + F.lane]; }
        OUT[((size_t)bg * 256 + i) * 64 + F.lane] = acc;
        if (which) ((bf16_t*)(F.ws + WS_VCT))[((size_t)bg * 64 + F.lane) * 256 + i] = f2bf(acc);
    }
}

typedef float f32x16 __attribute__((ext_vector_type(16)));
#define MFMA32(a, b, c) __builtin_amdgcn_mfma_f32_32x32x16_bf16((a), (b), (c), 0, 0, 0)
constexpr float LOG2E = 1.4426950408889634f;
constexpr float QK_C1 = 0.125f * LOG2E;
constexpr int AT_BUF = 0;
constexpr int AT_PSUM = 65536;
constexpr int AT_XM = AT_PSUM + 16384;
constexpr int AT_SELM = AT_PSUM + 65536;
constexpr int AT_MISC = AT_SELM + 1024;
constexpr int AT_END = AT_MISC + 64 + 2048;
static_assert(AT_END + LDS_WORK_OFF <= LDS_BYTES - 12288, "attention lds");
enum { FL_NEAR = 1, FL_CAUSAL = 2, FL_WINLO = 4, FL_BITS = 8, FL_LANE = 16 };

struct Att { float m, l; f32x16 o0, o1; };
DI void att_init(Att& a) { a.m = NEG_INF; a.l = 0.f;
#pragma unroll
    for (int i = 0; i < 16; ++i) { a.o0[i] = 0.f; a.o1[i] = 0.f; } }

typedef unsigned u32x4 __attribute__((ext_vector_type(4)));
#define OPAQUE(x) asm volatile("" : "+v"(x))
DI void st_write_K(LAS unsigned char* Kt, int tid, const uint4& rg) {
    OPAQUE(tid);
    const int key = tid >> 3, c = tid & 7;
    const u32x4 v = {rg.x, rg.y, rg.z, rg.w};
    *(LAS u32x4*)(Kt + (key ^ ((key >> 3) & 1)) * 128 + ((c ^ (key & 7)) << 4)) = v;
}
DI void st_write_VT(LAS unsigned char* Vt, int tid, const uint4& rg) {
    OPAQUE(tid);
    const int d = tid >> 3, m = tid & 7, G = m >> 1, a = m & 1, sw = (d >> 1) & 7;
    typedef unsigned u32x2 __attribute__((ext_vector_type(2)));
    const u32x2 lo = {rg.x, rg.y}, hi = {rg.z, rg.w};
    *(LAS u32x2*)(Vt + d * 128 + (((2 * G) ^ sw) << 4) + 8 * a) = lo;
    *(LAS u32x2*)(Vt + d * 128 + (((2 * G + 1) ^ sw) << 4) + 8 * a) = hi;
}
template <bool CINIT = false>
DI void qk_tile(const LAS unsigned char* Kt, const bf16x8 (&qf)[4], int r, int hf, f32x16& s0, f32x16& s1) {
    OPAQUE(r); OPAQUE(hf);
    const f32x16 zero16 = {0.f, 0.f, 0.f, 0.f, 0.f, 0.f, 0.f, 0.f, 0.f, 0.f, 0.f, 0.f, 0.f, 0.f, 0.f, 0.f};
#pragma unroll
    for (int s = 0; s < 4; ++s) {
        const int c = 2 * s + hf;
        const int pr = r ^ ((r >> 3) & 1);
        const bf16x8 a0 = *(const LAS bf16x8*)(Kt + pr * 128 + ((c ^ (r & 7)) << 4));
        const bf16x8 a1 = *(const LAS bf16x8*)(Kt + (32 + pr) * 128 + ((c ^ (r & 7)) << 4));
        if (s == 0 && !CINIT) { s0 = MFMA32(a0, qf[0], zero16); s1 = MFMA32(a1, qf[0], zero16); }
        else { s0 = MFMA32(a0, qf[s], s0); s1 = MFMA32(a1, qf[s], s1); }
    }
}
template <int FLAGS>
DI void fix_scores(f32x16& s, int posb, int kstep, int tq, const LAS float* bl, float bfar, unsigned mword, bool laneok, int hf) {
    OPAQUE(hf); OPAQUE(tq);
#pragma unroll
    for (int i = 0; i < 16; ++i) {
        const int koff = (i & 3) + 8 * (i >> 2) + 4 * hf;
        const int dist = tq - (posb + kstep * koff);
        float bias = bfar;
        if (FLAGS & FL_NEAR) { int dd = dist < 0 ? 0 : dist; dd = dd > 127 ? 127 : dd; bias = bl[dd]; }
        const float v = s[i] * QK_C1 + bias;
        bool ok = true;
        if (FLAGS & FL_CAUSAL) ok = ok && (dist >= 0);
        if (FLAGS & FL_WINLO) ok = ok && (dist < 512);
        if (FLAGS & FL_BITS) ok = ok && (((mword >> koff) & 1u) != 0u);
        if (FLAGS & FL_LANE) ok = ok && laneok;
        s[i] = ok ? v : NEG_INF;
    }
}
DI bf16x8 pack8(const f32x16& x, int s) {
    typedef unsigned u32x4 __attribute__((ext_vector_type(4)));
    u32x4 p;
    p[0] = pack2(x[8 * s + 0], x[8 * s + 1]); p[1] = pack2(x[8 * s + 2], x[8 * s + 3]); p[2] = pack2(x[8 * s + 4], x[8 * s + 5]); p[3] = pack2(x[8 * s + 6], x[8 * s + 7]);
    return __builtin_bit_cast(bf16x8, p);
}
DI void pv_tile(const LAS unsigned char* Vt, const f32x16& p0, const f32x16& p1, int r, int hf, f32x16& o0, f32x16& o1) {
#pragma unroll
    for (int G = 0; G < 4; ++G) {
        const bf16x8 pb = pack8((G >> 1) ? p1 : p0, G & 1);
        const int cc = 2 * G + hf;
        const bf16x8 a0 = *(const LAS bf16x8*)(Vt + r * 128 + ((cc ^ ((r >> 1) & 7)) << 4));
        const bf16x8 a1 = *(const LAS bf16x8*)(Vt + (32 + r) * 128 + ((cc ^ ((r >> 1) & 7)) << 4));
        o0 = MFMA32(a0, pb, o0); o1 = MFMA32(a1, pb, o1);
    }
}
DI void online_pv(Att& st, f32x16& s0, f32x16& s1, const LAS unsigned char* Vt, int r, int hf) {
    float tm = NEG_INF;
#pragma unroll
    for (int i = 0; i < 16; ++i) tm = fmaxf(tm, fmaxf(s0[i], s1[i]));
    tm = fmaxf(tm, __shfl_xor(tm, 32));
    const float mn = fmaxf(st.m, tm);
    const float mu = (mn == NEG_INF) ? 0.f : mn;
    const float alpha = __builtin_amdgcn_exp2f(st.m - mu);
    float ls = 0.f;
#pragma unroll
    for (int i = 0; i < 16; ++i) { s0[i] = __builtin_amdgcn_exp2f(s0[i] - mu); s1[i] = __builtin_amdgcn_exp2f(s1[i] - mu); ls += s0[i] + s1[i]; }
    st.l = st.l * alpha + ls;
    if (__ballot(mn != st.m) != 0ull) {
#pragma unroll
        for (int i = 0; i < 16; ++i) { st.o0[i] *= alpha; st.o1[i] *= alpha; } }
    st.m = mn;
    pv_tile(Vt, s0, s1, r, hf, st.o0, st.o1);
}
DI unsigned bitmask32(unsigned w, int pos) { unsigned m; asm("v_bfe_i32 %0, %1, %2, 1" : "=v"(m) : "v"(w), "n"(pos)); return m; }
template <bool BITS, bool NEARB, bool CAUSAL = false>
DI void far_soft(Att& st, f32x16& s0, f32x16& s1, const LAS unsigned char* Vt, int r, int hf, float bfar, bool laneok, unsigned m0, unsigned m1,
                 int tq, int posb, const LAS float* bl) {
    const float cb = laneok ? bfar - st.m : NEG_INF;
    const float nm = laneok ? -st.m : NEG_INF;
    const int dbase = tq - posb - 4 * hf;
    const unsigned w0 = m0 >> (4 * hf), w1 = m1 >> (4 * hf);
    const f32x2 c1v = {QK_C1, QK_C1}; f32x2 cbv = {cb, cb}; f32x2 ls2 = {0.f, 0.f};
#pragma unroll
    for (int i = 0; i < 16; i += 2) { const f32x2 sv = {s0[i], s0[i + 1]};
        if (NEARB) { int d0 = dbase - ((i & 3) + 8 * (i >> 2)), d1 = dbase - (((i + 1) & 3) + 8 * ((i + 1) >> 2)); const bool k0 = d0 >= 0, k1 = d1 >= 0;
            d0 = d0 > 127 ? 127 : d0; d1 = d1 > 127 ? 127 : d1; if (CAUSAL) { d0 = d0 < 0 ? 0 : d0; d1 = d1 < 0 ? 0 : d1; }
            cbv[0] = bl[d0] + nm; cbv[1] = bl[d1] + nm; if (CAUSAL) { cbv[0] = k0 ? cbv[0] : NEG_INF; cbv[1] = k1 ? cbv[1] : NEG_INF; } }
        const f32x2 av = sv * c1v + cbv;
        f32x2 pv; pv[0] = __builtin_amdgcn_exp2f(av[0]); pv[1] = __builtin_amdgcn_exp2f(av[1]);
        if (BITS) { pv[0] = __uint_as_float(__float_as_uint(pv[0]) & bitmask32(w0, (i & 3) + 8 * (i >> 2)));
                    pv[1] = __uint_as_float(__float_as_uint(pv[1]) & bitmask32(w0, ((i + 1) & 3) + 8 * ((i + 1) >> 2))); }
        s0[i] = pv[0]; s0[i + 1] = pv[1]; ls2 += pv; }
    const int rr = r;
#pragma unroll
    for (int G = 0; G < 2; ++G) { const bf16x8 pb = pack8(s0, G); const int cc = 2 * G + hf;
        const bf16x8 a0 = *(const LAS bf16x8*)(Vt + rr * 128 + ((cc ^ ((rr >> 1) & 7)) << 4)); const bf16x8 a1 = *(const LAS bf16x8*)(Vt + (32 + rr) * 128 + ((cc ^ ((rr >> 1) & 7)) << 4));
        st.o0 = MFMA32(a0, pb, st.o0); st.o1 = MFMA32(a1, pb, st.o1); }
#pragma unroll
    for (int i = 0; i < 16; i += 2) { const f32x2 sv = {s1[i], s1[i + 1]};
        if (NEARB) { int d0 = dbase - 32 - ((i & 3) + 8 * (i >> 2)), d1 = dbase - 32 - (((i + 1) & 3) + 8 * ((i + 1) >> 2)); const bool k0 = d0 >= 0, k1 = d1 >= 0;
            d0 = d0 > 127 ? 127 : d0; d1 = d1 > 127 ? 127 : d1; if (CAUSAL) { d0 = d0 < 0 ? 0 : d0; d1 = d1 < 0 ? 0 : d1; }
            cbv[0] = bl[d0] + nm; cbv[1] = bl[d1] + nm; if (CAUSAL) { cbv[0] = k0 ? cbv[0] : NEG_INF; cbv[1] = k1 ? cbv[1] : NEG_INF; } }
        const f32x2 av = sv * c1v + cbv;
        f32x2 pv; pv[0] = __builtin_amdgcn_exp2f(av[0]); pv[1] = __builtin_amdgcn_exp2f(av[1]);
        if (BITS) { pv[0] = __uint_as_float(__float_as_uint(pv[0]) & bitmask32(w1, (i & 3) + 8 * (i >> 2)));
                    pv[1] = __uint_as_float(__float_as_uint(pv[1]) & bitmask32(w1, ((i + 1) & 3) + 8 * ((i + 1) >> 2))); }
        s1[i] = pv[0]; s1[i + 1] = pv[1]; ls2 += pv; }
#pragma unroll
    for (int G = 2; G < 4; ++G) { const bf16x8 pb = pack8(s1, G & 1); const int cc = 2 * G + hf;
        const bf16x8 a0 = *(const LAS bf16x8*)(Vt + rr * 128 + ((cc ^ ((rr >> 1) & 7)) << 4)); const bf16x8 a1 = *(const LAS bf16x8*)(Vt + (32 + rr) * 128 + ((cc ^ ((rr >> 1) & 7)) << 4));
        st.o0 = MFMA32(a0, pb, st.o0); st.o1 = MFMA32(a1, pb, st.o1); }
    st.l += ls2[0] + ls2[1];
}
template <bool BITS, bool NEARB, bool CAUSAL = false>
DI void far_tile(Att& st, const LAS unsigned char* Kt, const LAS unsigned char* Vt, const bf16x8 (&qf)[4], int r, int hf, float bfar, bool laneok, unsigned m0, unsigned m1,
                 int tq, int posb, const LAS float* bl) {
    f32x16 s0, s1; qk_tile(Kt, qf, r, hf, s0, s1);
    far_soft<BITS, NEARB, CAUSAL>(st, s0, s1, Vt, r, hf, bfar, laneok, m0, m1, tq, posb, bl);
}
#define LDS_BARRIER() do { asm volatile("s_waitcnt lgkmcnt(0)" ::: "memory"); __builtin_amdgcn_s_barrier(); asm volatile("" ::: "memory"); } while (0)
#ifndef STAG_N
#define STAG_N 0
#endif
template <class LD, class BODY>
DI void tile_stream(int n, LAS unsigned char* buf, int tid, bool useV, LD ld, BODY body) {
    if (n <= 0) return;
    const bool late = __builtin_amdgcn_readfirstlane(tid >> 8) != 0;
    uint4 rk0, rk1 = make_uint4(0u, 0u, 0u, 0u), rv0 = make_uint4(0u, 0u, 0u, 0u), rv1 = make_uint4(0u, 0u, 0u, 0u);
    ld(0, rk0, rv0); if (n > 1) ld(1, rk1, rv1);
    st_write_K(buf, tid, rk0); if (useV) st_write_VT(buf + 8192, tid, rv0);
    if (n > 1) { st_write_K(buf + 16384, tid, rk1); if (useV) st_write_VT(buf + 24576, tid, rv1); }
    if (n > 2) ld(2, rk0, rv0); if (n > 3) ld(3, rk1, rv1);
    LDS_BARRIER();
#pragma unroll 1
    for (int i = 0; i < n; i += 2) {
        LAS unsigned char* cur = buf + ((i >> 1) & 1) * 32768;
        if (i + 2 < n) { LAS unsigned char* nxt = buf + (((i >> 1) + 1) & 1) * 32768;
            st_write_K(nxt, tid, rk0); if (useV) st_write_VT(nxt + 8192, tid, rv0);
            if (i + 3 < n) { st_write_K(nxt + 16384, tid, rk1); if (useV) st_write_VT(nxt + 24576, tid, rv1); }
            if (i + 4 < n) ld(i + 4, rk0, rv0); if (i + 5 < n) ld(i + 5, rk1, rv1); }
        if (late) __builtin_amdgcn_s_sleep(STAG_N);
        body(i, cur, cur + 8192);
        if (i + 1 < n) body(i + 1, cur + 16384, cur + 24576);
        LDS_BARRIER();
    }
}
template <class LD, class BODY>
DI void tile_stream_k4(int n, LAS unsigned char* buf, int tid, LD ld, BODY body) {
    if (n <= 0) return;
    uint4 r0, r1 = make_uint4(0u, 0u, 0u, 0u), r2 = make_uint4(0u, 0u, 0u, 0u), r3 = make_uint4(0u, 0u, 0u, 0u), dv;
    ld(0, r0, dv); if (n > 1) ld(1, r1, dv); if (n > 2) ld(2, r2, dv); if (n > 3) ld(3, r3, dv);
    st_write_K(buf, tid, r0); if (n > 1) st_write_K(buf + 8192, tid, r1); if (n > 2) st_write_K(buf + 16384, tid, r2); if (n > 3) st_write_K(buf + 24576, tid, r3);
    if (n > 4) ld(4, r0, dv); if (n > 5) ld(5, r1, dv); if (n > 6) ld(6, r2, dv); if (n > 7) ld(7, r3, dv);
    LDS_BARRIER();
#pragma unroll 1
    for (int i = 0; i < n; i += 4) {
        LAS unsigned char* cur = buf + ((i >> 2) & 1) * 32768;
        if (i + 4 < n) { LAS unsigned char* nxt = buf + (((i >> 2) + 1) & 1) * 32768;
            st_write_K(nxt, tid, r0); if (i + 5 < n) st_write_K(nxt + 8192, tid, r1); if (i + 6 < n) st_write_K(nxt + 16384, tid, r2); if (i + 7 < n) st_write_K(nxt + 24576, tid, r3);
            if (i + 8 < n) ld(i + 8, r0, dv); if (i + 9 < n) ld(i + 9, r1, dv); if (i + 10 < n) ld(i + 10, r2, dv); if (i + 11 < n) ld(i + 11, r3, dv); }
#pragma unroll 1
        for (int j = 0; j < 4; ++j) if (i + j < n) body(i + j, cur + j * 8192, cur);
        LDS_BARRIER();
    }
}
DI uint4 cvt8_f32(const float* p) { const f32x4 a = *(const f32x4*)p, b = *(const f32x4*)(p + 4); uint4 o; o.x = pack2(a[0], a[1]); o.y = pack2(a[2], a[3]); o.z = pack2(b[0], b[1]); o.w = pack2(b[2], b[3]); return o; }

DI void nsa_unit(const Frame& F, int b, int g, int qb) {
    int tid_ = F.tid; OPAQUE(tid_);
    const int tid = tid_, lane = tid & 63, w = F.wave, r = lane & 31, hf = lane >> 5;
    LAS unsigned char* L = F.ldsl;
    LAS unsigned char* buf = L + AT_BUF;
    LAS float* psum = (LAS float*)(L + AT_PSUM);
    LAS unsigned long long* selm = (LAS unsigned long long*)(L + AT_SELM);
    LAS unsigned char* tlist = L + AT_SELM + 528;
    LAS int* tcnt = (LAS int*)(L + AT_SELM + 520);
    const bf16_t* U = (const bf16_t*)(F.ws + WS_U);
    const float* KC = (const float*)(F.ws + WS_KCMP) + (size_t)(b * 2 + g) * 256 * 64;
    const bf16_t* VCT = (const bf16_t*)(F.ws + WS_VCT) + (size_t)(b * 2 + g) * 64 * 256;
    const bf16_t* VT = (const bf16_t*)(F.ws + WS_VT);
    bf16_t* Y = (bf16_t*)(F.ws + WS_BFB);
    const int t0 = qb * 64;
    const int ql = r >> 2, h = r & 3, hh = g * 4 + h;
    const int tq = t0 + 8 * w + ql;
    const size_t row = (size_t)b * SEQ + tq;
    const bf16_t* Ur = U + row * LD0;
    bf16x8 qf[4];
#pragma unroll
    for (int s = 0; s < 4; ++s) qf[s] = *(const bf16x8*)(Ur + C_AQ + hh * 64 + 16 * s + 8 * hf);
    const LAS float* bl = F.biasL + hh * 128; const float bfar = bl[127];
    float gate[3];
    { const unsigned* gp = (const unsigned*)(Ur + C_AG);
#pragma unroll
      for (int j = 0; j < 3; ++j) { const int e = hh * 3 + j; const unsigned wv = gp[e >> 1]; gate[j] = sigmoidf_((e & 1) ? __uint_as_float(wv & 0xFFFF0000u) : __uint_as_float(wv << 16)); } }
    LAS float* opark = psum + w * 2048 + lane;

    const int nvmax = ((t0 + 63 - 31) >> 4) + 1;
    const int ntc = (nvmax + 63) >> 6;
    for (int e = tid; e < 64 * 256; e += 512) psum[e] = 0.f;
    float cm = NEG_INF, cl = 0.f;
    {
#pragma unroll 1
        for (int i = 0; i < ntc; ++i) { const int key = tid >> 3, c = tid & 7;
            const uint4 rk = cvt8_f32(KC + (size_t)(i * 64 + key) * 64 + c * 8); const uint4 rv = *(const uint4*)(VCT + (size_t)key * 256 + i * 64 + c * 8);
            st_write_K(buf + i * 8192, tid, rk); st_write_VT(buf + 32768 + i * 8192, tid, rv); }
        __syncthreads();
        auto body = [&](int i, LAS unsigned char* Kt, LAS unsigned char* Vt) { (void)Vt;
            f32x16 s0, s1; qk_tile(Kt, qf, r, hf, s0, s1);
            if (16 * (i * 64 + 63) + 31 + 113 <= t0 + 8 * w) { fix_scores<0>(s0, 0, 16, tq, bl, bfar, 0u, true, hf); fix_scores<0>(s1, 0, 16, tq, bl, bfar, 0u, true, hf); }
            else { fix_scores<FL_NEAR | FL_CAUSAL>(s0, 16 * (i * 64) + 31, 16, tq, bl, bfar, 0u, true, hf); fix_scores<FL_NEAR | FL_CAUSAL>(s1, 16 * (i * 64 + 32) + 31, 16, tq, bl, bfar, 0u, true, hf); }
            float tm = NEG_INF;
#pragma unroll
            for (int k = 0; k < 16; ++k) tm = fmaxf(tm, fmaxf(s0[k], s1[k]));
            tm = fmaxf(tm, __shfl_xor(tm, 32));
            const float mn = fmaxf(cm, tm); const float mu = (mn == NEG_INF) ? 0.f : mn;
            float ls = 0.f;
#pragma unroll
            for (int k = 0; k < 16; ++k) ls += __builtin_amdgcn_exp2f(s0[k] - mu) + __builtin_amdgcn_exp2f(s1[k] - mu);
            cl = cl * __builtin_amdgcn_exp2f(cm - mu) + ls; cm = mn; };
#pragma unroll 1
        for (int i = 0; i < ntc; ++i) body(i, buf + i * 8192, buf + 32768 + i * 8192);
    }
    f32x16 c0, c1;
    {
        cl += __shfl_xor(cl, 32);
        const float cinv = cl > 0.f ? 1.0f / cl : 0.f; const float cmu = (cm == NEG_INF) ? 0.f : cm;
#pragma unroll
        for (int i = 0; i < 16; ++i) { c0[i] = 0.f; c1[i] = 0.f; }
        auto body = [&](int i, LAS unsigned char* Kt, LAS unsigned char* Vt) {
            f32x16 s0, s1; qk_tile(Kt, qf, r, hf, s0, s1);
            if (16 * (i * 64 + 63) + 31 + 113 <= t0 + 8 * w) { fix_scores<0>(s0, 0, 16, tq, bl, bfar, 0u, true, hf); fix_scores<0>(s1, 0, 16, tq, bl, bfar, 0u, true, hf); }
            else { fix_scores<FL_NEAR | FL_CAUSAL>(s0, 16 * (i * 64) + 31, 16, tq, bl, bfar, 0u, true, hf); fix_scores<FL_NEAR | FL_CAUSAL>(s1, 16 * (i * 64 + 32) + 31, 16, tq, bl, bfar, 0u, true, hf); }
#pragma unroll
            for (int k = 0; k < 16; ++k) { s0[k] = __builtin_amdgcn_exp2f(s0[k] - cmu) * cinv; s1[k] = __builtin_amdgcn_exp2f(s1[k] - cmu) * cinv; }
#pragma unroll
            for (int k = 0; k < 16; ++k) {
                float a0 = s0[k], a1 = s1[k];
                a0 += __shfl_xor(a0, 1); a0 += __shfl_xor(a0, 2); a1 += __shfl_xor(a1, 1); a1 += __shfl_xor(a1, 2);
                const int koff = (k & 3) + 8 * (k >> 2) + 4 * hf;
                if (h == 0) { psum[(8 * w + ql) * 256 + i * 64 + koff] = a0; psum[(8 * w + ql) * 256 + i * 64 + 32 + koff] = a1; }
            }
            pv_tile(Vt, s0, s1, r, hf, c0, c1); };
#pragma unroll 1
        for (int i = 0; i < ntc; ++i) body(i, buf + i * 8192, buf + 32768 + i * 8192);
        __syncthreads();
    }
    {
        const int cur = qb; const int npick = (cur + 1) < 8 ? (cur + 1) : 8;
        LAS float* scw = (LAS float*)(L + AT_MISC + 64) + w * 64;
#pragma unroll 1
        for (int q = 0; q < 8; ++q) {
            const LAS float* pr = psum + (8 * w + q) * 256;
            float imp = 0.f;
            const int i0 = 4 * lane - 1 < 0 ? 0 : 4 * lane - 1, i1 = 4 * lane + 3 > 254 ? 254 : 4 * lane + 3;
            for (int i = i0; i <= i1; ++i) imp += pr[i];
            const bool adm = lane <= cur; const bool forced = (lane == 0) || (lane == cur) || (lane == cur - 1);
            const float score = adm ? imp + (forced ? 1.0e4f : 0.f) : NEG_INF;
            __builtin_amdgcn_wave_barrier();
            scw[lane] = score;
            __builtin_amdgcn_wave_barrier();
            int rank = 0;
#pragma unroll
            for (int j4 = 0; j4 < 16; ++j4) { const f32x4 o = *(const LAS f32x4*)(scw + 4 * j4);
#pragma unroll
                for (int e = 0; e < 4; ++e) { const int j = 4 * j4 + e; rank += (o[e] > score || (o[e] == score && j < lane)) ? 1 : 0; } }
            const unsigned long long sm = __ballot(adm && rank < npick);
            if (lane == 0) selm[8 * w + q] = sm;
        }
    }
    __syncthreads();
    if (w == 0) {
        unsigned long long m = selm[lane];
        unsigned lo = (unsigned)m, hi = (unsigned)(m >> 32);
        for (int o = 32; o >= 1; o >>= 1) { lo |= __shfl_xor(lo, o); hi |= __shfl_xor(hi, o); }
        const unsigned long long un = ((unsigned long long)hi << 32) | lo;
        const bool mine = (un >> lane) & 1ull;
        const int pos = __popcll(un & ((1ull << lane) - 1ull));
        if (mine) tlist[pos] = (unsigned char)lane;
        if (lane == 0) tcnt[0] = __popcll(un);
    }
    __syncthreads();
#pragma unroll
    for (int i = 0; i < 16; ++i) { opark[i * 64] = gate[0] * c0[i]; opark[(16 + i) * 64] = gate[0] * c1[i]; }
    const unsigned long long mysel = selm[8 * w + ql];
    {
        Att st; att_init(st);
        const int nts = tcnt[0];
        auto lds_ = [&](int i, uint4& rk, uint4& rv) { const int j = tlist[i]; const int key = tid >> 3, c = tid & 7;
            const bf16_t* p = U + ((size_t)b * SEQ + j * 64 + key) * LD0 + g * 64 + c * 8; rk = *(const uint4*)(p + C_KS); rv = *(const uint4*)(VT + (size_t)(g * 64 + key) * MT + (size_t)b * SEQ + j * 64 + c * 8); };
        auto body = [&](int i, LAS unsigned char* Kt, LAS unsigned char* Vt) {
            const int j = tlist[i];
            const bool laneok = (mysel >> j) & 1ull;
            if (__ballot(laneok) == 0ull) return;
            if (__ballot(st.m == NEG_INF) == 0ull) {
                if (j < qb - 2) far_tile<false, false>(st, Kt, Vt, qf, r, hf, bfar, laneok, 0u, 0u, tq, j * 64, bl); else if (j < qb) far_tile<false, true>(st, Kt, Vt, qf, r, hf, bfar, laneok, 0u, 0u, tq, j * 64, bl);
                else far_tile<false, true, true>(st, Kt, Vt, qf, r, hf, bfar, laneok, 0u, 0u, tq, j * 64, bl);
                return; }
            f32x16 s0, s1; qk_tile(Kt, qf, r, hf, s0, s1);
            if (j >= qb - 2) { fix_scores<FL_NEAR | FL_CAUSAL | FL_LANE>(s0, j * 64, 1, tq, bl, bfar, 0u, laneok, hf); fix_scores<FL_NEAR | FL_CAUSAL | FL_LANE>(s1, j * 64 + 32, 1, tq, bl, bfar, 0u, laneok, hf); }
            else { fix_scores<FL_LANE>(s0, j * 64, 1, tq, bl, bfar, 0u, laneok, hf); fix_scores<FL_LANE>(s1, j * 64 + 32, 1, tq, bl, bfar, 0u, laneok, hf); }
            online_pv(st, s0, s1, Vt, r, hf); };
        tile_stream(nts, buf, tid, true, lds_, body);
        float l = st.l + __shfl_xor(st.l, 32);
        const float sc = l > 0.f ? gate[1] / l : 0.f;
#pragma unroll
        for (int i = 0; i < 16; ++i) { opark[i * 64] += sc * st.o0[i]; opark[(16 + i) * 64] += sc * st.o1[i]; }
    }
    {
        Att st; att_init(st);
        const int j0 = qb - 8 < 0 ? 0 : qb - 8; const int ntw = qb - j0 + 1;
        auto ldw = [&](int i, uint4& rk, uint4& rv) { const int j = j0 + i; const int key = tid >> 3, c = tid & 7;
            const bf16_t* p = U + ((size_t)b * SEQ + j * 64 + key) * LD0 + g * 64 + c * 8; rk = *(const uint4*)(p + C_KW); rv = *(const uint4*)(VT + (size_t)(128 + g * 64 + key) * MT + (size_t)b * SEQ + j * 64 + c * 8); };
        auto body = [&](int i, LAS unsigned char* Kt, LAS unsigned char* Vt) {
            const int j = j0 + i;
            if (j != qb - 8 && __ballot(st.m == NEG_INF) == 0ull) {
                if (j < qb - 2) far_tile<false, false>(st, Kt, Vt, qf, r, hf, bfar, true, 0u, 0u, tq, j * 64, bl); else if (j < qb) far_tile<false, true>(st, Kt, Vt, qf, r, hf, bfar, true, 0u, 0u, tq, j * 64, bl);
                else far_tile<false, true, true>(st, Kt, Vt, qf, r, hf, bfar, true, 0u, 0u, tq, j * 64, bl);
                return; }
            f32x16 s0, s1; qk_tile(Kt, qf, r, hf, s0, s1);
            if (j >= qb - 2) { fix_scores<FL_NEAR | FL_CAUSAL>(s0, j * 64, 1, tq, bl, bfar, 0u, true, hf); fix_scores<FL_NEAR | FL_CAUSAL>(s1, j * 64 + 32, 1, tq, bl, bfar, 0u, true, hf); }
            else if (j == qb - 8) { fix_scores<FL_WINLO>(s0, j * 64, 1, tq, bl, bfar, 0u, true, hf); fix_scores<FL_WINLO>(s1, j * 64 + 32, 1, tq, bl, bfar, 0u, true, hf); }
            else { fix_scores<0>(s0, j * 64, 1, tq, bl, bfar, 0u, true, hf); fix_scores<0>(s1, j * 64 + 32, 1, tq, bl, bfar, 0u, true, hf); }
            online_pv(st, s0, s1, Vt, r, hf); };
        tile_stream(ntw, buf, tid, true, ldw, body);
        float l = st.l + __shfl_xor(st.l, 32);
        const float sc = l > 0.f ? gate[2] / l : 0.f;
#pragma unroll
        for (int i = 0; i < 16; ++i) { c0[i] = opark[i * 64] + sc * st.o0[i]; c1[i] = opark[(16 + i) * 64] + sc * st.o1[i]; }
    }
#pragma unroll
    for (int dh = 0; dh < 2; ++dh)
#pragma unroll
        for (int k = 0; k < 4; ++k) {
            const int d = 32 * dh + 8 * k + 4 * hf;
            const uint2 zz = *(const uint2*)(Ur + C_AZ + hh * 64 + d);
            const float z0 = __uint_as_float(zz.x << 16), z1 = __uint_as_float(zz.x & 0xFFFF0000u), z2 = __uint_as_float(zz.y << 16), z3 = __uint_as_float(zz.y & 0xFFFF0000u);
            const f32x16& o = dh ? c1 : c0;
            uint2 pk; pk.x = pack2(o[4 * k + 0] * siluf_(z0), o[4 * k + 1] * siluf_(z1)); pk.y = pack2(o[4 * k + 2] * siluf_(z2), o[4 * k + 3] * siluf_(z3));
            *(uint2*)(Y + row * 1024 + hh * 64 + d) = pk;
        }
    __syncthreads();
}

DI unsigned short okey16(float x) {
    const _Float16 hx = (_Float16)x; unsigned short u = __builtin_bit_cast(unsigned short, hx);
    if ((u & 0x7FFFu) == 0u) u = 0u;
    return (u & 0x8000u) ? (unsigned short)~u : (unsigned short)(u | 0x8000u);
}
DI void dsa_unit(const Frame& F, int b, int qt) {
    int tid_ = F.tid; OPAQUE(tid_);
    const int tid = tid_, lane = tid & 63, w = F.wave, r = lane & 31, hf = lane >> 5, fr = lane & 15, fq = lane >> 4;
    LAS unsigned char* L = F.ldsl;
    LAS unsigned char* buf = L + AT_BUF;
    LAS unsigned* mask = (LAS unsigned*)(L + AT_PSUM);
    const bf16_t* U = (const bf16_t*)(F.ws + WS_U);
    bf16_t* Y = (bf16_t*)(F.ws + WS_BFB);
    const bf16_t* VT = (const bf16_t*)(F.ws + WS_VT);
    unsigned short* KS = (unsigned short*)(F.ws + WS_BFA) + (size_t)F.bid * 32 * 4096;
    const int t0 = qt * 32;
    const int nt = ((t0 + 31) >> 6) + 1;
    {
        bf16x8 qi[2]; float wi[4];
        { const bf16_t* Uq = U + ((size_t)b * SEQ + t0 + 4 * w + (fr >> 2)) * LD0;
#pragma unroll
          for (int ks = 0; ks < 2; ++ks) qi[ks] = *(const bf16x8*)(Uq + C_BQI + (fr & 3) * 64 + 32 * ks + 8 * fq);
          const uint2 wv = *(const uint2*)(U + ((size_t)b * SEQ + t0 + 4 * w + fq) * LD0 + C_BWI);
          wi[0] = __uint_as_float(wv.x << 16) * 0.0625f; wi[1] = __uint_as_float(wv.x & 0xFFFF0000u) * 0.0625f; wi[2] = __uint_as_float(wv.y << 16) * 0.0625f; wi[3] = __uint_as_float(wv.y & 0xFFFF0000u) * 0.0625f; }
        const int tqi = t0 + 4 * w + fq;
        auto ldi = [&](int i, uint4& rk, uint4& rv) { const int key = tid >> 3, c = tid & 7; rk = *(const uint4*)(U + ((size_t)b * SEQ + i * 64 + key) * LD0 + C_BKI + c * 8); (void)rv; };
        auto body = [&](int i, LAS unsigned char* Kt, LAS unsigned char* Vt) { (void)Vt;
#pragma unroll
            for (int kg = 0; kg < 4; ++kg) {
                const int kk = 16 * kg + fr;
                f32x4 acc = {0.f, 0.f, 0.f, 0.f};
#pragma unroll
                for (int ks = 0; ks < 2; ++ks) { const int c = 4 * ks + fq;
                    const bf16x8 kb = *(const LAS bf16x8*)(Kt + (kk ^ ((kk >> 3) & 1)) * 128 + ((c ^ (kk & 7)) << 4));
                    acc = __builtin_amdgcn_mfma_f32_16x16x32_bf16(qi[ks], kb, acc, 0, 0, 0); }
                const float sc = wi[0] * fmaxf(acc[0], 0.f) + wi[1] * fmaxf(acc[1], 0.f) + wi[2] * fmaxf(acc[2], 0.f) + wi[3] * fmaxf(acc[3], 0.f);
                const int pos = i * 64 + kk;
                KS[(size_t)(4 * w + fq) * 4096 + pos] = pos <= tqi ? okey16(sc) : (unsigned short)0;
            } };
        tile_stream_k4(nt, buf, tid, ldi, body);
    }
    asm volatile("s_waitcnt vmcnt(0)" ::: "memory");
    __syncthreads();
    __builtin_amdgcn_fence(__ATOMIC_ACQUIRE, "agent");
    asm volatile("s_waitcnt vmcnt(0)" ::: "memory");
    {
    LAS unsigned char* maskb = (LAS unsigned char*)mask;
    unsigned Tn[32];
    auto ldkeys = [&](int q) { const int qq = 4 * w + q; const int nk = t0 + qq + 1; int ln = lane; OPAQUE(ln); const unsigned short* kq = KS + (size_t)qq * 4096 + ln * 8;
#pragma unroll
        for (int c = 0; c < 8; ++c) { uint4 kv = make_uint4(0u, 0u, 0u, 0u); if (c * 512 < nk) kv = *(const uint4*)(kq + c * 512);
            Tn[4 * c] = kv.x; Tn[4 * c + 1] = kv.y; Tn[4 * c + 2] = kv.z; Tn[4 * c + 3] = kv.w; } };
    ldkeys(0);
#pragma unroll 1
    for (int q = 0; q < 4; ++q) {
        const int qq = 4 * w + q; const int tqq = t0 + qq; const int nk = tqq + 1;
        unsigned T[32];
#pragma unroll
        for (int e = 0; e < 32; ++e) T[e] = Tn[e];
        if (q < 3) ldkeys(q + 1);
        if (nk <= 256) {
#pragma unroll
            for (int c = 0; c < 8; ++c) { unsigned selb = 0u;
#pragma unroll
                for (int e = 0; e < 8; ++e) if (c * 512 + lane * 8 + e < nk) selb |= 1u << e;
                maskb[qq * 512 + c * 64 + lane] = (unsigned char)selb; }
            continue;
        }
#pragma unroll
        for (int e = 0; e < 32; ++e) { const int idx = (e >> 2) * 512 + lane * 8 + (e & 3) * 2;
            unsigned lo = T[e] & 0xFFFFu, hi = T[e] >> 16; if (idx >= nk) lo = 0u; if (idx + 1 >= nk) hi = 0u; T[e] = lo | (hi << 16); }
#pragma unroll
        for (int st = 0; st < 5; ++st) { const int j = 16 >> st; const unsigned m = st == 0 ? 0x0000FFFFu : st == 1 ? 0x00FF00FFu : st == 2 ? 0x0F0F0F0Fu : st == 3 ? 0x33333333u : 0x55555555u;
#pragma unroll
            for (int k0 = 0; k0 < 32; k0 += 2 * j)
#pragma unroll
                for (int i = 0; i < j; ++i) { const int k = k0 + i; const unsigned t = ((T[k] >> j) ^ T[k + j]) & m; T[k] ^= (t << j); T[k + j] ^= t; } }
        unsigned ce = 0xFFFFFFFFu, co = 0xFFFFFFFFu, ge = 0u, go = 0u; int above = 0;
#pragma unroll
        for (int bit = 15; bit >= 0; --bit) {
            const unsigned oe = ce & T[bit], oo = co & T[16 + bit];
            const int cnt = __popc(oe) + __popc(oo);
            int tot = 0;
#pragma unroll
            for (int bb = 0; bb < 7; ++bb) tot += __popcll(__ballot((cnt >> bb) & 1)) << bb;
            if (above + tot >= 256) { ce = oe; co = oo; }
            else { above += tot; ge |= oe; go |= oo; ce &= ~T[bit]; co &= ~T[16 + bit]; }
        }
        const int quota = 256 - above; int taken = 0;
#pragma unroll
        for (int c = 0; c < 8; ++c) {
            unsigned xe = (ge >> (4 * c)) & 0xFu, xo = (go >> (4 * c)) & 0xFu;
            xe = (xe | (xe << 2)) & 0x33u; xe = (xe | (xe << 1)) & 0x55u; xo = (xo | (xo << 2)) & 0x33u; xo = (xo | (xo << 1)) & 0x55u;
            unsigned selb = xe | (xo << 1);
            unsigned ye = (ce >> (4 * c)) & 0xFu, yo = (co >> (4 * c)) & 0xFu;
            ye = (ye | (ye << 2)) & 0x33u; ye = (ye | (ye << 1)) & 0x55u; yo = (yo | (yo << 2)) & 0x33u; yo = (yo | (yo << 1)) & 0x55u;
            const unsigned eqb = ye | (yo << 1);
            if (__ballot(eqb != 0u) != 0ull) {
                const int ne = __popc(eqb);
                int excl = 0, totc = 0;
#pragma unroll
                for (int bb = 0; bb < 4; ++bb) { const unsigned long long bl_ = __ballot((ne >> bb) & 1);
                    excl += (int)__builtin_amdgcn_mbcnt_hi((unsigned)(bl_ >> 32), __builtin_amdgcn_mbcnt_lo((unsigned)bl_, 0u)) << bb; totc += __popcll(bl_) << bb; }
                int rank = taken + excl;
#pragma unroll
                for (int e = 0; e < 8; ++e) if ((eqb >> e) & 1u) { if (rank < quota) selb |= 1u << e; ++rank; }
                taken += totc;
            }
            maskb[qq * 512 + c * 64 + lane] = (unsigned char)selb;
        }
    }
    }
    __syncthreads();
    {
        const int ql = r >> 3, h = r & 7;
        const int tq = t0 + 4 * w + ql;
        const size_t row = (size_t)b * SEQ + tq;
        const bf16_t* Ur = U + row * LD0;
        bf16x8 qf[4];
#pragma unroll
        for (int s = 0; s < 4; ++s) qf[s] = *(const bf16x8*)(Ur + C_BQ + h * 64 + 16 * s + 8 * hf);
        const LAS float* bl = F.biasL + (8 + h) * 128; const float bfar = bl[127];
        const LAS unsigned* mq = mask + (4 * w + ql) * 128;
        LAS unsigned char* xmw = L + AT_XM + w * 2304 + ql * 272 + hf * 128;
        auto expand = [&](int i) {
            const unsigned nib = (~mq[2 * i + (h >> 2)]) >> (8 * (h & 3) + 4 * hf);
            u32x4 v; v[0] = bitmask32(nib, 0) & 0xFF800000u; v[1] = bitmask32(nib, 1) & 0xFF800000u; v[2] = bitmask32(nib, 2) & 0xFF800000u; v[3] = bitmask32(nib, 3) & 0xFF800000u;
            *(LAS u32x4*)(xmw + (i & 1) * 1152 + h * 16) = v; };
        expand(0);
        Att st; att_init(st);
        auto lda = [&](int i, uint4& rk, uint4& rv) { const int key = tid >> 3, c = tid & 7;
            const bf16_t* p = U + ((size_t)b * SEQ + i * 64 + key) * LD0 + c * 8; rk = *(const uint4*)(p + C_BK); rv = *(const uint4*)(VT + (size_t)(256 + key) * MT + (size_t)b * SEQ + i * 64 + c * 8); };
        auto body = [&](int i, LAS unsigned char* Kt, LAS unsigned char* Vt) {
            f32x16 s0, s1;
            { const LAS unsigned char* xs = xmw + (i & 1) * 1152;
#pragma unroll
              for (int g = 0; g < 4; ++g) { const f32x4 a = *(const LAS f32x4*)(xs + g * 16), c = *(const LAS f32x4*)(xs + 64 + g * 16);
                  s0[4 * g] = a[0]; s0[4 * g + 1] = a[1]; s0[4 * g + 2] = a[2]; s0[4 * g + 3] = a[3]; s1[4 * g] = c[0]; s1[4 * g + 1] = c[1]; s1[4 * g + 2] = c[2]; s1[4 * g + 3] = c[3]; } }
            if (i + 1 < nt) expand(i + 1);
            qk_tile<true>(Kt, qf, r, hf, s0, s1);
            if (__ballot(st.m == NEG_INF) == 0ull) {
                if (i < nt - 4) far_soft<false, false>(st, s0, s1, Vt, r, hf, bfar, true, 0u, 0u, tq, i * 64, bl); else if (i < nt - 1) far_soft<false, true>(st, s0, s1, Vt, r, hf, bfar, true, 0u, 0u, tq, i * 64, bl);
                else far_soft<false, true, true>(st, s0, s1, Vt, r, hf, bfar, true, 0u, 0u, tq, i * 64, bl);
                return; }
            if (i >= nt - 4) { fix_scores<FL_NEAR | FL_CAUSAL>(s0, i * 64, 1, tq, bl, bfar, 0u, true, hf); fix_scores<FL_NEAR | FL_CAUSAL>(s1, i * 64 + 32, 1, tq, bl, bfar, 0u, true, hf); }
            else { fix_scores<0>(s0, i * 64, 1, tq, bl, bfar, 0u, true, hf); fix_scores<0>(s1, i * 64 + 32, 1, tq, bl, bfar, 0u, true, hf); }
            online_pv(st, s0, s1, Vt, r, hf); };
        tile_stream(nt, buf, tid, true, lda, body);
        float l = st.l + __shfl_xor(st.l, 32);
        const float sc = l > 0.f ? 1.0f / l : 0.f;
#pragma unroll
        for (int dh = 0; dh < 2; ++dh)
#pragma unroll
            for (int k = 0; k < 4; ++k) {
                const int d = 32 * dh + 8 * k + 4 * hf;
                const uint2 zz = *(const uint2*)(Ur + C_BZ + h * 64 + d);
                const float z0 = __uint_as_float(zz.x << 16), z1 = __uint_as_float(zz.x & 0xFFFF0000u), z2 = __uint_as_float(zz.y << 16), z3 = __uint_as_float(zz.y & 0xFFFF0000u);
                const f32x16& o = dh ? st.o1 : st.o0;
                uint2 pk; pk.x = pack2(o[4 * k + 0] * sc * siluf_(z0), o[4 * k + 1] * sc * siluf_(z1)); pk.y = pack2(o[4 * k + 2] * sc * siluf_(z2), o[4 * k + 3] * sc * siluf_(z3));
                *(uint2*)(Y + row * 1024 + 512 + h * 64 + d) = pk;
            }
    }
    __syncthreads();
}

DI void att_dsa(const Frame& F) {
    LAS int* ub = (LAS int*)(F.ldsl + AT_MISC);
    unsigned* qd = F.ctl + CW_QDSA;
    const int NDSA = NB * (SEQ / 32);
    __syncthreads();
    if (F.tid == 0) ub[0] = (int)__hip_atomic_fetch_add(qd, 1u, __ATOMIC_RELAXED, __HIP_MEMORY_SCOPE_AGENT);
    for (;;) {
        __syncthreads();
        const int k = ub[0];
        __syncthreads();
        if (k >= NDSA) break;
        int nxt = 0; if (F.tid == 0) nxt = (int)__hip_atomic_fetch_add(qd, 1u, __ATOMIC_RELAXED, __HIP_MEMORY_SCOPE_AGENT);
        dsa_unit(F, k & 7, (SEQ / 32) - 1 - (k >> 3));
        if (F.tid == 0) ub[0] = nxt;
    }
}
DI void att_nsa(const Frame& F) {
    LAS int* ub = (LAS int*)(F.ldsl + AT_MISC);
    unsigned* qn = F.ctl + CW_QNSA;
    const int NNSA = NB * 2 * (SEQ / 64);
    __syncthreads();
    if (F.tid == 0) ub[0] = (int)__hip_atomic_fetch_add(qn, 1u, __ATOMIC_RELAXED, __HIP_MEMORY_SCOPE_AGENT);
    for (;;) {
        __syncthreads();
        const int k = ub[0];
        __syncthreads();
        if (k >= NNSA) break;
        int nxt = 0; if (F.tid == 0) nxt = (int)__hip_atomic_fetch_add(qn, 1u, __ATOMIC_RELAXED, __HIP_MEMORY_SCOPE_AGENT);
        const int bg = k & 15;
        nsa_unit(F, bg >> 1, bg & 1, 63 - (k >> 4));
        if (F.tid == 0) ub[0] = nxt;
    }
}

DI f32x4 mma16(const bf16_t* A, int lda, const bf16_t* Bt, int ldb, int K, int lane) {
    const int fr = lane & 15, fq = lane >> 4;
    f32x4 acc = {0.f, 0.f, 0.f, 0.f};
    for (int k = 0; k < K; k += 32) {
        const bf16x8 a = *(const bf16x8*)(A + fr * lda + k + fq * 8);
        const bf16x8 b = *(const bf16x8*)(Bt + fr * ldb + k + fq * 8);
        acc = __builtin_amdgcn_mfma_f32_16x16x32_bf16(a, b, acc, 0, 0, 0);
    }
    return acc;
}
DI void conv8(const bf16_t* U1, int b, int t, int col, const float* cw  , int nch, const float* cb, float (&y)[8]) {
#pragma unroll
    for (int i = 0; i < 8; ++i) y[i] = cb[i];
#pragma unroll
    for (int j = 0; j < 4; ++j) { const int tt = t - 3 + j;
        if (tt >= 0) { const uint4 v = *(const uint4*)(U1 + ((size_t)b * SEQ + tt) * LD1 + col); float f[8]; unpack8(v, f);
#pragma unroll
            for (int i = 0; i < 8; ++i) y[i] += cw[(size_t)j * nch + i] * f[i]; } }
}
DI void stage_raw128(const Frame& F, const bf16_t* U1, int b, int t_first, int nrows, int col, bf16_t* raw) {
    for (int it = F.tid; it < nrows * 16; it += 512) { const int row = it >> 4, ch = it & 15; const int t = t_first + row;
        uint4 v = make_uint4(0u, 0u, 0u, 0u); if (t >= 0) v = *(const uint4*)(U1 + ((size_t)b * SEQ + t) * LD1 + col + ch * 8);
        *(uint4*)(raw + row * 136 + ch * 8) = v; }
}
DI void load_raw128(const Frame& F, const bf16_t* U1, int b, int t_first, int nrows, int col, uint4 (&rg)[3]) {
#pragma unroll
    for (int j = 0; j < 3; ++j) { const int it = F.tid + j * 512; const int row = it >> 4, ch = it & 15; const int t = t_first + row;
        rg[j] = make_uint4(0u, 0u, 0u, 0u); if (it < nrows * 16 && t >= 0) rg[j] = *(const uint4*)(U1 + ((size_t)b * SEQ + t) * LD1 + col + ch * 8); }
}
DI void write_raw128(const Frame& F, int nrows, const uint4 (&rg)[3], bf16_t* raw) {
#pragma unroll
    for (int j = 0; j < 3; ++j) { const int it = F.tid + j * 512; const int row = it >> 4, ch = it & 15; if (it < nrows * 16) *(uint4*)(raw + row * 136 + ch * 8) = rg[j]; }
}
DI void conv8_lds(const bf16_t* raw, int s, int d0, const float* cw  , const float* cb  , float (&y)[8]) {
#pragma unroll
    for (int i = 0; i < 8; ++i) y[i] = cb[d0 + i];
#pragma unroll
    for (int j = 0; j < 4; ++j) { const uint4 v = *(const uint4*)(raw + (s + j) * 136 + d0); float f[8]; unpack8(v, f);
#pragma unroll
        for (int i = 0; i < 8; ++i) y[i] += cw[j * 128 + d0 + i] * f[i]; }
}
DI void mlstm_gates(const Frame& F, const bf16_t* U1, int b, int h, int c, float* li, float* bc) {
    if (F.wave == 0) {
        const size_t row = (size_t)b * SEQ + c * 64 + F.lane;
        const float* gts = (const float*)(F.ws + WS_GATES);
        const float ip = gts[row * 8 + h] + F.in[26][h];
        const float fp = gts[row * 8 + 4 + h] + F.in[27][h];
        const float lf = fminf(fp, 0.f) - log1pf(expf(-fabsf(fp)));
        float cs = lf;
        for (int o = 1; o < 64; o <<= 1) { const float n = __shfl_up(cs, o); if (F.lane >= o) cs += n; }
        li[F.lane] = ip; bc[F.lane] = cs;
    }
    __syncthreads();
}
constexpr int ML_LI = 0, ML_BC = 256, ML_WK = 512, ML_MT = 768, ML_DQ = 1024, ML_RS = 1280, ML_NIN = 1536, ML_Q = 2048, ML_K = ML_Q + 64 * 136 * 2, ML_VT = ML_K + 64 * 136 * 2,
              ML_CT = ML_VT + 128 * 72 * 2, ML_W = ML_CT + 128 * 136 * 2, ML_KT = ML_W + 64 * 72 * 2, ML_END = ML_KT + 128 * 72 * 2;
static_assert(ML_END + 5120 + LDS_WORK_OFF <= LDS_BYTES - 12288, "mlstm lds");

DI void p8a_mlstm_local(const Frame& F) {
    const bf16_t* U1 = (const bf16_t*)(F.ws + WS_U);
    bf16_t* ST = (bf16_t*)(F.ws + WS_BFB);
    float* zloc = (float*)(F.ws + WS_ZLOC); float* scal = (float*)(F.ws + WS_SCAL);
    unsigned char* L = F.lds;
    float* li = (float*)(L + ML_LI); float* bc = (float*)(L + ML_BC); float* wk = (float*)(L + ML_WK);
    bf16_t* kT = (bf16_t*)(L + ML_KT); bf16_t* vT = (bf16_t*)(L + ML_VT); float* cwl = (float*)(L + ML_END); bf16_t* raw = (bf16_t*)(L + ML_Q);
    const float* cw = F.in[24]; const float* cb = F.in[25];
    uint4 rk3[3], rv3[3];
    auto prefetch = [&](int unit) { const int c = unit & 63, h = (unit >> 6) & 3, b = unit >> 8;
        load_raw128(F, U1, b, c * 64 - 3, 67, C_DK + h * 128, rk3); load_raw128(F, U1, b, c * 64, 64, C_DV + h * 128, rv3); };
    if (F.bid < 2048) prefetch(F.bid);
    for (int unit = F.bid; unit < 2048; unit += F.G) {
        const int c = unit & 63, h = (unit >> 6) & 3, b = unit >> 8;
        mlstm_gates(F, U1, b, h, c, li, bc);
        if (F.wave == 0) {
            const float bl = bc[63]; const float dec = bl - bc[F.lane] + li[F.lane];
            const float dmx = wave_max(dec);
            wk[F.lane] = expf(dec - dmx);
            if (F.lane == 0) { scal[unit] = bl; scal[2048 + unit] = dmx; }
        }
        for (int e = F.tid; e < 640; e += 512) cwl[e] = e < 512 ? cw[(size_t)(e >> 7) * 1024 + 512 + h * 128 + (e & 127)] : cb[512 + h * 128 + (e - 512)];
        write_raw128(F, 67, rk3, raw);
        __syncthreads();
        for (int it = F.tid; it < 1024; it += 512) {
            const int s = it & 63, d0 = (it >> 6) * 8;
            float y[8]; conv8_lds(raw, s, d0, cwl, cwl + 512, y);
            const float w = wk[s] * 0.08838834764831845f;
#pragma unroll
            for (int i = 0; i < 8; ++i) kT[(d0 + i) * 72 + s] = f2bf(siluf_(y[i]) * w);
        }
        __syncthreads();
        write_raw128(F, 64, rv3, raw);
        if (unit + F.G < 2048) prefetch(unit + F.G);
        __syncthreads();
        for (int it = F.tid; it < 1024; it += 512) {
            const int s = it & 63, d0 = (it >> 6) * 8;
            const uint4 vv = *(const uint4*)(raw + s * 136 + d0); const unsigned wv[4] = {vv.x, vv.y, vv.z, vv.w};
#pragma unroll
            for (int i = 0; i < 8; ++i) vT[(d0 + i) * 72 + s] = (bf16_t)((i & 1) ? (wv[i >> 1] >> 16) : (wv[i >> 1] & 0xFFFFu));
        }
        __syncthreads();
        for (int tix = F.wave * 8; tix < F.wave * 8 + 8; ++tix) {
            const int et = tix >> 3, dt = tix & 7;
            const f32x4 a = mma16(vT + et * 16 * 72, 72, kT + dt * 16 * 72, 72, 64, F.lane);
            const int fr = F.lane & 15, fq = F.lane >> 4;
#pragma unroll
            for (int r = 0; r < 4; ++r) ST[(size_t)unit * 16384 + (size_t)(et * 16 + 4 * fq + r) * 128 + dt * 16 + fr] = f2bf(a[r]);
        }
        { const int d = F.tid >> 2, part = F.tid & 3; float z = 0.f;
#pragma unroll
          for (int s = 0; s < 16; ++s) z += bf2f(kT[d * 72 + part * 16 + s]);
          z += __shfl_xor(z, 1); z += __shfl_xor(z, 2);
          if (part == 0) zloc[(size_t)unit * 128 + d] = z; }
        __syncthreads();
    }
}

DI void p8a_lru_local(const Frame& F) {
    const bf16_t* U1 = (const bf16_t*)(F.ws + WS_U);
    bf16_t* LA = (bf16_t*)(F.ws + WS_LRUA); bf16_t* LH = (bf16_t*)(F.ws + WS_LRUH);
    float* Aend = (float*)(F.ws + WS_AEND); float* Hend = (float*)(F.ws + WS_HEND);
    const bf16_t* WAT = (const bf16_t*)(F.ws + WS_WAT); const bf16_t* WXT = (const bf16_t*)(F.ws + WS_WXT);
    bf16_t* xcb = (bf16_t*)F.lds;
    float* cwL = (float*)(F.lds + 16640);
    bf16_t* rawl = (bf16_t*)(F.lds + 16640 + 10240);
    const int g = F.wave, lane = F.lane, fr = lane & 15, fq = lane >> 4;
    __syncthreads();
    for (int e = F.tid; e < 2048; e += 512) cwL[e] = F.in[17][e];
    cwL[2048 + F.tid] = F.in[18][F.tid];
    bf16x8 wa[4][2], wx[4][2]; float ba[4], bx[4], sp[4];
#pragma unroll
    for (int ct = 0; ct < 4; ++ct) { const int ch = g * 64 + ct * 16 + fr;
#pragma unroll
        for (int ks = 0; ks < 2; ++ks) { wa[ct][ks] = *(const bf16x8*)(WAT + (size_t)ch * 64 + 32 * ks + 8 * fq); wx[ct][ks] = *(const bf16x8*)(WXT + (size_t)ch * 64 + 32 * ks + 8 * fq); }
        ba[ct] = F.in[20][ch]; bx[ct] = F.in[22][ch]; sp[ct] = log1pf(expf(-F.in[23][ch])); }
    __syncthreads();
    for (int unit = F.bid; unit < 512; unit += F.G) {
        const int b = unit >> 6, c = unit & 63, t0 = c * 64;
        float Ac[4] = {1.f, 1.f, 1.f, 1.f}, hl[4] = {0.f, 0.f, 0.f, 0.f};
        uint4 rr[3];
        auto ldraw = [&](int sub) {
#pragma unroll
            for (int j = 0; j < 3; ++j) { const int it = F.tid + j * 512; const int row = it >> 6, c8 = (it & 63) * 8; const int t = t0 + sub * 16 - 3 + row;
                rr[j] = make_uint4(0u, 0u, 0u, 0u); if (it < 19 * 64 && t >= 0) rr[j] = *(const uint4*)(U1 + ((size_t)b * SEQ + t) * LD1 + C_CX + c8); } };
        ldraw(0);
#pragma unroll 1
        for (int sub = 0; sub < 4; ++sub) {
#pragma unroll
            for (int j = 0; j < 3; ++j) { const int it = F.tid + j * 512; if (it < 19 * 64) *(uint4*)(rawl + (it >> 6) * 520 + (it & 63) * 8) = rr[j]; }
            __syncthreads();
            if (sub < 3) ldraw(sub + 1);
            for (int it = F.tid; it < 1024; it += 512) {
                const int tk = it >> 6, c8 = (it & 63) * 8;
                float y[8];
#pragma unroll
                for (int i = 0; i < 8; ++i) y[i] = cwL[2048 + c8 + i];
#pragma unroll
                for (int j = 0; j < 4; ++j) { const uint4 v = *(const uint4*)(rawl + (tk + j) * 520 + c8); float f[8]; unpack8(v, f);
#pragma unroll
                    for (int i = 0; i < 8; ++i) y[i] += cwL[j * 512 + c8 + i] * f[i]; }
                uint4 o; o.x = pack2(y[0], y[1]); o.y = pack2(y[2], y[3]); o.z = pack2(y[4], y[5]); o.w = pack2(y[6], y[7]);
                *(uint4*)(xcb + tk * 520 + c8) = o;
            }
            __syncthreads();
            bf16x8 af[2];
#pragma unroll
            for (int ks = 0; ks < 2; ++ks) af[ks] = *(const bf16x8*)(xcb + fr * 520 + g * 64 + 32 * ks + 8 * fq);
#pragma unroll
            for (int ct = 0; ct < 4; ++ct) {
                const int ch = g * 64 + ct * 16 + fr;
                f32x4 accA = {0.f, 0.f, 0.f, 0.f}, accX = {0.f, 0.f, 0.f, 0.f};
#pragma unroll
                for (int ks = 0; ks < 2; ++ks) { accA = __builtin_amdgcn_mfma_f32_16x16x32_bf16(af[ks], wa[ct][ks], accA, 0, 0, 0); accX = __builtin_amdgcn_mfma_f32_16x16x32_bf16(af[ks], wx[ct][ks], accX, 0, 0, 0); }
                float Ap[4], Hp[4]; float A4 = 1.f, H4 = 0.f;
#pragma unroll
                for (int rg = 0; rg < 4; ++rg) {
                    const float xc = bf2f(xcb[(4 * fq + rg) * 520 + ch]);
                    const float r = sigmoidf_(accA[rg] + ba[ct]), ig = sigmoidf_(accX[rg] + bx[ct]);
                    const float a = fexp_(-8.0f * r * sp[ct]);
                    const float bt = sqrtf(fmaxf(1.0f - a * a, 0.f)) * (ig * xc);
                    H4 = a * H4 + bt; A4 *= a; Ap[rg] = A4; Hp[rg] = H4;
                }
                float iA = A4, iH = H4;
                { const float pA = __shfl_up(iA, 16), pH = __shfl_up(iH, 16); if (fq >= 1) { iH = iA * pH + iH; iA = pA * iA; } }
                { const float pA = __shfl_up(iA, 32), pH = __shfl_up(iH, 32); if (fq >= 2) { iH = iA * pH + iH; iA = pA * iA; } }
                float eA = __shfl_up(iA, 16), eH = __shfl_up(iH, 16); if (fq == 0) { eA = 1.f; eH = 0.f; }
                const float tA = __shfl(iA, 48 + fr), tH = __shfl(iH, 48 + fr);
                const float cA = Ac[ct] * eA, cH = eA * hl[ct] + eH;
#pragma unroll
                for (int rg = 0; rg < 4; ++rg) { const size_t row = (size_t)b * SEQ + t0 + sub * 16 + 4 * fq + rg;
                    LA[row * 512 + ch] = f2bf(cA * Ap[rg]); LH[row * 512 + ch] = f2bf(Ap[rg] * cH + Hp[rg]); }
                hl[ct] = tA * hl[ct] + tH; Ac[ct] = Ac[ct] * tA;
            }
            __syncthreads();
        }
        if (fq == 0) {
#pragma unroll
            for (int ct = 0; ct < 4; ++ct) { const int ch = g * 64 + ct * 16 + fr; Aend[((size_t)b * 64 + c) * 512 + ch] = Ac[ct]; Hend[((size_t)b * 64 + c) * 512 + ch] = hl[ct]; } }
    }
    __syncthreads();
}

DI void p8b_scans(const Frame& F) {
    const int gt = F.bid * 512 + F.tid, nthr = F.G * 512;
    if (gt < 4096) {
        const int b = gt >> 9, ch = gt & 511;
        const float* Aend = (const float*)(F.ws + WS_AEND); const float* Hend = (const float*)(F.ws + WS_HEND); float* Hin = (float*)(F.ws + WS_HIN);
        float H = 0.f;
#pragma unroll 1
        for (int c0 = 0; c0 < 64; c0 += 8) {
            float av[8], hv[8];
#pragma unroll
            for (int j = 0; j < 8; ++j) { const size_t o = ((size_t)b * 64 + c0 + j) * 512 + ch; av[j] = Aend[o]; hv[j] = Hend[o]; }
#pragma unroll
            for (int j = 0; j < 8; ++j) { const size_t o = ((size_t)b * 64 + c0 + j) * 512 + ch; Hin[o] = H; H = av[j] * H + hv[j]; }
        }
    }
    const float* scal = (const float*)(F.ws + WS_SCAL); float* minp = (float*)(F.ws + WS_SCAL) + 4096;
    if (gt >= nthr - 4096) {
        const int q = gt - (nthr - 4096); const int bh = q >> 7, d = q & 127;
        const float* zloc = (const float*)(F.ws + WS_ZLOC); float* nin = (float*)(F.ws + WS_NIN);
        float m = 0.f, n = 0.f;
#pragma unroll 1
        for (int c0 = 0; c0 < 64; c0 += 8) {
            float zv[8];
#pragma unroll
            for (int j = 0; j < 8; ++j) zv[j] = zloc[(size_t)(bh * 64 + c0 + j) * 128 + d];
#pragma unroll
            for (int j = 0; j < 8; ++j) { const int unit = bh * 64 + c0 + j; const float bl = scal[unit], dm = scal[2048 + unit];
                const float mn = fmaxf(bl + m, dm); const float keep = expf(bl + m - mn), add = expf(dm - mn);
                nin[(size_t)unit * 128 + d] = n; if (d == 0) minp[unit] = m;
                n = keep * n + add * zv[j]; m = mn; }
        }
    }
    bf16_t* ST = (bf16_t*)(F.ws + WS_BFB);
    float* kp = (float*)F.lds; float* ad = kp + 64;
    if (gt < 65536) {
        const int bh = gt >> 11, ed = (gt & 2047) * 8;
        if (F.wave == 0) { const int c = F.lane; const int unit = bh * 64 + c; const float bl = scal[unit], dm = scal[2048 + unit];
            float Bi = bl;
            for (int o = 1; o < 64; o <<= 1) { const float n = __shfl_up(Bi, o); if (c >= o) Bi += n; }
            float pm = dm - Bi;
            for (int o = 1; o < 64; o <<= 1) { const float n = __shfl_up(pm, o); if (c >= o) pm = fmaxf(pm, n); }
            const float mnext = Bi + fmaxf(0.f, pm);
            float mcur = __shfl_up(mnext, 1); if (c == 0) mcur = 0.f;
            kp[c] = expf(bl + mcur - mnext); ad[c] = expf(dm - mnext); }
        __syncthreads();
        float C[8] = {0.f, 0.f, 0.f, 0.f, 0.f, 0.f, 0.f, 0.f};
#pragma unroll 1
        for (int c0 = 0; c0 < 64; c0 += 8) {
            uint4 sv[8];
#pragma unroll
            for (int j = 0; j < 8; ++j) sv[j] = *(const uint4*)(ST + (size_t)(bh * 64 + c0 + j) * 16384 + ed);
#pragma unroll
            for (int j = 0; j < 8; ++j) { float sf[8]; unpack8(sv[j], sf);
                uint4 o; o.x = pack2(C[0], C[1]); o.y = pack2(C[2], C[3]); o.z = pack2(C[4], C[5]); o.w = pack2(C[6], C[7]);
                *(uint4*)(ST + (size_t)(bh * 64 + c0 + j) * 16384 + ed) = o;
                const float kk = kp[c0 + j], aa = ad[c0 + j];
#pragma unroll
                for (int i = 0; i < 8; ++i) C[i] = kk * C[i] + aa * sf[i]; }
        }
    }
}

DI void p8c_mlstm_out(const Frame& F) {
    const bf16_t* U1 = (const bf16_t*)(F.ws + WS_U);
    const bf16_t* ST = (const bf16_t*)(F.ws + WS_BFB);
    bf16_t* Y = (bf16_t*)(F.ws + WS_BFA);
    const float* nin_g = (const float*)(F.ws + WS_NIN); const float* minp = (const float*)(F.ws + WS_SCAL) + 4096;
    unsigned char* L = F.lds;
    float* li = (float*)(L + ML_LI); float* bc = (float*)(L + ML_BC); float* wkk = (float*)(L + ML_WK); float* mt = (float*)(L + ML_MT); float* dq = (float*)(L + ML_DQ); float* rs = (float*)(L + ML_RS); float* nin = (float*)(L + ML_NIN);
    bf16_t* q = (bf16_t*)(L + ML_Q); bf16_t* k = (bf16_t*)(L + ML_K); bf16_t* vT = (bf16_t*)(L + ML_VT); bf16_t* CT = (bf16_t*)(L + ML_CT); bf16_t* W = (bf16_t*)(L + ML_W); float* cwl = (float*)(L + ML_END); bf16_t* raw = (bf16_t*)(L + ML_KT); float* HT = (float*)(L + ML_Q);
    const float* cw = F.in[24]; const float* cb = F.in[25];
    uint4 rq3[3], rk3[3], rv3[3]; u32x4 rc4[4];
    auto prefetch = [&](int unit) { const int c = unit & 63, h = (unit >> 6) & 3, b = unit >> 8;
        load_raw128(F, U1, b, c * 64 - 3, 67, C_DQ + h * 128, rq3);
        load_raw128(F, U1, b, c * 64 - 3, 67, C_DK + h * 128, rk3);
        load_raw128(F, U1, b, c * 64, 64, C_DV + h * 128, rv3);
#pragma unroll
        for (int j = 0; j < 4; ++j) { const int it = F.tid + j * 512; rc4[j] = *(const u32x4*)(ST + (size_t)unit * 16384 + (it >> 4) * 128 + (it & 15) * 8); } };
    if (F.bid < 2048) prefetch(F.bid);
    for (int unit = F.bid; unit < 2048; unit += F.G) {
        const int c = unit & 63, h = (unit >> 6) & 3, b = unit >> 8;
        const float m_in = minp[unit];
        for (int e = F.tid; e < 1280; e += 512) { float v;
            if (e < 512) v = cw[(size_t)(e >> 7) * 1024 + h * 128 + (e & 127)]; else if (e < 1024) v = cw[(size_t)((e - 512) >> 7) * 1024 + 512 + h * 128 + (e & 127)];
            else if (e < 1152) v = cb[h * 128 + (e - 1024)]; else v = cb[512 + h * 128 + (e - 1152)];
            cwl[e] = v; }
        mlstm_gates(F, U1, b, h, c, li, bc);
        write_raw128(F, 67, rq3, raw);
        __syncthreads();
        for (int it = F.tid; it < 1024; it += 512) { const int s = it & 63, d0 = (it >> 6) * 8;
            float y[8]; conv8_lds(raw, s, d0, cwl, cwl + 1024, y);
            uint4 o; o.x = pack2(siluf_(y[0]), siluf_(y[1])); o.y = pack2(siluf_(y[2]), siluf_(y[3])); o.z = pack2(siluf_(y[4]), siluf_(y[5])); o.w = pack2(siluf_(y[6]), siluf_(y[7]));
            *(uint4*)(q + s * 136 + d0) = o; }
        __syncthreads();
        write_raw128(F, 67, rk3, raw);
        __syncthreads();
        for (int it = F.tid; it < 1024; it += 512) { const int s = it & 63, d0 = (it >> 6) * 8;
            float y[8]; conv8_lds(raw, s, d0, cwl + 512, cwl + 1152, y);
            const float sc = 0.08838834764831845f; uint4 o;
            o.x = pack2(siluf_(y[0]) * sc, siluf_(y[1]) * sc); o.y = pack2(siluf_(y[2]) * sc, siluf_(y[3]) * sc); o.z = pack2(siluf_(y[4]) * sc, siluf_(y[5]) * sc); o.w = pack2(siluf_(y[6]) * sc, siluf_(y[7]) * sc);
            *(uint4*)(k + s * 136 + d0) = o; }
        __syncthreads();
        write_raw128(F, 64, rv3, raw);
        __syncthreads();
        for (int it = F.tid; it < 1024; it += 512) { const int s = it & 63, d0 = (it >> 6) * 8;
            const uint4 vv = *(const uint4*)(raw + s * 136 + d0); const unsigned wv[4] = {vv.x, vv.y, vv.z, vv.w};
#pragma unroll
            for (int i = 0; i < 8; ++i) vT[(d0 + i) * 72 + s] = (bf16_t)((i & 1) ? (wv[i >> 1] >> 16) : (wv[i >> 1] & 0xFFFFu)); }
#pragma unroll
        for (int j = 0; j < 4; ++j) { const int it = F.tid + j * 512; *(u32x4*)(CT + (it >> 4) * 136 + (it & 15) * 8) = rc4[j]; }
        if (unit + F.G < 2048) prefetch(unit + F.G);
        if (F.tid < 128) nin[F.tid] = nin_g[(size_t)unit * 128 + F.tid];
        if (F.tid >= 128 && F.tid < 192) { const int l = F.tid - 128;
            float pm = li[l] - bc[l];
            for (int o = 1; o < 64; o <<= 1) { const float n = __shfl_up(pm, o); if (l >= o) pm = fmaxf(pm, n); }
            mt[l] = bc[l] + fmaxf(m_in, pm); }
        __syncthreads();
        { const int l = F.tid >> 3, part = F.tid & 7; float a = 0.f;
#pragma unroll
          for (int d = 0; d < 16; ++d) a += bf2f(q[l * 136 + part * 16 + d]) * nin[part * 16 + d];
          a += __shfl_xor(a, 1); a += __shfl_xor(a, 2); a += __shfl_xor(a, 4);
          if (part == 0) dq[l] = a; }
        for (int tix = F.wave * 2; tix < F.wave * 2 + 2; ++tix) {
            const int lt = tix >> 2, st = tix & 3;
            const f32x4 a = mma16(q + lt * 16 * 136, 136, k + st * 16 * 136, 136, 128, F.lane);
            const int fr = F.lane & 15, fq = F.lane >> 4; const int s = st * 16 + fr;
#pragma unroll
            for (int r = 0; r < 4; ++r) { const int l = lt * 16 + 4 * fq + r;
                const float w = s <= l ? a[r] * expf(bc[l] - bc[s] + li[s] - mt[l]) : 0.f;
                W[l * 72 + s] = f2bf(w); }
        }
        __syncthreads();
        { const int l = F.tid >> 3, part = F.tid & 7; float a = 0.f;
#pragma unroll
          for (int s = 0; s < 8; ++s) a += bf2f(W[l * 72 + part * 8 + s]);
          a += __shfl_xor(a, 1); a += __shfl_xor(a, 2); a += __shfl_xor(a, 4);
          if (part == 0) rs[l] = a; }
        if (F.tid >= 64 && F.tid < 128) { const int l = F.tid - 64; li[l] = expf(bc[l] + m_in - mt[l]); }
        if (F.tid >= 128 && F.tid < 192) { const int l = F.tid - 128; wkk[l] = expf(-mt[l]); }
        __syncthreads();
        uint4 ro2[2], rz2[2];
#pragma unroll
        for (int j = 0; j < 2; ++j) { const int it = F.tid + j * 512; const size_t row = (size_t)b * SEQ + c * 64 + (it >> 4);
            ro2[j] = *(const uint4*)(U1 + row * LD1 + C_DO + h * 128 + (it & 15) * 8); rz2[j] = *(const uint4*)(U1 + row * LD1 + C_DZ + h * 128 + (it & 15) * 8); }
        f32x4 hres[4];
#pragma unroll
        for (int ti = 0; ti < 4; ++ti) { const int tix = F.wave * 4 + ti;
            const int lt = tix >> 3, et = tix & 7;
            const f32x4 qc = mma16(q + lt * 16 * 136, 136, CT + et * 16 * 136, 136, 128, F.lane);
            const f32x4 wv = mma16(W + lt * 16 * 72, 72, vT + et * 16 * 72, 72, 64, F.lane);
            const int fq = F.lane >> 4;
#pragma unroll
            for (int r = 0; r < 4; ++r) { const int l = lt * 16 + 4 * fq + r;
                const float prev = li[l];
                const float num = prev * qc[r] + wv[r];
                const float den = prev * dq[l] + rs[l];
                hres[ti][r] = num * __builtin_amdgcn_rcpf(fmaxf(fabsf(den), wkk[l])); }
        }
        __syncthreads();
#pragma unroll
        for (int ti = 0; ti < 4; ++ti) { const int tix = F.wave * 4 + ti; const int lt = tix >> 3, et = tix & 7; const int fr = F.lane & 15, fq = F.lane >> 4;
#pragma unroll
            for (int r = 0; r < 4; ++r) HT[(lt * 16 + 4 * fq + r) * 132 + et * 16 + fr] = hres[ti][r]; }
        __syncthreads();
#pragma unroll
        for (int j = 0; j < 2; ++j) { const int it = F.tid + j * 512; const int l = it >> 4, e0 = (it & 15) * 8;
            const size_t row = (size_t)b * SEQ + c * 64 + l;
            float of[8], zf[8]; unpack8(ro2[j], of); unpack8(rz2[j], zf);
            const f32x4 h0 = *(const f32x4*)(HT + l * 132 + e0), h1 = *(const f32x4*)(HT + l * 132 + e0 + 4);
            float y[8];
#pragma unroll
            for (int i = 0; i < 4; ++i) { y[i] = sigmoidf_(of[i]) * h0[i] * siluf_(zf[i]); y[4 + i] = sigmoidf_(of[4 + i]) * h1[i] * siluf_(zf[4 + i]); }
            uint4 o; o.x = pack2(y[0], y[1]); o.y = pack2(y[2], y[3]); o.z = pack2(y[4], y[5]); o.w = pack2(y[6], y[7]);
            *(uint4*)(Y + row * 1024 + 512 + h * 128 + e0) = o; }
        __syncthreads();
    }
}
DI void p8c_lru_out(const Frame& F) {
    const bf16_t* U1 = (const bf16_t*)(F.ws + WS_U);
    const bf16_t* LA = (const bf16_t*)(F.ws + WS_LRUA); const bf16_t* LH = (const bf16_t*)(F.ws + WS_LRUH);
    const float* Hin = (const float*)(F.ws + WS_HIN);
    bf16_t* Y = (bf16_t*)(F.ws + WS_BFA);
    const size_t n8 = (size_t)MT * 64;
    for (size_t it = (size_t)F.bid * 512 + F.tid; it < n8; it += (size_t)F.G * 512) {
        const size_t row = it >> 6; const int c0 = (int)(it & 63) * 8; const int b = (int)(row >> 12), t = (int)(row & 4095), c = t >> 6;
        const uint4 av = *(const uint4*)(LA + row * 512 + c0), hv = *(const uint4*)(LH + row * 512 + c0), zv = *(const uint4*)(U1 + row * LD1 + C_CZ + c0);
        float af[8], hf[8], zf[8]; unpack8(av, af); unpack8(hv, hf); unpack8(zv, zf);
        const float* hi = Hin + ((size_t)b * 64 + c) * 512 + c0; float y[8];
#pragma unroll
        for (int i = 0; i < 8; ++i) y[i] = (af[i] * hi[i] + hf[i]) * siluf_(zf[i]);
        uint4 o; o.x = pack2(y[0], y[1]); o.y = pack2(y[2], y[3]); o.z = pack2(y[4], y[5]); o.w = pack2(y[6], y[7]);
        *(uint4*)(Y + row * 1024 + c0) = o;
    }
}

constexpr int N_PHASES = 16;
__global__ void __launch_bounds__(512, 2) mk_fwd(Args args) {
    extern __shared__ __attribute__((aligned(16))) unsigned char smem[];
    Frame F;
    F.tid = threadIdx.x; F.lane = F.tid & 63; F.wave = __builtin_amdgcn_readfirstlane(F.tid >> 6);
    F.G = gridDim.x; F.bid = blockIdx.x; F.gw = F.bid * 8 + F.wave; F.nw = F.G * 8;
    F.lds = smem + LDS_WORK_OFF; F.ws = args.ws; F.out = args.out; F.ctl = (unsigned*)args.ws;
#pragma unroll
    for (int i = 0; i < 28; ++i) F.in[i] = args.in[i];
    LAS unsigned char* lsm = (LAS unsigned char*)smem;
    LAS unsigned char* lut = lsm + (LDS_BYTES - 12288);
    LAS float* tbl = (LAS float*)(lsm + (LDS_BYTES - 12288 + 256));
    LAS float* biasL = (LAS float*)(lsm + (LDS_BYTES - 8192));
    if (F.tid < 4) ((LAS unsigned*)lsm)[F.tid] = 0u;
    if (F.tid < 128) { const int n = F.tid; int bk;
        if (n < 16) bk = n; else { bk = 16; const int thr[15] = {19, 21, 24, 27, 31, 35, 40, 46, 52, 59, 67, 77, 87, 99, 113};
#pragma unroll
            for (int j = 0; j < 15; ++j) bk += (n >= thr[j]) ? 1 : 0; }
        lut[n] = (unsigned char)bk; }
    { const int hd = F.tid >> 5, bk = F.tid & 31; tbl[hd * 32 + bk] = args.in[6][bk * 16 + hd]; }
    F.lut = lut; F.tbl = tbl; F.biasL = biasL; F.ldsl = lsm + LDS_WORK_OFF;
    __syncthreads();
    for (int e = F.tid; e < 16 * 128; e += 512) { const int hd = e >> 7, n = e & 127; const int bk = n < 16 ? n : (n >= 113 ? 31 : (int)lut[n]); biasL[e] = tbl[hd * 32 + bk] * 1.4426950408889634f; }
    __syncthreads();
    const int lo = args.ph_lo, hi = args.ph_hi;
    XcdBarrier bar; bar.bar = F.ctl; bar.x = 0; bar.st = nullptr;
#if !MK_PER_PHASE
    bar = xcd_barrier_post(F.ctl, (volatile LAS unsigned*)lsm);
#endif
#ifndef PH_MASK
#define PH_MASK 0xFFFF
#endif
#define IN(k) (phase_refresh(F), ((PH_MASK >> (k)) & 1) && lo <= (k) && (k) < hi)
#ifndef DLY_LO
#define DLY_LO -1
#define DLY_HI -1
#endif
#ifndef DLY_MULT
#define DLY_MULT 4
#endif
    unsigned long long dly_t0 = 0ull;
#define DLY_START(k) do { if ((k) == DLY_LO && F.bid == 0 && F.tid == 0) dly_t0 = __builtin_amdgcn_s_memrealtime(); } while (0)
#define DLY_END(k) do { if ((k) == DLY_HI && F.bid == 0) { if (F.tid == 0) { const unsigned long long t1 = __builtin_amdgcn_s_memrealtime(); const unsigned long long until = t1 + DLY_MULT * (t1 - dly_t0); \
        while (__builtin_amdgcn_s_memrealtime() < until) __builtin_amdgcn_s_sleep(16); } __syncthreads(); } } while (0)
#if MK_PER_PHASE
#define SEAM(k) do { } while (0)
#else
#define SEAM(k) do { if (IN(k) && IN((k) + 1)) xcd_barrier(bar); DLY_END(k); DLY_START((k) + 1); } while (0)
#endif
    LAS unsigned char* glds = lsm + LDS_WORK_OFF;
    unsigned char* ws = args.ws;
    bf16_t* BFA = (bf16_t*)(ws + WS_BFA); bf16_t* BFB = (bf16_t*)(ws + WS_BFB); bf16_t* U = (bf16_t*)(ws + WS_U); bf16_t* Ef = (bf16_t*)(ws + WS_U); bf16_t* X1b = (bf16_t*)F.out;

    DLY_START(0);
    if (IN(0)) { p0_prologue(F); }
    SEAM(0);
    if (IN(1)) {
        pg8::Gemm g{BFA, (const bf16_t*)(ws + WS_WIN0), MT, LD0, 1024}; pg8::StaticOrder S; S.init(MT, LD0, F.G, F.bid);
        pg8::EpiBf16<0> E{U, LD0};
        pg8::gemm_phase(glds, g, S, E);
        pg8::Gemm g2{(const bf16_t*)(ws + WS_WVT), BFA, 512, MT, 1024}; pg8::StaticOrder S2; S2.init(512, MT, F.G, F.bid);
        pg8::EpiBf16<0> E2{(bf16_t*)(ws + WS_VT), MT};
        pg8::gemm_phase(glds, g2, S2, E2);
    }
    SEAM(1);
    if (IN(2)) { p2a_build_blocks(F); }
    SEAM(2);
    if (IN(3)) {
        if (F.bid < 32) {
            const int which = F.bid >> 4;
            pg8::Gemm g{(const bf16_t*)(ws + (which ? WS_AV : WS_AK)), (const bf16_t*)(ws + (which ? WS_WC1V : WS_WC1K)), 4096, 256, 2048}; pg8::StaticOrder S; S.init(4096, 256, F.G, F.bid & 15);
            pg8::EpiBf16<1> E{(bf16_t*)(ws + (which ? WS_HV : WS_HK)), 256}; pg8::gemm_phase(glds, g, S, E);
            asm volatile("s_waitcnt vmcnt(0)" ::: "memory"); __syncthreads();
            pg8::Unit u; S.next(0, u);
            p2c_compress_rows(F, which, u.pm * 256);
            asm volatile("s_waitcnt vmcnt(0)" ::: "memory"); __syncthreads();
            if (F.tid == 0) { __builtin_amdgcn_fence(__ATOMIC_RELEASE, "agent"); asm volatile("s_waitcnt vmcnt(0)" ::: "memory");
                (void)__hip_atomic_fetch_add(F.ctl + CW_CMPDONE, 1u, __ATOMIC_RELAXED, __HIP_MEMORY_SCOPE_AGENT); }
        }
        att_dsa(F);
    }
    if (IN(5)) {
        if (F.tid == 0) { unsigned sp = 0;
            while (__hip_atomic_load(F.ctl + CW_CMPDONE, __ATOMIC_RELAXED, __HIP_MEMORY_SCOPE_AGENT) < 32u) { __builtin_amdgcn_s_sleep(2);
                if (++sp > (1u << 22)) { atomicAdd(F.ctl + XB_TMO, 1u); break; } }
            __builtin_amdgcn_fence(__ATOMIC_ACQUIRE, "agent"); asm volatile("s_waitcnt vmcnt(0)" ::: "memory"); }
        __syncthreads();
        att_nsa(F); }
    if (IN(3) && IN(6)) xcd_barrier(bar);
    if (IN(6)) {
        pg8::Gemm g{BFB, (const bf16_t*)(ws + WS_WOUT0), MT, 1024, 1024}; pg8::StaticOrder S; S.init(MT, 1024, F.G, F.bid);
        pg8::EpiResid<0> E{F.in[0], nullptr, BFA};
        pg8::gemm_phase(glds, g, S, E);
    }
    SEAM(6);
    if (IN(7)) {
        { pg8::Gemm g{(const bf16_t*)(ws + WS_PBF), (const bf16_t*)(ws + WS_WP0), MT, 1024, 256}; pg8::StaticOrder S; S.init(MT, 1024, F.G, F.bid);
          pg8::EpiBf16<0> E{Ef, 1024}; pg8::gemm_phase(glds, g, S, E); }
        asm volatile("s_waitcnt vmcnt(0)" ::: "memory"); __syncthreads();
        { pg8::Gemm g{BFA, (const bf16_t*)(ws + WS_WG0), MT, 1024, 1024}; pg8::StaticOrder S; S.init(MT, 1024, F.G, F.bid);
          pg8::EpiGate<1> E{nullptr, X1b, BFA, Ef}; pg8::gemm_phase(glds, g, S, E); }
    }
    SEAM(7);
    if (IN(8)) { rmsnorm_gates(F, X1b, F.in[2] + 1024, BFB); }
    SEAM(8);
    if (IN(9)) {
        pg8::Gemm g{BFB, (const bf16_t*)(ws + WS_WIN1), MT, LD1, 1024}; pg8::StaticOrder S; S.init(MT, LD1, F.G, F.bid);
        pg8::EpiBf16<0> E{U, LD1};
        pg8::gemm_phase(glds, g, S, E);
    }
    SEAM(9);
    if (IN(10)) { p8a_mlstm_local(F); p8a_lru_local(F); }
    SEAM(10);
    if (IN(11)) { p8b_scans(F); }
    SEAM(11);
    if (IN(12)) { p8c_mlstm_out(F); p8c_lru_out(F); }
    SEAM(12);

    if (IN(13)) {
        pg8::Gemm g{BFA, (const bf16_t*)(ws + WS_WOUT1), MT, 1024, 1024}; pg8::StaticOrder S; S.init(MT, 1024, F.G, F.bid);
        pg8::EpiResid<1> E{nullptr, X1b, BFB};
        pg8::gemm_phase(glds, g, S, E);
    }
    SEAM(13);
    if (IN(14)) {
        { pg8::Gemm g{(const bf16_t*)(ws + WS_PBF) + (size_t)MT * 256, (const bf16_t*)(ws + WS_WP1), MT, 1024, 256}; pg8::StaticOrder S; S.init(MT, 1024, F.G, F.bid);
          pg8::EpiBf16<0> E{Ef, 1024}; pg8::gemm_phase(glds, g, S, E); }
        asm volatile("s_waitcnt vmcnt(0)" ::: "memory"); __syncthreads();
        { pg8::Gemm g{BFB, (const bf16_t*)(ws + WS_WG1), MT, 1024, 1024}; pg8::StaticOrder S; S.init(MT, 1024, F.G, F.bid);
          pg8::EpiGateNorm E{F.out, BFB, Ef, F.in[3], (float*)(ws + WS_SS), F.ctl + CW_NORMCNT, F.ctl + XB_TMO}; pg8::gemm_phase(glds, g, S, E); }
    }
#undef IN
#undef SEAM
}

extern "C" void kernel_launch(void* const* d_in, const int* in_sizes, int n_in, void* d_out, int out_size, void* d_ws, size_t ws_size, hipStream_t stream) {
    static int grid = 0;
    if (grid == 0) {
        if (n_in != 28 || out_size != MT * DM || ws_size < WS_END) { fprintf(stderr, "kernel_launch: unexpected shapes (n_in %d, out %d, ws %zu < %zu)\n", n_in, out_size, ws_size, (size_t)WS_END); grid = -1; return; }
        int dev = 0, cus = 0, per_cu = 0;
        if (hipGetDevice(&dev) != hipSuccess || hipDeviceGetAttribute(&cus, hipDeviceAttributeMultiprocessorCount, dev) != hipSuccess) { grid = -1; return; }
        if (hipFuncSetAttribute((const void*)mk_fwd, hipFuncAttributeMaxDynamicSharedMemorySize, LDS_BYTES) != hipSuccess) { fprintf(stderr, "kernel_launch: hipFuncSetAttribute failed\n"); grid = -1; return; }
        if (hipOccupancyMaxActiveBlocksPerMultiprocessor(&per_cu, (const void*)mk_fwd, 512, LDS_BYTES) != hipSuccess || per_cu < 1)
            fprintf(stderr, "kernel_launch: occupancy query reports %d workgroups per CU\n", per_cu);
        (void)hipGetLastError();
        grid = cus > 256 ? 256 : cus;
    }
    if (grid < 0) return;
    if (hipMemsetAsync(d_ws, 0, CTL_BYTES, stream) != hipSuccess) return;
    Args a{};
    for (int i = 0; i < 28; ++i) a.in[i] = (const float*)d_in[i];
    a.out = (float*)d_out; a.ws = (unsigned char*)d_ws;
#if MK_PER_PHASE
    for (int p = 0; p < N_PHASES; ++p) { a.ph_lo = p; a.ph_hi = p + 1; hipLaunchKernelGGL(mk_fwd, dim3(grid), dim3(512), LDS_BYTES, stream, a); }
#else
    a.ph_lo = 0; a.ph_hi = N_PHASES;
    hipLaunchKernelGGL(mk_fwd, dim3(grid), dim3(512), LDS_BYTES, stream, a);
#endif
}
```

```cpp
#include <hip/hip_runtime.h>
#include <cstdio>
#include <cstdint>

#ifndef MK_PER_PHASE
#define MK_PER_PHASE 0
#endif

#define LAS __attribute__((address_space(3)))
typedef unsigned short bf16_t;
typedef short bf16x8 __attribute__((ext_vector_type(8)));
typedef float f32x4 __attribute__((ext_vector_type(4)));
#define DI __device__ __forceinline__

constexpr int NB = 8, SEQ = 4096, DM = 1024, MT = NB * SEQ;
constexpr int LD0 = 3072, LD1 = 3584;
constexpr int C_AQ = 0, C_KC = 512, C_VC = 640, C_KS = 768, C_KW = 896, C_AZ = 1024, C_BQ = 1536, C_BZ = 2048,
              C_BK = 2560, C_BKI = 2624, C_BQI = 2688, C_AG = 2944, C_BWI = 2968;
constexpr int C_VS = 0, C_VW = 0, C_BV = 0;
constexpr int C_CX = 0, C_CZ = 512, C_DQ = 1024, C_DK = 1536, C_DV = 2048, C_DO = 2560, C_DZ = 3072;
constexpr int NCMP = 255;
constexpr float NEG_INF = -__builtin_inff();

DI int map0(int n) {
    if (n < 896) return n;
    if (n < 1024) return 1024 + (n - 896);
    if (n < 1536) return 1304 + (n - 1024);
    if (n < 2048) return 1816 + (n - 1536);
    if (n < 2560) return 2780 + (n - 2048);
    if (n < 2624) return 2328 + (n - 2560);
    if (n < 2688) return 2712 + (n - 2624);
    if (n < 2944) return 2456 + (n - 2688);
    if (n < 2968) return 1280 + (n - 2944);
    if (n < 2972) return 2776 + (n - 2968);
    return -1;
}
DI int map1(int n) {
    if (n < 2560) return n;
    if (n < 3072) return 2568 + (n - 2560);
    if (n < 3584) return 3080 + (n - 3072);
    return -1;
}
DI int mapid(int n) { return n; }
DI int mapv(int f) { return f < 128 ? 896 + f : (f < 256 ? 1152 + (f - 128) : (f < 320 ? 2392 + (f - 256) : -1)); }

constexpr size_t CTL_BYTES = 16384;
constexpr size_t WS_WIN0  = CTL_BYTES;
constexpr size_t WS_WOUT0 = WS_WIN0  + (size_t)LD0 * 1024 * 2;
constexpr size_t WS_WG0   = WS_WOUT0 + (size_t)1024 * 1024 * 2;
constexpr size_t WS_WP0   = WS_WG0   + (size_t)1024 * 1024 * 2;
constexpr size_t WS_WIN1  = WS_WP0   + (size_t)1024 * 256 * 2;
constexpr size_t WS_WOUT1 = WS_WIN1  + (size_t)LD1 * 1024 * 2;
constexpr size_t WS_WG1   = WS_WOUT1 + (size_t)1024 * 1024 * 2;
constexpr size_t WS_WP1   = WS_WG1   + (size_t)1024 * 1024 * 2;
constexpr size_t WS_WC1K  = WS_WP1   + (size_t)1024 * 256 * 2;
constexpr size_t WS_WC1V  = WS_WC1K  + (size_t)256 * 2048 * 2;
constexpr size_t WS_WVT   = WS_WC1V  + (size_t)256 * 2048 * 2;
constexpr size_t WS_BFA   = WS_WVT   + (size_t)512 * 1024 * 2;
constexpr size_t WS_BFB   = WS_BFA   + (size_t)MT * 1024 * 2;
constexpr size_t WS_PBF   = WS_BFB   + (size_t)MT * 1024 * 2;
constexpr size_t WS_U     = WS_PBF   + (size_t)2 * MT * 256 * 2;
constexpr size_t WS_X     = WS_U     + (size_t)MT * LD1 * 2;
constexpr size_t WS_AK    = WS_X;
constexpr size_t WS_AV    = WS_AK    + (size_t)4096 * 2048 * 2;
constexpr size_t WS_HK    = WS_AV    + (size_t)4096 * 2048 * 2;
constexpr size_t WS_HV    = WS_HK    + (size_t)4096 * 256 * 2;
constexpr size_t WS_LRUA  = WS_X;
constexpr size_t WS_LRUH  = WS_LRUA  + (size_t)MT * 512 * 2;
constexpr size_t WS_S     = WS_X     + (size_t)64 * 1024 * 1024;
constexpr size_t WS_KCMP  = WS_S;
constexpr size_t WS_VCMP  = WS_KCMP  + (size_t)16 * 256 * 64 * 4;
constexpr size_t WS_AEND  = WS_VCMP  + (size_t)16 * 256 * 64 * 4;
constexpr size_t WS_HEND  = WS_AEND  + (size_t)8 * 64 * 512 * 4;
constexpr size_t WS_HIN   = WS_HEND  + (size_t)8 * 64 * 512 * 4;
constexpr size_t WS_ZLOC  = WS_HIN   + (size_t)8 * 64 * 512 * 4;
constexpr size_t WS_NIN   = WS_ZLOC  + (size_t)2048 * 128 * 4;
constexpr size_t WS_SCAL  = WS_NIN   + (size_t)2048 * 128 * 4;
constexpr size_t WS_VCT   = WS_SCAL  + (size_t)3 * 2048 * 4;
constexpr size_t WS_WAT   = WS_VCT   + (size_t)16 * 64 * 256 * 2;
constexpr size_t WS_WXT   = WS_WAT   + (size_t)8 * 64 * 64 * 2;
constexpr size_t WS_GATES = WS_WXT   + (size_t)8 * 64 * 64 * 2;
constexpr size_t WS_SS    = WS_GATES + (size_t)MT * 8 * 4;
constexpr size_t WS_IMGN  = WS_SS    + (size_t)MT * 4;
constexpr size_t WS_IMGD  = WS_IMGN  + (size_t)6 * 65536;
constexpr size_t WS_IMGW  = WS_IMGD  + (size_t)8 * 65536;
constexpr size_t WS_IMGZ  = WS_IMGW  + (size_t)65536;
constexpr size_t WS_END   = WS_IMGZ  + (size_t)8192;
constexpr size_t WS_VT    = WS_U     + (size_t)MT * LD0 * 2;
static_assert(WS_VT + (size_t)512 * MT * 2 <= WS_X, "VT region");
static_assert(WS_HV + (size_t)4096 * 256 * 2 <= WS_S, "compress region");
static_assert(WS_LRUH + (size_t)MT * 512 * 2 <= WS_S, "lru region");

constexpr int XCD_BAR_WORDS_C = 3456;
constexpr int CW_QNSA = 3520, CW_QDSA = 3584;
constexpr int CW_NORMCNT = 3712;
constexpr int CW_CMPDONE = 3648;

constexpr int LDS_BYTES = 147456;
constexpr int LDS_CTL_OFF = 0;
constexpr int LDS_WORK_OFF = 128;

DI float bf2f(bf16_t v) { return __uint_as_float(((unsigned)v) << 16); }
DI bf16_t f2bf(float f) { unsigned u = __float_as_uint(f); u += 0x7FFFu + ((u >> 16) & 1u); return (bf16_t)(u >> 16); }
typedef __bf16 bf16v2 __attribute__((ext_vector_type(2)));
typedef float f32x2 __attribute__((ext_vector_type(2)));
DI unsigned pack2(float lo, float hi) { const f32x2 v = {lo, hi}; return __builtin_bit_cast(unsigned, __builtin_convertvector(v, bf16v2)); }
DI float fexp_(float x) { return __builtin_amdgcn_exp2f(x * 1.4426950408889634f); }
DI float sigmoidf_(float x) { return __builtin_amdgcn_rcpf(1.0f + fexp_(-x)); }
DI float siluf_(float x) { return x * __builtin_amdgcn_rcpf(1.0f + fexp_(-x)); }
DI float wave_max(float v) { for (int o = 32; o >= 1; o >>= 1) v = fmaxf(v, __shfl_xor(v, o)); return v; }
DI float wave_sum(float v) { for (int o = 32; o >= 1; o >>= 1) v += __shfl_xor(v, o); return v; }
DI void unpack8(const uint4& v, float (&f)[8]) {
    f[0] = __uint_as_float(v.x << 16); f[1] = __uint_as_float(v.x & 0xFFFF0000u);
    f[2] = __uint_as_float(v.y << 16); f[3] = __uint_as_float(v.y & 0xFFFF0000u);
    f[4] = __uint_as_float(v.z << 16); f[5] = __uint_as_float(v.z & 0xFFFF0000u);
    f[6] = __uint_as_float(v.w << 16); f[7] = __uint_as_float(v.w & 0xFFFF0000u);
}

#define XB_TMO      128
#define XB_XCNT(j)  (256  + 64 * (j))
#define XB_XSUB(j)  (1280 + 64 * (j))
#define XB_XGEN(j)  (2304 + 64 * (j))
#define XB_TOP      3328
#define XB_TOPGEN   3392
#define XCD_BAR_WORDS 3456
#define XB_SPIN_CAP (1u << 22)
static_assert(XCD_BAR_WORDS == XCD_BAR_WORDS_C, "bar words");

__device__ __forceinline__ unsigned xb_ld(unsigned* p)              { return __hip_atomic_load(p, __ATOMIC_RELAXED, __HIP_MEMORY_SCOPE_AGENT); }
__device__ __forceinline__ unsigned xb_add(unsigned* p, unsigned v) { return __hip_atomic_fetch_add(p, v, __ATOMIC_RELAXED, __HIP_MEMORY_SCOPE_AGENT); }
__device__ __forceinline__ unsigned xb_xcc_id() { return (unsigned)__builtin_amdgcn_s_getreg((3 << 11) | 20) & 0xFu; }
#define XB_SPIN(cond, bar) do { unsigned _sp = 0; while (cond) { __builtin_amdgcn_s_sleep(1); \
    if ((++_sp & 255u) == 0u) { if (xb_ld(&(bar)[XB_TMO])) break; if (_sp > XB_SPIN_CAP) { atomicAdd(&(bar)[XB_TMO], 1u); break; } } } } while (0)

struct XcdBarrier { unsigned* bar; unsigned x; volatile LAS unsigned* st; };

__device__ __forceinline__ XcdBarrier xcd_barrier_post(unsigned* bar, volatile LAS unsigned* st) {
    XcdBarrier b; b.bar = bar; b.x = xb_xcc_id(); b.st = st;
    if (threadIdx.x == 0) (void)xb_add(&bar[XB_XCNT(b.x)], 1u);
    return b;
}
__device__ __forceinline__ void xcd_barrier_complete(unsigned* bar, unsigned x, unsigned& nloc, unsigned& nx) {
    const unsigned G = gridDim.x * gridDim.y * gridDim.z;
    unsigned sum, cnt, mine, sp = 0u;
    for (;;) {
        sum = 0u; cnt = 0u; mine = 0u;
#pragma unroll
        for (unsigned j = 0; j < 16; ++j) { const unsigned c = xb_ld(&bar[XB_XCNT(j)]); sum += c; cnt += (c > 0u) ? 1u : 0u; mine = (j == x) ? c : mine; }
        if (sum == G) break;
        __builtin_amdgcn_s_sleep(1);
        if ((++sp & 255u) == 0u) { if (xb_ld(&bar[XB_TMO])) break; if (sp > XB_SPIN_CAP) { atomicAdd(&bar[XB_TMO], 1u); break; } }
    }
    nloc = mine > 0u ? mine : 1u; nx = cnt > 0u ? cnt : 1u;
}
__device__ __forceinline__ void xcd_barrier(const XcdBarrier& b) {
    asm volatile("s_waitcnt vmcnt(0)" ::: "memory");
    __syncthreads();
    if (threadIdx.x == 0) {
        unsigned* bar = b.bar;
        __builtin_amdgcn_s_waitcnt(0);
        unsigned nloc = b.st[0], nx = b.st[1];
        if (nloc == 0u) { xcd_barrier_complete(bar, b.x, nloc, nx); b.st[0] = nloc; b.st[1] = nx; }
        const unsigned old = xb_add(&bar[XB_XSUB(b.x)], 1u);
        const unsigned gen = old / nloc;
        if (old + 1u == (gen + 1u) * nloc) {
            __builtin_amdgcn_fence(__ATOMIC_RELEASE, "agent");
            asm volatile("s_waitcnt vmcnt(0)" ::: "memory");
            const unsigned og = xb_add(&bar[XB_TOP], 1u);
            const unsigned tg = og / nx;
            if (og + 1u == (tg + 1u) * nx) xb_add(&bar[XB_TOPGEN], 1u);
            else XB_SPIN(xb_ld(&bar[XB_TOPGEN]) == tg, bar);
            __builtin_amdgcn_fence(__ATOMIC_ACQUIRE, "agent");
            xb_add(&bar[XB_XGEN(b.x)], 1u);
            asm volatile("s_waitcnt vmcnt(0)" ::: "memory");
        } else {
            XB_SPIN(xb_ld(&bar[XB_XGEN(b.x)]) == gen, bar);
            __builtin_amdgcn_fence(__ATOMIC_ACQUIRE, "agent");
            asm volatile("s_waitcnt vmcnt(0)" ::: "memory");
        }
    }
    __syncthreads();
}

namespace pg8 {
constexpr int BM = 256, BK = 64, HALF = 128, HTB = HALF * BK * 2, STAGE_BYTES = 8 * HTB, NXCD = 8, WGM = 8;
__host__ __device__ __forceinline__ int lds_byte(int r, int c) { const int st = (r >> 4) * 2 + (c >> 5), rr = r & 15, cc = c & 31, ob = rr * 64 + cc * 2; return st * 1024 + (ob ^ (((ob >> 9) & 1) << 5)); }
__host__ __device__ __forceinline__ void stage_rc(int b, int& R, int& C) { const int st = b / 1024, sb = b % 1024, swz = sb ^ (((sb >> 9) & 1) << 5); R = (st >> 1) * 16 + swz / 64; C = (st & 1) * 32 + (swz % 64) / 2; }
__host__ __device__ __forceinline__ int perm32(int rho) { const int n = rho >> 4, i = rho & 15; return 8 * (i >> 2) + 4 * n + (i & 3); }
struct Unit { int pm, pn; };
struct Gemm { const bf16_t* A; const bf16_t* Bt; int M, N, K; };
struct StaticOrder {
    int nM, nN, nwg, G, c;
    __host__ __device__ __forceinline__ void init(int M, int N, int G_, int c_) { nM = M / BM; nN = N / BM; nwg = nM * nN; G = G_; c = c_; }
    __host__ __device__ __forceinline__ bool next(int i, Unit& u) const {
        const long L = (long)i * G + c; if (L >= nwg) return false;
        int wgid = (int)L; { const int q = nwg / NXCD, r = nwg % NXCD, xcd = wgid % NXCD, off = wgid / NXCD; wgid = (xcd < r ? xcd * (q + 1) : r * (q + 1) + (xcd - r) * q) + off; }
        const int nig = WGM * nN, gid = wgid / nig, fm = gid * WGM, gsz = (nM - fm) < WGM ? (nM - fm) : WGM;
        u.pm = fm + ((wgid % nig) % gsz); u.pn = (wgid % nig) / gsz; return true;
    }
    __device__ __forceinline__ void a_ready(const Unit&) const {}
    __device__ __forceinline__ void done(const Unit&) const {}
};
template <class Epi, class Sched>
__device__ __forceinline__ void gemm_phase(LAS unsigned char* lds, const Gemm g, const Sched& S, const Epi& E) {
    int tid_ = threadIdx.x; asm volatile("" : "+v"(tid_));
    const int tid = tid_, wid = __builtin_amdgcn_readfirstlane(tid >> 6), lane = tid & 63, wr = wid >> 2, wc = wid & 3, fr = lane & 15, fq = lane >> 4;
    const int K = g.K, nt = K / BK;
    unsigned voffA[2], voffB[2];
#pragma unroll
    for (int i = 0; i < 2; ++i) { int R, C; stage_rc(tid * 16 + i * 8192, R, C); const int Rb = Epi::PERM ? ((R & ~31) + perm32(R & 31)) : R;
        voffA[i] = (unsigned)(R * K + C) * 2u; voffB[i] = (unsigned)(Rb * K + C) * 2u; }
    const size_t kstep = (size_t)(BK * 2);
    const size_t hstep = (size_t)HALF * K * 2;
    const size_t tstep = 2 * hstep;
    const unsigned ldsw = (unsigned)wid * 1024u;
    const int aoff = lds_byte(wr * 64 + fr, fq * 8), boff = lds_byte(wc * 32 + fr, fq * 8);
#define PG8_SA(b, h) (((b) * 2 + (h)) * HTB)
#define PG8_SB(b, h) ((4 + (b) * 2 + (h)) * HTB)
#define PG8_STAGE(bufoff, gbase, voff) do { _Pragma("unroll") for (int _i = 0; _i < 2; ++_i) \
        __builtin_amdgcn_global_load_lds((const unsigned*)((const char*)(gbase) + (voff)[_i]), (LAS unsigned*)(lds + (bufoff) + ldsw + _i * 8192), 16, 0, 0); } while (0)
#define PG8_LDA(dst, b, h) do { _Pragma("unroll") for (int m = 0; m < 4; ++m) _Pragma("unroll") for (int k = 0; k < 2; ++k) dst[m][k] = *(const LAS bf16x8*)(lds + PG8_SA(b, h) + aoff + m * 2048 + k * 1024); } while (0)
#define PG8_LDB(dst, b, h) do { _Pragma("unroll") for (int n = 0; n < 2; ++n) _Pragma("unroll") for (int k = 0; k < 2; ++k) dst[n][k] = *(const LAS bf16x8*)(lds + PG8_SB(b, h) + boff + n * 2048 + k * 1024); } while (0)
#define PG8_MMA(ai, bj, At, Bt) do { __builtin_amdgcn_s_setprio(1); _Pragma("unroll") for (int m = 0; m < 4; ++m) _Pragma("unroll") for (int n = 0; n < 2; ++n) _Pragma("unroll") for (int k = 0; k < 2; ++k) \
        acc[ai][bj][m][n] = __builtin_amdgcn_mfma_f32_16x16x32_bf16(Bt[n][k], At[m][k], acc[ai][bj][m][n], 0, 0, 0); __builtin_amdgcn_s_setprio(0); } while (0)
#define PG8_WAIT_V(n) asm volatile("s_waitcnt vmcnt(" #n ")" ::: "memory")
#define PG8_WAIT_L(n) asm volatile("s_waitcnt lgkmcnt(" #n ")" ::: "memory")
#define PG8_BAR __builtin_amdgcn_s_barrier()
#define PG8_SCHED __builtin_amdgcn_sched_barrier(0)
    Unit cur, nxt; int ui = 0;
    if (!S.next(0, cur)) return;
    f32x4 acc[2][2][4][2];
#pragma unroll
    for (int a = 0; a < 2; ++a)
#pragma unroll
        for (int b = 0; b < 2; ++b)
#pragma unroll
            for (int m = 0; m < 4; ++m)
#pragma unroll
                for (int n = 0; n < 2; ++n) acc[a][b][m][n] = (f32x4){0.f, 0.f, 0.f, 0.f};
    bf16x8 At[4][2], B0[2][2], B1[2][2];
    const char* cA = (const char*)g.A + (size_t)cur.pm * tstep; const char* cB = (const char*)g.Bt + (size_t)cur.pn * tstep;
    S.a_ready(cur);
    PG8_STAGE(PG8_SB(0, 0), cB, voffB); PG8_STAGE(PG8_SA(0, 0), cA, voffA); PG8_STAGE(PG8_SB(0, 1), cB + hstep, voffB); PG8_STAGE(PG8_SA(0, 1), cA + hstep, voffA);
    if (wr == 1) PG8_BAR;
    PG8_WAIT_V(4); PG8_BAR;
    PG8_STAGE(PG8_SB(1, 0), cB + kstep, voffB); PG8_STAGE(PG8_SA(1, 0), cA + kstep, voffA); PG8_STAGE(PG8_SB(1, 1), cB + hstep + kstep, voffB);
    PG8_WAIT_V(6); PG8_BAR;
    for (;;) {
        const bool has_next = S.next(ui + 1, nxt);
        const char* nA = has_next ? (const char*)g.A + (size_t)nxt.pm * tstep : cA; const char* nB = has_next ? (const char*)g.Bt + (size_t)nxt.pn * tstep : cB;
        for (int t = 0; t < nt; t += 2) {
            const bool last = (t == nt - 2);
            const char* a1 = cA + (size_t)(t + 1) * kstep;
            const char* a2 = last ? nA : cA + (size_t)(t + 2) * kstep; const char* b2 = last ? nB : cB + (size_t)(t + 2) * kstep;
            const char* a3 = a2 + kstep; const char* b3 = b2 + kstep;
            if (last && has_next) S.a_ready(nxt);
            PG8_LDB(B0, 0, 0); PG8_SCHED; PG8_LDA(At, 0, 0); PG8_STAGE(PG8_SA(1, 1), a1 + hstep, voffA);
            PG8_WAIT_L(8); PG8_BAR; PG8_WAIT_L(0); PG8_MMA(0, 0, At, B0); PG8_BAR; PG8_SCHED;
            PG8_LDB(B1, 0, 1); PG8_STAGE(PG8_SB(0, 0), b2, voffB);
            PG8_BAR; PG8_WAIT_L(0); PG8_MMA(0, 1, At, B1); PG8_BAR;
            PG8_LDA(At, 0, 1); PG8_STAGE(PG8_SA(0, 0), a2, voffA);
            PG8_BAR; PG8_WAIT_L(0); PG8_MMA(1, 0, At, B0); PG8_BAR; PG8_SCHED;
            PG8_STAGE(PG8_SB(0, 1), b2 + hstep, voffB);
            PG8_WAIT_V(6); PG8_BAR; PG8_MMA(1, 1, At, B1); PG8_BAR;
            PG8_LDB(B0, 1, 0); PG8_SCHED; PG8_LDA(At, 1, 0); PG8_STAGE(PG8_SA(0, 1), a2 + hstep, voffA);
            PG8_WAIT_L(8); PG8_BAR; PG8_WAIT_L(0); PG8_MMA(0, 0, At, B0); PG8_BAR; PG8_SCHED;
            PG8_LDB(B1, 1, 1); PG8_STAGE(PG8_SB(1, 0), b3, voffB);
            PG8_BAR; PG8_WAIT_L(0); PG8_MMA(0, 1, At, B1); PG8_BAR;
            PG8_LDA(At, 1, 1); PG8_STAGE(PG8_SA(1, 0), a3, voffA);
            PG8_BAR; PG8_WAIT_L(0); PG8_MMA(1, 0, At, B0); PG8_BAR; PG8_SCHED;
            PG8_STAGE(PG8_SB(1, 1), b3 + hstep, voffB);
            PG8_WAIT_V(6); PG8_BAR; PG8_MMA(1, 1, At, B1); PG8_BAR;
        }
        E(acc, cur, wr, wc, fr, fq); S.done(cur);
        if (!has_next) break;
#pragma unroll
        for (int a = 0; a < 2; ++a)
#pragma unroll
            for (int b = 0; b < 2; ++b)
#pragma unroll
                for (int m = 0; m < 4; ++m)
#pragma unroll
                    for (int n = 0; n < 2; ++n) acc[a][b][m][n] = (f32x4){0.f, 0.f, 0.f, 0.f};
        cur = nxt; cA = nA; cB = nB; ++ui;
    }
    PG8_WAIT_V(0);
    if (wr == 0) PG8_BAR;
    PG8_BAR;
#undef PG8_SA
#undef PG8_SB
#undef PG8_STAGE
#undef PG8_LDA
#undef PG8_LDB
#undef PG8_MMA
#undef PG8_WAIT_V
#undef PG8_WAIT_L
#undef PG8_BAR
#undef PG8_SCHED
}

template <int ACT  > struct EpiBf16 {
    static constexpr bool PERM = true;
    bf16_t* O; int ldc;
    __device__ __forceinline__ void operator()(const f32x4 (&acc)[2][2][4][2], const Unit& u, int wr, int wc, int fr, int fq) const {
        const int row0 = u.pm * BM + wr * 64 + fr, col0 = u.pn * BM + wc * 32 + 8 * fq;
#pragma unroll
        for (int ai = 0; ai < 2; ++ai)
#pragma unroll
            for (int m = 0; m < 4; ++m) { bf16_t* rowp = O + (size_t)(row0 + ai * HALF + m * 16) * ldc + col0;
#pragma unroll
                for (int bj = 0; bj < 2; ++bj) { f32x4 v0 = acc[ai][bj][m][0], v1 = acc[ai][bj][m][1];
                    if (ACT == 1) { for (int i = 0; i < 4; ++i) { v0[i] = siluf_(v0[i]); v1[i] = siluf_(v1[i]); } }
                    uint4 o; o.x = pack2(v0[0], v0[1]); o.y = pack2(v0[2], v0[3]); o.z = pack2(v1[0], v1[1]); o.w = pack2(v1[2], v1[3]);
                    *(uint4*)(rowp + bj * HALF) = o; } }
    }
};
struct EpiF32 {
    static constexpr bool PERM = false;
    float* C; int ldc;
    __device__ __forceinline__ void operator()(const f32x4 (&acc)[2][2][4][2], const Unit& u, int wr, int wc, int fr, int fq) const {
        const int row0 = u.pm * BM + wr * 64 + fr, col0 = u.pn * BM + wc * 32 + 4 * fq;
#pragma unroll
        for (int ai = 0; ai < 2; ++ai)
#pragma unroll
            for (int m = 0; m < 4; ++m) { float* rowp = C + (size_t)(row0 + ai * HALF + m * 16) * ldc + col0;
#pragma unroll
                for (int bj = 0; bj < 2; ++bj)
#pragma unroll
                    for (int n = 0; n < 2; ++n) *(f32x4*)(rowp + bj * HALF + n * 16) = acc[ai][bj][m][n]; }
    }
};
template <int IN_BF16> struct EpiResid {
    static constexpr bool PERM = true;
    const float* Xi; const bf16_t* Xib; bf16_t* Ob;
    __device__ __forceinline__ void operator()(const f32x4 (&acc)[2][2][4][2], const Unit& u, int wr, int wc, int fr, int fq) const {
        const int row0 = u.pm * BM + wr * 64 + fr, col0 = u.pn * BM + wc * 32 + 8 * fq;
#pragma unroll
        for (int ai = 0; ai < 2; ++ai)
#pragma unroll
            for (int m = 0; m < 4; ++m) { const size_t ro = (size_t)(row0 + ai * HALF + m * 16) * 1024 + col0;
#pragma unroll
                for (int bj = 0; bj < 2; ++bj) { const size_t o = ro + bj * HALF;
                    f32x4 x0, x1;
                    if (IN_BF16) { const uint4 xv = *(const uint4*)(Xib + o); float xf[8]; unpack8(xv, xf); x0 = (f32x4){xf[0], xf[1], xf[2], xf[3]}; x1 = (f32x4){xf[4], xf[5], xf[6], xf[7]}; }
                    else { x0 = *(const f32x4*)(Xi + o); x1 = *(const f32x4*)(Xi + o + 4); }
                    const f32x4 v0 = x0 + acc[ai][bj][m][0], v1 = x1 + acc[ai][bj][m][1];
                    uint4 pk; pk.x = pack2(v0[0], v0[1]); pk.y = pack2(v0[2], v0[3]); pk.z = pack2(v1[0], v1[1]); pk.w = pack2(v1[2], v1[3]); *(uint4*)(Ob + o) = pk; } }
    }
};
template <int OUT_BF16> struct EpiGate {
    static constexpr bool PERM = true;
    float* X; bf16_t* Xb; const bf16_t* R; const bf16_t* E;
    __device__ __forceinline__ void operator()(const f32x4 (&acc)[2][2][4][2], const Unit& u, int wr, int wc, int fr, int fq) const {
        const int row0 = u.pm * BM + wr * 64 + fr, col0 = u.pn * BM + wc * 32 + 8 * fq;
#pragma unroll
        for (int ai = 0; ai < 2; ++ai)
#pragma unroll
            for (int m = 0; m < 4; ++m) { const size_t ro = (size_t)(row0 + ai * HALF + m * 16) * 1024 + col0;
#pragma unroll
                for (int bj = 0; bj < 2; ++bj) { const size_t o = ro + bj * HALF;
                    const uint4 ev = *(const uint4*)(E + o), rv = *(const uint4*)(R + o); float ef[8], rf[8]; unpack8(ev, ef); unpack8(rv, rf);
                    float v[8];
#pragma unroll
                    for (int n = 0; n < 2; ++n)
#pragma unroll
                        for (int i = 0; i < 4; ++i) v[4 * n + i] = rf[4 * n + i] + ef[4 * n + i] * sigmoidf_(acc[ai][bj][m][n][i]);
                    if (OUT_BF16) { uint4 pk; pk.x = pack2(v[0], v[1]); pk.y = pack2(v[2], v[3]); pk.z = pack2(v[4], v[5]); pk.w = pack2(v[6], v[7]); *(uint4*)(Xb + o) = pk; }
                    else { *(f32x4*)(X + o) = (f32x4){v[0], v[1], v[2], v[3]}; *(f32x4*)(X + o + 4) = (f32x4){v[4], v[5], v[6], v[7]}; } } }
    }
};
struct EpiGateNorm {
    static constexpr bool PERM = true;
    float* X; const bf16_t* R; const bf16_t* E; const float* wn; float* SS; unsigned* cnt; unsigned* tmo;
    __device__ __forceinline__ void operator()(f32x4 (&acc)[2][2][4][2], const Unit& u, int wr, int wc, int fr, int fq) const {
        const int row0 = u.pm * BM + wr * 64 + fr, col0 = u.pn * BM + wc * 32 + 8 * fq;
#pragma unroll
        for (int ai = 0; ai < 2; ++ai)
#pragma unroll
            for (int m = 0; m < 4; ++m) { const int row = row0 + ai * HALF + m * 16; const size_t ro = (size_t)row * 1024 + col0; float ss = 0.f;
#pragma unroll
                for (int bj = 0; bj < 2; ++bj) { const size_t o = ro + bj * HALF;
                    const uint4 ev = *(const uint4*)(E + o), rv = *(const uint4*)(R + o); float ef[8], rf[8]; unpack8(ev, ef); unpack8(rv, rf);
#pragma unroll
                    for (int n = 0; n < 2; ++n)
#pragma unroll
                        for (int i = 0; i < 4; ++i) { const float v = rf[4 * n + i] + ef[4 * n + i] * sigmoidf_(acc[ai][bj][m][n][i]); acc[ai][bj][m][n][i] = v; ss += v * v; } }
                ss += __shfl_xor(ss, 16); ss += __shfl_xor(ss, 32);
                if (fq == 0) (void)__hip_atomic_fetch_add(SS + row, ss, __ATOMIC_RELAXED, __HIP_MEMORY_SCOPE_AGENT); }
        asm volatile("s_waitcnt vmcnt(0)" ::: "memory");
        if ((fr | fq) == 0) (void)__hip_atomic_fetch_add(cnt + 2 * u.pm + wr, 1u, __ATOMIC_RELAXED, __HIP_MEMORY_SCOPE_AGENT);
        f32x4 w[2][2];
#pragma unroll
        for (int bj = 0; bj < 2; ++bj) { w[bj][0] = *(const f32x4*)(wn + col0 + bj * HALF); w[bj][1] = *(const f32x4*)(wn + col0 + bj * HALF + 4); }
        { unsigned sp = 0;
          while (__hip_atomic_load(cnt + 2 * u.pm + wr, __ATOMIC_RELAXED, __HIP_MEMORY_SCOPE_AGENT) < 16u) { __builtin_amdgcn_s_sleep(1);
              if (++sp > (1u << 22)) { if ((fr | fq) == 0) atomicAdd(tmo, 1u); break; } } }
        asm volatile("" ::: "memory");
#pragma unroll
        for (int ai = 0; ai < 2; ++ai)
#pragma unroll
            for (int m = 0; m < 4; ++m) { const int row = row0 + ai * HALF + m * 16; const size_t ro = (size_t)row * 1024 + col0;
                const float rs = rsqrtf(__hip_atomic_load(SS + row, __ATOMIC_RELAXED, __HIP_MEMORY_SCOPE_AGENT) * (1.0f / 1024.0f) + 1e-6f);
#pragma unroll
                for (int bj = 0; bj < 2; ++bj) { const size_t o = ro + bj * HALF;
                    *(f32x4*)(X + o) = acc[ai][bj][m][0] * rs * w[bj][0]; *(f32x4*)(X + o + 4) = acc[ai][bj][m][1] * rs * w[bj][1]; } }
    }
};
}

struct Args { const float* in[28]; float* out; unsigned char* ws; int ph_lo, ph_hi; };

struct Frame {
    int tid, lane, wave, G, bid, gw, nw;
    unsigned char* lds;
    unsigned* ctl;
    const float* in[28]; float* out; unsigned char* ws;
    const LAS unsigned char* lut;
    const LAS float* tbl;
    const LAS float* biasL;
    LAS unsigned char* ldsl;
};
DI int t5b(const Frame& F, int n) { return n < 16 ? n : (n >= 113 ? 31 : (int)F.lut[n]); }

DI bool phase_refresh(Frame& F) { int t_ = threadIdx.x; asm volatile("" : "+v"(t_)); F.tid = t_; F.lane = t_ & 63; return true; }
struct TDesc { const float* src; bf16_t* dst; int K, Nsrc, Npad, mapk, ntiles; };
DI int tmap(int kind, int n) { return kind == 0 ? n : (kind == 1 ? map0(n) : (kind == 2 ? map1(n) : mapv(n))); }
DI void transpose_all(const Frame& F) {
    unsigned char* ws = F.ws;
    float* tile = (float*)F.lds;
    TDesc D[11];
    D[0] = TDesc{F.in[7], (bf16_t*)(ws + WS_WIN0), 1024, 3292, LD0, 1, 0};
    D[1] = TDesc{F.in[7], (bf16_t*)(ws + WS_WVT), 1024, 3292, 512, 3, 0};
    D[2] = TDesc{F.in[8], (bf16_t*)(ws + WS_WOUT0), 1024, 1024, 1024, 0, 0};
    D[3] = TDesc{F.in[5], (bf16_t*)(ws + WS_WG0), 1024, 1024, 1024, 0, 0};
    D[4] = TDesc{F.in[5] + (size_t)1024 * 1024, (bf16_t*)(ws + WS_WG1), 1024, 1024, 1024, 0, 0};
    D[5] = TDesc{F.in[4], (bf16_t*)(ws + WS_WP0), 256, 1024, 1024, 0, 0};
    D[6] = TDesc{F.in[4] + (size_t)256 * 1024, (bf16_t*)(ws + WS_WP1), 256, 1024, 1024, 0, 0};
    D[7] = TDesc{F.in[15], (bf16_t*)(ws + WS_WIN1), 1024, 3592, LD1, 2, 0};
    D[8] = TDesc{F.in[16], (bf16_t*)(ws + WS_WOUT1), 1024, 1024, 1024, 0, 0};
    D[9] = TDesc{F.in[10], (bf16_t*)(ws + WS_WC1K), 2048, 256, 256, 0, 0};
    D[10] = TDesc{F.in[13], (bf16_t*)(ws + WS_WC1V), 2048, 256, 256, 0, 0};
    int total = 0;
#pragma unroll
    for (int i = 0; i < 11; ++i) { D[i].ntiles = (D[i].Npad / 64) * (D[i].K / 64); total += D[i].ntiles; }
    float rg[8];
    auto locate = [&](int tix, TDesc& d, int& nt, int& kt) { int rem = tix;
#pragma unroll
        for (int i = 0; i < 11; ++i) { if (rem >= 0 && rem < D[i].ntiles) { d = D[i]; const int ntk = d.K / 64; nt = rem / ntk; kt = rem % ntk; rem = -1; } else if (rem >= 0) rem -= D[i].ntiles; } };
    auto load = [&](int tix) { TDesc d; int nt = 0, kt = 0; locate(tix, d, nt, kt);
#pragma unroll
        for (int q = 0; q < 8; ++q) { const int e = F.tid + q * 512; const int kk = e >> 6, nn = e & 63; const int col = tmap(d.mapk, nt * 64 + nn);
            rg[q] = col >= 0 ? d.src[(size_t)(kt * 64 + kk) * d.Nsrc + col] : 0.f; } };
    int tix = F.bid; int buf = 0;
    if (tix < total) load(tix);
    for (; tix < total; tix += F.G) {
        float* tl = tile + buf * (64 * 65);
#pragma unroll
        for (int q = 0; q < 8; ++q) { const int e = F.tid + q * 512; tl[(e >> 6) * 65 + (e & 63)] = rg[q]; }
        __syncthreads();
        TDesc d; int nt = 0, kt = 0; locate(tix, d, nt, kt);
        if (tix + F.G < total) load(tix + F.G);
#pragma unroll
        for (int q = 0; q < 8; ++q) { const int e = F.tid + q * 512; const int nn = e >> 6, kk = e & 63;
            d.dst[(size_t)(nt * 64 + nn) * d.K + kt * 64 + kk] = f2bf(tl[kk * 65 + nn]); }
        buf ^= 1;
    }
    __syncthreads();
}
template <int OUTF>
DI void rmsnorm_rows(const Frame& F, const float* X, const float* g, bf16_t* Ob, float* Of) {
    f32x4 gg[4];
#pragma unroll
    for (int i = 0; i < 4; ++i) gg[i] = *(const f32x4*)(g + i * 256 + F.lane * 4);
    for (int row0 = F.gw * 4; row0 < MT; row0 += F.nw * 4) {
        f32x4 v[4][4]; float ss[4];
#pragma unroll
        for (int r = 0; r < 4; ++r)
#pragma unroll
            for (int i = 0; i < 4; ++i) v[r][i] = *(const f32x4*)(X + (size_t)(row0 + r) * 1024 + i * 256 + F.lane * 4);
#pragma unroll
        for (int r = 0; r < 4; ++r) { float a = 0.f;
#pragma unroll
            for (int i = 0; i < 4; ++i) a += v[r][i][0] * v[r][i][0] + v[r][i][1] * v[r][i][1] + v[r][i][2] * v[r][i][2] + v[r][i][3] * v[r][i][3];
            ss[r] = a; }
#pragma unroll
        for (int o = 32; o >= 1; o >>= 1) {
#pragma unroll
            for (int r = 0; r < 4; ++r) ss[r] += __shfl_xor(ss[r], o); }
#pragma unroll
        for (int r = 0; r < 4; ++r) { const float rs = rsqrtf(ss[r] * (1.0f / 1024.0f) + 1e-6f);
#pragma unroll
            for (int i = 0; i < 4; ++i) { f32x4 y;
#pragma unroll
                for (int j = 0; j < 4; ++j) y[j] = v[r][i][j] * rs * gg[i][j];
                if (OUTF) *(f32x4*)(Of + (size_t)(row0 + r) * 1024 + i * 256 + F.lane * 4) = y;
                else { uint2 pk; pk.x = pack2(y[0], y[1]); pk.y = pack2(y[2], y[3]); *(uint2*)(Ob + (size_t)(row0 + r) * 1024 + i * 256 + F.lane * 4) = pk; } } }
    }
}
DI void rmsnorm_gates(const Frame& F, const bf16_t* X, const float* g, bf16_t* Ob) {
    const float* W = F.in[15]; float* gts = (float*)(F.ws + WS_GATES);
    float wg[2][8][8]; float gg[2][8];
#pragma unroll
    for (int i = 0; i < 2; ++i)
#pragma unroll
        for (int e = 0; e < 8; ++e) { const int k = i * 512 + F.lane * 8 + e; const f32x4 a = *(const f32x4*)(W + (size_t)k * 3592 + 2560), b = *(const f32x4*)(W + (size_t)k * 3592 + 2564);
            wg[i][e][0] = a[0]; wg[i][e][1] = a[1]; wg[i][e][2] = a[2]; wg[i][e][3] = a[3]; wg[i][e][4] = b[0]; wg[i][e][5] = b[1]; wg[i][e][6] = b[2]; wg[i][e][7] = b[3]; gg[i][e] = g[k]; }
    for (int row0 = F.gw * 2; row0 < MT; row0 += F.nw * 2) {
        uint4 xv[2][2]; float ss[2];
#pragma unroll
        for (int r = 0; r < 2; ++r)
#pragma unroll
            for (int i = 0; i < 2; ++i) xv[r][i] = *(const uint4*)(X + (size_t)(row0 + r) * 1024 + i * 512 + F.lane * 8);
        float xf[2][2][8];
#pragma unroll
        for (int r = 0; r < 2; ++r) { float a = 0.f;
#pragma unroll
            for (int i = 0; i < 2; ++i) { unpack8(xv[r][i], xf[r][i]);
#pragma unroll
                for (int e = 0; e < 8; ++e) a += xf[r][i][e] * xf[r][i][e]; }
            ss[r] = a; }
#pragma unroll
        for (int o = 32; o >= 1; o >>= 1) { ss[0] += __shfl_xor(ss[0], o); ss[1] += __shfl_xor(ss[1], o); }
#pragma unroll
        for (int r = 0; r < 2; ++r) { const int row = row0 + r;
            const float rs = rsqrtf(ss[r] * (1.0f / 1024.0f) + 1e-6f);
            float pg[8] = {0.f, 0.f, 0.f, 0.f, 0.f, 0.f, 0.f, 0.f};
#pragma unroll
            for (int i = 0; i < 2; ++i) { float y[8];
#pragma unroll
                for (int e = 0; e < 8; ++e) { y[e] = xf[r][i][e] * rs * gg[i][e];
#pragma unroll
                    for (int j = 0; j < 8; ++j) pg[j] += y[e] * wg[i][e][j]; }
                uint4 pk; pk.x = pack2(y[0], y[1]); pk.y = pack2(y[2], y[3]); pk.z = pack2(y[4], y[5]); pk.w = pack2(y[6], y[7]); *(uint4*)(Ob + (size_t)row * 1024 + i * 512 + F.lane * 8) = pk; }
#pragma unroll
            for (int o = 32; o >= 1; o >>= 1) {
#pragma unroll
                for (int j = 0; j < 8; ++j) pg[j] += __shfl_xor(pg[j], o); }
            float mine = 0.f;
#pragma unroll
            for (int j = 0; j < 8; ++j) if (F.lane == j) mine = pg[j];
            if (F.lane < 8) gts[(size_t)row * 8 + F.lane] = mine; }
    }
}
DI void p0_prologue(const Frame& F) {
    unsigned char* ws = F.ws;
    transpose_all(F);
    { bf16_t* wat = (bf16_t*)(ws + WS_WAT); bf16_t* wxt = (bf16_t*)(ws + WS_WXT);
      for (int idx = F.bid * 512 + F.tid; idx < 8 * 64 * 64; idx += F.G * 512) { const int g = idx >> 12, j = (idx >> 6) & 63, i = idx & 63;
          wat[idx] = f2bf(F.in[19][(size_t)(g * 64 + i) * 64 + j]); wxt[idx] = f2bf(F.in[21][(size_t)(g * 64 + i) * 64 + j]); } }
    { float* ssz = (float*)(ws + WS_SS); for (int i = F.bid * 512 + F.tid; i < MT; i += F.G * 512) ssz[i] = 0.f; }
    { float* imgn = (float*)(ws + WS_IMGN); float* imgd = (float*)(ws + WS_IMGD); float* imgw = (float*)(ws + WS_IMGW); float* imgz = (float*)(ws + WS_IMGZ);
      const float inv_c1 = 1.0f / (0.125f * 1.4426950408889634f);
      for (int idx = F.bid * 512 + F.tid; idx < (6 + 8 + 1) * 16384 + 2048; idx += F.G * 512) {
          const int e = idx & 3, ln = (idx >> 2) & 63, G = (idx >> 8) & 7, wv = (idx >> 11) & 7, im = idx >> 14;
          const int R = 4 * G + e, i = R & 15, hf_ = ln >> 5, r_ = ln & 31, koff = 32 * (R >> 4) + (i & 3) + 8 * (i >> 2) + 4 * hf_;
          if (im < 6) { const int g = im / 3, dl = im % 3, ql = r_ >> 2, hh = g * 4 + (r_ & 3); const int dist = 64 * dl + 8 * wv + ql - koff;
              imgn[idx] = dist < 0 ? NEG_INF : F.biasL[hh * 128 + (dist > 127 ? 127 : dist)] * inv_c1; }
          else if (im < 14) { const int k = im - 6, par = k >> 2, dl = k & 3, ql = r_ >> 3, hh = 8 + (r_ & 7); const int dist = 32 * par + 4 * wv + ql + 64 * dl - koff;
              imgd[idx - 6 * 16384] = dist < 0 ? NEG_INF : F.biasL[hh * 128 + (dist > 127 ? 127 : dist)] * inv_c1; }
          else if (im < 15) { const int ql = r_ >> 2; imgw[idx - 14 * 16384] = (koff > 8 * wv + ql) ? 0.f : NEG_INF; }
          else imgz[idx - 15 * 16384] = 0.f; } }
    rmsnorm_rows<0>(F, F.in[0], F.in[2], (bf16_t*)(ws + WS_BFA), nullptr);
    { const float* p = F.in[1]; bf16_t* pb = (bf16_t*)(ws + WS_PBF); const size_t n8 = (size_t)2 * MT * 256 / 8;
      for (size_t i = (size_t)F.bid * 512 + F.tid; i < n8; i += (size_t)F.G * 512) {
          const f32x4 a = *(const f32x4*)(p + i * 8), b = *(const f32x4*)(p + i * 8 + 4);
          uint4 o; o.x = pack2(a[0], a[1]); o.y = pack2(a[2], a[3]); o.z = pack2(b[0], b[1]); o.w = pack2(b[2], b[3]); *(uint4*)(pb + i * 8) = o; } }
}

DI void p2a_build_blocks(const Frame& F) {
    { const int gt = F.bid * 512 + F.tid;
      if (gt < 1024) { const int bg = gt >> 6, d = gt & 63; ((float*)(F.ws + WS_KCMP))[((size_t)bg * 256 + 255) * 64 + d] = 0.f; ((float*)(F.ws + WS_VCMP))[((size_t)bg * 256 + 255) * 64 + d] = 0.f;
          ((bf16_t*)(F.ws + WS_VCT))[((size_t)bg * 64 + d) * 256 + 255] = 0; } }
    const bf16_t* U = (const bf16_t*)(F.ws + WS_U);
    bf16_t* AK = (bf16_t*)(F.ws + WS_AK); bf16_t* AV = (bf16_t*)(F.ws + WS_AV);
    const float* posk = F.in[9]; const float* posv = F.in[12];
    const size_t nitem = (size_t)2 * 4096 * 32 * 8;
    for (size_t it = (size_t)F.bid * 512 + F.tid; it < nitem; it += (size_t)F.G * 512) {
        const int c8 = (int)(it & 7), l = (int)((it >> 3) & 31), r = (int)((it >> 8) & 4095), which = (int)(it >> 20);
        bf16_t* dst = (which ? AV : AK) + (size_t)r * 2048 + l * 64 + c8 * 8;
        uint4 o = make_uint4(0u, 0u, 0u, 0u);
        if (r < 4080) {
            const int b = r / 510, rem = r % 510, i = rem >> 1, g = rem & 1;
            const bf16_t* sp = U + ((size_t)b * SEQ + 16 * i + l) * LD0 + (which ? C_VC : C_KC) + g * 64 + c8 * 8;
            const float* pp = (which ? posv : posk) + l * 64 + c8 * 8;
            const uint4 v = *(const uint4*)sp; float f[8]; unpack8(v, f);
            o.x = pack2(f[0] + pp[0], f[1] + pp[1]); o.y = pack2(f[2] + pp[2], f[3] + pp[3]); o.z = pack2(f[4] + pp[4], f[5] + pp[5]); o.w = pack2(f[6] + pp[6], f[7] + pp[7]);
        }
        *(uint4*)dst = o;
    }
}
DI void p2c_compress_rows(const Frame& F, int which, int row0) {
    const bf16_t* H = (const bf16_t*)(F.ws + (which ? WS_HV : WS_HK));
    float* OUT = (float*)(F.ws + (which ? WS_VCMP : WS_KCMP));
    const float* w2 = which ? F.in[14] : F.in[11];
    for (int rr = F.wave; rr < 256; rr += 8) {
        const int r = row0 + rr; if (r >= 4080) break;
        const int b = r / 510, rem = r % 510, i = rem >> 1, g = rem & 1, bg = b * 2 + g;
        const bf16_t* hr = H + (size_t)r * 256; float acc = 0.f;
        for (int j = 0; j < 256; j += 8) { const uint4 hv = *(const uint4*)(hr + j); float hf[8]; unpack8(hv, hf);
#pragma unroll
            for (int q = 0; q < 8; ++q) acc += hf[q] * w2[(size_t)(j + q) * 64 + F.lane]; }
        OUT[((size_t)bg * 256 + i) * 64 + F.lane] = acc;
        if (which) ((bf16_t*)(F.ws + WS_VCT))[((size_t)bg * 64 + F.lane) * 256 + i] = f2bf(acc);
    }
}

typedef float f32x16 __attribute__((ext_vector_type(16)));
#define MFMA32(a, b, c) __builtin_amdgcn_mfma_f32_32x32x16_bf16((a), (b), (c), 0, 0, 0)
constexpr float LOG2E = 1.4426950408889634f;
constexpr float QK_C1 = 0.125f * LOG2E;
constexpr int AT_BUF = 0;
constexpr int AT_PSUM = 65536;
constexpr int AT_XM = AT_PSUM + 16384;
constexpr int AT_SELM = AT_PSUM + 65536;
constexpr int AT_MISC = AT_SELM + 1024;
constexpr int AT_END = AT_MISC + 64 + 2048;
static_assert(AT_END + LDS_WORK_OFF <= LDS_BYTES - 12288, "attention lds");
enum { FL_NEAR = 1, FL_CAUSAL = 2, FL_WINLO = 4, FL_BITS = 8, FL_LANE = 16 };

struct Att { float m, l; f32x16 o0, o1; };
DI void att_init(Att& a) { a.m = NEG_INF; a.l = 0.f;
#pragma unroll
    for (int i = 0; i < 16; ++i) { a.o0[i] = 0.f; a.o1[i] = 0.f; } }

typedef unsigned u32x4 __attribute__((ext_vector_type(4)));
#define OPAQUE(x) asm volatile("" : "+v"(x))
DI void st_write_K(LAS unsigned char* Kt, int tid, const uint4& rg) {
    OPAQUE(tid);
    const int key = tid >> 3, c = tid & 7;
    const u32x4 v = {rg.x, rg.y, rg.z, rg.w};
    *(LAS u32x4*)(Kt + (key ^ ((key >> 3) & 1)) * 128 + ((c ^ (key & 7)) << 4)) = v;
}
DI void st_write_VT(LAS unsigned char* Vt, int tid, const uint4& rg) {
    OPAQUE(tid);
    const int d = tid >> 3, m = tid & 7, G = m >> 1, a = m & 1, sw = (d >> 1) & 7;
    typedef unsigned u32x2 __attribute__((ext_vector_type(2)));
    const u32x2 lo = {rg.x, rg.y}, hi = {rg.z, rg.w};
    *(LAS u32x2*)(Vt + d * 128 + (((2 * G) ^ sw) << 4) + 8 * a) = lo;
    *(LAS u32x2*)(Vt + d * 128 + (((2 * G + 1) ^ sw) << 4) + 8 * a) = hi;
}
template <bool CINIT = false, bool BATCH = false>
DI void qk_tile(const LAS unsigned char* Kt, const bf16x8 (&qf)[4], int r, int hf, f32x16& s0, f32x16& s1) {
    OPAQUE(r); OPAQUE(hf);
    const f32x16 zero16 = {0.f, 0.f, 0.f, 0.f, 0.f, 0.f, 0.f, 0.f, 0.f, 0.f, 0.f, 0.f, 0.f, 0.f, 0.f, 0.f};
    if (BATCH) {
        bf16x8 a0[4], a1[4];
#pragma unroll
        for (int s = 0; s < 4; ++s) { const int c = 2 * s + hf; const int pr = r ^ ((r >> 3) & 1);
            a0[s] = *(const LAS bf16x8*)(Kt + pr * 128 + ((c ^ (r & 7)) << 4)); a1[s] = *(const LAS bf16x8*)(Kt + (32 + pr) * 128 + ((c ^ (r & 7)) << 4)); }
        __builtin_amdgcn_sched_barrier(0);
#pragma unroll
        for (int s = 0; s < 4; ++s) {
            if (s == 0 && !CINIT) { s0 = MFMA32(a0[0], qf[0], zero16); s1 = MFMA32(a1[0], qf[0], zero16); }
            else { s0 = MFMA32(a0[s], qf[s], s0); s1 = MFMA32(a1[s], qf[s], s1); } }
        return; }
#pragma unroll
    for (int s = 0; s < 4; ++s) {
        const int c = 2 * s + hf;
        const int pr = r ^ ((r >> 3) & 1);
        const bf16x8 a0 = *(const LAS bf16x8*)(Kt + pr * 128 + ((c ^ (r & 7)) << 4));
        const bf16x8 a1 = *(const LAS bf16x8*)(Kt + (32 + pr) * 128 + ((c ^ (r & 7)) << 4));
        if (s == 0 && !CINIT) { s0 = MFMA32(a0, qf[0], zero16); s1 = MFMA32(a1, qf[0], zero16); }
        else { s0 = MFMA32(a0, qf[s], s0); s1 = MFMA32(a1, qf[s], s1); }
    }
}
template <int FLAGS>
DI void fix_scores(f32x16& s, int posb, int kstep, int tq, const LAS float* bl, float bfar, unsigned mword, bool laneok, int hf) {
    OPAQUE(hf); OPAQUE(tq);
#pragma unroll
    for (int i = 0; i < 16; ++i) {
        const int koff = (i & 3) + 8 * (i >> 2) + 4 * hf;
        const int dist = tq - (posb + kstep * koff);
        float bias = bfar;
        if (FLAGS & FL_NEAR) { int dd = dist < 0 ? 0 : dist; dd = dd > 127 ? 127 : dd; bias = bl[dd]; }
        const float v = s[i] * QK_C1 + bias;
        bool ok = true;
        if (FLAGS & FL_CAUSAL) ok = ok && (dist >= 0);
        if (FLAGS & FL_WINLO) ok = ok && (dist < 512);
        if (FLAGS & FL_BITS) ok = ok && (((mword >> koff) & 1u) != 0u);
        if (FLAGS & FL_LANE) ok = ok && laneok;
        s[i] = ok ? v : NEG_INF;
    }
}
DI bf16x8 pack8(const f32x16& x, int s) {
    typedef unsigned u32x4 __attribute__((ext_vector_type(4)));
    u32x4 p;
    p[0] = pack2(x[8 * s + 0], x[8 * s + 1]); p[1] = pack2(x[8 * s + 2], x[8 * s + 3]); p[2] = pack2(x[8 * s + 4], x[8 * s + 5]); p[3] = pack2(x[8 * s + 6], x[8 * s + 7]);
    return __builtin_bit_cast(bf16x8, p);
}
DI void pv_tile(const LAS unsigned char* Vt, const f32x16& p0, const f32x16& p1, int r, int hf, f32x16& o0, f32x16& o1) {
#pragma unroll
    for (int G = 0; G < 4; ++G) {
        const bf16x8 pb = pack8((G >> 1) ? p1 : p0, G & 1);
        const int cc = 2 * G + hf;
        const bf16x8 a0 = *(const LAS bf16x8*)(Vt + r * 128 + ((cc ^ ((r >> 1) & 7)) << 4));
        const bf16x8 a1 = *(const LAS bf16x8*)(Vt + (32 + r) * 128 + ((cc ^ ((r >> 1) & 7)) << 4));
        o0 = MFMA32(a0, pb, o0); o1 = MFMA32(a1, pb, o1);
    }
}
DI void online_pv(Att& st, f32x16& s0, f32x16& s1, const LAS unsigned char* Vt, int r, int hf) {
    float tm = NEG_INF;
#pragma unroll
    for (int i = 0; i < 16; ++i) tm = fmaxf(tm, fmaxf(s0[i], s1[i]));
    tm = fmaxf(tm, __shfl_xor(tm, 32));
    const float mn = fmaxf(st.m, tm);
    const float mu = (mn == NEG_INF) ? 0.f : mn;
    const float alpha = __builtin_amdgcn_exp2f(st.m - mu);
    float ls = 0.f;
#pragma unroll
    for (int i = 0; i < 16; ++i) { s0[i] = __builtin_amdgcn_exp2f(s0[i] - mu); s1[i] = __builtin_amdgcn_exp2f(s1[i] - mu); ls += s0[i] + s1[i]; }
    st.l = st.l * alpha + ls;
    if (__ballot(mn != st.m) != 0ull) {
#pragma unroll
        for (int i = 0; i < 16; ++i) { st.o0[i] *= alpha; st.o1[i] *= alpha; } }
    st.m = mn;
    pv_tile(Vt, s0, s1, r, hf, st.o0, st.o1);
}
DI unsigned bitmask32(unsigned w, int pos) { unsigned m; asm("v_bfe_i32 %0, %1, %2, 1" : "=v"(m) : "v"(w), "n"(pos)); return m; }
template <bool BITS, bool NEARB, bool CAUSAL = false>
DI void far_soft(Att& st, f32x16& s0, f32x16& s1, const LAS unsigned char* Vt, int r, int hf, float bfar, bool laneok, unsigned m0, unsigned m1,
                 int tq, int posb, const LAS float* bl) {
    const float cb = laneok ? bfar - st.m : NEG_INF;
    const float nm = laneok ? -st.m : NEG_INF;
    const int dbase = tq - posb - 4 * hf;
    const unsigned w0 = m0 >> (4 * hf), w1 = m1 >> (4 * hf);
    const f32x2 c1v = {QK_C1, QK_C1}; f32x2 cbv = {cb, cb}; f32x2 ls2 = {0.f, 0.f};
#pragma unroll
    for (int i = 0; i < 16; i += 2) { const f32x2 sv = {s0[i], s0[i + 1]};
        if (NEARB) { int d0 = dbase - ((i & 3) + 8 * (i >> 2)), d1 = dbase - (((i + 1) & 3) + 8 * ((i + 1) >> 2)); const bool k0 = d0 >= 0, k1 = d1 >= 0;
            d0 = d0 > 127 ? 127 : d0; d1 = d1 > 127 ? 127 : d1; if (CAUSAL) { d0 = d0 < 0 ? 0 : d0; d1 = d1 < 0 ? 0 : d1; }
            cbv[0] = bl[d0] + nm; cbv[1] = bl[d1] + nm; if (CAUSAL) { cbv[0] = k0 ? cbv[0] : NEG_INF; cbv[1] = k1 ? cbv[1] : NEG_INF; } }
        const f32x2 av = sv * c1v + cbv;
        f32x2 pv; pv[0] = __builtin_amdgcn_exp2f(av[0]); pv[1] = __builtin_amdgcn_exp2f(av[1]);
        if (BITS) { pv[0] = __uint_as_float(__float_as_uint(pv[0]) & bitmask32(w0, (i & 3) + 8 * (i >> 2)));
                    pv[1] = __uint_as_float(__float_as_uint(pv[1]) & bitmask32(w0, ((i + 1) & 3) + 8 * ((i + 1) >> 2))); }
        s0[i] = pv[0]; s0[i + 1] = pv[1]; ls2 += pv; }
    const int rr = r;
#pragma unroll
    for (int G = 0; G < 2; ++G) { const bf16x8 pb = pack8(s0, G); const int cc = 2 * G + hf;
        const bf16x8 a0 = *(const LAS bf16x8*)(Vt + rr * 128 + ((cc ^ ((rr >> 1) & 7)) << 4)); const bf16x8 a1 = *(const LAS bf16x8*)(Vt + (32 + rr) * 128 + ((cc ^ ((rr >> 1) & 7)) << 4));
        st.o0 = MFMA32(a0, pb, st.o0); st.o1 = MFMA32(a1, pb, st.o1); }
#pragma unroll
    for (int i = 0; i < 16; i += 2) { const f32x2 sv = {s1[i], s1[i + 1]};
        if (NEARB) { int d0 = dbase - 32 - ((i & 3) + 8 * (i >> 2)), d1 = dbase - 32 - (((i + 1) & 3) + 8 * ((i + 1) >> 2)); const bool k0 = d0 >= 0, k1 = d1 >= 0;
            d0 = d0 > 127 ? 127 : d0; d1 = d1 > 127 ? 127 : d1; if (CAUSAL) { d0 = d0 < 0 ? 0 : d0; d1 = d1 < 0 ? 0 : d1; }
            cbv[0] = bl[d0] + nm; cbv[1] = bl[d1] + nm; if (CAUSAL) { cbv[0] = k0 ? cbv[0] : NEG_INF; cbv[1] = k1 ? cbv[1] : NEG_INF; } }
        const f32x2 av = sv * c1v + cbv;
        f32x2 pv; pv[0] = __builtin_amdgcn_exp2f(av[0]); pv[1] = __builtin_amdgcn_exp2f(av[1]);
        if (BITS) { pv[0] = __uint_as_float(__float_as_uint(pv[0]) & bitmask32(w1, (i & 3) + 8 * (i >> 2)));
                    pv[1] = __uint_as_float(__float_as_uint(pv[1]) & bitmask32(w1, ((i + 1) & 3) + 8 * ((i + 1) >> 2))); }
        s1[i] = pv[0]; s1[i + 1] = pv[1]; ls2 += pv; }
#pragma unroll
    for (int G = 2; G < 4; ++G) { const bf16x8 pb = pack8(s1, G & 1); const int cc = 2 * G + hf;
        const bf16x8 a0 = *(const LAS bf16x8*)(Vt + rr * 128 + ((cc ^ ((rr >> 1) & 7)) << 4)); const bf16x8 a1 = *(const LAS bf16x8*)(Vt + (32 + rr) * 128 + ((cc ^ ((rr >> 1) & 7)) << 4));
        st.o0 = MFMA32(a0, pb, st.o0); st.o1 = MFMA32(a1, pb, st.o1); }
    st.l += ls2[0] + ls2[1];
}
template <bool BITS, bool NEARB, bool CAUSAL = false, bool QB = false>
DI void far_tile(Att& st, const LAS unsigned char* Kt, const LAS unsigned char* Vt, const bf16x8 (&qf)[4], int r, int hf, float bfar, bool laneok, unsigned m0, unsigned m1,
                 int tq, int posb, const LAS float* bl) {
    f32x16 s0, s1; qk_tile<false, QB>(Kt, qf, r, hf, s0, s1);
    far_soft<BITS, NEARB, CAUSAL>(st, s0, s1, Vt, r, hf, bfar, laneok, m0, m1, tq, posb, bl);
}
template <int Q> DI void expq(f32x16& s, const f32x2 c1v, const f32x2 cbv, f32x2& ls2) {
    const f32x2 v0 = {s[4 * Q], s[4 * Q + 1]}, v1 = {s[4 * Q + 2], s[4 * Q + 3]};
    const f32x2 a0 = v0 * c1v + cbv, a1 = v1 * c1v + cbv;
    f32x2 p0, p1; p0[0] = __builtin_amdgcn_exp2f(a0[0]); p0[1] = __builtin_amdgcn_exp2f(a0[1]); p1[0] = __builtin_amdgcn_exp2f(a1[0]); p1[1] = __builtin_amdgcn_exp2f(a1[1]);
    s[4 * Q] = p0[0]; s[4 * Q + 1] = p0[1]; s[4 * Q + 2] = p1[0]; s[4 * Q + 3] = p1[1]; ls2 += p0; ls2 += p1;
}
DI void ldimg(const LAS unsigned char* xs, f32x16& s0, f32x16& s1) {
#pragma unroll
    for (int g = 0; g < 4; ++g) { const f32x4 a = *(const LAS f32x4*)(xs + g * 16), c = *(const LAS f32x4*)(xs + 64 + g * 16);
        s0[4 * g] = a[0]; s0[4 * g + 1] = a[1]; s0[4 * g + 2] = a[2]; s0[4 * g + 3] = a[3]; s1[4 * g] = c[0]; s1[4 * g + 1] = c[1]; s1[4 * g + 2] = c[2]; s1[4 * g + 3] = c[3]; }
}
DI void ldimg_g(const float* img, int lane, f32x16& s0, f32x16& s1) {
#pragma unroll
    for (int g = 0; g < 4; ++g) { const f32x4 a = *(const f32x4*)(img + g * 256 + lane * 4), c = *(const f32x4*)(img + (4 + g) * 256 + lane * 4);
        s0[4 * g] = a[0]; s0[4 * g + 1] = a[1]; s0[4 * g + 2] = a[2]; s0[4 * g + 3] = a[3]; s1[4 * g] = c[0]; s1[4 * g + 1] = c[1]; s1[4 * g + 2] = c[2]; s1[4 * g + 3] = c[3]; }
}
DI void soft_any(Att& st, f32x16& s0, f32x16& s1, const LAS unsigned char* Vt, int r, int hf, float cbx, bool laneok) {
    if (__ballot(st.m == NEG_INF) == 0ull) { far_soft<false, false>(st, s0, s1, Vt, r, hf, cbx, laneok, 0u, 0u, 0, 0, nullptr); return; }
    const float ad = laneok ? cbx : NEG_INF;
#pragma unroll
    for (int i = 0; i < 16; ++i) { s0[i] = s0[i] * QK_C1 + ad; s1[i] = s1[i] * QK_C1 + ad; }
    online_pv(st, s0, s1, Vt, r, hf);
}
template <bool CM>
DI void far_pair(Att& st, const LAS unsigned char* Ka, const LAS unsigned char* Va, const LAS unsigned char* Kb, const LAS unsigned char* Vb, const bf16x8 (&qf)[4], int r, int hf,
                 float cba, float cbb, const LAS unsigned char* xa, const LAS unsigned char* xb) {
    OPAQUE(r); OPAQUE(hf);
    const f32x16 zero16 = {0.f, 0.f, 0.f, 0.f, 0.f, 0.f, 0.f, 0.f, 0.f, 0.f, 0.f, 0.f, 0.f, 0.f, 0.f, 0.f};
    const int pr = r ^ ((r >> 3) & 1);
    const int kro = pr * 128, kx = r & 7;
    const int vro = r * 128, vx = (r >> 1) & 7;
#define KF0(K, s) (*(const LAS bf16x8*)((K) + kro + (((2 * (s) + hf) ^ kx) << 4)))
#define KF1(K, s) (*(const LAS bf16x8*)((K) + 4096 + kro + (((2 * (s) + hf) ^ kx) << 4)))
#define VF0(V, G) (*(const LAS bf16x8*)((V) + vro + (((2 * (G) + hf) ^ vx) << 4)))
#define VF1(V, G) (*(const LAS bf16x8*)((V) + 4096 + vro + (((2 * (G) + hf) ^ vx) << 4)))
    const f32x2 c1v = {QK_C1, QK_C1}, cav = {cba, cba}, cbv = {cbb, cbb}; f32x2 ls2 = {0.f, 0.f};
    f32x16 s0a, s1a, s0b, s1b;
    { bf16x8 k0[4], k1[4];
#pragma unroll
      for (int s = 0; s < 4; ++s) { k0[s] = KF0(Ka, s); k1[s] = KF1(Ka, s); }
      if (CM) { ldimg(xa, s0a, s1a); ldimg(xb, s0b, s1b); }
      __builtin_amdgcn_sched_barrier(0);
#pragma unroll
      for (int s = 0; s < 4; ++s) {
          if (s == 0 && !CM) { s0a = MFMA32(k0[0], qf[0], zero16); s1a = MFMA32(k1[0], qf[0], zero16); }
          else { s0a = MFMA32(k0[s], qf[s], s0a); s1a = MFMA32(k1[s], qf[s], s1a); } } }
    bf16x8 kb0[4], kb1[4];
#pragma unroll
    for (int s = 0; s < 4; ++s) { kb0[s] = KF0(Kb, s); kb1[s] = KF1(Kb, s); }
    bf16x8 va0[2], va1[2];
#pragma unroll
    for (int G = 0; G < 2; ++G) { va0[G] = VF0(Va, G); va1[G] = VF1(Va, G); }
    __builtin_amdgcn_sched_barrier(0);
    if (!CM) s0b = MFMA32(kb0[0], qf[0], zero16); else s0b = MFMA32(kb0[0], qf[0], s0b);
    expq<0>(s0a, c1v, cav, ls2);
    if (!CM) s1b = MFMA32(kb1[0], qf[0], zero16); else s1b = MFMA32(kb1[0], qf[0], s1b);
    expq<1>(s0a, c1v, cav, ls2);
    s0b = MFMA32(kb0[1], qf[1], s0b);
    expq<2>(s0a, c1v, cav, ls2);
    s1b = MFMA32(kb1[1], qf[1], s1b);
    expq<3>(s0a, c1v, cav, ls2);
    bf16x8 pa0 = pack8(s0a, 0), pa1 = pack8(s0a, 1);
    bf16x8 vc0[2], vc1[2];
#pragma unroll
    for (int G = 0; G < 2; ++G) { vc0[G] = VF0(Va, 2 + G); vc1[G] = VF1(Va, 2 + G); }
    __builtin_amdgcn_sched_barrier(0);
    st.o0 = MFMA32(va0[0], pa0, st.o0); s0b = MFMA32(kb0[2], qf[2], s0b);
    expq<0>(s1a, c1v, cav, ls2);
    st.o1 = MFMA32(va1[0], pa0, st.o1); s1b = MFMA32(kb1[2], qf[2], s1b);
    expq<1>(s1a, c1v, cav, ls2);
    st.o0 = MFMA32(va0[1], pa1, st.o0); s0b = MFMA32(kb0[3], qf[3], s0b);
    expq<2>(s1a, c1v, cav, ls2);
    st.o1 = MFMA32(va1[1], pa1, st.o1); s1b = MFMA32(kb1[3], qf[3], s1b);
    expq<3>(s1a, c1v, cav, ls2);
    pa0 = pack8(s1a, 0); pa1 = pack8(s1a, 1);
#pragma unroll
    for (int G = 0; G < 2; ++G) { va0[G] = VF0(Vb, G); va1[G] = VF1(Vb, G); }
    __builtin_amdgcn_sched_barrier(0);
    st.o0 = MFMA32(vc0[0], pa0, st.o0);
    expq<0>(s0b, c1v, cbv, ls2);
    st.o1 = MFMA32(vc1[0], pa0, st.o1);
    expq<1>(s0b, c1v, cbv, ls2);
    st.o0 = MFMA32(vc0[1], pa1, st.o0);
    expq<2>(s0b, c1v, cbv, ls2);
    st.o1 = MFMA32(vc1[1], pa1, st.o1);
    expq<3>(s0b, c1v, cbv, ls2);
    pa0 = pack8(s0b, 0); pa1 = pack8(s0b, 1);
#pragma unroll
    for (int G = 0; G < 2; ++G) { vc0[G] = VF0(Vb, 2 + G); vc1[G] = VF1(Vb, 2 + G); }
    __builtin_amdgcn_sched_barrier(0);
    st.o0 = MFMA32(va0[0], pa0, st.o0);
    expq<0>(s1b, c1v, cbv, ls2);
    st.o1 = MFMA32(va1[0], pa0, st.o1);
    expq<1>(s1b, c1v, cbv, ls2);
    st.o0 = MFMA32(va0[1], pa1, st.o0);
    expq<2>(s1b, c1v, cbv, ls2);
    st.o1 = MFMA32(va1[1], pa1, st.o1);
    expq<3>(s1b, c1v, cbv, ls2);
    pa0 = pack8(s1b, 0); pa1 = pack8(s1b, 1);
    __builtin_amdgcn_sched_barrier(0);
    st.o0 = MFMA32(vc0[0], pa0, st.o0); st.o1 = MFMA32(vc1[0], pa0, st.o1);
    st.o0 = MFMA32(vc0[1], pa1, st.o0); st.o1 = MFMA32(vc1[1], pa1, st.o1);
    st.l += ls2[0] + ls2[1];
#undef KF0
#undef KF1
#undef VF0
#undef VF1
}
#define LDS_BARRIER() do { asm volatile("s_waitcnt lgkmcnt(0)" ::: "memory"); __builtin_amdgcn_s_barrier(); asm volatile("" ::: "memory"); } while (0)
template <class LD, class BODY>
DI void tile_stream(int n, LAS unsigned char* buf, int tid, bool useV, LD ld, BODY body) {
    if (n <= 0) return;
    uint4 rk0, rk1 = make_uint4(0u, 0u, 0u, 0u), rv0 = make_uint4(0u, 0u, 0u, 0u), rv1 = make_uint4(0u, 0u, 0u, 0u);
    ld(0, rk0, rv0); if (n > 1) ld(1, rk1, rv1);
    st_write_K(buf, tid, rk0); if (useV) st_write_VT(buf + 8192, tid, rv0);
    if (n > 1) { st_write_K(buf + 16384, tid, rk1); if (useV) st_write_VT(buf + 24576, tid, rv1); }
    if (n > 2) ld(2, rk0, rv0); if (n > 3) ld(3, rk1, rv1);
    LDS_BARRIER();
#pragma unroll 1
    for (int i = 0; i < n; i += 2) {
        LAS unsigned char* cur = buf + ((i >> 1) & 1) * 32768;
        if (i + 2 < n) { LAS unsigned char* nxt = buf + (((i >> 1) + 1) & 1) * 32768;
            st_write_K(nxt, tid, rk0); if (useV) st_write_VT(nxt + 8192, tid, rv0);
            if (i + 3 < n) { st_write_K(nxt + 16384, tid, rk1); if (useV) st_write_VT(nxt + 24576, tid, rv1); }
            if (i + 4 < n) ld(i + 4, rk0, rv0); if (i + 5 < n) ld(i + 5, rk1, rv1); }
        body(i, cur, cur + 8192);
        if (i + 1 < n) body(i + 1, cur + 16384, cur + 24576);
        LDS_BARRIER();
    }
}
template <class LD, class BG, class BF, class BF2, class RD>
DI void tile_stream2(int n, LAS unsigned char* buf, int tid, LD ld, BG bodyG, BF bodyF, BF2 bodyF2, int ng, RD ready) {
    if (n <= 0) return;
    uint4 rk0, rk1 = make_uint4(0u, 0u, 0u, 0u), rv0 = make_uint4(0u, 0u, 0u, 0u), rv1 = make_uint4(0u, 0u, 0u, 0u);
    ld(0, rk0, rv0); if (n > 1) ld(1, rk1, rv1);
    st_write_K(buf, tid, rk0); st_write_VT(buf + 8192, tid, rv0);
    if (n > 1) { st_write_K(buf + 16384, tid, rk1); st_write_VT(buf + 24576, tid, rv1); }
    if (n > 2) ld(2, rk0, rv0); if (n > 3) ld(3, rk1, rv1);
    LDS_BARRIER();
    auto stage = [&](int i) {
        if (i + 2 < n) { LAS unsigned char* nxt = buf + (((i >> 1) + 1) & 1) * 32768;
            st_write_K(nxt, tid, rk0); st_write_VT(nxt + 8192, tid, rv0);
            if (i + 3 < n) { st_write_K(nxt + 16384, tid, rk1); st_write_VT(nxt + 24576, tid, rv1); }
            if (i + 4 < n) ld(i + 4, rk0, rv0); if (i + 5 < n) ld(i + 5, rk1, rv1); } };
    int i = 0;
#pragma unroll 1
    for (; i < n; i += 2) {
        if (i >= ng && ready()) break;
        LAS unsigned char* cur = buf + ((i >> 1) & 1) * 32768;
        stage(i);
        bodyG(i, cur, cur + 8192);
        if (i + 1 < n) bodyG(i + 1, cur + 16384, cur + 24576);
        LDS_BARRIER();
    }
#pragma unroll 1
    for (; i + 1 < n; i += 2) {
        LAS unsigned char* cur = buf + ((i >> 1) & 1) * 32768;
        stage(i);
        bodyF2(i, cur);
        LDS_BARRIER();
    }
    if (i < n) { bodyF(i, buf + ((i >> 1) & 1) * 32768, buf + ((i >> 1) & 1) * 32768 + 8192); LDS_BARRIER(); }
}
template <class LD, class BODY>
DI void tile_stream_k4(int n, LAS unsigned char* buf, int tid, LD ld, BODY body) {
    if (n <= 0) return;
    uint4 r0, r1 = make_uint4(0u, 0u, 0u, 0u), r2 = make_uint4(0u, 0u, 0u, 0u), r3 = make_uint4(0u, 0u, 0u, 0u), dv;
    ld(0, r0, dv); if (n > 1) ld(1, r1, dv); if (n > 2) ld(2, r2, dv); if (n > 3) ld(3, r3, dv);
    st_write_K(buf, tid, r0); if (n > 1) st_write_K(buf + 8192, tid, r1); if (n > 2) st_write_K(buf + 16384, tid, r2); if (n > 3) st_write_K(buf + 24576, tid, r3);
    if (n > 4) ld(4, r0, dv); if (n > 5) ld(5, r1, dv); if (n > 6) ld(6, r2, dv); if (n > 7) ld(7, r3, dv);
    LDS_BARRIER();
#pragma unroll 1
    for (int i = 0; i < n; i += 4) {
        LAS unsigned char* cur = buf + ((i >> 2) & 1) * 32768;
        if (i + 4 < n) { LAS unsigned char* nxt = buf + (((i >> 2) + 1) & 1) * 32768;
            st_write_K(nxt, tid, r0); if (i + 5 < n) st_write_K(nxt + 8192, tid, r1); if (i + 6 < n) st_write_K(nxt + 16384, tid, r2); if (i + 7 < n) st_write_K(nxt + 24576, tid, r3);
            if (i + 8 < n) ld(i + 8, r0, dv); if (i + 9 < n) ld(i + 9, r1, dv); if (i + 10 < n) ld(i + 10, r2, dv); if (i + 11 < n) ld(i + 11, r3, dv); }
#pragma unroll 1
        for (int j = 0; j < 4; ++j) if (i + j < n) body(i + j, cur + j * 8192, cur);
        LDS_BARRIER();
    }
}
DI uint4 cvt8_f32(const float* p) { const f32x4 a = *(const f32x4*)p, b = *(const f32x4*)(p + 4); uint4 o; o.x = pack2(a[0], a[1]); o.y = pack2(a[2], a[3]); o.z = pack2(b[0], b[1]); o.w = pack2(b[2], b[3]); return o; }

DI void nsa_unit(const Frame& F, int b, int g, int qb) {
    int tid_ = F.tid; OPAQUE(tid_);
    const int tid = tid_, lane = tid & 63, w = F.wave, r = lane & 31, hf = lane >> 5;
    LAS unsigned char* L = F.ldsl;
    LAS unsigned char* buf = L + AT_BUF;
    LAS float* psum = (LAS float*)(L + AT_PSUM);
    LAS unsigned long long* selm = (LAS unsigned long long*)(L + AT_SELM);
    LAS unsigned char* tlist = L + AT_SELM + 528;
    LAS int* tcnt = (LAS int*)(L + AT_SELM + 520);
    const bf16_t* U = (const bf16_t*)(F.ws + WS_U);
    const float* KC = (const float*)(F.ws + WS_KCMP) + (size_t)(b * 2 + g) * 256 * 64;
    const bf16_t* VCT = (const bf16_t*)(F.ws + WS_VCT) + (size_t)(b * 2 + g) * 64 * 256;
    const bf16_t* VT = (const bf16_t*)(F.ws + WS_VT);
    bf16_t* Y = (bf16_t*)(F.ws + WS_BFB);
    const int t0 = qb * 64;
    const int ql = r >> 2, h = r & 3, hh = g * 4 + h;
    const int tq = t0 + 8 * w + ql;
    const size_t row = (size_t)b * SEQ + tq;
    const bf16_t* Ur = U + row * LD0;
    bf16x8 qf[4];
#pragma unroll
    for (int s = 0; s < 4; ++s) qf[s] = *(const bf16x8*)(Ur + C_AQ + hh * 64 + 16 * s + 8 * hf);
    const LAS float* bl = F.biasL + hh * 128; const float bfar = bl[127];
    float gate[3];
    { const unsigned* gp = (const unsigned*)(Ur + C_AG);
#pragma unroll
      for (int j = 0; j < 3; ++j) { const int e = hh * 3 + j; const unsigned wv = gp[e >> 1]; gate[j] = sigmoidf_((e & 1) ? __uint_as_float(wv & 0xFFFF0000u) : __uint_as_float(wv << 16)); } }
    LAS float* opark = psum + w * 2048 + lane;

    const int nvmax = ((t0 + 63 - 31) >> 4) + 1;
    const int ntc = (nvmax + 63) >> 6;
    for (int e = tid; e < 64 * 256; e += 512) psum[e] = 0.f;
    float cm = NEG_INF, cl = 0.f;
    {
#pragma unroll 1
        for (int i = 0; i < ntc; ++i) { const int key = tid >> 3, c = tid & 7;
            const uint4 rk = cvt8_f32(KC + (size_t)(i * 64 + key) * 64 + c * 8); const uint4 rv = *(const uint4*)(VCT + (size_t)key * 256 + i * 64 + c * 8);
            st_write_K(buf + i * 8192, tid, rk); st_write_VT(buf + 32768 + i * 8192, tid, rv); }
        __syncthreads();
        auto body = [&](int i, LAS unsigned char* Kt, LAS unsigned char* Vt) { (void)Vt;
            f32x16 s0, s1; qk_tile(Kt, qf, r, hf, s0, s1);
            if (16 * (i * 64 + 63) + 31 + 113 <= t0 + 8 * w) { fix_scores<0>(s0, 0, 16, tq, bl, bfar, 0u, true, hf); fix_scores<0>(s1, 0, 16, tq, bl, bfar, 0u, true, hf); }
            else { fix_scores<FL_NEAR | FL_CAUSAL>(s0, 16 * (i * 64) + 31, 16, tq, bl, bfar, 0u, true, hf); fix_scores<FL_NEAR | FL_CAUSAL>(s1, 16 * (i * 64 + 32) + 31, 16, tq, bl, bfar, 0u, true, hf); }
            float tm = NEG_INF;
#pragma unroll
            for (int k = 0; k < 16; ++k) tm = fmaxf(tm, fmaxf(s0[k], s1[k]));
            tm = fmaxf(tm, __shfl_xor(tm, 32));
            const float mn = fmaxf(cm, tm); const float mu = (mn == NEG_INF) ? 0.f : mn;
            float ls = 0.f;
#pragma unroll
            for (int k = 0; k < 16; ++k) ls += __builtin_amdgcn_exp2f(s0[k] - mu) + __builtin_amdgcn_exp2f(s1[k] - mu);
            cl = cl * __builtin_amdgcn_exp2f(cm - mu) + ls; cm = mn; };
#pragma unroll 1
        for (int i = 0; i < ntc; ++i) body(i, buf + i * 8192, buf + 32768 + i * 8192);
    }
    f32x16 c0, c1;
    {
        cl += __shfl_xor(cl, 32);
        const float cinv = cl > 0.f ? 1.0f / cl : 0.f; const float cmu = (cm == NEG_INF) ? 0.f : cm;
#pragma unroll
        for (int i = 0; i < 16; ++i) { c0[i] = 0.f; c1[i] = 0.f; }
        auto body = [&](int i, LAS unsigned char* Kt, LAS unsigned char* Vt) {
            f32x16 s0, s1; qk_tile(Kt, qf, r, hf, s0, s1);
            if (16 * (i * 64 + 63) + 31 + 113 <= t0 + 8 * w) { fix_scores<0>(s0, 0, 16, tq, bl, bfar, 0u, true, hf); fix_scores<0>(s1, 0, 16, tq, bl, bfar, 0u, true, hf); }
            else { fix_scores<FL_NEAR | FL_CAUSAL>(s0, 16 * (i * 64) + 31, 16, tq, bl, bfar, 0u, true, hf); fix_scores<FL_NEAR | FL_CAUSAL>(s1, 16 * (i * 64 + 32) + 31, 16, tq, bl, bfar, 0u, true, hf); }
#pragma unroll
            for (int k = 0; k < 16; ++k) { s0[k] = __builtin_amdgcn_exp2f(s0[k] - cmu) * cinv; s1[k] = __builtin_amdgcn_exp2f(s1[k] - cmu) * cinv; }
#pragma unroll
            for (int k = 0; k < 16; ++k) {
                float a0 = s0[k], a1 = s1[k];
                a0 += __shfl_xor(a0, 1); a0 += __shfl_xor(a0, 2); a1 += __shfl_xor(a1, 1); a1 += __shfl_xor(a1, 2);
                const int koff = (k & 3) + 8 * (k >> 2) + 4 * hf;
                if (h == 0) { psum[(8 * w + ql) * 256 + i * 64 + koff] = a0; psum[(8 * w + ql) * 256 + i * 64 + 32 + koff] = a1; }
            }
            pv_tile(Vt, s0, s1, r, hf, c0, c1); };
#pragma unroll 1
        for (int i = 0; i < ntc; ++i) body(i, buf + i * 8192, buf + 32768 + i * 8192);
        __syncthreads();
    }
    {
        const int cur = qb; const int npick = (cur + 1) < 8 ? (cur + 1) : 8;
        LAS float* scw = (LAS float*)(L + AT_MISC + 64) + w * 64;
#pragma unroll 1
        for (int q = 0; q < 8; ++q) {
            const LAS float* pr = psum + (8 * w + q) * 256;
            float imp = 0.f;
            const int i0 = 4 * lane - 1 < 0 ? 0 : 4 * lane - 1, i1 = 4 * lane + 3 > 254 ? 254 : 4 * lane + 3;
            for (int i = i0; i <= i1; ++i) imp += pr[i];
            const bool adm = lane <= cur; const bool forced = (lane == 0) || (lane == cur) || (lane == cur - 1);
            const float score = adm ? imp + (forced ? 1.0e4f : 0.f) : NEG_INF;
            __builtin_amdgcn_wave_barrier();
            scw[lane] = score;
            __builtin_amdgcn_wave_barrier();
            int rank = 0;
#pragma unroll
            for (int j4 = 0; j4 < 16; ++j4) { const f32x4 o = *(const LAS f32x4*)(scw + 4 * j4);
#pragma unroll
                for (int e = 0; e < 4; ++e) { const int j = 4 * j4 + e; rank += (o[e] > score || (o[e] == score && j < lane)) ? 1 : 0; } }
            const unsigned long long sm = __ballot(adm && rank < npick);
            if (lane == 0) selm[8 * w + q] = sm;
        }
    }
    __syncthreads();
    if (w == 0) {
        unsigned long long m = selm[lane];
        unsigned lo = (unsigned)m, hi = (unsigned)(m >> 32);
        for (int o = 32; o >= 1; o >>= 1) { lo |= __shfl_xor(lo, o); hi |= __shfl_xor(hi, o); }
        const unsigned long long un = ((unsigned long long)hi << 32) | lo;
        const bool mine = (un >> lane) & 1ull;
        const int pos = __popcll(un & ((1ull << lane) - 1ull));
        if (mine) tlist[pos] = (unsigned char)lane;
        if (lane == 0) { tcnt[0] = __popcll(un); tcnt[1] = qb > 2 ? __popcll(un & ((1ull << (qb - 2)) - 1ull)) : 0; }
    }
    __syncthreads();
#pragma unroll
    for (int i = 0; i < 16; ++i) { opark[i * 64] = gate[0] * c0[i]; opark[(16 + i) * 64] = gate[0] * c1[i]; }
    const unsigned long long mysel = selm[8 * w + ql];
    {
        Att st; att_init(st);
        const int nts = tcnt[0];
        const int nfar = tcnt[1], nnear = nts - nfar;
        auto tileof = [&](int p) { return (int)tlist[p < nnear ? nfar + p : p - nnear]; };
        auto lds_ = [&](int p, uint4& rk, uint4& rv) { const int j = tileof(p); int t_ = tid; OPAQUE(t_); const int key = t_ >> 3, c = t_ & 7;
            const bf16_t* pp = U + ((size_t)b * SEQ + j * 64 + key) * LD0 + g * 64 + c * 8; rk = *(const uint4*)(pp + C_KS); rv = *(const uint4*)(VT + (size_t)(g * 64 + key) * MT + (size_t)b * SEQ + j * 64 + c * 8); };
        const float* imgn = (const float*)(F.ws + WS_IMGN) + (size_t)((g * 3) * 8 + w) * 2048; const float* imgz = (const float*)(F.ws + WS_IMGZ);
        auto body = [&](int p, LAS unsigned char* Kt, LAS unsigned char* Vt) {
            const int j = tileof(p);
            const bool laneok = (mysel >> j) & 1ull;
            if (__ballot(laneok) == 0ull) return;
            const int dl = qb - j; const bool near = dl < 3;
            f32x16 s0, s1;
            ldimg_g(near ? imgn + (size_t)dl * 16384 : imgz, lane, s0, s1);
            qk_tile<true>(Kt, qf, r, hf, s0, s1);
            soft_any(st, s0, s1, Vt, r, hf, near ? 0.f : bfar, laneok); };
        auto bodyF = [&](int p, LAS unsigned char* Kt, LAS unsigned char* Vt) {
            const int j = tlist[p - nnear];
            const bool laneok = (mysel >> j) & 1ull;
            if (__ballot(laneok) == 0ull) return;
            far_tile<false, false, false, true>(st, Kt, Vt, qf, r, hf, bfar, laneok, 0u, 0u, tq, j * 64, bl); };
        auto bodyF2 = [&](int p, LAS unsigned char* cur) {
            const int ja = tlist[p - nnear], jb = tlist[p + 1 - nnear];
            const float cba = ((mysel >> ja) & 1ull) ? bfar - st.m : NEG_INF, cbb = ((mysel >> jb) & 1ull) ? bfar - st.m : NEG_INF;
            far_pair<false>(st, cur, cur + 8192, cur + 16384, cur + 24576, qf, r, hf, cba, cbb, nullptr, nullptr); };
        tile_stream2(nts, buf, tid, lds_, body, bodyF, bodyF2, nnear, [&]() { return __ballot(st.m == NEG_INF) == 0ull; });
        float l = st.l + __shfl_xor(st.l, 32);
        const float sc = l > 0.f ? gate[1] / l : 0.f;
#pragma unroll
        for (int i = 0; i < 16; ++i) { opark[i * 64] += sc * st.o0[i]; opark[(16 + i) * 64] += sc * st.o1[i]; }
    }
    {
        Att st; att_init(st);
        const int j0 = qb - 8 < 0 ? 0 : qb - 8; const int ntw = qb - j0 + 1;
        const int hasw = qb >= 8 ? 1 : 0, gs = (qb - 2 > j0 + hasw) ? qb - 2 : j0 + hasw, ngw = hasw + (qb - gs + 1), f0 = j0 + hasw;
        auto tileof = [&](int p) { return p < ngw ? ((hasw && p == 0) ? j0 : gs + p - hasw) : f0 + (p - ngw); };
        auto ldw = [&](int p, uint4& rk, uint4& rv) { const int j = tileof(p); int t_ = tid; OPAQUE(t_); const int key = t_ >> 3, c = t_ & 7;
            const bf16_t* pp = U + ((size_t)b * SEQ + j * 64 + key) * LD0 + g * 64 + c * 8; rk = *(const uint4*)(pp + C_KW); rv = *(const uint4*)(VT + (size_t)(128 + g * 64 + key) * MT + (size_t)b * SEQ + j * 64 + c * 8); };
        const float* imgn = (const float*)(F.ws + WS_IMGN) + (size_t)((g * 3) * 8 + w) * 2048; const float* imgz = (const float*)(F.ws + WS_IMGZ); const float* imgw = (const float*)(F.ws + WS_IMGW) + (size_t)w * 2048;
        auto body = [&](int p, LAS unsigned char* Kt, LAS unsigned char* Vt) {
            const int j = tileof(p);
            const int dl = qb - j; const bool near = dl < 3;
            f32x16 s0, s1;
            ldimg_g(near ? imgn + (size_t)dl * 16384 : (dl == 8 ? imgw : imgz), lane, s0, s1);
            qk_tile<true>(Kt, qf, r, hf, s0, s1);
            soft_any(st, s0, s1, Vt, r, hf, near ? 0.f : bfar, true); };
        auto bodyF = [&](int p, LAS unsigned char* Kt, LAS unsigned char* Vt) { far_tile<false, false, false, true>(st, Kt, Vt, qf, r, hf, bfar, true, 0u, 0u, tq, (f0 + p - ngw) * 64, bl); };
        auto bodyF2 = [&](int p, LAS unsigned char* cur) { (void)p; far_pair<false>(st, cur, cur + 8192, cur + 16384, cur + 24576, qf, r, hf, bfar - st.m, bfar - st.m, nullptr, nullptr); };
        tile_stream2(ntw, buf, tid, ldw, body, bodyF, bodyF2, ngw, [&]() { return __ballot(st.m == NEG_INF) == 0ull; });
        float l = st.l + __shfl_xor(st.l, 32);
        const float sc = l > 0.f ? gate[2] / l : 0.f;
#pragma unroll
        for (int i = 0; i < 16; ++i) { c0[i] = opark[i * 64] + sc * st.o0[i]; c1[i] = opark[(16 + i) * 64] + sc * st.o1[i]; }
    }
#pragma unroll
    for (int dh = 0; dh < 2; ++dh)
#pragma unroll
        for (int k = 0; k < 4; ++k) {
            const int d = 32 * dh + 8 * k + 4 * hf;
            const uint2 zz = *(const uint2*)(Ur + C_AZ + hh * 64 + d);
            const float z0 = __uint_as_float(zz.x << 16), z1 = __uint_as_float(zz.x & 0xFFFF0000u), z2 = __uint_as_float(zz.y << 16), z3 = __uint_as_float(zz.y & 0xFFFF0000u);
            const f32x16& o = dh ? c1 : c0;
            uint2 pk; pk.x = pack2(o[4 * k + 0] * siluf_(z0), o[4 * k + 1] * siluf_(z1)); pk.y = pack2(o[4 * k + 2] * siluf_(z2), o[4 * k + 3] * siluf_(z3));
            *(uint2*)(Y + row * 1024 + hh * 64 + d) = pk;
        }
    __syncthreads();
}

DI unsigned short okey16(float x) {
    const _Float16 hx = (_Float16)x; unsigned short u = __builtin_bit_cast(unsigned short, hx);
    if ((u & 0x7FFFu) == 0u) u = 0u;
    return (u & 0x8000u) ? (unsigned short)~u : (unsigned short)(u | 0x8000u);
}
DI void dsa_unit(const Frame& F, int b, int qt) {
    int tid_ = F.tid; OPAQUE(tid_);
    const int tid = tid_, lane = tid & 63, w = F.wave, r = lane & 31, hf = lane >> 5, fr = lane & 15, fq = lane >> 4;
    LAS unsigned char* L = F.ldsl;
    LAS unsigned char* buf = L + AT_BUF;
    LAS unsigned* mask = (LAS unsigned*)(L + AT_PSUM);
    const bf16_t* U = (const bf16_t*)(F.ws + WS_U);
    bf16_t* Y = (bf16_t*)(F.ws + WS_BFB);
    const bf16_t* VT = (const bf16_t*)(F.ws + WS_VT);
    unsigned short* KS = (unsigned short*)(F.ws + WS_BFA) + (size_t)F.bid * 32 * 4096;
    const int t0 = qt * 32;
    const int nt = ((t0 + 31) >> 6) + 1;
    {
        bf16x8 qi[2]; float wi[4];
        { const bf16_t* Uq = U + ((size_t)b * SEQ + t0 + 4 * w + (fr >> 2)) * LD0;
#pragma unroll
          for (int ks = 0; ks < 2; ++ks) qi[ks] = *(const bf16x8*)(Uq + C_BQI + (fr & 3) * 64 + 32 * ks + 8 * fq);
          const uint2 wv = *(const uint2*)(U + ((size_t)b * SEQ + t0 + 4 * w + fq) * LD0 + C_BWI);
          wi[0] = __uint_as_float(wv.x << 16) * 0.0625f; wi[1] = __uint_as_float(wv.x & 0xFFFF0000u) * 0.0625f; wi[2] = __uint_as_float(wv.y << 16) * 0.0625f; wi[3] = __uint_as_float(wv.y & 0xFFFF0000u) * 0.0625f; }
        const int tqi = t0 + 4 * w + fq;
        auto ldi = [&](int i, uint4& rk, uint4& rv) { const int key = tid >> 3, c = tid & 7; rk = *(const uint4*)(U + ((size_t)b * SEQ + i * 64 + key) * LD0 + C_BKI + c * 8); (void)rv; };
        auto body = [&](int i, LAS unsigned char* Kt, LAS unsigned char* Vt) { (void)Vt;
#pragma unroll
            for (int kg = 0; kg < 4; ++kg) {
                const int kk = 16 * kg + fr;
                f32x4 acc = {0.f, 0.f, 0.f, 0.f};
#pragma unroll
                for (int ks = 0; ks < 2; ++ks) { const int c = 4 * ks + fq;
                    const bf16x8 kb = *(const LAS bf16x8*)(Kt + (kk ^ ((kk >> 3) & 1)) * 128 + ((c ^ (kk & 7)) << 4));
                    acc = __builtin_amdgcn_mfma_f32_16x16x32_bf16(qi[ks], kb, acc, 0, 0, 0); }
                const float sc = wi[0] * fmaxf(acc[0], 0.f) + wi[1] * fmaxf(acc[1], 0.f) + wi[2] * fmaxf(acc[2], 0.f) + wi[3] * fmaxf(acc[3], 0.f);
                const int pos = i * 64 + kk;
                KS[(size_t)(4 * w + fq) * 4096 + pos] = pos <= tqi ? okey16(sc) : (unsigned short)0;
            } };
        tile_stream_k4(nt, buf, tid, ldi, body);
    }
    asm volatile("s_waitcnt vmcnt(0)" ::: "memory");
    __syncthreads();
    __builtin_amdgcn_fence(__ATOMIC_ACQUIRE, "agent");
    asm volatile("s_waitcnt vmcnt(0)" ::: "memory");
    {
    LAS unsigned char* maskb = (LAS unsigned char*)mask;
    unsigned Tn[32];
    auto ldkeys = [&](int q) { const int qq = 4 * w + q; const int nk = t0 + qq + 1; int ln = lane; OPAQUE(ln); const unsigned short* kq = KS + (size_t)qq * 4096 + ln * 8;
#pragma unroll
        for (int c = 0; c < 8; ++c) { uint4 kv = make_uint4(0u, 0u, 0u, 0u); if (c * 512 < nk) kv = *(const uint4*)(kq + c * 512);
            Tn[4 * c] = kv.x; Tn[4 * c + 1] = kv.y; Tn[4 * c + 2] = kv.z; Tn[4 * c + 3] = kv.w; } };
    ldkeys(0);
#pragma unroll 1
    for (int q = 0; q < 4; ++q) {
        const int qq = 4 * w + q; const int tqq = t0 + qq; const int nk = tqq + 1;
        unsigned T[32];
#pragma unroll
        for (int e = 0; e < 32; ++e) T[e] = Tn[e];
        if (q < 3) ldkeys(q + 1);
        if (nk <= 256) {
#pragma unroll
            for (int c = 0; c < 8; ++c) { unsigned selb = 0u;
#pragma unroll
                for (int e = 0; e < 8; ++e) if (c * 512 + lane * 8 + e < nk) selb |= 1u << e;
                maskb[qq * 512 + c * 64 + lane] = (unsigned char)selb; }
            continue;
        }
#pragma unroll
        for (int e = 0; e < 32; ++e) { const int idx = (e >> 2) * 512 + lane * 8 + (e & 3) * 2;
            unsigned lo = T[e] & 0xFFFFu, hi = T[e] >> 16; if (idx >= nk) lo = 0u; if (idx + 1 >= nk) hi = 0u; T[e] = lo | (hi << 16); }
#pragma unroll
        for (int st = 0; st < 5; ++st) { const int j = 16 >> st; const unsigned m = st == 0 ? 0x0000FFFFu : st == 1 ? 0x00FF00FFu : st == 2 ? 0x0F0F0F0Fu : st == 3 ? 0x33333333u : 0x55555555u;
#pragma unroll
            for (int k0 = 0; k0 < 32; k0 += 2 * j)
#pragma unroll
                for (int i = 0; i < j; ++i) { const int k = k0 + i; const unsigned t = ((T[k] >> j) ^ T[k + j]) & m; T[k] ^= (t << j); T[k + j] ^= t; } }
        unsigned ce = 0xFFFFFFFFu, co = 0xFFFFFFFFu, ge = 0u, go = 0u; int above = 0;
#pragma unroll
        for (int bit = 15; bit >= 0; --bit) {
            const unsigned oe = ce & T[bit], oo = co & T[16 + bit];
            const int cnt = __popc(oe) + __popc(oo);
            int tot = 0;
#pragma unroll
            for (int bb = 0; bb < 7; ++bb) tot += __popcll(__ballot((cnt >> bb) & 1)) << bb;
            if (above + tot >= 256) { ce = oe; co = oo; }
            else { above += tot; ge |= oe; go |= oo; ce &= ~T[bit]; co &= ~T[16 + bit]; }
        }
        const int quota = 256 - above; int taken = 0;
#pragma unroll
        for (int c = 0; c < 8; ++c) {
            unsigned xe = (ge >> (4 * c)) & 0xFu, xo = (go >> (4 * c)) & 0xFu;
            xe = (xe | (xe << 2)) & 0x33u; xe = (xe | (xe << 1)) & 0x55u; xo = (xo | (xo << 2)) & 0x33u; xo = (xo | (xo << 1)) & 0x55u;
            unsigned selb = xe | (xo << 1);
            unsigned ye = (ce >> (4 * c)) & 0xFu, yo = (co >> (4 * c)) & 0xFu;
            ye = (ye | (ye << 2)) & 0x33u; ye = (ye | (ye << 1)) & 0x55u; yo = (yo | (yo << 2)) & 0x33u; yo = (yo | (yo << 1)) & 0x55u;
            const unsigned eqb = ye | (yo << 1);
            if (__ballot(eqb != 0u) != 0ull) {
                const int ne = __popc(eqb);
                int excl = 0, totc = 0;
#pragma unroll
                for (int bb = 0; bb < 4; ++bb) { const unsigned long long bl_ = __ballot((ne >> bb) & 1);
                    excl += (int)__builtin_amdgcn_mbcnt_hi((unsigned)(bl_ >> 32), __builtin_amdgcn_mbcnt_lo((unsigned)bl_, 0u)) << bb; totc += __popcll(bl_) << bb; }
                int rank = taken + excl;
#pragma unroll
                for (int e = 0; e < 8; ++e) if ((eqb >> e) & 1u) { if (rank < quota) selb |= 1u << e; ++rank; }
                taken += totc;
            }
            maskb[qq * 512 + c * 64 + lane] = (unsigned char)selb;
        }
    }
    }
    __syncthreads();
    {
        const int ql = r >> 3, h = r & 7;
        const int tq = t0 + 4 * w + ql;
        const size_t row = (size_t)b * SEQ + tq;
        const bf16_t* Ur = U + row * LD0;
        bf16x8 qf[4];
#pragma unroll
        for (int s = 0; s < 4; ++s) qf[s] = *(const bf16x8*)(Ur + C_BQ + h * 64 + 16 * s + 8 * hf);
        const LAS float* bl = F.biasL + (8 + h) * 128; const float bfar = bl[127];
        const LAS unsigned* mq = mask + (4 * w + ql) * 128;
        LAS unsigned char* xmw = L + AT_XM + w * 2304 + ql * 272 + hf * 128;
        const int nnear = nt < 4 ? nt : 4;
        auto tileof = [&](int p) { return p < nnear ? nt - nnear + p : p - nnear; };
        auto expand = [&](int p) { const int i = tileof(p);
            const unsigned nib = (~mq[2 * i + (h >> 2)]) >> (8 * (h & 3) + 4 * hf);
            u32x4 v; v[0] = bitmask32(nib, 0) & 0xFF800000u; v[1] = bitmask32(nib, 1) & 0xFF800000u; v[2] = bitmask32(nib, 2) & 0xFF800000u; v[3] = bitmask32(nib, 3) & 0xFF800000u;
            *(LAS u32x4*)(xmw + (p & 1) * 1152 + h * 16) = v; };
        expand(0);
        Att st; att_init(st);
        auto lda = [&](int p, uint4& rk, uint4& rv) { const int i = tileof(p); int t_ = tid; OPAQUE(t_); const int key = t_ >> 3, c = t_ & 7;
            const bf16_t* pp = U + ((size_t)b * SEQ + i * 64 + key) * LD0 + c * 8; rk = *(const uint4*)(pp + C_BK); rv = *(const uint4*)(VT + (size_t)(256 + key) * MT + (size_t)b * SEQ + i * 64 + c * 8); };
        const float* imgd = (const float*)(F.ws + WS_IMGD) + (size_t)(((qt & 1) * 4) * 8 + w) * 2048; const float* imgz = (const float*)(F.ws + WS_IMGZ);
        auto body = [&](int p, LAS unsigned char* Kt, LAS unsigned char* Vt) { const int i = tileof(p);
            const int dl = nt - 1 - i; const bool near = dl < 4;
            f32x16 s0, s1, b0, b1;
            ldimg_g(near ? imgd + (size_t)dl * 16384 : imgz, lane, b0, b1);
            ldimg(xmw + (p & 1) * 1152, s0, s1);
            if (p + 1 < nt) expand(p + 1);
            s0 += b0; s1 += b1;
            qk_tile<true>(Kt, qf, r, hf, s0, s1);
            soft_any(st, s0, s1, Vt, r, hf, near ? 0.f : bfar, true); };
        auto bodyF = [&](int p, LAS unsigned char* Kt, LAS unsigned char* Vt) { const int i = p - nnear;
            f32x16 s0, s1;
            { const LAS unsigned char* xs = xmw + (p & 1) * 1152;
#pragma unroll
              for (int g = 0; g < 4; ++g) { const f32x4 a = *(const LAS f32x4*)(xs + g * 16), c = *(const LAS f32x4*)(xs + 64 + g * 16);
                  s0[4 * g] = a[0]; s0[4 * g + 1] = a[1]; s0[4 * g + 2] = a[2]; s0[4 * g + 3] = a[3]; s1[4 * g] = c[0]; s1[4 * g + 1] = c[1]; s1[4 * g + 2] = c[2]; s1[4 * g + 3] = c[3]; } }
            if (p + 1 < nt) expand(p + 1);
            qk_tile<true, true>(Kt, qf, r, hf, s0, s1);
            far_soft<false, false>(st, s0, s1, Vt, r, hf, bfar, true, 0u, 0u, tq, i * 64, bl); };
        auto bodyF2 = [&](int p, LAS unsigned char* cur) {
            expand(p + 1);
            far_pair<true>(st, cur, cur + 8192, cur + 16384, cur + 24576, qf, r, hf, bfar - st.m, bfar - st.m, xmw, xmw + 1152);
            if (p + 2 < nt) expand(p + 2); };
        tile_stream2(nt, buf, tid, lda, body, bodyF, bodyF2, nnear, [&]() { return __ballot(st.m == NEG_INF) == 0ull; });
        float l = st.l + __shfl_xor(st.l, 32);
        const float sc = l > 0.f ? 1.0f / l : 0.f;
#pragma unroll
        for (int dh = 0; dh < 2; ++dh)
#pragma unroll
            for (int k = 0; k < 4; ++k) {
                const int d = 32 * dh + 8 * k + 4 * hf;
                const uint2 zz = *(const uint2*)(Ur + C_BZ + h * 64 + d);
                const float z0 = __uint_as_float(zz.x << 16), z1 = __uint_as_float(zz.x & 0xFFFF0000u), z2 = __uint_as_float(zz.y << 16), z3 = __uint_as_float(zz.y & 0xFFFF0000u);
                const f32x16& o = dh ? st.o1 : st.o0;
                uint2 pk; pk.x = pack2(o[4 * k + 0] * sc * siluf_(z0), o[4 * k + 1] * sc * siluf_(z1)); pk.y = pack2(o[4 * k + 2] * sc * siluf_(z2), o[4 * k + 3] * sc * siluf_(z3));
                *(uint2*)(Y + row * 1024 + 512 + h * 64 + d) = pk;
            }
    }
    __syncthreads();
}

DI void att_dsa(const Frame& F) {
    LAS int* ub = (LAS int*)(F.ldsl + AT_MISC);
    unsigned* qd = F.ctl + CW_QDSA;
    const int NDSA = NB * (SEQ / 32);
    __syncthreads();
    if (F.tid == 0) ub[0] = (int)__hip_atomic_fetch_add(qd, 1u, __ATOMIC_RELAXED, __HIP_MEMORY_SCOPE_AGENT);
    for (;;) {
        __syncthreads();
        const int k = ub[0];
        __syncthreads();
        if (k >= NDSA) break;
        int nxt = 0; if (F.tid == 0) nxt = (int)__hip_atomic_fetch_add(qd, 1u, __ATOMIC_RELAXED, __HIP_MEMORY_SCOPE_AGENT);
        dsa_unit(F, k & 7, (SEQ / 32) - 1 - (k >> 3));
        if (F.tid == 0) ub[0] = nxt;
    }
}
DI void att_nsa(const Frame& F) {
    LAS int* ub = (LAS int*)(F.ldsl + AT_MISC);
    unsigned* qn = F.ctl + CW_QNSA;
    const int NNSA = NB * 2 * (SEQ / 64);
    __syncthreads();
    if (F.tid == 0) ub[0] = (int)__hip_atomic_fetch_add(qn, 1u, __ATOMIC_RELAXED, __HIP_MEMORY_SCOPE_AGENT);
    for (;;) {
        __syncthreads();
        const int k = ub[0];
        __syncthreads();
        if (k >= NNSA) break;
        int nxt = 0; if (F.tid == 0) nxt = (int)__hip_atomic_fetch_add(qn, 1u, __ATOMIC_RELAXED, __HIP_MEMORY_SCOPE_AGENT);
        const int bg = k & 15;
        nsa_unit(F, bg >> 1, bg & 1, 63 - (k >> 4));
        if (F.tid == 0) ub[0] = nxt;
    }
}

DI f32x4 mma16(const bf16_t* A, int lda, const bf16_t* Bt, int ldb, int K, int lane) {
    const int fr = lane & 15, fq = lane >> 4;
    f32x4 acc = {0.f, 0.f, 0.f, 0.f};
    for (int k = 0; k < K; k += 32) {
        const bf16x8 a = *(const bf16x8*)(A + fr * lda + k + fq * 8);
        const bf16x8 b = *(const bf16x8*)(Bt + fr * ldb + k + fq * 8);
        acc = __builtin_amdgcn_mfma_f32_16x16x32_bf16(a, b, acc, 0, 0, 0);
    }
    return acc;
}
DI void conv8(const bf16_t* U1, int b, int t, int col, const float* cw  , int nch, const float* cb, float (&y)[8]) {
#pragma unroll
    for (int i = 0; i < 8; ++i) y[i] = cb[i];
#pragma unroll
    for (int j = 0; j < 4; ++j) { const int tt = t - 3 + j;
        if (tt >= 0) { const uint4 v = *(const uint4*)(U1 + ((size_t)b * SEQ + tt) * LD1 + col); float f[8]; unpack8(v, f);
#pragma unroll
            for (int i = 0; i < 8; ++i) y[i] += cw[(size_t)j * nch + i] * f[i]; } }
}
DI void stage_raw128(const Frame& F, const bf16_t* U1, int b, int t_first, int nrows, int col, bf16_t* raw) {
    for (int it = F.tid; it < nrows * 16; it += 512) { const int row = it >> 4, ch = it & 15; const int t = t_first + row;
        uint4 v = make_uint4(0u, 0u, 0u, 0u); if (t >= 0) v = *(const uint4*)(U1 + ((size_t)b * SEQ + t) * LD1 + col + ch * 8);
        *(uint4*)(raw + row * 136 + ch * 8) = v; }
}
DI void load_raw128(const Frame& F, const bf16_t* U1, int b, int t_first, int nrows, int col, uint4 (&rg)[3]) {
#pragma unroll
    for (int j = 0; j < 3; ++j) { const int it = F.tid + j * 512; const int row = it >> 4, ch = it & 15; const int t = t_first + row;
        rg[j] = make_uint4(0u, 0u, 0u, 0u); if (it < nrows * 16 && t >= 0) rg[j] = *(const uint4*)(U1 + ((size_t)b * SEQ + t) * LD1 + col + ch * 8); }
}
DI void write_raw128(const Frame& F, int nrows, const uint4 (&rg)[3], bf16_t* raw) {
#pragma unroll
    for (int j = 0; j < 3; ++j) { const int it = F.tid + j * 512; const int row = it >> 4, ch = it & 15; if (it < nrows * 16) *(uint4*)(raw + row * 136 + ch * 8) = rg[j]; }
}
DI void conv8_lds(const bf16_t* raw, int s, int d0, const float* cw  , const float* cb  , float (&y)[8]) {
#pragma unroll
    for (int i = 0; i < 8; ++i) y[i] = cb[d0 + i];
#pragma unroll
    for (int j = 0; j < 4; ++j) { const uint4 v = *(const uint4*)(raw + (s + j) * 136 + d0); float f[8]; unpack8(v, f);
#pragma unroll
        for (int i = 0; i < 8; ++i) y[i] += cw[j * 128 + d0 + i] * f[i]; }
}
DI void mlstm_gates(const Frame& F, const bf16_t* U1, int b, int h, int c, float* li, float* bc) {
    if (F.wave == 0) {
        const size_t row = (size_t)b * SEQ + c * 64 + F.lane;
        const float* gts = (const float*)(F.ws + WS_GATES);
        const float ip = gts[row * 8 + h] + F.in[26][h];
        const float fp = gts[row * 8 + 4 + h] + F.in[27][h];
        const float lf = fminf(fp, 0.f) - log1pf(expf(-fabsf(fp)));
        float cs = lf;
        for (int o = 1; o < 64; o <<= 1) { const float n = __shfl_up(cs, o); if (F.lane >= o) cs += n; }
        li[F.lane] = ip; bc[F.lane] = cs;
    }
    __syncthreads();
}
constexpr int ML_LI = 0, ML_BC = 256, ML_WK = 512, ML_MT = 768, ML_DQ = 1024, ML_RS = 1280, ML_NIN = 1536, ML_Q = 2048, ML_K = ML_Q + 64 * 136 * 2, ML_VT = ML_K + 64 * 136 * 2,
              ML_CT = ML_VT + 128 * 72 * 2, ML_W = ML_CT + 128 * 136 * 2, ML_KT = ML_W + 64 * 72 * 2, ML_END = ML_KT + 128 * 72 * 2;
static_assert(ML_END + 5120 + LDS_WORK_OFF <= LDS_BYTES - 12288, "mlstm lds");

DI void p8a_mlstm_local(const Frame& F) {
    const bf16_t* U1 = (const bf16_t*)(F.ws + WS_U);
    bf16_t* ST = (bf16_t*)(F.ws + WS_BFB);
    float* zloc = (float*)(F.ws + WS_ZLOC); float* scal = (float*)(F.ws + WS_SCAL);
    unsigned char* L = F.lds;
    float* li = (float*)(L + ML_LI); float* bc = (float*)(L + ML_BC); float* wk = (float*)(L + ML_WK);
    bf16_t* kT = (bf16_t*)(L + ML_KT); bf16_t* vT = (bf16_t*)(L + ML_VT); float* cwl = (float*)(L + ML_END); bf16_t* raw = (bf16_t*)(L + ML_Q);
    const float* cw = F.in[24]; const float* cb = F.in[25];
    uint4 rk3[3], rv3[3];
    auto prefetch = [&](int unit) { const int c = unit & 63, h = (unit >> 6) & 3, b = unit >> 8;
        load_raw128(F, U1, b, c * 64 - 3, 67, C_DK + h * 128, rk3); load_raw128(F, U1, b, c * 64, 64, C_DV + h * 128, rv3); };
    if (F.bid < 2048) prefetch(F.bid);
    for (int unit = F.bid; unit < 2048; unit += F.G) {
        const int c = unit & 63, h = (unit >> 6) & 3, b = unit >> 8;
        mlstm_gates(F, U1, b, h, c, li, bc);
        if (F.wave == 0) {
            const float bl = bc[63]; const float dec = bl - bc[F.lane] + li[F.lane];
            const float dmx = wave_max(dec);
            wk[F.lane] = expf(dec - dmx);
            if (F.lane == 0) { scal[unit] = bl; scal[2048 + unit] = dmx; }
        }
        for (int e = F.tid; e < 640; e += 512) cwl[e] = e < 512 ? cw[(size_t)(e >> 7) * 1024 + 512 + h * 128 + (e & 127)] : cb[512 + h * 128 + (e - 512)];
        write_raw128(F, 67, rk3, raw);
        __syncthreads();
        for (int it = F.tid; it < 1024; it += 512) {
            const int s = it & 63, d0 = (it >> 6) * 8;
            float y[8]; conv8_lds(raw, s, d0, cwl, cwl + 512, y);
            const float w = wk[s] * 0.08838834764831845f;
#pragma unroll
            for (int i = 0; i < 8; ++i) kT[(d0 + i) * 72 + s] = f2bf(siluf_(y[i]) * w);
        }
        __syncthreads();
        write_raw128(F, 64, rv3, raw);
        if (unit + F.G < 2048) prefetch(unit + F.G);
        __syncthreads();
        for (int it = F.tid; it < 1024; it += 512) {
            const int s = it & 63, d0 = (it >> 6) * 8;
            const uint4 vv = *(const uint4*)(raw + s * 136 + d0); const unsigned wv[4] = {vv.x, vv.y, vv.z, vv.w};
#pragma unroll
            for (int i = 0; i < 8; ++i) vT[(d0 + i) * 72 + s] = (bf16_t)((i & 1) ? (wv[i >> 1] >> 16) : (wv[i >> 1] & 0xFFFFu));
        }
        __syncthreads();
        for (int tix = F.wave * 8; tix < F.wave * 8 + 8; ++tix) {
            const int et = tix >> 3, dt = tix & 7;
            const f32x4 a = mma16(vT + et * 16 * 72, 72, kT + dt * 16 * 72, 72, 64, F.lane);
            const int fr = F.lane & 15, fq = F.lane >> 4;
#pragma unroll
            for (int r = 0; r < 4; ++r) ST[(size_t)unit * 16384 + (size_t)(et * 16 + 4 * fq + r) * 128 + dt * 16 + fr] = f2bf(a[r]);
        }
        { const int d = F.tid >> 2, part = F.tid & 3; float z = 0.f;
#pragma unroll
          for (int s = 0; s < 16; ++s) z += bf2f(kT[d * 72 + part * 16 + s]);
          z += __shfl_xor(z, 1); z += __shfl_xor(z, 2);
          if (part == 0) zloc[(size_t)unit * 128 + d] = z; }
        __syncthreads();
    }
}

DI void p8a_lru_local(const Frame& F) {
    const bf16_t* U1 = (const bf16_t*)(F.ws + WS_U);
    bf16_t* LA = (bf16_t*)(F.ws + WS_LRUA); bf16_t* LH = (bf16_t*)(F.ws + WS_LRUH);
    float* Aend = (float*)(F.ws + WS_AEND); float* Hend = (float*)(F.ws + WS_HEND);
    const bf16_t* WAT = (const bf16_t*)(F.ws + WS_WAT); const bf16_t* WXT = (const bf16_t*)(F.ws + WS_WXT);
    bf16_t* xcb = (bf16_t*)F.lds;
    float* cwL = (float*)(F.lds + 16640);
    bf16_t* rawl = (bf16_t*)(F.lds + 16640 + 10240);
    const int g = F.wave, lane = F.lane, fr = lane & 15, fq = lane >> 4;
    __syncthreads();
    for (int e = F.tid; e < 2048; e += 512) cwL[e] = F.in[17][e];
    cwL[2048 + F.tid] = F.in[18][F.tid];
    bf16x8 wa[4][2], wx[4][2]; float ba[4], bx[4], sp[4];
#pragma unroll
    for (int ct = 0; ct < 4; ++ct) { const int ch = g * 64 + ct * 16 + fr;
#pragma unroll
        for (int ks = 0; ks < 2; ++ks) { wa[ct][ks] = *(const bf16x8*)(WAT + (size_t)ch * 64 + 32 * ks + 8 * fq); wx[ct][ks] = *(const bf16x8*)(WXT + (size_t)ch * 64 + 32 * ks + 8 * fq); }
        ba[ct] = F.in[20][ch]; bx[ct] = F.in[22][ch]; sp[ct] = log1pf(expf(-F.in[23][ch])); }
    __syncthreads();
    for (int unit = F.bid; unit < 512; unit += F.G) {
        const int b = unit >> 6, c = unit & 63, t0 = c * 64;
        float Ac[4] = {1.f, 1.f, 1.f, 1.f}, hl[4] = {0.f, 0.f, 0.f, 0.f};
        uint4 rr[3];
        auto ldraw = [&](int sub) {
#pragma unroll
            for (int j = 0; j < 3; ++j) { const int it = F.tid + j * 512; const int row = it >> 6, c8 = (it & 63) * 8; const int t = t0 + sub * 16 - 3 + row;
                rr[j] = make_uint4(0u, 0u, 0u, 0u); if (it < 19 * 64 && t >= 0) rr[j] = *(const uint4*)(U1 + ((size_t)b * SEQ + t) * LD1 + C_CX + c8); } };
        ldraw(0);
#pragma unroll 1
        for (int sub = 0; sub < 4; ++sub) {
#pragma unroll
            for (int j = 0; j < 3; ++j) { const int it = F.tid + j * 512; if (it < 19 * 64) *(uint4*)(rawl + (it >> 6) * 520 + (it & 63) * 8) = rr[j]; }
            __syncthreads();
            if (sub < 3) ldraw(sub + 1);
            for (int it = F.tid; it < 1024; it += 512) {
                const int tk = it >> 6, c8 = (it & 63) * 8;
                float y[8];
#pragma unroll
                for (int i = 0; i < 8; ++i) y[i] = cwL[2048 + c8 + i];
#pragma unroll
                for (int j = 0; j < 4; ++j) { const uint4 v = *(const uint4*)(rawl + (tk + j) * 520 + c8); float f[8]; unpack8(v, f);
#pragma unroll
                    for (int i = 0; i < 8; ++i) y[i] += cwL[j * 512 + c8 + i] * f[i]; }
                uint4 o; o.x = pack2(y[0], y[1]); o.y = pack2(y[2], y[3]); o.z = pack2(y[4], y[5]); o.w = pack2(y[6], y[7]);
                *(uint4*)(xcb + tk * 520 + c8) = o;
            }
            __syncthreads();
            bf16x8 af[2];
#pragma unroll
            for (int ks = 0; ks < 2; ++ks) af[ks] = *(const bf16x8*)(xcb + fr * 520 + g * 64 + 32 * ks + 8 * fq);
#pragma unroll
            for (int ct = 0; ct < 4; ++ct) {
                const int ch = g * 64 + ct * 16 + fr;
                f32x4 accA = {0.f, 0.f, 0.f, 0.f}, accX = {0.f, 0.f, 0.f, 0.f};
#pragma unroll
                for (int ks = 0; ks < 2; ++ks) { accA = __builtin_amdgcn_mfma_f32_16x16x32_bf16(af[ks], wa[ct][ks], accA, 0, 0, 0); accX = __builtin_amdgcn_mfma_f32_16x16x32_bf16(af[ks], wx[ct][ks], accX, 0, 0, 0); }
                float Ap[4], Hp[4]; float A4 = 1.f, H4 = 0.f;
#pragma unroll
                for (int rg = 0; rg < 4; ++rg) {
                    const float xc = bf2f(xcb[(4 * fq + rg) * 520 + ch]);
                    const float r = sigmoidf_(accA[rg] + ba[ct]), ig = sigmoidf_(accX[rg] + bx[ct]);
                    const float a = fexp_(-8.0f * r * sp[ct]);
                    const float bt = sqrtf(fmaxf(1.0f - a * a, 0.f)) * (ig * xc);
                    H4 = a * H4 + bt; A4 *= a; Ap[rg] = A4; Hp[rg] = H4;
                }
                float iA = A4, iH = H4;
                { const float pA = __shfl_up(iA, 16), pH = __shfl_up(iH, 16); if (fq >= 1) { iH = iA * pH + iH; iA = pA * iA; } }
                { const float pA = __shfl_up(iA, 32), pH = __shfl_up(iH, 32); if (fq >= 2) { iH = iA * pH + iH; iA = pA * iA; } }
                float eA = __shfl_up(iA, 16), eH = __shfl_up(iH, 16); if (fq == 0) { eA = 1.f; eH = 0.f; }
                const float tA = __shfl(iA, 48 + fr), tH = __shfl(iH, 48 + fr);
                const float cA = Ac[ct] * eA, cH = eA * hl[ct] + eH;
#pragma unroll
                for (int rg = 0; rg < 4; ++rg) { const size_t row = (size_t)b * SEQ + t0 + sub * 16 + 4 * fq + rg;
                    LA[row * 512 + ch] = f2bf(cA * Ap[rg]); LH[row * 512 + ch] = f2bf(Ap[rg] * cH + Hp[rg]); }
                hl[ct] = tA * hl[ct] + tH; Ac[ct] = Ac[ct] * tA;
            }
            __syncthreads();
        }
        if (fq == 0) {
#pragma unroll
            for (int ct = 0; ct < 4; ++ct) { const int ch = g * 64 + ct * 16 + fr; Aend[((size_t)b * 64 + c) * 512 + ch] = Ac[ct]; Hend[((size_t)b * 64 + c) * 512 + ch] = hl[ct]; } }
    }
    __syncthreads();
}

DI void p8b_scans(const Frame& F) {
    const int gt = F.bid * 512 + F.tid, nthr = F.G * 512;
    if (gt < 4096) {
        const int b = gt >> 9, ch = gt & 511;
        const float* Aend = (const float*)(F.ws + WS_AEND); const float* Hend = (const float*)(F.ws + WS_HEND); float* Hin = (float*)(F.ws + WS_HIN);
        float H = 0.f;
#pragma unroll 1
        for (int c0 = 0; c0 < 64; c0 += 8) {
            float av[8], hv[8];
#pragma unroll
            for (int j = 0; j < 8; ++j) { const size_t o = ((size_t)b * 64 + c0 + j) * 512 + ch; av[j] = Aend[o]; hv[j] = Hend[o]; }
#pragma unroll
            for (int j = 0; j < 8; ++j) { const size_t o = ((size_t)b * 64 + c0 + j) * 512 + ch; Hin[o] = H; H = av[j] * H + hv[j]; }
        }
    }
    const float* scal = (const float*)(F.ws + WS_SCAL); float* minp = (float*)(F.ws + WS_SCAL) + 4096;
    if (gt >= nthr - 4096) {
        const int q = gt - (nthr - 4096); const int bh = q >> 7, d = q & 127;
        const float* zloc = (const float*)(F.ws + WS_ZLOC); float* nin = (float*)(F.ws + WS_NIN);
        float m = 0.f, n = 0.f;
#pragma unroll 1
        for (int c0 = 0; c0 < 64; c0 += 8) {
            float zv[8];
#pragma unroll
            for (int j = 0; j < 8; ++j) zv[j] = zloc[(size_t)(bh * 64 + c0 + j) * 128 + d];
#pragma unroll
            for (int j = 0; j < 8; ++j) { const int unit = bh * 64 + c0 + j; const float bl = scal[unit], dm = scal[2048 + unit];
                const float mn = fmaxf(bl + m, dm); const float keep = expf(bl + m - mn), add = expf(dm - mn);
                nin[(size_t)unit * 128 + d] = n; if (d == 0) minp[unit] = m;
                n = keep * n + add * zv[j]; m = mn; }
        }
    }
    bf16_t* ST = (bf16_t*)(F.ws + WS_BFB);
    float* kp = (float*)F.lds; float* ad = kp + 64;
    if (gt < 65536) {
        const int bh = gt >> 11, ed = (gt & 2047) * 8;
        if (F.wave == 0) { const int c = F.lane; const int unit = bh * 64 + c; const float bl = scal[unit], dm = scal[2048 + unit];
            float Bi = bl;
            for (int o = 1; o < 64; o <<= 1) { const float n = __shfl_up(Bi, o); if (c >= o) Bi += n; }
            float pm = dm - Bi;
            for (int o = 1; o < 64; o <<= 1) { const float n = __shfl_up(pm, o); if (c >= o) pm = fmaxf(pm, n); }
            const float mnext = Bi + fmaxf(0.f, pm);
            float mcur = __shfl_up(mnext, 1); if (c == 0) mcur = 0.f;
            kp[c] = expf(bl + mcur - mnext); ad[c] = expf(dm - mnext); }
        __syncthreads();
        float C[8] = {0.f, 0.f, 0.f, 0.f, 0.f, 0.f, 0.f, 0.f};
#pragma unroll 1
        for (int c0 = 0; c0 < 64; c0 += 8) {
            uint4 sv[8];
#pragma unroll
            for (int j = 0; j < 8; ++j) sv[j] = *(const uint4*)(ST + (size_t)(bh * 64 + c0 + j) * 16384 + ed);
#pragma unroll
            for (int j = 0; j < 8; ++j) { float sf[8]; unpack8(sv[j], sf);
                uint4 o; o.x = pack2(C[0], C[1]); o.y = pack2(C[2], C[3]); o.z = pack2(C[4], C[5]); o.w = pack2(C[6], C[7]);
                *(uint4*)(ST + (size_t)(bh * 64 + c0 + j) * 16384 + ed) = o;
                const float kk = kp[c0 + j], aa = ad[c0 + j];
#pragma unroll
                for (int i = 0; i < 8; ++i) C[i] = kk * C[i] + aa * sf[i]; }
        }
    }
}

DI void p8c_mlstm_out(const Frame& F) {
    const bf16_t* U1 = (const bf16_t*)(F.ws + WS_U);
    const bf16_t* ST = (const bf16_t*)(F.ws + WS_BFB);
    bf16_t* Y = (bf16_t*)(F.ws + WS_BFA);
    const float* nin_g = (const float*)(F.ws + WS_NIN); const float* minp = (const float*)(F.ws + WS_SCAL) + 4096;
    unsigned char* L = F.lds;
    float* li = (float*)(L + ML_LI); float* bc = (float*)(L + ML_BC); float* wkk = (float*)(L + ML_WK); float* mt = (float*)(L + ML_MT); float* dq = (float*)(L + ML_DQ); float* rs = (float*)(L + ML_RS); float* nin = (float*)(L + ML_NIN);
    bf16_t* q = (bf16_t*)(L + ML_Q); bf16_t* k = (bf16_t*)(L + ML_K); bf16_t* vT = (bf16_t*)(L + ML_VT); bf16_t* CT = (bf16_t*)(L + ML_CT); bf16_t* W = (bf16_t*)(L + ML_W); float* cwl = (float*)(L + ML_END); bf16_t* raw = (bf16_t*)(L + ML_KT); float* HT = (float*)(L + ML_Q);
    const float* cw = F.in[24]; const float* cb = F.in[25];
    uint4 rq3[3], rk3[3], rv3[3]; u32x4 rc4[4];
    auto prefetch = [&](int unit) { const int c = unit & 63, h = (unit >> 6) & 3, b = unit >> 8;
        load_raw128(F, U1, b, c * 64 - 3, 67, C_DQ + h * 128, rq3);
        load_raw128(F, U1, b, c * 64 - 3, 67, C_DK + h * 128, rk3);
        load_raw128(F, U1, b, c * 64, 64, C_DV + h * 128, rv3);
#pragma unroll
        for (int j = 0; j < 4; ++j) { const int it = F.tid + j * 512; rc4[j] = *(const u32x4*)(ST + (size_t)unit * 16384 + (it >> 4) * 128 + (it & 15) * 8); } };
    if (F.bid < 2048) prefetch(F.bid);
    for (int unit = F.bid; unit < 2048; unit += F.G) {
        const int c = unit & 63, h = (unit >> 6) & 3, b = unit >> 8;
        const float m_in = minp[unit];
        for (int e = F.tid; e < 1280; e += 512) { float v;
            if (e < 512) v = cw[(size_t)(e >> 7) * 1024 + h * 128 + (e & 127)]; else if (e < 1024) v = cw[(size_t)((e - 512) >> 7) * 1024 + 512 + h * 128 + (e & 127)];
            else if (e < 1152) v = cb[h * 128 + (e - 1024)]; else v = cb[512 + h * 128 + (e - 1152)];
            cwl[e] = v; }
        mlstm_gates(F, U1, b, h, c, li, bc);
        write_raw128(F, 67, rq3, raw);
        __syncthreads();
        for (int it = F.tid; it < 1024; it += 512) { const int s = it & 63, d0 = (it >> 6) * 8;
            float y[8]; conv8_lds(raw, s, d0, cwl, cwl + 1024, y);
            uint4 o; o.x = pack2(siluf_(y[0]), siluf_(y[1])); o.y = pack2(siluf_(y[2]), siluf_(y[3])); o.z = pack2(siluf_(y[4]), siluf_(y[5])); o.w = pack2(siluf_(y[6]), siluf_(y[7]));
            *(uint4*)(q + s * 136 + d0) = o; }
        __syncthreads();
        write_raw128(F, 67, rk3, raw);
        __syncthreads();
        for (int it = F.tid; it < 1024; it += 512) { const int s = it & 63, d0 = (it >> 6) * 8;
            float y[8]; conv8_lds(raw, s, d0, cwl + 512, cwl + 1152, y);
            const float sc = 0.08838834764831845f; uint4 o;
            o.x = pack2(siluf_(y[0]) * sc, siluf_(y[1]) * sc); o.y = pack2(siluf_(y[2]) * sc, siluf_(y[3]) * sc); o.z = pack2(siluf_(y[4]) * sc, siluf_(y[5]) * sc); o.w = pack2(siluf_(y[6]) * sc, siluf_(y[7]) * sc);
            *(uint4*)(k + s * 136 + d0) = o; }
        __syncthreads();
        write_raw128(F, 64, rv3, raw);
        __syncthreads();
        for (int it = F.tid; it < 1024; it += 512) { const int s = it & 63, d0 = (it >> 6) * 8;
            const uint4 vv = *(const uint4*)(raw + s * 136 + d0); const unsigned wv[4] = {vv.x, vv.y, vv.z, vv.w};
#pragma unroll
            for (int i = 0; i < 8; ++i) vT[(d0 + i) * 72 + s] = (bf16_t)((i & 1) ? (wv[i >> 1] >> 16) : (wv[i >> 1] & 0xFFFFu)); }
#pragma unroll
        for (int j = 0; j < 4; ++j) { const int it = F.tid + j * 512; *(u32x4*)(CT + (it >> 4) * 136 + (it & 15) * 8) = rc4[j]; }
        if (unit + F.G < 2048) prefetch(unit + F.G);
        if (F.tid < 128) nin[F.tid] = nin_g[(size_t)unit * 128 + F.tid];
        if (F.tid >= 128 && F.tid < 192) { const int l = F.tid - 128;
            float pm = li[l] - bc[l];
            for (int o = 1; o < 64; o <<= 1) { const float n = __shfl_up(pm, o); if (l >= o) pm = fmaxf(pm, n); }
            mt[l] = bc[l] + fmaxf(m_in, pm); }
        __syncthreads();
        { const int l = F.tid >> 3, part = F.tid & 7; float a = 0.f;
#pragma unroll
          for (int d = 0; d < 16; ++d) a += bf2f(q[l * 136 + part * 16 + d]) * nin[part * 16 + d];
          a += __shfl_xor(a, 1); a += __shfl_xor(a, 2); a += __shfl_xor(a, 4);
          if (part == 0) dq[l] = a; }
        for (int tix = F.wave * 2; tix < F.wave * 2 + 2; ++tix) {
            const int lt = tix >> 2, st = tix & 3;
            const f32x4 a = mma16(q + lt * 16 * 136, 136, k + st * 16 * 136, 136, 128, F.lane);
            const int fr = F.lane & 15, fq = F.lane >> 4; const int s = st * 16 + fr;
#pragma unroll
            for (int r = 0; r < 4; ++r) { const int l = lt * 16 + 4 * fq + r;
                const float w = s <= l ? a[r] * expf(bc[l] - bc[s] + li[s] - mt[l]) : 0.f;
                W[l * 72 + s] = f2bf(w); }
        }
        __syncthreads();
        { const int l = F.tid >> 3, part = F.tid & 7; float a = 0.f;
#pragma unroll
          for (int s = 0; s < 8; ++s) a += bf2f(W[l * 72 + part * 8 + s]);
          a += __shfl_xor(a, 1); a += __shfl_xor(a, 2); a += __shfl_xor(a, 4);
          if (part == 0) rs[l] = a; }
        if (F.tid >= 64 && F.tid < 128) { const int l = F.tid - 64; li[l] = expf(bc[l] + m_in - mt[l]); }
        if (F.tid >= 128 && F.tid < 192) { const int l = F.tid - 128; wkk[l] = expf(-mt[l]); }
        __syncthreads();
        uint4 ro2[2], rz2[2];
#pragma unroll
        for (int j = 0; j < 2; ++j) { const int it = F.tid + j * 512; const size_t row = (size_t)b * SEQ + c * 64 + (it >> 4);
            ro2[j] = *(const uint4*)(U1 + row * LD1 + C_DO + h * 128 + (it & 15) * 8); rz2[j] = *(const uint4*)(U1 + row * LD1 + C_DZ + h * 128 + (it & 15) * 8); }
        f32x4 hres[4];
#pragma unroll
        for (int ti = 0; ti < 4; ++ti) { const int tix = F.wave * 4 + ti;
            const int lt = tix >> 3, et = tix & 7;
            const f32x4 qc = mma16(q + lt * 16 * 136, 136, CT + et * 16 * 136, 136, 128, F.lane);
            const f32x4 wv = mma16(W + lt * 16 * 72, 72, vT + et * 16 * 72, 72, 64, F.lane);
            const int fq = F.lane >> 4;
#pragma unroll
            for (int r = 0; r < 4; ++r) { const int l = lt * 16 + 4 * fq + r;
                const float prev = li[l];
                const float num = prev * qc[r] + wv[r];
                const float den = prev * dq[l] + rs[l];
                hres[ti][r] = num * __builtin_amdgcn_rcpf(fmaxf(fabsf(den), wkk[l])); }
        }
        __syncthreads();
#pragma unroll
        for (int ti = 0; ti < 4; ++ti) { const int tix = F.wave * 4 + ti; const int lt = tix >> 3, et = tix & 7; const int fr = F.lane & 15, fq = F.lane >> 4;
#pragma unroll
            for (int r = 0; r < 4; ++r) HT[(lt * 16 + 4 * fq + r) * 132 + et * 16 + fr] = hres[ti][r]; }
        __syncthreads();
#pragma unroll
        for (int j = 0; j < 2; ++j) { const int it = F.tid + j * 512; const int l = it >> 4, e0 = (it & 15) * 8;
            const size_t row = (size_t)b * SEQ + c * 64 + l;
            float of[8], zf[8]; unpack8(ro2[j], of); unpack8(rz2[j], zf);
            const f32x4 h0 = *(const f32x4*)(HT + l * 132 + e0), h1 = *(const f32x4*)(HT + l * 132 + e0 + 4);
            float y[8];
#pragma unroll
            for (int i = 0; i < 4; ++i) { y[i] = sigmoidf_(of[i]) * h0[i] * siluf_(zf[i]); y[4 + i] = sigmoidf_(of[4 + i]) * h1[i] * siluf_(zf[4 + i]); }
            uint4 o; o.x = pack2(y[0], y[1]); o.y = pack2(y[2], y[3]); o.z = pack2(y[4], y[5]); o.w = pack2(y[6], y[7]);
            *(uint4*)(Y + row * 1024 + 512 + h * 128 + e0) = o; }
        __syncthreads();
    }
}
DI void p8c_lru_out(const Frame& F) {
    const bf16_t* U1 = (const bf16_t*)(F.ws + WS_U);
    const bf16_t* LA = (const bf16_t*)(F.ws + WS_LRUA); const bf16_t* LH = (const bf16_t*)(F.ws + WS_LRUH);
    const float* Hin = (const float*)(F.ws + WS_HIN);
    bf16_t* Y = (bf16_t*)(F.ws + WS_BFA);
    const size_t n8 = (size_t)MT * 64;
    for (size_t it = (size_t)F.bid * 512 + F.tid; it < n8; it += (size_t)F.G * 512) {
        const size_t row = it >> 6; const int c0 = (int)(it & 63) * 8; const int b = (int)(row >> 12), t = (int)(row & 4095), c = t >> 6;
        const uint4 av = *(const uint4*)(LA + row * 512 + c0), hv = *(const uint4*)(LH + row * 512 + c0), zv = *(const uint4*)(U1 + row * LD1 + C_CZ + c0);
        float af[8], hf[8], zf[8]; unpack8(av, af); unpack8(hv, hf); unpack8(zv, zf);
        const float* hi = Hin + ((size_t)b * 64 + c) * 512 + c0; float y[8];
#pragma unroll
        for (int i = 0; i < 8; ++i) y[i] = (af[i] * hi[i] + hf[i]) * siluf_(zf[i]);
        uint4 o; o.x = pack2(y[0], y[1]); o.y = pack2(y[2], y[3]); o.z = pack2(y[4], y[5]); o.w = pack2(y[6], y[7]);
        *(uint4*)(Y + row * 1024 + c0) = o;
    }
}

constexpr int N_PHASES = 16;
__global__ void __launch_bounds__(512, 2) mk_fwd(Args args) {
    extern __shared__ __attribute__((aligned(16))) unsigned char smem[];
    Frame F;
    F.tid = threadIdx.x; F.lane = F.tid & 63; F.wave = __builtin_amdgcn_readfirstlane(F.tid >> 6);
    F.G = gridDim.x; F.bid = blockIdx.x; F.gw = F.bid * 8 + F.wave; F.nw = F.G * 8;
    F.lds = smem + LDS_WORK_OFF; F.ws = args.ws; F.out = args.out; F.ctl = (unsigned*)args.ws;
#pragma unroll
    for (int i = 0; i < 28; ++i) F.in[i] = args.in[i];
    LAS unsigned char* lsm = (LAS unsigned char*)smem;
    LAS unsigned char* lut = lsm + (LDS_BYTES - 12288);
    LAS float* tbl = (LAS float*)(lsm + (LDS_BYTES - 12288 + 256));
    LAS float* biasL = (LAS float*)(lsm + (LDS_BYTES - 8192));
    if (F.tid < 4) ((LAS unsigned*)lsm)[F.tid] = 0u;
    if (F.tid < 128) { const int n = F.tid; int bk;
        if (n < 16) bk = n; else { bk = 16; const int thr[15] = {19, 21, 24, 27, 31, 35, 40, 46, 52, 59, 67, 77, 87, 99, 113};
#pragma unroll
            for (int j = 0; j < 15; ++j) bk += (n >= thr[j]) ? 1 : 0; }
        lut[n] = (unsigned char)bk; }
    { const int hd = F.tid >> 5, bk = F.tid & 31; tbl[hd * 32 + bk] = args.in[6][bk * 16 + hd]; }
    F.lut = lut; F.tbl = tbl; F.biasL = biasL; F.ldsl = lsm + LDS_WORK_OFF;
    __syncthreads();
    for (int e = F.tid; e < 16 * 128; e += 512) { const int hd = e >> 7, n = e & 127; const int bk = n < 16 ? n : (n >= 113 ? 31 : (int)lut[n]); biasL[e] = tbl[hd * 32 + bk] * 1.4426950408889634f; }
    __syncthreads();
    const int lo = args.ph_lo, hi = args.ph_hi;
    XcdBarrier bar; bar.bar = F.ctl; bar.x = 0; bar.st = nullptr;
#if !MK_PER_PHASE
    bar = xcd_barrier_post(F.ctl, (volatile LAS unsigned*)lsm);
#endif
#ifndef PH_MASK
#define PH_MASK 0xFFFF
#endif
#define IN(k) (phase_refresh(F), ((PH_MASK >> (k)) & 1) && lo <= (k) && (k) < hi)
#ifndef DLY_LO
#define DLY_LO -1
#define DLY_HI -1
#endif
#ifndef DLY_MULT
#define DLY_MULT 4
#endif
    unsigned long long dly_t0 = 0ull;
#define DLY_START(k) do { if ((k) == DLY_LO && F.bid == 0 && F.tid == 0) dly_t0 = __builtin_amdgcn_s_memrealtime(); } while (0)
#define DLY_END(k) do { if ((k) == DLY_HI && F.bid == 0) { if (F.tid == 0) { const unsigned long long t1 = __builtin_amdgcn_s_memrealtime(); const unsigned long long until = t1 + DLY_MULT * (t1 - dly_t0); \
        while (__builtin_amdgcn_s_memrealtime() < until) __builtin_amdgcn_s_sleep(16); } __syncthreads(); } } while (0)
#if MK_PER_PHASE
#define SEAM(k) do { } while (0)
#else
#define SEAM(k) do { if (IN(k) && IN((k) + 1)) xcd_barrier(bar); DLY_END(k); DLY_START((k) + 1); } while (0)
#endif
    LAS unsigned char* glds = lsm + LDS_WORK_OFF;
    unsigned char* ws = args.ws;
    bf16_t* BFA = (bf16_t*)(ws + WS_BFA); bf16_t* BFB = (bf16_t*)(ws + WS_BFB); bf16_t* U = (bf16_t*)(ws + WS_U); bf16_t* Ef = (bf16_t*)(ws + WS_U); bf16_t* X1b = (bf16_t*)F.out;

    DLY_START(0);
    if (IN(0)) { p0_prologue(F); }
    SEAM(0);
    if (IN(1)) {
        pg8::Gemm g{BFA, (const bf16_t*)(ws + WS_WIN0), MT, LD0, 1024}; pg8::StaticOrder S; S.init(MT, LD0, F.G, F.bid);
        pg8::EpiBf16<0> E{U, LD0};
        pg8::gemm_phase(glds, g, S, E);
        pg8::Gemm g2{(const bf16_t*)(ws + WS_WVT), BFA, 512, MT, 1024}; pg8::StaticOrder S2; S2.init(512, MT, F.G, F.bid);
        pg8::EpiBf16<0> E2{(bf16_t*)(ws + WS_VT), MT};
        pg8::gemm_phase(glds, g2, S2, E2);
    }
    SEAM(1);
    if (IN(2)) { p2a_build_blocks(F); }
    SEAM(2);
    if (IN(3)) {
        if (F.bid < 32) {
            const int which = F.bid >> 4;
            pg8::Gemm g{(const bf16_t*)(ws + (which ? WS_AV : WS_AK)), (const bf16_t*)(ws + (which ? WS_WC1V : WS_WC1K)), 4096, 256, 2048}; pg8::StaticOrder S; S.init(4096, 256, F.G, F.bid & 15);
            pg8::EpiBf16<1> E{(bf16_t*)(ws + (which ? WS_HV : WS_HK)), 256}; pg8::gemm_phase(glds, g, S, E);
            asm volatile("s_waitcnt vmcnt(0)" ::: "memory"); __syncthreads();
            pg8::Unit u; S.next(0, u);
            p2c_compress_rows(F, which, u.pm * 256);
            asm volatile("s_waitcnt vmcnt(0)" ::: "memory"); __syncthreads();
            if (F.tid == 0) { __builtin_amdgcn_fence(__ATOMIC_RELEASE, "agent"); asm volatile("s_waitcnt vmcnt(0)" ::: "memory");
                (void)__hip_atomic_fetch_add(F.ctl + CW_CMPDONE, 1u, __ATOMIC_RELAXED, __HIP_MEMORY_SCOPE_AGENT); }
        }
        att_dsa(F);
    }
    if (IN(5)) {
        if (F.tid == 0) { unsigned sp = 0;
            while (__hip_atomic_load(F.ctl + CW_CMPDONE, __ATOMIC_RELAXED, __HIP_MEMORY_SCOPE_AGENT) < 32u) { __builtin_amdgcn_s_sleep(2);
                if (++sp > (1u << 22)) { atomicAdd(F.ctl + XB_TMO, 1u); break; } }
            __builtin_amdgcn_fence(__ATOMIC_ACQUIRE, "agent"); asm volatile("s_waitcnt vmcnt(0)" ::: "memory"); }
        __syncthreads();
        att_nsa(F); }
    if (IN(3) && IN(6)) xcd_barrier(bar);
    if (IN(6)) {
        pg8::Gemm g{BFB, (const bf16_t*)(ws + WS_WOUT0), MT, 1024, 1024}; pg8::StaticOrder S; S.init(MT, 1024, F.G, F.bid);
        pg8::EpiResid<0> E{F.in[0], nullptr, BFA};
        pg8::gemm_phase(glds, g, S, E);
    }
    SEAM(6);
    if (IN(7)) {
        { pg8::Gemm g{(const bf16_t*)(ws + WS_PBF), (const bf16_t*)(ws + WS_WP0), MT, 1024, 256}; pg8::StaticOrder S; S.init(MT, 1024, F.G, F.bid);
          pg8::EpiBf16<0> E{Ef, 1024}; pg8::gemm_phase(glds, g, S, E); }
        asm volatile("s_waitcnt vmcnt(0)" ::: "memory"); __syncthreads();
        { pg8::Gemm g{BFA, (const bf16_t*)(ws + WS_WG0), MT, 1024, 1024}; pg8::StaticOrder S; S.init(MT, 1024, F.G, F.bid);
          pg8::EpiGate<1> E{nullptr, X1b, BFA, Ef}; pg8::gemm_phase(glds, g, S, E); }
    }
    SEAM(7);
    if (IN(8)) { rmsnorm_gates(F, X1b, F.in[2] + 1024, BFB); }
    SEAM(8);
    if (IN(9)) {
        pg8::Gemm g{BFB, (const bf16_t*)(ws + WS_WIN1), MT, LD1, 1024}; pg8::StaticOrder S; S.init(MT, LD1, F.G, F.bid);
        pg8::EpiBf16<0> E{U, LD1};
        pg8::gemm_phase(glds, g, S, E);
    }
    SEAM(9);
    if (IN(10)) { p8a_mlstm_local(F); p8a_lru_local(F); }
    SEAM(10);
    if (IN(11)) { p8b_scans(F); }
    SEAM(11);
    if (IN(12)) { p8c_mlstm_out(F); p8c_lru_out(F); }
    SEAM(12);

    if (IN(13)) {
        pg8::Gemm g{BFA, (const bf16_t*)(ws + WS_WOUT1), MT, 1024, 1024}; pg8::StaticOrder S; S.init(MT, 1024, F.G, F.bid);
        pg8::EpiResid<1> E{nullptr, X1b, BFB};
        pg8::gemm_phase(glds, g, S, E);
    }
    SEAM(13);
    if (IN(14)) {
        { pg8::Gemm g{(const bf16_t*)(ws + WS_PBF) + (size_t)MT * 256, (const bf16_t*)(ws + WS_WP1), MT, 1024, 256}; pg8::StaticOrder S; S.init(MT, 1024, F.G, F.bid);
          pg8::EpiBf16<0> E{Ef, 1024}; pg8::gemm_phase(glds, g, S, E); }
        asm volatile("s_waitcnt vmcnt(0)" ::: "memory"); __syncthreads();
        { pg8::Gemm g{BFB, (const bf16_t*)(ws + WS_WG1), MT, 1024, 1024}; pg8::StaticOrder S; S.init(MT, 1024, F.G, F.bid);
          pg8::EpiGateNorm E{F.out, BFB, Ef, F.in[3], (float*)(ws + WS_SS), F.ctl + CW_NORMCNT, F.ctl + XB_TMO}; pg8::gemm_phase(glds, g, S, E); }
    }
#undef IN
#undef SEAM
}

extern "C" void kernel_launch(void* const* d_in, const int* in_sizes, int n_in, void* d_out, int out_size, void* d_ws, size_t ws_size, hipStream_t stream) {
    static int grid = 0;
    if (grid == 0) {
        if (n_in != 28 || out_size != MT * DM || ws_size < WS_END) { fprintf(stderr, "kernel_launch: unexpected shapes (n_in %d, out %d, ws %zu < %zu)\n", n_in, out_size, ws_size, (size_t)WS_END); grid = -1; return; }
        int dev = 0, cus = 0, per_cu = 0;
        if (hipGetDevice(&dev) != hipSuccess || hipDeviceGetAttribute(&cus, hipDeviceAttributeMultiprocessorCount, dev) != hipSuccess) { grid = -1; return; }
        if (hipFuncSetAttribute((const void*)mk_fwd, hipFuncAttributeMaxDynamicSharedMemorySize, LDS_BYTES) != hipSuccess) { fprintf(stderr, "kernel_launch: hipFuncSetAttribute failed\n"); grid = -1; return; }
        if (hipOccupancyMaxActiveBlocksPerMultiprocessor(&per_cu, (const void*)mk_fwd, 512, LDS_BYTES) != hipSuccess || per_cu < 1)
            fprintf(stderr, "kernel_launch: occupancy query reports %d workgroups per CU\n", per_cu);
        (void)hipGetLastError();
        grid = cus > 256 ? 256 : cus;
    }
    if (grid < 0) return;
    if (hipMemsetAsync(d_ws, 0, CTL_BYTES, stream) != hipSuccess) return;
    Args a{};
    for (int i = 0; i < 28; ++i) a.in[i] = (const float*)d_in[i];
    a.out = (float*)d_out; a.ws = (unsigned char*)d_ws;
#if MK_PER_PHASE
    for (int p = 0; p < N_PHASES; ++p) { a.ph_lo = p; a.ph_hi = p + 1; hipLaunchKernelGGL(mk_fwd, dim3(grid), dim3(512), LDS_BYTES, stream, a); }
#else
    a.ph_lo = 0; a.ph_hi = N_PHASES;
    hipLaunchKernelGGL(mk_fwd, dim3(grid), dim3(512), LDS_BYTES, stream, a);
#endif
}
```

```cpp
#include <hip/hip_runtime.h>
#include <cstdio>
#include <cstdint>

#ifndef MK_PER_PHASE
#define MK_PER_PHASE 0
#endif

#define LAS __attribute__((address_space(3)))
typedef unsigned short bf16_t;
typedef short bf16x8 __attribute__((ext_vector_type(8)));
typedef float f32x4 __attribute__((ext_vector_type(4)));
#define DI __device__ __forceinline__

constexpr int NB = 8, SEQ = 4096, DM = 1024, MT = NB * SEQ;
constexpr int LD0 = 3072, LD1 = 3584;
constexpr int C_AQ = 0, C_KC = 512, C_VC = 640, C_KS = 768, C_KW = 896, C_AZ = 1024, C_BQ = 1536, C_BZ = 2048,
              C_BK = 2560, C_BKI = 2624, C_BQI = 2688, C_AG = 2944, C_BWI = 2968;
constexpr int C_VS = 0, C_VW = 0, C_BV = 0;
constexpr int C_CX = 0, C_CZ = 512, C_DQ = 1024, C_DK = 1536, C_DV = 2048, C_DO = 2560, C_DZ = 3072;
constexpr int NCMP = 255;
constexpr float NEG_INF = -__builtin_inff();

DI int map0(int n) {
    if (n < 896) return n;
    if (n < 1024) return 1024 + (n - 896);
    if (n < 1536) return 1304 + (n - 1024);
    if (n < 2048) return 1816 + (n - 1536);
    if (n < 2560) return 2780 + (n - 2048);
    if (n < 2624) return 2328 + (n - 2560);
    if (n < 2688) return 2712 + (n - 2624);
    if (n < 2944) return 2456 + (n - 2688);
    if (n < 2968) return 1280 + (n - 2944);
    if (n < 2972) return 2776 + (n - 2968);
    return -1;
}
DI int map1(int n) {
    if (n < 2560) return n;
    if (n < 3072) return 2568 + (n - 2560);
    if (n < 3584) return 3080 + (n - 3072);
    return -1;
}
DI int mapid(int n) { return n; }
DI int mapv(int f) { return f < 128 ? 896 + f : (f < 256 ? 1152 + (f - 128) : (f < 320 ? 2392 + (f - 256) : -1)); }

constexpr size_t CTL_BYTES = 16384;
constexpr size_t WS_WIN0  = CTL_BYTES;
constexpr size_t WS_WOUT0 = WS_WIN0  + (size_t)LD0 * 1024 * 2;
constexpr size_t WS_WG0   = WS_WOUT0 + (size_t)1024 * 1024 * 2;
constexpr size_t WS_WP0   = WS_WG0   + (size_t)1024 * 1024 * 2;
constexpr size_t WS_WIN1  = WS_WP0   + (size_t)1024 * 256 * 2;
constexpr size_t WS_WOUT1 = WS_WIN1  + (size_t)LD1 * 1024 * 2;
constexpr size_t WS_WG1   = WS_WOUT1 + (size_t)1024 * 1024 * 2;
constexpr size_t WS_WP1   = WS_WG1   + (size_t)1024 * 1024 * 2;
constexpr size_t WS_WC1K  = WS_WP1   + (size_t)1024 * 256 * 2;
constexpr size_t WS_WC1V  = WS_WC1K  + (size_t)256 * 2048 * 2;
constexpr size_t WS_WVT   = WS_WC1V  + (size_t)256 * 2048 * 2;
constexpr size_t WS_BFA   = WS_WVT   + (size_t)512 * 1024 * 2;
constexpr size_t WS_BFB   = WS_BFA   + (size_t)MT * 1024 * 2;
constexpr size_t WS_PBF   = WS_BFB   + (size_t)MT * 1024 * 2;
constexpr size_t WS_U     = WS_PBF   + (size_t)2 * MT * 256 * 2;
constexpr size_t WS_X     = WS_U     + (size_t)MT * LD1 * 2;
constexpr size_t WS_AK    = WS_X;
constexpr size_t WS_AV    = WS_AK    + (size_t)4096 * 2048 * 2;
constexpr size_t WS_HK    = WS_AV    + (size_t)4096 * 2048 * 2;
constexpr size_t WS_HV    = WS_HK    + (size_t)4096 * 256 * 2;
constexpr size_t WS_LRUA  = WS_X;
constexpr size_t WS_LRUH  = WS_LRUA  + (size_t)MT * 512 * 2;
constexpr size_t WS_S     = WS_X     + (size_t)64 * 1024 * 1024;
constexpr size_t WS_KCMP  = WS_S;
constexpr size_t WS_VCMP  = WS_KCMP  + (size_t)16 * 256 * 64 * 4;
constexpr size_t WS_AEND  = WS_VCMP  + (size_t)16 * 256 * 64 * 4;
constexpr size_t WS_HEND  = WS_AEND  + (size_t)8 * 64 * 512 * 4;
constexpr size_t WS_HIN   = WS_HEND  + (size_t)8 * 64 * 512 * 4;
constexpr size_t WS_ZLOC  = WS_HIN   + (size_t)8 * 64 * 512 * 4;
constexpr size_t WS_NIN   = WS_ZLOC  + (size_t)2048 * 128 * 4;
constexpr size_t WS_SCAL  = WS_NIN   + (size_t)2048 * 128 * 4;
constexpr size_t WS_VCT   = WS_SCAL  + (size_t)3 * 2048 * 4;
constexpr size_t WS_WAT   = WS_VCT   + (size_t)16 * 64 * 256 * 2;
constexpr size_t WS_WXT   = WS_WAT   + (size_t)8 * 64 * 64 * 2;
constexpr size_t WS_GATES = WS_WXT   + (size_t)8 * 64 * 64 * 2;
constexpr size_t WS_SS    = WS_GATES + (size_t)MT * 8 * 4;
constexpr size_t WS_IMGN  = WS_SS    + (size_t)MT * 4;
constexpr size_t WS_IMGD  = WS_IMGN  + (size_t)6 * 65536;
constexpr size_t WS_IMGW  = WS_IMGD  + (size_t)8 * 65536;
constexpr size_t WS_IMGZ  = WS_IMGW  + (size_t)65536;
constexpr size_t WS_END   = WS_IMGZ  + (size_t)8192;
constexpr size_t WS_VT    = WS_U     + (size_t)MT * LD0 * 2;
static_assert(WS_VT + (size_t)512 * MT * 2 <= WS_X, "VT region");
static_assert(WS_HV + (size_t)4096 * 256 * 2 <= WS_S, "compress region");
static_assert(WS_LRUH + (size_t)MT * 512 * 2 <= WS_S, "lru region");

constexpr int XCD_BAR_WORDS_C = 3456;
constexpr int CW_QNSA = 3520, CW_QDSA = 3584;
constexpr int CW_NORMCNT = 3712;
constexpr int CW_CMPDONE = 3648;

constexpr int LDS_BYTES = 147456;
constexpr int LDS_CTL_OFF = 0;
constexpr int LDS_WORK_OFF = 128;

DI float bf2f(bf16_t v) { return __uint_as_float(((unsigned)v) << 16); }
DI bf16_t f2bf(float f) { unsigned u = __float_as_uint(f); u += 0x7FFFu + ((u >> 16) & 1u); return (bf16_t)(u >> 16); }
typedef __bf16 bf16v2 __attribute__((ext_vector_type(2)));
typedef float f32x2 __attribute__((ext_vector_type(2)));
DI unsigned pack2(float lo, float hi) { const f32x2 v = {lo, hi}; return __builtin_bit_cast(unsigned, __builtin_convertvector(v, bf16v2)); }
DI float fexp_(float x) { return __builtin_amdgcn_exp2f(x * 1.4426950408889634f); }
DI float sigmoidf_(float x) { return __builtin_amdgcn_rcpf(1.0f + fexp_(-x)); }
DI float siluf_(float x) { return x * __builtin_amdgcn_rcpf(1.0f + fexp_(-x)); }
DI float wave_max(float v) { for (int o = 32; o >= 1; o >>= 1) v = fmaxf(v, __shfl_xor(v, o)); return v; }
DI float wave_sum(float v) { for (int o = 32; o >= 1; o >>= 1) v += __shfl_xor(v, o); return v; }
DI void unpack8(const uint4& v, float (&f)[8]) {
    f[0] = __uint_as_float(v.x << 16); f[1] = __uint_as_float(v.x & 0xFFFF0000u);
    f[2] = __uint_as_float(v.y << 16); f[3] = __uint_as_float(v.y & 0xFFFF0000u);
    f[4] = __uint_as_float(v.z << 16); f[5] = __uint_as_float(v.z & 0xFFFF0000u);
    f[6] = __uint_as_float(v.w << 16); f[7] = __uint_as_float(v.w & 0xFFFF0000u);
}

#define XB_TMO      128
#define XB_XCNT(j)  (256  + 64 * (j))
#define XB_XSUB(j)  (1280 + 64 * (j))
#define XB_XGEN(j)  (2304 + 64 * (j))
#define XB_TOP      3328
#define XB_TOPGEN   3392
#define XCD_BAR_WORDS 3456
#define XB_SPIN_CAP (1u << 22)
static_assert(XCD_BAR_WORDS == XCD_BAR_WORDS_C, "bar words");

__device__ __forceinline__ unsigned xb_ld(unsigned* p)              { return __hip_atomic_load(p, __ATOMIC_RELAXED, __HIP_MEMORY_SCOPE_AGENT); }
__device__ __forceinline__ unsigned xb_add(unsigned* p, unsigned v) { return __hip_atomic_fetch_add(p, v, __ATOMIC_RELAXED, __HIP_MEMORY_SCOPE_AGENT); }
__device__ __forceinline__ unsigned xb_xcc_id() { return (unsigned)__builtin_amdgcn_s_getreg((3 << 11) | 20) & 0xFu; }
#define XB_SPIN(cond, bar) do { unsigned _sp = 0; while (cond) { __builtin_amdgcn_s_sleep(1); \
    if ((++_sp & 255u) == 0u) { if (xb_ld(&(bar)[XB_TMO])) break; if (_sp > XB_SPIN_CAP) { atomicAdd(&(bar)[XB_TMO], 1u); break; } } } } while (0)

struct XcdBarrier { unsigned* bar; unsigned x; volatile LAS unsigned* st; };

__device__ __forceinline__ XcdBarrier xcd_barrier_post(unsigned* bar, volatile LAS unsigned* st) {
    XcdBarrier b; b.bar = bar; b.x = xb_xcc_id(); b.st = st;
    if (threadIdx.x == 0) (void)xb_add(&bar[XB_XCNT(b.x)], 1u);
    return b;
}
__device__ __forceinline__ void xcd_barrier_complete(unsigned* bar, unsigned x, unsigned& nloc, unsigned& nx) {
    const unsigned G = gridDim.x * gridDim.y * gridDim.z;
    unsigned sum, cnt, mine, sp = 0u;
    for (;;) {
        sum = 0u; cnt = 0u; mine = 0u;
#pragma unroll
        for (unsigned j = 0; j < 16; ++j) { const unsigned c = xb_ld(&bar[XB_XCNT(j)]); sum += c; cnt += (c > 0u) ? 1u : 0u; mine = (j == x) ? c : mine; }
        if (sum == G) break;
        __builtin_amdgcn_s_sleep(1);
        if ((++sp & 255u) == 0u) { if (xb_ld(&bar[XB_TMO])) break; if (sp > XB_SPIN_CAP) { atomicAdd(&bar[XB_TMO], 1u); break; } }
    }
    nloc = mine > 0u ? mine : 1u; nx = cnt > 0u ? cnt : 1u;
}
__device__ __forceinline__ void xcd_barrier(const XcdBarrier& b) {
    asm volatile("s_waitcnt vmcnt(0)" ::: "memory");
    __syncthreads();
    if (threadIdx.x == 0) {
        unsigned* bar = b.bar;
        __builtin_amdgcn_s_waitcnt(0);
        unsigned nloc = b.st[0], nx = b.st[1];
        if (nloc == 0u) { xcd_barrier_complete(bar, b.x, nloc, nx); b.st[0] = nloc; b.st[1] = nx; }
        const unsigned old = xb_add(&bar[XB_XSUB(b.x)], 1u);
        const unsigned gen = old / nloc;
        if (old + 1u == (gen + 1u) * nloc) {
            __builtin_amdgcn_fence(__ATOMIC_RELEASE, "agent");
            asm volatile("s_waitcnt vmcnt(0)" ::: "memory");
            const unsigned og = xb_add(&bar[XB_TOP], 1u);
            const unsigned tg = og / nx;
            if (og + 1u == (tg + 1u) * nx) xb_add(&bar[XB_TOPGEN], 1u);
            else XB_SPIN(xb_ld(&bar[XB_TOPGEN]) == tg, bar);
            __builtin_amdgcn_fence(__ATOMIC_ACQUIRE, "agent");
            xb_add(&bar[XB_XGEN(b.x)], 1u);
            asm volatile("s_waitcnt vmcnt(0)" ::: "memory");
        } else {
            XB_SPIN(xb_ld(&bar[XB_XGEN(b.x)]) == gen, bar);
            __builtin_amdgcn_fence(__ATOMIC_ACQUIRE, "agent");
            asm volatile("s_waitcnt vmcnt(0)" ::: "memory");
        }
    }
    __syncthreads();
}

namespace pg8 {
constexpr int BM = 256, BK = 64, HALF = 128, HTB = HALF * BK * 2, STAGE_BYTES = 8 * HTB, NXCD = 8, WGM = 8;
__host__ __device__ __forceinline__ int lds_byte(int r, int c) { const int st = (r >> 4) * 2 + (c >> 5), rr = r & 15, cc = c & 31, ob = rr * 64 + cc * 2; return st * 1024 + (ob ^ (((ob >> 9) & 1) << 5)); }
__host__ __device__ __forceinline__ void stage_rc(int b, int& R, int& C) { const int st = b / 1024, sb = b % 1024, swz = sb ^ (((sb >> 9) & 1) << 5); R = (st >> 1) * 16 + swz / 64; C = (st & 1) * 32 + (swz % 64) / 2; }
__host__ __device__ __forceinline__ int perm32(int rho) { const int n = rho >> 4, i = rho & 15; return 8 * (i >> 2) + 4 * n + (i & 3); }
struct Unit { int pm, pn; };
struct Gemm { const bf16_t* A; const bf16_t* Bt; int M, N, K; };
struct StaticOrder {
    int nM, nN, nwg, G, c;
    __host__ __device__ __forceinline__ void init(int M, int N, int G_, int c_) { nM = M / BM; nN = N / BM; nwg = nM * nN; G = G_; c = c_; }
    __host__ __device__ __forceinline__ bool next(int i, Unit& u) const {
        const long L = (long)i * G + c; if (L >= nwg) return false;
        int wgid = (int)L; { const int q = nwg / NXCD, r = nwg % NXCD, xcd = wgid % NXCD, off = wgid / NXCD; wgid = (xcd < r ? xcd * (q + 1) : r * (q + 1) + (xcd - r) * q) + off; }
        const int nig = WGM * nN, gid = wgid / nig, fm = gid * WGM, gsz = (nM - fm) < WGM ? (nM - fm) : WGM;
        u.pm = fm + ((wgid % nig) % gsz); u.pn = (wgid % nig) / gsz; return true;
    }
    __device__ __forceinline__ void a_ready(const Unit&) const {}
    __device__ __forceinline__ void done(const Unit&) const {}
};
template <class Epi, class Sched>
__device__ __forceinline__ void gemm_phase(LAS unsigned char* lds, const Gemm g, const Sched& S, const Epi& E) {
    int tid_ = threadIdx.x; asm volatile("" : "+v"(tid_));
    const int tid = tid_, wid = __builtin_amdgcn_readfirstlane(tid >> 6), lane = tid & 63, wr = wid >> 2, wc = wid & 3, fr = lane & 15, fq = lane >> 4;
    const int K = g.K, nt = K / BK;
    unsigned voffA[2], voffB[2];
#pragma unroll
    for (int i = 0; i < 2; ++i) { int R, C; stage_rc(tid * 16 + i * 8192, R, C); const int Rb = Epi::PERM ? ((R & ~31) + perm32(R & 31)) : R;
        voffA[i] = (unsigned)(R * K + C) * 2u; voffB[i] = (unsigned)(Rb * K + C) * 2u; }
    const size_t kstep = (size_t)(BK * 2);
    const size_t hstep = (size_t)HALF * K * 2;
    const size_t tstep = 2 * hstep;
    const unsigned ldsw = (unsigned)wid * 1024u;
    const int aoff = lds_byte(wr * 64 + fr, fq * 8), boff = lds_byte(wc * 32 + fr, fq * 8);
#define PG8_SA(b, h) (((b) * 2 + (h)) * HTB)
#define PG8_SB(b, h) ((4 + (b) * 2 + (h)) * HTB)
#define PG8_STAGE(bufoff, gbase, voff) do { _Pragma("unroll") for (int _i = 0; _i < 2; ++_i) \
        __builtin_amdgcn_global_load_lds((const unsigned*)((const char*)(gbase) + (voff)[_i]), (LAS unsigned*)(lds + (bufoff) + ldsw + _i * 8192), 16, 0, 0); } while (0)
#define PG8_LDA(dst, b, h) do { _Pragma("unroll") for (int m = 0; m < 4; ++m) _Pragma("unroll") for (int k = 0; k < 2; ++k) dst[m][k] = *(const LAS bf16x8*)(lds + PG8_SA(b, h) + aoff + m * 2048 + k * 1024); } while (0)
#define PG8_LDB(dst, b, h) do { _Pragma("unroll") for (int n = 0; n < 2; ++n) _Pragma("unroll") for (int k = 0; k < 2; ++k) dst[n][k] = *(const LAS bf16x8*)(lds + PG8_SB(b, h) + boff + n * 2048 + k * 1024); } while (0)
#define PG8_MMA(ai, bj, At, Bt) do { __builtin_amdgcn_s_setprio(1); _Pragma("unroll") for (int m = 0; m < 4; ++m) _Pragma("unroll") for (int n = 0; n < 2; ++n) _Pragma("unroll") for (int k = 0; k < 2; ++k) \
        acc[ai][bj][m][n] = __builtin_amdgcn_mfma_f32_16x16x32_bf16(Bt[n][k], At[m][k], acc[ai][bj][m][n], 0, 0, 0); __builtin_amdgcn_s_setprio(0); } while (0)
#define PG8_WAIT_V(n) asm volatile("s_waitcnt vmcnt(" #n ")" ::: "memory")
#define PG8_WAIT_L(n) asm volatile("s_waitcnt lgkmcnt(" #n ")" ::: "memory")
#define PG8_BAR __builtin_amdgcn_s_barrier()
#define PG8_SCHED __builtin_amdgcn_sched_barrier(0)
    Unit cur, nxt; int ui = 0;
    if (!S.next(0, cur)) return;
    f32x4 acc[2][2][4][2];
#pragma unroll
    for (int a = 0; a < 2; ++a)
#pragma unroll
        for (int b = 0; b < 2; ++b)
#pragma unroll
            for (int m = 0; m < 4; ++m)
#pragma unroll
                for (int n = 0; n < 2; ++n) acc[a][b][m][n] = (f32x4){0.f, 0.f, 0.f, 0.f};
    bf16x8 At[4][2], B0[2][2], B1[2][2];
    const char* cA = (const char*)g.A + (size_t)cur.pm * tstep; const char* cB = (const char*)g.Bt + (size_t)cur.pn * tstep;
    S.a_ready(cur);
    PG8_STAGE(PG8_SB(0, 0), cB, voffB); PG8_STAGE(PG8_SA(0, 0), cA, voffA); PG8_STAGE(PG8_SB(0, 1), cB + hstep, voffB); PG8_STAGE(PG8_SA(0, 1), cA + hstep, voffA);
    if (wr == 1) PG8_BAR;
    PG8_WAIT_V(4); PG8_BAR;
    PG8_STAGE(PG8_SB(1, 0), cB + kstep, voffB); PG8_STAGE(PG8_SA(1, 0), cA + kstep, voffA); PG8_STAGE(PG8_SB(1, 1), cB + hstep + kstep, voffB);
    PG8_WAIT_V(6); PG8_BAR;
    for (;;) {
        const bool has_next = S.next(ui + 1, nxt);
        const char* nA = has_next ? (const char*)g.A + (size_t)nxt.pm * tstep : cA; const char* nB = has_next ? (const char*)g.Bt + (size_t)nxt.pn * tstep : cB;
        for (int t = 0; t < nt; t += 2) {
            const bool last = (t == nt - 2);
            const char* a1 = cA + (size_t)(t + 1) * kstep;
            const char* a2 = last ? nA : cA + (size_t)(t + 2) * kstep; const char* b2 = last ? nB : cB + (size_t)(t + 2) * kstep;
            const char* a3 = a2 + kstep; const char* b3 = b2 + kstep;
            if (last && has_next) S.a_ready(nxt);
            PG8_LDB(B0, 0, 0); PG8_SCHED; PG8_LDA(At, 0, 0); PG8_STAGE(PG8_SA(1, 1), a1 + hstep, voffA);
            PG8_WAIT_L(8); PG8_BAR; PG8_WAIT_L(0); PG8_MMA(0, 0, At, B0); PG8_BAR; PG8_SCHED;
            PG8_LDB(B1, 0, 1); PG8_STAGE(PG8_SB(0, 0), b2, voffB);
            PG8_BAR; PG8_WAIT_L(0); PG8_MMA(0, 1, At, B1); PG8_BAR;
            PG8_LDA(At, 0, 1); PG8_STAGE(PG8_SA(0, 0), a2, voffA);
            PG8_BAR; PG8_WAIT_L(0); PG8_MMA(1, 0, At, B0); PG8_BAR; PG8_SCHED;
            PG8_STAGE(PG8_SB(0, 1), b2 + hstep, voffB);
            PG8_WAIT_V(6); PG8_BAR; PG8_MMA(1, 1, At, B1); PG8_BAR;
            PG8_LDB(B0, 1, 0); PG8_SCHED; PG8_LDA(At, 1, 0); PG8_STAGE(PG8_SA(0, 1), a2 + hstep, voffA);
            PG8_WAIT_L(8); PG8_BAR; PG8_WAIT_L(0); PG8_MMA(0, 0, At, B0); PG8_BAR; PG8_SCHED;
            PG8_LDB(B1, 1, 1); PG8_STAGE(PG8_SB(1, 0), b3, voffB);
            PG8_BAR; PG8_WAIT_L(0); PG8_MMA(0, 1, At, B1); PG8_BAR;
            PG8_LDA(At, 1, 1); PG8_STAGE(PG8_SA(1, 0), a3, voffA);
            PG8_BAR; PG8_WAIT_L(0); PG8_MMA(1, 0, At, B0); PG8_BAR; PG8_SCHED;
            PG8_STAGE(PG8_SB(1, 1), b3 + hstep, voffB);
            PG8_WAIT_V(6); PG8_BAR; PG8_MMA(1, 1, At, B1); PG8_BAR;
        }
        E(acc, cur, wr, wc, fr, fq); S.done(cur);
        if (!has_next) break;
#pragma unroll
        for (int a = 0; a < 2; ++a)
#pragma unroll
            for (int b = 0; b < 2; ++b)
#pragma unroll
                for (int m = 0; m < 4; ++m)
#pragma unroll
                    for (int n = 0; n < 2; ++n) acc[a][b][m][n] = (f32x4){0.f, 0.f, 0.f, 0.f};
        cur = nxt; cA = nA; cB = nB; ++ui;
    }
    PG8_WAIT_V(0);
    if (wr == 0) PG8_BAR;
    PG8_BAR;
#undef PG8_SA
#undef PG8_SB
#undef PG8_STAGE
#undef PG8_LDA
#undef PG8_LDB
#undef PG8_MMA
#undef PG8_WAIT_V
#undef PG8_WAIT_L
#undef PG8_BAR
#undef PG8_SCHED
}

template <int ACT  > struct EpiBf16 {
    static constexpr bool PERM = true;
    bf16_t* O; int ldc;
    __device__ __forceinline__ void operator()(const f32x4 (&acc)[2][2][4][2], const Unit& u, int wr, int wc, int fr, int fq) const {
        const int row0 = u.pm * BM + wr * 64 + fr, col0 = u.pn * BM + wc * 32 + 8 * fq;
#pragma unroll
        for (int ai = 0; ai < 2; ++ai)
#pragma unroll
            for (int m = 0; m < 4; ++m) { bf16_t* rowp = O + (size_t)(row0 + ai * HALF + m * 16) * ldc + col0;
#pragma unroll
                for (int bj = 0; bj < 2; ++bj) { f32x4 v0 = acc[ai][bj][m][0], v1 = acc[ai][bj][m][1];
                    if (ACT == 1) { for (int i = 0; i < 4; ++i) { v0[i] = siluf_(v0[i]); v1[i] = siluf_(v1[i]); } }
                    uint4 o; o.x = pack2(v0[0], v0[1]); o.y = pack2(v0[2], v0[3]); o.z = pack2(v1[0], v1[1]); o.w = pack2(v1[2], v1[3]);
                    *(uint4*)(rowp + bj * HALF) = o; } }
    }
};
struct EpiF32 {
    static constexpr bool PERM = false;
    float* C; int ldc;
    __device__ __forceinline__ void operator()(const f32x4 (&acc)[2][2][4][2], const Unit& u, int wr, int wc, int fr, int fq) const {
        const int row0 = u.pm * BM + wr * 64 + fr, col0 = u.pn * BM + wc * 32 + 4 * fq;
#pragma unroll
        for (int ai = 0; ai < 2; ++ai)
#pragma unroll
            for (int m = 0; m < 4; ++m) { float* rowp = C + (size_t)(row0 + ai * HALF + m * 16) * ldc + col0;
#pragma unroll
                for (int bj = 0; bj < 2; ++bj)
#pragma unroll
                    for (int n = 0; n < 2; ++n) *(f32x4*)(rowp + bj * HALF + n * 16) = acc[ai][bj][m][n]; }
    }
};
template <int IN_BF16> struct EpiResid {
    static constexpr bool PERM = true;
    const float* Xi; const bf16_t* Xib; bf16_t* Ob;
    __device__ __forceinline__ void operator()(const f32x4 (&acc)[2][2][4][2], const Unit& u, int wr, int wc, int fr, int fq) const {
        const int row0 = u.pm * BM + wr * 64 + fr, col0 = u.pn * BM + wc * 32 + 8 * fq;
#pragma unroll
        for (int ai = 0; ai < 2; ++ai)
#pragma unroll
            for (int m = 0; m < 4; ++m) { const size_t ro = (size_t)(row0 + ai * HALF + m * 16) * 1024 + col0;
#pragma unroll
                for (int bj = 0; bj < 2; ++bj) { const size_t o = ro + bj * HALF;
                    f32x4 x0, x1;
                    if (IN_BF16) { const uint4 xv = *(const uint4*)(Xib + o); float xf[8]; unpack8(xv, xf); x0 = (f32x4){xf[0], xf[1], xf[2], xf[3]}; x1 = (f32x4){xf[4], xf[5], xf[6], xf[7]}; }
                    else { x0 = *(const f32x4*)(Xi + o); x1 = *(const f32x4*)(Xi + o + 4); }
                    const f32x4 v0 = x0 + acc[ai][bj][m][0], v1 = x1 + acc[ai][bj][m][1];
                    uint4 pk; pk.x = pack2(v0[0], v0[1]); pk.y = pack2(v0[2], v0[3]); pk.z = pack2(v1[0], v1[1]); pk.w = pack2(v1[2], v1[3]); *(uint4*)(Ob + o) = pk; } }
    }
};
template <int OUT_BF16> struct EpiGate {
    static constexpr bool PERM = true;
    float* X; bf16_t* Xb; const bf16_t* R; const bf16_t* E;
    __device__ __forceinline__ void operator()(const f32x4 (&acc)[2][2][4][2], const Unit& u, int wr, int wc, int fr, int fq) const {
        const int row0 = u.pm * BM + wr * 64 + fr, col0 = u.pn * BM + wc * 32 + 8 * fq;
#pragma unroll
        for (int ai = 0; ai < 2; ++ai)
#pragma unroll
            for (int m = 0; m < 4; ++m) { const size_t ro = (size_t)(row0 + ai * HALF + m * 16) * 1024 + col0;
#pragma unroll
                for (int bj = 0; bj < 2; ++bj) { const size_t o = ro + bj * HALF;
                    const uint4 ev = *(const uint4*)(E + o), rv = *(const uint4*)(R + o); float ef[8], rf[8]; unpack8(ev, ef); unpack8(rv, rf);
                    float v[8];
#pragma unroll
                    for (int n = 0; n < 2; ++n)
#pragma unroll
                        for (int i = 0; i < 4; ++i) v[4 * n + i] = rf[4 * n + i] + ef[4 * n + i] * sigmoidf_(acc[ai][bj][m][n][i]);
                    if (OUT_BF16) { uint4 pk; pk.x = pack2(v[0], v[1]); pk.y = pack2(v[2], v[3]); pk.z = pack2(v[4], v[5]); pk.w = pack2(v[6], v[7]); *(uint4*)(Xb + o) = pk; }
                    else { *(f32x4*)(X + o) = (f32x4){v[0], v[1], v[2], v[3]}; *(f32x4*)(X + o + 4) = (f32x4){v[4], v[5], v[6], v[7]}; } } }
    }
};
struct EpiGateNorm {
    static constexpr bool PERM = true;
    float* X; const bf16_t* R; const bf16_t* E; const float* wn; float* SS; unsigned* cnt; unsigned* tmo;
    __device__ __forceinline__ void operator()(f32x4 (&acc)[2][2][4][2], const Unit& u, int wr, int wc, int fr, int fq) const {
        const int row0 = u.pm * BM + wr * 64 + fr, col0 = u.pn * BM + wc * 32 + 8 * fq;
#pragma unroll
        for (int ai = 0; ai < 2; ++ai)
#pragma unroll
            for (int m = 0; m < 4; ++m) { const int row = row0 + ai * HALF + m * 16; const size_t ro = (size_t)row * 1024 + col0; float ss = 0.f;
#pragma unroll
                for (int bj = 0; bj < 2; ++bj) { const size_t o = ro + bj * HALF;
                    const uint4 ev = *(const uint4*)(E + o), rv = *(const uint4*)(R + o); float ef[8], rf[8]; unpack8(ev, ef); unpack8(rv, rf);
#pragma unroll
                    for (int n = 0; n < 2; ++n)
#pragma unroll
                        for (int i = 0; i < 4; ++i) { const float v = rf[4 * n + i] + ef[4 * n + i] * sigmoidf_(acc[ai][bj][m][n][i]); acc[ai][bj][m][n][i] = v; ss += v * v; } }
                ss += __shfl_xor(ss, 16); ss += __shfl_xor(ss, 32);
                if (fq == 0) (void)__hip_atomic_fetch_add(SS + row, ss, __ATOMIC_RELAXED, __HIP_MEMORY_SCOPE_AGENT); }
        asm volatile("s_waitcnt vmcnt(0)" ::: "memory");
        if ((fr | fq) == 0) (void)__hip_atomic_fetch_add(cnt + 2 * u.pm + wr, 1u, __ATOMIC_RELAXED, __HIP_MEMORY_SCOPE_AGENT);
        f32x4 w[2][2];
#pragma unroll
        for (int bj = 0; bj < 2; ++bj) { w[bj][0] = *(const f32x4*)(wn + col0 + bj * HALF); w[bj][1] = *(const f32x4*)(wn + col0 + bj * HALF + 4); }
        { unsigned sp = 0;
          while (__hip_atomic_load(cnt + 2 * u.pm + wr, __ATOMIC_RELAXED, __HIP_MEMORY_SCOPE_AGENT) < 16u) { __builtin_amdgcn_s_sleep(1);
              if (++sp > (1u << 22)) { if ((fr | fq) == 0) atomicAdd(tmo, 1u); break; } } }
        asm volatile("" ::: "memory");
#pragma unroll
        for (int ai = 0; ai < 2; ++ai)
#pragma unroll
            for (int m = 0; m < 4; ++m) { const int row = row0 + ai * HALF + m * 16; const size_t ro = (size_t)row * 1024 + col0;
                const float rs = rsqrtf(__hip_atomic_load(SS + row, __ATOMIC_RELAXED, __HIP_MEMORY_SCOPE_AGENT) * (1.0f / 1024.0f) + 1e-6f);
#pragma unroll
                for (int bj = 0; bj < 2; ++bj) { const size_t o = ro + bj * HALF;
                    *(f32x4*)(X + o) = acc[ai][bj][m][0] * rs * w[bj][0]; *(f32x4*)(X + o + 4) = acc[ai][bj][m][1] * rs * w[bj][1]; } }
    }
};
}

struct Args { const float* in[28]; float* out; unsigned char* ws; int ph_lo, ph_hi; };

struct Frame {
    int tid, lane, wave, G, bid, gw, nw;
    unsigned char* lds;
    unsigned* ctl;
    const float* in[28]; float* out; unsigned char* ws;
    const LAS unsigned char* lut;
    const LAS float* tbl;
    const LAS float* biasL;
    LAS unsigned char* ldsl;
};
DI int t5b(const Frame& F, int n) { return n < 16 ? n : (n >= 113 ? 31 : (int)F.lut[n]); }

DI bool phase_refresh(Frame& F) { int t_ = threadIdx.x; asm volatile("" : "+v"(t_)); F.tid = t_; F.lane = t_ & 63; return true; }
struct TDesc { const float* src; bf16_t* dst; int K, Nsrc, Npad, mapk, ntiles; };
DI int tmap(int kind, int n) { return kind == 0 ? n : (kind == 1 ? map0(n) : (kind == 2 ? map1(n) : mapv(n))); }
DI void transpose_all(const Frame& F) {
    unsigned char* ws = F.ws;
    float* tile = (float*)F.lds;
    TDesc D[11];
    D[0] = TDesc{F.in[7], (bf16_t*)(ws + WS_WIN0), 1024, 3292, LD0, 1, 0};
    D[1] = TDesc{F.in[7], (bf16_t*)(ws + WS_WVT), 1024, 3292, 512, 3, 0};
    D[2] = TDesc{F.in[8], (bf16_t*)(ws + WS_WOUT0), 1024, 1024, 1024, 0, 0};
    D[3] = TDesc{F.in[5], (bf16_t*)(ws + WS_WG0), 1024, 1024, 1024, 0, 0};
    D[4] = TDesc{F.in[5] + (size_t)1024 * 1024, (bf16_t*)(ws + WS_WG1), 1024, 1024, 1024, 0, 0};
    D[5] = TDesc{F.in[4], (bf16_t*)(ws + WS_WP0), 256, 1024, 1024, 0, 0};
    D[6] = TDesc{F.in[4] + (size_t)256 * 1024, (bf16_t*)(ws + WS_WP1), 256, 1024, 1024, 0, 0};
    D[7] = TDesc{F.in[15], (bf16_t*)(ws + WS_WIN1), 1024, 3592, LD1, 2, 0};
    D[8] = TDesc{F.in[16], (bf16_t*)(ws + WS_WOUT1), 1024, 1024, 1024, 0, 0};
    D[9] = TDesc{F.in[10], (bf16_t*)(ws + WS_WC1K), 2048, 256, 256, 0, 0};
    D[10] = TDesc{F.in[13], (bf16_t*)(ws + WS_WC1V), 2048, 256, 256, 0, 0};
    int total = 0;
#pragma unroll
    for (int i = 0; i < 11; ++i) { D[i].ntiles = (D[i].Npad / 64) * (D[i].K / 64); total += D[i].ntiles; }
    float rg[8];
    auto locate = [&](int tix, TDesc& d, int& nt, int& kt) { int rem = tix;
#pragma unroll
        for (int i = 0; i < 11; ++i) { if (rem >= 0 && rem < D[i].ntiles) { d = D[i]; const int ntk = d.K / 64; nt = rem / ntk; kt = rem % ntk; rem = -1; } else if (rem >= 0) rem -= D[i].ntiles; } };
    auto load = [&](int tix) { TDesc d; int nt = 0, kt = 0; locate(tix, d, nt, kt);
#pragma unroll
        for (int q = 0; q < 8; ++q) { const int e = F.tid + q * 512; const int kk = e >> 6, nn = e & 63; const int col = tmap(d.mapk, nt * 64 + nn);
            rg[q] = col >= 0 ? d.src[(size_t)(kt * 64 + kk) * d.Nsrc + col] : 0.f; } };
    int tix = F.bid; int buf = 0;
    if (tix < total) load(tix);
    for (; tix < total; tix += F.G) {
        float* tl = tile + buf * (64 * 65);
#pragma unroll
        for (int q = 0; q < 8; ++q) { const int e = F.tid + q * 512; tl[(e >> 6) * 65 + (e & 63)] = rg[q]; }
        __syncthreads();
        TDesc d; int nt = 0, kt = 0; locate(tix, d, nt, kt);
        if (tix + F.G < total) load(tix + F.G);
#pragma unroll
        for (int q = 0; q < 8; ++q) { const int e = F.tid + q * 512; const int nn = e >> 6, kk = e & 63;
            d.dst[(size_t)(nt * 64 + nn) * d.K + kt * 64 + kk] = f2bf(tl[kk * 65 + nn]); }
        buf ^= 1;
    }
    __syncthreads();
}
template <int OUTF>
DI void rmsnorm_rows(const Frame& F, const float* X, const float* g, bf16_t* Ob, float* Of) {
    f32x4 gg[4];
#pragma unroll
    for (int i = 0; i < 4; ++i) gg[i] = *(const f32x4*)(g + i * 256 + F.lane * 4);
    for (int row0 = F.gw * 4; row0 < MT; row0 += F.nw * 4) {
        f32x4 v[4][4]; float ss[4];
#pragma unroll
        for (int r = 0; r < 4; ++r)
#pragma unroll
            for (int i = 0; i < 4; ++i) v[r][i] = *(const f32x4*)(X + (size_t)(row0 + r) * 1024 + i * 256 + F.lane * 4);
#pragma unroll
        for (int r = 0; r < 4; ++r) { float a = 0.f;
#pragma unroll
            for (int i = 0; i < 4; ++i) a += v[r][i][0] * v[r][i][0] + v[r][i][1] * v[r][i][1] + v[r][i][2] * v[r][i][2] + v[r][i][3] * v[r][i][3];
            ss[r] = a; }
#pragma unroll
        for (int o = 32; o >= 1; o >>= 1) {
#pragma unroll
            for (int r = 0; r < 4; ++r) ss[r] += __shfl_xor(ss[r], o); }
#pragma unroll
        for (int r = 0; r < 4; ++r) { const float rs = rsqrtf(ss[r] * (1.0f / 1024.0f) + 1e-6f);
#pragma unroll
            for (int i = 0; i < 4; ++i) { f32x4 y;
#pragma unroll
                for (int j = 0; j < 4; ++j) y[j] = v[r][i][j] * rs * gg[i][j];
                if (OUTF) *(f32x4*)(Of + (size_t)(row0 + r) * 1024 + i * 256 + F.lane * 4) = y;
                else { uint2 pk; pk.x = pack2(y[0], y[1]); pk.y = pack2(y[2], y[3]); *(uint2*)(Ob + (size_t)(row0 + r) * 1024 + i * 256 + F.lane * 4) = pk; } } }
    }
}
DI void rmsnorm_gates(const Frame& F, const bf16_t* X, const float* g, bf16_t* Ob) {
    const float* W = F.in[15]; float* gts = (float*)(F.ws + WS_GATES);
    float wg[2][8][8]; float gg[2][8];
#pragma unroll
    for (int i = 0; i < 2; ++i)
#pragma unroll
        for (int e = 0; e < 8; ++e) { const int k = i * 512 + F.lane * 8 + e; const f32x4 a = *(const f32x4*)(W + (size_t)k * 3592 + 2560), b = *(const f32x4*)(W + (size_t)k * 3592 + 2564);
            wg[i][e][0] = a[0]; wg[i][e][1] = a[1]; wg[i][e][2] = a[2]; wg[i][e][3] = a[3]; wg[i][e][4] = b[0]; wg[i][e][5] = b[1]; wg[i][e][6] = b[2]; wg[i][e][7] = b[3]; gg[i][e] = g[k]; }
    for (int row0 = F.gw * 2; row0 < MT; row0 += F.nw * 2) {
        uint4 xv[2][2]; float ss[2];
#pragma unroll
        for (int r = 0; r < 2; ++r)
#pragma unroll
            for (int i = 0; i < 2; ++i) xv[r][i] = *(const uint4*)(X + (size_t)(row0 + r) * 1024 + i * 512 + F.lane * 8);
        float xf[2][2][8];
#pragma unroll
        for (int r = 0; r < 2; ++r) { float a = 0.f;
#pragma unroll
            for (int i = 0; i < 2; ++i) { unpack8(xv[r][i], xf[r][i]);
#pragma unroll
                for (int e = 0; e < 8; ++e) a += xf[r][i][e] * xf[r][i][e]; }
            ss[r] = a; }
#pragma unroll
        for (int o = 32; o >= 1; o >>= 1) { ss[0] += __shfl_xor(ss[0], o); ss[1] += __shfl_xor(ss[1], o); }
#pragma unroll
        for (int r = 0; r < 2; ++r) { const int row = row0 + r;
            const float rs = rsqrtf(ss[r] * (1.0f / 1024.0f) + 1e-6f);
            float pg[8] = {0.f, 0.f, 0.f, 0.f, 0.f, 0.f, 0.f, 0.f};
#pragma unroll
            for (int i = 0; i < 2; ++i) { float y[8];
#pragma unroll
                for (int e = 0; e < 8; ++e) { y[e] = xf[r][i][e] * rs * gg[i][e];
#pragma unroll
                    for (int j = 0; j < 8; ++j) pg[j] += y[e] * wg[i][e][j]; }
                uint4 pk; pk.x = pack2(y[0], y[1]); pk.y = pack2(y[2], y[3]); pk.z = pack2(y[4], y[5]); pk.w = pack2(y[6], y[7]); *(uint4*)(Ob + (size_t)row * 1024 + i * 512 + F.lane * 8) = pk; }
#pragma unroll
            for (int o = 32; o >= 1; o >>= 1) {
#pragma unroll
                for (int j = 0; j < 8; ++j) pg[j] += __shfl_xor(pg[j], o); }
            float mine = 0.f;
#pragma unroll
            for (int j = 0; j < 8; ++j) if (F.lane == j) mine = pg[j];
            if (F.lane < 8) gts[(size_t)row * 8 + F.lane] = mine; }
    }
}
DI void p0_prologue(const Frame& F) {
    unsigned char* ws = F.ws;
    transpose_all(F);
    { bf16_t* wat = (bf16_t*)(ws + WS_WAT); bf16_t* wxt = (bf16_t*)(ws + WS_WXT);
      for (int idx = F.bid * 512 + F.tid; idx < 8 * 64 * 64; idx += F.G * 512) { const int g = idx >> 12, j = (idx >> 6) & 63, i = idx & 63;
          wat[idx] = f2bf(F.in[19][(size_t)(g * 64 + i) * 64 + j]); wxt[idx] = f2bf(F.in[21][(size_t)(g * 64 + i) * 64 + j]); } }
    { float* ssz = (float*)(ws + WS_SS); for (int i = F.bid * 512 + F.tid; i < MT; i += F.G * 512) ssz[i] = 0.f; }
    { float* imgn = (float*)(ws + WS_IMGN); float* imgd = (float*)(ws + WS_IMGD); float* imgw = (float*)(ws + WS_IMGW); float* imgz = (float*)(ws + WS_IMGZ);
      const float inv_c1 = 1.0f / (0.125f * 1.4426950408889634f);
      for (int idx = F.bid * 512 + F.tid; idx < (6 + 8 + 1) * 16384 + 2048; idx += F.G * 512) {
          const int e = idx & 3, ln = (idx >> 2) & 63, G = (idx >> 8) & 7, wv = (idx >> 11) & 7, im = idx >> 14;
          const int R = 4 * G + e, i = R & 15, hf_ = ln >> 5, r_ = ln & 31, koff = 32 * (R >> 4) + (i & 3) + 8 * (i >> 2) + 4 * hf_;
          if (im < 6) { const int g = im / 3, dl = im % 3, ql = r_ >> 2, hh = g * 4 + (r_ & 3); const int dist = 64 * dl + 8 * wv + ql - koff;
              imgn[idx] = dist < 0 ? NEG_INF : F.biasL[hh * 128 + (dist > 127 ? 127 : dist)] * inv_c1; }
          else if (im < 14) { const int k = im - 6, par = k >> 2, dl = k & 3, ql = r_ >> 3, hh = 8 + (r_ & 7); const int dist = 32 * par + 4 * wv + ql + 64 * dl - koff;
              imgd[idx - 6 * 16384] = dist < 0 ? NEG_INF : F.biasL[hh * 128 + (dist > 127 ? 127 : dist)] * inv_c1; }
          else if (im < 15) { const int ql = r_ >> 2; imgw[idx - 14 * 16384] = (koff > 8 * wv + ql) ? 0.f : NEG_INF; }
          else imgz[idx - 15 * 16384] = 0.f; } }
    rmsnorm_rows<0>(F, F.in[0], F.in[2], (bf16_t*)(ws + WS_BFA), nullptr);
    { const float* p = F.in[1]; bf16_t* pb = (bf16_t*)(ws + WS_PBF); const size_t n8 = (size_t)2 * MT * 256 / 8;
      for (size_t i = (size_t)F.bid * 512 + F.tid; i < n8; i += (size_t)F.G * 512) {
          const f32x4 a = *(const f32x4*)(p + i * 8), b = *(const f32x4*)(p + i * 8 + 4);
          uint4 o; o.x = pack2(a[0], a[1]); o.y = pack2(a[2], a[3]); o.z = pack2(b[0], b[1]); o.w = pack2(b[2], b[3]); *(uint4*)(pb + i * 8) = o; } }
}

DI void p2a_build_blocks(const Frame& F) {
    { const int gt = F.bid * 512 + F.tid;
      if (gt < 1024) { const int bg = gt >> 6, d = gt & 63; ((float*)(F.ws + WS_KCMP))[((size_t)bg * 256 + 255) * 64 + d] = 0.f; ((float*)(F.ws + WS_VCMP))[((size_t)bg * 256 + 255) * 64 + d] = 0.f;
          ((bf16_t*)(F.ws + WS_VCT))[((size_t)bg * 64 + d) * 256 + 255] = 0; } }
    const bf16_t* U = (const bf16_t*)(F.ws + WS_U);
    bf16_t* AK = (bf16_t*)(F.ws + WS_AK); bf16_t* AV = (bf16_t*)(F.ws + WS_AV);
    const float* posk = F.in[9]; const float* posv = F.in[12];
    const size_t nitem = (size_t)2 * 4096 * 32 * 8;
    for (size_t it = (size_t)F.bid * 512 + F.tid; it < nitem; it += (size_t)F.G * 512) {
        const int c8 = (int)(it & 7), l = (int)((it >> 3) & 31), r = (int)((it >> 8) & 4095), which = (int)(it >> 20);
        bf16_t* dst = (which ? AV : AK) + (size_t)r * 2048 + l * 64 + c8 * 8;
        uint4 o = make_uint4(0u, 0u, 0u, 0u);
        if (r < 4080) {
            const int b = r / 510, rem = r % 510, i = rem >> 1, g = rem & 1;
            const bf16_t* sp = U + ((size_t)b * SEQ + 16 * i + l) * LD0 + (which ? C_VC : C_KC) + g * 64 + c8 * 8;
            const float* pp = (which ? posv : posk) + l * 64 + c8 * 8;
            const uint4 v = *(const uint4*)sp; float f[8]; unpack8(v, f);
            o.x = pack2(f[0] + pp[0], f[1] + pp[1]); o.y = pack2(f[2] + pp[2], f[3] + pp[3]); o.z = pack2(f[4] + pp[4], f[5] + pp[5]); o.w = pack2(f[6] + pp[6], f[7] + pp[7]);
        }
        *(uint4*)dst = o;
    }
}
DI void p2c_compress_rows(const Frame& F, int which, int row0) {
    const bf16_t* H = (const bf16_t*)(F.ws + (which ? WS_HV : WS_HK));
    float* OUT = (float*)(F.ws + (which ? WS_VCMP : WS_KCMP));
    const float* w2 = which ? F.in[14] : F.in[11];
    for (int rr = F.wave; rr < 256; rr += 8) {
        const int r = row0 + rr; if (r >= 4080) break;
        const int b = r / 510, rem = r % 510, i = rem >> 1, g = rem & 1, bg = b * 2 + g;
        const bf16_t* hr = H + (size_t)r * 256; float acc = 0.f;
        for (int j = 0; j < 256; j += 8) { const uint4 hv = *(const uint4*)(hr + j); float hf[8]; unpack8(hv, hf);
#pragma unroll
            for (int q = 0; q < 8; ++q) acc += hf[q] * w2[(size_t)(j + q) * 64 + F.lane]; }
        OUT[((size_t)bg * 256 + i) * 64 + F.lane] = acc;
        if (which) ((bf16_t*)(F.ws + WS_VCT))[((size_t)bg * 64 + F.lane) * 256 + i] = f2bf(acc);
    }
}

typedef float f32x16 __attribute__((ext_vector_type(16)));
#define MFMA32(a, b, c) __builtin_amdgcn_mfma_f32_32x32x16_bf16((a), (b), (c), 0, 0, 0)
constexpr float LOG2E = 1.4426950408889634f;
constexpr float QK_C1 = 0.125f * LOG2E;
constexpr int AT_BUF = 0;
constexpr int AT_PSUM = 65536;
constexpr int AT_XM = AT_PSUM + 16384;
constexpr int AT_SELM = AT_PSUM + 65536;
constexpr int AT_MISC = AT_SELM + 1024;
constexpr int AT_END = AT_MISC + 64 + 2048;
static_assert(AT_END + LDS_WORK_OFF <= LDS_BYTES - 12288, "attention lds");
enum { FL_NEAR = 1, FL_CAUSAL = 2, FL_WINLO = 4, FL_BITS = 8, FL_LANE = 16 };

struct Att { float m, l; f32x16 o0, o1; };
DI void att_init(Att& a) { a.m = NEG_INF; a.l = 0.f;
#pragma unroll
    for (int i = 0; i < 16; ++i) { a.o0[i] = 0.f; a.o1[i] = 0.f; } }

typedef unsigned u32x4 __attribute__((ext_vector_type(4)));
#define OPAQUE(x) asm volatile("" : "+v"(x))
DI void st_write_K(LAS unsigned char* Kt, int tid, const uint4& rg) {
    OPAQUE(tid);
    const int key = tid >> 3, c = tid & 7;
    const u32x4 v = {rg.x, rg.y, rg.z, rg.w};
    *(LAS u32x4*)(Kt + (key ^ ((key >> 3) & 1)) * 128 + ((c ^ (key & 7)) << 4)) = v;
}
DI void st_write_VT(LAS unsigned char* Vt, int tid, const uint4& rg) {
    OPAQUE(tid);
    const int d = tid >> 3, m = tid & 7, G = m >> 1, a = m & 1, sw = (d >> 1) & 7;
    typedef unsigned u32x2 __attribute__((ext_vector_type(2)));
    const u32x2 lo = {rg.x, rg.y}, hi = {rg.z, rg.w};
    *(LAS u32x2*)(Vt + d * 128 + (((2 * G) ^ sw) << 4) + 8 * a) = lo;
    *(LAS u32x2*)(Vt + d * 128 + (((2 * G + 1) ^ sw) << 4) + 8 * a) = hi;
}
template <bool CINIT = false, bool BATCH = false>
DI void qk_tile(const LAS unsigned char* Kt, const bf16x8 (&qf)[4], int r, int hf, f32x16& s0, f32x16& s1) {
    OPAQUE(r); OPAQUE(hf);
    const f32x16 zero16 = {0.f, 0.f, 0.f, 0.f, 0.f, 0.f, 0.f, 0.f, 0.f, 0.f, 0.f, 0.f, 0.f, 0.f, 0.f, 0.f};
    if (BATCH) {
        bf16x8 a0[4], a1[4];
#pragma unroll
        for (int s = 0; s < 4; ++s) { const int c = 2 * s + hf; const int pr = r ^ ((r >> 3) & 1);
            a0[s] = *(const LAS bf16x8*)(Kt + pr * 128 + ((c ^ (r & 7)) << 4)); a1[s] = *(const LAS bf16x8*)(Kt + (32 + pr) * 128 + ((c ^ (r & 7)) << 4)); }
        __builtin_amdgcn_sched_barrier(0);
#pragma unroll
        for (int s = 0; s < 4; ++s) {
            if (s == 0 && !CINIT) { s0 = MFMA32(a0[0], qf[0], zero16); s1 = MFMA32(a1[0], qf[0], zero16); }
            else { s0 = MFMA32(a0[s], qf[s], s0); s1 = MFMA32(a1[s], qf[s], s1); } }
        return; }
#pragma unroll
    for (int s = 0; s < 4; ++s) {
        const int c = 2 * s + hf;
        const int pr = r ^ ((r >> 3) & 1);
        const bf16x8 a0 = *(const LAS bf16x8*)(Kt + pr * 128 + ((c ^ (r & 7)) << 4));
        const bf16x8 a1 = *(const LAS bf16x8*)(Kt + (32 + pr) * 128 + ((c ^ (r & 7)) << 4));
        if (s == 0 && !CINIT) { s0 = MFMA32(a0, qf[0], zero16); s1 = MFMA32(a1, qf[0], zero16); }
        else { s0 = MFMA32(a0, qf[s], s0); s1 = MFMA32(a1, qf[s], s1); }
    }
}
template <int FLAGS>
DI void fix_scores(f32x16& s, int posb, int kstep, int tq, const LAS float* bl, float bfar, unsigned mword, bool laneok, int hf) {
    OPAQUE(hf); OPAQUE(tq);
#pragma unroll
    for (int i = 0; i < 16; ++i) {
        const int koff = (i & 3) + 8 * (i >> 2) + 4 * hf;
        const int dist = tq - (posb + kstep * koff);
        float bias = bfar;
        if (FLAGS & FL_NEAR) { int dd = dist < 0 ? 0 : dist; dd = dd > 127 ? 127 : dd; bias = bl[dd]; }
        const float v = s[i] * QK_C1 + bias;
        bool ok = true;
        if (FLAGS & FL_CAUSAL) ok = ok && (dist >= 0);
        if (FLAGS & FL_WINLO) ok = ok && (dist < 512);
        if (FLAGS & FL_BITS) ok = ok && (((mword >> koff) & 1u) != 0u);
        if (FLAGS & FL_LANE) ok = ok && laneok;
        s[i] = ok ? v : NEG_INF;
    }
}
DI bf16x8 pack8(const f32x16& x, int s) {
    typedef unsigned u32x4 __attribute__((ext_vector_type(4)));
    u32x4 p;
    p[0] = pack2(x[8 * s + 0], x[8 * s + 1]); p[1] = pack2(x[8 * s + 2], x[8 * s + 3]); p[2] = pack2(x[8 * s + 4], x[8 * s + 5]); p[3] = pack2(x[8 * s + 6], x[8 * s + 7]);
    return __builtin_bit_cast(bf16x8, p);
}
DI void pv_tile(const LAS unsigned char* Vt, const f32x16& p0, const f32x16& p1, int r, int hf, f32x16& o0, f32x16& o1) {
#pragma unroll
    for (int G = 0; G < 4; ++G) {
        const bf16x8 pb = pack8((G >> 1) ? p1 : p0, G & 1);
        const int cc = 2 * G + hf;
        const bf16x8 a0 = *(const LAS bf16x8*)(Vt + r * 128 + ((cc ^ ((r >> 1) & 7)) << 4));
        const bf16x8 a1 = *(const LAS bf16x8*)(Vt + (32 + r) * 128 + ((cc ^ ((r >> 1) & 7)) << 4));
        o0 = MFMA32(a0, pb, o0); o1 = MFMA32(a1, pb, o1);
    }
}
DI void online_pv(Att& st, f32x16& s0, f32x16& s1, const LAS unsigned char* Vt, int r, int hf) {
    float tm = NEG_INF;
#pragma unroll
    for (int i = 0; i < 16; ++i) tm = fmaxf(tm, fmaxf(s0[i], s1[i]));
    tm = fmaxf(tm, __shfl_xor(tm, 32));
    const float mn = fmaxf(st.m, tm);
    const float mu = (mn == NEG_INF) ? 0.f : mn;
    const float alpha = __builtin_amdgcn_exp2f(st.m - mu);
    float ls = 0.f;
#pragma unroll
    for (int i = 0; i < 16; ++i) { s0[i] = __builtin_amdgcn_exp2f(s0[i] - mu); s1[i] = __builtin_amdgcn_exp2f(s1[i] - mu); ls += s0[i] + s1[i]; }
    st.l = st.l * alpha + ls;
    if (__ballot(mn != st.m) != 0ull) {
#pragma unroll
        for (int i = 0; i < 16; ++i) { st.o0[i] *= alpha; st.o1[i] *= alpha; } }
    st.m = mn;
    pv_tile(Vt, s0, s1, r, hf, st.o0, st.o1);
}
DI unsigned bitmask32(unsigned w, int pos) { unsigned m; asm("v_bfe_i32 %0, %1, %2, 1" : "=v"(m) : "v"(w), "n"(pos)); return m; }
template <bool BITS, bool NEARB, bool CAUSAL = false>
DI void far_soft(Att& st, f32x16& s0, f32x16& s1, const LAS unsigned char* Vt, int r, int hf, float bfar, bool laneok, unsigned m0, unsigned m1,
                 int tq, int posb, const LAS float* bl) {
    const float cb = laneok ? bfar - st.m : NEG_INF;
    const float nm = laneok ? -st.m : NEG_INF;
    const int dbase = tq - posb - 4 * hf;
    const unsigned w0 = m0 >> (4 * hf), w1 = m1 >> (4 * hf);
    const f32x2 c1v = {QK_C1, QK_C1}; f32x2 cbv = {cb, cb}; f32x2 ls2 = {0.f, 0.f};
#pragma unroll
    for (int i = 0; i < 16; i += 2) { const f32x2 sv = {s0[i], s0[i + 1]};
        if (NEARB) { int d0 = dbase - ((i & 3) + 8 * (i >> 2)), d1 = dbase - (((i + 1) & 3) + 8 * ((i + 1) >> 2)); const bool k0 = d0 >= 0, k1 = d1 >= 0;
            d0 = d0 > 127 ? 127 : d0; d1 = d1 > 127 ? 127 : d1; if (CAUSAL) { d0 = d0 < 0 ? 0 : d0; d1 = d1 < 0 ? 0 : d1; }
            cbv[0] = bl[d0] + nm; cbv[1] = bl[d1] + nm; if (CAUSAL) { cbv[0] = k0 ? cbv[0] : NEG_INF; cbv[1] = k1 ? cbv[1] : NEG_INF; } }
        const f32x2 av = sv * c1v + cbv;
        f32x2 pv; pv[0] = __builtin_amdgcn_exp2f(av[0]); pv[1] = __builtin_amdgcn_exp2f(av[1]);
        if (BITS) { pv[0] = __uint_as_float(__float_as_uint(pv[0]) & bitmask32(w0, (i & 3) + 8 * (i >> 2)));
                    pv[1] = __uint_as_float(__float_as_uint(pv[1]) & bitmask32(w0, ((i + 1) & 3) + 8 * ((i + 1) >> 2))); }
        s0[i] = pv[0]; s0[i + 1] = pv[1]; ls2 += pv; }
    const int rr = r;
#pragma unroll
    for (int G = 0; G < 2; ++G) { const bf16x8 pb = pack8(s0, G); const int cc = 2 * G + hf;
        const bf16x8 a0 = *(const LAS bf16x8*)(Vt + rr * 128 + ((cc ^ ((rr >> 1) & 7)) << 4)); const bf16x8 a1 = *(const LAS bf16x8*)(Vt + (32 + rr) * 128 + ((cc ^ ((rr >> 1) & 7)) << 4));
        st.o0 = MFMA32(a0, pb, st.o0); st.o1 = MFMA32(a1, pb, st.o1); }
#pragma unroll
    for (int i = 0; i < 16; i += 2) { const f32x2 sv = {s1[i], s1[i + 1]};
        if (NEARB) { int d0 = dbase - 32 - ((i & 3) + 8 * (i >> 2)), d1 = dbase - 32 - (((i + 1) & 3) + 8 * ((i + 1) >> 2)); const bool k0 = d0 >= 0, k1 = d1 >= 0;
            d0 = d0 > 127 ? 127 : d0; d1 = d1 > 127 ? 127 : d1; if (CAUSAL) { d0 = d0 < 0 ? 0 : d0; d1 = d1 < 0 ? 0 : d1; }
            cbv[0] = bl[d0] + nm; cbv[1] = bl[d1] + nm; if (CAUSAL) { cbv[0] = k0 ? cbv[0] : NEG_INF; cbv[1] = k1 ? cbv[1] : NEG_INF; } }
        const f32x2 av = sv * c1v + cbv;
        f32x2 pv; pv[0] = __builtin_amdgcn_exp2f(av[0]); pv[1] = __builtin_amdgcn_exp2f(av[1]);
        if (BITS) { pv[0] = __uint_as_float(__float_as_uint(pv[0]) & bitmask32(w1, (i & 3) + 8 * (i >> 2)));
                    pv[1] = __uint_as_float(__float_as_uint(pv[1]) & bitmask32(w1, ((i + 1) & 3) + 8 * ((i + 1) >> 2))); }
        s1[i] = pv[0]; s1[i + 1] = pv[1]; ls2 += pv; }
#pragma unroll
    for (int G = 2; G < 4; ++G) { const bf16x8 pb = pack8(s1, G & 1); const int cc = 2 * G + hf;
        const bf16x8 a0 = *(const LAS bf16x8*)(Vt + rr * 128 + ((cc ^ ((rr >> 1) & 7)) << 4)); const bf16x8 a1 = *(const LAS bf16x8*)(Vt + (32 + rr) * 128 + ((cc ^ ((rr >> 1) & 7)) << 4));
        st.o0 = MFMA32(a0, pb, st.o0); st.o1 = MFMA32(a1, pb, st.o1); }
    st.l += ls2[0] + ls2[1];
}
template <bool BITS, bool NEARB, bool CAUSAL = false, bool QB = false>
DI void far_tile(Att& st, const LAS unsigned char* Kt, const LAS unsigned char* Vt, const bf16x8 (&qf)[4], int r, int hf, float bfar, bool laneok, unsigned m0, unsigned m1,
                 int tq, int posb, const LAS float* bl) {
    f32x16 s0, s1; qk_tile<false, QB>(Kt, qf, r, hf, s0, s1);
    far_soft<BITS, NEARB, CAUSAL>(st, s0, s1, Vt, r, hf, bfar, laneok, m0, m1, tq, posb, bl);
}
template <int Q> DI void expq(f32x16& s, const f32x2 c1v, const f32x2 cbv, f32x2& ls2) {
    const f32x2 v0 = {s[4 * Q], s[4 * Q + 1]}, v1 = {s[4 * Q + 2], s[4 * Q + 3]};
    const f32x2 a0 = v0 * c1v + cbv, a1 = v1 * c1v + cbv;
    f32x2 p0, p1; p0[0] = __builtin_amdgcn_exp2f(a0[0]); p0[1] = __builtin_amdgcn_exp2f(a0[1]); p1[0] = __builtin_amdgcn_exp2f(a1[0]); p1[1] = __builtin_amdgcn_exp2f(a1[1]);
    s[4 * Q] = p0[0]; s[4 * Q + 1] = p0[1]; s[4 * Q + 2] = p1[0]; s[4 * Q + 3] = p1[1]; ls2 += p0; ls2 += p1;
}
DI void ldimg(const LAS unsigned char* xs, f32x16& s0, f32x16& s1) {
#pragma unroll
    for (int g = 0; g < 4; ++g) { const f32x4 a = *(const LAS f32x4*)(xs + g * 16), c = *(const LAS f32x4*)(xs + 64 + g * 16);
        s0[4 * g] = a[0]; s0[4 * g + 1] = a[1]; s0[4 * g + 2] = a[2]; s0[4 * g + 3] = a[3]; s1[4 * g] = c[0]; s1[4 * g + 1] = c[1]; s1[4 * g + 2] = c[2]; s1[4 * g + 3] = c[3]; }
}
DI void ldimg_g(const float* img, int lane, f32x16& s0, f32x16& s1) {
#pragma unroll
    for (int g = 0; g < 4; ++g) { const f32x4 a = *(const f32x4*)(img + g * 256 + lane * 4), c = *(const f32x4*)(img + (4 + g) * 256 + lane * 4);
        s0[4 * g] = a[0]; s0[4 * g + 1] = a[1]; s0[4 * g + 2] = a[2]; s0[4 * g + 3] = a[3]; s1[4 * g] = c[0]; s1[4 * g + 1] = c[1]; s1[4 * g + 2] = c[2]; s1[4 * g + 3] = c[3]; }
}
DI void soft_any(Att& st, f32x16& s0, f32x16& s1, const LAS unsigned char* Vt, int r, int hf, float cbx, bool laneok) {
    if (__ballot(st.m == NEG_INF) == 0ull) { far_soft<false, false>(st, s0, s1, Vt, r, hf, cbx, laneok, 0u, 0u, 0, 0, nullptr); return; }
    const float ad = laneok ? cbx : NEG_INF;
#pragma unroll
    for (int i = 0; i < 16; ++i) { s0[i] = s0[i] * QK_C1 + ad; s1[i] = s1[i] * QK_C1 + ad; }
    online_pv(st, s0, s1, Vt, r, hf);
}
template <bool CM>
DI void far_pair(Att& st, const LAS unsigned char* Ka, const LAS unsigned char* Va, const LAS unsigned char* Kb, const LAS unsigned char* Vb, const bf16x8 (&qf)[4], int r, int hf,
                 float cba, float cbb, const LAS unsigned char* xa, const LAS unsigned char* xb) {
    OPAQUE(r); OPAQUE(hf);
    const f32x16 zero16 = {0.f, 0.f, 0.f, 0.f, 0.f, 0.f, 0.f, 0.f, 0.f, 0.f, 0.f, 0.f, 0.f, 0.f, 0.f, 0.f};
    const int pr = r ^ ((r >> 3) & 1);
    const int kro = pr * 128, kx = r & 7;
    const int vro = r * 128, vx = (r >> 1) & 7;
#define KF0(K, s) (*(const LAS bf16x8*)((K) + kro + (((2 * (s) + hf) ^ kx) << 4)))
#define KF1(K, s) (*(const LAS bf16x8*)((K) + 4096 + kro + (((2 * (s) + hf) ^ kx) << 4)))
#define VF0(V, G) (*(const LAS bf16x8*)((V) + vro + (((2 * (G) + hf) ^ vx) << 4)))
#define VF1(V, G) (*(const LAS bf16x8*)((V) + 4096 + vro + (((2 * (G) + hf) ^ vx) << 4)))
    const f32x2 c1v = {QK_C1, QK_C1}, cav = {cba, cba}, cbv = {cbb, cbb}; f32x2 ls2 = {0.f, 0.f};
    f32x16 s0a, s1a, s0b, s1b;
    { bf16x8 k0[4], k1[4];
#pragma unroll
      for (int s = 0; s < 4; ++s) { k0[s] = KF0(Ka, s); k1[s] = KF1(Ka, s); }
      if (CM) { ldimg(xa, s0a, s1a); ldimg(xb, s0b, s1b); }
      __builtin_amdgcn_sched_barrier(0);
#pragma unroll
      for (int s = 0; s < 4; ++s) {
          if (s == 0 && !CM) { s0a = MFMA32(k0[0], qf[0], zero16); s1a = MFMA32(k1[0], qf[0], zero16); }
          else { s0a = MFMA32(k0[s], qf[s], s0a); s1a = MFMA32(k1[s], qf[s], s1a); } } }
    bf16x8 kb0[4], kb1[4];
#pragma unroll
    for (int s = 0; s < 4; ++s) { kb0[s] = KF0(Kb, s); kb1[s] = KF1(Kb, s); }
    bf16x8 va0[2], va1[2];
#pragma unroll
    for (int G = 0; G < 2; ++G) { va0[G] = VF0(Va, G); va1[G] = VF1(Va, G); }
    __builtin_amdgcn_sched_barrier(0);
    if (!CM) s0b = MFMA32(kb0[0], qf[0], zero16); else s0b = MFMA32(kb0[0], qf[0], s0b);
    expq<0>(s0a, c1v, cav, ls2);
    if (!CM) s1b = MFMA32(kb1[0], qf[0], zero16); else s1b = MFMA32(kb1[0], qf[0], s1b);
    expq<1>(s0a, c1v, cav, ls2);
    s0b = MFMA32(kb0[1], qf[1], s0b);
    expq<2>(s0a, c1v, cav, ls2);
    s1b = MFMA32(kb1[1], qf[1], s1b);
    expq<3>(s0a, c1v, cav, ls2);
    bf16x8 pa0 = pack8(s0a, 0), pa1 = pack8(s0a, 1);
    bf16x8 vc0[2], vc1[2];
#pragma unroll
    for (int G = 0; G < 2; ++G) { vc0[G] = VF0(Va, 2 + G); vc1[G] = VF1(Va, 2 + G); }
    __builtin_amdgcn_sched_barrier(0);
    st.o0 = MFMA32(va0[0], pa0, st.o0); s0b = MFMA32(kb0[2], qf[2], s0b);
    expq<0>(s1a, c1v, cav, ls2);
    st.o1 = MFMA32(va1[0], pa0, st.o1); s1b = MFMA32(kb1[2], qf[2], s1b);
    expq<1>(s1a, c1v, cav, ls2);
    st.o0 = MFMA32(va0[1], pa1, st.o0); s0b = MFMA32(kb0[3], qf[3], s0b);
    expq<2>(s1a, c1v, cav, ls2);
    st.o1 = MFMA32(va1[1], pa1, st.o1); s1b = MFMA32(kb1[3], qf[3], s1b);
    expq<3>(s1a, c1v, cav, ls2);
    pa0 = pack8(s1a, 0); pa1 = pack8(s1a, 1);
#pragma unroll
    for (int G = 0; G < 2; ++G) { va0[G] = VF0(Vb, G); va1[G] = VF1(Vb, G); }
    __builtin_amdgcn_sched_barrier(0);
    st.o0 = MFMA32(vc0[0], pa0, st.o0);
    expq<0>(s0b, c1v, cbv, ls2);
    st.o1 = MFMA32(vc1[0], pa0, st.o1);
    expq<1>(s0b, c1v, cbv, ls2);
    st.o0 = MFMA32(vc0[1], pa1, st.o0);
    expq<2>(s0b, c1v, cbv, ls2);
    st.o1 = MFMA32(vc1[1], pa1, st.o1);
    expq<3>(s0b, c1v, cbv, ls2);
    pa0 = pack8(s0b, 0); pa1 = pack8(s0b, 1);
#pragma unroll
    for (int G = 0; G < 2; ++G) { vc0[G] = VF0(Vb, 2 + G); vc1[G] = VF1(Vb, 2 + G); }
    __builtin_amdgcn_sched_barrier(0);
    st.o0 = MFMA32(va0[0], pa0, st.o0);
    expq<0>(s1b, c1v, cbv, ls2);
    st.o1 = MFMA32(va1[0], pa0, st.o1);
    expq<1>(s1b, c1v, cbv, ls2);
    st.o0 = MFMA32(va0[1], pa1, st.o0);
    expq<2>(s1b, c1v, cbv, ls2);
    st.o1 = MFMA32(va1[1], pa1, st.o1);
    expq<3>(s1b, c1v, cbv, ls2);
    pa0 = pack8(s1b, 0); pa1 = pack8(s1b, 1);
    __builtin_amdgcn_sched_barrier(0);
    st.o0 = MFMA32(vc0[0], pa0, st.o0); st.o1 = MFMA32(vc1[0], pa0, st.o1);
    st.o0 = MFMA32(vc0[1], pa1, st.o0); st.o1 = MFMA32(vc1[1], pa1, st.o1);
    st.l += ls2[0] + ls2[1];
#undef KF0
#undef KF1
#undef VF0
#undef VF1
}
#define LDS_BARRIER() do { asm volatile("s_waitcnt lgkmcnt(0)" ::: "memory"); __builtin_amdgcn_s_barrier(); asm volatile("" ::: "memory"); } while (0)
template <class LD, class BODY>
DI void tile_stream(int n, LAS unsigned char* buf, int tid, bool useV, LD ld, BODY body) {
    if (n <= 0) return;
    uint4 rk0, rk1 = make_uint4(0u, 0u, 0u, 0u), rv0 = make_uint4(0u, 0u, 0u, 0u), rv1 = make_uint4(0u, 0u, 0u, 0u);
    ld(0, rk0, rv0); if (n > 1) ld(1, rk1, rv1);
    st_write_K(buf, tid, rk0); if (useV) st_write_VT(buf + 8192, tid, rv0);
    if (n > 1) { st_write_K(buf + 16384, tid, rk1); if (useV) st_write_VT(buf + 24576, tid, rv1); }
    if (n > 2) ld(2, rk0, rv0); if (n > 3) ld(3, rk1, rv1);
    LDS_BARRIER();
#pragma unroll 1
    for (int i = 0; i < n; i += 2) {
        LAS unsigned char* cur = buf + ((i >> 1) & 1) * 32768;
        if (i + 2 < n) { LAS unsigned char* nxt = buf + (((i >> 1) + 1) & 1) * 32768;
            st_write_K(nxt, tid, rk0); if (useV) st_write_VT(nxt + 8192, tid, rv0);
            if (i + 3 < n) { st_write_K(nxt + 16384, tid, rk1); if (useV) st_write_VT(nxt + 24576, tid, rv1); }
            if (i + 4 < n) ld(i + 4, rk0, rv0); if (i + 5 < n) ld(i + 5, rk1, rv1); }
        body(i, cur, cur + 8192);
        if (i + 1 < n) body(i + 1, cur + 16384, cur + 24576);
        LDS_BARRIER();
    }
}
template <class LD, class BG, class BF, class BF2, class RD>
DI void tile_stream2(int n, LAS unsigned char* buf, int tid, LD ld, BG bodyG, BF bodyF, BF2 bodyF2, int ng, RD ready) {
    if (n <= 0) return;
    uint4 rk0, rk1 = make_uint4(0u, 0u, 0u, 0u), rv0 = make_uint4(0u, 0u, 0u, 0u), rv1 = make_uint4(0u, 0u, 0u, 0u);
    ld(0, rk0, rv0); if (n > 1) ld(1, rk1, rv1);
    st_write_K(buf, tid, rk0); st_write_VT(buf + 8192, tid, rv0);
    if (n > 1) { st_write_K(buf + 16384, tid, rk1); st_write_VT(buf + 24576, tid, rv1); }
    if (n > 2) ld(2, rk0, rv0); if (n > 3) ld(3, rk1, rv1);
    LDS_BARRIER();
    auto stage = [&](int i) {
        if (i + 2 < n) { LAS unsigned char* nxt = buf + (((i >> 1) + 1) & 1) * 32768;
            st_write_K(nxt, tid, rk0); st_write_VT(nxt + 8192, tid, rv0);
            if (i + 3 < n) { st_write_K(nxt + 16384, tid, rk1); st_write_VT(nxt + 24576, tid, rv1); }
            if (i + 4 < n) ld(i + 4, rk0, rv0); if (i + 5 < n) ld(i + 5, rk1, rv1); } };
    int i = 0;
#pragma unroll 1
    for (; i < n; i += 2) {
        if (i >= ng && ready()) break;
        LAS unsigned char* cur = buf + ((i >> 1) & 1) * 32768;
        stage(i);
        bodyG(i, cur, cur + 8192);
        if (i + 1 < n) bodyG(i + 1, cur + 16384, cur + 24576);
        LDS_BARRIER();
    }
#pragma unroll 1
    for (; i + 1 < n; i += 2) {
        LAS unsigned char* cur = buf + ((i >> 1) & 1) * 32768;
        stage(i);
        bodyF2(i, cur);
        LDS_BARRIER();
    }
    if (i < n) { bodyF(i, buf + ((i >> 1) & 1) * 32768, buf + ((i >> 1) & 1) * 32768 + 8192); LDS_BARRIER(); }
}
template <class LD, class BODY>
DI void tile_stream_k4(int n, LAS unsigned char* buf, int tid, LD ld, BODY body) {
    if (n <= 0) return;
    uint4 r0, r1 = make_uint4(0u, 0u, 0u, 0u), r2 = make_uint4(0u, 0u, 0u, 0u), r3 = make_uint4(0u, 0u, 0u, 0u), dv;
    ld(0, r0, dv); if (n > 1) ld(1, r1, dv); if (n > 2) ld(2, r2, dv); if (n > 3) ld(3, r3, dv);
    st_write_K(buf, tid, r0); if (n > 1) st_write_K(buf + 8192, tid, r1); if (n > 2) st_write_K(buf + 16384, tid, r2); if (n > 3) st_write_K(buf + 24576, tid, r3);
    if (n > 4) ld(4, r0, dv); if (n > 5) ld(5, r1, dv); if (n > 6) ld(6, r2, dv); if (n > 7) ld(7, r3, dv);
    LDS_BARRIER();
#pragma unroll 1
    for (int i = 0; i < n; i += 4) {
        LAS unsigned char* cur = buf + ((i >> 2) & 1) * 32768;
        if (i + 4 < n) { LAS unsigned char* nxt = buf + (((i >> 2) + 1) & 1) * 32768;
            st_write_K(nxt, tid, r0); if (i + 5 < n) st_write_K(nxt + 8192, tid, r1); if (i + 6 < n) st_write_K(nxt + 16384, tid, r2); if (i + 7 < n) st_write_K(nxt + 24576, tid, r3);
            if (i + 8 < n) ld(i + 8, r0, dv); if (i + 9 < n) ld(i + 9, r1, dv); if (i + 10 < n) ld(i + 10, r2, dv); if (i + 11 < n) ld(i + 11, r3, dv); }
#pragma unroll 1
        for (int j = 0; j < 4; ++j) if (i + j < n) body(i + j, cur + j * 8192, cur);
        LDS_BARRIER();
    }
}
DI uint4 cvt8_f32(const float* p) { const f32x4 a = *(const f32x4*)p, b = *(const f32x4*)(p + 4); uint4 o; o.x = pack2(a[0], a[1]); o.y = pack2(a[2], a[3]); o.z = pack2(b[0], b[1]); o.w = pack2(b[2], b[3]); return o; }

DI unsigned wave_max_u32(unsigned x) {
#define WMX_DPP(v, ctrl, rmask) (unsigned)__builtin_amdgcn_update_dpp(0, (int)(v), (ctrl), (rmask), 0xF, true)
    unsigned y;
    y = WMX_DPP(x, 0x111, 0xF); x = x > y ? x : y;
    y = WMX_DPP(x, 0x112, 0xF); x = x > y ? x : y;
    y = WMX_DPP(x, 0x114, 0xF); x = x > y ? x : y;
    y = WMX_DPP(x, 0x118, 0xF); x = x > y ? x : y;
    y = WMX_DPP(x, 0x142, 0xA); x = x > y ? x : y;
    y = WMX_DPP(x, 0x143, 0xC); x = x > y ? x : y;
#undef WMX_DPP
    return (unsigned)__builtin_amdgcn_readlane((int)x, 63);
}
DI void nsa_unit(const Frame& F, int b, int g, int qb) {
    int tid_ = F.tid; OPAQUE(tid_);
    const int tid = tid_, lane = tid & 63, w = F.wave, r = lane & 31, hf = lane >> 5;
    LAS unsigned char* L = F.ldsl;
    LAS unsigned char* buf = L + AT_BUF;
    LAS float* psum = (LAS float*)(L + AT_PSUM);
    LAS unsigned long long* selm = (LAS unsigned long long*)(L + AT_SELM);
    LAS unsigned char* tlist = L + AT_SELM + 528;
    LAS int* tcnt = (LAS int*)(L + AT_SELM + 520);
    const bf16_t* U = (const bf16_t*)(F.ws + WS_U);
    const float* KC = (const float*)(F.ws + WS_KCMP) + (size_t)(b * 2 + g) * 256 * 64;
    const bf16_t* VCT = (const bf16_t*)(F.ws + WS_VCT) + (size_t)(b * 2 + g) * 64 * 256;
    const bf16_t* VT = (const bf16_t*)(F.ws + WS_VT);
    bf16_t* Y = (bf16_t*)(F.ws + WS_BFB);
    const int t0 = qb * 64;
    const int ql = r >> 2, h = r & 3, hh = g * 4 + h;
    const int tq = t0 + 8 * w + ql;
    const size_t row = (size_t)b * SEQ + tq;
    const bf16_t* Ur = U + row * LD0;
    bf16x8 qf[4];
#pragma unroll
    for (int s = 0; s < 4; ++s) qf[s] = *(const bf16x8*)(Ur + C_AQ + hh * 64 + 16 * s + 8 * hf);
    const LAS float* bl = F.biasL + hh * 128; const float bfar = bl[127];
    float gate[3];
    { const unsigned* gp = (const unsigned*)(Ur + C_AG);
#pragma unroll
      for (int j = 0; j < 3; ++j) { const int e = hh * 3 + j; const unsigned wv = gp[e >> 1]; gate[j] = sigmoidf_((e & 1) ? __uint_as_float(wv & 0xFFFF0000u) : __uint_as_float(wv << 16)); } }
    LAS float* opark = psum + w * 2048 + lane;

    const int nvmax = ((t0 + 63 - 31) >> 4) + 1;
    const int ntc = (nvmax + 63) >> 6;
    for (int e = tid; e < 64 * 256; e += 512) psum[e] = 0.f;
    float cm = NEG_INF, cl = 0.f;
    {
#pragma unroll 1
        for (int i = 0; i < ntc; ++i) { const int key = tid >> 3, c = tid & 7;
            const uint4 rk = cvt8_f32(KC + (size_t)(i * 64 + key) * 64 + c * 8); const uint4 rv = *(const uint4*)(VCT + (size_t)key * 256 + i * 64 + c * 8);
            st_write_K(buf + i * 8192, tid, rk); st_write_VT(buf + 32768 + i * 8192, tid, rv); }
        __syncthreads();
        auto body = [&](int i, LAS unsigned char* Kt, LAS unsigned char* Vt) { (void)Vt;
            f32x16 s0, s1; qk_tile(Kt, qf, r, hf, s0, s1);
            if (16 * (i * 64 + 63) + 31 + 113 <= t0 + 8 * w) { fix_scores<0>(s0, 0, 16, tq, bl, bfar, 0u, true, hf); fix_scores<0>(s1, 0, 16, tq, bl, bfar, 0u, true, hf); }
            else { fix_scores<FL_NEAR | FL_CAUSAL>(s0, 16 * (i * 64) + 31, 16, tq, bl, bfar, 0u, true, hf); fix_scores<FL_NEAR | FL_CAUSAL>(s1, 16 * (i * 64 + 32) + 31, 16, tq, bl, bfar, 0u, true, hf); }
            float tm = NEG_INF;
#pragma unroll
            for (int k = 0; k < 16; ++k) tm = fmaxf(tm, fmaxf(s0[k], s1[k]));
            tm = fmaxf(tm, __shfl_xor(tm, 32));
            const float mn = fmaxf(cm, tm); const float mu = (mn == NEG_INF) ? 0.f : mn;
            float ls = 0.f;
#pragma unroll
            for (int k = 0; k < 16; ++k) ls += __builtin_amdgcn_exp2f(s0[k] - mu) + __builtin_amdgcn_exp2f(s1[k] - mu);
            cl = cl * __builtin_amdgcn_exp2f(cm - mu) + ls; cm = mn; };
#pragma unroll 1
        for (int i = 0; i < ntc; ++i) body(i, buf + i * 8192, buf + 32768 + i * 8192);
    }
    f32x16 c0, c1;
    {
        cl += __shfl_xor(cl, 32);
        const float cinv = cl > 0.f ? 1.0f / cl : 0.f; const float cmu = (cm == NEG_INF) ? 0.f : cm;
#pragma unroll
        for (int i = 0; i < 16; ++i) { c0[i] = 0.f; c1[i] = 0.f; }
        auto body = [&](int i, LAS unsigned char* Kt, LAS unsigned char* Vt) {
            f32x16 s0, s1; qk_tile(Kt, qf, r, hf, s0, s1);
            if (16 * (i * 64 + 63) + 31 + 113 <= t0 + 8 * w) { fix_scores<0>(s0, 0, 16, tq, bl, bfar, 0u, true, hf); fix_scores<0>(s1, 0, 16, tq, bl, bfar, 0u, true, hf); }
            else { fix_scores<FL_NEAR | FL_CAUSAL>(s0, 16 * (i * 64) + 31, 16, tq, bl, bfar, 0u, true, hf); fix_scores<FL_NEAR | FL_CAUSAL>(s1, 16 * (i * 64 + 32) + 31, 16, tq, bl, bfar, 0u, true, hf); }
#pragma unroll
            for (int k = 0; k < 16; ++k) { s0[k] = __builtin_amdgcn_exp2f(s0[k] - cmu) * cinv; s1[k] = __builtin_amdgcn_exp2f(s1[k] - cmu) * cinv; }
#pragma unroll
            for (int k = 0; k < 16; ++k) {
                float a0 = s0[k], a1 = s1[k];
                a0 += __shfl_xor(a0, 1); a0 += __shfl_xor(a0, 2); a1 += __shfl_xor(a1, 1); a1 += __shfl_xor(a1, 2);
                const int koff = (k & 3) + 8 * (k >> 2) + 4 * hf;
                if (h == 0) { psum[(8 * w + ql) * 256 + i * 64 + koff] = a0; psum[(8 * w + ql) * 256 + i * 64 + 32 + koff] = a1; }
            }
            pv_tile(Vt, s0, s1, r, hf, c0, c1); };
#pragma unroll 1
        for (int i = 0; i < ntc; ++i) body(i, buf + i * 8192, buf + 32768 + i * 8192);
        __syncthreads();
    }
    {
        const int cur = qb; const int npick = (cur + 1) < 8 ? (cur + 1) : 8;
#pragma unroll 1
        for (int q = 0; q < 8; ++q) {
            const LAS float* pr = psum + (8 * w + q) * 256;
            float imp = 0.f;
            const int i0 = 4 * lane - 1 < 0 ? 0 : 4 * lane - 1, i1 = 4 * lane + 3 > 254 ? 254 : 4 * lane + 3;
            for (int i = i0; i <= i1; ++i) imp += pr[i];
            const bool adm = lane <= cur; const bool forced = (lane == 0) || (lane == cur) || (lane == cur - 1);
            const float score = imp + (forced ? 1.0e4f : 0.f);
            unsigned key = adm ? ((__float_as_uint(score) & ~63u) | (unsigned)(63 - lane)) : 0u;
            unsigned long long sm = 0ull;
#pragma unroll 1
            for (int t = 0; t < npick; ++t) {
                const unsigned m = wave_max_u32(key);
                const bool sel = (key == m) && adm;
                sm |= __ballot(sel);
                key = sel ? 0u : key;
            }
            if (lane == 0) selm[8 * w + q] = sm;
        }
    }
    __syncthreads();
    if (w == 0) {
        unsigned long long m = selm[lane];
        unsigned lo = (unsigned)m, hi = (unsigned)(m >> 32);
        for (int o = 32; o >= 1; o >>= 1) { lo |= __shfl_xor(lo, o); hi |= __shfl_xor(hi, o); }
        const unsigned long long un = ((unsigned long long)hi << 32) | lo;
        const bool mine = (un >> lane) & 1ull;
        const int pos = __popcll(un & ((1ull << lane) - 1ull));
        if (mine) tlist[pos] = (unsigned char)lane;
        if (lane == 0) { tcnt[0] = __popcll(un); tcnt[1] = qb > 2 ? __popcll(un & ((1ull << (qb - 2)) - 1ull)) : 0; }
    }
    __syncthreads();
#pragma unroll
    for (int i = 0; i < 16; ++i) { opark[i * 64] = gate[0] * c0[i]; opark[(16 + i) * 64] = gate[0] * c1[i]; }
    const unsigned long long mysel = selm[8 * w + ql];
    {
        Att st; att_init(st);
        const int nts = tcnt[0];
        const int nfar = tcnt[1], nnear = nts - nfar;
        auto tileof = [&](int p) { return (int)tlist[p < nnear ? nfar + p : p - nnear]; };
        auto lds_ = [&](int p, uint4& rk, uint4& rv) { const int j = tileof(p); int t_ = tid; OPAQUE(t_); const int key = t_ >> 3, c = t_ & 7;
            const bf16_t* pp = U + ((size_t)b * SEQ + j * 64 + key) * LD0 + g * 64 + c * 8; rk = *(const uint4*)(pp + C_KS); rv = *(const uint4*)(VT + (size_t)(g * 64 + key) * MT + (size_t)b * SEQ + j * 64 + c * 8); };
        const float* imgn = (const float*)(F.ws + WS_IMGN) + (size_t)((g * 3) * 8 + w) * 2048; const float* imgz = (const float*)(F.ws + WS_IMGZ);
        auto body = [&](int p, LAS unsigned char* Kt, LAS unsigned char* Vt) {
            const int j = tileof(p);
            const bool laneok = (mysel >> j) & 1ull;
            if (__ballot(laneok) == 0ull) return;
            const int dl = qb - j; const bool near = dl < 3;
            f32x16 s0, s1;
            ldimg_g(near ? imgn + (size_t)dl * 16384 : imgz, lane, s0, s1);
            qk_tile<true>(Kt, qf, r, hf, s0, s1);
            soft_any(st, s0, s1, Vt, r, hf, near ? 0.f : bfar, laneok); };
        auto bodyF = [&](int p, LAS unsigned char* Kt, LAS unsigned char* Vt) {
            const int j = tlist[p - nnear];
            const bool laneok = (mysel >> j) & 1ull;
            if (__ballot(laneok) == 0ull) return;
            far_tile<false, false, false, true>(st, Kt, Vt, qf, r, hf, bfar, laneok, 0u, 0u, tq, j * 64, bl); };
        auto bodyF2 = [&](int p, LAS unsigned char* cur) {
            const int ja = tlist[p - nnear], jb = tlist[p + 1 - nnear];
            const float cba = ((mysel >> ja) & 1ull) ? bfar - st.m : NEG_INF, cbb = ((mysel >> jb) & 1ull) ? bfar - st.m : NEG_INF;
            far_pair<false>(st, cur, cur + 8192, cur + 16384, cur + 24576, qf, r, hf, cba, cbb, nullptr, nullptr); };
        tile_stream2(nts, buf, tid, lds_, body, bodyF, bodyF2, nnear, [&]() { return __ballot(st.m == NEG_INF) == 0ull; });
        float l = st.l + __shfl_xor(st.l, 32);
        const float sc = l > 0.f ? gate[1] / l : 0.f;
#pragma unroll
        for (int i = 0; i < 16; ++i) { opark[i * 64] += sc * st.o0[i]; opark[(16 + i) * 64] += sc * st.o1[i]; }
    }
    {
        Att st; att_init(st);
        const int j0 = qb - 8 < 0 ? 0 : qb - 8; const int ntw = qb - j0 + 1;
        const int hasw = qb >= 8 ? 1 : 0, gs = (qb - 2 > j0 + hasw) ? qb - 2 : j0 + hasw, ngw = hasw + (qb - gs + 1), f0 = j0 + hasw;
        auto tileof = [&](int p) { return p < ngw ? ((hasw && p == 0) ? j0 : gs + p - hasw) : f0 + (p - ngw); };
        auto ldw = [&](int p, uint4& rk, uint4& rv) { const int j = tileof(p); int t_ = tid; OPAQUE(t_); const int key = t_ >> 3, c = t_ & 7;
            const bf16_t* pp = U + ((size_t)b * SEQ + j * 64 + key) * LD0 + g * 64 + c * 8; rk = *(const uint4*)(pp + C_KW); rv = *(const uint4*)(VT + (size_t)(128 + g * 64 + key) * MT + (size_t)b * SEQ + j * 64 + c * 8); };
        const float* imgn = (const float*)(F.ws + WS_IMGN) + (size_t)((g * 3) * 8 + w) * 2048; const float* imgz = (const float*)(F.ws + WS_IMGZ); const float* imgw = (const float*)(F.ws + WS_IMGW) + (size_t)w * 2048;
        auto body = [&](int p, LAS unsigned char* Kt, LAS unsigned char* Vt) {
            const int j = tileof(p);
            const int dl = qb - j; const bool near = dl < 3;
            f32x16 s0, s1;
            ldimg_g(near ? imgn + (size_t)dl * 16384 : (dl == 8 ? imgw : imgz), lane, s0, s1);
            qk_tile<true>(Kt, qf, r, hf, s0, s1);
            soft_any(st, s0, s1, Vt, r, hf, near ? 0.f : bfar, true); };
        auto bodyF = [&](int p, LAS unsigned char* Kt, LAS unsigned char* Vt) { far_tile<false, false, false, true>(st, Kt, Vt, qf, r, hf, bfar, true, 0u, 0u, tq, (f0 + p - ngw) * 64, bl); };
        auto bodyF2 = [&](int p, LAS unsigned char* cur) { (void)p; far_pair<false>(st, cur, cur + 8192, cur + 16384, cur + 24576, qf, r, hf, bfar - st.m, bfar - st.m, nullptr, nullptr); };
        tile_stream2(ntw, buf, tid, ldw, body, bodyF, bodyF2, ngw, [&]() { return __ballot(st.m == NEG_INF) == 0ull; });
        float l = st.l + __shfl_xor(st.l, 32);
        const float sc = l > 0.f ? gate[2] / l : 0.f;
#pragma unroll
        for (int i = 0; i < 16; ++i) { c0[i] = opark[i * 64] + sc * st.o0[i]; c1[i] = opark[(16 + i) * 64] + sc * st.o1[i]; }
    }
#pragma unroll
    for (int dh = 0; dh < 2; ++dh)
#pragma unroll
        for (int k = 0; k < 4; ++k) {
            const int d = 32 * dh + 8 * k + 4 * hf;
            const uint2 zz = *(const uint2*)(Ur + C_AZ + hh * 64 + d);
            const float z0 = __uint_as_float(zz.x << 16), z1 = __uint_as_float(zz.x & 0xFFFF0000u), z2 = __uint_as_float(zz.y << 16), z3 = __uint_as_float(zz.y & 0xFFFF0000u);
            const f32x16& o = dh ? c1 : c0;
            uint2 pk; pk.x = pack2(o[4 * k + 0] * siluf_(z0), o[4 * k + 1] * siluf_(z1)); pk.y = pack2(o[4 * k + 2] * siluf_(z2), o[4 * k + 3] * siluf_(z3));
            *(uint2*)(Y + row * 1024 + hh * 64 + d) = pk;
        }
    __syncthreads();
}

DI unsigned short okey16(float x) {
    const _Float16 hx = (_Float16)x; unsigned short u = __builtin_bit_cast(unsigned short, hx);
    if ((u & 0x7FFFu) == 0u) u = 0u;
    return (u & 0x8000u) ? (unsigned short)~u : (unsigned short)(u | 0x8000u);
}
DI void dsa_unit(const Frame& F, int b, int qt) {
    int tid_ = F.tid; OPAQUE(tid_);
    const int tid = tid_, lane = tid & 63, w = F.wave, r = lane & 31, hf = lane >> 5, fr = lane & 15, fq = lane >> 4;
    LAS unsigned char* L = F.ldsl;
    LAS unsigned char* buf = L + AT_BUF;
    LAS unsigned* mask = (LAS unsigned*)(L + AT_PSUM);
    const bf16_t* U = (const bf16_t*)(F.ws + WS_U);
    bf16_t* Y = (bf16_t*)(F.ws + WS_BFB);
    const bf16_t* VT = (const bf16_t*)(F.ws + WS_VT);
    unsigned short* KS = (unsigned short*)(F.ws + WS_BFA) + (size_t)F.bid * 32 * 4096;
    const int t0 = qt * 32;
    const int nt = ((t0 + 31) >> 6) + 1;
    {
        bf16x8 qi[2]; float wi[4];
        { const bf16_t* Uq = U + ((size_t)b * SEQ + t0 + 4 * w + (fr >> 2)) * LD0;
#pragma unroll
          for (int ks = 0; ks < 2; ++ks) qi[ks] = *(const bf16x8*)(Uq + C_BQI + (fr & 3) * 64 + 32 * ks + 8 * fq);
          const uint2 wv = *(const uint2*)(U + ((size_t)b * SEQ + t0 + 4 * w + fq) * LD0 + C_BWI);
          wi[0] = __uint_as_float(wv.x << 16) * 0.0625f; wi[1] = __uint_as_float(wv.x & 0xFFFF0000u) * 0.0625f; wi[2] = __uint_as_float(wv.y << 16) * 0.0625f; wi[3] = __uint_as_float(wv.y & 0xFFFF0000u) * 0.0625f; }
        const int tqi = t0 + 4 * w + fq;
        auto ldi = [&](int i, uint4& rk, uint4& rv) { const int key = tid >> 3, c = tid & 7; rk = *(const uint4*)(U + ((size_t)b * SEQ + i * 64 + key) * LD0 + C_BKI + c * 8); (void)rv; };
        auto body = [&](int i, LAS unsigned char* Kt, LAS unsigned char* Vt) { (void)Vt;
#pragma unroll
            for (int kg = 0; kg < 4; ++kg) {
                const int kk = 16 * kg + fr;
                f32x4 acc = {0.f, 0.f, 0.f, 0.f};
#pragma unroll
                for (int ks = 0; ks < 2; ++ks) { const int c = 4 * ks + fq;
                    const bf16x8 kb = *(const LAS bf16x8*)(Kt + (kk ^ ((kk >> 3) & 1)) * 128 + ((c ^ (kk & 7)) << 4));
                    acc = __builtin_amdgcn_mfma_f32_16x16x32_bf16(qi[ks], kb, acc, 0, 0, 0); }
                const float sc = wi[0] * fmaxf(acc[0], 0.f) + wi[1] * fmaxf(acc[1], 0.f) + wi[2] * fmaxf(acc[2], 0.f) + wi[3] * fmaxf(acc[3], 0.f);
                const int pos = i * 64 + kk;
                KS[(size_t)(4 * w + fq) * 4096 + pos] = pos <= tqi ? okey16(sc) : (unsigned short)0;
            } };
        tile_stream_k4(nt, buf, tid, ldi, body);
    }
    asm volatile("s_waitcnt vmcnt(0)" ::: "memory");
    __syncthreads();
    __builtin_amdgcn_fence(__ATOMIC_ACQUIRE, "agent");
    asm volatile("s_waitcnt vmcnt(0)" ::: "memory");
    {
    LAS unsigned char* maskb = (LAS unsigned char*)mask;
    unsigned Tn[32];
    auto ldkeys = [&](int q) { const int qq = 4 * w + q; const int nk = t0 + qq + 1; int ln = lane; OPAQUE(ln); const unsigned short* kq = KS + (size_t)qq * 4096 + ln * 8;
#pragma unroll
        for (int c = 0; c < 8; ++c) { uint4 kv = make_uint4(0u, 0u, 0u, 0u); if (c * 512 < nk) kv = *(const uint4*)(kq + c * 512);
            Tn[4 * c] = kv.x; Tn[4 * c + 1] = kv.y; Tn[4 * c + 2] = kv.z; Tn[4 * c + 3] = kv.w; } };
    ldkeys(0);
#pragma unroll 1
    for (int q = 0; q < 4; ++q) {
        const int qq = 4 * w + q; const int tqq = t0 + qq; const int nk = tqq + 1;
        unsigned T[32];
#pragma unroll
        for (int e = 0; e < 32; ++e) T[e] = Tn[e];
        if (q < 3) ldkeys(q + 1);
        if (nk <= 256) {
#pragma unroll
            for (int c = 0; c < 8; ++c) { unsigned selb = 0u;
#pragma unroll
                for (int e = 0; e < 8; ++e) if (c * 512 + lane * 8 + e < nk) selb |= 1u << e;
                maskb[qq * 512 + c * 64 + lane] = (unsigned char)selb; }
            continue;
        }
#pragma unroll
        for (int e = 0; e < 32; ++e) { const int idx = (e >> 2) * 512 + lane * 8 + (e & 3) * 2;
            unsigned lo = T[e] & 0xFFFFu, hi = T[e] >> 16; if (idx >= nk) lo = 0u; if (idx + 1 >= nk) hi = 0u; T[e] = lo | (hi << 16); }
#pragma unroll
        for (int st = 0; st < 5; ++st) { const int j = 16 >> st; const unsigned m = st == 0 ? 0x0000FFFFu : st == 1 ? 0x00FF00FFu : st == 2 ? 0x0F0F0F0Fu : st == 3 ? 0x33333333u : 0x55555555u;
#pragma unroll
            for (int k0 = 0; k0 < 32; k0 += 2 * j)
#pragma unroll
                for (int i = 0; i < j; ++i) { const int k = k0 + i; const unsigned t = ((T[k] >> j) ^ T[k + j]) & m; T[k] ^= (t << j); T[k + j] ^= t; } }
        unsigned ce = 0xFFFFFFFFu, co = 0xFFFFFFFFu, ge = 0u, go = 0u; int above = 0;
#pragma unroll
        for (int bit = 15; bit >= 0; --bit) {
            const unsigned oe = ce & T[bit], oo = co & T[16 + bit];
            const int cnt = __popc(oe) + __popc(oo);
            int tot = 0;
#pragma unroll
            for (int bb = 0; bb < 7; ++bb) tot += __popcll(__ballot((cnt >> bb) & 1)) << bb;
            if (above + tot >= 256) { ce = oe; co = oo; }
            else { above += tot; ge |= oe; go |= oo; ce &= ~T[bit]; co &= ~T[16 + bit]; }
        }
        const int quota = 256 - above; int taken = 0;
#pragma unroll
        for (int c = 0; c < 8; ++c) {
            unsigned xe = (ge >> (4 * c)) & 0xFu, xo = (go >> (4 * c)) & 0xFu;
            xe = (xe | (xe << 2)) & 0x33u; xe = (xe | (xe << 1)) & 0x55u; xo = (xo | (xo << 2)) & 0x33u; xo = (xo | (xo << 1)) & 0x55u;
            unsigned selb = xe | (xo << 1);
            unsigned ye = (ce >> (4 * c)) & 0xFu, yo = (co >> (4 * c)) & 0xFu;
            ye = (ye | (ye << 2)) & 0x33u; ye = (ye | (ye << 1)) & 0x55u; yo = (yo | (yo << 2)) & 0x33u; yo = (yo | (yo << 1)) & 0x55u;
            const unsigned eqb = ye | (yo << 1);
            if (__ballot(eqb != 0u) != 0ull) {
                const int ne = __popc(eqb);
                int excl = 0, totc = 0;
#pragma unroll
                for (int bb = 0; bb < 4; ++bb) { const unsigned long long bl_ = __ballot((ne >> bb) & 1);
                    excl += (int)__builtin_amdgcn_mbcnt_hi((unsigned)(bl_ >> 32), __builtin_amdgcn_mbcnt_lo((unsigned)bl_, 0u)) << bb; totc += __popcll(bl_) << bb; }
                int rank = taken + excl;
#pragma unroll
                for (int e = 0; e < 8; ++e) if ((eqb >> e) & 1u) { if (rank < quota) selb |= 1u << e; ++rank; }
                taken += totc;
            }
            maskb[qq * 512 + c * 64 + lane] = (unsigned char)selb;
        }
    }
    }
    __syncthreads();
    {
        const int ql = r >> 3, h = r & 7;
        const int tq = t0 + 4 * w + ql;
        const size_t row = (size_t)b * SEQ + tq;
        const bf16_t* Ur = U + row * LD0;
        bf16x8 qf[4];
#pragma unroll
        for (int s = 0; s < 4; ++s) qf[s] = *(const bf16x8*)(Ur + C_BQ + h * 64 + 16 * s + 8 * hf);
        const LAS float* bl = F.biasL + (8 + h) * 128; const float bfar = bl[127];
        const LAS unsigned* mq = mask + (4 * w + ql) * 128;
        LAS unsigned char* xmw = L + AT_XM + w * 2304 + ql * 272 + hf * 128;
        const int nnear = nt < 4 ? nt : 4;
        auto tileof = [&](int p) { return p < nnear ? nt - nnear + p : p - nnear; };
        auto expand = [&](int p) { const int i = tileof(p);
            const unsigned nib = (~mq[2 * i + (h >> 2)]) >> (8 * (h & 3) + 4 * hf);
            u32x4 v; v[0] = bitmask32(nib, 0) & 0xFF800000u; v[1] = bitmask32(nib, 1) & 0xFF800000u; v[2] = bitmask32(nib, 2) & 0xFF800000u; v[3] = bitmask32(nib, 3) & 0xFF800000u;
            *(LAS u32x4*)(xmw + (p & 1) * 1152 + h * 16) = v; };
        expand(0);
        Att st; att_init(st);
        auto lda = [&](int p, uint4& rk, uint4& rv) { const int i = tileof(p); int t_ = tid; OPAQUE(t_); const int key = t_ >> 3, c = t_ & 7;
            const bf16_t* pp = U + ((size_t)b * SEQ + i * 64 + key) * LD0 + c * 8; rk = *(const uint4*)(pp + C_BK); rv = *(const uint4*)(VT + (size_t)(256 + key) * MT + (size_t)b * SEQ + i * 64 + c * 8); };
        const float* imgd = (const float*)(F.ws + WS_IMGD) + (size_t)(((qt & 1) * 4) * 8 + w) * 2048; const float* imgz = (const float*)(F.ws + WS_IMGZ);
        auto body = [&](int p, LAS unsigned char* Kt, LAS unsigned char* Vt) { const int i = tileof(p);
            const int dl = nt - 1 - i; const bool near = dl < 4;
            f32x16 s0, s1, b0, b1;
            ldimg_g(near ? imgd + (size_t)dl * 16384 : imgz, lane, b0, b1);
            ldimg(xmw + (p & 1) * 1152, s0, s1);
            if (p + 1 < nt) expand(p + 1);
            s0 += b0; s1 += b1;
            qk_tile<true>(Kt, qf, r, hf, s0, s1);
            soft_any(st, s0, s1, Vt, r, hf, near ? 0.f : bfar, true); };
        auto bodyF = [&](int p, LAS unsigned char* Kt, LAS unsigned char* Vt) { const int i = p - nnear;
            f32x16 s0, s1;
            { const LAS unsigned char* xs = xmw + (p & 1) * 1152;
#pragma unroll
              for (int g = 0; g < 4; ++g) { const f32x4 a = *(const LAS f32x4*)(xs + g * 16), c = *(const LAS f32x4*)(xs + 64 + g * 16);
                  s0[4 * g] = a[0]; s0[4 * g + 1] = a[1]; s0[4 * g + 2] = a[2]; s0[4 * g + 3] = a[3]; s1[4 * g] = c[0]; s1[4 * g + 1] = c[1]; s1[4 * g + 2] = c[2]; s1[4 * g + 3] = c[3]; } }
            if (p + 1 < nt) expand(p + 1);
            qk_tile<true, true>(Kt, qf, r, hf, s0, s1);
            far_soft<false, false>(st, s0, s1, Vt, r, hf, bfar, true, 0u, 0u, tq, i * 64, bl); };
        auto bodyF2 = [&](int p, LAS unsigned char* cur) {
            expand(p + 1);
            far_pair<true>(st, cur, cur + 8192, cur + 16384, cur + 24576, qf, r, hf, bfar - st.m, bfar - st.m, xmw, xmw + 1152);
            if (p + 2 < nt) expand(p + 2); };
        tile_stream2(nt, buf, tid, lda, body, bodyF, bodyF2, nnear, [&]() { return __ballot(st.m == NEG_INF) == 0ull; });
        float l = st.l + __shfl_xor(st.l, 32);
        const float sc = l > 0.f ? 1.0f / l : 0.f;
#pragma unroll
        for (int dh = 0; dh < 2; ++dh)
#pragma unroll
            for (int k = 0; k < 4; ++k) {
                const int d = 32 * dh + 8 * k + 4 * hf;
                const uint2 zz = *(const uint2*)(Ur + C_BZ + h * 64 + d);
                const float z0 = __uint_as_float(zz.x << 16), z1 = __uint_as_float(zz.x & 0xFFFF0000u), z2 = __uint_as_float(zz.y << 16), z3 = __uint_as_float(zz.y & 0xFFFF0000u);
                const f32x16& o = dh ? st.o1 : st.o0;
                uint2 pk; pk.x = pack2(o[4 * k + 0] * sc * siluf_(z0), o[4 * k + 1] * sc * siluf_(z1)); pk.y = pack2(o[4 * k + 2] * sc * siluf_(z2), o[4 * k + 3] * sc * siluf_(z3));
                *(uint2*)(Y + row * 1024 + 512 + h * 64 + d) = pk;
            }
    }
    __syncthreads();
}

DI void att_dsa(const Frame& F) {
    LAS int* ub = (LAS int*)(F.ldsl + AT_MISC);
    unsigned* qd = F.ctl + CW_QDSA;
    const int NDSA = NB * (SEQ / 32);
    __syncthreads();
    if (F.tid == 0) ub[0] = (int)__hip_atomic_fetch_add(qd, 1u, __ATOMIC_RELAXED, __HIP_MEMORY_SCOPE_AGENT);
    for (;;) {
        __syncthreads();
        const int k = ub[0];
        __syncthreads();
        if (k >= NDSA) break;
        int nxt = 0; if (F.tid == 0) nxt = (int)__hip_atomic_fetch_add(qd, 1u, __ATOMIC_RELAXED, __HIP_MEMORY_SCOPE_AGENT);
        dsa_unit(F, k & 7, (SEQ / 32) - 1 - (k >> 3));
        if (F.tid == 0) ub[0] = nxt;
    }
}
DI void att_nsa(const Frame& F) {
    LAS int* ub = (LAS int*)(F.ldsl + AT_MISC);
    unsigned* qn = F.ctl + CW_QNSA;
    const int NNSA = NB * 2 * (SEQ / 64);
    __syncthreads();
    if (F.tid == 0) ub[0] = (int)__hip_atomic_fetch_add(qn, 1u, __ATOMIC_RELAXED, __HIP_MEMORY_SCOPE_AGENT);
    for (;;) {
        __syncthreads();
        const int k = ub[0];
        __syncthreads();
        if (k >= NNSA) break;
        int nxt = 0; if (F.tid == 0) nxt = (int)__hip_atomic_fetch_add(qn, 1u, __ATOMIC_RELAXED, __HIP_MEMORY_SCOPE_AGENT);
        const int bg = k & 15;
        nsa_unit(F, bg >> 1, bg & 1, 63 - (k >> 4));
        if (F.tid == 0) ub[0] = nxt;
    }
}

DI f32x4 mma16(const bf16_t* A, int lda, const bf16_t* Bt, int ldb, int K, int lane) {
    const int fr = lane & 15, fq = lane >> 4;
    f32x4 acc = {0.f, 0.f, 0.f, 0.f};
    for (int k = 0; k < K; k += 32) {
        const bf16x8 a = *(const bf16x8*)(A + fr * lda + k + fq * 8);
        const bf16x8 b = *(const bf16x8*)(Bt + fr * ldb + k + fq * 8);
        acc = __builtin_amdgcn_mfma_f32_16x16x32_bf16(a, b, acc, 0, 0, 0);
    }
    return acc;
}
DI void conv8(const bf16_t* U1, int b, int t, int col, const float* cw  , int nch, const float* cb, float (&y)[8]) {
#pragma unroll
    for (int i = 0; i < 8; ++i) y[i] = cb[i];
#pragma unroll
    for (int j = 0; j < 4; ++j) { const int tt = t - 3 + j;
        if (tt >= 0) { const uint4 v = *(const uint4*)(U1 + ((size_t)b * SEQ + tt) * LD1 + col); float f[8]; unpack8(v, f);
#pragma unroll
            for (int i = 0; i < 8; ++i) y[i] += cw[(size_t)j * nch + i] * f[i]; } }
}
DI void stage_raw128(const Frame& F, const bf16_t* U1, int b, int t_first, int nrows, int col, bf16_t* raw) {
    for (int it = F.tid; it < nrows * 16; it += 512) { const int row = it >> 4, ch = it & 15; const int t = t_first + row;
        uint4 v = make_uint4(0u, 0u, 0u, 0u); if (t >= 0) v = *(const uint4*)(U1 + ((size_t)b * SEQ + t) * LD1 + col + ch * 8);
        *(uint4*)(raw + row * 136 + ch * 8) = v; }
}
DI void load_raw128(const Frame& F, const bf16_t* U1, int b, int t_first, int nrows, int col, uint4 (&rg)[3]) {
#pragma unroll
    for (int j = 0; j < 3; ++j) { const int it = F.tid + j * 512; const int row = it >> 4, ch = it & 15; const int t = t_first + row;
        rg[j] = make_uint4(0u, 0u, 0u, 0u); if (it < nrows * 16 && t >= 0) rg[j] = *(const uint4*)(U1 + ((size_t)b * SEQ + t) * LD1 + col + ch * 8); }
}
DI void write_raw128(const Frame& F, int nrows, const uint4 (&rg)[3], bf16_t* raw) {
#pragma unroll
    for (int j = 0; j < 3; ++j) { const int it = F.tid + j * 512; const int row = it >> 4, ch = it & 15; if (it < nrows * 16) *(uint4*)(raw + row * 136 + ch * 8) = rg[j]; }
}
DI void conv8_lds(const bf16_t* raw, int s, int d0, const float* cw  , const float* cb  , float (&y)[8]) {
#pragma unroll
    for (int i = 0; i < 8; ++i) y[i] = cb[d0 + i];
#pragma unroll
    for (int j = 0; j < 4; ++j) { const uint4 v = *(const uint4*)(raw + (s + j) * 136 + d0); float f[8]; unpack8(v, f);
#pragma unroll
        for (int i = 0; i < 8; ++i) y[i] += cw[j * 128 + d0 + i] * f[i]; }
}
DI void mlstm_gates(const Frame& F, const bf16_t* U1, int b, int h, int c, float* li, float* bc) {
    if (F.wave == 0) {
        const size_t row = (size_t)b * SEQ + c * 64 + F.lane;
        const float* gts = (const float*)(F.ws + WS_GATES);
        const float ip = gts[row * 8 + h] + F.in[26][h];
        const float fp = gts[row * 8 + 4 + h] + F.in[27][h];
        const float lf = fminf(fp, 0.f) - log1pf(expf(-fabsf(fp)));
        float cs = lf;
        for (int o = 1; o < 64; o <<= 1) { const float n = __shfl_up(cs, o); if (F.lane >= o) cs += n; }
        li[F.lane] = ip; bc[F.lane] = cs;
    }
    __syncthreads();
}
constexpr int ML_LI = 0, ML_BC = 256, ML_WK = 512, ML_MT = 768, ML_DQ = 1024, ML_RS = 1280, ML_NIN = 1536, ML_Q = 2048, ML_K = ML_Q + 64 * 136 * 2, ML_VT = ML_K + 64 * 136 * 2,
              ML_CT = ML_VT + 128 * 72 * 2, ML_W = ML_CT + 128 * 136 * 2, ML_KT = ML_W + 64 * 72 * 2, ML_END = ML_KT + 128 * 72 * 2;
static_assert(ML_END + 5120 + LDS_WORK_OFF <= LDS_BYTES - 12288, "mlstm lds");

DI void p8a_mlstm_local(const Frame& F) {
    const bf16_t* U1 = (const bf16_t*)(F.ws + WS_U);
    bf16_t* ST = (bf16_t*)(F.ws + WS_BFB);
    float* zloc = (float*)(F.ws + WS_ZLOC); float* scal = (float*)(F.ws + WS_SCAL);
    unsigned char* L = F.lds;
    float* li = (float*)(L + ML_LI); float* bc = (float*)(L + ML_BC); float* wk = (float*)(L + ML_WK);
    bf16_t* kT = (bf16_t*)(L + ML_KT); bf16_t* vT = (bf16_t*)(L + ML_VT); float* cwl = (float*)(L + ML_END); bf16_t* raw = (bf16_t*)(L + ML_Q);
    const float* cw = F.in[24]; const float* cb = F.in[25];
    uint4 rk3[3], rv3[3];
    auto prefetch = [&](int unit) { const int c = unit & 63, h = (unit >> 6) & 3, b = unit >> 8;
        load_raw128(F, U1, b, c * 64 - 3, 67, C_DK + h * 128, rk3); load_raw128(F, U1, b, c * 64, 64, C_DV + h * 128, rv3); };
    if (F.bid < 2048) prefetch(F.bid);
    for (int unit = F.bid; unit < 2048; unit += F.G) {
        const int c = unit & 63, h = (unit >> 6) & 3, b = unit >> 8;
        mlstm_gates(F, U1, b, h, c, li, bc);
        if (F.wave == 0) {
            const float bl = bc[63]; const float dec = bl - bc[F.lane] + li[F.lane];
            const float dmx = wave_max(dec);
            wk[F.lane] = expf(dec - dmx);
            if (F.lane == 0) { scal[unit] = bl; scal[2048 + unit] = dmx; }
        }
        for (int e = F.tid; e < 640; e += 512) cwl[e] = e < 512 ? cw[(size_t)(e >> 7) * 1024 + 512 + h * 128 + (e & 127)] : cb[512 + h * 128 + (e - 512)];
        write_raw128(F, 67, rk3, raw);
        __syncthreads();
        for (int it = F.tid; it < 1024; it += 512) {
            const int s = it & 63, d0 = (it >> 6) * 8;
            float y[8]; conv8_lds(raw, s, d0, cwl, cwl + 512, y);
            const float w = wk[s] * 0.08838834764831845f;
#pragma unroll
            for (int i = 0; i < 8; ++i) kT[(d0 + i) * 72 + s] = f2bf(siluf_(y[i]) * w);
        }
        __syncthreads();
        write_raw128(F, 64, rv3, raw);
        if (unit + F.G < 2048) prefetch(unit + F.G);
        __syncthreads();
        for (int it = F.tid; it < 1024; it += 512) {
            const int s = it & 63, d0 = (it >> 6) * 8;
            const uint4 vv = *(const uint4*)(raw + s * 136 + d0); const unsigned wv[4] = {vv.x, vv.y, vv.z, vv.w};
#pragma unroll
            for (int i = 0; i < 8; ++i) vT[(d0 + i) * 72 + s] = (bf16_t)((i & 1) ? (wv[i >> 1] >> 16) : (wv[i >> 1] & 0xFFFFu));
        }
        __syncthreads();
        for (int tix = F.wave * 8; tix < F.wave * 8 + 8; ++tix) {
            const int et = tix >> 3, dt = tix & 7;
            const f32x4 a = mma16(vT + et * 16 * 72, 72, kT + dt * 16 * 72, 72, 64, F.lane);
            const int fr = F.lane & 15, fq = F.lane >> 4;
#pragma unroll
            for (int r = 0; r < 4; ++r) ST[(size_t)unit * 16384 + (size_t)(et * 16 + 4 * fq + r) * 128 + dt * 16 + fr] = f2bf(a[r]);
        }
        { const int d = F.tid >> 2, part = F.tid & 3; float z = 0.f;
#pragma unroll
          for (int s = 0; s < 16; ++s) z += bf2f(kT[d * 72 + part * 16 + s]);
          z += __shfl_xor(z, 1); z += __shfl_xor(z, 2);
          if (part == 0) zloc[(size_t)unit * 128 + d] = z; }
        __syncthreads();
    }
}

DI void p8a_lru_local(const Frame& F) {
    const bf16_t* U1 = (const bf16_t*)(F.ws + WS_U);
    bf16_t* LA = (bf16_t*)(F.ws + WS_LRUA); bf16_t* LH = (bf16_t*)(F.ws + WS_LRUH);
    float* Aend = (float*)(F.ws + WS_AEND); float* Hend = (float*)(F.ws + WS_HEND);
    const bf16_t* WAT = (const bf16_t*)(F.ws + WS_WAT); const bf16_t* WXT = (const bf16_t*)(F.ws + WS_WXT);
    bf16_t* xcb = (bf16_t*)F.lds;
    float* cwL = (float*)(F.lds + 16640);
    bf16_t* rawl = (bf16_t*)(F.lds + 16640 + 10240);
    const int g = F.wave, lane = F.lane, fr = lane & 15, fq = lane >> 4;
    __syncthreads();
    for (int e = F.tid; e < 2048; e += 512) cwL[e] = F.in[17][e];
    cwL[2048 + F.tid] = F.in[18][F.tid];
    bf16x8 wa[4][2], wx[4][2]; float ba[4], bx[4], sp[4];
#pragma unroll
    for (int ct = 0; ct < 4; ++ct) { const int ch = g * 64 + ct * 16 + fr;
#pragma unroll
        for (int ks = 0; ks < 2; ++ks) { wa[ct][ks] = *(const bf16x8*)(WAT + (size_t)ch * 64 + 32 * ks + 8 * fq); wx[ct][ks] = *(const bf16x8*)(WXT + (size_t)ch * 64 + 32 * ks + 8 * fq); }
        ba[ct] = F.in[20][ch]; bx[ct] = F.in[22][ch]; sp[ct] = log1pf(expf(-F.in[23][ch])); }
    __syncthreads();
    for (int unit = F.bid; unit < 512; unit += F.G) {
        const int b = unit >> 6, c = unit & 63, t0 = c * 64;
        float Ac[4] = {1.f, 1.f, 1.f, 1.f}, hl[4] = {0.f, 0.f, 0.f, 0.f};
        uint4 rr[3];
        auto ldraw = [&](int sub) {
#pragma unroll
            for (int j = 0; j < 3; ++j) { const int it = F.tid + j * 512; const int row = it >> 6, c8 = (it & 63) * 8; const int t = t0 + sub * 16 - 3 + row;
                rr[j] = make_uint4(0u, 0u, 0u, 0u); if (it < 19 * 64 && t >= 0) rr[j] = *(const uint4*)(U1 + ((size_t)b * SEQ + t) * LD1 + C_CX + c8); } };
        ldraw(0);
#pragma unroll 1
        for (int sub = 0; sub < 4; ++sub) {
#pragma unroll
            for (int j = 0; j < 3; ++j) { const int it = F.tid + j * 512; if (it < 19 * 64) *(uint4*)(rawl + (it >> 6) * 520 + (it & 63) * 8) = rr[j]; }
            __syncthreads();
            if (sub < 3) ldraw(sub + 1);
            for (int it = F.tid; it < 1024; it += 512) {
                const int tk = it >> 6, c8 = (it & 63) * 8;
                float y[8];
#pragma unroll
                for (int i = 0; i < 8; ++i) y[i] = cwL[2048 + c8 + i];
#pragma unroll
                for (int j = 0; j < 4; ++j) { const uint4 v = *(const uint4*)(rawl + (tk + j) * 520 + c8); float f[8]; unpack8(v, f);
#pragma unroll
                    for (int i = 0; i < 8; ++i) y[i] += cwL[j * 512 + c8 + i] * f[i]; }
                uint4 o; o.x = pack2(y[0], y[1]); o.y = pack2(y[2], y[3]); o.z = pack2(y[4], y[5]); o.w = pack2(y[6], y[7]);
                *(uint4*)(xcb + tk * 520 + c8) = o;
            }
            __syncthreads();
            bf16x8 af[2];
#pragma unroll
            for (int ks = 0; ks < 2; ++ks) af[ks] = *(const bf16x8*)(xcb + fr * 520 + g * 64 + 32 * ks + 8 * fq);
#pragma unroll
            for (int ct = 0; ct < 4; ++ct) {
                const int ch = g * 64 + ct * 16 + fr;
                f32x4 accA = {0.f, 0.f, 0.f, 0.f}, accX = {0.f, 0.f, 0.f, 0.f};
#pragma unroll
                for (int ks = 0; ks < 2; ++ks) { accA = __builtin_amdgcn_mfma_f32_16x16x32_bf16(af[ks], wa[ct][ks], accA, 0, 0, 0); accX = __builtin_amdgcn_mfma_f32_16x16x32_bf16(af[ks], wx[ct][ks], accX, 0, 0, 0); }
                float Ap[4], Hp[4]; float A4 = 1.f, H4 = 0.f;
#pragma unroll
                for (int rg = 0; rg < 4; ++rg) {
                    const float xc = bf2f(xcb[(4 * fq + rg) * 520 + ch]);
                    const float r = sigmoidf_(accA[rg] + ba[ct]), ig = sigmoidf_(accX[rg] + bx[ct]);
                    const float a = fexp_(-8.0f * r * sp[ct]);
                    const float bt = sqrtf(fmaxf(1.0f - a * a, 0.f)) * (ig * xc);
                    H4 = a * H4 + bt; A4 *= a; Ap[rg] = A4; Hp[rg] = H4;
                }
                float iA = A4, iH = H4;
                { const float pA = __shfl_up(iA, 16), pH = __shfl_up(iH, 16); if (fq >= 1) { iH = iA * pH + iH; iA = pA * iA; } }
                { const float pA = __shfl_up(iA, 32), pH = __shfl_up(iH, 32); if (fq >= 2) { iH = iA * pH + iH; iA = pA * iA; } }
                float eA = __shfl_up(iA, 16), eH = __shfl_up(iH, 16); if (fq == 0) { eA = 1.f; eH = 0.f; }
                const float tA = __shfl(iA, 48 + fr), tH = __shfl(iH, 48 + fr);
                const float cA = Ac[ct] * eA, cH = eA * hl[ct] + eH;
#pragma unroll
                for (int rg = 0; rg < 4; ++rg) { const size_t row = (size_t)b * SEQ + t0 + sub * 16 + 4 * fq + rg;
                    LA[row * 512 + ch] = f2bf(cA * Ap[rg]); LH[row * 512 + ch] = f2bf(Ap[rg] * cH + Hp[rg]); }
                hl[ct] = tA * hl[ct] + tH; Ac[ct] = Ac[ct] * tA;
            }
            __syncthreads();
        }
        if (fq == 0) {
#pragma unroll
            for (int ct = 0; ct < 4; ++ct) { const int ch = g * 64 + ct * 16 + fr; Aend[((size_t)b * 64 + c) * 512 + ch] = Ac[ct]; Hend[((size_t)b * 64 + c) * 512 + ch] = hl[ct]; } }
    }
    __syncthreads();
}

DI void p8b_scans(const Frame& F) {
    const int gt = F.bid * 512 + F.tid, nthr = F.G * 512;
    if (gt < 4096) {
        const int b = gt >> 9, ch = gt & 511;
        const float* Aend = (const float*)(F.ws + WS_AEND); const float* Hend = (const float*)(F.ws + WS_HEND); float* Hin = (float*)(F.ws + WS_HIN);
        float H = 0.f;
#pragma unroll 1
        for (int c0 = 0; c0 < 64; c0 += 8) {
            float av[8], hv[8];
#pragma unroll
            for (int j = 0; j < 8; ++j) { const size_t o = ((size_t)b * 64 + c0 + j) * 512 + ch; av[j] = Aend[o]; hv[j] = Hend[o]; }
#pragma unroll
            for (int j = 0; j < 8; ++j) { const size_t o = ((size_t)b * 64 + c0 + j) * 512 + ch; Hin[o] = H; H = av[j] * H + hv[j]; }
        }
    }
    const float* scal = (const float*)(F.ws + WS_SCAL); float* minp = (float*)(F.ws + WS_SCAL) + 4096;
    if (gt >= nthr - 4096) {
        const int q = gt - (nthr - 4096); const int bh = q >> 7, d = q & 127;
        const float* zloc = (const float*)(F.ws + WS_ZLOC); float* nin = (float*)(F.ws + WS_NIN);
        float m = 0.f, n = 0.f;
#pragma unroll 1
        for (int c0 = 0; c0 < 64; c0 += 8) {
            float zv[8];
#pragma unroll
            for (int j = 0; j < 8; ++j) zv[j] = zloc[(size_t)(bh * 64 + c0 + j) * 128 + d];
#pragma unroll
            for (int j = 0; j < 8; ++j) { const int unit = bh * 64 + c0 + j; const float bl = scal[unit], dm = scal[2048 + unit];
                const float mn = fmaxf(bl + m, dm); const float keep = expf(bl + m - mn), add = expf(dm - mn);
                nin[(size_t)unit * 128 + d] = n; if (d == 0) minp[unit] = m;
                n = keep * n + add * zv[j]; m = mn; }
        }
    }
    bf16_t* ST = (bf16_t*)(F.ws + WS_BFB);
    float* kp = (float*)F.lds; float* ad = kp + 64;
    if (gt < 65536) {
        const int bh = gt >> 11, ed = (gt & 2047) * 8;
        if (F.wave == 0) { const int c = F.lane; const int unit = bh * 64 + c; const float bl = scal[unit], dm = scal[2048 + unit];
            float Bi = bl;
            for (int o = 1; o < 64; o <<= 1) { const float n = __shfl_up(Bi, o); if (c >= o) Bi += n; }
            float pm = dm - Bi;
            for (int o = 1; o < 64; o <<= 1) { const float n = __shfl_up(pm, o); if (c >= o) pm = fmaxf(pm, n); }
            const float mnext = Bi + fmaxf(0.f, pm);
            float mcur = __shfl_up(mnext, 1); if (c == 0) mcur = 0.f;
            kp[c] = expf(bl + mcur - mnext); ad[c] = expf(dm - mnext); }
        __syncthreads();
        float C[8] = {0.f, 0.f, 0.f, 0.f, 0.f, 0.f, 0.f, 0.f};
#pragma unroll 1
        for (int c0 = 0; c0 < 64; c0 += 8) {
            uint4 sv[8];
#pragma unroll
            for (int j = 0; j < 8; ++j) sv[j] = *(const uint4*)(ST + (size_t)(bh * 64 + c0 + j) * 16384 + ed);
#pragma unroll
            for (int j = 0; j < 8; ++j) { float sf[8]; unpack8(sv[j], sf);
                uint4 o; o.x = pack2(C[0], C[1]); o.y = pack2(C[2], C[3]); o.z = pack2(C[4], C[5]); o.w = pack2(C[6], C[7]);
                *(uint4*)(ST + (size_t)(bh * 64 + c0 + j) * 16384 + ed) = o;
                const float kk = kp[c0 + j], aa = ad[c0 + j];
#pragma unroll
                for (int i = 0; i < 8; ++i) C[i] = kk * C[i] + aa * sf[i]; }
        }
    }
}

DI void p8c_mlstm_out(const Frame& F) {
    const bf16_t* U1 = (const bf16_t*)(F.ws + WS_U);
    const bf16_t* ST = (const bf16_t*)(F.ws + WS_BFB);
    bf16_t* Y = (bf16_t*)(F.ws + WS_BFA);
    const float* nin_g = (const float*)(F.ws + WS_NIN); const float* minp = (const float*)(F.ws + WS_SCAL) + 4096;
    unsigned char* L = F.lds;
    float* li = (float*)(L + ML_LI); float* bc = (float*)(L + ML_BC); float* wkk = (float*)(L + ML_WK); float* mt = (float*)(L + ML_MT); float* dq = (float*)(L + ML_DQ); float* rs = (float*)(L + ML_RS); float* nin = (float*)(L + ML_NIN);
    bf16_t* q = (bf16_t*)(L + ML_Q); bf16_t* k = (bf16_t*)(L + ML_K); bf16_t* vT = (bf16_t*)(L + ML_VT); bf16_t* CT = (bf16_t*)(L + ML_CT); bf16_t* W = (bf16_t*)(L + ML_W); float* cwl = (float*)(L + ML_END); bf16_t* raw = (bf16_t*)(L + ML_KT); float* HT = (float*)(L + ML_Q);
    const float* cw = F.in[24]; const float* cb = F.in[25];
    uint4 rq3[3], rk3[3], rv3[3]; u32x4 rc4[4];
    auto prefetch = [&](int unit) { const int c = unit & 63, h = (unit >> 6) & 3, b = unit >> 8;
        load_raw128(F, U1, b, c * 64 - 3, 67, C_DQ + h * 128, rq3);
        load_raw128(F, U1, b, c * 64 - 3, 67, C_DK + h * 128, rk3);
        load_raw128(F, U1, b, c * 64, 64, C_DV + h * 128, rv3);
#pragma unroll
        for (int j = 0; j < 4; ++j) { const int it = F.tid + j * 512; rc4[j] = *(const u32x4*)(ST + (size_t)unit * 16384 + (it >> 4) * 128 + (it & 15) * 8); } };
    if (F.bid < 2048) prefetch(F.bid);
    for (int unit = F.bid; unit < 2048; unit += F.G) {
        const int c = unit & 63, h = (unit >> 6) & 3, b = unit >> 8;
        const float m_in = minp[unit];
        for (int e = F.tid; e < 1280; e += 512) { float v;
            if (e < 512) v = cw[(size_t)(e >> 7) * 1024 + h * 128 + (e & 127)]; else if (e < 1024) v = cw[(size_t)((e - 512) >> 7) * 1024 + 512 + h * 128 + (e & 127)];
            else if (e < 1152) v = cb[h * 128 + (e - 1024)]; else v = cb[512 + h * 128 + (e - 1152)];
            cwl[e] = v; }
        mlstm_gates(F, U1, b, h, c, li, bc);
        write_raw128(F, 67, rq3, raw);
        __syncthreads();
        for (int it = F.tid; it < 1024; it += 512) { const int s = it & 63, d0 = (it >> 6) * 8;
            float y[8]; conv8_lds(raw, s, d0, cwl, cwl + 1024, y);
            uint4 o; o.x = pack2(siluf_(y[0]), siluf_(y[1])); o.y = pack2(siluf_(y[2]), siluf_(y[3])); o.z = pack2(siluf_(y[4]), siluf_(y[5])); o.w = pack2(siluf_(y[6]), siluf_(y[7]));
            *(uint4*)(q + s * 136 + d0) = o; }
        __syncthreads();
        write_raw128(F, 67, rk3, raw);
        __syncthreads();
        for (int it = F.tid; it < 1024; it += 512) { const int s = it & 63, d0 = (it >> 6) * 8;
            float y[8]; conv8_lds(raw, s, d0, cwl + 512, cwl + 1152, y);
            const float sc = 0.08838834764831845f; uint4 o;
            o.x = pack2(siluf_(y[0]) * sc, siluf_(y[1]) * sc); o.y = pack2(siluf_(y[2]) * sc, siluf_(y[3]) * sc); o.z = pack2(siluf_(y[4]) * sc, siluf_(y[5]) * sc); o.w = pack2(siluf_(y[6]) * sc, siluf_(y[7]) * sc);
            *(uint4*)(k + s * 136 + d0) = o; }
        __syncthreads();
        write_raw128(F, 64, rv3, raw);
        __syncthreads();
        for (int it = F.tid; it < 1024; it += 512) { const int s = it & 63, d0 = (it >> 6) * 8;
            const uint4 vv = *(const uint4*)(raw + s * 136 + d0); const unsigned wv[4] = {vv.x, vv.y, vv.z, vv.w};
#pragma unroll
            for (int i = 0; i < 8; ++i) vT[(d0 + i) * 72 + s] = (bf16_t)((i & 1) ? (wv[i >> 1] >> 16) : (wv[i >> 1] & 0xFFFFu)); }
#pragma unroll
        for (int j = 0; j < 4; ++j) { const int it = F.tid + j * 512; *(u32x4*)(CT + (it >> 4) * 136 + (it & 15) * 8) = rc4[j]; }
        if (unit + F.G < 2048) prefetch(unit + F.G);
        if (F.tid < 128) nin[F.tid] = nin_g[(size_t)unit * 128 + F.tid];
        if (F.tid >= 128 && F.tid < 192) { const int l = F.tid - 128;
            float pm = li[l] - bc[l];
            for (int o = 1; o < 64; o <<= 1) { const float n = __shfl_up(pm, o); if (l >= o) pm = fmaxf(pm, n); }
            mt[l] = bc[l] + fmaxf(m_in, pm); }
        __syncthreads();
        { const int l = F.tid >> 3, part = F.tid & 7; float a = 0.f;
#pragma unroll
          for (int d = 0; d < 16; ++d) a += bf2f(q[l * 136 + part * 16 + d]) * nin[part * 16 + d];
          a += __shfl_xor(a, 1); a += __shfl_xor(a, 2); a += __shfl_xor(a, 4);
          if (part == 0) dq[l] = a; }
        for (int tix = F.wave * 2; tix < F.wave * 2 + 2; ++tix) {
            const int lt = tix >> 2, st = tix & 3;
            const f32x4 a = mma16(q + lt * 16 * 136, 136, k + st * 16 * 136, 136, 128, F.lane);
            const int fr = F.lane & 15, fq = F.lane >> 4; const int s = st * 16 + fr;
#pragma unroll
            for (int r = 0; r < 4; ++r) { const int l = lt * 16 + 4 * fq + r;
                const float w = s <= l ? a[r] * expf(bc[l] - bc[s] + li[s] - mt[l]) : 0.f;
                W[l * 72 + s] = f2bf(w); }
        }
        __syncthreads();
        { const int l = F.tid >> 3, part = F.tid & 7; float a = 0.f;
#pragma unroll
          for (int s = 0; s < 8; ++s) a += bf2f(W[l * 72 + part * 8 + s]);
          a += __shfl_xor(a, 1); a += __shfl_xor(a, 2); a += __shfl_xor(a, 4);
          if (part == 0) rs[l] = a; }
        if (F.tid >= 64 && F.tid < 128) { const int l = F.tid - 64; li[l] = expf(bc[l] + m_in - mt[l]); }
        if (F.tid >= 128 && F.tid < 192) { const int l = F.tid - 128; wkk[l] = expf(-mt[l]); }
        __syncthreads();
        uint4 ro2[2], rz2[2];
#pragma unroll
        for (int j = 0; j < 2; ++j) { const int it = F.tid + j * 512; const size_t row = (size_t)b * SEQ + c * 64 + (it >> 4);
            ro2[j] = *(const uint4*)(U1 + row * LD1 + C_DO + h * 128 + (it & 15) * 8); rz2[j] = *(const uint4*)(U1 + row * LD1 + C_DZ + h * 128 + (it & 15) * 8); }
        f32x4 hres[4];
#pragma unroll
        for (int ti = 0; ti < 4; ++ti) { const int tix = F.wave * 4 + ti;
            const int lt = tix >> 3, et = tix & 7;
            const f32x4 qc = mma16(q + lt * 16 * 136, 136, CT + et * 16 * 136, 136, 128, F.lane);
            const f32x4 wv = mma16(W + lt * 16 * 72, 72, vT + et * 16 * 72, 72, 64, F.lane);
            const int fq = F.lane >> 4;
#pragma unroll
            for (int r = 0; r < 4; ++r) { const int l = lt * 16 + 4 * fq + r;
                const float prev = li[l];
                const float num = prev * qc[r] + wv[r];
                const float den = prev * dq[l] + rs[l];
                hres[ti][r] = num * __builtin_amdgcn_rcpf(fmaxf(fabsf(den), wkk[l])); }
        }
        __syncthreads();
#pragma unroll
        for (int ti = 0; ti < 4; ++ti) { const int tix = F.wave * 4 + ti; const int lt = tix >> 3, et = tix & 7; const int fr = F.lane & 15, fq = F.lane >> 4;
#pragma unroll
            for (int r = 0; r < 4; ++r) HT[(lt * 16 + 4 * fq + r) * 132 + et * 16 + fr] = hres[ti][r]; }
        __syncthreads();
#pragma unroll
        for (int j = 0; j < 2; ++j) { const int it = F.tid + j * 512; const int l = it >> 4, e0 = (it & 15) * 8;
            const size_t row = (size_t)b * SEQ + c * 64 + l;
            float of[8], zf[8]; unpack8(ro2[j], of); unpack8(rz2[j], zf);
            const f32x4 h0 = *(const f32x4*)(HT + l * 132 + e0), h1 = *(const f32x4*)(HT + l * 132 + e0 + 4);
            float y[8];
#pragma unroll
            for (int i = 0; i < 4; ++i) { y[i] = sigmoidf_(of[i]) * h0[i] * siluf_(zf[i]); y[4 + i] = sigmoidf_(of[4 + i]) * h1[i] * siluf_(zf[4 + i]); }
            uint4 o; o.x = pack2(y[0], y[1]); o.y = pack2(y[2], y[3]); o.z = pack2(y[4], y[5]); o.w = pack2(y[6], y[7]);
            *(uint4*)(Y + row * 1024 + 512 + h * 128 + e0) = o; }
        __syncthreads();
    }
}
DI void p8c_lru_out(const Frame& F) {
    const bf16_t* U1 = (const bf16_t*)(F.ws + WS_U);
    const bf16_t* LA = (const bf16_t*)(F.ws + WS_LRUA); const bf16_t* LH = (const bf16_t*)(F.ws + WS_LRUH);
    const float* Hin = (const float*)(F.ws + WS_HIN);
    bf16_t* Y = (bf16_t*)(F.ws + WS_BFA);
    const size_t n8 = (size_t)MT * 64;
    for (size_t it = (size_t)F.bid * 512 + F.tid; it < n8; it += (size_t)F.G * 512) {
        const size_t row = it >> 6; const int c0 = (int)(it & 63) * 8; const int b = (int)(row >> 12), t = (int)(row & 4095), c = t >> 6;
        const uint4 av = *(const uint4*)(LA + row * 512 + c0), hv = *(const uint4*)(LH + row * 512 + c0), zv = *(const uint4*)(U1 + row * LD1 + C_CZ + c0);
        float af[8], hf[8], zf[8]; unpack8(av, af); unpack8(hv, hf); unpack8(zv, zf);
        const float* hi = Hin + ((size_t)b * 64 + c) * 512 + c0; float y[8];
#pragma unroll
        for (int i = 0; i < 8; ++i) y[i] = (af[i] * hi[i] + hf[i]) * siluf_(zf[i]);
        uint4 o; o.x = pack2(y[0], y[1]); o.y = pack2(y[2], y[3]); o.z = pack2(y[4], y[5]); o.w = pack2(y[6], y[7]);
        *(uint4*)(Y + row * 1024 + c0) = o;
    }
}

constexpr int N_PHASES = 16;
__global__ void __launch_bounds__(512, 2) mk_fwd(Args args) {
    extern __shared__ __attribute__((aligned(16))) unsigned char smem[];
    Frame F;
    F.tid = threadIdx.x; F.lane = F.tid & 63; F.wave = __builtin_amdgcn_readfirstlane(F.tid >> 6);
    F.G = gridDim.x; F.bid = blockIdx.x; F.gw = F.bid * 8 + F.wave; F.nw = F.G * 8;
    F.lds = smem + LDS_WORK_OFF; F.ws = args.ws; F.out = args.out; F.ctl = (unsigned*)args.ws;
#pragma unroll
    for (int i = 0; i < 28; ++i) F.in[i] = args.in[i];
    LAS unsigned char* lsm = (LAS unsigned char*)smem;
    LAS unsigned char* lut = lsm + (LDS_BYTES - 12288);
    LAS float* tbl = (LAS float*)(lsm + (LDS_BYTES - 12288 + 256));
    LAS float* biasL = (LAS float*)(lsm + (LDS_BYTES - 8192));
    if (F.tid < 4) ((LAS unsigned*)lsm)[F.tid] = 0u;
    if (F.tid < 128) { const int n = F.tid; int bk;
        if (n < 16) bk = n; else { bk = 16; const int thr[15] = {19, 21, 24, 27, 31, 35, 40, 46, 52, 59, 67, 77, 87, 99, 113};
#pragma unroll
            for (int j = 0; j < 15; ++j) bk += (n >= thr[j]) ? 1 : 0; }
        lut[n] = (unsigned char)bk; }
    { const int hd = F.tid >> 5, bk = F.tid & 31; tbl[hd * 32 + bk] = args.in[6][bk * 16 + hd]; }
    F.lut = lut; F.tbl = tbl; F.biasL = biasL; F.ldsl = lsm + LDS_WORK_OFF;
    __syncthreads();
    for (int e = F.tid; e < 16 * 128; e += 512) { const int hd = e >> 7, n = e & 127; const int bk = n < 16 ? n : (n >= 113 ? 31 : (int)lut[n]); biasL[e] = tbl[hd * 32 + bk] * 1.4426950408889634f; }
    __syncthreads();
    const int lo = args.ph_lo, hi = args.ph_hi;
    XcdBarrier bar; bar.bar = F.ctl; bar.x = 0; bar.st = nullptr;
#if !MK_PER_PHASE
    bar = xcd_barrier_post(F.ctl, (volatile LAS unsigned*)lsm);
#endif
#ifndef PH_MASK
#define PH_MASK 0xFFFF
#endif
#define IN(k) (phase_refresh(F), ((PH_MASK >> (k)) & 1) && lo <= (k) && (k) < hi)
#ifndef DLY_LO
#define DLY_LO -1
#define DLY_HI -1
#endif
#ifndef DLY_MULT
#define DLY_MULT 4
#endif
    unsigned long long dly_t0 = 0ull;
#define DLY_START(k) do { if ((k) == DLY_LO && F.bid == 0 && F.tid == 0) dly_t0 = __builtin_amdgcn_s_memrealtime(); } while (0)
#define DLY_END(k) do { if ((k) == DLY_HI && F.bid == 0) { if (F.tid == 0) { const unsigned long long t1 = __builtin_amdgcn_s_memrealtime(); const unsigned long long until = t1 + DLY_MULT * (t1 - dly_t0); \
        while (__builtin_amdgcn_s_memrealtime() < until) __builtin_amdgcn_s_sleep(16); } __syncthreads(); } } while (0)
#if MK_PER_PHASE
#define SEAM(k) do { } while (0)
#else
#define SEAM(k) do { if (IN(k) && IN((k) + 1)) xcd_barrier(bar); DLY_END(k); DLY_START((k) + 1); } while (0)
#endif
    LAS unsigned char* glds = lsm + LDS_WORK_OFF;
    unsigned char* ws = args.ws;
    bf16_t* BFA = (bf16_t*)(ws + WS_BFA); bf16_t* BFB = (bf16_t*)(ws + WS_BFB); bf16_t* U = (bf16_t*)(ws + WS_U); bf16_t* Ef = (bf16_t*)(ws + WS_U); bf16_t* X1b = (bf16_t*)F.out;

    DLY_START(0);
    if (IN(0)) { p0_prologue(F); }
    SEAM(0);
    if (IN(1)) {
        pg8::Gemm g{BFA, (const bf16_t*)(ws + WS_WIN0), MT, LD0, 1024}; pg8::StaticOrder S; S.init(MT, LD0, F.G, F.bid);
        pg8::EpiBf16<0> E{U, LD0};
        pg8::gemm_phase(glds, g, S, E);
        pg8::Gemm g2{(const bf16_t*)(ws + WS_WVT), BFA, 512, MT, 1024}; pg8::StaticOrder S2; S2.init(512, MT, F.G, F.bid);
        pg8::EpiBf16<0> E2{(bf16_t*)(ws + WS_VT), MT};
        pg8::gemm_phase(glds, g2, S2, E2);
    }
    SEAM(1);
    if (IN(2)) { p2a_build_blocks(F); }
    SEAM(2);
    if (IN(3)) {
        if (F.bid < 32) {
            const int which = F.bid >> 4;
            pg8::Gemm g{(const bf16_t*)(ws + (which ? WS_AV : WS_AK)), (const bf16_t*)(ws + (which ? WS_WC1V : WS_WC1K)), 4096, 256, 2048}; pg8::StaticOrder S; S.init(4096, 256, F.G, F.bid & 15);
            pg8::EpiBf16<1> E{(bf16_t*)(ws + (which ? WS_HV : WS_HK)), 256}; pg8::gemm_phase(glds, g, S, E);
            asm volatile("s_waitcnt vmcnt(0)" ::: "memory"); __syncthreads();
            pg8::Unit u; S.next(0, u);
            p2c_compress_rows(F, which, u.pm * 256);
            asm volatile("s_waitcnt vmcnt(0)" ::: "memory"); __syncthreads();
            if (F.tid == 0) { __builtin_amdgcn_fence(__ATOMIC_RELEASE, "agent"); asm volatile("s_waitcnt vmcnt(0)" ::: "memory");
                (void)__hip_atomic_fetch_add(F.ctl + CW_CMPDONE, 1u, __ATOMIC_RELAXED, __HIP_MEMORY_SCOPE_AGENT); }
        }
        att_dsa(F);
    }
    if (IN(5)) {
        if (F.tid == 0) { unsigned sp = 0;
            while (__hip_atomic_load(F.ctl + CW_CMPDONE, __ATOMIC_RELAXED, __HIP_MEMORY_SCOPE_AGENT) < 32u) { __builtin_amdgcn_s_sleep(2);
                if (++sp > (1u << 22)) { atomicAdd(F.ctl + XB_TMO, 1u); break; } }
            __builtin_amdgcn_fence(__ATOMIC_ACQUIRE, "agent"); asm volatile("s_waitcnt vmcnt(0)" ::: "memory"); }
        __syncthreads();
        att_nsa(F); }
    if (IN(3) && IN(6)) xcd_barrier(bar);
    if (IN(6)) {
        pg8::Gemm g{BFB, (const bf16_t*)(ws + WS_WOUT0), MT, 1024, 1024}; pg8::StaticOrder S; S.init(MT, 1024, F.G, F.bid);
        pg8::EpiResid<0> E{F.in[0], nullptr, BFA};
        pg8::gemm_phase(glds, g, S, E);
    }
    SEAM(6);
    if (IN(7)) {
        { pg8::Gemm g{(const bf16_t*)(ws + WS_PBF), (const bf16_t*)(ws + WS_WP0), MT, 1024, 256}; pg8::StaticOrder S; S.init(MT, 1024, F.G, F.bid);
          pg8::EpiBf16<0> E{Ef, 1024}; pg8::gemm_phase(glds, g, S, E); }
        asm volatile("s_waitcnt vmcnt(0)" ::: "memory"); __syncthreads();
        { pg8::Gemm g{BFA, (const bf16_t*)(ws + WS_WG0), MT, 1024, 1024}; pg8::StaticOrder S; S.init(MT, 1024, F.G, F.bid);
          pg8::EpiGate<1> E{nullptr, X1b, BFA, Ef}; pg8::gemm_phase(glds, g, S, E); }
    }
    SEAM(7);
    if (IN(8)) { rmsnorm_gates(F, X1b, F.in[2] + 1024, BFB); }
    SEAM(8);
    if (IN(9)) {
        pg8::Gemm g{BFB, (const bf16_t*)(ws + WS_WIN1), MT, LD1, 1024}; pg8::StaticOrder S; S.init(MT, LD1, F.G, F.bid);
        pg8::EpiBf16<0> E{U, LD1};
        pg8::gemm_phase(glds, g, S, E);
    }
    SEAM(9);
    if (IN(10)) { p8a_mlstm_local(F); p8a_lru_local(F); }
    SEAM(10);
    if (IN(11)) { p8b_scans(F); }
    SEAM(11);
    if (IN(12)) { p8c_mlstm_out(F); p8c_lru_out(F); }
    SEAM(12);

    if (IN(13)) {
        pg8::Gemm g{BFA, (const bf16_t*)(ws + WS_WOUT1), MT, 1024, 1024}; pg8::StaticOrder S; S.init(MT, 1024, F.G, F.bid);
        pg8::EpiResid<1> E{nullptr, X1b, BFB};
        pg8::gemm_phase(glds, g, S, E);
    }
    SEAM(13);
    if (IN(14)) {
        { pg8::Gemm g{(const bf16_t*)(ws + WS_PBF) + (size_t)MT * 256, (const bf16_t*)(ws + WS_WP1), MT, 1024, 256}; pg8::StaticOrder S; S.init(MT, 1024, F.G, F.bid);
          pg8::EpiBf16<0> E{Ef, 1024}; pg8::gemm_phase(glds, g, S, E); }
        asm volatile("s_waitcnt vmcnt(0)" ::: "memory"); __syncthreads();
        { pg8::Gemm g{BFB, (const bf16_t*)(ws + WS_WG1), MT, 1024, 1024}; pg8::StaticOrder S; S.init(MT, 1024, F.G, F.bid);
          pg8::EpiGateNorm E{F.out, BFB, Ef, F.in[3], (float*)(ws + WS_SS), F.ctl + CW_NORMCNT, F.ctl + XB_TMO}; pg8::gemm_phase(glds, g, S, E); }
    }
#undef IN
#undef SEAM
}

extern "C" void kernel_launch(void* const* d_in, const int* in_sizes, int n_in, void* d_out, int out_size, void* d_ws, size_t ws_size, hipStream_t stream) {
    static int grid = 0;
    if (grid == 0) {
        if (n_in != 28 || out_size != MT * DM || ws_size < WS_END) { fprintf(stderr, "kernel_launch: unexpected shapes (n_in %d, out %d, ws %zu < %zu)\n", n_in, out_size, ws_size, (size_t)WS_END); grid = -1; return; }
        int dev = 0, cus = 0, per_cu = 0;
        if (hipGetDevice(&dev) != hipSuccess || hipDeviceGetAttribute(&cus, hipDeviceAttributeMultiprocessorCount, dev) != hipSuccess) { grid = -1; return; }
        if (hipFuncSetAttribute((const void*)mk_fwd, hipFuncAttributeMaxDynamicSharedMemorySize, LDS_BYTES) != hipSuccess) { fprintf(stderr, "kernel_launch: hipFuncSetAttribute failed\n"); grid = -1; return; }
        if (hipOccupancyMaxActiveBlocksPerMultiprocessor(&per_cu, (const void*)mk_fwd, 512, LDS_BYTES) != hipSuccess || per_cu < 1)
            fprintf(stderr, "kernel_launch: occupancy query reports %d workgroups per CU\n", per_cu);
        (void)hipGetLastError();
        grid = cus > 256 ? 256 : cus;
    }
    if (grid < 0) return;
    if (hipMemsetAsync(d_ws, 0, CTL_BYTES, stream) != hipSuccess) return;
    Args a{};
    for (int i = 0; i < 28; ++i) a.in[i] = (const float*)d_in[i];
    a.out = (float*)d_out; a.ws = (unsigned char*)d_ws;
#if MK_PER_PHASE
    for (int p = 0; p < N_PHASES; ++p) { a.ph_lo = p; a.ph_hi = p + 1; hipLaunchKernelGGL(mk_fwd, dim3(grid), dim3(512), LDS_BYTES, stream, a); }
#else
    a.ph_lo = 0; a.ph_hi = N_PHASES;
    hipLaunchKernelGGL(mk_fwd, dim3(grid), dim3(512), LDS_BYTES, stream, a);
#endif
}
```

```cpp
#include <hip/hip_runtime.h>
#include <cstdio>
#include <cstdint>

#ifndef MK_PER_PHASE
#define MK_PER_PHASE 0
#endif

#define LAS __attribute__((address_space(3)))
typedef unsigned short bf16_t;
typedef short bf16x8 __attribute__((ext_vector_type(8)));
typedef float f32x4 __attribute__((ext_vector_type(4)));
typedef unsigned u32x4 __attribute__((ext_vector_type(4)));
#define DI __device__ __forceinline__

constexpr int NB = 8, SEQ = 4096, DM = 1024, MT = NB * SEQ;
constexpr int LD0 = 3072, LD1 = 3584;
constexpr int C_AQ = 0, C_KC = 512, C_VC = 640, C_KS = 768, C_KW = 896, C_AZ = 1024, C_BQ = 1536, C_BZ = 2048,
              C_BK = 2560, C_BKI = 2624, C_BQI = 2688, C_AG = 2944, C_BWI = 2968;
constexpr int C_VS = 0, C_VW = 0, C_BV = 0;
constexpr int C_CX = 0, C_CZ = 512, C_DQ = 1024, C_DK = 1536, C_DV = 2048, C_DO = 2560, C_DZ = 3072;
constexpr int NCMP = 255;
constexpr float NEG_INF = -__builtin_inff();

DI int map0(int n) {
    if (n < 896) return n;
    if (n < 1024) return 1024 + (n - 896);
    if (n < 1536) return 1304 + (n - 1024);
    if (n < 2048) return 1816 + (n - 1536);
    if (n < 2560) return 2780 + (n - 2048);
    if (n < 2624) return 2328 + (n - 2560);
    if (n < 2688) return 2712 + (n - 2624);
    if (n < 2944) return 2456 + (n - 2688);
    if (n < 2968) return 1280 + (n - 2944);
    if (n < 2972) return 2776 + (n - 2968);
    return -1;
}
DI int map1(int n) {
    if (n < 2560) return n;
    if (n < 3072) return 2568 + (n - 2560);
    if (n < 3584) return 3080 + (n - 3072);
    return -1;
}
DI int mapid(int n) { return n; }
DI int mapv(int f) { return f < 128 ? 896 + f : (f < 256 ? 1152 + (f - 128) : (f < 320 ? 2392 + (f - 256) : -1)); }

constexpr size_t CTL_BYTES = 16384;
constexpr size_t WS_WIN0  = CTL_BYTES;
constexpr size_t WS_WOUT0 = WS_WIN0  + (size_t)LD0 * 1024 * 2;
constexpr size_t WS_WG0   = WS_WOUT0 + (size_t)1024 * 1024 * 2;
constexpr size_t WS_WP0   = WS_WG0   + (size_t)1024 * 1024 * 2;
constexpr size_t WS_WIN1  = WS_WP0   + (size_t)1024 * 256 * 2;
constexpr size_t WS_WOUT1 = WS_WIN1  + (size_t)LD1 * 1024 * 2;
constexpr size_t WS_WG1   = WS_WOUT1 + (size_t)1024 * 1024 * 2;
constexpr size_t WS_WP1   = WS_WG1   + (size_t)1024 * 1024 * 2;
constexpr size_t WS_WC1K  = WS_WP1   + (size_t)1024 * 256 * 2;
constexpr size_t WS_WC1V  = WS_WC1K  + (size_t)256 * 2048 * 2;
constexpr size_t WS_WVT   = WS_WC1V  + (size_t)256 * 2048 * 2;
constexpr size_t WS_BFA   = WS_WVT   + (size_t)512 * 1024 * 2;
constexpr size_t WS_BFB   = WS_BFA   + (size_t)MT * 1024 * 2;
constexpr size_t WS_PBF   = WS_BFB   + (size_t)MT * 1024 * 2;
constexpr size_t WS_U     = WS_PBF   + (size_t)2 * MT * 256 * 2;
constexpr size_t WS_X     = WS_U     + (size_t)MT * LD1 * 2;
constexpr size_t WS_AK    = WS_X;
constexpr size_t WS_AV    = WS_AK    + (size_t)4096 * 2048 * 2;
constexpr size_t WS_HK    = WS_AV    + (size_t)4096 * 2048 * 2;
constexpr size_t WS_HV    = WS_HK    + (size_t)4096 * 256 * 2;
constexpr size_t WS_LRUA  = WS_X;
constexpr size_t WS_LRUH  = WS_LRUA  + (size_t)MT * 512 * 2;
constexpr size_t WS_S     = WS_X     + (size_t)64 * 1024 * 1024;
constexpr size_t WS_KCMP  = WS_S;
constexpr size_t WS_VCMP  = WS_KCMP  + (size_t)16 * 256 * 64 * 4;
constexpr size_t WS_AEND  = WS_VCMP  + (size_t)16 * 256 * 64 * 4;
constexpr size_t WS_HEND  = WS_AEND  + (size_t)8 * 64 * 512 * 4;
constexpr size_t WS_HIN   = WS_HEND  + (size_t)8 * 64 * 512 * 4;
constexpr size_t WS_ZLOC  = WS_HIN   + (size_t)8 * 64 * 512 * 4;
constexpr size_t WS_NIN   = WS_ZLOC  + (size_t)2048 * 128 * 4;
constexpr size_t WS_SCAL  = WS_NIN   + (size_t)2048 * 128 * 4;
constexpr size_t WS_VCT   = WS_SCAL  + (size_t)3 * 2048 * 4;
constexpr size_t WS_WAT   = WS_VCT   + (size_t)16 * 64 * 256 * 2;
constexpr size_t WS_WXT   = WS_WAT   + (size_t)8 * 64 * 64 * 2;
constexpr size_t WS_GATES = WS_WXT   + (size_t)8 * 64 * 64 * 2;
constexpr size_t WS_SS    = WS_GATES + (size_t)MT * 8 * 4;
constexpr size_t WS_IMGN  = WS_SS    + (size_t)MT * 4;
constexpr size_t WS_IMGD  = WS_IMGN  + (size_t)6 * 65536;
constexpr size_t WS_IMGW  = WS_IMGD  + (size_t)8 * 65536;
constexpr size_t WS_IMGZ  = WS_IMGW  + (size_t)65536;
constexpr size_t WS_END   = WS_IMGZ  + (size_t)8192;
constexpr size_t WS_VT    = WS_U     + (size_t)MT * LD0 * 2;
static_assert(WS_VT + (size_t)512 * MT * 2 <= WS_X, "VT region");
static_assert(WS_HV + (size_t)4096 * 256 * 2 <= WS_S, "compress region");
static_assert(WS_LRUH + (size_t)MT * 512 * 2 <= WS_S, "lru region");

constexpr int XCD_BAR_WORDS_C = 3456;
constexpr int CW_QNSA = 3520, CW_QDSA = 3584;
constexpr int CW_NORMCNT = 3712;
constexpr int CW_CMPDONE = 3648;

constexpr int LDS_BYTES = 147456;
constexpr int LDS_CTL_OFF = 0;
constexpr int LDS_WORK_OFF = 128;

DI float bf2f(bf16_t v) { return __uint_as_float(((unsigned)v) << 16); }
DI bf16_t f2bf(float f) { unsigned u = __float_as_uint(f); u += 0x7FFFu + ((u >> 16) & 1u); return (bf16_t)(u >> 16); }
typedef __bf16 bf16v2 __attribute__((ext_vector_type(2)));
typedef float f32x2 __attribute__((ext_vector_type(2)));
DI unsigned pack2(float lo, float hi) { const f32x2 v = {lo, hi}; return __builtin_bit_cast(unsigned, __builtin_convertvector(v, bf16v2)); }
DI float fexp_(float x) { return __builtin_amdgcn_exp2f(x * 1.4426950408889634f); }
DI float sigmoidf_(float x) { return __builtin_amdgcn_rcpf(1.0f + fexp_(-x)); }
DI float siluf_(float x) { return x * __builtin_amdgcn_rcpf(1.0f + fexp_(-x)); }
DI float wave_max(float v) { for (int o = 32; o >= 1; o >>= 1) v = fmaxf(v, __shfl_xor(v, o)); return v; }
DI float wave_sum(float v) { for (int o = 32; o >= 1; o >>= 1) v += __shfl_xor(v, o); return v; }
DI void unpack8(const uint4& v, float (&f)[8]) {
    f[0] = __uint_as_float(v.x << 16); f[1] = __uint_as_float(v.x & 0xFFFF0000u);
    f[2] = __uint_as_float(v.y << 16); f[3] = __uint_as_float(v.y & 0xFFFF0000u);
    f[4] = __uint_as_float(v.z << 16); f[5] = __uint_as_float(v.z & 0xFFFF0000u);
    f[6] = __uint_as_float(v.w << 16); f[7] = __uint_as_float(v.w & 0xFFFF0000u);
}

#define XB_TMO      128
#define XB_XCNT(j)  (256  + 64 * (j))
#define XB_XSUB(j)  (1280 + 64 * (j))
#define XB_XGEN(j)  (2304 + 64 * (j))
#define XB_TOP      3328
#define XB_TOPGEN   3392
#define XCD_BAR_WORDS 3456
#define XB_SPIN_CAP (1u << 22)
static_assert(XCD_BAR_WORDS == XCD_BAR_WORDS_C, "bar words");

__device__ __forceinline__ unsigned xb_ld(unsigned* p)              { return __hip_atomic_load(p, __ATOMIC_RELAXED, __HIP_MEMORY_SCOPE_AGENT); }
__device__ __forceinline__ unsigned xb_add(unsigned* p, unsigned v) { return __hip_atomic_fetch_add(p, v, __ATOMIC_RELAXED, __HIP_MEMORY_SCOPE_AGENT); }
__device__ __forceinline__ unsigned xb_xcc_id() { return (unsigned)__builtin_amdgcn_s_getreg((3 << 11) | 20) & 0xFu; }
#define XB_SPIN(cond, bar) do { unsigned _sp = 0; while (cond) { __builtin_amdgcn_s_sleep(1); \
    if ((++_sp & 255u) == 0u) { if (xb_ld(&(bar)[XB_TMO])) break; if (_sp > XB_SPIN_CAP) { atomicAdd(&(bar)[XB_TMO], 1u); break; } } } } while (0)

struct XcdBarrier { unsigned* bar; unsigned x; volatile LAS unsigned* st; };

__device__ __forceinline__ XcdBarrier xcd_barrier_post(unsigned* bar, volatile LAS unsigned* st) {
    XcdBarrier b; b.bar = bar; b.x = xb_xcc_id(); b.st = st;
    if (threadIdx.x == 0) (void)xb_add(&bar[XB_XCNT(b.x)], 1u);
    return b;
}
__device__ __forceinline__ void xcd_barrier_complete(unsigned* bar, unsigned x, unsigned& nloc, unsigned& nx) {
    const unsigned G = gridDim.x * gridDim.y * gridDim.z;
    unsigned sum, cnt, mine, sp = 0u;
    for (;;) {
        sum = 0u; cnt = 0u; mine = 0u;
#pragma unroll
        for (unsigned j = 0; j < 16; ++j) { const unsigned c = xb_ld(&bar[XB_XCNT(j)]); sum += c; cnt += (c > 0u) ? 1u : 0u; mine = (j == x) ? c : mine; }
        if (sum == G) break;
        __builtin_amdgcn_s_sleep(1);
        if ((++sp & 255u) == 0u) { if (xb_ld(&bar[XB_TMO])) break; if (sp > XB_SPIN_CAP) { atomicAdd(&bar[XB_TMO], 1u); break; } }
    }
    nloc = mine > 0u ? mine : 1u; nx = cnt > 0u ? cnt : 1u;
}
__device__ __forceinline__ void xcd_barrier(const XcdBarrier& b) {
    asm volatile("s_waitcnt vmcnt(0)" ::: "memory");
    __syncthreads();
    if (threadIdx.x == 0) {
        unsigned* bar = b.bar;
        __builtin_amdgcn_s_waitcnt(0);
        unsigned nloc = b.st[0], nx = b.st[1];
        if (nloc == 0u) { xcd_barrier_complete(bar, b.x, nloc, nx); b.st[0] = nloc; b.st[1] = nx; }
        const unsigned old = xb_add(&bar[XB_XSUB(b.x)], 1u);
        const unsigned gen = old / nloc;
        if (old + 1u == (gen + 1u) * nloc) {
            __builtin_amdgcn_fence(__ATOMIC_RELEASE, "agent");
            asm volatile("s_waitcnt vmcnt(0)" ::: "memory");
            const unsigned og = xb_add(&bar[XB_TOP], 1u);
            const unsigned tg = og / nx;
            if (og + 1u == (tg + 1u) * nx) xb_add(&bar[XB_TOPGEN], 1u);
            else XB_SPIN(xb_ld(&bar[XB_TOPGEN]) == tg, bar);
            __builtin_amdgcn_fence(__ATOMIC_ACQUIRE, "agent");
            xb_add(&bar[XB_XGEN(b.x)], 1u);
            asm volatile("s_waitcnt vmcnt(0)" ::: "memory");
        } else {
            XB_SPIN(xb_ld(&bar[XB_XGEN(b.x)]) == gen, bar);
            __builtin_amdgcn_fence(__ATOMIC_ACQUIRE, "agent");
            asm volatile("s_waitcnt vmcnt(0)" ::: "memory");
        }
    }
    __syncthreads();
}

namespace pg8 {
constexpr int BM = 256, BK = 64, HALF = 128, HTB = HALF * BK * 2, STAGE_BYTES = 8 * HTB, NXCD = 8, WGM = 8;
__host__ __device__ __forceinline__ int lds_byte(int r, int c) { const int st = (r >> 4) * 2 + (c >> 5), rr = r & 15, cc = c & 31, ob = rr * 64 + cc * 2; return st * 1024 + (ob ^ (((ob >> 9) & 1) << 5)); }
__host__ __device__ __forceinline__ void stage_rc(int b, int& R, int& C) { const int st = b / 1024, sb = b % 1024, swz = sb ^ (((sb >> 9) & 1) << 5); R = (st >> 1) * 16 + swz / 64; C = (st & 1) * 32 + (swz % 64) / 2; }
__host__ __device__ __forceinline__ int perm32(int rho) { const int n = rho >> 4, i = rho & 15; return 8 * (i >> 2) + 4 * n + (i & 3); }
struct Unit { int pm, pn; };
struct Gemm { const bf16_t* A; const bf16_t* Bt; int M, N, K; };
struct StaticOrder {
    int nM, nN, nwg, G, c;
    __host__ __device__ __forceinline__ void init(int M, int N, int G_, int c_) { nM = M / BM; nN = N / BM; nwg = nM * nN; G = G_; c = c_; }
    __host__ __device__ __forceinline__ bool next(int i, Unit& u) const {
        const long L = (long)i * G + c; if (L >= nwg) return false;
        int wgid = (int)L; { const int q = nwg / NXCD, r = nwg % NXCD, xcd = wgid % NXCD, off = wgid / NXCD; wgid = (xcd < r ? xcd * (q + 1) : r * (q + 1) + (xcd - r) * q) + off; }
        const int nig = WGM * nN, gid = wgid / nig, fm = gid * WGM, gsz = (nM - fm) < WGM ? (nM - fm) : WGM;
        u.pm = fm + ((wgid % nig) % gsz); u.pn = (wgid % nig) / gsz; return true;
    }
    __device__ __forceinline__ void a_ready(const Unit&) const {}
    __device__ __forceinline__ void done(const Unit&) const {}
};
template <class Epi, class Sched>
__device__ __forceinline__ void gemm_phase(LAS unsigned char* lds, const Gemm g, const Sched& S, const Epi& E) {
    int tid_ = threadIdx.x; asm volatile("" : "+v"(tid_));
    const int tid = tid_, wid = __builtin_amdgcn_readfirstlane(tid >> 6), lane = tid & 63, wr = wid >> 2, wc = wid & 3, fr = lane & 15, fq = lane >> 4;
    const int K = g.K, nt = K / BK;
    unsigned voffA[2], voffB[2];
#pragma unroll
    for (int i = 0; i < 2; ++i) { int R, C; stage_rc(tid * 16 + i * 8192, R, C); const int Rb = Epi::PERM ? ((R & ~31) + perm32(R & 31)) : R;
        voffA[i] = (unsigned)(R * K + C) * 2u; voffB[i] = (unsigned)(Rb * K + C) * 2u; }
    const size_t kstep = (size_t)(BK * 2);
    const size_t hstep = (size_t)HALF * K * 2;
    const size_t tstep = 2 * hstep;
    const unsigned ldsw = (unsigned)wid * 1024u;
    const int aoff = lds_byte(wr * 64 + fr, fq * 8), boff = lds_byte(wc * 32 + fr, fq * 8);
#define PG8_SA(b, h) (((b) * 2 + (h)) * HTB)
#define PG8_SB(b, h) ((4 + (b) * 2 + (h)) * HTB)
#define PG8_STAGE(bufoff, gbase, voff) do { _Pragma("unroll") for (int _i = 0; _i < 2; ++_i) \
        __builtin_amdgcn_global_load_lds((const unsigned*)((const char*)(gbase) + (voff)[_i]), (LAS unsigned*)(lds + (bufoff) + ldsw + _i * 8192), 16, 0, 0); } while (0)
#define PG8_LDA(dst, b, h) do { _Pragma("unroll") for (int m = 0; m < 4; ++m) _Pragma("unroll") for (int k = 0; k < 2; ++k) dst[m][k] = *(const LAS bf16x8*)(lds + PG8_SA(b, h) + aoff + m * 2048 + k * 1024); } while (0)
#define PG8_LDB(dst, b, h) do { _Pragma("unroll") for (int n = 0; n < 2; ++n) _Pragma("unroll") for (int k = 0; k < 2; ++k) dst[n][k] = *(const LAS bf16x8*)(lds + PG8_SB(b, h) + boff + n * 2048 + k * 1024); } while (0)
#define PG8_MMA(ai, bj, At, Bt) do { __builtin_amdgcn_s_setprio(1); _Pragma("unroll") for (int m = 0; m < 4; ++m) _Pragma("unroll") for (int n = 0; n < 2; ++n) _Pragma("unroll") for (int k = 0; k < 2; ++k) \
        acc[ai][bj][m][n] = __builtin_amdgcn_mfma_f32_16x16x32_bf16(Bt[n][k], At[m][k], acc[ai][bj][m][n], 0, 0, 0); __builtin_amdgcn_s_setprio(0); } while (0)
#define PG8_WAIT_V(n) asm volatile("s_waitcnt vmcnt(" #n ")" ::: "memory")
#define PG8_WAIT_L(n) asm volatile("s_waitcnt lgkmcnt(" #n ")" ::: "memory")
#define PG8_BAR __builtin_amdgcn_s_barrier()
#define PG8_SCHED __builtin_amdgcn_sched_barrier(0)
    Unit cur, nxt; int ui = 0;
    if (!S.next(0, cur)) return;
    f32x4 acc[2][2][4][2];
#pragma unroll
    for (int a = 0; a < 2; ++a)
#pragma unroll
        for (int b = 0; b < 2; ++b)
#pragma unroll
            for (int m = 0; m < 4; ++m)
#pragma unroll
                for (int n = 0; n < 2; ++n) acc[a][b][m][n] = (f32x4){0.f, 0.f, 0.f, 0.f};
    bf16x8 At[4][2], B0[2][2], B1[2][2];
    const char* cA = (const char*)g.A + (size_t)cur.pm * tstep; const char* cB = (const char*)g.Bt + (size_t)cur.pn * tstep;
    S.a_ready(cur);
    PG8_STAGE(PG8_SB(0, 0), cB, voffB); PG8_STAGE(PG8_SA(0, 0), cA, voffA); PG8_STAGE(PG8_SB(0, 1), cB + hstep, voffB); PG8_STAGE(PG8_SA(0, 1), cA + hstep, voffA);
    if (wr == 1) PG8_BAR;
    PG8_WAIT_V(4); PG8_BAR;
    PG8_STAGE(PG8_SB(1, 0), cB + kstep, voffB); PG8_STAGE(PG8_SA(1, 0), cA + kstep, voffA); PG8_STAGE(PG8_SB(1, 1), cB + hstep + kstep, voffB);
    PG8_WAIT_V(6); PG8_BAR;
    for (;;) {
        const bool has_next = S.next(ui + 1, nxt);
        const char* nA = has_next ? (const char*)g.A + (size_t)nxt.pm * tstep : cA; const char* nB = has_next ? (const char*)g.Bt + (size_t)nxt.pn * tstep : cB;
        for (int t = 0; t < nt; t += 2) {
            const bool last = (t == nt - 2);
            const char* a1 = cA + (size_t)(t + 1) * kstep;
            const char* a2 = last ? nA : cA + (size_t)(t + 2) * kstep; const char* b2 = last ? nB : cB + (size_t)(t + 2) * kstep;
            const char* a3 = a2 + kstep; const char* b3 = b2 + kstep;
            if (last && has_next) S.a_ready(nxt);
            PG8_LDB(B0, 0, 0); PG8_SCHED; PG8_LDA(At, 0, 0); PG8_STAGE(PG8_SA(1, 1), a1 + hstep, voffA);
            PG8_WAIT_L(8); PG8_BAR; PG8_WAIT_L(0); PG8_MMA(0, 0, At, B0); PG8_BAR; PG8_SCHED;
            PG8_LDB(B1, 0, 1); PG8_STAGE(PG8_SB(0, 0), b2, voffB);
            PG8_BAR; PG8_WAIT_L(0); PG8_MMA(0, 1, At, B1); PG8_BAR;
            PG8_LDA(At, 0, 1); PG8_STAGE(PG8_SA(0, 0), a2, voffA);
            PG8_BAR; PG8_WAIT_L(0); PG8_MMA(1, 0, At, B0); PG8_BAR; PG8_SCHED;
            PG8_STAGE(PG8_SB(0, 1), b2 + hstep, voffB);
            PG8_WAIT_V(6); PG8_BAR; PG8_MMA(1, 1, At, B1); PG8_BAR;
            PG8_LDB(B0, 1, 0); PG8_SCHED; PG8_LDA(At, 1, 0); PG8_STAGE(PG8_SA(0, 1), a2 + hstep, voffA);
            PG8_WAIT_L(8); PG8_BAR; PG8_WAIT_L(0); PG8_MMA(0, 0, At, B0); PG8_BAR; PG8_SCHED;
            PG8_LDB(B1, 1, 1); PG8_STAGE(PG8_SB(1, 0), b3, voffB);
            PG8_BAR; PG8_WAIT_L(0); PG8_MMA(0, 1, At, B1); PG8_BAR;
            PG8_LDA(At, 1, 1); PG8_STAGE(PG8_SA(1, 0), a3, voffA);
            PG8_BAR; PG8_WAIT_L(0); PG8_MMA(1, 0, At, B0); PG8_BAR; PG8_SCHED;
            PG8_STAGE(PG8_SB(1, 1), b3 + hstep, voffB);
            PG8_WAIT_V(6); PG8_BAR; PG8_MMA(1, 1, At, B1); PG8_BAR;
        }
        E(acc, cur, wr, wc, fr, fq); S.done(cur);
        if (!has_next) break;
#pragma unroll
        for (int a = 0; a < 2; ++a)
#pragma unroll
            for (int b = 0; b < 2; ++b)
#pragma unroll
                for (int m = 0; m < 4; ++m)
#pragma unroll
                    for (int n = 0; n < 2; ++n) acc[a][b][m][n] = (f32x4){0.f, 0.f, 0.f, 0.f};
        cur = nxt; cA = nA; cB = nB; ++ui;
    }
    PG8_WAIT_V(0);
    if (wr == 0) PG8_BAR;
    PG8_BAR;
#undef PG8_SA
#undef PG8_SB
#undef PG8_STAGE
#undef PG8_LDA
#undef PG8_LDB
#undef PG8_MMA
#undef PG8_WAIT_V
#undef PG8_WAIT_L
#undef PG8_BAR
#undef PG8_SCHED
}

template <int ACT  > struct EpiBf16 {
    static constexpr bool PERM = true;
    bf16_t* O; int ldc;
    __device__ __forceinline__ void operator()(const f32x4 (&acc)[2][2][4][2], const Unit& u, int wr, int wc, int fr, int fq) const {
        const int row0 = u.pm * BM + wr * 64 + fr, col0 = u.pn * BM + wc * 32 + 8 * fq;
#pragma unroll
        for (int ai = 0; ai < 2; ++ai)
#pragma unroll
            for (int m = 0; m < 4; ++m) { bf16_t* rowp = O + (size_t)(row0 + ai * HALF + m * 16) * ldc + col0;
#pragma unroll
                for (int bj = 0; bj < 2; ++bj) { f32x4 v0 = acc[ai][bj][m][0], v1 = acc[ai][bj][m][1];
                    if (ACT == 1) { for (int i = 0; i < 4; ++i) { v0[i] = siluf_(v0[i]); v1[i] = siluf_(v1[i]); } }
                    uint4 o; o.x = pack2(v0[0], v0[1]); o.y = pack2(v0[2], v0[3]); o.z = pack2(v1[0], v1[1]); o.w = pack2(v1[2], v1[3]);
                    *(uint4*)(rowp + bj * HALF) = o; } }
    }
};
struct EpiF32 {
    static constexpr bool PERM = false;
    float* C; int ldc;
    __device__ __forceinline__ void operator()(const f32x4 (&acc)[2][2][4][2], const Unit& u, int wr, int wc, int fr, int fq) const {
        const int row0 = u.pm * BM + wr * 64 + fr, col0 = u.pn * BM + wc * 32 + 4 * fq;
#pragma unroll
        for (int ai = 0; ai < 2; ++ai)
#pragma unroll
            for (int m = 0; m < 4; ++m) { float* rowp = C + (size_t)(row0 + ai * HALF + m * 16) * ldc + col0;
#pragma unroll
                for (int bj = 0; bj < 2; ++bj)
#pragma unroll
                    for (int n = 0; n < 2; ++n) *(f32x4*)(rowp + bj * HALF + n * 16) = acc[ai][bj][m][n]; }
    }
};
template <int IN_BF16> struct EpiResid {
    static constexpr bool PERM = true;
    const float* Xi; const bf16_t* Xib; bf16_t* Ob;
    __device__ __forceinline__ void operator()(const f32x4 (&acc)[2][2][4][2], const Unit& u, int wr, int wc, int fr, int fq) const {
        const int row0 = u.pm * BM + wr * 64 + fr, col0 = u.pn * BM + wc * 32 + 8 * fq;
        if (IN_BF16) {
            u32x4 xa[2][4][2];
#pragma unroll
            for (int ai = 0; ai < 2; ++ai)
#pragma unroll
                for (int m = 0; m < 4; ++m)
#pragma unroll
                    for (int bj = 0; bj < 2; ++bj) xa[ai][m][bj] = *(const u32x4*)(Xib + (size_t)(row0 + ai * HALF + m * 16) * 1024 + col0 + bj * HALF);
            __builtin_amdgcn_sched_barrier(0);
#pragma unroll
            for (int ai = 0; ai < 2; ++ai)
#pragma unroll
                for (int m = 0; m < 4; ++m)
#pragma unroll
                    for (int bj = 0; bj < 2; ++bj) { const size_t o = (size_t)(row0 + ai * HALF + m * 16) * 1024 + col0 + bj * HALF; const u32x4 w = xa[ai][m][bj];
                        const f32x4 a0 = (f32x4){__uint_as_float(w[0] << 16), __uint_as_float(w[0] & 0xFFFF0000u), __uint_as_float(w[1] << 16), __uint_as_float(w[1] & 0xFFFF0000u)};
                        const f32x4 a1 = (f32x4){__uint_as_float(w[2] << 16), __uint_as_float(w[2] & 0xFFFF0000u), __uint_as_float(w[3] << 16), __uint_as_float(w[3] & 0xFFFF0000u)};
                        const f32x4 v0 = a0 + acc[ai][bj][m][0], v1 = a1 + acc[ai][bj][m][1];
                        uint4 pk; pk.x = pack2(v0[0], v0[1]); pk.y = pack2(v0[2], v0[3]); pk.z = pack2(v1[0], v1[1]); pk.w = pack2(v1[2], v1[3]); *(uint4*)(Ob + o) = pk; }
            return; }
#pragma unroll
        for (int ai = 0; ai < 2; ++ai) {
            f32x4 x0[4][2], x1[4][2]; u32x4 xb[4][2];
#pragma unroll
            for (int m = 0; m < 4; ++m)
#pragma unroll
                for (int bj = 0; bj < 2; ++bj) { const size_t o = (size_t)(row0 + ai * HALF + m * 16) * 1024 + col0 + bj * HALF;
                    if (IN_BF16) xb[m][bj] = *(const u32x4*)(Xib + o); else { x0[m][bj] = *(const f32x4*)(Xi + o); x1[m][bj] = *(const f32x4*)(Xi + o + 4); } }
            __builtin_amdgcn_sched_barrier(0);
#pragma unroll
            for (int m = 0; m < 4; ++m)
#pragma unroll
                for (int bj = 0; bj < 2; ++bj) { const size_t o = (size_t)(row0 + ai * HALF + m * 16) * 1024 + col0 + bj * HALF;
                    f32x4 a0, a1;
                    if (IN_BF16) { const u32x4 w = xb[m][bj];
                        a0 = (f32x4){__uint_as_float(w[0] << 16), __uint_as_float(w[0] & 0xFFFF0000u), __uint_as_float(w[1] << 16), __uint_as_float(w[1] & 0xFFFF0000u)};
                        a1 = (f32x4){__uint_as_float(w[2] << 16), __uint_as_float(w[2] & 0xFFFF0000u), __uint_as_float(w[3] << 16), __uint_as_float(w[3] & 0xFFFF0000u)}; }
                    else { a0 = x0[m][bj]; a1 = x1[m][bj]; }
                    const f32x4 v0 = a0 + acc[ai][bj][m][0], v1 = a1 + acc[ai][bj][m][1];
                    uint4 pk; pk.x = pack2(v0[0], v0[1]); pk.y = pack2(v0[2], v0[3]); pk.z = pack2(v1[0], v1[1]); pk.w = pack2(v1[2], v1[3]); *(uint4*)(Ob + o) = pk; }
        }
    }
};
template <int OUT_BF16> struct EpiGate {
    static constexpr bool PERM = true;
    float* X; bf16_t* Xb; const bf16_t* R; const bf16_t* E;
    __device__ __forceinline__ void operator()(const f32x4 (&acc)[2][2][4][2], const Unit& u, int wr, int wc, int fr, int fq) const {
        const int row0 = u.pm * BM + wr * 64 + fr, col0 = u.pn * BM + wc * 32 + 8 * fq;
#pragma unroll
        for (int ai = 0; ai < 2; ++ai) {
            u32x4 eb[4][2], rb[4][2];
#pragma unroll
            for (int m = 0; m < 4; ++m)
#pragma unroll
                for (int bj = 0; bj < 2; ++bj) { const size_t o = (size_t)(row0 + ai * HALF + m * 16) * 1024 + col0 + bj * HALF; eb[m][bj] = *(const u32x4*)(E + o); rb[m][bj] = *(const u32x4*)(R + o); }
            __builtin_amdgcn_sched_barrier(0);
#pragma unroll
            for (int m = 0; m < 4; ++m)
#pragma unroll
                for (int bj = 0; bj < 2; ++bj) { const size_t o = (size_t)(row0 + ai * HALF + m * 16) * 1024 + col0 + bj * HALF;
                    const uint4 ev = make_uint4(eb[m][bj][0], eb[m][bj][1], eb[m][bj][2], eb[m][bj][3]), rv = make_uint4(rb[m][bj][0], rb[m][bj][1], rb[m][bj][2], rb[m][bj][3]);
                    float ef[8], rf[8]; unpack8(ev, ef); unpack8(rv, rf);
                    float v[8];
#pragma unroll
                    for (int n = 0; n < 2; ++n)
#pragma unroll
                        for (int i = 0; i < 4; ++i) v[4 * n + i] = rf[4 * n + i] + ef[4 * n + i] * sigmoidf_(acc[ai][bj][m][n][i]);
                    if (OUT_BF16) { uint4 pk; pk.x = pack2(v[0], v[1]); pk.y = pack2(v[2], v[3]); pk.z = pack2(v[4], v[5]); pk.w = pack2(v[6], v[7]); *(uint4*)(Xb + o) = pk; }
                    else { *(f32x4*)(X + o) = (f32x4){v[0], v[1], v[2], v[3]}; *(f32x4*)(X + o + 4) = (f32x4){v[4], v[5], v[6], v[7]}; } }
        }
    }
};
struct EpiGateNorm {
    static constexpr bool PERM = true;
    float* X; const bf16_t* R; const bf16_t* E; const float* wn; float* SS; unsigned* cnt; unsigned* tmo;
    __device__ __forceinline__ void operator()(f32x4 (&acc)[2][2][4][2], const Unit& u, int wr, int wc, int fr, int fq) const {
        const int row0 = u.pm * BM + wr * 64 + fr, col0 = u.pn * BM + wc * 32 + 8 * fq;
#pragma unroll
        for (int ai = 0; ai < 2; ++ai) {
          u32x4 eb[4][2], rb[4][2];
#pragma unroll
          for (int m = 0; m < 4; ++m)
#pragma unroll
              for (int bj = 0; bj < 2; ++bj) { const size_t o = (size_t)(row0 + ai * HALF + m * 16) * 1024 + col0 + bj * HALF; eb[m][bj] = *(const u32x4*)(E + o); rb[m][bj] = *(const u32x4*)(R + o); }
          __builtin_amdgcn_sched_barrier(0);
#pragma unroll
            for (int m = 0; m < 4; ++m) { const int row = row0 + ai * HALF + m * 16; float ss = 0.f;
#pragma unroll
                for (int bj = 0; bj < 2; ++bj) {
                    const uint4 ev = make_uint4(eb[m][bj][0], eb[m][bj][1], eb[m][bj][2], eb[m][bj][3]), rv = make_uint4(rb[m][bj][0], rb[m][bj][1], rb[m][bj][2], rb[m][bj][3]); float ef[8], rf[8]; unpack8(ev, ef); unpack8(rv, rf);
#pragma unroll
                    for (int n = 0; n < 2; ++n)
#pragma unroll
                        for (int i = 0; i < 4; ++i) { const float v = rf[4 * n + i] + ef[4 * n + i] * sigmoidf_(acc[ai][bj][m][n][i]); acc[ai][bj][m][n][i] = v; ss += v * v; } }
                ss += __shfl_xor(ss, 16); ss += __shfl_xor(ss, 32);
                if (fq == 0) (void)__hip_atomic_fetch_add(SS + row, ss, __ATOMIC_RELAXED, __HIP_MEMORY_SCOPE_AGENT); }
        }
        asm volatile("s_waitcnt vmcnt(0)" ::: "memory");
        if ((fr | fq) == 0) (void)__hip_atomic_fetch_add(cnt + 2 * u.pm + wr, 1u, __ATOMIC_RELAXED, __HIP_MEMORY_SCOPE_AGENT);
        f32x4 w[2][2];
#pragma unroll
        for (int bj = 0; bj < 2; ++bj) { w[bj][0] = *(const f32x4*)(wn + col0 + bj * HALF); w[bj][1] = *(const f32x4*)(wn + col0 + bj * HALF + 4); }
        { unsigned sp = 0;
          while (__hip_atomic_load(cnt + 2 * u.pm + wr, __ATOMIC_RELAXED, __HIP_MEMORY_SCOPE_AGENT) < 16u) { __builtin_amdgcn_s_sleep(1);
              if (++sp > (1u << 22)) { if ((fr | fq) == 0) atomicAdd(tmo, 1u); break; } } }
        asm volatile("" ::: "memory");
        float ssv[2][4];
#pragma unroll
        for (int ai = 0; ai < 2; ++ai)
#pragma unroll
            for (int m = 0; m < 4; ++m) ssv[ai][m] = __hip_atomic_load(SS + row0 + ai * HALF + m * 16, __ATOMIC_RELAXED, __HIP_MEMORY_SCOPE_AGENT);
#pragma unroll
        for (int ai = 0; ai < 2; ++ai)
#pragma unroll
            for (int m = 0; m < 4; ++m) { const int row = row0 + ai * HALF + m * 16; const size_t ro = (size_t)row * 1024 + col0;
                const float rs = rsqrtf(ssv[ai][m] * (1.0f / 1024.0f) + 1e-6f);
#pragma unroll
                for (int bj = 0; bj < 2; ++bj) { const size_t o = ro + bj * HALF;
                    *(f32x4*)(X + o) = acc[ai][bj][m][0] * rs * w[bj][0]; *(f32x4*)(X + o + 4) = acc[ai][bj][m][1] * rs * w[bj][1]; } }
    }
};
}

struct Args { const float* in[28]; float* out; unsigned char* ws; int ph_lo, ph_hi; };

struct Frame {
    int tid, lane, wave, G, bid, gw, nw;
    unsigned char* lds;
    unsigned* ctl;
    const float* in[28]; float* out; unsigned char* ws;
    const LAS unsigned char* lut;
    const LAS float* tbl;
    const LAS float* biasL;
    LAS unsigned char* ldsl;
};
DI int t5b(const Frame& F, int n) { return n < 16 ? n : (n >= 113 ? 31 : (int)F.lut[n]); }

DI bool phase_refresh(Frame& F) { int t_ = threadIdx.x; asm volatile("" : "+v"(t_)); F.tid = t_; F.lane = t_ & 63; return true; }
struct TDesc { const float* src; bf16_t* dst; int K, Nsrc, Npad, mapk, ntiles; };
DI int tmap(int kind, int n) { return kind == 0 ? n : (kind == 1 ? map0(n) : (kind == 2 ? map1(n) : mapv(n))); }
DI void transpose_all(const Frame& F) {
    unsigned char* ws = F.ws;
    float* tile = (float*)F.lds;
    TDesc D[11];
    D[0] = TDesc{F.in[7], (bf16_t*)(ws + WS_WIN0), 1024, 3292, LD0, 1, 0};
    D[1] = TDesc{F.in[7], (bf16_t*)(ws + WS_WVT), 1024, 3292, 512, 3, 0};
    D[2] = TDesc{F.in[8], (bf16_t*)(ws + WS_WOUT0), 1024, 1024, 1024, 0, 0};
    D[3] = TDesc{F.in[5], (bf16_t*)(ws + WS_WG0), 1024, 1024, 1024, 0, 0};
    D[4] = TDesc{F.in[5] + (size_t)1024 * 1024, (bf16_t*)(ws + WS_WG1), 1024, 1024, 1024, 0, 0};
    D[5] = TDesc{F.in[4], (bf16_t*)(ws + WS_WP0), 256, 1024, 1024, 0, 0};
    D[6] = TDesc{F.in[4] + (size_t)256 * 1024, (bf16_t*)(ws + WS_WP1), 256, 1024, 1024, 0, 0};
    D[7] = TDesc{F.in[15], (bf16_t*)(ws + WS_WIN1), 1024, 3592, LD1, 2, 0};
    D[8] = TDesc{F.in[16], (bf16_t*)(ws + WS_WOUT1), 1024, 1024, 1024, 0, 0};
    D[9] = TDesc{F.in[10], (bf16_t*)(ws + WS_WC1K), 2048, 256, 256, 0, 0};
    D[10] = TDesc{F.in[13], (bf16_t*)(ws + WS_WC1V), 2048, 256, 256, 0, 0};
    int total = 0;
#pragma unroll
    for (int i = 0; i < 11; ++i) { D[i].ntiles = (D[i].Npad / 64) * (D[i].K / 64); total += D[i].ntiles; }
    f32x4 rg[2];
    auto locate = [&](int tix, TDesc& d, int& nt, int& kt) { int rem = tix;
#pragma unroll
        for (int i = 0; i < 11; ++i) { if (rem >= 0 && rem < D[i].ntiles) { d = D[i]; const int ntk = d.K / 64; nt = rem / ntk; kt = rem % ntk; rem = -1; } else if (rem >= 0) rem -= D[i].ntiles; } };
    auto load = [&](int tix) { TDesc d; int nt = 0, kt = 0; locate(tix, d, nt, kt);
#pragma unroll
        for (int q = 0; q < 2; ++q) { const int e = F.tid + q * 512; const int kk = e >> 4, n4 = (e & 15) * 4; const int col = tmap(d.mapk, nt * 64 + n4);
            rg[q] = col >= 0 ? *(const f32x4*)(d.src + (size_t)(kt * 64 + kk) * d.Nsrc + col) : (f32x4){0.f, 0.f, 0.f, 0.f}; } };
    int tix = F.bid; int buf = 0;
    if (tix < total) load(tix);
    for (; tix < total; tix += F.G) {
        float* tl = tile + buf * (64 * 68);
#pragma unroll
        for (int q = 0; q < 2; ++q) { const int e = F.tid + q * 512; *(f32x4*)(tl + (e >> 4) * 68 + (e & 15) * 4) = rg[q]; }
        __syncthreads();
        TDesc d; int nt = 0, kt = 0; locate(tix, d, nt, kt);
        if (tix + F.G < total) load(tix + F.G);
        { const int nn = F.tid & 63, k0 = (F.tid >> 6) * 8; float v[8];
#pragma unroll
          for (int j = 0; j < 8; ++j) v[j] = tl[(k0 + j) * 68 + nn];
          uint4 o; o.x = pack2(v[0], v[1]); o.y = pack2(v[2], v[3]); o.z = pack2(v[4], v[5]); o.w = pack2(v[6], v[7]);
          *(uint4*)(d.dst + (size_t)(nt * 64 + nn) * d.K + kt * 64 + k0) = o; }
        buf ^= 1;
    }
    __syncthreads();
}
template <int OUTF>
DI void rmsnorm_rows(const Frame& F, const float* X, const float* g, bf16_t* Ob, float* Of) {
    f32x4 gg[4];
#pragma unroll
    for (int i = 0; i < 4; ++i) gg[i] = *(const f32x4*)(g + i * 256 + F.lane * 4);
    for (int row0 = F.gw * 4; row0 < MT; row0 += F.nw * 4) {
        f32x4 v[4][4]; float ss[4];
#pragma unroll
        for (int r = 0; r < 4; ++r)
#pragma unroll
            for (int i = 0; i < 4; ++i) v[r][i] = *(const f32x4*)(X + (size_t)(row0 + r) * 1024 + i * 256 + F.lane * 4);
#pragma unroll
        for (int r = 0; r < 4; ++r) { float a = 0.f;
#pragma unroll
            for (int i = 0; i < 4; ++i) a += v[r][i][0] * v[r][i][0] + v[r][i][1] * v[r][i][1] + v[r][i][2] * v[r][i][2] + v[r][i][3] * v[r][i][3];
            ss[r] = a; }
#pragma unroll
        for (int o = 32; o >= 1; o >>= 1) {
#pragma unroll
            for (int r = 0; r < 4; ++r) ss[r] += __shfl_xor(ss[r], o); }
#pragma unroll
        for (int r = 0; r < 4; ++r) { const float rs = rsqrtf(ss[r] * (1.0f / 1024.0f) + 1e-6f);
#pragma unroll
            for (int i = 0; i < 4; ++i) { f32x4 y;
#pragma unroll
                for (int j = 0; j < 4; ++j) y[j] = v[r][i][j] * rs * gg[i][j];
                if (OUTF) *(f32x4*)(Of + (size_t)(row0 + r) * 1024 + i * 256 + F.lane * 4) = y;
                else { uint2 pk; pk.x = pack2(y[0], y[1]); pk.y = pack2(y[2], y[3]); *(uint2*)(Ob + (size_t)(row0 + r) * 1024 + i * 256 + F.lane * 4) = pk; } } }
    }
}
DI void rmsnorm_gates(const Frame& F, const bf16_t* X, const float* g, bf16_t* Ob) {
    const float* W = F.in[15]; float* gts = (float*)(F.ws + WS_GATES);
    float wg[2][8][8]; float gg[2][8];
#pragma unroll
    for (int i = 0; i < 2; ++i)
#pragma unroll
        for (int e = 0; e < 8; ++e) { const int k = i * 512 + F.lane * 8 + e; const f32x4 a = *(const f32x4*)(W + (size_t)k * 3592 + 2560), b = *(const f32x4*)(W + (size_t)k * 3592 + 2564);
            wg[i][e][0] = a[0]; wg[i][e][1] = a[1]; wg[i][e][2] = a[2]; wg[i][e][3] = a[3]; wg[i][e][4] = b[0]; wg[i][e][5] = b[1]; wg[i][e][6] = b[2]; wg[i][e][7] = b[3]; gg[i][e] = g[k];
#pragma unroll
            for (int j = 0; j < 8; ++j) wg[i][e][j] *= gg[i][e]; }
    u32x4 xn[2][2];
    { const int r0 = F.gw * 2;
      if (r0 < MT) {
#pragma unroll
        for (int r = 0; r < 2; ++r)
#pragma unroll
            for (int i = 0; i < 2; ++i) xn[r][i] = *(const u32x4*)(X + (size_t)(r0 + r) * 1024 + i * 512 + F.lane * 8); } }
    for (int row0 = F.gw * 2; row0 < MT; row0 += F.nw * 2) {
        uint4 xv[2][2]; float ss[2];
#pragma unroll
        for (int r = 0; r < 2; ++r)
#pragma unroll
            for (int i = 0; i < 2; ++i) xv[r][i] = make_uint4(xn[r][i][0], xn[r][i][1], xn[r][i][2], xn[r][i][3]);
        { const int rn = row0 + F.nw * 2;
          if (rn < MT) {
#pragma unroll
            for (int r = 0; r < 2; ++r)
#pragma unroll
                for (int i = 0; i < 2; ++i) xn[r][i] = *(const u32x4*)(X + (size_t)(rn + r) * 1024 + i * 512 + F.lane * 8); } }
        float xf[2][2][8]; float pg[2][8];
#pragma unroll
        for (int r = 0; r < 2; ++r) { float a = 0.f;
#pragma unroll
            for (int j = 0; j < 8; ++j) pg[r][j] = 0.f;
#pragma unroll
            for (int i = 0; i < 2; ++i) { unpack8(xv[r][i], xf[r][i]);
#pragma unroll
                for (int e = 0; e < 8; ++e) { a += xf[r][i][e] * xf[r][i][e];
#pragma unroll
                    for (int j = 0; j < 8; ++j) pg[r][j] += xf[r][i][e] * wg[i][e][j]; } }
            ss[r] = a; }
#pragma unroll
        for (int o = 32; o >= 1; o >>= 1) { ss[0] += __shfl_xor(ss[0], o); ss[1] += __shfl_xor(ss[1], o);
#pragma unroll
            for (int j = 0; j < 8; ++j) { pg[0][j] += __shfl_xor(pg[0][j], o); pg[1][j] += __shfl_xor(pg[1][j], o); } }
#pragma unroll
        for (int r = 0; r < 2; ++r) { const int row = row0 + r;
            const float rs = rsqrtf(ss[r] * (1.0f / 1024.0f) + 1e-6f);
#pragma unroll
            for (int i = 0; i < 2; ++i) { float y[8];
#pragma unroll
                for (int e = 0; e < 8; ++e) y[e] = xf[r][i][e] * rs * gg[i][e];
                uint4 pk; pk.x = pack2(y[0], y[1]); pk.y = pack2(y[2], y[3]); pk.z = pack2(y[4], y[5]); pk.w = pack2(y[6], y[7]); *(uint4*)(Ob + (size_t)row * 1024 + i * 512 + F.lane * 8) = pk; }
            float mine = 0.f;
#pragma unroll
            for (int j = 0; j < 8; ++j) if (F.lane == j) mine = pg[r][j] * rs;
            if (F.lane < 8) gts[(size_t)row * 8 + F.lane] = mine; }
    }
}
DI void p0_prologue(const Frame& F) {
    unsigned char* ws = F.ws;
    transpose_all(F);
    { bf16_t* wat = (bf16_t*)(ws + WS_WAT); bf16_t* wxt = (bf16_t*)(ws + WS_WXT);
      for (int idx = F.bid * 512 + F.tid; idx < 8 * 64 * 64; idx += F.G * 512) { const int g = idx >> 12, j = (idx >> 6) & 63, i = idx & 63;
          wat[idx] = f2bf(F.in[19][(size_t)(g * 64 + i) * 64 + j]); wxt[idx] = f2bf(F.in[21][(size_t)(g * 64 + i) * 64 + j]); } }
    { float* ssz = (float*)(ws + WS_SS); for (int i = F.bid * 512 + F.tid; i < MT; i += F.G * 512) ssz[i] = 0.f; }
    { float* imgn = (float*)(ws + WS_IMGN); float* imgd = (float*)(ws + WS_IMGD); float* imgw = (float*)(ws + WS_IMGW); float* imgz = (float*)(ws + WS_IMGZ);
      for (int idx = F.bid * 512 + F.tid; idx < (6 + 8 + 1) * 16384 + 2048; idx += F.G * 512) {
          const int e = idx & 3, ln = (idx >> 2) & 63, G = (idx >> 8) & 7, wv = (idx >> 11) & 7, im = idx >> 14;
          const int R = 4 * G + e, i = R & 15, hf_ = ln >> 5, r_ = ln & 31, koff = 32 * (R >> 4) + (i & 3) + 8 * (i >> 2) + 4 * hf_;
          if (im < 6) { const int g = im / 3, dl = im % 3, ql = r_ >> 2, hh = g * 4 + (r_ & 3); const int dist = 64 * dl + 8 * wv + ql - koff;
              imgn[idx] = dist < 0 ? NEG_INF : F.biasL[hh * 128 + (dist > 127 ? 127 : dist)]; }
          else if (im < 14) { const int k = im - 6, par = k >> 2, dl = k & 3, ql = r_ >> 3, hh = 8 + (r_ & 7); const int dist = 32 * par + 4 * wv + ql + 64 * dl - koff;
              imgd[idx - 6 * 16384] = dist < 0 ? NEG_INF : F.biasL[hh * 128 + (dist > 127 ? 127 : dist)]; }
          else if (im < 15) { const int ql = r_ >> 2; imgw[idx - 14 * 16384] = (koff > 8 * wv + ql) ? 0.f : NEG_INF; }
          else imgz[idx - 15 * 16384] = 0.f; } }
    rmsnorm_rows<0>(F, F.in[0], F.in[2], (bf16_t*)(ws + WS_BFA), nullptr);
    { const float* p = F.in[1]; bf16_t* pb = (bf16_t*)(ws + WS_PBF); const size_t n8 = (size_t)2 * MT * 256 / 8;
      const size_t str = (size_t)F.G * 512; size_t i = (size_t)F.bid * 512 + F.tid;
      for (; i + 3 * str < n8; i += 4 * str) {
          f32x4 a[4], b[4];
#pragma unroll
          for (int u = 0; u < 4; ++u) { a[u] = *(const f32x4*)(p + (i + u * str) * 8); b[u] = *(const f32x4*)(p + (i + u * str) * 8 + 4); }
#pragma unroll
          for (int u = 0; u < 4; ++u) { uint4 o; o.x = pack2(a[u][0], a[u][1]); o.y = pack2(a[u][2], a[u][3]); o.z = pack2(b[u][0], b[u][1]); o.w = pack2(b[u][2], b[u][3]); *(uint4*)(pb + (i + u * str) * 8) = o; } }
      for (; i < n8; i += str) {
          const f32x4 a = *(const f32x4*)(p + i * 8), b = *(const f32x4*)(p + i * 8 + 4);
          uint4 o; o.x = pack2(a[0], a[1]); o.y = pack2(a[2], a[3]); o.z = pack2(b[0], b[1]); o.w = pack2(b[2], b[3]); *(uint4*)(pb + i * 8) = o; } }
}

DI void p2a_build_blocks(const Frame& F) {
    { const int gt = F.bid * 512 + F.tid;
      if (gt < 1024) { const int bg = gt >> 6, d = gt & 63; ((float*)(F.ws + WS_KCMP))[((size_t)bg * 256 + 255) * 64 + d] = 0.f; ((float*)(F.ws + WS_VCMP))[((size_t)bg * 256 + 255) * 64 + d] = 0.f;
          ((bf16_t*)(F.ws + WS_VCT))[((size_t)bg * 64 + d) * 256 + 255] = 0; } }
    const bf16_t* U = (const bf16_t*)(F.ws + WS_U);
    bf16_t* AK = (bf16_t*)(F.ws + WS_AK); bf16_t* AV = (bf16_t*)(F.ws + WS_AV);
    const float* posk = F.in[9]; const float* posv = F.in[12];
    const size_t nitem = (size_t)2 * 4096 * 32 * 8;
    for (size_t it = (size_t)F.bid * 512 + F.tid; it < nitem; it += (size_t)F.G * 512) {
        const int c8 = (int)(it & 7), l = (int)((it >> 3) & 31), r = (int)((it >> 8) & 4095), which = (int)(it >> 20);
        bf16_t* dst = (which ? AV : AK) + (size_t)r * 2048 + l * 64 + c8 * 8;
        uint4 o = make_uint4(0u, 0u, 0u, 0u);
        if (r < 4080) {
            const int b = r / 510, rem = r % 510, i = rem >> 1, g = rem & 1;
            const bf16_t* sp = U + ((size_t)b * SEQ + 16 * i + l) * LD0 + (which ? C_VC : C_KC) + g * 64 + c8 * 8;
            const float* pp = (which ? posv : posk) + l * 64 + c8 * 8;
            const uint4 v = *(const uint4*)sp; float f[8]; unpack8(v, f);
            o.x = pack2(f[0] + pp[0], f[1] + pp[1]); o.y = pack2(f[2] + pp[2], f[3] + pp[3]); o.z = pack2(f[4] + pp[4], f[5] + pp[5]); o.w = pack2(f[6] + pp[6], f[7] + pp[7]);
        }
        *(uint4*)dst = o;
    }
}
DI void p2c_compress_rows(const Frame& F, int which, int row0) {
    const bf16_t* H = (const bf16_t*)(F.ws + (which ? WS_HV : WS_HK));
    float* OUT = (float*)(F.ws + (which ? WS_VCMP : WS_KCMP));
    const float* w2 = which ? F.in[14] : F.in[11];
    typedef float f32x16_ __attribute__((ext_vector_type(16)));
    const int c32 = F.lane & 31, kh = F.lane >> 5;
    const int rbase = row0 + 32 * F.wave;
    const bf16_t* hrow = H + (size_t)(rbase + c32) * 256 + 8 * kh;
    f32x16_ acc0, acc1;
#pragma unroll
    for (int i = 0; i < 16; ++i) { acc0[i] = 0.f; acc1[i] = 0.f; }
#pragma unroll 4
    for (int ks = 0; ks < 16; ++ks) {
        const bf16x8 a = *(const bf16x8*)(hrow + 16 * ks);
        const float* wp = w2 + (size_t)(16 * ks + 8 * kh) * 64 + c32;
        float f0[8], f1[8];
#pragma unroll
        for (int j = 0; j < 8; ++j) { f0[j] = wp[j * 64]; f1[j] = wp[j * 64 + 32]; }
        u32x4 p0, p1;
#pragma unroll
        for (int j = 0; j < 4; ++j) { p0[j] = pack2(f0[2 * j], f0[2 * j + 1]); p1[j] = pack2(f1[2 * j], f1[2 * j + 1]); }
        acc0 = __builtin_amdgcn_mfma_f32_32x32x16_bf16(a, __builtin_bit_cast(bf16x8, p0), acc0, 0, 0, 0);
        acc1 = __builtin_amdgcn_mfma_f32_32x32x16_bf16(a, __builtin_bit_cast(bf16x8, p1), acc1, 0, 0, 0);
    }
#pragma unroll
    for (int i = 0; i < 16; ++i) { const int r = rbase + (i & 3) + 8 * (i >> 2) + 4 * kh; if (r < 4080) {
        const int b = r / 510, rem = r % 510, ci = rem >> 1, g = rem & 1, bg = b * 2 + g;
        OUT[((size_t)bg * 256 + ci) * 64 + c32] = acc0[i]; OUT[((size_t)bg * 256 + ci) * 64 + 32 + c32] = acc1[i];
        if (which) { bf16_t* vct = (bf16_t*)(F.ws + WS_VCT); vct[((size_t)bg * 64 + c32) * 256 + ci] = f2bf(acc0[i]); vct[((size_t)bg * 64 + 32 + c32) * 256 + ci] = f2bf(acc1[i]); } } }
}

typedef float f32x16 __attribute__((ext_vector_type(16)));
#define MFMA32(a, b, c) __builtin_amdgcn_mfma_f32_32x32x16_bf16((a), (b), (c), 0, 0, 0)
constexpr float LOG2E = 1.4426950408889634f;
constexpr float QK_C1 = 0.125f * LOG2E;
constexpr int AT_BUF = 0;
constexpr int AT_PSUM = 65536;
constexpr int AT_XM = AT_PSUM + 16384;
constexpr int AT_SELM = AT_PSUM + 65536;
constexpr int AT_MISC = AT_SELM + 1024;
constexpr int AT_END = AT_MISC + 64 + 2048;
static_assert(AT_END + LDS_WORK_OFF <= LDS_BYTES - 12288, "attention lds");
enum { FL_NEAR = 1, FL_CAUSAL = 2, FL_WINLO = 4, FL_BITS = 8, FL_LANE = 16 };

struct Att { float m, l; f32x16 o0, o1; };
DI void att_init(Att& a) { a.m = NEG_INF; a.l = 0.f;
#pragma unroll
    for (int i = 0; i < 16; ++i) { a.o0[i] = 0.f; a.o1[i] = 0.f; } }

typedef unsigned u32x4 __attribute__((ext_vector_type(4)));
#define OPAQUE(x) asm volatile("" : "+v"(x))
DI void st_write_K(LAS unsigned char* Kt, int tid, const uint4& rg) {
    OPAQUE(tid);
    const int key = tid >> 3, c = tid & 7;
    const u32x4 v = {rg.x, rg.y, rg.z, rg.w};
    *(LAS u32x4*)(Kt + (key ^ ((key >> 3) & 1)) * 128 + ((c ^ (key & 7)) << 4)) = v;
}
DI void st_write_VT(LAS unsigned char* Vt, int tid, const uint4& rg) {
    OPAQUE(tid);
    const int d = tid >> 3, m = tid & 7, G = m >> 1, a = m & 1, sw = (d >> 1) & 7;
    typedef unsigned u32x2 __attribute__((ext_vector_type(2)));
    const u32x2 lo = {rg.x, rg.y}, hi = {rg.z, rg.w};
    *(LAS u32x2*)(Vt + d * 128 + (((2 * G) ^ sw) << 4) + 8 * a) = lo;
    *(LAS u32x2*)(Vt + d * 128 + (((2 * G + 1) ^ sw) << 4) + 8 * a) = hi;
}
template <bool CINIT = false, bool BATCH = false>
DI void qk_tile(const LAS unsigned char* Kt, const bf16x8 (&qf)[4], int r, int hf, f32x16& s0, f32x16& s1) {
    OPAQUE(r); OPAQUE(hf);
    const f32x16 zero16 = {0.f, 0.f, 0.f, 0.f, 0.f, 0.f, 0.f, 0.f, 0.f, 0.f, 0.f, 0.f, 0.f, 0.f, 0.f, 0.f};
    if (BATCH) {
        bf16x8 a0[4], a1[4];
#pragma unroll
        for (int s = 0; s < 4; ++s) { const int c = 2 * s + hf; const int pr = r ^ ((r >> 3) & 1);
            a0[s] = *(const LAS bf16x8*)(Kt + pr * 128 + ((c ^ (r & 7)) << 4)); a1[s] = *(const LAS bf16x8*)(Kt + (32 + pr) * 128 + ((c ^ (r & 7)) << 4)); }
        __builtin_amdgcn_sched_barrier(0);
#pragma unroll
        for (int s = 0; s < 4; ++s) {
            if (s == 0 && !CINIT) { s0 = MFMA32(a0[0], qf[0], zero16); s1 = MFMA32(a1[0], qf[0], zero16); }
            else { s0 = MFMA32(a0[s], qf[s], s0); s1 = MFMA32(a1[s], qf[s], s1); } }
        return; }
#pragma unroll
    for (int s = 0; s < 4; ++s) {
        const int c = 2 * s + hf;
        const int pr = r ^ ((r >> 3) & 1);
        const bf16x8 a0 = *(const LAS bf16x8*)(Kt + pr * 128 + ((c ^ (r & 7)) << 4));
        const bf16x8 a1 = *(const LAS bf16x8*)(Kt + (32 + pr) * 128 + ((c ^ (r & 7)) << 4));
        if (s == 0 && !CINIT) { s0 = MFMA32(a0, qf[0], zero16); s1 = MFMA32(a1, qf[0], zero16); }
        else { s0 = MFMA32(a0, qf[s], s0); s1 = MFMA32(a1, qf[s], s1); }
    }
}
DI int kimg_ofs(int tid) { const int key = tid >> 3, c = tid & 7; return (key ^ ((key >> 3) & 1)) * 128 + ((c ^ (key & 7)) << 4); }
DI int vimg_ofs(int tid) { const int d = tid >> 3, m = tid & 7, G = m >> 1, a = m & 1, sw = (d >> 1) & 7; return d * 128 + (((2 * G) ^ sw) << 4) + 8 * a; }
DI void st_write_K2(LAS unsigned char* Kt, int kofs, const uint4& rg) { const u32x4 v = {rg.x, rg.y, rg.z, rg.w}; *(LAS u32x4*)(Kt + kofs) = v; }
DI void st_write_VT2(LAS unsigned char* Vt, int vofs, const uint4& rg) {
    typedef unsigned u32x2 __attribute__((ext_vector_type(2)));
    const u32x2 lo = {rg.x, rg.y}, hi = {rg.z, rg.w};
    *(LAS u32x2*)(Vt + vofs) = lo; *(LAS u32x2*)(Vt + (vofs ^ 16)) = hi;
}
template <int FLAGS>
DI void fix_scores(f32x16& s, int posb, int kstep, int tq, const LAS float* bl, float bfar, unsigned mword, bool laneok, int hf) {
    OPAQUE(hf); OPAQUE(tq);
#pragma unroll
    for (int i = 0; i < 16; ++i) {
        const int koff = (i & 3) + 8 * (i >> 2) + 4 * hf;
        const int dist = tq - (posb + kstep * koff);
        float bias = bfar;
        if (FLAGS & FL_NEAR) { int dd = dist < 0 ? 0 : dist; dd = dd > 127 ? 127 : dd; bias = bl[dd]; }
        const float v = s[i] * QK_C1 + bias;
        bool ok = true;
        if (FLAGS & FL_CAUSAL) ok = ok && (dist >= 0);
        if (FLAGS & FL_WINLO) ok = ok && (dist < 512);
        if (FLAGS & FL_BITS) ok = ok && (((mword >> koff) & 1u) != 0u);
        if (FLAGS & FL_LANE) ok = ok && laneok;
        s[i] = ok ? v : NEG_INF;
    }
}
DI bf16x8 pack8(const f32x16& x, int s) {
    typedef unsigned u32x4 __attribute__((ext_vector_type(4)));
    u32x4 p;
    p[0] = pack2(x[8 * s + 0], x[8 * s + 1]); p[1] = pack2(x[8 * s + 2], x[8 * s + 3]); p[2] = pack2(x[8 * s + 4], x[8 * s + 5]); p[3] = pack2(x[8 * s + 6], x[8 * s + 7]);
    return __builtin_bit_cast(bf16x8, p);
}
DI void pv_tile(const LAS unsigned char* Vt, const f32x16& p0, const f32x16& p1, int r, int hf, f32x16& o0, f32x16& o1) {
#pragma unroll
    for (int G = 0; G < 4; ++G) {
        const bf16x8 pb = pack8((G >> 1) ? p1 : p0, G & 1);
        const int cc = 2 * G + hf;
        const bf16x8 a0 = *(const LAS bf16x8*)(Vt + r * 128 + ((cc ^ ((r >> 1) & 7)) << 4));
        const bf16x8 a1 = *(const LAS bf16x8*)(Vt + (32 + r) * 128 + ((cc ^ ((r >> 1) & 7)) << 4));
        o0 = MFMA32(a0, pb, o0); o1 = MFMA32(a1, pb, o1);
    }
}
DI void online_pv(Att& st, f32x16& s0, f32x16& s1, const LAS unsigned char* Vt, int r, int hf) {
    float tm = NEG_INF;
#pragma unroll
    for (int i = 0; i < 16; ++i) tm = fmaxf(tm, fmaxf(s0[i], s1[i]));
    tm = fmaxf(tm, __shfl_xor(tm, 32));
    const float mn = fmaxf(st.m, tm);
    const float mu = (mn == NEG_INF) ? 0.f : mn;
    const float alpha = __builtin_amdgcn_exp2f(st.m - mu);
    float ls = 0.f;
#pragma unroll
    for (int i = 0; i < 16; ++i) { s0[i] = __builtin_amdgcn_exp2f(s0[i] - mu); s1[i] = __builtin_amdgcn_exp2f(s1[i] - mu); ls += s0[i] + s1[i]; }
    st.l = st.l * alpha + ls;
    if (__ballot(mn != st.m) != 0ull) {
#pragma unroll
        for (int i = 0; i < 16; ++i) { st.o0[i] *= alpha; st.o1[i] *= alpha; } }
    st.m = mn;
    pv_tile(Vt, s0, s1, r, hf, st.o0, st.o1);
}
DI unsigned bitmask32(unsigned w, int pos) { unsigned m; asm("v_bfe_i32 %0, %1, %2, 1" : "=v"(m) : "v"(w), "n"(pos)); return m; }
template <bool BITS, bool NEARB, bool CAUSAL = false>
DI void far_soft(Att& st, f32x16& s0, f32x16& s1, const LAS unsigned char* Vt, int r, int hf, float bfar, bool laneok, unsigned m0, unsigned m1,
                 int tq, int posb, const LAS float* bl) {
    const float cb = laneok ? bfar - st.m : NEG_INF;
    const float nm = laneok ? -st.m : NEG_INF;
    const int dbase = tq - posb - 4 * hf;
    const unsigned w0 = m0 >> (4 * hf), w1 = m1 >> (4 * hf);
    const f32x2 c1v = {1.0f, 1.0f}; f32x2 cbv = {cb, cb}; f32x2 ls2 = {0.f, 0.f};
#pragma unroll
    for (int i = 0; i < 16; i += 2) { const f32x2 sv = {s0[i], s0[i + 1]};
        if (NEARB) { int d0 = dbase - ((i & 3) + 8 * (i >> 2)), d1 = dbase - (((i + 1) & 3) + 8 * ((i + 1) >> 2)); const bool k0 = d0 >= 0, k1 = d1 >= 0;
            d0 = d0 > 127 ? 127 : d0; d1 = d1 > 127 ? 127 : d1; if (CAUSAL) { d0 = d0 < 0 ? 0 : d0; d1 = d1 < 0 ? 0 : d1; }
            cbv[0] = bl[d0] + nm; cbv[1] = bl[d1] + nm; if (CAUSAL) { cbv[0] = k0 ? cbv[0] : NEG_INF; cbv[1] = k1 ? cbv[1] : NEG_INF; } }
        const f32x2 av = sv * c1v + cbv;
        f32x2 pv; pv[0] = __builtin_amdgcn_exp2f(av[0]); pv[1] = __builtin_amdgcn_exp2f(av[1]);
        if (BITS) { pv[0] = __uint_as_float(__float_as_uint(pv[0]) & bitmask32(w0, (i & 3) + 8 * (i >> 2)));
                    pv[1] = __uint_as_float(__float_as_uint(pv[1]) & bitmask32(w0, ((i + 1) & 3) + 8 * ((i + 1) >> 2))); }
        s0[i] = pv[0]; s0[i + 1] = pv[1]; ls2 += pv; }
    const int rr = r;
#pragma unroll
    for (int G = 0; G < 2; ++G) { const bf16x8 pb = pack8(s0, G); const int cc = 2 * G + hf;
        const bf16x8 a0 = *(const LAS bf16x8*)(Vt + rr * 128 + ((cc ^ ((rr >> 1) & 7)) << 4)); const bf16x8 a1 = *(const LAS bf16x8*)(Vt + (32 + rr) * 128 + ((cc ^ ((rr >> 1) & 7)) << 4));
        st.o0 = MFMA32(a0, pb, st.o0); st.o1 = MFMA32(a1, pb, st.o1); }
#pragma unroll
    for (int i = 0; i < 16; i += 2) { const f32x2 sv = {s1[i], s1[i + 1]};
        if (NEARB) { int d0 = dbase - 32 - ((i & 3) + 8 * (i >> 2)), d1 = dbase - 32 - (((i + 1) & 3) + 8 * ((i + 1) >> 2)); const bool k0 = d0 >= 0, k1 = d1 >= 0;
            d0 = d0 > 127 ? 127 : d0; d1 = d1 > 127 ? 127 : d1; if (CAUSAL) { d0 = d0 < 0 ? 0 : d0; d1 = d1 < 0 ? 0 : d1; }
            cbv[0] = bl[d0] + nm; cbv[1] = bl[d1] + nm; if (CAUSAL) { cbv[0] = k0 ? cbv[0] : NEG_INF; cbv[1] = k1 ? cbv[1] : NEG_INF; } }
        const f32x2 av = sv * c1v + cbv;
        f32x2 pv; pv[0] = __builtin_amdgcn_exp2f(av[0]); pv[1] = __builtin_amdgcn_exp2f(av[1]);
        if (BITS) { pv[0] = __uint_as_float(__float_as_uint(pv[0]) & bitmask32(w1, (i & 3) + 8 * (i >> 2)));
                    pv[1] = __uint_as_float(__float_as_uint(pv[1]) & bitmask32(w1, ((i + 1) & 3) + 8 * ((i + 1) >> 2))); }
        s1[i] = pv[0]; s1[i + 1] = pv[1]; ls2 += pv; }
#pragma unroll
    for (int G = 2; G < 4; ++G) { const bf16x8 pb = pack8(s1, G & 1); const int cc = 2 * G + hf;
        const bf16x8 a0 = *(const LAS bf16x8*)(Vt + rr * 128 + ((cc ^ ((rr >> 1) & 7)) << 4)); const bf16x8 a1 = *(const LAS bf16x8*)(Vt + (32 + rr) * 128 + ((cc ^ ((rr >> 1) & 7)) << 4));
        st.o0 = MFMA32(a0, pb, st.o0); st.o1 = MFMA32(a1, pb, st.o1); }
    st.l += ls2[0] + ls2[1];
}
template <bool BITS, bool NEARB, bool CAUSAL = false, bool QB = false>
DI void far_tile(Att& st, const LAS unsigned char* Kt, const LAS unsigned char* Vt, const bf16x8 (&qf)[4], int r, int hf, float bfar, bool laneok, unsigned m0, unsigned m1,
                 int tq, int posb, const LAS float* bl) {
    f32x16 s0, s1; qk_tile<false, QB>(Kt, qf, r, hf, s0, s1);
    far_soft<BITS, NEARB, CAUSAL>(st, s0, s1, Vt, r, hf, bfar, laneok, m0, m1, tq, posb, bl);
}
template <int Q, bool RAW> DI void expq(f32x16& s, const f32x2 c1v, const f32x2 cbv, f32x2& ls2) {
    (void)c1v;
    const f32x2 v0 = {s[4 * Q], s[4 * Q + 1]}, v1 = {s[4 * Q + 2], s[4 * Q + 3]};
    const f32x2 a0 = RAW ? v0 : v0 + cbv, a1 = RAW ? v1 : v1 + cbv;
    f32x2 p0, p1; p0[0] = __builtin_amdgcn_exp2f(a0[0]); p0[1] = __builtin_amdgcn_exp2f(a0[1]); p1[0] = __builtin_amdgcn_exp2f(a1[0]); p1[1] = __builtin_amdgcn_exp2f(a1[1]);
    s[4 * Q] = p0[0]; s[4 * Q + 1] = p0[1]; s[4 * Q + 2] = p1[0]; s[4 * Q + 3] = p1[1]; ls2 += p0; ls2 += p1;
}
DI void scale_q(bf16x8 (&qf)[4]) {
#pragma unroll
    for (int s = 0; s < 4; ++s) { u32x4 u = __builtin_bit_cast(u32x4, qf[s]);
#pragma unroll
        for (int j = 0; j < 4; ++j) u[j] = pack2(__uint_as_float(u[j] << 16) * QK_C1, __uint_as_float(u[j] & 0xFFFF0000u) * QK_C1);
        qf[s] = __builtin_bit_cast(bf16x8, u); }
}
DI void to_raw_scale(Att& st, float bfar) {
    const float f = __builtin_amdgcn_exp2f(st.m - bfar);
    st.l *= f;
#pragma unroll
    for (int i = 0; i < 16; ++i) { st.o0[i] *= f; st.o1[i] *= f; }
    st.m = bfar;
}
DI void ldimg(const LAS unsigned char* xs, f32x16& s0, f32x16& s1) {
#pragma unroll
    for (int g = 0; g < 4; ++g) { const f32x4 a = *(const LAS f32x4*)(xs + g * 16), c = *(const LAS f32x4*)(xs + 64 + g * 16);
        s0[4 * g] = a[0]; s0[4 * g + 1] = a[1]; s0[4 * g + 2] = a[2]; s0[4 * g + 3] = a[3]; s1[4 * g] = c[0]; s1[4 * g + 1] = c[1]; s1[4 * g + 2] = c[2]; s1[4 * g + 3] = c[3]; }
}
DI void ldimg_g(const float* img, int lane, f32x16& s0, f32x16& s1) {
#pragma unroll
    for (int g = 0; g < 4; ++g) { const f32x4 a = *(const f32x4*)(img + g * 256 + lane * 4), c = *(const f32x4*)(img + (4 + g) * 256 + lane * 4);
        s0[4 * g] = a[0]; s0[4 * g + 1] = a[1]; s0[4 * g + 2] = a[2]; s0[4 * g + 3] = a[3]; s1[4 * g] = c[0]; s1[4 * g + 1] = c[1]; s1[4 * g + 2] = c[2]; s1[4 * g + 3] = c[3]; }
}
DI void soft_any(Att& st, f32x16& s0, f32x16& s1, const LAS unsigned char* Vt, int r, int hf, float cbx, bool laneok) {
    if (__ballot(st.m == NEG_INF) == 0ull) { far_soft<false, false>(st, s0, s1, Vt, r, hf, cbx, laneok, 0u, 0u, 0, 0, nullptr); return; }
    const float ad = laneok ? cbx : NEG_INF;
#pragma unroll
    for (int i = 0; i < 16; ++i) { s0[i] = s0[i] + ad; s1[i] = s1[i] + ad; }
    online_pv(st, s0, s1, Vt, r, hf);
}
struct NoHook { DI void operator()() const {} };
template <int CM, bool RAW = false, class M1 = NoHook, class M2 = NoHook>
DI void far_pair(Att& st, const LAS unsigned char* Ka, const LAS unsigned char* Va, const LAS unsigned char* Kb, const LAS unsigned char* Vb, const bf16x8 (&qf)[4], int r, int hf,
                 float cba, float cbb, const LAS unsigned char* xa, const LAS unsigned char* xb, f32x16& s0a, f32x16& s1a, f32x16& s0b, f32x16& s1b, M1 mid1 = M1(), M2 mid2 = M2()) {
    OPAQUE(r); OPAQUE(hf);
    const f32x16 zero16 = {0.f, 0.f, 0.f, 0.f, 0.f, 0.f, 0.f, 0.f, 0.f, 0.f, 0.f, 0.f, 0.f, 0.f, 0.f, 0.f};
    const int pr = r ^ ((r >> 3) & 1);
    const int kro = pr * 128, kx = r & 7;
    const int vro = r * 128, vx = (r >> 1) & 7;
#define KF0(K, s) (*(const LAS bf16x8*)((K) + kro + (((2 * (s) + hf) ^ kx) << 4)))
#define KF1(K, s) (*(const LAS bf16x8*)((K) + 4096 + kro + (((2 * (s) + hf) ^ kx) << 4)))
#define VF0(V, G) (*(const LAS bf16x8*)((V) + vro + (((2 * (G) + hf) ^ vx) << 4)))
#define VF1(V, G) (*(const LAS bf16x8*)((V) + 4096 + vro + (((2 * (G) + hf) ^ vx) << 4)))
    const f32x2 c1v = {1.0f, 1.0f}, cav = {cba, cba}, cbv = {cbb, cbb}; f32x2 ls2 = {0.f, 0.f};
    { bf16x8 k0[4], k1[4];
#pragma unroll
      for (int s = 0; s < 4; ++s) { k0[s] = KF0(Ka, s); k1[s] = KF1(Ka, s); }
      if (CM == 1) { ldimg(xa, s0a, s1a); ldimg(xb, s0b, s1b); }
  #pragma unroll
      for (int s = 0; s < 4; ++s) {
          if (s == 0 && !CM) { s0a = MFMA32(k0[0], qf[0], zero16); s1a = MFMA32(k1[0], qf[0], zero16); }
          else { s0a = MFMA32(k0[s], qf[s], s0a); s1a = MFMA32(k1[s], qf[s], s1a); } } }
    bf16x8 kb0[4], kb1[4];
#pragma unroll
    for (int s = 0; s < 2; ++s) { kb0[s] = KF0(Kb, s); kb1[s] = KF1(Kb, s); }
    if (!CM) s0b = MFMA32(kb0[0], qf[0], zero16); else s0b = MFMA32(kb0[0], qf[0], s0b);
    mid1();
    expq<0, RAW>(s0a, c1v, cav, ls2);
    if (!CM) s1b = MFMA32(kb1[0], qf[0], zero16); else s1b = MFMA32(kb1[0], qf[0], s1b);
    expq<1, RAW>(s0a, c1v, cav, ls2);
    s0b = MFMA32(kb0[1], qf[1], s0b);
    expq<2, RAW>(s0a, c1v, cav, ls2);
    s1b = MFMA32(kb1[1], qf[1], s1b);
    expq<3, RAW>(s0a, c1v, cav, ls2);
    bf16x8 pa0 = pack8(s0a, 0), pa1 = pack8(s0a, 1);
    bf16x8 vf0[2], vf1[2];
#pragma unroll
    for (int s = 2; s < 4; ++s) { kb0[s] = KF0(Kb, s); kb1[s] = KF1(Kb, s); }
#pragma unroll
    for (int G = 0; G < 2; ++G) { vf0[G] = VF0(Va, G); vf1[G] = VF1(Va, G); }
    s0b = MFMA32(kb0[2], qf[2], s0b);
    mid2();
    expq<0, RAW>(s1a, c1v, cav, ls2);
    s1b = MFMA32(kb1[2], qf[2], s1b); st.o0 = MFMA32(vf0[0], pa0, st.o0);
    expq<1, RAW>(s1a, c1v, cav, ls2);
    s0b = MFMA32(kb0[3], qf[3], s0b); st.o1 = MFMA32(vf1[0], pa0, st.o1);
    expq<2, RAW>(s1a, c1v, cav, ls2);
    s1b = MFMA32(kb1[3], qf[3], s1b); st.o0 = MFMA32(vf0[1], pa1, st.o0);
    expq<3, RAW>(s1a, c1v, cav, ls2);
    st.o1 = MFMA32(vf1[1], pa1, st.o1);
    pa0 = pack8(s1a, 0); pa1 = pack8(s1a, 1);
#pragma unroll
    for (int G = 0; G < 2; ++G) { vf0[G] = VF0(Va, 2 + G); vf1[G] = VF1(Va, 2 + G); }
    expq<0, RAW>(s0b, c1v, cbv, ls2);
    st.o0 = MFMA32(vf0[0], pa0, st.o0);
    expq<1, RAW>(s0b, c1v, cbv, ls2);
    st.o1 = MFMA32(vf1[0], pa0, st.o1);
    expq<2, RAW>(s0b, c1v, cbv, ls2);
    st.o0 = MFMA32(vf0[1], pa1, st.o0);
    expq<3, RAW>(s0b, c1v, cbv, ls2);
    st.o1 = MFMA32(vf1[1], pa1, st.o1);
    pa0 = pack8(s0b, 0); pa1 = pack8(s0b, 1);
#pragma unroll
    for (int G = 0; G < 2; ++G) { vf0[G] = VF0(Vb, G); vf1[G] = VF1(Vb, G); }
    expq<0, RAW>(s1b, c1v, cbv, ls2);
    st.o0 = MFMA32(vf0[0], pa0, st.o0);
    expq<1, RAW>(s1b, c1v, cbv, ls2);
    st.o1 = MFMA32(vf1[0], pa0, st.o1);
    expq<2, RAW>(s1b, c1v, cbv, ls2);
    st.o0 = MFMA32(vf0[1], pa1, st.o0);
    expq<3, RAW>(s1b, c1v, cbv, ls2);
    st.o1 = MFMA32(vf1[1], pa1, st.o1);
    pa0 = pack8(s1b, 0); pa1 = pack8(s1b, 1);
#pragma unroll
    for (int G = 0; G < 2; ++G) { vf0[G] = VF0(Vb, 2 + G); vf1[G] = VF1(Vb, 2 + G); }
    st.o0 = MFMA32(vf0[0], pa0, st.o0); st.o1 = MFMA32(vf1[0], pa0, st.o1);
    st.o0 = MFMA32(vf0[1], pa1, st.o0); st.o1 = MFMA32(vf1[1], pa1, st.o1);
    st.l += ls2[0] + ls2[1];
#undef KF0
#undef KF1
#undef VF0
#undef VF1
}
DI __amdgpu_buffer_rsrc_t make_rsrc(const void* p, int bytes) {
    const unsigned long long a = (unsigned long long)p;
    const unsigned lo = (unsigned)__builtin_amdgcn_readfirstlane((int)(unsigned)a), hi = (unsigned)__builtin_amdgcn_readfirstlane((int)(unsigned)(a >> 32));
    return __builtin_amdgcn_make_buffer_rsrc((void*)(((unsigned long long)hi << 32) | lo), 0, bytes, 0x00020000);
}
DI uint4 bufld16(__amdgpu_buffer_rsrc_t rs, int voff, int soff) {
    const u32x4 v = __builtin_amdgcn_raw_buffer_load_b128(rs, voff, __builtin_amdgcn_readfirstlane(soff), 0);
    return make_uint4(v[0], v[1], v[2], v[3]);
}
#define LDS_BARRIER() do { asm volatile("s_waitcnt lgkmcnt(0)" ::: "memory"); __builtin_amdgcn_s_barrier(); asm volatile("" ::: "memory"); } while (0)
template <class LD, class BODY>
DI void tile_stream(int n, LAS unsigned char* buf, int tid, bool useV, LD ld, BODY body) {
    if (n <= 0) return;
    uint4 rk0, rk1 = make_uint4(0u, 0u, 0u, 0u), rv0 = make_uint4(0u, 0u, 0u, 0u), rv1 = make_uint4(0u, 0u, 0u, 0u);
    ld(0, rk0, rv0); if (n > 1) ld(1, rk1, rv1);
    st_write_K(buf, tid, rk0); if (useV) st_write_VT(buf + 8192, tid, rv0);
    if (n > 1) { st_write_K(buf + 16384, tid, rk1); if (useV) st_write_VT(buf + 24576, tid, rv1); }
    if (n > 2) ld(2, rk0, rv0); if (n > 3) ld(3, rk1, rv1);
    LDS_BARRIER();
#pragma unroll 1
    for (int i = 0; i < n; i += 2) {
        LAS unsigned char* cur = buf + ((i >> 1) & 1) * 32768;
        if (i + 2 < n) { LAS unsigned char* nxt = buf + (((i >> 1) + 1) & 1) * 32768;
            st_write_K(nxt, tid, rk0); if (useV) st_write_VT(nxt + 8192, tid, rv0);
            if (i + 3 < n) { st_write_K(nxt + 16384, tid, rk1); if (useV) st_write_VT(nxt + 24576, tid, rv1); }
            if (i + 4 < n) ld(i + 4, rk0, rv0); if (i + 5 < n) ld(i + 5, rk1, rv1); }
        body(i, cur, cur + 8192);
        if (i + 1 < n) body(i + 1, cur + 16384, cur + 24576);
        LDS_BARRIER();
    }
}
struct Prel { uint4 k0, v0, k1, v1; };
template <bool DEEP, bool NEARP, bool PREL = false, class LD, class PRE, class BG, class BN2, class BF, class BF2, class RD, class EF>
DI void tile_stream2(int n, LAS unsigned char* buf, int tid, LD ld, PRE pre, BG bodyG, BN2 bodyN2, BF bodyF, BF2 bodyF2, int ng, RD ready, EF enter_far, const Prel& pl = Prel()) {
    if (n <= 0) return;
    const int kofs = kimg_ofs(tid), vofs = vimg_ofs(tid);
    uint4 rk0, rk1 = make_uint4(0u, 0u, 0u, 0u), rv0 = make_uint4(0u, 0u, 0u, 0u), rv1 = make_uint4(0u, 0u, 0u, 0u);
    if (PREL) { rk0 = pl.k0; rv0 = pl.v0; rk1 = pl.k1; rv1 = pl.v1; } else { ld(0, rk0, rv0); if (n > 1) ld(1, rk1, rv1); }
    st_write_K2(buf, kofs, rk0); st_write_VT2(buf + 8192, vofs, rv0);
    if (n > 1) { st_write_K2(buf + 16384, kofs, rk1); st_write_VT2(buf + 24576, vofs, rv1); }
    if (n > 2) ld(2, rk0, rv0); if (n > 3) ld(3, rk1, rv1);
    LDS_BARRIER();
    auto stage = [&](int i) {
        if (i + 2 < n) { LAS unsigned char* nxt = buf + (((i >> 1) + 1) & 1) * 32768;
            st_write_K2(nxt, kofs, rk0); st_write_VT2(nxt + 8192, vofs, rv0);
            if (i + 3 < n) { st_write_K2(nxt + 16384, kofs, rk1); st_write_VT2(nxt + 24576, vofs, rv1); }
            if (i + 4 < n) ld(i + 4, rk0, rv0); if (i + 5 < n) ld(i + 5, rk1, rv1); } };
    int i = 0;
#pragma unroll 1
    for (; i < n; i += 2) {
        if (NEARP ? (i >= 2 && ready() && (i >= ng || i + 1 < n)) : (i >= ng && ready())) break;
        LAS unsigned char* cur = buf + ((i >> 1) & 1) * 32768;
        stage(i);
#pragma unroll 1
        for (int t = 0; t < 2; ++t) if (i + t < n) { f32x16 ia0, ia1; pre(i + t, ia0, ia1); bodyG(i + t, cur + t * 16384, cur + t * 16384 + 8192, ia0, ia1); }
        LDS_BARRIER();
    }
#pragma unroll 1
    for (; NEARP && i < ng && i + 1 < n; i += 2) {
        LAS unsigned char* cur = buf + ((i >> 1) & 1) * 32768;
        stage(i);
        bodyN2(i, cur);
        LDS_BARRIER();
    }
    enter_far();
    if (!DEEP) {
#pragma unroll 1
        for (; i + 1 < n; i += 2) {
            LAS unsigned char* cur = buf + ((i >> 1) & 1) * 32768;
            bodyF2(i, cur, [&]() { stage(i); }, NoHook());
            LDS_BARRIER();
        }
        if (i < n) { bodyF(i, buf + ((i >> 1) & 1) * 32768, buf + ((i >> 1) & 1) * 32768 + 8192); LDS_BARRIER(); }
        return;
    }
    uint4 qk0 = make_uint4(0u, 0u, 0u, 0u), qk1 = make_uint4(0u, 0u, 0u, 0u), qv0 = make_uint4(0u, 0u, 0u, 0u), qv1 = make_uint4(0u, 0u, 0u, 0u);
    if (i + 1 < n) { if (i + 4 < n) ld(i + 4, qk0, qv0); if (i + 5 < n) ld(i + 5, qk1, qv1); }
#pragma unroll 1
    for (; i + 1 < n; i += 4) {
        { LAS unsigned char* cur = buf + ((i >> 1) & 1) * 32768;
          bodyF2(i, cur,
              [&]() { if (i + 2 < n) { LAS unsigned char* nxt = buf + (((i >> 1) + 1) & 1) * 32768;
                          st_write_K2(nxt, kofs, rk0); st_write_VT2(nxt + 8192, vofs, rv0);
                          if (i + 3 < n) { st_write_K2(nxt + 16384, kofs, rk1); st_write_VT2(nxt + 24576, vofs, rv1); } } },
              [&]() { if (i + 6 < n) ld(i + 6, rk0, rv0); if (i + 7 < n) ld(i + 7, rk1, rv1); });
          LDS_BARRIER(); }
        if (i + 3 >= n) { i += 2; break; }
        { const int i2 = i + 2; LAS unsigned char* cur = buf + ((i2 >> 1) & 1) * 32768;
          bodyF2(i2, cur,
              [&]() { if (i2 + 2 < n) { LAS unsigned char* nxt = buf + (((i2 >> 1) + 1) & 1) * 32768;
                          st_write_K2(nxt, kofs, qk0); st_write_VT2(nxt + 8192, vofs, qv0);
                          if (i2 + 3 < n) { st_write_K2(nxt + 16384, kofs, qk1); st_write_VT2(nxt + 24576, vofs, qv1); } } },
              [&]() { if (i2 + 6 < n) ld(i2 + 6, qk0, qv0); if (i2 + 7 < n) ld(i2 + 7, qk1, qv1); });
          LDS_BARRIER(); }
    }
    if (i < n) {
        bodyF(i, buf + ((i >> 1) & 1) * 32768, buf + ((i >> 1) & 1) * 32768 + 8192); LDS_BARRIER(); }
}
template <class LD, class BODY>
DI void tile_stream_k4(int n, LAS unsigned char* buf, int tid, LD ld, BODY body) {
    if (n <= 0) return;
    const int kofs = kimg_ofs(tid);
    uint4 r0, r1 = make_uint4(0u, 0u, 0u, 0u), r2 = make_uint4(0u, 0u, 0u, 0u), r3 = make_uint4(0u, 0u, 0u, 0u), dv;
    ld(0, r0, dv); if (n > 1) ld(1, r1, dv); if (n > 2) ld(2, r2, dv); if (n > 3) ld(3, r3, dv);
    st_write_K2(buf, kofs, r0); if (n > 1) st_write_K2(buf + 8192, kofs, r1); if (n > 2) st_write_K2(buf + 16384, kofs, r2); if (n > 3) st_write_K2(buf + 24576, kofs, r3);
    if (n > 4) ld(4, r0, dv); if (n > 5) ld(5, r1, dv); if (n > 6) ld(6, r2, dv); if (n > 7) ld(7, r3, dv);
    LDS_BARRIER();
#pragma unroll 1
    for (int i = 0; i < n; i += 4) {
        LAS unsigned char* cur = buf + ((i >> 2) & 1) * 32768;
        if (i + 4 < n) { LAS unsigned char* nxt = buf + (((i >> 2) + 1) & 1) * 32768;
            st_write_K2(nxt, kofs, r0); if (i + 5 < n) st_write_K2(nxt + 8192, kofs, r1); if (i + 6 < n) st_write_K2(nxt + 16384, kofs, r2); if (i + 7 < n) st_write_K2(nxt + 24576, kofs, r3);
            if (i + 8 < n) ld(i + 8, r0, dv); if (i + 9 < n) ld(i + 9, r1, dv); if (i + 10 < n) ld(i + 10, r2, dv); if (i + 11 < n) ld(i + 11, r3, dv); }
#pragma unroll 1
        for (int j = 0; j < 4; ++j) if (i + j < n) body(i + j, cur + j * 8192, cur);
        LDS_BARRIER();
    }
}
DI uint4 cvt8_f32(const float* p) { const f32x4 a = *(const f32x4*)p, b = *(const f32x4*)(p + 4); uint4 o; o.x = pack2(a[0], a[1]); o.y = pack2(a[2], a[3]); o.z = pack2(b[0], b[1]); o.w = pack2(b[2], b[3]); return o; }

DI float quad_sum(float x) {
    x += __int_as_float(__builtin_amdgcn_update_dpp(0, __float_as_int(x), 0xB1, 0xF, 0xF, true));
    x += __int_as_float(__builtin_amdgcn_update_dpp(0, __float_as_int(x), 0x4E, 0xF, 0xF, true));
    return x;
}
DI unsigned wave_max_u32(unsigned x) {
#define WMX_DPP(v, ctrl, rmask) (unsigned)__builtin_amdgcn_update_dpp(0, (int)(v), (ctrl), (rmask), 0xF, true)
    unsigned y;
    y = WMX_DPP(x, 0x111, 0xF); x = x > y ? x : y;
    y = WMX_DPP(x, 0x112, 0xF); x = x > y ? x : y;
    y = WMX_DPP(x, 0x114, 0xF); x = x > y ? x : y;
    y = WMX_DPP(x, 0x118, 0xF); x = x > y ? x : y;
    y = WMX_DPP(x, 0x142, 0xA); x = x > y ? x : y;
    y = WMX_DPP(x, 0x143, 0xC); x = x > y ? x : y;
#undef WMX_DPP
    return (unsigned)__builtin_amdgcn_readlane((int)x, 63);
}
DI void nsa_unit(const Frame& F, int b, int g, int qb) {
    int tid_ = F.tid; OPAQUE(tid_);
    const int tid = tid_, lane = tid & 63, w = F.wave, r = lane & 31, hf = lane >> 5;
    LAS unsigned char* L = F.ldsl;
    LAS unsigned char* buf = L + AT_BUF;
    LAS float* psum = (LAS float*)(L + AT_PSUM);
    LAS unsigned long long* selm = (LAS unsigned long long*)(L + AT_SELM);
    LAS unsigned char* tlist = L + AT_SELM + 528;
    LAS int* tcnt = (LAS int*)(L + AT_SELM + 520);
    const bf16_t* U = (const bf16_t*)(F.ws + WS_U);
    const float* KC = (const float*)(F.ws + WS_KCMP) + (size_t)(b * 2 + g) * 256 * 64;
    const bf16_t* VCT = (const bf16_t*)(F.ws + WS_VCT) + (size_t)(b * 2 + g) * 64 * 256;
    const bf16_t* VT = (const bf16_t*)(F.ws + WS_VT);
    bf16_t* Y = (bf16_t*)(F.ws + WS_BFB);
    const int t0 = qb * 64;
    const int ql = r >> 2, h = r & 3, hh = g * 4 + h;
    const int tq = t0 + 8 * w + ql;
    const size_t row = (size_t)b * SEQ + tq;
    const bf16_t* Ur = U + row * LD0;
    bf16x8 qf[4];
#pragma unroll
    for (int s = 0; s < 4; ++s) qf[s] = *(const bf16x8*)(Ur + C_AQ + hh * 64 + 16 * s + 8 * hf);
    const LAS float* bl = F.biasL + hh * 128; const float bfar = bl[127];
    float gate[3];
    { const unsigned* gp = (const unsigned*)(Ur + C_AG);
#pragma unroll
      for (int j = 0; j < 3; ++j) { const int e = hh * 3 + j; const unsigned wv = gp[e >> 1]; gate[j] = sigmoidf_((e & 1) ? __uint_as_float(wv & 0xFFFF0000u) : __uint_as_float(wv << 16)); } }
    LAS float* opark = psum + w * 2048 + lane;

    const int nvmax = ((t0 + 63 - 31) >> 4) + 1;
    const int ntc = (nvmax + 63) >> 6;
    for (int e = tid; e < 64 * 256; e += 512) psum[e] = 0.f;
    float cm = NEG_INF, cl = 0.f;
    {
        { const int key = tid >> 3, c = tid & 7;
          f32x4 ka[4], kb[4]; u32x4 vv[4];
#pragma unroll
          for (int i = 0; i < 4; ++i) if (i < ntc) { const float* kp_ = KC + (size_t)(i * 64 + key) * 64 + c * 8; ka[i] = *(const f32x4*)kp_; kb[i] = *(const f32x4*)(kp_ + 4);
              vv[i] = *(const u32x4*)(VCT + (size_t)key * 256 + i * 64 + c * 8); }
#pragma unroll
          for (int i = 0; i < 4; ++i) if (i < ntc) {
              uint4 rk; rk.x = pack2(ka[i][0], ka[i][1]); rk.y = pack2(ka[i][2], ka[i][3]); rk.z = pack2(kb[i][0], kb[i][1]); rk.w = pack2(kb[i][2], kb[i][3]);
              st_write_K(buf + i * 8192, tid, rk); st_write_VT(buf + 32768 + i * 8192, tid, make_uint4(vv[i][0], vv[i][1], vv[i][2], vv[i][3])); } }
        __syncthreads();
        auto body = [&](int i, LAS unsigned char* Kt, LAS unsigned char* Vt) { (void)Vt;
            f32x16 s0, s1; qk_tile(Kt, qf, r, hf, s0, s1);
            if (16 * (i * 64 + 63) + 31 + 113 <= t0 + 8 * w) { fix_scores<0>(s0, 0, 16, tq, bl, bfar, 0u, true, hf); fix_scores<0>(s1, 0, 16, tq, bl, bfar, 0u, true, hf); }
            else { fix_scores<FL_NEAR | FL_CAUSAL>(s0, 16 * (i * 64) + 31, 16, tq, bl, bfar, 0u, true, hf); fix_scores<FL_NEAR | FL_CAUSAL>(s1, 16 * (i * 64 + 32) + 31, 16, tq, bl, bfar, 0u, true, hf); }
            float tm = NEG_INF;
#pragma unroll
            for (int k = 0; k < 16; ++k) tm = fmaxf(tm, fmaxf(s0[k], s1[k]));
            tm = fmaxf(tm, __shfl_xor(tm, 32));
            const float mn = fmaxf(cm, tm); const float mu = (mn == NEG_INF) ? 0.f : mn;
            float ls = 0.f;
#pragma unroll
            for (int k = 0; k < 16; ++k) ls += __builtin_amdgcn_exp2f(s0[k] - mu) + __builtin_amdgcn_exp2f(s1[k] - mu);
            cl = cl * __builtin_amdgcn_exp2f(cm - mu) + ls; cm = mn; };
#pragma unroll 1
        for (int i = 0; i < ntc; ++i) body(i, buf + i * 8192, buf + 32768 + i * 8192);
    }
    f32x16 c0, c1;
    {
        cl += __shfl_xor(cl, 32);
        const float cinv = cl > 0.f ? 1.0f / cl : 0.f; const float cmu = (cm == NEG_INF) ? 0.f : cm;
#pragma unroll
        for (int i = 0; i < 16; ++i) { c0[i] = 0.f; c1[i] = 0.f; }
        auto body = [&](int i, LAS unsigned char* Kt, LAS unsigned char* Vt) {
            f32x16 s0, s1; qk_tile(Kt, qf, r, hf, s0, s1);
            if (16 * (i * 64 + 63) + 31 + 113 <= t0 + 8 * w) { fix_scores<0>(s0, 0, 16, tq, bl, bfar, 0u, true, hf); fix_scores<0>(s1, 0, 16, tq, bl, bfar, 0u, true, hf); }
            else { fix_scores<FL_NEAR | FL_CAUSAL>(s0, 16 * (i * 64) + 31, 16, tq, bl, bfar, 0u, true, hf); fix_scores<FL_NEAR | FL_CAUSAL>(s1, 16 * (i * 64 + 32) + 31, 16, tq, bl, bfar, 0u, true, hf); }
#pragma unroll
            for (int k = 0; k < 16; ++k) { s0[k] = __builtin_amdgcn_exp2f(s0[k] - cmu) * cinv; s1[k] = __builtin_amdgcn_exp2f(s1[k] - cmu) * cinv; }
#pragma unroll
            for (int k = 0; k < 16; ++k) {
                const float a0 = quad_sum(s0[k]), a1 = quad_sum(s1[k]);
                const int koff = (k & 3) + 8 * (k >> 2) + 4 * hf;
                if (h == 0) { psum[(8 * w + ql) * 256 + i * 64 + koff] = a0; psum[(8 * w + ql) * 256 + i * 64 + 32 + koff] = a1; }
            }
            pv_tile(Vt, s0, s1, r, hf, c0, c1); };
#pragma unroll 1
        for (int i = 0; i < ntc; ++i) body(i, buf + i * 8192, buf + 32768 + i * 8192);
        __syncthreads();
    }
    {
        const int cur = qb; const int npick = (cur + 1) < 8 ? (cur + 1) : 8;
#pragma unroll 1
        for (int q = 0; q < 8; ++q) {
            const LAS float* pr = psum + (8 * w + q) * 256;
            const f32x4 pv = *(const LAS f32x4*)(pr + 4 * lane); const float pm = pr[lane > 0 ? 4 * lane - 1 : 0];
            const float imp = (lane > 0 ? pm : 0.f) + ((pv[0] + pv[1]) + (pv[2] + pv[3]));
            const bool adm = lane <= cur; const bool forced = (lane == 0) || (lane == cur) || (lane == cur - 1);
            const float score = imp + (forced ? 1.0e4f : 0.f);
            unsigned key = adm ? ((__float_as_uint(score) & ~63u) | (unsigned)(63 - lane)) : 0u;
            unsigned long long sm = 0ull;
#pragma unroll 1
            for (int t = 0; t < npick; ++t) {
                const unsigned m = wave_max_u32(key);
                const bool sel = (key == m) && adm;
                sm |= __ballot(sel);
                key = sel ? 0u : key;
            }
            if (lane == 0) selm[8 * w + q] = sm;
        }
    }
#pragma unroll
    for (int i = 0; i < 16; ++i) { opark[i * 64] = gate[0] * c0[i]; opark[(16 + i) * 64] = gate[0] * c1[i]; }
    scale_q(qf);
    __syncthreads();
    if (w == 0) {
        unsigned long long m = selm[lane];
        unsigned lo = (unsigned)m, hi = (unsigned)(m >> 32);
        for (int o = 32; o >= 1; o >>= 1) { lo |= __shfl_xor(lo, o); hi |= __shfl_xor(hi, o); }
        const unsigned long long un = ((unsigned long long)hi << 32) | lo;
        const bool mine = (un >> lane) & 1ull;
        const int pos = __popcll(un & ((1ull << lane) - 1ull));
        if (mine) tlist[pos] = (unsigned char)lane;
        if (lane == 0) { tcnt[0] = __popcll(un); tcnt[1] = qb > 2 ? __popcll(un & ((1ull << (qb - 2)) - 1ull)) : 0; }
    }
    __syncthreads();
    const unsigned long long mysel = selm[8 * w + ql];
    const __amdgpu_buffer_rsrc_t rsU = make_rsrc(U, MT * LD0 * 2), rsV = make_rsrc(VT, 512 * MT * 2);
    const int voK = ((tid >> 3) * LD0 + (tid & 7) * 8) * 2, voV = ((tid >> 3) * MT + (tid & 7) * 8) * 2;
    {
        Att st; att_init(st);
        const int nts = tcnt[0];
        const int nfar = tcnt[1], nnear = nts - nfar;
        auto tileof = [&](int p) { return (int)tlist[p < nnear ? nfar + p : p - nnear]; };
        auto lds_ = [&](int p, uint4& rk, uint4& rv) { const int j = tileof(p);
            rk = bufld16(rsU, voK, ((b * SEQ + j * 64) * LD0 + g * 64 + C_KS) * 2); rv = bufld16(rsV, voV, (g * 64 * MT + b * SEQ + j * 64) * 2); };
        const float* imgn = (const float*)(F.ws + WS_IMGN) + (size_t)((g * 3) * 8 + w) * 2048; const float* imgz = (const float*)(F.ws + WS_IMGZ);
        auto pre = [&](int p, f32x16& i0, f32x16& i1) { const int dl = qb - tileof(p); ldimg_g(dl < 3 ? imgn + (size_t)dl * 16384 : imgz, lane, i0, i1); };
        auto body = [&](int p, LAS unsigned char* Kt, LAS unsigned char* Vt, f32x16& s0, f32x16& s1) {
            const int j = tileof(p);
            const bool laneok = (mysel >> j) & 1ull;
            if (__ballot(laneok) == 0ull) return;
            const int dl = qb - j; const bool near = dl < 3;
            qk_tile<true>(Kt, qf, r, hf, s0, s1);
            soft_any(st, s0, s1, Vt, r, hf, near ? 0.f : bfar, laneok); };
        auto bodyF = [&](int p, LAS unsigned char* Kt, LAS unsigned char* Vt) {
            const int j = tlist[p - nnear];
            const bool laneok = (mysel >> j) & 1ull;
            if (__ballot(laneok) == 0ull) return;
            far_tile<false, false, false, true>(st, Kt, Vt, qf, r, hf, bfar, laneok, 0u, 0u, tq, j * 64, bl); };
        auto bodyF2 = [&](int p, LAS unsigned char* cur, auto m1, auto m2) {
            const int ja = tlist[p - nnear], jb = tlist[p + 1 - nnear];
            const float cba = ((mysel >> ja) & 1ull) ? bfar - st.m : NEG_INF, cbb = ((mysel >> jb) & 1ull) ? bfar - st.m : NEG_INF;
            f32x16 a0, a1, b0, b1; far_pair<0>(st, cur, cur + 8192, cur + 16384, cur + 24576, qf, r, hf, cba, cbb, nullptr, nullptr, a0, a1, b0, b1, m1, m2); };
        auto bodyN2 = [&](int p, LAS unsigned char* cur) {
            const int ja = tileof(p), jb = tileof(p + 1); const int da = qb - ja, db = qb - jb;
            f32x16 a0, a1, b0, b1;
            ldimg_g(da < 3 ? imgn + (size_t)da * 16384 : imgz, lane, a0, a1); ldimg_g(db < 3 ? imgn + (size_t)db * 16384 : imgz, lane, b0, b1);
            const float cba = ((mysel >> ja) & 1ull) ? (da < 3 ? 0.f : bfar) - st.m : NEG_INF, cbb = ((mysel >> jb) & 1ull) ? (db < 3 ? 0.f : bfar) - st.m : NEG_INF;
            far_pair<2>(st, cur, cur + 8192, cur + 16384, cur + 24576, qf, r, hf, cba, cbb, nullptr, nullptr, a0, a1, b0, b1); };
        tile_stream2<false, false>(nts, buf, tid, lds_, pre, body, bodyN2, bodyF, bodyF2, nnear, [&]() { return __ballot(st.m == NEG_INF) == 0ull; }, [&]() {});
        float l = st.l + __shfl_xor(st.l, 32);
        const float sc = l > 0.f ? gate[1] / l : 0.f;
#pragma unroll
        for (int i = 0; i < 16; ++i) { opark[i * 64] += sc * st.o0[i]; opark[(16 + i) * 64] += sc * st.o1[i]; }
    }
    {
        Att st; att_init(st);
        const int j0 = qb - 8 < 0 ? 0 : qb - 8; const int ntw = qb - j0 + 1;
        const int hasw = qb >= 8 ? 1 : 0, gs = (qb - 2 > j0 + hasw) ? qb - 2 : j0 + hasw, ngw = hasw + (qb - gs + 1), f0 = j0 + hasw;
        auto tileof = [&](int p) { return p < ngw ? ((hasw && p == 0) ? j0 : gs + p - hasw) : f0 + (p - ngw); };
        auto ldw = [&](int p, uint4& rk, uint4& rv) { const int j = tileof(p);
            rk = bufld16(rsU, voK, ((b * SEQ + j * 64) * LD0 + g * 64 + C_KW) * 2); rv = bufld16(rsV, voV, ((128 + g * 64) * MT + b * SEQ + j * 64) * 2); };
        const float* imgn = (const float*)(F.ws + WS_IMGN) + (size_t)((g * 3) * 8 + w) * 2048; const float* imgz = (const float*)(F.ws + WS_IMGZ); const float* imgw = (const float*)(F.ws + WS_IMGW) + (size_t)w * 2048;
        auto pre = [&](int p, f32x16& i0, f32x16& i1) { const int dl = qb - tileof(p); ldimg_g(dl < 3 ? imgn + (size_t)dl * 16384 : (dl == 8 ? imgw : imgz), lane, i0, i1); };
        auto body = [&](int p, LAS unsigned char* Kt, LAS unsigned char* Vt, f32x16& s0, f32x16& s1) {
            const int j = tileof(p);
            const int dl = qb - j; const bool near = dl < 3;
            qk_tile<true>(Kt, qf, r, hf, s0, s1);
            soft_any(st, s0, s1, Vt, r, hf, near ? 0.f : bfar, true); };
        auto bodyF = [&](int p, LAS unsigned char* Kt, LAS unsigned char* Vt) { far_tile<false, false, false, true>(st, Kt, Vt, qf, r, hf, bfar, true, 0u, 0u, tq, (f0 + p - ngw) * 64, bl); };
        auto bodyF2 = [&](int p, LAS unsigned char* cur, auto m1, auto m2) { (void)p; f32x16 a0, a1, b0, b1; far_pair<0, true>(st, cur, cur + 8192, cur + 16384, cur + 24576, qf, r, hf, 0.f, 0.f, nullptr, nullptr, a0, a1, b0, b1, m1, m2); };
        auto bodyN2 = [&](int p, LAS unsigned char* cur) {
            const int da = qb - tileof(p), db = qb - tileof(p + 1);
            f32x16 a0, a1, b0, b1;
            ldimg_g(da < 3 ? imgn + (size_t)da * 16384 : (da == 8 ? imgw : imgz), lane, a0, a1); ldimg_g(db < 3 ? imgn + (size_t)db * 16384 : (db == 8 ? imgw : imgz), lane, b0, b1);
            far_pair<2>(st, cur, cur + 8192, cur + 16384, cur + 24576, qf, r, hf, (da < 3 ? 0.f : bfar) - st.m, (db < 3 ? 0.f : bfar) - st.m, nullptr, nullptr, a0, a1, b0, b1); };
        tile_stream2<false, true>(ntw, buf, tid, ldw, pre, body, bodyN2, bodyF, bodyF2, ngw, [&]() { return __ballot(st.m == NEG_INF) == 0ull; }, [&]() { to_raw_scale(st, bfar); });
        float l = st.l + __shfl_xor(st.l, 32);
        const float sc = l > 0.f ? gate[2] / l : 0.f;
#pragma unroll
        for (int i = 0; i < 16; ++i) { c0[i] = opark[i * 64] + sc * st.o0[i]; c1[i] = opark[(16 + i) * 64] + sc * st.o1[i]; }
    }
    uint2 zq[2][4];
#pragma unroll
    for (int dh = 0; dh < 2; ++dh)
#pragma unroll
        for (int k = 0; k < 4; ++k) zq[dh][k] = *(const uint2*)(Ur + C_AZ + hh * 64 + 32 * dh + 8 * k + 4 * hf);
    __builtin_amdgcn_sched_barrier(0);
#pragma unroll
    for (int dh = 0; dh < 2; ++dh)
#pragma unroll
        for (int k = 0; k < 4; ++k) {
            const int d = 32 * dh + 8 * k + 4 * hf;
            const uint2 zz = zq[dh][k];
            const float z0 = __uint_as_float(zz.x << 16), z1 = __uint_as_float(zz.x & 0xFFFF0000u), z2 = __uint_as_float(zz.y << 16), z3 = __uint_as_float(zz.y & 0xFFFF0000u);
            const f32x16& o = dh ? c1 : c0;
            uint2 pk; pk.x = pack2(o[4 * k + 0] * siluf_(z0), o[4 * k + 1] * siluf_(z1)); pk.y = pack2(o[4 * k + 2] * siluf_(z2), o[4 * k + 3] * siluf_(z3));
            *(uint2*)(Y + row * 1024 + hh * 64 + d) = pk;
        }
    __syncthreads();
}

DI unsigned short okey16(float x) {
    const _Float16 hx = (_Float16)x; const unsigned u = __builtin_bit_cast(unsigned short, hx);
    const unsigned sg = (unsigned)((int)(u << 16) >> 31);
    return (unsigned short)(u ^ (sg | 0x8000u));
}
DI void dsa_unit(const Frame& F, int b, int qt) {
    int tid_ = F.tid; OPAQUE(tid_);
    const int tid = tid_, lane = tid & 63, w = F.wave, r = lane & 31, hf = lane >> 5, fr = lane & 15, fq = lane >> 4;
    LAS unsigned char* L = F.ldsl;
    LAS unsigned char* buf = L + AT_BUF;
    LAS unsigned* mask = (LAS unsigned*)(L + AT_PSUM);
    const bf16_t* U = (const bf16_t*)(F.ws + WS_U);
    bf16_t* Y = (bf16_t*)(F.ws + WS_BFB);
    const bf16_t* VT = (const bf16_t*)(F.ws + WS_VT);
    unsigned short* KS = (unsigned short*)(F.ws + WS_BFA) + (size_t)F.bid * 32 * 4096;
    const int t0 = qt * 32;
    const int nt = ((t0 + 31) >> 6) + 1;
    const int aql = r >> 3, ah = r & 7;
    const bf16_t* Ur = U + ((size_t)b * SEQ + t0 + 4 * w + aql) * LD0;
    bf16x8 qf[4];
#pragma unroll
    for (int s = 0; s < 4; ++s) qf[s] = *(const bf16x8*)(Ur + C_BQ + ah * 64 + 16 * s + 8 * hf);
    const __amdgpu_buffer_rsrc_t rsU = make_rsrc(U, MT * LD0 * 2), rsV = make_rsrc(VT, 512 * MT * 2);
    const int voK = ((tid >> 3) * LD0 + (tid & 7) * 8) * 2, voV = ((tid >> 3) * MT + (tid & 7) * 8) * 2;
    const int nnear = nt < 4 ? nt : 4;
    Prel pl;
    { const int i0 = nt - nnear, i1 = nt > 1 ? i0 + 1 : i0;
      pl.k0 = bufld16(rsU, voK, ((b * SEQ + i0 * 64) * LD0 + C_BK) * 2); pl.v0 = bufld16(rsV, voV, (256 * MT + b * SEQ + i0 * 64) * 2);
      pl.k1 = bufld16(rsU, voK, ((b * SEQ + i1 * 64) * LD0 + C_BK) * 2); pl.v1 = bufld16(rsV, voV, (256 * MT + b * SEQ + i1 * 64) * 2); }
    {
        bf16x8 qi[2]; float wi[4];
        { const bf16_t* Uq = U + ((size_t)b * SEQ + t0 + 4 * w + (fr >> 2)) * LD0;
#pragma unroll
          for (int ks = 0; ks < 2; ++ks) qi[ks] = *(const bf16x8*)(Uq + C_BQI + (fr & 3) * 64 + 32 * ks + 8 * fq);
          const uint2 wv = *(const uint2*)(U + ((size_t)b * SEQ + t0 + 4 * w + fq) * LD0 + C_BWI);
          wi[0] = __uint_as_float(wv.x << 16) * 0.0625f; wi[1] = __uint_as_float(wv.x & 0xFFFF0000u) * 0.0625f; wi[2] = __uint_as_float(wv.y << 16) * 0.0625f; wi[3] = __uint_as_float(wv.y & 0xFFFF0000u) * 0.0625f; }
        const int tqi = t0 + 4 * w + fq;
        const __amdgpu_buffer_rsrc_t rsUi = make_rsrc(U, MT * LD0 * 2); const int voKi = ((tid >> 3) * LD0 + (tid & 7) * 8) * 2;
        auto ldi = [&](int i, uint4& rk, uint4& rv) { rk = bufld16(rsUi, voKi, ((b * SEQ + i * 64) * LD0 + C_BKI) * 2); (void)rv; };
        auto body = [&](int i, LAS unsigned char* Kt, LAS unsigned char* Vt) { (void)Vt;
            bf16x8 kb[4][2];
#pragma unroll
            for (int kg = 0; kg < 4; ++kg) { const int kk = 16 * kg + fr;
#pragma unroll
                for (int ks = 0; ks < 2; ++ks) { const int c = 4 * ks + fq; kb[kg][ks] = *(const LAS bf16x8*)(Kt + (kk ^ ((kk >> 3) & 1)) * 128 + ((c ^ (kk & 7)) << 4)); } }
            __builtin_amdgcn_sched_barrier(0);
            f32x4 acc[4];
#pragma unroll
            for (int kg = 0; kg < 4; ++kg) acc[kg] = __builtin_amdgcn_mfma_f32_16x16x32_bf16(qi[0], kb[kg][0], (f32x4){0.f, 0.f, 0.f, 0.f}, 0, 0, 0);
#pragma unroll
            for (int kg = 0; kg < 4; ++kg) acc[kg] = __builtin_amdgcn_mfma_f32_16x16x32_bf16(qi[1], kb[kg][1], acc[kg], 0, 0, 0);
            __builtin_amdgcn_sched_barrier(0);
#pragma unroll
            for (int kg = 0; kg < 4; ++kg) { const int kk = 16 * kg + fr;
                float r0, r1, r2, r3;
                asm("v_max_f32 %0, 0, %1" : "=v"(r0) : "v"(acc[kg][0])); asm("v_max_f32 %0, 0, %1" : "=v"(r1) : "v"(acc[kg][1]));
                asm("v_max_f32 %0, 0, %1" : "=v"(r2) : "v"(acc[kg][2])); asm("v_max_f32 %0, 0, %1" : "=v"(r3) : "v"(acc[kg][3]));
                const float sc = __builtin_fmaf(wi[0], r0, __builtin_fmaf(wi[1], r1, __builtin_fmaf(wi[2], r2, wi[3] * r3)));
                unsigned key = okey16(sc);
                asm volatile("" : "+v"(key));
                const int pos = i * 64 + kk;
                KS[(size_t)(4 * w + fq) * 4096 + pos] = (unsigned short)(pos <= tqi ? key : 0u);
            } };
        tile_stream_k4(nt, buf, tid, ldi, body);
        { const int zend = (t0 + 32 + 511) & ~511, zp = nt * 64 + 8 * lane;
          if (zp < zend) {
#pragma unroll
              for (int q = 0; q < 4; ++q) *(uint4*)(KS + (size_t)(4 * w + q) * 4096 + zp) = make_uint4(0u, 0u, 0u, 0u); } }
    }
    asm volatile("s_waitcnt vmcnt(0)" ::: "memory");
    __syncthreads();
    __builtin_amdgcn_fence(__ATOMIC_ACQUIRE, "workgroup");
    asm volatile("s_waitcnt vmcnt(0)" ::: "memory");
    {
    LAS unsigned char* maskb = (LAS unsigned char*)mask;
    unsigned Tn[32];
    auto ldkeys = [&](int q) { const int qq = 4 * w + q; const int nk = t0 + qq + 1; int ln = lane; OPAQUE(ln); const unsigned short* kq = KS + (size_t)qq * 4096 + ln * 8;
#pragma unroll
        for (int c = 0; c < 8; ++c) { uint4 kv = make_uint4(0u, 0u, 0u, 0u); if (c * 512 < nk) kv = *(const uint4*)(kq + c * 512);
            Tn[4 * c] = kv.x; Tn[4 * c + 1] = kv.y; Tn[4 * c + 2] = kv.z; Tn[4 * c + 3] = kv.w; } };
    ldkeys(0);
#pragma unroll 1
    for (int q = 0; q < 4; ++q) {
        const int qq = 4 * w + q; const int tqq = t0 + qq; const int nk = tqq + 1;
        unsigned T[32];
#pragma unroll
        for (int e = 0; e < 32; ++e) T[e] = Tn[e];
        if (q < 3) ldkeys(q + 1);
        if (nk <= 256) {
#pragma unroll
            for (int c = 0; c < 8; ++c) { unsigned selb = 0u;
#pragma unroll
                for (int e = 0; e < 8; ++e) if (c * 512 + lane * 8 + e < nk) selb |= 1u << e;
                maskb[qq * 512 + c * 64 + lane] = (unsigned char)selb; }
            continue;
        }
#pragma unroll
        for (int st = 0; st < 5; ++st) { const int j = 16 >> st; const unsigned m = st == 0 ? 0x0000FFFFu : st == 1 ? 0x00FF00FFu : st == 2 ? 0x0F0F0F0Fu : st == 3 ? 0x33333333u : 0x55555555u;
#pragma unroll
            for (int k0 = 0; k0 < 32; k0 += 2 * j)
#pragma unroll
                for (int i = 0; i < j; ++i) { const int k = k0 + i; const unsigned t = ((T[k] >> j) ^ T[k + j]) & m; T[k] ^= (t << j); T[k + j] ^= t; } }
        unsigned ce = 0xFFFFFFFFu, co = 0xFFFFFFFFu, ge = 0u, go = 0u; int above = 0;
#pragma unroll
        for (int bit = 15; bit >= 0; --bit) {
            const unsigned oe = ce & T[bit], oo = co & T[16 + bit];
            const int cnt = __popc(oe) + __popc(oo);
            int tot = 0;
#pragma unroll
            for (int bb = 0; bb < 7; ++bb) tot += __popcll(__ballot((cnt >> bb) & 1)) << bb;
            if (above + tot >= 256) { ce = oe; co = oo; }
            else { above += tot; ge |= oe; go |= oo; ce &= ~T[bit]; co &= ~T[16 + bit]; }
        }
        const int quota = 256 - above; int taken = 0;
#pragma unroll
        for (int c = 0; c < 8; ++c) {
            unsigned xe = (ge >> (4 * c)) & 0xFu, xo = (go >> (4 * c)) & 0xFu;
            xe = (xe | (xe << 2)) & 0x33u; xe = (xe | (xe << 1)) & 0x55u; xo = (xo | (xo << 2)) & 0x33u; xo = (xo | (xo << 1)) & 0x55u;
            unsigned selb = xe | (xo << 1);
            unsigned ye = (ce >> (4 * c)) & 0xFu, yo = (co >> (4 * c)) & 0xFu;
            ye = (ye | (ye << 2)) & 0x33u; ye = (ye | (ye << 1)) & 0x55u; yo = (yo | (yo << 2)) & 0x33u; yo = (yo | (yo << 1)) & 0x55u;
            const unsigned eqb = ye | (yo << 1);
            if (__ballot(eqb != 0u) != 0ull) {
                const int ne = __popc(eqb);
                int excl = 0, totc = 0;
#pragma unroll
                for (int bb = 0; bb < 4; ++bb) { const unsigned long long bl_ = __ballot((ne >> bb) & 1);
                    excl += (int)__builtin_amdgcn_mbcnt_hi((unsigned)(bl_ >> 32), __builtin_amdgcn_mbcnt_lo((unsigned)bl_, 0u)) << bb; totc += __popcll(bl_) << bb; }
                int rank = taken + excl;
#pragma unroll
                for (int e = 0; e < 8; ++e) if ((eqb >> e) & 1u) { if (rank < quota) selb |= 1u << e; ++rank; }
                taken += totc;
            }
            maskb[qq * 512 + c * 64 + lane] = (unsigned char)selb;
        }
    }
    }
    __syncthreads();
    {
        const int ql = aql, h = ah;
        const int tq = t0 + 4 * w + ql;
        const size_t row = (size_t)b * SEQ + tq;
        scale_q(qf);
        const LAS float* bl = F.biasL + (8 + h) * 128; const float bfar = bl[127];
        const LAS unsigned* mq = mask + (4 * w + ql) * 128;
        LAS unsigned char* xmw = L + AT_XM + w * 2304 + ql * 272 + hf * 128;
        auto tileof = [&](int p) { return p < nnear ? nt - nnear + p : p - nnear; };
        auto expand = [&](int p) { const int i = tileof(p);
            const unsigned nib = (~mq[2 * i + (h >> 2)]) >> (8 * (h & 3) + 4 * hf);
            u32x4 v; v[0] = bitmask32(nib, 0) & 0xFF800000u; v[1] = bitmask32(nib, 1) & 0xFF800000u; v[2] = bitmask32(nib, 2) & 0xFF800000u; v[3] = bitmask32(nib, 3) & 0xFF800000u;
            *(LAS u32x4*)(xmw + (p & 1) * 1152 + h * 16) = v; };
        expand(0);
        Att st; att_init(st);
        auto lda = [&](int p, uint4& rk, uint4& rv) { const int i = tileof(p);
            rk = bufld16(rsU, voK, ((b * SEQ + i * 64) * LD0 + C_BK) * 2); rv = bufld16(rsV, voV, (256 * MT + b * SEQ + i * 64) * 2); };
        const float* imgd = (const float*)(F.ws + WS_IMGD) + (size_t)(((qt & 1) * 4) * 8 + w) * 2048; const float* imgz = (const float*)(F.ws + WS_IMGZ);
        auto pre = [&](int p, f32x16& i0, f32x16& i1) { const int dl = nt - 1 - tileof(p); ldimg_g(dl < 4 ? imgd + (size_t)dl * 16384 : imgz, lane, i0, i1); };
        auto body = [&](int p, LAS unsigned char* Kt, LAS unsigned char* Vt, f32x16& b0, f32x16& b1) { const int i = tileof(p);
            const int dl = nt - 1 - i; const bool near = dl < 4;
            f32x16 s0, s1;
            ldimg(xmw + (p & 1) * 1152, s0, s1);
            if (p + 1 < nt) expand(p + 1);
            s0 += b0; s1 += b1;
            qk_tile<true>(Kt, qf, r, hf, s0, s1);
            soft_any(st, s0, s1, Vt, r, hf, near ? 0.f : bfar, true); };
        auto bodyF = [&](int p, LAS unsigned char* Kt, LAS unsigned char* Vt) { const int i = p - nnear;
            f32x16 s0, s1;
            { const LAS unsigned char* xs = xmw + (p & 1) * 1152;
#pragma unroll
              for (int g = 0; g < 4; ++g) { const f32x4 a = *(const LAS f32x4*)(xs + g * 16), c = *(const LAS f32x4*)(xs + 64 + g * 16);
                  s0[4 * g] = a[0]; s0[4 * g + 1] = a[1]; s0[4 * g + 2] = a[2]; s0[4 * g + 3] = a[3]; s1[4 * g] = c[0]; s1[4 * g + 1] = c[1]; s1[4 * g + 2] = c[2]; s1[4 * g + 3] = c[3]; } }
            if (p + 1 < nt) expand(p + 1);
            qk_tile<true, true>(Kt, qf, r, hf, s0, s1);
            far_soft<false, false>(st, s0, s1, Vt, r, hf, bfar, true, 0u, 0u, tq, i * 64, bl); };
        auto bodyF2 = [&](int p, LAS unsigned char* cur, auto m1, auto m2) {
            expand(p + 1);
            f32x16 a0, a1, b0, b1; far_pair<1, true>(st, cur, cur + 8192, cur + 16384, cur + 24576, qf, r, hf, 0.f, 0.f, xmw, xmw + 1152, a0, a1, b0, b1, m1, m2);
            if (p + 2 < nt) expand(p + 2); };
        auto bodyN2 = [&](int p, LAS unsigned char* cur) {
            const int da = nt - 1 - tileof(p), db = nt - 1 - tileof(p + 1);
            f32x16 a0, a1, b0, b1;
            expand(p + 1);
            ldimg_g(da < 4 ? imgd + (size_t)da * 16384 : imgz, lane, a0, a1);
            { f32x16 m0, m1; ldimg(xmw, m0, m1); a0 += m0; a1 += m1; }
            __builtin_amdgcn_sched_barrier(0);
            ldimg_g(db < 4 ? imgd + (size_t)db * 16384 : imgz, lane, b0, b1);
            { f32x16 m0, m1; ldimg(xmw + 1152, m0, m1); b0 += m0; b1 += m1; }
            __builtin_amdgcn_sched_barrier(0);
            far_pair<2>(st, cur, cur + 8192, cur + 16384, cur + 24576, qf, r, hf, (da < 4 ? 0.f : bfar) - st.m, (db < 4 ? 0.f : bfar) - st.m, nullptr, nullptr, a0, a1, b0, b1);
            if (p + 2 < nt) expand(p + 2); };
        tile_stream2<false, true, true>(nt, buf, tid, lda, pre, body, bodyN2, bodyF, bodyF2, nnear, [&]() { return __ballot(st.m == NEG_INF) == 0ull; }, [&]() { to_raw_scale(st, bfar); }, pl);
        float l = st.l + __shfl_xor(st.l, 32);
        const float sc = l > 0.f ? 1.0f / l : 0.f;
        uint2 zq[2][4];
#pragma unroll
        for (int dh = 0; dh < 2; ++dh)
#pragma unroll
            for (int k = 0; k < 4; ++k) zq[dh][k] = *(const uint2*)(Ur + C_BZ + h * 64 + 32 * dh + 8 * k + 4 * hf);
        __builtin_amdgcn_sched_barrier(0);
#pragma unroll
        for (int dh = 0; dh < 2; ++dh)
#pragma unroll
            for (int k = 0; k < 4; ++k) {
                const int d = 32 * dh + 8 * k + 4 * hf;
                const uint2 zz = zq[dh][k];
                const float z0 = __uint_as_float(zz.x << 16), z1 = __uint_as_float(zz.x & 0xFFFF0000u), z2 = __uint_as_float(zz.y << 16), z3 = __uint_as_float(zz.y & 0xFFFF0000u);
                const f32x16& o = dh ? st.o1 : st.o0;
                uint2 pk; pk.x = pack2(o[4 * k + 0] * sc * siluf_(z0), o[4 * k + 1] * sc * siluf_(z1)); pk.y = pack2(o[4 * k + 2] * sc * siluf_(z2), o[4 * k + 3] * sc * siluf_(z3));
                *(uint2*)(Y + row * 1024 + 512 + h * 64 + d) = pk;
            }
    }
    __syncthreads();
}

DI void att_dsa(const Frame& F) {
    LAS int* ub = (LAS int*)(F.ldsl + AT_MISC);
    unsigned* qd = F.ctl + CW_QDSA;
    const int NDSA = NB * (SEQ / 32);
    __syncthreads();
    if (F.tid == 0) ub[0] = (int)__hip_atomic_fetch_add(qd, 1u, __ATOMIC_RELAXED, __HIP_MEMORY_SCOPE_AGENT);
    for (;;) {
        __syncthreads();
        const int k = ub[0];
        __syncthreads();
        if (k >= NDSA) break;
        int nxt = 0; if (F.tid == 0) nxt = (int)__hip_atomic_fetch_add(qd, 1u, __ATOMIC_RELAXED, __HIP_MEMORY_SCOPE_AGENT);
        dsa_unit(F, k & 7, (SEQ / 32) - 1 - (k >> 3));
        if (F.tid == 0) ub[0] = nxt;
    }
}
DI void att_nsa(const Frame& F) {
    LAS int* ub = (LAS int*)(F.ldsl + AT_MISC);
    unsigned* qn = F.ctl + CW_QNSA;
    const int NNSA = NB * 2 * (SEQ / 64);
    __syncthreads();
    if (F.tid == 0) ub[0] = (int)__hip_atomic_fetch_add(qn, 1u, __ATOMIC_RELAXED, __HIP_MEMORY_SCOPE_AGENT);
    for (;;) {
        __syncthreads();
        const int k = ub[0];
        __syncthreads();
        if (k >= NNSA) break;
        int nxt = 0; if (F.tid == 0) nxt = (int)__hip_atomic_fetch_add(qn, 1u, __ATOMIC_RELAXED, __HIP_MEMORY_SCOPE_AGENT);
        const int bg = k & 15;
        nsa_unit(F, bg >> 1, bg & 1, 63 - (k >> 4));
        if (F.tid == 0) ub[0] = nxt;
    }
}

DI f32x4 mma16(const bf16_t* A, int lda, const bf16_t* Bt, int ldb, int K, int lane) {
    const int fr = lane & 15, fq = lane >> 4;
    f32x4 acc = {0.f, 0.f, 0.f, 0.f};
    for (int k = 0; k < K; k += 32) {
        const bf16x8 a = *(const bf16x8*)(A + fr * lda + k + fq * 8);
        const bf16x8 b = *(const bf16x8*)(Bt + fr * ldb + k + fq * 8);
        acc = __builtin_amdgcn_mfma_f32_16x16x32_bf16(a, b, acc, 0, 0, 0);
    }
    return acc;
}
DI void conv8(const bf16_t* U1, int b, int t, int col, const float* cw  , int nch, const float* cb, float (&y)[8]) {
#pragma unroll
    for (int i = 0; i < 8; ++i) y[i] = cb[i];
#pragma unroll
    for (int j = 0; j < 4; ++j) { const int tt = t - 3 + j;
        if (tt >= 0) { const uint4 v = *(const uint4*)(U1 + ((size_t)b * SEQ + tt) * LD1 + col); float f[8]; unpack8(v, f);
#pragma unroll
            for (int i = 0; i < 8; ++i) y[i] += cw[(size_t)j * nch + i] * f[i]; } }
}
DI void stage_raw128(const Frame& F, const bf16_t* U1, int b, int t_first, int nrows, int col, bf16_t* raw) {
    for (int it = F.tid; it < nrows * 16; it += 512) { const int row = it >> 4, ch = it & 15; const int t = t_first + row;
        uint4 v = make_uint4(0u, 0u, 0u, 0u); if (t >= 0) v = *(const uint4*)(U1 + ((size_t)b * SEQ + t) * LD1 + col + ch * 8);
        *(uint4*)(raw + row * 136 + ch * 8) = v; }
}
DI void load_raw128(const Frame& F, const bf16_t* U1, int b, int t_first, int nrows, int col, uint4 (&rg)[3]) {
#pragma unroll
    for (int j = 0; j < 3; ++j) { const int it = F.tid + j * 512; const int row = it >> 4, ch = it & 15; const int t = t_first + row;
        rg[j] = make_uint4(0u, 0u, 0u, 0u); if (it < nrows * 16 && t >= 0) rg[j] = *(const uint4*)(U1 + ((size_t)b * SEQ + t) * LD1 + col + ch * 8); }
}
DI void write_raw128(const Frame& F, int nrows, const uint4 (&rg)[3], bf16_t* raw) {
#pragma unroll
    for (int j = 0; j < 3; ++j) { const int it = F.tid + j * 512; const int row = it >> 4, ch = it & 15; if (it < nrows * 16) *(uint4*)(raw + row * 136 + ch * 8) = rg[j]; }
}
DI void conv8_lds(const bf16_t* raw, int s, int d0, const float* cw  , const float* cb  , float (&y)[8]) {
#pragma unroll
    for (int i = 0; i < 8; ++i) y[i] = cb[d0 + i];
#pragma unroll
    for (int j = 0; j < 4; ++j) { const uint4 v = *(const uint4*)(raw + (s + j) * 136 + d0); float f[8]; unpack8(v, f);
#pragma unroll
        for (int i = 0; i < 8; ++i) y[i] += cw[j * 128 + d0 + i] * f[i]; }
}
DI void mlstm_gates_v(const Frame& F, float gi, float gf, int h, float* li, float* bc) {
    if (F.wave == 0) {
        const float ip = gi + F.in[26][h];
        const float fp = gf + F.in[27][h];
        const float lf = fminf(fp, 0.f) - log1pf(expf(-fabsf(fp)));
        float cs = lf;
        for (int o = 1; o < 64; o <<= 1) { const float n = __shfl_up(cs, o); if (F.lane >= o) cs += n; }
        li[F.lane] = ip; bc[F.lane] = cs;
    }
}
DI void mlstm_gates(const Frame& F, const bf16_t* U1, int b, int h, int c, float* li, float* bc) {
    if (F.wave == 0) {
        const size_t row = (size_t)b * SEQ + c * 64 + F.lane;
        const float* gts = (const float*)(F.ws + WS_GATES);
        const float ip = gts[row * 8 + h] + F.in[26][h];
        const float fp = gts[row * 8 + 4 + h] + F.in[27][h];
        const float lf = fminf(fp, 0.f) - log1pf(expf(-fabsf(fp)));
        float cs = lf;
        for (int o = 1; o < 64; o <<= 1) { const float n = __shfl_up(cs, o); if (F.lane >= o) cs += n; }
        li[F.lane] = ip; bc[F.lane] = cs;
    }
    __syncthreads();
}
constexpr int ML_LI = 0, ML_BC = 256, ML_WK = 512, ML_MT = 768, ML_DQ = 1024, ML_RS = 1280, ML_NIN = 1536, ML_Q = 2048, ML_K = ML_Q + 64 * 136 * 2, ML_VT = ML_K + 64 * 136 * 2,
              ML_CT = ML_VT + 128 * 72 * 2, ML_W = ML_CT + 128 * 136 * 2, ML_KT = ML_W + 64 * 72 * 2, ML_END = ML_KT + 128 * 72 * 2;
static_assert(ML_END + 5120 + LDS_WORK_OFF <= LDS_BYTES - 12288, "mlstm lds");

DI void p8a_mlstm_local(const Frame& F) {
    const bf16_t* U1 = (const bf16_t*)(F.ws + WS_U);
    bf16_t* ST = (bf16_t*)(F.ws + WS_BFB);
    float* zloc = (float*)(F.ws + WS_ZLOC); float* scal = (float*)(F.ws + WS_SCAL);
    bf16_t* KCV = (bf16_t*)F.out + (size_t)MT * 1024;
    unsigned char* L = F.lds;
    float* li = (float*)(L + ML_LI); float* bc = (float*)(L + ML_BC); float* wk = (float*)(L + ML_WK);
    bf16_t* kT = (bf16_t*)(L + ML_KT); bf16_t* vT = (bf16_t*)(L + ML_VT); float* cwl = (float*)(L + ML_END); bf16_t* raw = (bf16_t*)(L + ML_Q); bf16_t* raw2 = (bf16_t*)(L + ML_CT);
    const float* cw = F.in[24]; const float* cb = F.in[25];
    uint4 rk3[3], rv3[3];
    float gi_n = 0.f, gf_n = 0.f; int hprev = -1;
    auto prefetch = [&](int unit) { const int c = unit & 63, h = (unit >> 6) & 3, b = unit >> 8;
        load_raw128(F, U1, b, c * 64 - 3, 67, C_DK + h * 128, rk3); load_raw128(F, U1, b, c * 64, 64, C_DV + h * 128, rv3);
        if (F.wave == 0) { const float* gts = (const float*)(F.ws + WS_GATES) + ((size_t)b * SEQ + c * 64 + F.lane) * 8; gi_n = gts[h]; gf_n = gts[4 + h]; } };
    if (F.bid < 2048) prefetch(F.bid);
    for (int unit = F.bid; unit < 2048; unit += F.G) {
        const int c = unit & 63, h = (unit >> 6) & 3, b = unit >> 8; (void)b; (void)c;
        if (h != hprev) { hprev = h;
            for (int e = F.tid; e < 640; e += 512) cwl[e] = e < 512 ? cw[(size_t)(e >> 7) * 1024 + 512 + h * 128 + (e & 127)] : cb[512 + h * 128 + (e - 512)]; }
        mlstm_gates_v(F, gi_n, gf_n, h, li, bc);
        if (F.wave == 0) {
            const float bl = bc[63]; const float dec = bl - bc[F.lane] + li[F.lane];
            const float dmx = wave_max(dec);
            wk[F.lane] = expf(dec - dmx);
            if (F.lane == 0) { scal[unit] = bl; scal[2048 + unit] = dmx; }
        }
        write_raw128(F, 67, rk3, raw); write_raw128(F, 64, rv3, raw2);
        if (unit + F.G < 2048) prefetch(unit + F.G);
        __syncthreads();
        for (int it = F.tid; it < 1024; it += 512) {
            const int s = it & 63, d0 = (it >> 6) * 8;
            float y[8]; conv8_lds(raw, s, d0, cwl, cwl + 512, y);
            const float sc = 0.08838834764831845f, w = wk[s];
#pragma unroll
            for (int i = 0; i < 8; ++i) y[i] = siluf_(y[i]) * sc;
            uint4 o; o.x = pack2(y[0], y[1]); o.y = pack2(y[2], y[3]); o.z = pack2(y[4], y[5]); o.w = pack2(y[6], y[7]);
            *(uint4*)(KCV + (size_t)unit * 8192 + s * 128 + d0) = o;
#pragma unroll
            for (int i = 0; i < 8; ++i) kT[(d0 + i) * 72 + s] = f2bf(y[i] * w);
        }
        for (int it = F.tid; it < 1024; it += 512) {
            const int s = it & 63, d0 = (it >> 6) * 8;
            const uint4 vv = *(const uint4*)(raw2 + s * 136 + d0); const unsigned wv[4] = {vv.x, vv.y, vv.z, vv.w};
#pragma unroll
            for (int i = 0; i < 8; ++i) vT[(d0 + i) * 72 + s] = (bf16_t)((i & 1) ? (wv[i >> 1] >> 16) : (wv[i >> 1] & 0xFFFFu));
        }
        __syncthreads();
        for (int tix = F.wave * 8; tix < F.wave * 8 + 8; ++tix) {
            const int et = tix >> 3, dt = tix & 7;
            const f32x4 a = mma16(vT + et * 16 * 72, 72, kT + dt * 16 * 72, 72, 64, F.lane);
            const int fr = F.lane & 15, fq = F.lane >> 4;
#pragma unroll
            for (int r = 0; r < 4; ++r) ST[(size_t)unit * 16384 + (size_t)(et * 16 + 4 * fq + r) * 128 + dt * 16 + fr] = f2bf(a[r]);
        }
        { const int d = F.tid >> 2, part = F.tid & 3; float z = 0.f;
#pragma unroll
          for (int s = 0; s < 16; ++s) z += bf2f(kT[d * 72 + part * 16 + s]);
          z += __shfl_xor(z, 1); z += __shfl_xor(z, 2);
          if (part == 0) zloc[(size_t)unit * 128 + d] = z; }
        __syncthreads();
    }
}

DI void p8a_lru_local(const Frame& F) {
    const bf16_t* U1 = (const bf16_t*)(F.ws + WS_U);
    bf16_t* LA = (bf16_t*)(F.ws + WS_LRUA); bf16_t* LH = (bf16_t*)(F.ws + WS_LRUH);
    float* Aend = (float*)(F.ws + WS_AEND); float* Hend = (float*)(F.ws + WS_HEND);
    const bf16_t* WAT = (const bf16_t*)(F.ws + WS_WAT); const bf16_t* WXT = (const bf16_t*)(F.ws + WS_WXT);
    bf16_t* xcb = (bf16_t*)F.lds;
    float* cwL = (float*)(F.lds + 16640);
    bf16_t* rawl = (bf16_t*)(F.lds + 16640 + 10240);
    const int g = F.wave, lane = F.lane, fr = lane & 15, fq = lane >> 4;
    __syncthreads();
    for (int e = F.tid; e < 2048; e += 512) cwL[e] = F.in[17][e];
    cwL[2048 + F.tid] = F.in[18][F.tid];
    bf16x8 wa[4][2], wx[4][2]; float ba[4], bx[4], sp[4];
#pragma unroll
    for (int ct = 0; ct < 4; ++ct) { const int ch = g * 64 + ct * 16 + fr;
#pragma unroll
        for (int ks = 0; ks < 2; ++ks) { wa[ct][ks] = *(const bf16x8*)(WAT + (size_t)ch * 64 + 32 * ks + 8 * fq); wx[ct][ks] = *(const bf16x8*)(WXT + (size_t)ch * 64 + 32 * ks + 8 * fq); }
        ba[ct] = F.in[20][ch]; bx[ct] = F.in[22][ch]; sp[ct] = log1pf(expf(-F.in[23][ch])); }
    __syncthreads();
    for (int unit = F.bid; unit < 512; unit += F.G) {
        const int b = unit >> 6, c = unit & 63, t0 = c * 64;
        float Ac[4] = {1.f, 1.f, 1.f, 1.f}, hl[4] = {0.f, 0.f, 0.f, 0.f};
        uint4 rr[3];
        auto ldraw = [&](int sub) {
#pragma unroll
            for (int j = 0; j < 3; ++j) { const int it = F.tid + j * 512; const int row = it >> 6, c8 = (it & 63) * 8; const int t = t0 + sub * 16 - 3 + row;
                rr[j] = make_uint4(0u, 0u, 0u, 0u); if (it < 19 * 64 && t >= 0) rr[j] = *(const uint4*)(U1 + ((size_t)b * SEQ + t) * LD1 + C_CX + c8); } };
        ldraw(0);
#pragma unroll 1
        for (int sub = 0; sub < 4; ++sub) {
#pragma unroll
            for (int j = 0; j < 3; ++j) { const int it = F.tid + j * 512; if (it < 19 * 64) *(uint4*)(rawl + (it >> 6) * 520 + (it & 63) * 8) = rr[j]; }
            __syncthreads();
            if (sub < 3) ldraw(sub + 1);
            for (int it = F.tid; it < 1024; it += 512) {
                const int tk = it >> 6, c8 = (it & 63) * 8;
                float y[8];
#pragma unroll
                for (int i = 0; i < 8; ++i) y[i] = cwL[2048 + c8 + i];
#pragma unroll
                for (int j = 0; j < 4; ++j) { const uint4 v = *(const uint4*)(rawl + (tk + j) * 520 + c8); float f[8]; unpack8(v, f);
#pragma unroll
                    for (int i = 0; i < 8; ++i) y[i] += cwL[j * 512 + c8 + i] * f[i]; }
                uint4 o; o.x = pack2(y[0], y[1]); o.y = pack2(y[2], y[3]); o.z = pack2(y[4], y[5]); o.w = pack2(y[6], y[7]);
                *(uint4*)(xcb + tk * 520 + c8) = o;
            }
            __syncthreads();
            bf16x8 af[2];
#pragma unroll
            for (int ks = 0; ks < 2; ++ks) af[ks] = *(const bf16x8*)(xcb + fr * 520 + g * 64 + 32 * ks + 8 * fq);
#pragma unroll
            for (int ct = 0; ct < 4; ++ct) {
                const int ch = g * 64 + ct * 16 + fr;
                f32x4 accA = {0.f, 0.f, 0.f, 0.f}, accX = {0.f, 0.f, 0.f, 0.f};
#pragma unroll
                for (int ks = 0; ks < 2; ++ks) { accA = __builtin_amdgcn_mfma_f32_16x16x32_bf16(af[ks], wa[ct][ks], accA, 0, 0, 0); accX = __builtin_amdgcn_mfma_f32_16x16x32_bf16(af[ks], wx[ct][ks], accX, 0, 0, 0); }
                float Ap[4], Hp[4]; float A4 = 1.f, H4 = 0.f;
#pragma unroll
                for (int rg = 0; rg < 4; ++rg) {
                    const float xc = bf2f(xcb[(4 * fq + rg) * 520 + ch]);
                    const float r = sigmoidf_(accA[rg] + ba[ct]), ig = sigmoidf_(accX[rg] + bx[ct]);
                    const float a = fexp_(-8.0f * r * sp[ct]);
                    const float bt = sqrtf(fmaxf(1.0f - a * a, 0.f)) * (ig * xc);
                    H4 = a * H4 + bt; A4 *= a; Ap[rg] = A4; Hp[rg] = H4;
                }
                float iA = A4, iH = H4;
                { const float pA = __shfl_up(iA, 16), pH = __shfl_up(iH, 16); if (fq >= 1) { iH = iA * pH + iH; iA = pA * iA; } }
                { const float pA = __shfl_up(iA, 32), pH = __shfl_up(iH, 32); if (fq >= 2) { iH = iA * pH + iH; iA = pA * iA; } }
                float eA = __shfl_up(iA, 16), eH = __shfl_up(iH, 16); if (fq == 0) { eA = 1.f; eH = 0.f; }
                const float tA = __shfl(iA, 48 + fr), tH = __shfl(iH, 48 + fr);
                const float cA = Ac[ct] * eA, cH = eA * hl[ct] + eH;
#pragma unroll
                for (int rg = 0; rg < 4; ++rg) { const size_t row = (size_t)b * SEQ + t0 + sub * 16 + 4 * fq + rg;
                    LA[row * 512 + ch] = f2bf(cA * Ap[rg]); LH[row * 512 + ch] = f2bf(Ap[rg] * cH + Hp[rg]); }
                hl[ct] = tA * hl[ct] + tH; Ac[ct] = Ac[ct] * tA;
            }
            __syncthreads();
        }
        if (fq == 0) {
#pragma unroll
            for (int ct = 0; ct < 4; ++ct) { const int ch = g * 64 + ct * 16 + fr; Aend[((size_t)b * 64 + c) * 512 + ch] = Ac[ct]; Hend[((size_t)b * 64 + c) * 512 + ch] = hl[ct]; } }
    }
    __syncthreads();
}

DI void p8b_scans(const Frame& F) {
    const int gt = F.bid * 512 + F.tid, nthr = F.G * 512;
    const int glru = nthr >= 65536 + 4096 + 4096 ? gt - 65536 : gt;
    if (glru >= 0 && glru < 4096) {
        const int b = glru >> 9, ch = glru & 511;
        const float* Aend = (const float*)(F.ws + WS_AEND); const float* Hend = (const float*)(F.ws + WS_HEND); float* Hin = (float*)(F.ws + WS_HIN);
        float H = 0.f; float an[8], hn[8];
#pragma unroll
        for (int j = 0; j < 8; ++j) { const size_t o = ((size_t)b * 64 + j) * 512 + ch; an[j] = Aend[o]; hn[j] = Hend[o]; }
#pragma unroll 1
        for (int c0 = 0; c0 < 64; c0 += 8) {
            float av[8], hv[8];
#pragma unroll
            for (int j = 0; j < 8; ++j) { av[j] = an[j]; hv[j] = hn[j]; }
            if (c0 + 8 < 64) {
#pragma unroll
                for (int j = 0; j < 8; ++j) { const size_t o = ((size_t)b * 64 + c0 + 8 + j) * 512 + ch; an[j] = Aend[o]; hn[j] = Hend[o]; } }
#pragma unroll
            for (int j = 0; j < 8; ++j) { const size_t o = ((size_t)b * 64 + c0 + j) * 512 + ch; Hin[o] = H; H = av[j] * H + hv[j]; }
        }
    }
    const float* scal = (const float*)(F.ws + WS_SCAL); float* minp = (float*)(F.ws + WS_SCAL) + 4096;
    if (gt >= nthr - 4096) {
        const int q = gt - (nthr - 4096); const int bh = q >> 7, d = q & 127;
        const float* zloc = (const float*)(F.ws + WS_ZLOC); float* nin = (float*)(F.ws + WS_NIN);
        float m = 0.f, n = 0.f; float zn[8], bn[8], dn[8];
#pragma unroll
        for (int j = 0; j < 8; ++j) { const int unit = bh * 64 + j; zn[j] = zloc[(size_t)unit * 128 + d]; bn[j] = scal[unit]; dn[j] = scal[2048 + unit]; }
#pragma unroll 1
        for (int c0 = 0; c0 < 64; c0 += 8) {
            float zv[8], blv[8], dmv[8];
#pragma unroll
            for (int j = 0; j < 8; ++j) { zv[j] = zn[j]; blv[j] = bn[j]; dmv[j] = dn[j]; }
            if (c0 + 8 < 64) {
#pragma unroll
                for (int j = 0; j < 8; ++j) { const int unit = bh * 64 + c0 + 8 + j; zn[j] = zloc[(size_t)unit * 128 + d]; bn[j] = scal[unit]; dn[j] = scal[2048 + unit]; } }
#pragma unroll
            for (int j = 0; j < 8; ++j) { const int unit = bh * 64 + c0 + j; const float bl = blv[j], dm = dmv[j];
                const float mn = fmaxf(bl + m, dm); const float keep = fexp_(bl + m - mn), add = fexp_(dm - mn);
                nin[(size_t)unit * 128 + d] = n; if (d == 0) minp[unit] = m;
                n = keep * n + add * zv[j]; m = mn; }
        }
    }
    bf16_t* ST = (bf16_t*)(F.ws + WS_BFB);
    float* kp = (float*)F.lds; float* ad = kp + 64;
    if (gt < 65536) {
        const int bh = gt >> 11, ed = (gt & 2047) * 8;
        if (F.wave == 0) { const int c = F.lane; const int unit = bh * 64 + c; const float bl = scal[unit], dm = scal[2048 + unit];
            float Bi = bl;
            for (int o = 1; o < 64; o <<= 1) { const float n = __shfl_up(Bi, o); if (c >= o) Bi += n; }
            float pm = dm - Bi;
            for (int o = 1; o < 64; o <<= 1) { const float n = __shfl_up(pm, o); if (c >= o) pm = fmaxf(pm, n); }
            const float mnext = Bi + fmaxf(0.f, pm);
            float mcur = __shfl_up(mnext, 1); if (c == 0) mcur = 0.f;
            kp[c] = expf(bl + mcur - mnext); ad[c] = expf(dm - mnext); }
        u32x4 sn[8];
#pragma unroll
        for (int j = 0; j < 8; ++j) sn[j] = *(const u32x4*)(ST + (size_t)(bh * 64 + j) * 16384 + ed);
        __syncthreads();
        float C[8] = {0.f, 0.f, 0.f, 0.f, 0.f, 0.f, 0.f, 0.f};
#pragma unroll 1
        for (int c0 = 0; c0 < 64; c0 += 8) {
            uint4 sv[8];
#pragma unroll
            for (int j = 0; j < 8; ++j) sv[j] = make_uint4(sn[j][0], sn[j][1], sn[j][2], sn[j][3]);
            if (c0 + 8 < 64) {
#pragma unroll
                for (int j = 0; j < 8; ++j) sn[j] = *(const u32x4*)(ST + (size_t)(bh * 64 + c0 + 8 + j) * 16384 + ed); }
#pragma unroll
            for (int j = 0; j < 8; ++j) { float sf[8]; unpack8(sv[j], sf);
                uint4 o; o.x = pack2(C[0], C[1]); o.y = pack2(C[2], C[3]); o.z = pack2(C[4], C[5]); o.w = pack2(C[6], C[7]);
                *(uint4*)(ST + (size_t)(bh * 64 + c0 + j) * 16384 + ed) = o;
                const float kk = kp[c0 + j], aa = ad[c0 + j];
#pragma unroll
                for (int i = 0; i < 8; ++i) C[i] = kk * C[i] + aa * sf[i]; }
        }
    }
}

DI void p8c_mlstm_out(const Frame& F) {
    const bf16_t* U1 = (const bf16_t*)(F.ws + WS_U);
    const bf16_t* ST = (const bf16_t*)(F.ws + WS_BFB);
    bf16_t* Y = (bf16_t*)(F.ws + WS_BFA);
    const float* nin_g = (const float*)(F.ws + WS_NIN); const float* minp = (const float*)(F.ws + WS_SCAL) + 4096;
    unsigned char* L = F.lds;
    float* li = (float*)(L + ML_LI); float* bc = (float*)(L + ML_BC); float* wkk = (float*)(L + ML_WK); float* mt = (float*)(L + ML_MT); float* dq = (float*)(L + ML_DQ); float* rs = (float*)(L + ML_RS); float* nin = (float*)(L + ML_NIN);
    bf16_t* q = (bf16_t*)(L + ML_Q); bf16_t* k = (bf16_t*)(L + ML_K); bf16_t* vT = (bf16_t*)(L + ML_VT); bf16_t* CT = (bf16_t*)(L + ML_CT); bf16_t* W = (bf16_t*)(L + ML_W); float* cwl = (float*)(L + ML_END); bf16_t* raw = (bf16_t*)(L + ML_KT); float* HT = (float*)(L + ML_Q);
    const float* cw = F.in[24]; const float* cb = F.in[25];
    const bf16_t* KCV = (const bf16_t*)F.out + (size_t)MT * 1024;
    float gi_n = 0.f, gf_n = 0.f, nin_n = 0.f, min_n = 0.f; int hprev = -1;
    uint4 rq3[3], rv3[3]; u32x4 rc4[4], rkc[2];
    auto prefetch = [&](int unit) { const int c = unit & 63, h = (unit >> 6) & 3, b = unit >> 8;
        load_raw128(F, U1, b, c * 64 - 3, 67, C_DQ + h * 128, rq3);
#pragma unroll
        for (int j = 0; j < 2; ++j) rkc[j] = *(const u32x4*)(KCV + (size_t)unit * 8192 + (size_t)(F.tid + j * 512) * 8);
        load_raw128(F, U1, b, c * 64, 64, C_DV + h * 128, rv3);
#pragma unroll
        for (int j = 0; j < 4; ++j) { const int it = F.tid + j * 512; rc4[j] = *(const u32x4*)(ST + (size_t)unit * 16384 + (it >> 4) * 128 + (it & 15) * 8); }
        if (F.wave == 0) { const float* gts = (const float*)(F.ws + WS_GATES) + ((size_t)b * SEQ + c * 64 + F.lane) * 8; gi_n = gts[h]; gf_n = gts[4 + h]; }
        if (F.tid < 128) nin_n = nin_g[(size_t)unit * 128 + F.tid];
        min_n = minp[unit]; };
    if (F.bid < 2048) prefetch(F.bid);
    for (int unit = F.bid; unit < 2048; unit += F.G) {
        const int c = unit & 63, h = (unit >> 6) & 3, b = unit >> 8;
        const float m_in = min_n;
        if (h != hprev) { hprev = h;
            for (int e = F.tid; e < 1280; e += 512) { float v;
                if (e < 512) v = cw[(size_t)(e >> 7) * 1024 + h * 128 + (e & 127)]; else if (e < 1024) v = cw[(size_t)((e - 512) >> 7) * 1024 + 512 + h * 128 + (e & 127)];
                else if (e < 1152) v = cb[h * 128 + (e - 1024)]; else v = cb[512 + h * 128 + (e - 1152)];
                cwl[e] = v; } }
        mlstm_gates_v(F, gi_n, gf_n, h, li, bc);
        write_raw128(F, 67, rq3, raw);
#pragma unroll
        for (int j = 0; j < 2; ++j) { const int it = F.tid + j * 512; *(u32x4*)(k + (it >> 4) * 136 + (it & 15) * 8) = rkc[j]; }
        __syncthreads();
        for (int it = F.tid; it < 1024; it += 512) { const int s = it & 63, d0 = (it >> 6) * 8;
            float y[8]; conv8_lds(raw, s, d0, cwl, cwl + 1024, y);
            uint4 o; o.x = pack2(siluf_(y[0]), siluf_(y[1])); o.y = pack2(siluf_(y[2]), siluf_(y[3])); o.z = pack2(siluf_(y[4]), siluf_(y[5])); o.w = pack2(siluf_(y[6]), siluf_(y[7]));
            *(uint4*)(q + s * 136 + d0) = o; }
        __syncthreads();
        write_raw128(F, 64, rv3, raw);
        __syncthreads();
        for (int it = F.tid; it < 1024; it += 512) { const int s = it & 63, d0 = (it >> 6) * 8;
            const uint4 vv = *(const uint4*)(raw + s * 136 + d0); const unsigned wv[4] = {vv.x, vv.y, vv.z, vv.w};
#pragma unroll
            for (int i = 0; i < 8; ++i) vT[(d0 + i) * 72 + s] = (bf16_t)((i & 1) ? (wv[i >> 1] >> 16) : (wv[i >> 1] & 0xFFFFu)); }
#pragma unroll
        for (int j = 0; j < 4; ++j) { const int it = F.tid + j * 512; *(u32x4*)(CT + (it >> 4) * 136 + (it & 15) * 8) = rc4[j]; }
        if (F.tid < 128) nin[F.tid] = nin_n;
        if (unit + F.G < 2048) prefetch(unit + F.G);
        if (F.tid >= 128 && F.tid < 192) { const int l = F.tid - 128;
            float pm = li[l] - bc[l];
            for (int o = 1; o < 64; o <<= 1) { const float n = __shfl_up(pm, o); if (l >= o) pm = fmaxf(pm, n); }
            mt[l] = bc[l] + fmaxf(m_in, pm); }
        __syncthreads();
        { const int l = F.tid >> 3, part = F.tid & 7; float a = 0.f;
#pragma unroll
          for (int d = 0; d < 16; ++d) a += bf2f(q[l * 136 + part * 16 + d]) * nin[part * 16 + d];
          a += __shfl_xor(a, 1); a += __shfl_xor(a, 2); a += __shfl_xor(a, 4);
          if (part == 0) dq[l] = a; }
        for (int tix = F.wave * 2; tix < F.wave * 2 + 2; ++tix) {
            const int lt = tix >> 2, st = tix & 3;
            const f32x4 a = mma16(q + lt * 16 * 136, 136, k + st * 16 * 136, 136, 128, F.lane);
            const int fr = F.lane & 15, fq = F.lane >> 4; const int s = st * 16 + fr;
#pragma unroll
            for (int r = 0; r < 4; ++r) { const int l = lt * 16 + 4 * fq + r;
                const float w = s <= l ? a[r] * expf(bc[l] - bc[s] + li[s] - mt[l]) : 0.f;
                W[l * 72 + s] = f2bf(w); }
        }
        __syncthreads();
        { const int l = F.tid >> 3, part = F.tid & 7; float a = 0.f;
#pragma unroll
          for (int s = 0; s < 8; ++s) a += bf2f(W[l * 72 + part * 8 + s]);
          a += __shfl_xor(a, 1); a += __shfl_xor(a, 2); a += __shfl_xor(a, 4);
          if (part == 0) rs[l] = a; }
        if (F.tid >= 64 && F.tid < 128) { const int l = F.tid - 64; li[l] = expf(bc[l] + m_in - mt[l]); }
        if (F.tid >= 128 && F.tid < 192) { const int l = F.tid - 128; wkk[l] = expf(-mt[l]); }
        __syncthreads();
        uint4 ro2[2], rz2[2];
#pragma unroll
        for (int j = 0; j < 2; ++j) { const int it = F.tid + j * 512; const size_t row = (size_t)b * SEQ + c * 64 + (it >> 4);
            ro2[j] = *(const uint4*)(U1 + row * LD1 + C_DO + h * 128 + (it & 15) * 8); rz2[j] = *(const uint4*)(U1 + row * LD1 + C_DZ + h * 128 + (it & 15) * 8); }
        f32x4 hres[4];
#pragma unroll
        for (int ti = 0; ti < 4; ++ti) { const int tix = F.wave * 4 + ti;
            const int lt = tix >> 3, et = tix & 7;
            const f32x4 qc = mma16(q + lt * 16 * 136, 136, CT + et * 16 * 136, 136, 128, F.lane);
            const f32x4 wv = mma16(W + lt * 16 * 72, 72, vT + et * 16 * 72, 72, 64, F.lane);
            const int fq = F.lane >> 4;
#pragma unroll
            for (int r = 0; r < 4; ++r) { const int l = lt * 16 + 4 * fq + r;
                const float prev = li[l];
                const float num = prev * qc[r] + wv[r];
                const float den = prev * dq[l] + rs[l];
                hres[ti][r] = num * __builtin_amdgcn_rcpf(fmaxf(fabsf(den), wkk[l])); }
        }
        __syncthreads();
#pragma unroll
        for (int ti = 0; ti < 4; ++ti) { const int tix = F.wave * 4 + ti; const int lt = tix >> 3, et = tix & 7; const int fr = F.lane & 15, fq = F.lane >> 4;
#pragma unroll
            for (int r = 0; r < 4; ++r) HT[(lt * 16 + 4 * fq + r) * 132 + et * 16 + fr] = hres[ti][r]; }
        __syncthreads();
#pragma unroll
        for (int j = 0; j < 2; ++j) { const int it = F.tid + j * 512; const int l = it >> 4, e0 = (it & 15) * 8;
            const size_t row = (size_t)b * SEQ + c * 64 + l;
            float of[8], zf[8]; unpack8(ro2[j], of); unpack8(rz2[j], zf);
            const f32x4 h0 = *(const f32x4*)(HT + l * 132 + e0), h1 = *(const f32x4*)(HT + l * 132 + e0 + 4);
            float y[8];
#pragma unroll
            for (int i = 0; i < 4; ++i) { y[i] = sigmoidf_(of[i]) * h0[i] * siluf_(zf[i]); y[4 + i] = sigmoidf_(of[4 + i]) * h1[i] * siluf_(zf[4 + i]); }
            uint4 o; o.x = pack2(y[0], y[1]); o.y = pack2(y[2], y[3]); o.z = pack2(y[4], y[5]); o.w = pack2(y[6], y[7]);
            *(uint4*)(Y + row * 1024 + 512 + h * 128 + e0) = o; }
        __syncthreads();
    }
}
DI void p8c_lru_out(const Frame& F) {
    const bf16_t* U1 = (const bf16_t*)(F.ws + WS_U);
    const bf16_t* LA = (const bf16_t*)(F.ws + WS_LRUA); const bf16_t* LH = (const bf16_t*)(F.ws + WS_LRUH);
    const float* Hin = (const float*)(F.ws + WS_HIN);
    bf16_t* Y = (bf16_t*)(F.ws + WS_BFA);
    const size_t n8 = (size_t)MT * 64;
    for (size_t it = (size_t)F.bid * 512 + F.tid; it < n8; it += (size_t)F.G * 512) {
        const size_t row = it >> 6; const int c0 = (int)(it & 63) * 8; const int b = (int)(row >> 12), t = (int)(row & 4095), c = t >> 6;
        const uint4 av = *(const uint4*)(LA + row * 512 + c0), hv = *(const uint4*)(LH + row * 512 + c0), zv = *(const uint4*)(U1 + row * LD1 + C_CZ + c0);
        float af[8], hf[8], zf[8]; unpack8(av, af); unpack8(hv, hf); unpack8(zv, zf);
        const float* hi = Hin + ((size_t)b * 64 + c) * 512 + c0; float y[8];
#pragma unroll
        for (int i = 0; i < 8; ++i) y[i] = (af[i] * hi[i] + hf[i]) * siluf_(zf[i]);
        uint4 o; o.x = pack2(y[0], y[1]); o.y = pack2(y[2], y[3]); o.z = pack2(y[4], y[5]); o.w = pack2(y[6], y[7]);
        *(uint4*)(Y + row * 1024 + c0) = o;
    }
}

constexpr int N_PHASES = 16;
__global__ void __launch_bounds__(512, 2) mk_fwd(Args args) {
    extern __shared__ __attribute__((aligned(16))) unsigned char smem[];
    Frame F;
    F.tid = threadIdx.x; F.lane = F.tid & 63; F.wave = __builtin_amdgcn_readfirstlane(F.tid >> 6);
    F.G = gridDim.x; F.bid = blockIdx.x; F.gw = F.bid * 8 + F.wave; F.nw = F.G * 8;
    F.lds = smem + LDS_WORK_OFF; F.ws = args.ws; F.out = args.out; F.ctl = (unsigned*)args.ws;
#pragma unroll
    for (int i = 0; i < 28; ++i) F.in[i] = args.in[i];
    LAS unsigned char* lsm = (LAS unsigned char*)smem;
    LAS unsigned char* lut = lsm + (LDS_BYTES - 12288);
    LAS float* tbl = (LAS float*)(lsm + (LDS_BYTES - 12288 + 256));
    LAS float* biasL = (LAS float*)(lsm + (LDS_BYTES - 8192));
    if (F.tid < 4) ((LAS unsigned*)lsm)[F.tid] = 0u;
    if (F.tid < 128) { const int n = F.tid; int bk;
        if (n < 16) bk = n; else { bk = 16; const int thr[15] = {19, 21, 24, 27, 31, 35, 40, 46, 52, 59, 67, 77, 87, 99, 113};
#pragma unroll
            for (int j = 0; j < 15; ++j) bk += (n >= thr[j]) ? 1 : 0; }
        lut[n] = (unsigned char)bk; }
    { const int hd = F.tid >> 5, bk = F.tid & 31; tbl[hd * 32 + bk] = args.in[6][bk * 16 + hd]; }
    F.lut = lut; F.tbl = tbl; F.biasL = biasL; F.ldsl = lsm + LDS_WORK_OFF;
    __syncthreads();
    for (int e = F.tid; e < 16 * 128; e += 512) { const int hd = e >> 7, n = e & 127; const int bk = n < 16 ? n : (n >= 113 ? 31 : (int)lut[n]); biasL[e] = tbl[hd * 32 + bk] * 1.4426950408889634f; }
    __syncthreads();
    const int lo = args.ph_lo, hi = args.ph_hi;
    XcdBarrier bar; bar.bar = F.ctl; bar.x = 0; bar.st = nullptr;
#if !MK_PER_PHASE
    bar = xcd_barrier_post(F.ctl, (volatile LAS unsigned*)lsm);
#endif
#ifndef PH_MASK
#define PH_MASK 0xFFFF
#endif
#define IN(k) (phase_refresh(F), ((PH_MASK >> (k)) & 1) && lo <= (k) && (k) < hi)
#ifndef DLY_LO
#define DLY_LO -1
#define DLY_HI -1
#endif
#ifndef DLY_MULT
#define DLY_MULT 4
#endif
    unsigned long long dly_t0 = 0ull;
#define DLY_START(k) do { if ((k) == DLY_LO && F.bid == 0 && F.tid == 0) dly_t0 = __builtin_amdgcn_s_memrealtime(); } while (0)
#define DLY_END(k) do { if ((k) == DLY_HI && F.bid == 0) { if (F.tid == 0) { const unsigned long long t1 = __builtin_amdgcn_s_memrealtime(); const unsigned long long until = t1 + DLY_MULT * (t1 - dly_t0); \
        while (__builtin_amdgcn_s_memrealtime() < until) __builtin_amdgcn_s_sleep(16); } __syncthreads(); } } while (0)
#if MK_PER_PHASE
#define SEAM(k) do { } while (0)
#else
#define SEAM(k) do { if (IN(k) && IN((k) + 1)) xcd_barrier(bar); DLY_END(k); DLY_START((k) + 1); } while (0)
#endif
    LAS unsigned char* glds = lsm + LDS_WORK_OFF;
    unsigned char* ws = args.ws;
    bf16_t* BFA = (bf16_t*)(ws + WS_BFA); bf16_t* BFB = (bf16_t*)(ws + WS_BFB); bf16_t* U = (bf16_t*)(ws + WS_U); bf16_t* Ef = (bf16_t*)(ws + WS_U); bf16_t* X1b = (bf16_t*)F.out;

    DLY_START(0);
    if (IN(0)) { p0_prologue(F); }
    SEAM(0);
    if (IN(1)) {
        pg8::Gemm g{BFA, (const bf16_t*)(ws + WS_WIN0), MT, LD0, 1024}; pg8::StaticOrder S; S.init(MT, LD0, F.G, F.bid);
        pg8::EpiBf16<0> E{U, LD0};
        pg8::gemm_phase(glds, g, S, E);
        pg8::Gemm g2{(const bf16_t*)(ws + WS_WVT), BFA, 512, MT, 1024}; pg8::StaticOrder S2; S2.init(512, MT, F.G, F.bid);
        pg8::EpiBf16<0> E2{(bf16_t*)(ws + WS_VT), MT};
        pg8::gemm_phase(glds, g2, S2, E2);
    }
    SEAM(1);
    if (IN(2)) { p2a_build_blocks(F); }
    SEAM(2);
    if (IN(3)) {
        if (F.bid < 32) {
            const int which = F.bid >> 4;
            pg8::Gemm g{(const bf16_t*)(ws + (which ? WS_AV : WS_AK)), (const bf16_t*)(ws + (which ? WS_WC1V : WS_WC1K)), 4096, 256, 2048}; pg8::StaticOrder S; S.init(4096, 256, F.G, F.bid & 15);
            pg8::EpiBf16<1> E{(bf16_t*)(ws + (which ? WS_HV : WS_HK)), 256}; pg8::gemm_phase(glds, g, S, E);
            asm volatile("s_waitcnt vmcnt(0)" ::: "memory"); __syncthreads();
            pg8::Unit u; S.next(0, u);
            p2c_compress_rows(F, which, u.pm * 256);
            asm volatile("s_waitcnt vmcnt(0)" ::: "memory"); __syncthreads();
            if (F.tid == 0) { __builtin_amdgcn_fence(__ATOMIC_RELEASE, "agent"); asm volatile("s_waitcnt vmcnt(0)" ::: "memory");
                (void)__hip_atomic_fetch_add(F.ctl + CW_CMPDONE, 1u, __ATOMIC_RELAXED, __HIP_MEMORY_SCOPE_AGENT); }
        }
        att_dsa(F);
    }
    if (IN(5)) {
        if (F.tid == 0) { unsigned sp = 0;
            while (__hip_atomic_load(F.ctl + CW_CMPDONE, __ATOMIC_RELAXED, __HIP_MEMORY_SCOPE_AGENT) < 32u) { __builtin_amdgcn_s_sleep(2);
                if (++sp > (1u << 22)) { atomicAdd(F.ctl + XB_TMO, 1u); break; } }
            __builtin_amdgcn_fence(__ATOMIC_ACQUIRE, "agent"); asm volatile("s_waitcnt vmcnt(0)" ::: "memory"); }
        __syncthreads();
        att_nsa(F); }
    if (IN(3) && IN(6)) xcd_barrier(bar);
    if (IN(6)) {
        pg8::Gemm g{BFB, (const bf16_t*)(ws + WS_WOUT0), MT, 1024, 1024}; pg8::StaticOrder S; S.init(MT, 1024, F.G, F.bid);
        pg8::EpiResid<0> E{F.in[0], nullptr, BFA};
        pg8::gemm_phase(glds, g, S, E);
    }
    SEAM(6);
    if (IN(7)) {
        { pg8::Gemm g{(const bf16_t*)(ws + WS_PBF), (const bf16_t*)(ws + WS_WP0), MT, 1024, 256}; pg8::StaticOrder S; S.init(MT, 1024, F.G, F.bid);
          pg8::EpiBf16<0> E{Ef, 1024}; pg8::gemm_phase(glds, g, S, E); }
        asm volatile("s_waitcnt vmcnt(0)" ::: "memory"); __syncthreads();
        { pg8::Gemm g{BFA, (const bf16_t*)(ws + WS_WG0), MT, 1024, 1024}; pg8::StaticOrder S; S.init(MT, 1024, F.G, F.bid);
          pg8::EpiGate<1> E{nullptr, X1b, BFA, Ef}; pg8::gemm_phase(glds, g, S, E); }
    }
    SEAM(7);
    if (IN(8)) { rmsnorm_gates(F, X1b, F.in[2] + 1024, BFB); }
    SEAM(8);
    if (IN(9)) {
        pg8::Gemm g{BFB, (const bf16_t*)(ws + WS_WIN1), MT, LD1, 1024}; pg8::StaticOrder S; S.init(MT, LD1, F.G, F.bid);
        pg8::EpiBf16<0> E{U, LD1};
        pg8::gemm_phase(glds, g, S, E);
    }
    SEAM(9);
    if (IN(10)) { p8a_mlstm_local(F); p8a_lru_local(F); }
    SEAM(10);
    if (IN(11)) { p8b_scans(F); }
    SEAM(11);
    if (IN(12)) { p8c_mlstm_out(F); p8c_lru_out(F); }
    SEAM(12);

    if (IN(13)) {
        pg8::Gemm g{BFA, (const bf16_t*)(ws + WS_WOUT1), MT, 1024, 1024}; pg8::StaticOrder S; S.init(MT, 1024, F.G, F.bid);
        pg8::EpiResid<1> E{nullptr, X1b, BFB};
        pg8::gemm_phase(glds, g, S, E);
    }
    SEAM(13);
    if (IN(14)) {
        { pg8::Gemm g{(const bf16_t*)(ws + WS_PBF) + (size_t)MT * 256, (const bf16_t*)(ws + WS_WP1), MT, 1024, 256}; pg8::StaticOrder S; S.init(MT, 1024, F.G, F.bid);
          pg8::EpiBf16<0> E{Ef, 1024}; pg8::gemm_phase(glds, g, S, E); }
        asm volatile("s_waitcnt vmcnt(0)" ::: "memory"); __syncthreads();
        { pg8::Gemm g{BFB, (const bf16_t*)(ws + WS_WG1), MT, 1024, 1024}; pg8::StaticOrder S; S.init(MT, 1024, F.G, F.bid);
          pg8::EpiGateNorm E{F.out, BFB, Ef, F.in[3], (float*)(ws + WS_SS), F.ctl + CW_NORMCNT, F.ctl + XB_TMO}; pg8::gemm_phase(glds, g, S, E); }
    }
#undef IN
#undef SEAM
}

extern "C" void kernel_launch(void* const* d_in, const int* in_sizes, int n_in, void* d_out, int out_size, void* d_ws, size_t ws_size, hipStream_t stream) {
    static int grid = 0;
    if (grid == 0) {
        if (n_in != 28 || out_size != MT * DM || ws_size < WS_END) { fprintf(stderr, "kernel_launch: unexpected shapes (n_in %d, out %d, ws %zu < %zu)\n", n_in, out_size, ws_size, (size_t)WS_END); grid = -1; return; }
        int dev = 0, cus = 0, per_cu = 0;
        if (hipGetDevice(&dev) != hipSuccess || hipDeviceGetAttribute(&cus, hipDeviceAttributeMultiprocessorCount, dev) != hipSuccess) { grid = -1; return; }
        if (hipFuncSetAttribute((const void*)mk_fwd, hipFuncAttributeMaxDynamicSharedMemorySize, LDS_BYTES) != hipSuccess) { fprintf(stderr, "kernel_launch: hipFuncSetAttribute failed\n"); grid = -1; return; }
        if (hipOccupancyMaxActiveBlocksPerMultiprocessor(&per_cu, (const void*)mk_fwd, 512, LDS_BYTES) != hipSuccess || per_cu < 1)
            fprintf(stderr, "kernel_launch: occupancy query reports %d workgroups per CU\n", per_cu);
        (void)hipGetLastError();
        grid = cus > 256 ? 256 : cus;
    }
    if (grid < 0) return;
    if (hipMemsetAsync(d_ws, 0, CTL_BYTES, stream) != hipSuccess) return;
    Args a{};
    for (int i = 0; i < 28; ++i) a.in[i] = (const float*)d_in[i];
    a.out = (float*)d_out; a.ws = (unsigned char*)d_ws;
#if MK_PER_PHASE
    for (int p = 0; p < N_PHASES; ++p) { a.ph_lo = p; a.ph_hi = p + 1; hipLaunchKernelGGL(mk_fwd, dim3(grid), dim3(512), LDS_BYTES, stream, a); }
#else
    a.ph_lo = 0; a.ph_hi = N_PHASES;
    hipLaunchKernelGGL(mk_fwd, dim3(grid), dim3(512), LDS_BYTES, stream, a);
#endif
}
```
